# Optimizing an MI355X kernel written in HIP

```python
import math
import jax, jax.numpy as jnp
from jax import lax
import numpy as np

D_MODEL = 2048
BATCH = 8
SEQ = 4096
DEPTH = 1

MIX_WIDTH = D_MODEL
ATTN_WIDTH = MIX_WIDTH // 2
CONV_CHANNELS = MIX_WIDTH - ATTN_WIDTH
N_ATTN_HEADS = 8
V_HEAD_DIM = ATTN_WIDTH // N_ATTN_HEADS
QK_HEAD_DIM = V_HEAD_DIM // 2
IN_COLS = 3 * ATTN_WIDTH + 2 * CONV_CHANNELS
CONV_TAPS = 31
Q_BLOCK = 128
N_GROUPS = 4
EXPERTS_PER_GROUP = 8
N_EXPERTS = N_GROUPS * EXPERTS_PER_GROUP
TOP_K = 2
D_EXPERT = D_MODEL // 2
MOE_BLOCK = 128
EPS = 1e-6
NEG_INF = -1e30

kernel_name = 'hybrid_diffattn_conformer_hmoe'


def rmsnorm(x, g):
    xf = x.astype(jnp.float32)
    y = xf * lax.rsqrt(jnp.mean(xf * xf, axis=-1, keepdims=True) + EPS)
    return (y * g.astype(jnp.float32)).astype(x.dtype)


def layernorm(x, g, b):
    xf = x.astype(jnp.float32)
    xc = xf - jnp.mean(xf, axis=-1, keepdims=True)
    var = jnp.mean(xc * xc, axis=-1, keepdims=True)
    y = xc * lax.rsqrt(var + EPS) * g.astype(jnp.float32) + b.astype(jnp.float32)
    return y.astype(x.dtype)


def lambda_init(layer):
    return 0.8 - 0.6 * math.exp(-0.3 * layer)


def alibi_slopes(n_heads):
    return 2.0 ** (-8.0 * (jnp.arange(n_heads, dtype=jnp.float32) + 1.0) / n_heads)


def diff_attention(q, k, v, lam, lam0, subln_g):
    B, S, H = q.shape[0], q.shape[1], q.shape[2]
    n_blocks = S // Q_BLOCK
    scale = QK_HEAD_DIM ** -0.5
    slopes = alibi_slopes(H)
    kpos = jnp.arange(S)
    qb = q.reshape(B, n_blocks, Q_BLOCK, H, 2, QK_HEAD_DIM).transpose(1, 0, 2, 3, 4, 5)

    def one_block(args):
        q_blk, i = args
        qpos = i * Q_BLOCK + jnp.arange(Q_BLOCK)
        s = jnp.einsum('bqhcd,bkhcd->bhcqk', q_blk, k,
                       preferred_element_type=jnp.float32) * scale
        dist = (qpos[:, None] - kpos[None, :]).astype(jnp.float32)
        s = s - slopes[None, :, None, None, None] * dist
        s = jnp.where(dist >= 0.0, s, NEG_INF)
        p = jax.nn.softmax(s, axis=-1)
        w = p[:, :, 0] - lam * p[:, :, 1]
        return jnp.einsum('bhqk,bkhd->bqhd', w.astype(v.dtype), v)

    ob = lax.map(one_block, (qb, jnp.arange(n_blocks)))
    o = ob.transpose(1, 0, 2, 3, 4).reshape(B, S, H, V_HEAD_DIM)
    o = rmsnorm(o, subln_g) * (1.0 - lam0)
    return o.reshape(B, S, H * V_HEAD_DIM)


def conformer_conv(a, gate, conv_w, conv_b, ln_g, ln_b):
    u = a * jax.nn.sigmoid(gate)
    c = lax.conv_general_dilated(u, conv_w.astype(u.dtype), window_strides=(1,),
                                 padding=[(CONV_TAPS - 1, 0)],
                                 dimension_numbers=('NWC', 'WIO', 'NWC'),
                                 feature_group_count=CONV_CHANNELS)
    c = c + conv_b
    return jax.nn.silu(layernorm(c, ln_g, ln_b))


def hier_moe(xn, w_group_router, b_group_router, w_expert_router, b_expert_router,
             w_gate, w_up, w_down):
    B, S, D = xn.shape
    T = B * S
    xf = xn.reshape(T, D)
    g_logits = (xf @ w_group_router).astype(jnp.float32) + b_group_router.astype(jnp.float32)
    g_prob = jax.nn.softmax(g_logits, axis=-1)
    g_sel = jnp.argmax(g_prob, axis=-1)
    g_w = jnp.take_along_axis(g_prob, g_sel[:, None], axis=-1)[:, 0]
    e_logits = ((xf @ w_expert_router).astype(jnp.float32)
                + b_expert_router.astype(jnp.float32)).reshape(T, N_GROUPS, EXPERTS_PER_GROUP)
    e_in_group = jnp.take_along_axis(e_logits, g_sel[:, None, None], axis=1)[:, 0]
    top_val, top_loc = lax.top_k(e_in_group, TOP_K)
    e_w = jax.nn.softmax(top_val, axis=-1) * g_w[:, None]
    e_id = g_sel[:, None] * EXPERTS_PER_GROUP + top_loc

    A = T * TOP_K
    flat_e = e_id.reshape(A)
    flat_tok = jnp.repeat(jnp.arange(T, dtype=jnp.int32), TOP_K)
    flat_w = e_w.reshape(A)
    order = jnp.argsort(flat_e)
    s_e, s_tok, s_w = flat_e[order], flat_tok[order], flat_w[order]
    counts = jnp.bincount(flat_e, length=N_EXPERTS)
    padded = (counts + MOE_BLOCK - 1) // MOE_BLOCK * MOE_BLOCK
    starts = jnp.cumsum(counts) - counts
    ends_p = jnp.cumsum(padded)
    starts_p = ends_p - padded
    dest = starts_p[s_e] + jnp.arange(A) - starts[s_e]
    n_blocks = -(-(A + N_EXPERTS * (MOE_BLOCK - 1)) // MOE_BLOCK)
    P = n_blocks * MOE_BLOCK
    pad_tok = jnp.zeros((P,), jnp.int32).at[dest].set(s_tok)
    pad_w = jnp.zeros((P,), jnp.float32).at[dest].set(s_w)
    blk_e = jnp.minimum(jnp.searchsorted(ends_p, jnp.arange(n_blocks) * MOE_BLOCK, side='right'),
                        N_EXPERTS - 1)

    def expert_block(args):
        tok, w, e = args
        rows = xf[tok]
        h = jax.nn.silu(rows @ w_gate[e]) * (rows @ w_up[e])
        return (h @ w_down[e]) * w[:, None].astype(rows.dtype)

    ys = lax.map(expert_block, (pad_tok.reshape(n_blocks, MOE_BLOCK),
                                pad_w.reshape(n_blocks, MOE_BLOCK), blk_e))
    out = jnp.zeros((T, D), xf.dtype).at[pad_tok].add(ys.reshape(P, D))
    return out.reshape(B, S, D)


def setup_inputs(seed: int = 0) -> dict:
    key = jax.random.key(seed)
    ks = jax.random.split(key, 22)
    L = DEPTH

    def nrm(k, shape, scale):
        return jax.random.normal(k, shape, jnp.float32) * scale

    return {
        'x': nrm(ks[0], (BATCH, SEQ, D_MODEL), 1.0),
        'norm_mix_g': 1.0 + nrm(ks[1], (L, D_MODEL), 0.02),
        'w_in': nrm(ks[2], (L, D_MODEL, IN_COLS), D_MODEL ** -0.5),
        'lambda_q1': nrm(ks[3], (L, QK_HEAD_DIM), 0.1),
        'lambda_k1': nrm(ks[4], (L, QK_HEAD_DIM), 0.1),
        'lambda_q2': nrm(ks[5], (L, QK_HEAD_DIM), 0.1),
        'lambda_k2': nrm(ks[6], (L, QK_HEAD_DIM), 0.1),
        'subln_g': 1.0 + nrm(ks[7], (L, V_HEAD_DIM), 0.02),
        'conv_w': nrm(ks[8], (L, CONV_TAPS, 1, CONV_CHANNELS), CONV_TAPS ** -0.5),
        'conv_b': nrm(ks[9], (L, CONV_CHANNELS), 0.02),
        'conv_ln_g': 1.0 + nrm(ks[10], (L, CONV_CHANNELS), 0.02),
        'conv_ln_b': nrm(ks[11], (L, CONV_CHANNELS), 0.02),
        'w_out': nrm(ks[12], (L, MIX_WIDTH, D_MODEL), MIX_WIDTH ** -0.5),
        'norm_ffn_g': 1.0 + nrm(ks[13], (L, D_MODEL), 0.02),
        'w_group_router': nrm(ks[14], (L, D_MODEL, N_GROUPS), D_MODEL ** -0.5),
        'b_group_router': nrm(ks[15], (L, N_GROUPS), 0.01),
        'w_expert_router': nrm(ks[16], (L, D_MODEL, N_EXPERTS), D_MODEL ** -0.5),
        'b_expert_router': nrm(ks[17], (L, N_EXPERTS), 0.01),
        'w_gate': nrm(ks[18], (L, N_EXPERTS, D_MODEL, D_EXPERT), D_MODEL ** -0.5),
        'w_up': nrm(ks[19], (L, N_EXPERTS, D_MODEL, D_EXPERT), D_MODEL ** -0.5),
        'w_down': nrm(ks[20], (L, N_EXPERTS, D_EXPERT, D_MODEL), D_EXPERT ** -0.5),
        'norm_final_g': 1.0 + nrm(ks[21], (D_MODEL,), 0.02),
    }


def reference(x, norm_mix_g, w_in, lambda_q1, lambda_k1, lambda_q2, lambda_k2, subln_g,
              conv_w, conv_b, conv_ln_g, conv_ln_b, w_out, norm_ffn_g, w_group_router,
              b_group_router, w_expert_router, b_expert_router, w_gate, w_up, w_down,
              norm_final_g):
    B, S, _ = x.shape
    h = x
    for l in range(DEPTH):
        lam0 = lambda_init(l)
        lam = (jnp.exp(jnp.sum(lambda_q1[l] * lambda_k1[l]).astype(jnp.float32))
               - jnp.exp(jnp.sum(lambda_q2[l] * lambda_k2[l]).astype(jnp.float32)) + lam0)
        xn = rmsnorm(h, norm_mix_g[l])
        proj = xn @ w_in[l]
        q, k, v, ca, cg = jnp.split(proj, [ATTN_WIDTH, 2 * ATTN_WIDTH, 3 * ATTN_WIDTH,
                                           3 * ATTN_WIDTH + CONV_CHANNELS], axis=-1)
        q = q.reshape(B, S, N_ATTN_HEADS, 2, QK_HEAD_DIM)
        k = k.reshape(B, S, N_ATTN_HEADS, 2, QK_HEAD_DIM)
        v = v.reshape(B, S, N_ATTN_HEADS, V_HEAD_DIM)
        attn_out = diff_attention(q, k, v, lam, lam0, subln_g[l])
        conv_out = conformer_conv(ca, cg, conv_w[l], conv_b[l], conv_ln_g[l], conv_ln_b[l])
        h = h + jnp.concatenate([attn_out, conv_out], axis=-1) @ w_out[l]
        h = h + hier_moe(rmsnorm(h, norm_ffn_g[l]), w_group_router[l], b_group_router[l],
                         w_expert_router[l], b_expert_router[l], w_gate[l], w_up[l], w_down[l])
    return rmsnorm(h, norm_final_g)
```

```cpp
#include <hip/hip_runtime.h>
#include <cstdio>
#include <cstdint>
namespace pg8 {
#define PG8_LAS __attribute__((address_space(3)))
typedef unsigned short bf16_t;
typedef short bf16x8 __attribute__((ext_vector_type(8)));
typedef float f32x4 __attribute__((ext_vector_type(4)));
typedef unsigned u32x4 __attribute__((ext_vector_type(4)));
constexpr int BM = 256, BK = 64, HALF = 128, HTB = HALF * BK * 2  , STAGE_BYTES = 8 * HTB, NXCD = 8, WGM = 8;

__host__ __device__ __forceinline__ int lds_byte(int r, int c) { const int st = (r >> 4) * 2 + (c >> 5), rr = r & 15, cc = c & 31, ob = rr * 64 + cc * 2; return st * 1024 + (ob ^ (((ob >> 9) & 1) << 5)); }
__host__ __device__ __forceinline__ void stage_rc(int b, int& R, int& C) { const int st = b / 1024, sb = b % 1024, swz = sb ^ (((sb >> 9) & 1) << 5); R = (st >> 1) * 16 + swz / 64; C = (st & 1) * 32 + (swz % 64) / 2; }
__host__ __device__ __forceinline__ int perm32(int rho) { const int n = rho >> 4, i = rho & 15; return 8 * (i >> 2) + 4 * n + (i & 3); }

struct Unit { int pm, pn, e, nvalid, lbase; };
struct Gemm { const bf16_t* A; const bf16_t* Bt; int M, N, K; };

struct StaticOrder {
    int nM, nN, nwg, G, c;
    __host__ __device__ void init(int M, int N, int G_, int c_) { nM = M / BM; nN = N / BM; nwg = nM * nN; G = G_; c = c_; }
    __host__ __device__ bool next(int i, Unit& u) const {
        const long L = (long)i * G + c; if (L >= nwg) return false;
        int wgid = (int)L; { const int q = nwg / NXCD, r = nwg % NXCD, xcd = wgid % NXCD, off = wgid / NXCD; wgid = (xcd < r ? xcd * (q + 1) : r * (q + 1) + (xcd - r) * q) + off; }
        const int nig = WGM * nN, gid = wgid / nig, fm = gid * WGM, gsz = (nM - fm) < WGM ? (nM - fm) : WGM;
        u.pm = fm + ((wgid % nig) % gsz); u.pn = (wgid % nig) / gsz; return true;
    }
    __device__ __forceinline__ const char* bbase(const Gemm& g, const Unit& u, size_t tstep) const { return (const char*)g.Bt + (size_t)u.pn * tstep; }
    __device__ __forceinline__ unsigned goff(const Unit&, int, int, int) const { return 0u; }
    __device__ __forceinline__ void a_ready(const Unit&) const {}
    __device__ __forceinline__ void done(const Unit&) const {}
};

struct MoeOrder {
    const PG8_LAS int* tstart; const PG8_LAS int* cnt; const int* list; int G, c, shift, lcap; size_t estride;
    __device__ __forceinline__ bool next(int i, Unit& u) const {
        const int ntiles = tstart[32]; const long L = (long)i * G + c; if (L >= (long)ntiles * 8) return false;
        const int rt = (int)(L >> 3); int e = 0;
#pragma unroll
        for (int k = 1; k < 32; ++k) e += (tstart[k] <= rt) ? 1 : 0;
        e = __builtin_amdgcn_readfirstlane(e);
        const int pm = __builtin_amdgcn_readfirstlane(rt - tstart[e]); const int rem = __builtin_amdgcn_readfirstlane(cnt[e]) - 256 * pm;
        u.pm = pm; u.pn = (int)(L & 7); u.e = e; u.nvalid = rem < 256 ? rem : 256; u.lbase = e * lcap + 256 * pm; return true;
    }
    __device__ __forceinline__ const char* bbase(const Gemm& g, const Unit& u, size_t tstep) const { return (const char*)g.Bt + (size_t)u.e * estride + (size_t)u.pn * tstep; }
    __device__ __forceinline__ unsigned goff(const Unit& u, int r, int C, int K) const {
        const int a = list[u.lbase + (r < u.nvalid ? r : 0)];
        return ((unsigned)(a >> shift) * (unsigned)K + (unsigned)C) * 2u;
    }
    __device__ __forceinline__ void a_ready(const Unit&) const {}
    __device__ __forceinline__ void done(const Unit&) const {}
};

__device__ __forceinline__ unsigned cvt_pk_bf16(float lo, float hi) { unsigned r; asm volatile("v_cvt_pk_bf16_f32 %0, %1, %2" : "=v"(r) : "v"(lo), "v"(hi)); return r; }
__device__ __forceinline__ float bf_lo(unsigned w) { return __builtin_bit_cast(float, w << 16); }
__device__ __forceinline__ float bf_hi(unsigned w) { return __builtin_bit_cast(float, w & 0xffff0000u); }

struct EpiIn {
    static constexpr bool PERM = true, AFTER_DRAIN = false;
    bf16_t* P0; size_t stride; bf16_t* CG; const float* rstd; float scale0;
    __device__ __forceinline__ void operator()(const f32x4 (&acc)[2][2][4][2], const Unit& u, int wr, int wc, int fr, int fq) const {
        const int row0 = u.pm * BM + wr * 64 + fr, t = u.pn >> 2; bf16_t* base = (t < 4) ? P0 + (size_t)t * stride : CG;
        const float sc = (t == 0) ? scale0 : 1.f; const int col0 = (u.pn & 3) * BM + wc * 32 + 8 * fq;
#pragma unroll
        for (int ai = 0; ai < 2; ++ai)
#pragma unroll
            for (int m = 0; m < 4; ++m) { const int row = row0 + ai * HALF + m * 16; const float rs = rstd[row] * sc; bf16_t* rowp = base + (size_t)row * 1024 + col0;
#pragma unroll
                for (int bj = 0; bj < 2; ++bj) { const f32x4 v0 = acc[ai][bj][m][0] * rs, v1 = acc[ai][bj][m][1] * rs;
                    u32x4 w; w.x = cvt_pk_bf16(v0[0], v0[1]); w.y = cvt_pk_bf16(v0[2], v0[3]); w.z = cvt_pk_bf16(v1[0], v1[1]); w.w = cvt_pk_bf16(v1[2], v1[3]);
                    *(u32x4*)(rowp + bj * HALF) = w; } }
    }
};
struct EpiOut {
    static constexpr bool PERM = true, AFTER_DRAIN = false;
    bf16_t* H; const bf16_t* XB; float* part;
    __device__ __forceinline__ void operator()(const f32x4 (&acc)[2][2][4][2], const Unit& u, int wr, int wc, int fr, int fq) const {
        const int row0 = u.pm * BM + wr * 64 + fr, col0 = u.pn * BM + wc * 32 + 8 * fq;
#pragma unroll
        for (int ai = 0; ai < 2; ++ai)
#pragma unroll
            for (int m = 0; m < 4; ++m) { const int row = row0 + ai * HALF + m * 16; const size_t off = (size_t)row * 2048 + col0; float ss = 0.f;
#pragma unroll
                for (int bj = 0; bj < 2; ++bj) { const u32x4 xb = *(const u32x4*)(XB + off + bj * HALF);
                    f32x4 v0 = acc[ai][bj][m][0], v1 = acc[ai][bj][m][1];
                    v0[0] += bf_lo(xb.x); v0[1] += bf_hi(xb.x); v0[2] += bf_lo(xb.y); v0[3] += bf_hi(xb.y); v1[0] += bf_lo(xb.z); v1[1] += bf_hi(xb.z); v1[2] += bf_lo(xb.w); v1[3] += bf_hi(xb.w);
                    ss += (v0[0] * v0[0] + v0[1] * v0[1]) + (v0[2] * v0[2] + v0[3] * v0[3]) + (v1[0] * v1[0] + v1[1] * v1[1]) + (v1[2] * v1[2] + v1[3] * v1[3]);
                    u32x4 w; w.x = cvt_pk_bf16(v0[0], v0[1]); w.y = cvt_pk_bf16(v0[2], v0[3]); w.z = cvt_pk_bf16(v1[0], v1[1]); w.w = cvt_pk_bf16(v1[2], v1[3]);
                    *(u32x4*)(H + off + bj * HALF) = w; }
                ss += __shfl_xor(ss, 16); ss += __shfl_xor(ss, 32);
                if (fq == 0) part[(size_t)row * 32 + u.pn * 4 + wc] = ss; }
    }
};
__device__ __forceinline__ float silu_f(float x) { return x * __builtin_amdgcn_rcpf(1.f + __builtin_amdgcn_exp2f(-1.4426950408889634f * x)); }
struct EpiGU {
    static constexpr bool PERM = true, AFTER_DRAIN = false;
    bf16_t* H1; const int* list; const float* rstd2;
    __device__ __forceinline__ void operator()(const f32x4 (&acc)[2][2][4][2], const Unit& u, int wr, int wc, int fr, int fq) const {
        const int col0 = u.pn * HALF + wc * 32 + 8 * fq;
#pragma unroll
        for (int ai = 0; ai < 2; ++ai)
#pragma unroll
            for (int m = 0; m < 4; ++m) { const int r = ai * HALF + wr * 64 + m * 16 + fr;
                if (r < u.nvalid) { const int a = list[u.lbase + r]; const float rs = rstd2[a >> 1];
                    const f32x4 g0 = acc[ai][0][m][0] * rs, g1 = acc[ai][0][m][1] * rs, u0 = acc[ai][1][m][0] * rs, u1 = acc[ai][1][m][1] * rs;
                    u32x4 w; w.x = cvt_pk_bf16(silu_f(g0[0]) * u0[0], silu_f(g0[1]) * u0[1]); w.y = cvt_pk_bf16(silu_f(g0[2]) * u0[2], silu_f(g0[3]) * u0[3]);
                    w.z = cvt_pk_bf16(silu_f(g1[0]) * u1[0], silu_f(g1[1]) * u1[1]); w.w = cvt_pk_bf16(silu_f(g1[2]) * u1[2], silu_f(g1[3]) * u1[3]);
                    *(u32x4*)(H1 + (size_t)a * 1024 + col0) = w; } }
    }
};
struct EpiDown {
    static constexpr bool PERM = true, AFTER_DRAIN = false;
    bf16_t* Y; const int* list; const float* wts;
    __device__ __forceinline__ void operator()(const f32x4 (&acc)[2][2][4][2], const Unit& u, int wr, int wc, int fr, int fq) const {
        const int col0 = u.pn * BM + wc * 32 + 8 * fq;
#pragma unroll
        for (int ai = 0; ai < 2; ++ai)
#pragma unroll
            for (int m = 0; m < 4; ++m) { const int r = ai * HALF + wr * 64 + m * 16 + fr;
                if (r < u.nvalid) { const int a = list[u.lbase + r]; const float ws = wts[a]; bf16_t* rowp = Y + (size_t)a * 2048 + col0;
#pragma unroll
                    for (int bj = 0; bj < 2; ++bj) { const f32x4 v0 = acc[ai][bj][m][0] * ws, v1 = acc[ai][bj][m][1] * ws;
                        u32x4 w; w.x = cvt_pk_bf16(v0[0], v0[1]); w.y = cvt_pk_bf16(v0[2], v0[3]); w.z = cvt_pk_bf16(v1[0], v1[1]); w.w = cvt_pk_bf16(v1[2], v1[3]);
                        *(u32x4*)(rowp + bj * HALF) = w; } } }
    }
};

template <class Epi, class Sched, bool ALIGN_EPI, bool GATHER>
__device__ __forceinline__ void gemm_phase(PG8_LAS unsigned char* lds, const Gemm g, const Sched& S, const Epi& E) {
    const int tid = threadIdx.x, wid = __builtin_amdgcn_readfirstlane(tid >> 6), lane = tid & 63, wr = wid >> 2, wc = wid & 3, fr = lane & 15, fq = lane >> 4;
    const int K = g.K, nt = K / BK;
    unsigned voffA[2], voffB[2]; int RA[2], CA[2];
#pragma unroll
    for (int i = 0; i < 2; ++i) { int R, C; stage_rc(tid * 16 + i * 8192, R, C); const int Rb = Epi::PERM ? ((R & ~31) + perm32(R & 31)) : R;
        voffA[i] = (unsigned)(R * K + C) * 2u; voffB[i] = (unsigned)(Rb * K + C) * 2u; RA[i] = R; CA[i] = C; }
    const size_t kstep = (size_t)(BK * 2);
    const size_t hstep = (size_t)HALF * K * 2;
    const size_t tstep = 2 * hstep;
    const unsigned ldsw = (unsigned)wid * 1024u;
    const int aoff = lds_byte(wr * 64 + fr, fq * 8), boff = lds_byte(wc * 32 + fr, fq * 8);
#define PG8_SA(b, h) (((b) * 2 + (h)) * HTB)
#define PG8_SB(b, h) ((4 + (b) * 2 + (h)) * HTB)
#define PG8_STAGE(bufoff, gbase, voff) do { _Pragma("unroll") for (int _i = 0; _i < 2; ++_i) \
        __builtin_amdgcn_global_load_lds((const unsigned*)((const char*)(gbase) + (voff)[_i]), (PG8_LAS unsigned*)(lds + (bufoff) + ldsw + _i * 8192), 16, 0, 0); } while (0)
#define PG8_STAGE_A(bufoff, kp, h) do { if constexpr (GATHER) { PG8_STAGE(bufoff, kp, cgo[h]); } else { PG8_STAGE(bufoff, (kp) + (h) * hstep, voffA); } } while (0)
#define PG8_LDA(dst, b, h) do { _Pragma("unroll") for (int m = 0; m < 4; ++m) _Pragma("unroll") for (int k = 0; k < 2; ++k) dst[m][k] = *(const PG8_LAS bf16x8*)(lds + PG8_SA(b, h) + aoff + m * 2048 + k * 1024); } while (0)
#define PG8_LDB(dst, b, h) do { _Pragma("unroll") for (int n = 0; n < 2; ++n) _Pragma("unroll") for (int k = 0; k < 2; ++k) dst[n][k] = *(const PG8_LAS bf16x8*)(lds + PG8_SB(b, h) + boff + n * 2048 + k * 1024); } while (0)
#define PG8_MMA(ai, bj, At, Bt) do { __builtin_amdgcn_s_setprio(1); _Pragma("unroll") for (int m = 0; m < 4; ++m) _Pragma("unroll") for (int n = 0; n < 2; ++n) _Pragma("unroll") for (int k = 0; k < 2; ++k) \
        acc[ai][bj][m][n] = __builtin_amdgcn_mfma_f32_16x16x32_bf16(Bt[n][k], At[m][k], acc[ai][bj][m][n], 0, 0, 0); __builtin_amdgcn_s_setprio(0); } while (0)
#define PG8_WAIT_V(n) asm volatile("s_waitcnt vmcnt(" #n ")" ::: "memory")
#define PG8_WAIT_L(n) asm volatile("s_waitcnt lgkmcnt(" #n ")" ::: "memory")
#define PG8_BAR __builtin_amdgcn_s_barrier()
#define PG8_SCHED __builtin_amdgcn_sched_barrier(0)
    Unit cur, nxt; int ui = 0;
    if (!S.next(0, cur)) return;
    f32x4 acc[2][2][4][2];
#pragma unroll
    for (int a = 0; a < 2; ++a)
#pragma unroll
        for (int b = 0; b < 2; ++b)
#pragma unroll
            for (int m = 0; m < 4; ++m)
#pragma unroll
                for (int n = 0; n < 2; ++n) acc[a][b][m][n] = (f32x4){0.f, 0.f, 0.f, 0.f};
    bf16x8 At[4][2], B0[2][2], B1[2][2];
    unsigned cgo[2][2] = {{0u, 0u}, {0u, 0u}}, ngo[2][2] = {{0u, 0u}, {0u, 0u}};
    if constexpr (GATHER) {
#pragma unroll
        for (int h = 0; h < 2; ++h)
#pragma unroll
            for (int i = 0; i < 2; ++i) cgo[h][i] = S.goff(cur, h * HALF + RA[i], CA[i], K);
    }
    const char* cA = GATHER ? (const char*)g.A : (const char*)g.A + (size_t)cur.pm * tstep; const char* cB = S.bbase(g, cur, tstep);
    S.a_ready(cur);
    PG8_STAGE(PG8_SB(0, 0), cB, voffB); PG8_STAGE(PG8_SB(0, 1), cB + hstep, voffB); PG8_STAGE_A(PG8_SA(0, 0), cA, 0); PG8_STAGE_A(PG8_SA(0, 1), cA, 1);
    if (wr == 1) PG8_BAR;
    PG8_WAIT_V(2); PG8_BAR;
    PG8_STAGE(PG8_SB(1, 0), cB + kstep, voffB); PG8_STAGE_A(PG8_SA(1, 0), cA + kstep, 0); PG8_STAGE(PG8_SB(1, 1), cB + hstep + kstep, voffB);
    PG8_WAIT_V(6); PG8_BAR;
    for (;;) {
        const bool has_next = S.next(ui + 1, nxt);
        if constexpr (GATHER) {
            if (has_next) {
#pragma unroll
                for (int h = 0; h < 2; ++h)
#pragma unroll
                    for (int i = 0; i < 2; ++i) ngo[h][i] = S.goff(nxt, h * HALF + RA[i], CA[i], K);
            } else {
#pragma unroll
                for (int h = 0; h < 2; ++h)
#pragma unroll
                    for (int i = 0; i < 2; ++i) ngo[h][i] = cgo[h][i];
            }
        }
        const char* nA = GATHER ? (const char*)g.A : (has_next ? (const char*)g.A + (size_t)nxt.pm * tstep : cA); const char* nB = has_next ? S.bbase(g, nxt, tstep) : cB;
        for (int t = 0; t < nt; t += 2) {
            const bool last = (t == nt - 2);
            const char* a1 = cA + (size_t)(t + 1) * kstep;
            const char* a2 = last ? nA : cA + (size_t)(t + 2) * kstep; const char* b2 = last ? nB : cB + (size_t)(t + 2) * kstep;
            const char* a3 = a2 + kstep; const char* b3 = b2 + kstep;
            if (last && has_next) S.a_ready(nxt);
            PG8_LDB(B0, 0, 0); PG8_LDB(B1, 0, 1); PG8_SCHED; PG8_LDA(At, 0, 0); PG8_STAGE_A(PG8_SA(1, 1), a1, 1);
            if constexpr (GATHER) { if (last) {
#pragma unroll
                for (int h = 0; h < 2; ++h)
#pragma unroll
                    for (int i = 0; i < 2; ++i) cgo[h][i] = ngo[h][i]; } }
            PG8_WAIT_V(8); PG8_WAIT_L(0); PG8_BAR; PG8_MMA(0, 0, At, B0); PG8_MMA(0, 1, At, B1); PG8_BAR; PG8_SCHED;
            PG8_LDA(At, 0, 1); PG8_STAGE(PG8_SB(0, 0), b2, voffB); PG8_STAGE(PG8_SB(0, 1), b2 + hstep, voffB); PG8_STAGE_A(PG8_SA(0, 0), a2, 0);
            PG8_WAIT_V(8); PG8_WAIT_L(0); PG8_BAR; PG8_MMA(1, 0, At, B0); PG8_MMA(1, 1, At, B1); PG8_BAR; PG8_SCHED;
            PG8_LDB(B0, 1, 0); PG8_LDB(B1, 1, 1); PG8_SCHED; PG8_LDA(At, 1, 0); PG8_STAGE_A(PG8_SA(0, 1), a2, 1);
            PG8_WAIT_V(8); PG8_WAIT_L(0); PG8_BAR; PG8_MMA(0, 0, At, B0); PG8_MMA(0, 1, At, B1); PG8_BAR; PG8_SCHED;
            PG8_LDA(At, 1, 1); PG8_STAGE(PG8_SB(1, 0), b3, voffB); PG8_STAGE(PG8_SB(1, 1), b3 + hstep, voffB); PG8_STAGE_A(PG8_SA(1, 0), a3, 0);
            PG8_WAIT_V(8); PG8_WAIT_L(0); PG8_BAR; PG8_MMA(1, 0, At, B0); PG8_MMA(1, 1, At, B1); PG8_BAR; PG8_SCHED;
        }
        if constexpr (ALIGN_EPI) { if (wr == 0) PG8_BAR; }
        E(acc, cur, wr, wc, fr, fq); S.done(cur);
        if (!has_next) break;
#pragma unroll
        for (int a = 0; a < 2; ++a)
#pragma unroll
            for (int b = 0; b < 2; ++b)
#pragma unroll
                for (int m = 0; m < 4; ++m)
#pragma unroll
                    for (int n = 0; n < 2; ++n) acc[a][b][m][n] = (f32x4){0.f, 0.f, 0.f, 0.f};
        cur = nxt; cA = nA; cB = nB; ++ui;
        if constexpr (ALIGN_EPI) { if (wr == 1) PG8_BAR; }
    }
    PG8_WAIT_V(0);
    if constexpr (!ALIGN_EPI) { if (wr == 0) PG8_BAR; }
    PG8_BAR;
#undef PG8_SA
#undef PG8_SB
#undef PG8_STAGE
#undef PG8_STAGE_A
#undef PG8_LDA
#undef PG8_LDB
#undef PG8_MMA
#undef PG8_WAIT_V
#undef PG8_WAIT_L
#undef PG8_BAR
#undef PG8_SCHED
}
}
#define GAS __attribute__((address_space(1)))
#define LAS __attribute__((address_space(3)))
typedef unsigned short bf16;
typedef unsigned v4u __attribute__((ext_vector_type(4)));
typedef float f32x4 __attribute__((ext_vector_type(4)));
typedef short bf16x8 __attribute__((ext_vector_type(8)));
typedef GAS unsigned gu32;
typedef GAS unsigned long long gu64;
#define RLX_AGENT __ATOMIC_RELAXED, __HIP_MEMORY_SCOPE_AGENT
#define LDS_WAIT() asm volatile("s_waitcnt lgkmcnt(0)" ::: "memory")
#define VM_WAIT() asm volatile("s_waitcnt vmcnt(0)" ::: "memory")
__device__ __forceinline__ unsigned long long rt() { return __builtin_amdgcn_s_memrealtime(); }
__device__ __forceinline__ unsigned f2bf(float f) { unsigned u = __builtin_bit_cast(unsigned, f); return (u + 0x7fffu + ((u >> 16) & 1u)) >> 16; }
__device__ __forceinline__ unsigned pk2(float lo, float hi) { return f2bf(lo) | (f2bf(hi) << 16); }

#define XB_TMO      128
#define XB_XCNT(j)  (256  + 64 * (j))
#define XB_XSUB(j)  (1280 + 64 * (j))
#define XB_XGEN(j)  (2304 + 64 * (j))
#define XB_TOP      3328
#define XB_TOPGEN   3392
#define XCD_BAR_WORDS 3456
#define XB_SPIN_CAP (1u << 18)

__device__ __forceinline__ unsigned xb_ld(unsigned* p)              { return __hip_atomic_load(p, __ATOMIC_RELAXED, __HIP_MEMORY_SCOPE_AGENT); }
__device__ __forceinline__ unsigned xb_add(unsigned* p, unsigned v) { return __hip_atomic_fetch_add(p, v, __ATOMIC_RELAXED, __HIP_MEMORY_SCOPE_AGENT); }
__device__ __forceinline__ unsigned xb_xcc_id() { return (unsigned)__builtin_amdgcn_s_getreg((3 << 11) | 20) & 0xFu; }
#define XB_SPIN(cond, bar) do { unsigned _sp = 0; while (cond) { __builtin_amdgcn_s_sleep(1); \
    if ((++_sp & 255u) == 0u) { if (xb_ld(&(bar)[XB_TMO])) break; if (_sp > XB_SPIN_CAP) { atomicAdd(&(bar)[XB_TMO], 1u); break; } } } } while (0)

struct XcdBarrier {
    unsigned* bar; unsigned x;
    volatile LAS unsigned* st;
};

__device__ __forceinline__ XcdBarrier xcd_barrier_post(unsigned* bar, volatile LAS unsigned* st) {
    XcdBarrier b; b.bar = bar; b.x = xb_xcc_id(); b.st = st;
    if (threadIdx.x == 0) (void)xb_add(&bar[XB_XCNT(b.x)], 1u);
    return b;
}
__device__ __forceinline__ void xcd_barrier_complete(unsigned* bar, unsigned x, unsigned& nloc, unsigned& nx) {
    const unsigned G = gridDim.x * gridDim.y * gridDim.z;
    unsigned sum, cnt, mine, sp = 0u;
    for (;;) {
        sum = 0u; cnt = 0u; mine = 0u;
#pragma unroll
        for (unsigned j = 0; j < 16; ++j) { const unsigned c = xb_ld(&bar[XB_XCNT(j)]); sum += c; cnt += (c > 0u) ? 1u : 0u; mine = (j == x) ? c : mine; }
        if (sum == G) break;
        __builtin_amdgcn_s_sleep(1);
        if ((++sp & 255u) == 0u) { if (xb_ld(&bar[XB_TMO])) break; if (sp > XB_SPIN_CAP) { atomicAdd(&bar[XB_TMO], 1u); break; } }
    }
    nloc = mine > 0u ? mine : 1u; nx = cnt > 0u ? cnt : 1u;
}

__device__ __forceinline__ void xcd_barrier(const XcdBarrier& b) {
    asm volatile("s_waitcnt vmcnt(0)" ::: "memory");
    __syncthreads();
    if (threadIdx.x == 0) {
        unsigned* bar = b.bar;
        __builtin_amdgcn_s_waitcnt(0);
        unsigned nloc = b.st[0], nx = b.st[1];
        if (nloc == 0u) { xcd_barrier_complete(bar, b.x, nloc, nx); b.st[0] = nloc; b.st[1] = nx; }
        const unsigned old = xb_add(&bar[XB_XSUB(b.x)], 1u);
        const unsigned gen = old / nloc;
        if (old + 1u == (gen + 1u) * nloc) {
            __builtin_amdgcn_fence(__ATOMIC_RELEASE, "agent");
            asm volatile("s_waitcnt vmcnt(0)" ::: "memory");
            const unsigned og = xb_add(&bar[XB_TOP], 1u);
            const unsigned tg = og / nx;
            if (og + 1u == (tg + 1u) * nx) xb_add(&bar[XB_TOPGEN], 1u);
            else XB_SPIN(xb_ld(&bar[XB_TOPGEN]) == tg, bar);
            __builtin_amdgcn_fence(__ATOMIC_ACQUIRE, "agent");
            xb_add(&bar[XB_XGEN(b.x)], 1u);
            asm volatile("s_waitcnt vmcnt(0)" ::: "memory");
        } else {
            XB_SPIN(xb_ld(&bar[XB_XGEN(b.x)]) == gen, bar);
            __builtin_amdgcn_fence(__ATOMIC_ACQUIRE, "agent");
            asm volatile("s_waitcnt vmcnt(0)" ::: "memory");
        }
    }
    __syncthreads();
}

constexpr int NWAVES = 8;
constexpr int BATCH = 8, SEQ = 4096, T = BATCH * SEQ, D = 2048, NIN = 5120, NEXP = 32, NA = 2 * T;
constexpr float EPS = 1e-6f, LOG2E = 1.4426950408889634f, C2 = 0.125f * 1.4426950408889634f;
constexpr size_t MiB = 1u << 20;
constexpr size_t WS_CTL = 0, CTL_ZERO_BYTES = 1 * MiB;
constexpr size_t WS_RSTD1 = 1 * MiB, WS_RSTD2 = WS_RSTD1 + 128 * 1024, WS_WTS = WS_RSTD2 + 128 * 1024;
constexpr size_t WS_LIST = 2 * MiB;
constexpr size_t WS_PART = 6 * MiB;
constexpr size_t WS_WIN = 10 * MiB, WS_WOUT = 30 * MiB, WS_WGU = 38 * MiB, WS_WD = 294 * MiB;
constexpr size_t WS_XB = 422 * MiB;
constexpr size_t WS_CG = 550 * MiB;
constexpr size_t WS_MIX = 614 * MiB;
constexpr size_t WS_HB = 742 * MiB;
constexpr size_t WS_END = 870 * MiB;
constexpr int CW_TMO = 0, CW_CODE = 1, CW_BAR = 4096, CW_CNT = 8192;
constexpr int RING_OFF = 0, RING_BYTES = 131072, LDSCTL_OFF = RING_BYTES, MISC_OFF = LDSCTL_OFF + 320, TAB_OFF = LDSCTL_OFF + 1024;
constexpr int LDS_BYTES = 147456;
constexpr int NPHASE = 8;
#ifndef MK_ONE_LAUNCH
#define MK_ONE_LAUNCH 0
#endif


typedef unsigned u32x4g __attribute__((ext_vector_type(4)));
__device__ __forceinline__ float wave_sum(float v) {
#pragma unroll
    for (int o = 1; o < 64; o <<= 1) v += __shfl_xor(v, o);
    return v;
}
__device__ __forceinline__ float bflo(unsigned w) { return __builtin_bit_cast(float, w << 16); }
__device__ __forceinline__ float bfhi(unsigned w) { return __builtin_bit_cast(float, w & 0xffff0000u); }
__device__ __forceinline__ float fexp2(float x) { return __builtin_amdgcn_exp2f(x); }

__device__ __forceinline__ void tr_item(const float* W, int N, const float* gk, int k0, int n0, bf16* dst, int dstK, LAS float* scr, int lane) {
#pragma unroll 8
    for (int i = 0; i < 32; ++i) { const int kk = 2 * i + (lane >> 5); float v = W[(size_t)(k0 + kk) * N + n0 + (lane & 31)]; if (gk) v *= gk[k0 + kk]; scr[kk * 33 + (lane & 31)] = v; }
    LDS_WAIT(); asm volatile("" ::: "memory");
    const int c = lane & 7;
#pragma unroll
    for (int j = 0; j < 4; ++j) { const int n = (lane >> 3) + 8 * j; const LAS float* s = scr + (8 * c) * 33 + n;
        v4u o; o.x = pk2(s[0 * 33], s[1 * 33]); o.y = pk2(s[2 * 33], s[3 * 33]); o.z = pk2(s[4 * 33], s[5 * 33]); o.w = pk2(s[6 * 33], s[7 * 33]);
        *(GAS v4u*)(dst + (size_t)n * dstK + 8 * c) = o; }
    LDS_WAIT(); asm volatile("" ::: "memory");
}
struct Ptrs {
    const float *x, *g1, *w_in, *lq1, *lk1, *lq2, *lk2, *subg, *cw, *cb, *lng, *lnb, *w_out, *g2, *wgr, *bgr, *wer, *ber, *w_gate, *w_up, *w_down, *gf;
    float* out; unsigned char* ws;
};
__device__ __forceinline__ void p0_prologue(const Ptrs& P, LAS unsigned char* lds, int lane, int wave, int gw, int NGW) {
    LAS float* scr = (LAS float*)(lds + RING_OFF + wave * 16384);
    bf16* WIN = (bf16*)(P.ws + WS_WIN); bf16* WOUT = (bf16*)(P.ws + WS_WOUT); bf16* WGU = (bf16*)(P.ws + WS_WGU); bf16* WD = (bf16*)(P.ws + WS_WD);
    constexpr int I_IN = 32 * 160, I_OUT = 32 * 64, I_E = 32 * 1024, NITEMS = I_IN + I_OUT + 3 * I_E;
    for (int it = gw; it < NITEMS; it += NGW) {
        if (it < I_IN) { const int kb = it / 160, nb = it % 160; tr_item(P.w_in, NIN, P.g1, 64 * kb, 32 * nb, WIN + (size_t)(32 * nb) * 2048 + 64 * kb, 2048, scr, lane); }
        else if (it < I_IN + I_OUT) { const int r = it - I_IN, kb = r >> 6, nb = r & 63; tr_item(P.w_out, 2048, nullptr, 64 * kb, 32 * nb, WOUT + (size_t)(32 * nb) * 2048 + 64 * kb, 2048, scr, lane); }
        else { const int r = it - I_IN - I_OUT, mat = r >> 15, r2 = r & 32767, e = r2 >> 10, idx = r2 & 1023;
            if (mat < 2) { const int kb = idx >> 5, n0 = 32 * (idx & 31); const int drow = e * 2048 + 256 * (n0 >> 7) + (n0 & 127) + (mat == 1 ? 128 : 0);
                const float* src = (mat == 0 ? P.w_gate : P.w_up) + (size_t)e * 2048 * 1024;
                tr_item(src, 1024, P.g2, 64 * kb, n0, WGU + (size_t)drow * 2048 + 64 * kb, 2048, scr, lane); }
            else { const int kb = idx >> 6, nb = idx & 63; const float* src = P.w_down + (size_t)e * 1024 * 2048;
                tr_item(src, 2048, nullptr, 64 * kb, 32 * nb, WD + ((size_t)e * 2048 + 32 * nb) * 1024 + 64 * kb, 1024, scr, lane); } }
    }
    bf16* XB = (bf16*)(P.ws + WS_XB); float* RS1 = (float*)(P.ws + WS_RSTD1);
    for (int m = gw; m < T; m += NGW) {
        const GAS f32x4* xr = (const GAS f32x4*)(P.x + (size_t)m * D) + lane; f32x4 v[8]; float ss = 0.f;
#pragma unroll
        for (int j = 0; j < 8; ++j) { v[j] = xr[64 * j]; ss += (v[j].x * v[j].x + v[j].y * v[j].y) + (v[j].z * v[j].z + v[j].w * v[j].w); }
        ss = wave_sum(ss);
        if (lane == 0) RS1[m] = 1.0f / sqrtf(ss * (1.0f / D) + EPS);
        GAS unsigned long long* o8 = (GAS unsigned long long*)(XB + (size_t)m * D) + lane;
#pragma unroll
        for (int j = 0; j < 8; ++j) o8[64 * j] = (unsigned long long)pk2(v[j].x, v[j].y) | ((unsigned long long)pk2(v[j].z, v[j].w) << 32);
    }
}

__device__ __forceinline__ void naive_attn(const Ptrs& P, const bf16* Q, const bf16* Kb, const bf16* Vb, bf16* MIX, int lane, int gw, int NGW) {
    const float s1 = wave_sum(P.lq1[lane] * P.lk1[lane]), s2 = wave_sum(P.lq2[lane] * P.lk2[lane]);
    const float lam0 = 0.2f, lam = expf(s1) - expf(s2) + lam0;
    const int r16 = lane & 15, c = (lane >> 4) & 1, vh = lane >> 5;
    for (int u = gw; u < 16384; u += NGW) {
        const int bh = u & 63, qb = 255 - (u >> 6), b = bh >> 3, h = bh & 7, i = qb * 16 + r16, jmax = qb * 16 + 15;
        const float sl2 = exp2f(-(float)(h + 1)) * LOG2E; const size_t rowb = (size_t)b * SEQ;
        float q[64], O[64];
        { const u32x4g* qp = (const u32x4g*)(Q + (rowb + i) * 1024 + h * 128 + c * 64);
#pragma unroll
          for (int d8 = 0; d8 < 8; ++d8) { const u32x4g w = qp[d8]; q[8 * d8 + 0] = bflo(w.x); q[8 * d8 + 1] = bfhi(w.x); q[8 * d8 + 2] = bflo(w.y); q[8 * d8 + 3] = bfhi(w.y);
              q[8 * d8 + 4] = bflo(w.z); q[8 * d8 + 5] = bfhi(w.z); q[8 * d8 + 6] = bflo(w.w); q[8 * d8 + 7] = bfhi(w.w); } }
#pragma unroll
        for (int d = 0; d < 64; ++d) O[d] = 0.f;
        float m = -1e30f, l = 0.f;
        for (int j = 0; j <= jmax; ++j) {
            const u32x4g* kp = (const u32x4g*)(Kb + (rowb + j) * 1024 + h * 128 + c * 64); float s = 0.f;
#pragma unroll
            for (int d8 = 0; d8 < 8; ++d8) { const u32x4g w = kp[d8];
                s += q[8 * d8 + 0] * bflo(w.x) + q[8 * d8 + 1] * bfhi(w.x) + q[8 * d8 + 2] * bflo(w.y) + q[8 * d8 + 3] * bfhi(w.y)
                   + q[8 * d8 + 4] * bflo(w.z) + q[8 * d8 + 5] * bfhi(w.z) + q[8 * d8 + 6] * bflo(w.w) + q[8 * d8 + 7] * bfhi(w.w); }
            s += sl2 * (float)(j - i);
            if (j <= i) {
                if (s > m) { const float al = fexp2(m - s); l *= al;
#pragma unroll
                    for (int d = 0; d < 64; ++d) O[d] *= al;
                    m = s; }
                const float p = fexp2(s - m); l += p;
                const u32x4g* vp = (const u32x4g*)(Vb + (rowb + j) * 1024 + h * 128 + vh * 64);
#pragma unroll
                for (int d8 = 0; d8 < 8; ++d8) { const u32x4g w = vp[d8];
                    O[8 * d8 + 0] += p * bflo(w.x); O[8 * d8 + 1] += p * bfhi(w.x); O[8 * d8 + 2] += p * bflo(w.y); O[8 * d8 + 3] += p * bfhi(w.y);
                    O[8 * d8 + 4] += p * bflo(w.z); O[8 * d8 + 5] += p * bfhi(w.z); O[8 * d8 + 6] += p * bflo(w.w); O[8 * d8 + 7] += p * bfhi(w.w); }
            }
        }
        const float il = 1.0f / l; float ss = 0.f;
#pragma unroll
        for (int d = 0; d < 64; ++d) { float o = O[d] * il; const float o2 = __shfl_xor(o, 16); o = o - lam * o2; O[d] = o; ss += o * o; }
        ss += __shfl_xor(ss, 32);
        const float r = (1.0f / sqrtf(ss * (1.0f / 128.0f) + EPS)) * (1.0f - lam0);
        if (c == 0) { u32x4g* op = (u32x4g*)(MIX + (rowb + i) * 2048 + h * 128 + vh * 64); const float* sg = P.subg + vh * 64;
#pragma unroll
            for (int d8 = 0; d8 < 8; ++d8) { u32x4g w; w.x = pk2(O[8 * d8 + 0] * r * sg[8 * d8 + 0], O[8 * d8 + 1] * r * sg[8 * d8 + 1]); w.y = pk2(O[8 * d8 + 2] * r * sg[8 * d8 + 2], O[8 * d8 + 3] * r * sg[8 * d8 + 3]);
                w.z = pk2(O[8 * d8 + 4] * r * sg[8 * d8 + 4], O[8 * d8 + 5] * r * sg[8 * d8 + 5]); w.w = pk2(O[8 * d8 + 6] * r * sg[8 * d8 + 6], O[8 * d8 + 7] * r * sg[8 * d8 + 7]); op[d8] = w; } }
    }
}

__device__ __forceinline__ void conv_phase(const Ptrs& P, const bf16* CA, const bf16* CGp, bf16* MIX, LAS unsigned char* lds, int tid, int lane, int wave, int blk, int G) {
    LAS unsigned* U = (LAS unsigned*)(lds + RING_OFF);
    float w0[31], w1[31];
#pragma unroll
    for (int j = 0; j < 31; ++j) { w0[j] = P.cw[j * 1024 + 2 * tid]; w1[j] = P.cw[j * 1024 + 2 * tid + 1]; }
    const float b0 = P.cb[2 * tid], b1 = P.cb[2 * tid + 1];
    for (int tile = blk; tile < 1024; tile += G) {
        const int b = tile >> 7, t0 = (tile & 127) * 32; const size_t rowb = (size_t)b * SEQ;
        for (int r = 0; r < 62; ++r) { const int t = t0 - 30 + r; unsigned uw = 0u;
            if (t >= 0) { const unsigned a = *(const unsigned*)(CA + (rowb + t) * 1024 + 2 * tid), g = *(const unsigned*)(CGp + (rowb + t) * 1024 + 2 * tid);
                const float u0 = bflo(a) / (1.f + __expf(-bflo(g))), u1 = bfhi(a) / (1.f + __expf(-bfhi(g))); uw = pk2(u0, u1); }
            U[r * 512 + tid] = uw; }
        for (int t = 31; t >= 0; --t) { float c0 = b0, c1 = b1;
#pragma unroll
            for (int j = 0; j < 31; ++j) { const unsigned uw = U[(t + j) * 512 + tid]; c0 += w0[j] * bflo(uw); c1 += w1[j] * bfhi(uw); }
            U[(t + 30) * 512 + tid] = pk2(c0, c1); }
        __syncthreads();
#pragma unroll 1
        for (int k = 0; k < 4; ++k) { const int rr = wave + 8 * k, t = t0 + rr; const LAS unsigned* row = U + (30 + rr) * 512;
            const v4u x0 = *(const LAS v4u*)(row + 4 * lane), x1 = *(const LAS v4u*)(row + 256 + 4 * lane);
            float v[16] = {bflo(x0.x), bfhi(x0.x), bflo(x0.y), bfhi(x0.y), bflo(x0.z), bfhi(x0.z), bflo(x0.w), bfhi(x0.w), bflo(x1.x), bfhi(x1.x), bflo(x1.y), bfhi(x1.y), bflo(x1.z), bfhi(x1.z), bflo(x1.w), bfhi(x1.w)};
            float s = 0.f;
#pragma unroll
            for (int i = 0; i < 16; ++i) s += v[i];
            const float mean = wave_sum(s) * (1.0f / 1024.0f); float qq = 0.f;
#pragma unroll
            for (int i = 0; i < 16; ++i) { v[i] -= mean; qq += v[i] * v[i]; }
            const float rstd = 1.0f / sqrtf(wave_sum(qq) * (1.0f / 1024.0f) + EPS);
            float y[16];
#pragma unroll
            for (int i = 0; i < 16; ++i) { const int ch = (i < 8 ? 8 * lane + i : 512 + 8 * lane + (i - 8)); const float z = v[i] * rstd * P.lng[ch] + P.lnb[ch]; y[i] = z / (1.f + __expf(-z)); }
            bf16* op = MIX + (rowb + t) * 2048 + 1024 + 8 * lane;
            v4u o0, o1; o0.x = pk2(y[0], y[1]); o0.y = pk2(y[2], y[3]); o0.z = pk2(y[4], y[5]); o0.w = pk2(y[6], y[7]); o1.x = pk2(y[8], y[9]); o1.y = pk2(y[10], y[11]); o1.z = pk2(y[12], y[13]); o1.w = pk2(y[14], y[15]);
            *(GAS v4u*)op = o0; *(GAS v4u*)(op + 512) = o1; }
        __syncthreads();
    }
}

__device__ __forceinline__ void router_phase(const Ptrs& P, const bf16* HB, int lane, int gw, int NGW) {
    float* RS2 = (float*)(P.ws + WS_RSTD2); float* WTS = (float*)(P.ws + WS_WTS); int* LIST = (int*)(P.ws + WS_LIST); unsigned* CNT = (unsigned*)(P.ws + WS_CTL) + CW_CNT;
    for (int tok = gw; tok < T; tok += NGW) {
        float hv[32]; const bf16* hp = HB + (size_t)tok * D; float ss = 0.f;
#pragma unroll
        for (int j = 0; j < 4; ++j) { const u32x4g w = *(const u32x4g*)(hp + 8 * lane + 512 * j);
            hv[8 * j + 0] = bflo(w.x); hv[8 * j + 1] = bfhi(w.x); hv[8 * j + 2] = bflo(w.y); hv[8 * j + 3] = bfhi(w.y); hv[8 * j + 4] = bflo(w.z); hv[8 * j + 5] = bfhi(w.z); hv[8 * j + 6] = bflo(w.w); hv[8 * j + 7] = bfhi(w.w); }
#pragma unroll
        for (int k = 0; k < 32; ++k) ss += hv[k] * hv[k];
        ss = wave_sum(ss); const float rstd = 1.0f / sqrtf(ss * (1.0f / D) + EPS);
        float lg[36];
#pragma unroll
        for (int o = 0; o < 36; ++o) lg[o] = 0.f;
#pragma unroll
        for (int j = 0; j < 4; ++j)
#pragma unroll 2
            for (int i = 0; i < 8; ++i) { const int e = 8 * lane + 512 * j + i; const float xv = hv[8 * j + i] * P.g2[e];
                const f32x4* wr = (const f32x4*)(P.wer + (size_t)e * 32); const f32x4 wg = *(const f32x4*)(P.wgr + (size_t)e * 4);
#pragma unroll
                for (int o4 = 0; o4 < 8; ++o4) { const f32x4 w = wr[o4]; lg[4 * o4 + 0] += xv * w.x; lg[4 * o4 + 1] += xv * w.y; lg[4 * o4 + 2] += xv * w.z; lg[4 * o4 + 3] += xv * w.w; }
                lg[32] += xv * wg.x; lg[33] += xv * wg.y; lg[34] += xv * wg.z; lg[35] += xv * wg.w; }
#pragma unroll
        for (int o = 0; o < 36; ++o) lg[o] = wave_sum(lg[o]) * rstd + (o < 32 ? P.ber[o] : P.bgr[o - 32]);
        int gs = 0; float gm = lg[32];
#pragma unroll
        for (int g = 1; g < 4; ++g) if (lg[32 + g] > gm) { gm = lg[32 + g]; gs = g; }
        float gsum = 0.f;
#pragma unroll
        for (int g = 0; g < 4; ++g) gsum += __expf(lg[32 + g] - gm);
        const float gw_ = 1.0f / gsum;
        float ev[8];
#pragma unroll
        for (int i = 0; i < 8; ++i) ev[i] = gs == 0 ? lg[i] : gs == 1 ? lg[8 + i] : gs == 2 ? lg[16 + i] : lg[24 + i];
        int i1 = 0; float v1 = ev[0];
#pragma unroll
        for (int i = 1; i < 8; ++i) if (ev[i] > v1) { v1 = ev[i]; i1 = i; }
        int i2 = -1; float v2 = -3.0e38f;
#pragma unroll
        for (int i = 0; i < 8; ++i) if (i != i1 && ev[i] > v2) { v2 = ev[i]; i2 = i; }
        const float e2 = __expf(v2 - v1), w1 = gw_ / (1.f + e2), w2 = gw_ * e2 / (1.f + e2);
        if (lane == 0) {
            RS2[tok] = rstd;
            const int ea = gs * 8 + i1, eb = gs * 8 + i2;
            const unsigned ra = __hip_atomic_fetch_add(CNT + 64 * ea, 1u, __ATOMIC_RELAXED, __HIP_MEMORY_SCOPE_AGENT);
            const unsigned rb = __hip_atomic_fetch_add(CNT + 64 * eb, 1u, __ATOMIC_RELAXED, __HIP_MEMORY_SCOPE_AGENT);
            LIST[(size_t)ea * T + ra] = 2 * tok; LIST[(size_t)eb * T + rb] = 2 * tok + 1; WTS[2 * tok] = w1; WTS[2 * tok + 1] = w2;
        }
    }
}
__device__ __forceinline__ void moe_tables(const Ptrs& P, LAS unsigned char* lds, int tid) {
    LAS int* cntL = (LAS int*)(lds + TAB_OFF); LAS int* ts = cntL + 32; unsigned* CNT = (unsigned*)(P.ws + WS_CTL) + CW_CNT;
    if (tid < 32) cntL[tid] = (int)__hip_atomic_load(CNT + 64 * tid, __ATOMIC_RELAXED, __HIP_MEMORY_SCOPE_AGENT);
    __syncthreads();
    if (tid == 0) { int s = 0; for (int e = 0; e < 32; ++e) { ts[e] = s; s += (cntL[e] + 255) >> 8; } ts[32] = s; }
    __syncthreads();
}

__device__ __forceinline__ void final_phase(const Ptrs& P, const bf16* HB, int lane, int gw, int NGW) {
    for (int tok = gw; tok < T; tok += NGW) {
        const bf16* hp = HB + (size_t)tok * D; const bf16* y1 = (const bf16*)P.out + (size_t)tok * 4096; const bf16* y2 = y1 + 2048; float v[32]; float ss = 0.f;
#pragma unroll
        for (int j = 0; j < 4; ++j) { const int o = 8 * lane + 512 * j; const u32x4g a = *(const u32x4g*)(hp + o), b = *(const u32x4g*)(y1 + o), c = *(const u32x4g*)(y2 + o);
            v[8 * j + 0] = bflo(a.x) + bflo(b.x) + bflo(c.x); v[8 * j + 1] = bfhi(a.x) + bfhi(b.x) + bfhi(c.x); v[8 * j + 2] = bflo(a.y) + bflo(b.y) + bflo(c.y); v[8 * j + 3] = bfhi(a.y) + bfhi(b.y) + bfhi(c.y);
            v[8 * j + 4] = bflo(a.z) + bflo(b.z) + bflo(c.z); v[8 * j + 5] = bfhi(a.z) + bfhi(b.z) + bfhi(c.z); v[8 * j + 6] = bflo(a.w) + bflo(b.w) + bflo(c.w); v[8 * j + 7] = bfhi(a.w) + bfhi(b.w) + bfhi(c.w); }
#pragma unroll
        for (int k = 0; k < 32; ++k) ss += v[k] * v[k];
        ss = wave_sum(ss); const float rstd = 1.0f / sqrtf(ss * (1.0f / D) + EPS);
        float* op = P.out + (size_t)tok * D;
#pragma unroll
        for (int j = 0; j < 4; ++j) { const int o = 8 * lane + 512 * j; const f32x4 g0 = *(const f32x4*)(P.gf + o), g1 = *(const f32x4*)(P.gf + o + 4);
            f32x4 r0 = {v[8 * j + 0] * rstd * g0.x, v[8 * j + 1] * rstd * g0.y, v[8 * j + 2] * rstd * g0.z, v[8 * j + 3] * rstd * g0.w};
            f32x4 r1 = {v[8 * j + 4] * rstd * g1.x, v[8 * j + 5] * rstd * g1.y, v[8 * j + 6] * rstd * g1.z, v[8 * j + 7] * rstd * g1.w};
            *(f32x4*)(op + o) = r0; *(f32x4*)(op + o + 4) = r1; }
    }
}

struct Args { const float* in[22]; float* out; unsigned char* ws; int ph_lo, ph_hi; };
__global__ void __launch_bounds__(NWAVES * 64, 2) fwd(Args args) {
    extern __shared__ __attribute__((aligned(16))) unsigned char lds_raw[];
    LAS unsigned char* lds = (LAS unsigned char*)lds_raw;
    volatile LAS unsigned* MISC = (volatile LAS unsigned*)(lds + MISC_OFF);
    const int tid = threadIdx.x, lane = tid & 63, wave = __builtin_amdgcn_readfirstlane(tid >> 6), G = gridDim.x;
    const int gw = blockIdx.x * NWAVES + wave, NGW = G * NWAVES;
    Ptrs P;
    P.x = args.in[0]; P.g1 = args.in[1]; P.w_in = args.in[2]; P.lq1 = args.in[3]; P.lk1 = args.in[4]; P.lq2 = args.in[5]; P.lk2 = args.in[6]; P.subg = args.in[7];
    P.cw = args.in[8]; P.cb = args.in[9]; P.lng = args.in[10]; P.lnb = args.in[11]; P.w_out = args.in[12]; P.g2 = args.in[13]; P.wgr = args.in[14]; P.bgr = args.in[15];
    P.wer = args.in[16]; P.ber = args.in[17]; P.w_gate = args.in[18]; P.w_up = args.in[19]; P.w_down = args.in[20]; P.gf = args.in[21]; P.out = args.out; P.ws = args.ws;
    unsigned char* ws = args.ws;
    bf16* WIN = (bf16*)(ws + WS_WIN); bf16* WOUT = (bf16*)(ws + WS_WOUT); bf16* WGU = (bf16*)(ws + WS_WGU); bf16* WD = (bf16*)(ws + WS_WD);
    bf16* XB = (bf16*)(ws + WS_XB); bf16* H1 = (bf16*)(ws + WS_XB); bf16* CGB = (bf16*)(ws + WS_CG); bf16* MIX = (bf16*)(ws + WS_MIX); bf16* HB = (bf16*)(ws + WS_HB);
    bf16* QB = (bf16*)args.out; bf16* KB = QB + (size_t)T * 1024; bf16* VB = KB + (size_t)T * 1024; bf16* CAB = VB + (size_t)T * 1024; bf16* YB = (bf16*)args.out;
    for (int u = tid; u < (LDS_BYTES - LDSCTL_OFF) / 4; u += NWAVES * 64) ((LAS unsigned*)(lds + LDSCTL_OFF))[u] = 0u;
    __syncthreads();
    const int lo = args.ph_lo, hi = args.ph_hi;
    XcdBarrier bar; bar.bar = (unsigned*)(ws + WS_CTL) + CW_BAR; bar.x = 0; bar.st = nullptr;
    if (hi - lo > 1) bar = xcd_barrier_post((unsigned*)(ws + WS_CTL) + CW_BAR, MISC + 8);
#define IN(k) (lo <= (k) && (k) < hi)
#define SEAM(k) do { if (IN(k) && IN((k) + 1)) xcd_barrier(bar); } while (0)

    if (IN(0)) { p0_prologue(P, lds, lane, wave, gw, NGW); }
    SEAM(0);
    if (IN(1)) {
        pg8::Gemm g{XB, WIN, T, NIN, D}; pg8::StaticOrder S; S.init(T, NIN, G, (int)blockIdx.x);
        pg8::EpiIn E{QB, (size_t)T * 1024, CGB, (const float*)(ws + WS_RSTD1), C2};
        pg8::gemm_phase<pg8::EpiIn, pg8::StaticOrder, true, false>(lds + RING_OFF, g, S, E);
    }
    SEAM(1);
    if (IN(2)) {
        naive_attn(P, QB, KB, VB, MIX, lane, gw, NGW);
        conv_phase(P, CAB, CGB, MIX, lds, tid, lane, wave, (int)blockIdx.x, G);
    }
    SEAM(2);
    if (IN(3)) {
        pg8::Gemm g{MIX, WOUT, T, D, D}; pg8::StaticOrder S; S.init(T, D, G, (int)blockIdx.x);
        pg8::EpiOut E{HB, XB, (float*)(ws + WS_PART)};
        pg8::gemm_phase<pg8::EpiOut, pg8::StaticOrder, true, false>(lds + RING_OFF, g, S, E);
    }
    SEAM(3);
    if (IN(4)) { router_phase(P, HB, lane, gw, NGW); }
    SEAM(4);
    if (IN(5)) {
        moe_tables(P, lds, tid);
        pg8::Gemm g{HB, WGU, 0, 2048, D};
        pg8::MoeOrder S{(const LAS int*)(lds + TAB_OFF) + 32, (const LAS int*)(lds + TAB_OFF), (const int*)(ws + WS_LIST), G, (int)blockIdx.x, 1, T, (size_t)2048 * 2048 * 2};
        pg8::EpiGU E{H1, (const int*)(ws + WS_LIST), (const float*)(ws + WS_RSTD2)};
        pg8::gemm_phase<pg8::EpiGU, pg8::MoeOrder, true, true>(lds + RING_OFF, g, S, E);
    }
    SEAM(5);
    if (IN(6)) {
        moe_tables(P, lds, tid);
        pg8::Gemm g{H1, WD, 0, 2048, 1024};
        pg8::MoeOrder S{(const LAS int*)(lds + TAB_OFF) + 32, (const LAS int*)(lds + TAB_OFF), (const int*)(ws + WS_LIST), G, (int)blockIdx.x, 0, T, (size_t)2048 * 1024 * 2};
        pg8::EpiDown E{YB, (const int*)(ws + WS_LIST), (const float*)(ws + WS_WTS)};
        pg8::gemm_phase<pg8::EpiDown, pg8::MoeOrder, true, true>(lds + RING_OFF, g, S, E);
    }
    SEAM(6);
    if (IN(7)) { final_phase(P, HB, lane, gw, NGW); }
#undef IN
#undef SEAM
}

extern "C" void kernel_launch(void* const* d_in, const int* in_sizes, int n_in, void* d_out, int out_size, void* d_ws, size_t ws_size, hipStream_t stream) {
    static int grid = 0;
    if (grid == 0) {
        if (n_in != 22 || in_sizes[0] != T * D || out_size != T * D || ws_size < WS_END) { fprintf(stderr, "kernel_launch: unexpected shapes (n_in %d, in0 %d, out %d, ws %zu); nothing launched\n", n_in, n_in > 0 ? in_sizes[0] : -1, out_size, ws_size); grid = -1; return; }
        int dev = 0, cus = 0, per_cu = 0;
        if (hipGetDevice(&dev) != hipSuccess || hipDeviceGetAttribute(&cus, hipDeviceAttributeMultiprocessorCount, dev) != hipSuccess) { grid = -1; return; }
        if (hipFuncSetAttribute((const void*)fwd, hipFuncAttributeMaxDynamicSharedMemorySize, LDS_BYTES) != hipSuccess) { fprintf(stderr, "kernel_launch: hipFuncSetAttribute failed\n"); grid = -1; return; }
        if (hipOccupancyMaxActiveBlocksPerMultiprocessor(&per_cu, (const void*)fwd, NWAVES * 64, LDS_BYTES) != hipSuccess || per_cu < 1) fprintf(stderr, "kernel_launch: occupancy query reports %d\n", per_cu);
        (void)hipGetLastError();
        grid = cus;
    }
    if (grid < 0) return;
    if (hipMemsetAsync((char*)d_ws + WS_CTL, 0, CTL_ZERO_BYTES, stream) != hipSuccess) return;
    Args a{};
    for (int i = 0; i < 22; ++i) a.in[i] = (const float*)d_in[i];
    a.out = (float*)d_out; a.ws = (unsigned char*)d_ws;
#if MK_ONE_LAUNCH
    a.ph_lo = 0; a.ph_hi = NPHASE;
    hipLaunchKernelGGL(fwd, dim3(grid), dim3(NWAVES * 64), LDS_BYTES, stream, a);
#else
    for (int p = 0; p < NPHASE; ++p) { a.ph_lo = p; a.ph_hi = p + 1; hipLaunchKernelGGL(fwd, dim3(grid), dim3(NWAVES * 64), LDS_BYTES, stream, a); }
#endif
}
```

```cpp
#include <hip/hip_runtime.h>
#include <cstdio>
#include <cstdint>
#ifndef PROBE_KLOOP
#define PROBE_KLOOP 0
#endif
#ifndef PROBE_WHAT
#define PROBE_WHAT 0
#endif
#ifndef PROBE_PHASE
#define PROBE_PHASE -1
#endif
#ifndef PROBE_ATT
#define PROBE_ATT 0
#endif
#ifndef PROBE_BLK
#define PROBE_BLK 0
#endif
namespace pg8 {
#define PG8_LAS __attribute__((address_space(3)))
typedef unsigned short bf16_t;
typedef short bf16x8 __attribute__((ext_vector_type(8)));
typedef float f32x4 __attribute__((ext_vector_type(4)));
typedef unsigned u32x4 __attribute__((ext_vector_type(4)));
constexpr int BM = 256, BK = 64, HALF = 128, HTB = HALF * BK * 2  , STAGE_BYTES = 8 * HTB, NXCD = 8, WGM = 8;

__host__ __device__ __forceinline__ int lds_byte(int r, int c) { const int st = (r >> 4) * 2 + (c >> 5), rr = r & 15, cc = c & 31, ob = rr * 64 + cc * 2; return st * 1024 + (ob ^ (((ob >> 9) & 1) << 5)); }
__host__ __device__ __forceinline__ void stage_rc(int b, int& R, int& C) { const int st = b / 1024, sb = b % 1024, swz = sb ^ (((sb >> 9) & 1) << 5); R = (st >> 1) * 16 + swz / 64; C = (st & 1) * 32 + (swz % 64) / 2; }
__host__ __device__ __forceinline__ int perm32(int rho) { const int n = rho >> 4, i = rho & 15; return 8 * (i >> 2) + 4 * n + (i & 3); }

struct Unit { int pm, pn, e, nvalid, lbase, srow, ord; };
struct Gemm { const bf16_t* A; const bf16_t* Bt; int M, N, K; unsigned* probe = nullptr; };

struct StaticOrder {
    int nM, nN, nwg, G, c, rep = 1;
    __host__ __device__ void init(int M, int N, int G_, int c_) { nM = M / BM; nN = N / BM; nwg = nM * nN; G = G_; c = c_; }
    __host__ __device__ bool next(int i, Unit& u) const {
        long L = (long)i * G + c; if (L >= (long)nwg * rep) return false; L %= nwg;
        int wgid = (int)L; { const int q = nwg / NXCD, r = nwg % NXCD, xcd = wgid % NXCD, off = wgid / NXCD; wgid = (xcd < r ? xcd * (q + 1) : r * (q + 1) + (xcd - r) * q) + off; }
        const int nig = WGM * nN, gid = wgid / nig, fm = gid * WGM, gsz = (nM - fm) < WGM ? (nM - fm) : WGM;
        u.pm = fm + ((wgid % nig) % gsz); u.pn = (wgid % nig) / gsz; return true;
    }
    __device__ __forceinline__ const char* bbase(const Gemm& g, const Unit& u, size_t tstep) const { return (const char*)g.Bt + (size_t)u.pn * tstep; }
    __device__ __forceinline__ unsigned goff(const Unit&, int, int, int) const { return 0u; }
    __device__ __forceinline__ void a_ready(const Unit&) const {}
    __device__ __forceinline__ void done(const Unit&) const {}
};

struct StaticOrderG : StaticOrder {
    __device__ __forceinline__ unsigned goff(const Unit& u, int r, int C, int K) const { return ((unsigned)(u.pm * BM + r) * (unsigned)K + (unsigned)C) * 2u; }
};

struct MoeOrder {
    const PG8_LAS int* tstart; const PG8_LAS int* cnt; const int* list; int G, c, shift, lcap; size_t estride; int sorted; const PG8_LAS unsigned short* ids;
    __device__ __forceinline__ bool next(int i, Unit& u) const {
        const int ntiles = tstart[32]; const int x = c & 7, k = i * (G >> 3) + (c >> 3); const int rt = 2 * (k >> 1) + (x & 1); if (rt >= ntiles) return false;
        int e = 0;
#pragma unroll
        for (int q = 1; q < 32; ++q) e += (tstart[q] <= rt) ? 1 : 0;
        e = __builtin_amdgcn_readfirstlane(e);
        const int pm = __builtin_amdgcn_readfirstlane(rt - tstart[e]); const int rem = __builtin_amdgcn_readfirstlane(cnt[e]) - 256 * pm;
        u.pm = pm; u.pn = 2 * (x >> 1) + (k & 1); u.e = e; u.nvalid = rem < 256 ? rem : 256; u.lbase = e * lcap + 256 * pm; u.srow = 256 * rt; u.ord = i; return true;
    }
    __device__ __forceinline__ const char* bbase(const Gemm& g, const Unit& u, size_t tstep) const { return (const char*)g.Bt + (size_t)u.e * estride + (size_t)u.pn * tstep; }
    __device__ __forceinline__ unsigned goff(const Unit& u, int r, int C, int K) const {
        if (sorted) return ((unsigned)(u.srow + r) * (unsigned)K + (unsigned)C) * 2u;
        const int a = ids[u.ord * 256 + (r < u.nvalid ? r : 0)];
        return ((unsigned)(a >> shift) * (unsigned)K + (unsigned)C) * 2u;
    }
    __device__ __forceinline__ void a_ready(const Unit&) const {}
    __device__ __forceinline__ void done(const Unit&) const {}
};

struct DynQ {
    unsigned* ctr; volatile PG8_LAS int* slot; int x0, qi; unsigned pend;
    __device__ __forceinline__ void qinit(unsigned* ctr_, volatile PG8_LAS int* slot_, int bx) { ctr = ctr_; slot = slot_; x0 = bx & 7; qi = 0; pend = 0u;
        if (threadIdx.x == 0) pend = __hip_atomic_fetch_add(ctr + 64 * x0, 1u, __ATOMIC_RELAXED, __HIP_MEMORY_SCOPE_AGENT); }
    template <class SizeF> __device__ __forceinline__ int qnext(int i, const SizeF& size_of) {
        const int par = i & 1;
        if (threadIdx.x == 0) { int res = -1;
            while (qi < 8) { const int x = (x0 + qi) & 7; if (pend < (unsigned)size_of(x)) { res = (x << 24) | (int)pend; break; }
                ++qi; if (qi < 8) pend = __hip_atomic_fetch_add(ctr + 64 * ((x0 + qi) & 7), 1u, __ATOMIC_RELAXED, __HIP_MEMORY_SCOPE_AGENT); }
            slot[par] = res;
            if (res >= 0) pend = __hip_atomic_fetch_add(ctr + 64 * ((x0 + qi) & 7), 1u, __ATOMIC_RELAXED, __HIP_MEMORY_SCOPE_AGENT); }
        asm volatile("s_waitcnt lgkmcnt(0)" ::: "memory"); __builtin_amdgcn_s_barrier(); asm volatile("" ::: "memory");
        return __builtin_amdgcn_readfirstlane(slot[par]);
    }
};
struct DynDense : DynQ {
    int nM, nN, nwg;
    __device__ __forceinline__ void init(int M, int N, unsigned* ctr_, volatile PG8_LAS int* slot_, int bx) { nM = M / BM; nN = N / BM; nwg = nM * nN; qinit(ctr_, slot_, bx); }
    __device__ __forceinline__ bool next(int i, Unit& u) {
        const int q = nwg / NXCD, r = nwg % NXCD;
        const int code = qnext(i, [=](int x) { return q + (x < r ? 1 : 0); }); if (code < 0) return false;
        const int x = code >> 24, k = code & 0xffffff; const int wgid = (x < r ? x * (q + 1) : r * (q + 1) + (x - r) * q) + k;
        const int nig = WGM * nN, gid = wgid / nig, fm = gid * WGM, gsz = (nM - fm) < WGM ? (nM - fm) : WGM;
        u.pm = fm + ((wgid % nig) % gsz); u.pn = (wgid % nig) / gsz; return true;
    }
    __device__ __forceinline__ const char* bbase(const Gemm& g, const Unit& u, size_t tstep) const { return (const char*)g.Bt + (size_t)u.pn * tstep; }
    __device__ __forceinline__ unsigned goff(const Unit&, int, int, int) const { return 0u; }
    __device__ __forceinline__ void a_ready(const Unit&) const {}
    __device__ __forceinline__ void done(const Unit&) const {}
};
struct DynDenseG : DynDense {
    __device__ __forceinline__ unsigned goff(const Unit& u, int r, int C, int K) const { return ((unsigned)(u.pm * BM + r) * (unsigned)K + (unsigned)C) * 2u; }
};

__device__ __forceinline__ unsigned cvt_pk_bf16(float lo, float hi) { unsigned r; asm volatile("v_cvt_pk_bf16_f32 %0, %1, %2" : "=v"(r) : "v"(lo), "v"(hi)); return r; }
__device__ __forceinline__ float bf_lo(unsigned w) { return __builtin_bit_cast(float, w << 16); }
__device__ __forceinline__ float bf_hi(unsigned w) { return __builtin_bit_cast(float, w & 0xffff0000u); }
__device__ __forceinline__ unsigned pk4_fp8(float a, float b, float c, float d) {
    a = __builtin_amdgcn_fmed3f(a, -440.f, 440.f); b = __builtin_amdgcn_fmed3f(b, -440.f, 440.f); c = __builtin_amdgcn_fmed3f(c, -440.f, 440.f); d = __builtin_amdgcn_fmed3f(d, -440.f, 440.f);
    int r = __builtin_amdgcn_cvt_pk_fp8_f32(a, b, 0, false); r = __builtin_amdgcn_cvt_pk_fp8_f32(c, d, r, true); return (unsigned)r; }
typedef unsigned u32x2 __attribute__((ext_vector_type(2)));
__device__ __forceinline__ void swap16(u32x2& a, u32x2& b) { auto r0 = __builtin_amdgcn_permlane16_swap(a.x, b.x, false, false); auto r1 = __builtin_amdgcn_permlane16_swap(a.y, b.y, false, false); a = (u32x2){r0[0], r1[0]}; b = (u32x2){r0[1], r1[1]}; }
typedef int v4i_t __attribute__((ext_vector_type(4)));

struct EpiIn {
    static constexpr bool PERM = true, AFTER_DRAIN = false;
    bf16_t* P0; size_t stride; bf16_t* CG; const float* rstd; float scale0; unsigned* nmax; int tbase; float oscale;
    __device__ __forceinline__ void operator()(const f32x4 (&acc)[2][2][4][2], const Unit& u, int wr, int wc, int fr, int fq) const {
        const int row0 = u.pm * BM + wr * 64 + fr, t = (u.pn >> 2) + tbase; bf16_t* base = (t < 4) ? P0 + (size_t)t * stride : CG;
        const float sc = ((t == 0) ? scale0 : 1.f) * oscale; const int col0 = (u.pn & 3) * BM + wc * 32 + 8 * fq;
        float mx[2] = {0.f, 0.f}; float rsv[2][4];
#pragma unroll
        for (int ai = 0; ai < 2; ++ai)
#pragma unroll
            for (int m = 0; m < 4; ++m) rsv[ai][m] = rstd[row0 + ai * HALF + m * 16];
#pragma unroll
        for (int ai = 0; ai < 2; ++ai)
#pragma unroll
            for (int m = 0; m < 4; ++m) { const int row = row0 + ai * HALF + m * 16; const float rs = rsv[ai][m] * sc; bf16_t* rowp = base + (size_t)row * 1024 + col0;
#pragma unroll
                for (int bj = 0; bj < 2; ++bj) { const f32x4 v0 = acc[ai][bj][m][0] * rs, v1 = acc[ai][bj][m][1] * rs;
                    u32x4 w; w.x = cvt_pk_bf16(v0[0], v0[1]); w.y = cvt_pk_bf16(v0[2], v0[3]); w.z = cvt_pk_bf16(v1[0], v1[1]); w.w = cvt_pk_bf16(v1[2], v1[3]);
                    *(u32x4*)(rowp + bj * HALF) = w;
                    if (t < 2) { float ss = (v0[0] * v0[0] + v0[1] * v0[1]) + (v0[2] * v0[2] + v0[3] * v0[3]) + (v1[0] * v1[0] + v1[1] * v1[1]) + (v1[2] * v1[2] + v1[3] * v1[3]);
                        ss += __shfl_xor(ss, 16); ss += __shfl_xor(ss, 32); mx[bj] = __builtin_fmaxf(mx[bj], ss); } } }
        if (t < 2) {
#pragma unroll
            for (int bj = 0; bj < 2; ++bj) { float v = mx[bj];
                v = __builtin_fmaxf(v, __shfl_xor(v, 1)); v = __builtin_fmaxf(v, __shfl_xor(v, 2)); v = __builtin_fmaxf(v, __shfl_xor(v, 4)); v = __builtin_fmaxf(v, __shfl_xor(v, 8));
                const int colb = (u.pn & 3) * BM + bj * HALF + wc * 32, g64 = colb >> 6, bh = (u.pm >> 4) * 8 + (g64 >> 1);
                if (fr == 0 && fq == 0) atomicMax(nmax + ((t * 64 + bh) * 2 + (g64 & 1)) * 2 + (wc & 1), __builtin_bit_cast(unsigned, v)); }
        }
    }
};
struct EpiGLU {
    static constexpr bool PERM = true, AFTER_DRAIN = false;
    bf16_t* U; const float* rstd; float oscale;
    __device__ __forceinline__ void operator()(const f32x4 (&acc)[2][2][4][2], const Unit& u, int wr, int wc, int fr, int fq) const {
        const int row0 = u.pm * BM + wr * 64 + fr, col0 = u.pn * HALF + wc * 32 + 8 * fq; float rsv[2][4];
#pragma unroll
        for (int ai = 0; ai < 2; ++ai)
#pragma unroll
            for (int m = 0; m < 4; ++m) rsv[ai][m] = rstd[row0 + ai * HALF + m * 16];
#pragma unroll
        for (int ai = 0; ai < 2; ++ai)
#pragma unroll
            for (int m = 0; m < 4; ++m) { const int row = row0 + ai * HALF + m * 16; const float rs = rsv[ai][m] * oscale;
                const f32x4 a0 = acc[ai][0][m][0] * rs, a1 = acc[ai][0][m][1] * rs, g0 = acc[ai][1][m][0] * rs, g1 = acc[ai][1][m][1] * rs;
#define PG8_SG(x) __builtin_amdgcn_rcpf(1.f + __builtin_amdgcn_exp2f(-1.4426950408889634f * (x)))
                u32x4 w; w.x = cvt_pk_bf16(a0[0] * PG8_SG(g0[0]), a0[1] * PG8_SG(g0[1])); w.y = cvt_pk_bf16(a0[2] * PG8_SG(g0[2]), a0[3] * PG8_SG(g0[3]));
                w.z = cvt_pk_bf16(a1[0] * PG8_SG(g1[0]), a1[1] * PG8_SG(g1[1])); w.w = cvt_pk_bf16(a1[2] * PG8_SG(g1[2]), a1[3] * PG8_SG(g1[3]));
#undef PG8_SG
                *(u32x4*)(U + (size_t)row * 1024 + col0) = w; }
    }
};
struct EpiOut {
    static constexpr bool PERM = true, AFTER_DRAIN = false;
    bf16_t* H; const bf16_t* XB; float* part; unsigned char* H8;
    __device__ __forceinline__ void operator()(const f32x4 (&acc)[2][2][4][2], const Unit& u, int wr, int wc, int fr, int fq) const {
        const int row0 = u.pm * BM + wr * 64 + fr, col0 = u.pn * BM + wc * 32 + 8 * fq;
        u32x4 xball[2][4][2];
#pragma unroll
        for (int ai = 0; ai < 2; ++ai)
#pragma unroll
            for (int m = 0; m < 4; ++m)
#pragma unroll
                for (int bj = 0; bj < 2; ++bj) xball[ai][m][bj] = *(const u32x4*)(XB + (size_t)(row0 + ai * HALF + m * 16) * 2048 + col0 + bj * HALF);
#pragma unroll
        for (int ai = 0; ai < 2; ++ai) {
#pragma unroll
            for (int m = 0; m < 4; ++m) { const int row = row0 + ai * HALF + m * 16; const size_t off = (size_t)row * 2048 + col0; float ss = 0.f;
#pragma unroll
                for (int bj = 0; bj < 2; ++bj) { const u32x4 xb = xball[ai][m][bj];
                    f32x4 v0 = acc[ai][bj][m][0], v1 = acc[ai][bj][m][1];
                    v0[0] += bf_lo(xb.x); v0[1] += bf_hi(xb.x); v0[2] += bf_lo(xb.y); v0[3] += bf_hi(xb.y); v1[0] += bf_lo(xb.z); v1[1] += bf_hi(xb.z); v1[2] += bf_lo(xb.w); v1[3] += bf_hi(xb.w);
                    ss += (v0[0] * v0[0] + v0[1] * v0[1]) + (v0[2] * v0[2] + v0[3] * v0[3]) + (v1[0] * v1[0] + v1[1] * v1[1]) + (v1[2] * v1[2] + v1[3] * v1[3]);
                    u32x4 w; w.x = cvt_pk_bf16(v0[0], v0[1]); w.y = cvt_pk_bf16(v0[2], v0[3]); w.z = cvt_pk_bf16(v1[0], v1[1]); w.w = cvt_pk_bf16(v1[2], v1[3]);
                    *(u32x4*)(H + off + bj * HALF) = w;
                    if (H8) { u32x2 w8; w8.x = pk4_fp8(v0[0], v0[1], v0[2], v0[3]); w8.y = pk4_fp8(v1[0], v1[1], v1[2], v1[3]); *(u32x2*)(H8 + off + bj * HALF) = w8; } }
                ss += __shfl_xor(ss, 16); ss += __shfl_xor(ss, 32);
                if (fq == 0) part[(size_t)row * 32 + u.pn * 4 + wc] = ss; } }
    }
};
__device__ __forceinline__ float silu_f(float x) { return x * __builtin_amdgcn_rcpf(1.f + __builtin_amdgcn_exp2f(-1.4426950408889634f * x)); }
struct EpiGU {
    static constexpr bool PERM = true, AFTER_DRAIN = false;
    unsigned char* H1; const PG8_LAS float* rsl; float wscale, oscale;
    __device__ __forceinline__ void operator()(const f32x4 (&acc)[2][2][4][2], const Unit& u, int wr, int wc, int fr, int fq) const {
        const int col0 = u.pn * HALF + wc * 32 + 8 * fq;
        float rsv[2][4]; int fro = fr; asm volatile("" : "+v"(fro));
#pragma unroll
        for (int ai = 0; ai < 2; ++ai)
#pragma unroll
            for (int m = 0; m < 4; ++m) { const int r = ai * HALF + wr * 64 + m * 16 + fro; rsv[ai][m] = rsl[u.ord * 256 + (r < u.nvalid ? r : 0)]; }
#pragma unroll
        for (int ai = 0; ai < 2; ++ai)
#pragma unroll
            for (int mp = 0; mp < 4; mp += 2) { u32x2 wv[2];
#pragma unroll
                for (int q = 0; q < 2; ++q) { const int m = mp + q; const float rs = rsv[ai][m] * wscale;
                    const f32x4 g0 = acc[ai][0][m][0] * rs, g1 = acc[ai][0][m][1] * rs, u0 = acc[ai][1][m][0] * (rs * oscale), u1 = acc[ai][1][m][1] * (rs * oscale);
                    wv[q].x = pk4_fp8(silu_f(g0[0]) * u0[0], silu_f(g0[1]) * u0[1], silu_f(g0[2]) * u0[2], silu_f(g0[3]) * u0[3]);
                    wv[q].y = pk4_fp8(silu_f(g1[0]) * u1[0], silu_f(g1[1]) * u1[1], silu_f(g1[2]) * u1[2], silu_f(g1[3]) * u1[3]); }
                swap16(wv[0], wv[1]);
                const int odd = fq & 1, r = ai * HALF + wr * 64 + (mp + odd) * 16 + fr;
                if (r < u.nvalid) { const u32x4 w = {wv[0].x, wv[0].y, wv[1].x, wv[1].y};
                    *(u32x4*)(H1 + (size_t)(u.srow + r) * 1024 + col0 - 8 * odd) = w; } }
    }
};
struct EpiDown {
    static constexpr bool PERM = true, AFTER_DRAIN = false;
    unsigned char* Y; const PG8_LAS unsigned short* ids; const PG8_LAS float* wl; float oscale;
    __device__ __forceinline__ void operator()(const f32x4 (&acc)[2][2][4][2], const Unit& u, int wr, int wc, int fr, int fq) const {
        const int col0 = u.pn * BM + wc * 32 + 8 * fq;
        int av[2][4]; float wv[2][4]; int fro = fr; asm volatile("" : "+v"(fro));
#pragma unroll
        for (int ai = 0; ai < 2; ++ai)
#pragma unroll
            for (int m = 0; m < 4; ++m) { const int r = ai * HALF + wr * 64 + m * 16 + fro, ix = u.ord * 256 + (r < u.nvalid ? r : 0); av[ai][m] = ids[ix]; wv[ai][m] = wl[ix]; }
#pragma unroll
        for (int ai = 0; ai < 2; ++ai)
#pragma unroll
            for (int m = 0; m < 4; ++m) { const int r = ai * HALF + wr * 64 + m * 16 + fr; const int a = av[ai][m]; const float ws = wv[ai][m] * oscale;
                u32x2 w0, w1;
                { const f32x4 v0 = acc[ai][0][m][0] * ws, v1 = acc[ai][0][m][1] * ws; w0.x = pk4_fp8(v0[0], v0[1], v0[2], v0[3]); w0.y = pk4_fp8(v1[0], v1[1], v1[2], v1[3]); }
                { const f32x4 v0 = acc[ai][1][m][0] * ws, v1 = acc[ai][1][m][1] * ws; w1.x = pk4_fp8(v0[0], v0[1], v0[2], v0[3]); w1.y = pk4_fp8(v1[0], v1[1], v1[2], v1[3]); }
                swap16(w0, w1);
                if (r < u.nvalid) { const int odd = fq & 1; const u32x4 w = {w0.x, w0.y, w1.x, w1.y};
                    *(u32x4*)(Y + (size_t)a * 2048 + col0 + (odd ? HALF - 8 : 0)) = w; } }
    }
};
struct EpiRouter {
    static constexpr bool PERM = true, AFTER_DRAIN = false;
    const float* part; const float* ber; const float* bgr; float* listr; float* listw; int* list; unsigned* cnt; int lcap;
    __device__ __forceinline__ void operator()(const f32x4 (&acc)[2][2][4][2], const Unit& u, int wr, int wc, int fr, int fq) const {
        if (wc != 0) return;
#pragma unroll
        for (int ai = 0; ai < 2; ++ai)
#pragma unroll
            for (int m = 0; m < 4; ++m) { const int row = u.pm * BM + ai * HALF + wr * 64 + m * 16 + fr;
                const f32x4 p0 = *(const f32x4*)(part + (size_t)row * 32 + 8 * fq), p1 = *(const f32x4*)(part + (size_t)row * 32 + 8 * fq + 4);
                float ss = ((p0[0] + p0[1]) + (p0[2] + p0[3])) + ((p1[0] + p1[1]) + (p1[2] + p1[3]));
                ss += __shfl_xor(ss, 16); ss += __shfl_xor(ss, 32);
                const float rstd = 1.0f / sqrtf(ss * (1.0f / 2048.0f) + 1e-6f);
                const f32x4 gl = acc[ai][1][m][0]; float g[4];
#pragma unroll
                for (int i = 0; i < 4; ++i) g[i] = __shfl(gl[i], fr) * rstd + bgr[i];
                int gs = 0; float gm = g[0];
#pragma unroll
                for (int i = 1; i < 4; ++i) if (g[i] > gm) { gm = g[i]; gs = i; }
                float gsum = 0.f;
#pragma unroll
                for (int i = 0; i < 4; ++i) gsum += __expf(g[i] - gm);
                const float gw = 1.0f / gsum;
                if (fq == gs) { float ev[8];
#pragma unroll
                    for (int i = 0; i < 4; ++i) { ev[i] = acc[ai][0][m][0][i] * rstd + ber[8 * fq + i]; ev[4 + i] = acc[ai][0][m][1][i] * rstd + ber[8 * fq + 4 + i]; }
                    int i1 = 0; float v1 = ev[0];
#pragma unroll
                    for (int i = 1; i < 8; ++i) if (ev[i] > v1) { v1 = ev[i]; i1 = i; }
                    int i2 = -1; float v2 = -3.0e38f;
#pragma unroll
                    for (int i = 0; i < 8; ++i) if (i != i1 && ev[i] > v2) { v2 = ev[i]; i2 = i; }
                    const float e2 = __expf(v2 - v1), w1 = gw / (1.f + e2), w2 = gw * e2 / (1.f + e2);
                    const int ea = gs * 8 + i1, eb = gs * 8 + i2;
                    const unsigned ra = __hip_atomic_fetch_add(cnt + 64 * ea, 1u, __ATOMIC_RELAXED, __HIP_MEMORY_SCOPE_AGENT);
                    const unsigned rb = __hip_atomic_fetch_add(cnt + 64 * eb, 1u, __ATOMIC_RELAXED, __HIP_MEMORY_SCOPE_AGENT);
                    const size_t ia = (size_t)ea * lcap + ra, ib = (size_t)eb * lcap + rb;
                    list[ia] = 2 * row; list[ib] = 2 * row + 1; listw[ia] = w1; listw[ib] = w2; listr[ia] = rstd; listr[ib] = rstd; } }
    }
};

template <class Epi, class Sched, bool ALIGN_EPI, bool GATHER, bool FP8 = false>
__device__ __forceinline__ void gemm_phase(PG8_LAS unsigned char* lds, const Gemm g, Sched& S, const Epi& E) {
    int tid_ = threadIdx.x; asm volatile("" : "+v"(tid_));
    const int tid = tid_, wid = __builtin_amdgcn_readfirstlane(tid >> 6), lane = tid & 63, wr = wid >> 2, wc = wid & 3, fr = lane & 15, fq = lane >> 4;
    const int K = g.K, nt = K / BK;
    unsigned voffA[2], voffB[2]; int RA[2], CA[2];
#pragma unroll
    for (int i = 0; i < 2; ++i) { int R, C; stage_rc(tid * 16 + i * 8192, R, C); const int Rb = Epi::PERM ? ((R & ~31) + perm32(R & 31)) : R;
        voffA[i] = (unsigned)(R * K + C) * 2u; voffB[i] = (unsigned)(Rb * K + C) * 2u; RA[i] = R; CA[i] = C; }
    const size_t kstep = (size_t)(BK * 2);
    const size_t hstep = (size_t)HALF * K * 2;
    const size_t tstep = 2 * hstep;
    const unsigned ldsw = (unsigned)wid * 1024u;
    const int aoff = lds_byte(wr * 64 + fr, fq * 8), boff = lds_byte(wc * 32 + fr, fq * 8);
#define PG8_SA(b, h) (((b) * 2 + (h)) * HTB)
#define PG8_SB(b, h) ((4 + (b) * 2 + (h)) * HTB)
#define PG8_STAGE(bufoff, gbase, voff) do { _Pragma("unroll") for (int _i = 0; _i < 2; ++_i) \
        __builtin_amdgcn_global_load_lds((const unsigned*)((const char*)(gbase) + (voff)[_i]), (PG8_LAS unsigned*)(lds + (bufoff) + ldsw + _i * 8192), 16, 0, 0); } while (0)
#define PG8_STAGE_A(bufoff, kp, h) do { if constexpr (GATHER) { PG8_STAGE(bufoff, kp, cgo[h]); } else { PG8_STAGE(bufoff, (kp) + (h) * hstep, voffA); } } while (0)
#define PG8_LDA(dst, b, h) do { _Pragma("unroll") for (int m = 0; m < 4; ++m) _Pragma("unroll") for (int k = 0; k < 2; ++k) dst[m][k] = *(const PG8_LAS bf16x8*)(lds + PG8_SA(b, h) + aoff + m * 2048 + k * 1024); } while (0)
#define PG8_LDB(dst, b, h) do { _Pragma("unroll") for (int n = 0; n < 2; ++n) _Pragma("unroll") for (int k = 0; k < 2; ++k) dst[n][k] = *(const PG8_LAS bf16x8*)(lds + PG8_SB(b, h) + boff + n * 2048 + k * 1024); } while (0)
#define PG8_CAT(x, y) __builtin_shufflevector(__builtin_bit_cast(v4i_t, x), __builtin_bit_cast(v4i_t, y), 0, 1, 2, 3, 4, 5, 6, 7)
#define PG8_MMA(ai, bj, At, Bt) do { __builtin_amdgcn_s_setprio(1); \
        if constexpr (FP8) { _Pragma("unroll") for (int m = 0; m < 4; ++m) _Pragma("unroll") for (int n = 0; n < 2; ++n) \
            acc[ai][bj][m][n] = __builtin_amdgcn_mfma_scale_f32_16x16x128_f8f6f4(PG8_CAT(Bt[n][0], Bt[n][1]), PG8_CAT(At[m][0], At[m][1]), acc[ai][bj][m][n], 0, 0, 0, 0, 0, 0); } \
        else { _Pragma("unroll") for (int m = 0; m < 4; ++m) _Pragma("unroll") for (int n = 0; n < 2; ++n) _Pragma("unroll") for (int k = 0; k < 2; ++k) \
            acc[ai][bj][m][n] = __builtin_amdgcn_mfma_f32_16x16x32_bf16(Bt[n][k], At[m][k], acc[ai][bj][m][n], 0, 0, 0); } \
        __builtin_amdgcn_s_setprio(0); } while (0)
#define PG8_WAIT_V(n) asm volatile("s_waitcnt vmcnt(" #n ")" ::: "memory")
#define PG8_WAIT_L(n) asm volatile("s_waitcnt lgkmcnt(" #n ")" ::: "memory")
#define PG8_BAR __builtin_amdgcn_s_barrier()
#define PG8_SCHED __builtin_amdgcn_sched_barrier(0)
    Unit cur, nxt; int ui = 0;
#if PROBE_KLOOP
    unsigned pk_acc_ = 0u;
#endif
    if (!S.next(0, cur)) return;
    f32x4 acc[2][2][4][2];
#pragma unroll
    for (int a = 0; a < 2; ++a)
#pragma unroll
        for (int b = 0; b < 2; ++b)
#pragma unroll
            for (int m = 0; m < 4; ++m)
#pragma unroll
                for (int n = 0; n < 2; ++n) acc[a][b][m][n] = (f32x4){0.f, 0.f, 0.f, 0.f};
    bf16x8 At[4][2], B0[2][2], B1[2][2];
    unsigned cgo[2][2] = {{0u, 0u}, {0u, 0u}}, ngo[2][2] = {{0u, 0u}, {0u, 0u}};
    if constexpr (GATHER) {
#pragma unroll
        for (int h = 0; h < 2; ++h)
#pragma unroll
            for (int i = 0; i < 2; ++i) cgo[h][i] = S.goff(cur, h * HALF + RA[i], CA[i], K);
    }
    const char* cA = GATHER ? (const char*)g.A : (const char*)g.A + (size_t)cur.pm * tstep; const char* cB = S.bbase(g, cur, tstep);
    S.a_ready(cur);
    PG8_STAGE(PG8_SB(0, 0), cB, voffB); PG8_STAGE(PG8_SB(0, 1), cB + hstep, voffB); PG8_STAGE_A(PG8_SA(0, 0), cA, 0); PG8_STAGE_A(PG8_SA(0, 1), cA, 1);
    if (wr == 1) PG8_BAR;
    PG8_WAIT_V(2); PG8_BAR;
    PG8_STAGE(PG8_SB(1, 0), cB + kstep, voffB); PG8_STAGE_A(PG8_SA(1, 0), cA + kstep, 0); PG8_STAGE(PG8_SB(1, 1), cB + hstep + kstep, voffB);
    PG8_WAIT_V(6); PG8_BAR;
    for (;;) {
        const bool has_next = S.next(ui + 1, nxt);
        if constexpr (GATHER) {
            if (has_next) {
#pragma unroll
                for (int h = 0; h < 2; ++h)
#pragma unroll
                    for (int i = 0; i < 2; ++i) ngo[h][i] = S.goff(nxt, h * HALF + RA[i], CA[i], K);
            } else {
#pragma unroll
                for (int h = 0; h < 2; ++h)
#pragma unroll
                    for (int i = 0; i < 2; ++i) ngo[h][i] = cgo[h][i];
            }
        }
        const char* nA = GATHER ? (const char*)g.A : (has_next ? (const char*)g.A + (size_t)nxt.pm * tstep : cA); const char* nB = has_next ? S.bbase(g, nxt, tstep) : cB;
#if PROBE_KLOOP
        const unsigned long long pk0_ = __builtin_amdgcn_s_memrealtime();
#endif
        for (int t = 0; t < nt; t += 2) {
            const bool last = (t == nt - 2);
            const char* a1 = cA + (size_t)(t + 1) * kstep;
            const char* a2 = last ? nA : cA + (size_t)(t + 2) * kstep; const char* b2 = last ? nB : cB + (size_t)(t + 2) * kstep;
            const char* a3 = a2 + kstep; const char* b3 = b2 + kstep;
            if (last && has_next) S.a_ready(nxt);
            PG8_LDB(B0, 0, 0); PG8_LDB(B1, 0, 1); PG8_SCHED; PG8_LDA(At, 0, 0); PG8_STAGE_A(PG8_SA(1, 1), a1, 1);
            if constexpr (GATHER) { if (last) {
#pragma unroll
                for (int h = 0; h < 2; ++h)
#pragma unroll
                    for (int i = 0; i < 2; ++i) cgo[h][i] = ngo[h][i]; } }
            PG8_WAIT_V(8); PG8_WAIT_L(0); PG8_BAR; PG8_MMA(0, 0, At, B0); PG8_MMA(0, 1, At, B1); PG8_BAR; PG8_SCHED;
            PG8_LDA(At, 0, 1); PG8_STAGE(PG8_SB(0, 0), b2, voffB); PG8_STAGE(PG8_SB(0, 1), b2 + hstep, voffB); PG8_STAGE_A(PG8_SA(0, 0), a2, 0);
            PG8_WAIT_V(8); PG8_WAIT_L(0); PG8_BAR; PG8_MMA(1, 0, At, B0); PG8_MMA(1, 1, At, B1); PG8_BAR; PG8_SCHED;
            PG8_LDB(B0, 1, 0); PG8_LDB(B1, 1, 1); PG8_SCHED; PG8_LDA(At, 1, 0); PG8_STAGE_A(PG8_SA(0, 1), a2, 1);
            PG8_WAIT_V(8); PG8_WAIT_L(0); PG8_BAR; PG8_MMA(0, 0, At, B0); PG8_MMA(0, 1, At, B1); PG8_BAR; PG8_SCHED;
            PG8_LDA(At, 1, 1); PG8_STAGE(PG8_SB(1, 0), b3, voffB); PG8_STAGE(PG8_SB(1, 1), b3 + hstep, voffB); PG8_STAGE_A(PG8_SA(1, 0), a3, 0);
            PG8_WAIT_V(8); PG8_WAIT_L(0); PG8_BAR; PG8_MMA(1, 0, At, B0); PG8_MMA(1, 1, At, B1); PG8_BAR; PG8_SCHED;
        }
#if PROBE_KLOOP
        const unsigned long long pk1_ = __builtin_amdgcn_s_memrealtime(); if (PROBE_WHAT == 0) pk_acc_ += (unsigned)(pk1_ - pk0_);
#endif
        if constexpr (ALIGN_EPI) { if (wr == 0) PG8_BAR; }
#if PROBE_KLOOP
        const unsigned long long pk2_ = __builtin_amdgcn_s_memrealtime(); if (PROBE_WHAT == 1) pk_acc_ += (unsigned)(pk2_ - pk1_);
#endif
        E(acc, cur, wr, wc, fr, fq); S.done(cur);
#if PROBE_KLOOP
        asm volatile("s_waitcnt vmcnt(0)" ::: "memory"); if (PROBE_WHAT == 2) pk_acc_ += (unsigned)(__builtin_amdgcn_s_memrealtime() - pk2_);
#endif
        if (!has_next) break;
#pragma unroll
        for (int a = 0; a < 2; ++a)
#pragma unroll
            for (int b = 0; b < 2; ++b)
#pragma unroll
                for (int m = 0; m < 4; ++m)
#pragma unroll
                    for (int n = 0; n < 2; ++n) acc[a][b][m][n] = (f32x4){0.f, 0.f, 0.f, 0.f};
        cur = nxt; cA = nA; cB = nB; ++ui;
        if constexpr (ALIGN_EPI) { if (wr == 1) PG8_BAR; }
    }
#if PROBE_KLOOP
    if (blockIdx.x == PROBE_BLK && tid == 0 && g.M == PROBE_KLOOP) atomicAdd(g.probe, pk_acc_);
#endif
    PG8_WAIT_V(0);
    if constexpr (!ALIGN_EPI) { if (wr == 0) PG8_BAR; }
    PG8_BAR;
#undef PG8_SA
#undef PG8_SB
#undef PG8_STAGE
#undef PG8_STAGE_A
#undef PG8_LDA
#undef PG8_LDB
#undef PG8_MMA
#undef PG8_CAT
#undef PG8_WAIT_V
#undef PG8_WAIT_L
#undef PG8_BAR
#undef PG8_SCHED
}
}
#include <hip/hip_bf16.h>
#include <cmath>
namespace attn_body {
using bf16=__hip_bfloat16;
using bf16x8=__attribute__((ext_vector_type(8)))short;
using s16x4=__attribute__((ext_vector_type(4)))short;
using f32x16=__attribute__((ext_vector_type(16)))float;
using u32x4=__attribute__((ext_vector_type(4)))unsigned;
constexpr int BATCH=8,SEQ=4096,D=64,DM=1024;
constexpr int NW=8,QBLK=32,QB=QBLK*NW,KVBLK=64,NQB=SEQ/QB;
__device__ __forceinline__ int crow(int r,int hi){return (r&3)+8*(r>>2)+4*hi;}
#define SBAR() __builtin_amdgcn_sched_barrier(0)
__device__ __forceinline__ void cmask(f32x16&p0,f32x16&p1,int jb,int qrel,int hi){
  const float NEG=-INFINITY; const int lim=qrel-64*jb-4*hi;
  #pragma unroll
  for(int r=0;r<16;++r){const int cr=(r&3)+8*(r>>2); if(cr>lim)p0[r]=NEG; if(cr+32>lim)p1[r]=NEG;}
}

constexpr int NSLOT=3, SLOTB=8192;
constexpr int LDS_K=0, LDS_V=NSLOT*SLOTB, LDS_WS=3*NSLOT*SLOTB, LDS_OST=LDS_WS+NW*64*4, LDS_BYTES=LDS_OST+NW*4096;
__device__ __forceinline__ void glds16(const void*sbase,unsigned voff,unsigned lds_dst){unsigned keep;
  asm volatile("s_mov_b32 %0, m0\n\ts_mov_b32 m0, %3\n\ts_nop 0\n\tglobal_load_lds_dwordx4 %1, %2\n\ts_mov_b32 m0, %0":"=&s"(keep):"v"(voff),"s"(sbase),"s"(lds_dst):"memory");}
__device__ __forceinline__ float max3f(float a,float b,float c){float r;asm("v_max3_f32 %0, %1, %2, %3":"=v"(r):"v"(a),"v"(b),"v"(c));return r;}
__device__ __forceinline__ float max2f(float a,float b){float r;asm("v_max_f32_e32 %0, %1, %2":"=v"(r):"v"(a),"v"(b));return r;}
__device__ __forceinline__ float fsub_s(float a,float b){float r;asm("v_sub_f32_e32 %0, %1, %2":"=v"(r):"v"(a),"v"(b));return r;}
typedef float f32x2_t __attribute__((ext_vector_type(2))); typedef __bf16 bf16x2_t __attribute__((ext_vector_type(2)));
__device__ __forceinline__ unsigned cvtpk_s(float lo,float hi){f32x2_t v={lo,hi};bf16x2_t b=__builtin_convertvector(v,bf16x2_t);return __builtin_bit_cast(unsigned,b);}
#define WAIT_BAR(N) asm volatile("s_waitcnt vmcnt(" #N ") lgkmcnt(0)\n\ts_barrier":::"memory")
#define MFMA32(a,b,c) __builtin_amdgcn_mfma_f32_32x32x16_bf16(a,b,c,0,0,0)

__device__ __forceinline__ void qkt(f32x16&p0,f32x16&p1,const char*Kslot,const bf16x8*qr,int r32,int hi){
  const char*kb=Kslot+hi*1024+r32*16;
  #pragma unroll
  for(int d0=0;d0<4;++d0){
    const bf16x8 b0=*reinterpret_cast<const bf16x8*>(kb+d0*2048);
    const bf16x8 b1=*reinterpret_cast<const bf16x8*>(kb+d0*2048+512);
    p0=MFMA32(b0,qr[d0],p0);p1=MFMA32(b1,qr[d0],p1);}
}
typedef __attribute__((address_space(3))) const char* lds_cptr;
typedef short v4i16_t __attribute__((ext_vector_type(4)));
__device__ __forceinline__ void kload8(bf16x8*kf,lds_cptr kp){
  kf[0]=*(const __attribute__((address_space(3))) bf16x8*)(kp);      kf[1]=*(const __attribute__((address_space(3))) bf16x8*)(kp+512);
  kf[2]=*(const __attribute__((address_space(3))) bf16x8*)(kp+2048); kf[3]=*(const __attribute__((address_space(3))) bf16x8*)(kp+2560);
  kf[4]=*(const __attribute__((address_space(3))) bf16x8*)(kp+4096); kf[5]=*(const __attribute__((address_space(3))) bf16x8*)(kp+4608);
  kf[6]=*(const __attribute__((address_space(3))) bf16x8*)(kp+6144); kf[7]=*(const __attribute__((address_space(3))) bf16x8*)(kp+6656);
}
__device__ __forceinline__ void kload2(bf16x8*kf,lds_cptr kp,int j){ kf[2*j]=*(const __attribute__((address_space(3))) bf16x8*)(kp+j*2048); kf[2*j+1]=*(const __attribute__((address_space(3))) bf16x8*)(kp+j*2048+512); }
__device__ __forceinline__ s16x4 vtr(lds_cptr p){ return __builtin_bit_cast(s16x4,__builtin_amdgcn_ds_read_tr16_b64_v4i16((__attribute__((address_space(3))) v4i16_t*)p)); }
__device__ __forceinline__ float rowmax(const f32x16&p0,const f32x16&p1){
  float a=max3f(p0[0],p0[1],p1[0]),b=max3f(p0[2],p0[3],p1[1]);a=max3f(a,p1[2],p1[3]);
  #pragma unroll
  for(int r=4;r<16;r+=4){a=max3f(a,p0[r],p0[r+1]);b=max3f(b,p0[r+2],p0[r+3]);a=max3f(a,p1[r],p1[r+1]);b=max3f(b,p1[r+2],p1[r+3]);}
  const float m=max2f(a,b);
  auto rr=__builtin_amdgcn_permlane32_swap(__float_as_uint(m),__float_as_uint(m),false,false);
  return max2f(__uint_as_float(rr[0]),__uint_as_float(rr[1]));
}
__device__ __forceinline__ void pv(f32x16*o,int vb,bf16x8 pa0,bf16x8 pa1,bf16x8 pa2,bf16x8 pa3){
  #pragma unroll
  for(int d0=0;d0<4;++d0){s16x4 lo[4],hi[4];
    #pragma unroll
    for(int ks=0;ks<4;++ks){
      asm volatile("ds_read_b64_tr_b16 %0,%1 offset:%c2":"=&v"(lo[ks]):"v"(vb),"i"(d0*4096+ks*1024):"memory");
      asm volatile("ds_read_b64_tr_b16 %0,%1 offset:%c2":"=&v"(hi[ks]):"v"(vb),"i"(d0*4096+ks*1024+512):"memory");}
    asm volatile("s_waitcnt lgkmcnt(0)":::"memory");SBAR();
    #define PK(k) (bf16x8){lo[k][0],lo[k][1],lo[k][2],lo[k][3],hi[k][0],hi[k][1],hi[k][2],hi[k][3]}
    o[d0]=MFMA32(pa0,PK(0),o[d0]);
    o[d0]=MFMA32(pa1,PK(1),o[d0]);
    o[d0]=MFMA32(pa2,PK(2),o[d0]);
    o[d0]=MFMA32(pa3,PK(3),o[d0]);
    #undef PK
  }
}

template<int THRL> __device__ __forceinline__ void attn_sub(int b,int qkcol,int vcol,int qb,int cmap,float sl2,float lam,int ntcap,float oscale,const float*subg,unsigned*o1s,bf16*MIXh,const bf16*Q,const bf16*__restrict__ K,const bf16*__restrict__ V,char*shm,unsigned*pw_){
#if PROBE_ATT >= 3
  const unsigned long long ps0_=__builtin_amdgcn_s_memrealtime();
#endif
  const int tid=threadIdx.x,lane=tid&63,r32=lane&31,hi=lane>>5; const int wid=__builtin_amdgcn_readfirstlane(tid>>6);
  const long rowbase=(long)b*SEQ; const int q0=qb*QB;
  const bf16*Qw=Q+(rowbase+q0+wid*QBLK)*DM+qkcol;
  const bf16*Kh=K+rowbase*DM+qkcol,*Vh=V+rowbase*DM+vcol;
  const unsigned lds0=(unsigned)(uintptr_t)shm;
  float*wsf=(float*)(shm+LDS_WS)+wid*64;
  const unsigned koff=(unsigned)(lane*DM+wid*8)*2u, voffv=(unsigned)((16*(wid&3)+(lane>>2))*DM+(wid>>2)*32+(lane&3)*8)*2u;
  const unsigned kdst=lds0+LDS_K+wid*1024, vdst=lds0+LDS_V+wid*1024;
  const int NTR=(q0+QB)/KVBLK;
  const int NT=NTR<ntcap?NTR:ntcap;
  #define DMA_K(t,slot) glds16(Kh+(long)(NTR-1-(t))*KVBLK*DM,koff,(unsigned)__builtin_amdgcn_readfirstlane(kdst+(slot)))
  #define DMA_V(t,slot) do{ glds16(Vh+(long)(NTR-1-(t))*KVBLK*DM,voffv,(unsigned)__builtin_amdgcn_readfirstlane(vdst+2*(slot))); glds16(Vh+(long)(NTR-1-(t))*KVBLK*DM+64,voffv,(unsigned)__builtin_amdgcn_readfirstlane(vdst+2*(slot)+8192)); }while(0)
  const int vb0=(int)(lds0+LDS_V)+((lane>>4)&1)*32+(lane&3)*8+(4*hi+((lane&15)>>2))*64;
  const char*Kbase=shm+LDS_K; bf16x8 kf[8];
  const lds_cptr shm3=(lds_cptr)shm; const lds_cptr kp0=shm3+LDS_K+hi*1024+r32*16; const lds_cptr vp0=shm3+LDS_V+((lane>>4)&1)*32+(lane&3)*8+(4*hi+((lane&15)>>2))*64;
  DMA_K(0,0);DMA_V(0,0);DMA_K(1,SLOTB);
  bf16x8 qr[4];
  #pragma unroll
  for(int d0=0;d0<4;++d0)qr[d0]=*reinterpret_cast<const bf16x8*>(&Qw[(long)r32*DM+d0*16+hi*8]);
  const int qrel=wid*QBLK+r32;
  const unsigned lm=hi?0u:0xffffffffu;
  const unsigned kx0=cvtpk_s((float)r32,(float)r32), kx1=cvtpk_s((float)(r32+32),(float)(r32+32));
  unsigned bbx; { const unsigned sh=__float_as_uint(sl2)&0xffff0000u; const float sr=sl2-__uint_as_float(sh); bbx=((sh>>16)|(cvtpk_s(sr,0.f)<<16))&lm; }
  const float dlt=64.f*sl2;
  float cref=sl2*(float)(192-qrel);
  #define BIAS2(C0,C1,t) do{ const float c_=__builtin_fmaf(-dlt,(float)(t),cref); const unsigned h_=__float_as_uint(c_)&0xffff0000u; const float r1_=c_-__uint_as_float(h_); \
      const unsigned m_=__float_as_uint(r1_)&0xffff0000u; const float r2_=r1_-__uint_as_float(m_); \
      u32x4 b_=(u32x4){bbx,((h_>>16)|m_)&lm,(__float_as_uint(r2_)>>16)&lm,0u}; u32x4 a_=(u32x4){kx0,0x3F803F80u,0x00003F80u,0u}; asm volatile("":"+v"(a_),"+v"(b_)); \
      const f32x16 z_=f32x16{}; C0=MFMA32(__builtin_bit_cast(bf16x8,a_),__builtin_bit_cast(bf16x8,b_),z_); \
      a_.x=kx1; asm volatile("":"+v"(a_)); C1=MFMA32(__builtin_bit_cast(bf16x8,a_),__builtin_bit_cast(bf16x8,b_),z_); }while(0)
  float l_reg=0.f;f32x16 o[4];o[0]=f32x16{};o[1]=f32x16{};o[2]=f32x16{};o[3]=f32x16{};
  #define CMASK(P0,P1,t) do{int jb_=3-(t); if(jb_>=0)cmask(P0,P1,jb_,qrel,hi);}while(0)
  bool resc=false;
  #define START(P0,P1) do{ const float rm=rowmax(P0,P1); resc=false; \
    if(__any(rm>(float)THRL)){ const float dl=max2f(rm,0.f); cref=fsub_s(cref,dl); \
      _Pragma("unroll") for(int r=0;r<16;++r){P0[r]=fsub_s(P0[r],dl);P1[r]=fsub_s(P1[r],dl);} } \
    _Pragma("unroll") for(int r=0;r<16;++r)P0[r]=__builtin_amdgcn_exp2f(P0[r]); }while(0)
  #define RESC() do{ if(resc){ asm volatile("s_waitcnt lgkmcnt(0)":::"memory"); \
      _Pragma("unroll") for(int d_=0;d_<4;++d_) _Pragma("unroll") for(int r=0;r<16;++r)o[d_][r]*=wsf[crow(r,hi)]; } }while(0)
  f32x16 pA0,pA1,pB0,pB1;
  int sl_prev=0,sl_cur=0,sl_next=SLOTB;
  #define ROT() do{sl_prev=sl_cur;sl_cur=sl_next;sl_next=(sl_next==(NSLOT-1)*SLOTB)?0:sl_next+SLOTB;}while(0)
  DMA_K(2,2*SLOTB);
  WAIT_BAR(3);
  BIAS2(pA0,pA1,0);
  qkt(pA0,pA1,Kbase,qr,r32,hi);asm volatile("s_nop 15\n\ts_nop 7":"+v"(pA0),"+v"(pA1));CMASK(pA0,pA1,0);
  START(pA0,pA1);
  _Pragma("unroll") for(int r=0;r<16;++r)pA1[r]=__builtin_amdgcn_exp2f(pA1[r]);
  WAIT_BAR(0);
  DMA_K(3,0);DMA_V(1,SLOTB);
  ROT();
  kload8(kf,kp0+sl_cur);
  WAIT_BAR(3);
  s16x4 vlo[8],vhi[8]; u32x4 pw0,pw1,pw2,pw3;
  #define PKW(P,B) cvtpk_s(P[B],P[B+1])
  #define PAF(k) __builtin_bit_cast(bf16x8,pw##k)
  #define VFR(i) (bf16x8){vlo[i][0],vlo[i][1],vlo[i][2],vlo[i][3],vhi[i][0],vhi[i][1],vhi[i][2],vhi[i][3]}
  #define PIN(x) asm volatile("":"+v"(x))
  #define MX3(a,b,c) __builtin_fmaxf(__builtin_fmaxf((a),(b)),(c))
  #define GAPA(MF,A0,A1,A2,A3,W0,W1,PW) do{ MF; sacc+=A0; sacc+=A1; sacc+=A2; sacc+=A3; PIN(sacc); W0; W1; PIN(PW); SBAR(); }while(0)
  #define EX(v) __builtin_amdgcn_exp2f(v)
  #define GAPB(MF,X,B) do{ MF; X[B]=EX(X[B]); X[B+1]=EX(X[B+1]); PIN(X); SBAR(); }while(0)
  #define VRD2(i) do{ vlo[i]=vtr(vp_+(8192+((i)>>2)*4096+((i)&3)*1024)); vhi[i]=vtr(vp_+(8192+((i)>>2)*4096+((i)&3)*1024+512)); SBAR(); }while(0)
  #define VRD(i) do{ vlo[i]=vtr(vp_+(((i)>>2)*4096+((i)&3)*1024)); vhi[i]=vtr(vp_+(((i)>>2)*4096+((i)&3)*1024+512)); }while(0)
  #define KRD(G,j) do{ if(G){ kload2(kf,kp0+sl_next,j); SBAR(); } }while(0)
  #define STEP(C0,C1,P0,P1,t,GK,GV,GL) do{ SBAR(); \
    BIAS2(C0,C1,t); SBAR(); \
    const lds_cptr vp_=vp0+2*sl_prev; \
    VRD(0); SBAR(); float sacc=(P0[0]+P0[1]); \
    GAPA(C0=MFMA32(kf[0],qr[0],C0), P0[2],P0[3],P0[4],P0[5],     pw0[0]=PKW(P0,0), pw0[1]=PKW(P0,2), pw0); \
    VRD(4); SBAR(); GAPA(C1=MFMA32(kf[1],qr[0],C1), P0[6],P0[7],P0[8],P0[9],     pw0[2]=PKW(P0,4), pw0[3]=PKW(P0,6), pw0); \
    VRD(1); SBAR(); GAPA(C0=MFMA32(kf[2],qr[1],C0),   P0[10],P0[11],P0[12],P0[13], pw1[0]=PKW(P0,8), pw1[1]=PKW(P0,10), pw1); \
    VRD(5); SBAR(); GAPA(C1=MFMA32(kf[3],qr[1],C1),   P0[14],P0[15],P1[0],P1[1],   pw1[2]=PKW(P0,12),pw1[3]=PKW(P0,14), pw1); \
    VRD(2); SBAR(); GAPA(C0=MFMA32(kf[4],qr[2],C0),   P1[2],P1[3],P1[4],P1[5],     pw2[0]=PKW(P1,0), pw2[1]=PKW(P1,2), pw2); \
    VRD(6); SBAR(); GAPA(C1=MFMA32(kf[5],qr[2],C1),   P1[6],P1[7],P1[8],P1[9],     pw2[2]=PKW(P1,4), pw2[3]=PKW(P1,6), pw2); \
    VRD(3); SBAR(); GAPA(C0=MFMA32(kf[6],qr[3],C0),   P1[10],P1[11],P1[12],P1[13], pw3[0]=PKW(P1,8), pw3[1]=PKW(P1,10), pw3); \
    VRD(7); SBAR(); GAPA(C1=MFMA32(kf[7],qr[3],C1),   P1[14],P1[15],0.f,0.f,       pw3[2]=PKW(P1,12),pw3[3]=PKW(P1,14), pw3); \
    l_reg+=sacc; \
    if(GK){DMA_K((t)+3,sl_cur);} if(GV){DMA_V((t)+1,sl_next);} \
    CMASK(C0,C1,t); \
    { float a=MX3(C0[0],C0[1],C1[0]),b=MX3(C0[2],C0[3],C1[1]); a=MX3(a,C1[2],C1[3]); \
      _Pragma("unroll") for(int r=4;r<16;r+=4){a=MX3(a,C0[r],C0[r+1]);b=MX3(b,C0[r+2],C0[r+3]);a=MX3(a,C1[r],C1[r+1]);b=MX3(b,C1[r+2],C1[r+3]);} \
      float rm=__builtin_fmaxf(a,b); { auto rr=__builtin_amdgcn_permlane32_swap(__float_as_uint(rm),__float_as_uint(rm),false,false); rm=__builtin_fmaxf(__uint_as_float(rr[0]),__uint_as_float(rr[1])); } \
      resc=false; \
      if(__builtin_expect(__any(rm>(float)THRL),0)){ const float dl=__builtin_fmaxf(rm,0.f); cref-=dl; \
        _Pragma("unroll") for(int r=0;r<16;++r){C0[r]-=dl;C1[r]-=dl;} \
        const float f=__builtin_amdgcn_exp2f(-dl); l_reg*=f; if(hi==0)wsf[r32]=f; resc=true; } } \
    SBAR(); \
    GAPB(o[0]=MFMA32(PAF(0),VFR(0),o[0]), C0,0);  VRD2(0); \
    GAPB(o[1]=MFMA32(PAF(0),VFR(4),o[1]), C0,2);  VRD2(4); \
    KRD(GL,0); GAPB(o[0]=MFMA32(PAF(1),VFR(1),o[0]), C0,4);  VRD2(1); \
    KRD(GL,1); GAPB(o[1]=MFMA32(PAF(1),VFR(5),o[1]), C0,6);  VRD2(5); \
    KRD(GL,2); GAPB(o[0]=MFMA32(PAF(2),VFR(2),o[0]), C0,8);  VRD2(2); \
    KRD(GL,3); GAPB(o[1]=MFMA32(PAF(2),VFR(6),o[1]), C0,10); VRD2(6); \
    GAPB(o[0]=MFMA32(PAF(3),VFR(3),o[0]), C0,12); VRD2(3); \
    GAPB(o[1]=MFMA32(PAF(3),VFR(7),o[1]), C0,14); VRD2(7); \
    GAPB(o[2]=MFMA32(PAF(0),VFR(0),o[2]), C1,0); \
    GAPB(o[3]=MFMA32(PAF(0),VFR(4),o[3]), C1,2); \
    GAPB(o[2]=MFMA32(PAF(1),VFR(1),o[2]), C1,4); \
    GAPB(o[3]=MFMA32(PAF(1),VFR(5),o[3]), C1,6); \
    GAPB(o[2]=MFMA32(PAF(2),VFR(2),o[2]), C1,8); \
    GAPB(o[3]=MFMA32(PAF(2),VFR(6),o[3]), C1,10); \
    GAPB(o[2]=MFMA32(PAF(3),VFR(3),o[2]), C1,12); \
    GAPB(o[3]=MFMA32(PAF(3),VFR(7),o[3]), C1,14); \
    }while(0)
  #define ENDW(tt) do{ if((tt)+3<NT){WAIT_BAR(3);} else if((tt)+2<NT){WAIT_BAR(2);} else {WAIT_BAR(0);} }while(0)
#if PROBE_ATT == 3
  if(blockIdx.x==PROBE_BLK&&threadIdx.x==0)atomicAdd(pw_,(unsigned)(__builtin_amdgcn_s_memrealtime()-ps0_));
#endif
  int t=1;
  for(;t<5&&t+1<NT;t+=2){
    STEP(pB0,pB1,pA0,pA1,t,(t+3<NT),(t+1<NT),(t+1<NT));       ENDW(t);   RESC(); ROT();
    STEP(pA0,pA1,pB0,pB1,t+1,(t+4<NT),(t+2<NT),(t+2<NT));     ENDW(t+1); RESC(); ROT();
  }
  #undef CMASK
  #define CMASK(P0,P1,t) do{}while(0)
  for(;t+5<NT;t+=2){
    STEP(pB0,pB1,pA0,pA1,t,true,true,true);     WAIT_BAR(3); RESC(); ROT();
    STEP(pA0,pA1,pB0,pB1,t+1,true,true,true);   WAIT_BAR(3); RESC(); ROT();
  }
  for(;t+1<NT;t+=2){
    STEP(pB0,pB1,pA0,pA1,t,(t+3<NT),(t+1<NT),(t+1<NT));       ENDW(t);   RESC(); ROT();
    STEP(pA0,pA1,pB0,pB1,t+1,(t+4<NT),(t+2<NT),(t+2<NT));     ENDW(t+1); RESC(); ROT();
  }
  #undef CMASK
  #define CMASK(P0,P1,t) do{int jb_=3-(t); if(jb_>=0)cmask(P0,P1,jb_,qrel,hi);}while(0)
  STEP(pB0,pB1,pA0,pA1,NT-1,false,false,false); RESC();
#if PROBE_ATT == 4
  const unsigned long long ps1_=__builtin_amdgcn_s_memrealtime();
#endif
  { float sacc=pB0[0]+pB0[1]; _Pragma("unroll") for(int r=2;r<16;++r)sacc+=pB0[r]; _Pragma("unroll") for(int r=0;r<16;++r)sacc+=pB1[r]; l_reg+=sacc;
    pw0=(u32x4){PKW(pB0,0),PKW(pB0,2),PKW(pB0,4),PKW(pB0,6)};pw1=(u32x4){PKW(pB0,8),PKW(pB0,10),PKW(pB0,12),PKW(pB0,14)};pw2=(u32x4){PKW(pB1,0),PKW(pB1,2),PKW(pB1,4),PKW(pB1,6)};pw3=(u32x4){PKW(pB1,8),PKW(pB1,10),PKW(pB1,12),PKW(pB1,14)};
    SBAR(); pv(o,vb0+2*sl_cur,PAF(0),PAF(1),PAF(2),PAF(3)); }
  #undef PKW
  #undef PAF
  #undef VFR
  #undef PIN
  #undef MX3
  #undef GAPA
  #undef GAPB
  #undef EX
  #undef VRD
  #undef VRD2
  #undef KRD
  #undef STEP
  #undef ENDW
  { int tid_e=threadIdx.x; asm volatile("":"+v"(tid_e)); const int lane=tid_e&63,r32=lane&31,hi=lane>>5; const int wid=__builtin_amdgcn_readfirstlane(tid_e>>6);
    float*wsf=(float*)(shm+LDS_WS)+wid*64;
  {auto rr=__builtin_amdgcn_permlane32_swap(__float_as_uint(l_reg),__float_as_uint(l_reg),false,false);l_reg=__uint_as_float(rr[0])+__uint_as_float(rr[1]);}
  if(hi==0)wsf[32+r32]=l_reg;asm volatile("s_waitcnt lgkmcnt(0)":::"memory");
  float rli[16];
  #pragma unroll
  for(int r=0;r<16;++r)rli[r]=__builtin_amdgcn_rcpf(wsf[32+crow(r,hi)]);
  u32x4*ow=(u32x4*)(o1s+wid*2048)+lane;
  if(cmap==0){
    #pragma unroll
    for(int i=0;i<8;++i){ const int dq=i>>1,r0=8*(i&1); u32x4 w;
      w.x=cvtpk_s(o[dq][r0+0]*rli[r0+0],o[dq][r0+1]*rli[r0+1]); w.y=cvtpk_s(o[dq][r0+2]*rli[r0+2],o[dq][r0+3]*rli[r0+3]);
      w.z=cvtpk_s(o[dq][r0+4]*rli[r0+4],o[dq][r0+5]*rli[r0+5]); w.w=cvtpk_s(o[dq][r0+6]*rli[r0+6],o[dq][r0+7]*rli[r0+7]); ow[i*64]=w; }
  } else {
    bf16*stg=(bf16*)(shm+LDS_OST)+wid*2048;
    const int row=lane>>1,part=lane&1; float v[64]; float ss=0.f;
    unsigned o1w[32];
    #pragma unroll
    for(int i=0;i<8;++i){ const u32x4 w=ow[i*64]; o1w[4*i+0]=w.x; o1w[4*i+1]=w.y; o1w[4*i+2]=w.z; o1w[4*i+3]=w.w; }
    #pragma unroll
    for(int p_=0;p_<2;++p_){
      #pragma unroll
      for(int d0=0;d0<2;++d0){ const int dq=2*p_+d0;
        #pragma unroll
        for(int rp=0;rp<8;++rp){ const unsigned w=o1w[dq*8+rp];
          const float a0=__uint_as_float(w<<16)-lam*(o[dq][2*rp]*rli[2*rp]), a1=__uint_as_float(w&0xffff0000u)-lam*(o[dq][2*rp+1]*rli[2*rp+1]);
          stg[crow(2*rp,hi)*64+d0*32+r32]=__float2bfloat16(a0); stg[crow(2*rp+1,hi)*64+d0*32+r32]=__float2bfloat16(a1); } }
      asm volatile("s_waitcnt lgkmcnt(0)":::"memory");
      #pragma unroll
      for(int i=0;i<4;++i){ const u32x4 w=*(const u32x4*)(stg+row*64+part*32+8*i);
        v[32*p_+8*i+0]=__uint_as_float(w.x<<16); v[32*p_+8*i+1]=__uint_as_float(w.x&0xffff0000u); v[32*p_+8*i+2]=__uint_as_float(w.y<<16); v[32*p_+8*i+3]=__uint_as_float(w.y&0xffff0000u);
        v[32*p_+8*i+4]=__uint_as_float(w.z<<16); v[32*p_+8*i+5]=__uint_as_float(w.z&0xffff0000u); v[32*p_+8*i+6]=__uint_as_float(w.w<<16); v[32*p_+8*i+7]=__uint_as_float(w.w&0xffff0000u); }
      asm volatile("s_waitcnt lgkmcnt(0)":::"memory");
    }
    #pragma unroll
    for(int i=0;i<64;++i)ss+=v[i]*v[i];
    ss+=__uint_as_float((unsigned)__builtin_amdgcn_update_dpp(0,(int)__float_as_uint(ss),0xB1,0xF,0xF,false));
    const float rs=(1.0f/sqrtf(ss*(1.0f/128.0f)+1e-6f))*oscale;
    bf16*op=MIXh+((long)rowbase+q0+wid*QBLK+row)*2048+part*32;
    #pragma unroll
    for(int p_=0;p_<2;++p_){ const float*sg=subg+64*p_+32*part;
      #pragma unroll
      for(int i=0;i<4;++i){ u32x4 w; const float*vv=v+32*p_+8*i; const float*gg=sg+8*i;
        w.x=cvtpk_s(vv[0]*rs*gg[0],vv[1]*rs*gg[1]); w.y=cvtpk_s(vv[2]*rs*gg[2],vv[3]*rs*gg[3]); w.z=cvtpk_s(vv[4]*rs*gg[4],vv[5]*rs*gg[5]); w.w=cvtpk_s(vv[6]*rs*gg[6],vv[7]*rs*gg[7]);
        *(u32x4*)(op+64*p_+8*i)=w; } }
  }
  }
  asm volatile("s_waitcnt lgkmcnt(0)\n\ts_barrier":::"memory");
#if PROBE_ATT == 4
  if(blockIdx.x==PROBE_BLK&&threadIdx.x==0)atomicAdd(pw_,(unsigned)(__builtin_amdgcn_s_memrealtime()-ps1_));
#endif
  #undef DMA_K
  #undef DMA_V
  #undef CMASK
  #undef START
  #undef RESC
  #undef ROT
  #undef BIAS2
}
constexpr int ATTN_LDS_BYTES=LDS_BYTES;
template<int THRL> __device__ __forceinline__ void attn_unit4(int b,int h,int qb,float lam,float oscale,const float*subg,const unsigned*nmax,unsigned*o1s,const bf16*Q,const bf16*K,const bf16*V,bf16*MIX,char*shm){
  const float sl2=exp2f(-(float)(h+1))*1.4426950408889634f;
  int cap[2];
  #pragma unroll
  for(int c=0;c<2;++c){ const int bh=b*8+h; const unsigned*qn=nmax+((0*64+bh)*2+c)*2,*kn=nmax+((1*64+bh)*2+c)*2;
    const float U=1.02f*(sqrtf(__uint_as_float(qn[0])*__uint_as_float(kn[0]))+sqrtf(__uint_as_float(qn[1])*__uint_as_float(kn[1])));
    const float d0=(2.f*U+24.f+log2f(1.f/(1.f-exp2f(-sl2))))/sl2; float st=ceilf((d0+255.f)*(1.f/64.f)); st=st<4.f?4.f:(st>64.f?64.f:st);
    cap[c]=__builtin_amdgcn_readfirstlane((((int)st)+1)&~1); }
  for(int c=0;c<2;++c) attn_sub<THRL>(b,(2*h+c)*64,h*128,qb,c,sl2,lam,c?cap[1]:cap[0],oscale,subg,o1s,MIX+h*128,Q,K,V,shm,(unsigned*)nmax+900);
}
__device__ __forceinline__ int wg_pop(unsigned*ctr,volatile __attribute__((address_space(3))) unsigned*slot){
  if(threadIdx.x==0)*slot=__hip_atomic_fetch_add(ctr,1u,__ATOMIC_RELAXED,__HIP_MEMORY_SCOPE_AGENT);
  __syncthreads(); const unsigned n=*slot; __syncthreads(); return (int)n;
}
template<int THRL=8> __device__ __forceinline__ void attn_phase(char*lds,int bx,unsigned*qctr,volatile __attribute__((address_space(3))) unsigned*slot,float lam,float oscale,const float*subg,const unsigned*nmax,unsigned*o1s,const bf16*Q,const bf16*K,const bf16*V,bf16*MIX){
  for(int qi=0;qi<8;++qi){ const int x=(bx+qi)&7;
    for(;;){ const int n=wg_pop(qctr+64*x,slot); if(n>=128)break;
      const int qb=15-(n>>3),h=7-(n&7),b=(x+h)&7;
#if PROBE_ATT == 1
      const unsigned long long pa0_=__builtin_amdgcn_s_memrealtime();
#endif
      attn_unit4<THRL>(b,h,qb,lam,oscale,subg,nmax,o1s,Q,K,V,MIX,lds);
#if PROBE_ATT == 1
      if(blockIdx.x==PROBE_BLK&&threadIdx.x==0)atomicAdd((unsigned*)nmax+900,(unsigned)(__builtin_amdgcn_s_memrealtime()-pa0_));
#endif
    } }
}
#undef SBAR
#undef WAIT_BAR
#undef MFMA32
}
#define GAS __attribute__((address_space(1)))
#define LAS __attribute__((address_space(3)))
typedef unsigned short bf16;
typedef unsigned v4u __attribute__((ext_vector_type(4)));
typedef float f32x4 __attribute__((ext_vector_type(4)));
typedef short bf16x8 __attribute__((ext_vector_type(8)));
typedef GAS unsigned gu32;
typedef GAS unsigned long long gu64;
#define RLX_AGENT __ATOMIC_RELAXED, __HIP_MEMORY_SCOPE_AGENT
#define LDS_WAIT() asm volatile("s_waitcnt lgkmcnt(0)" ::: "memory")
#define VM_WAIT() asm volatile("s_waitcnt vmcnt(0)" ::: "memory")
__device__ __forceinline__ unsigned long long rt() { return __builtin_amdgcn_s_memrealtime(); }
__device__ __forceinline__ unsigned f2bf(float f) { unsigned u = __builtin_bit_cast(unsigned, f); return (u + 0x7fffu + ((u >> 16) & 1u)) >> 16; }
__device__ __forceinline__ unsigned pk2(float lo, float hi) { return f2bf(lo) | (f2bf(hi) << 16); }

#define XB_TMO      128
#define XB_XCNT(j)  (256  + 64 * (j))
#define XB_XSUB(j)  (1280 + 64 * (j))
#define XB_XGEN(j)  (2304 + 64 * (j))
#define XB_TOP      3328
#define XB_TOPGEN   3392
#define XCD_BAR_WORDS 3456
#define XB_SPIN_CAP (1u << 18)

__device__ __forceinline__ unsigned xb_ld(unsigned* p)              { return __hip_atomic_load(p, __ATOMIC_RELAXED, __HIP_MEMORY_SCOPE_AGENT); }
__device__ __forceinline__ unsigned xb_add(unsigned* p, unsigned v) { return __hip_atomic_fetch_add(p, v, __ATOMIC_RELAXED, __HIP_MEMORY_SCOPE_AGENT); }
__device__ __forceinline__ unsigned xb_xcc_id() { return (unsigned)__builtin_amdgcn_s_getreg((3 << 11) | 20) & 0xFu; }
#define XB_SPIN(cond, bar) do { unsigned _sp = 0; while (cond) { __builtin_amdgcn_s_sleep(1); \
    if ((++_sp & 255u) == 0u) { if (xb_ld(&(bar)[XB_TMO])) break; if (_sp > XB_SPIN_CAP) { atomicAdd(&(bar)[XB_TMO], 1u); break; } } } } while (0)

struct XcdBarrier {
    unsigned* bar; unsigned x;
    volatile LAS unsigned* st;
};

__device__ __forceinline__ XcdBarrier xcd_barrier_post(unsigned* bar, volatile LAS unsigned* st) {
    XcdBarrier b; b.bar = bar; b.x = xb_xcc_id(); b.st = st;
    if (threadIdx.x == 0) (void)xb_add(&bar[XB_XCNT(b.x)], 1u);
    return b;
}
__device__ __forceinline__ void xcd_barrier_complete(unsigned* bar, unsigned x, unsigned& nloc, unsigned& nx) {
    const unsigned G = gridDim.x * gridDim.y * gridDim.z;
    unsigned sum, cnt, mine, sp = 0u;
    for (;;) {
        sum = 0u; cnt = 0u; mine = 0u;
#pragma unroll
        for (unsigned j = 0; j < 16; ++j) { const unsigned c = xb_ld(&bar[XB_XCNT(j)]); sum += c; cnt += (c > 0u) ? 1u : 0u; mine = (j == x) ? c : mine; }
        if (sum == G) break;
        __builtin_amdgcn_s_sleep(1);
        if ((++sp & 255u) == 0u) { if (xb_ld(&bar[XB_TMO])) break; if (sp > XB_SPIN_CAP) { atomicAdd(&bar[XB_TMO], 1u); break; } }
    }
    nloc = mine > 0u ? mine : 1u; nx = cnt > 0u ? cnt : 1u;
}

__device__ __forceinline__ void xcd_barrier(const XcdBarrier& b) {
    asm volatile("s_waitcnt vmcnt(0)" ::: "memory");
    __syncthreads();
    if (threadIdx.x == 0) {
        unsigned* bar = b.bar;
        __builtin_amdgcn_s_waitcnt(0);
        unsigned nloc = b.st[0], nx = b.st[1];
        if (nloc == 0u) { xcd_barrier_complete(bar, b.x, nloc, nx); b.st[0] = nloc; b.st[1] = nx; }
        const unsigned old = xb_add(&bar[XB_XSUB(b.x)], 1u);
        const unsigned gen = old / nloc;
        if (old + 1u == (gen + 1u) * nloc) {
            __builtin_amdgcn_fence(__ATOMIC_RELEASE, "agent");
            asm volatile("s_waitcnt vmcnt(0)" ::: "memory");
            const unsigned og = xb_add(&bar[XB_TOP], 1u);
            const unsigned tg = og / nx;
            if (og + 1u == (tg + 1u) * nx) xb_add(&bar[XB_TOPGEN], 1u);
            else XB_SPIN(xb_ld(&bar[XB_TOPGEN]) == tg, bar);
            __builtin_amdgcn_fence(__ATOMIC_ACQUIRE, "agent");
            xb_add(&bar[XB_XGEN(b.x)], 1u);
            asm volatile("s_waitcnt vmcnt(0)" ::: "memory");
        } else {
            XB_SPIN(xb_ld(&bar[XB_XGEN(b.x)]) == gen, bar);
            __builtin_amdgcn_fence(__ATOMIC_ACQUIRE, "agent");
            asm volatile("s_waitcnt vmcnt(0)" ::: "memory");
        }
    }
    __syncthreads();
}

constexpr int NWAVES = 8;
constexpr int BATCH = 8, SEQ = 4096, T = BATCH * SEQ, D = 2048, NIN = 5120, NEXP = 32, NA = 2 * T;
constexpr float EPS = 1e-6f, LOG2E = 1.4426950408889634f, C2 = 0.125f * 1.4426950408889634f;
constexpr size_t MiB = 1u << 20;
constexpr size_t WS_CTL = 0, CTL_ZERO_BYTES = 1 * MiB;
constexpr size_t WS_RSTD1 = 1 * MiB, WS_RSTD2 = WS_RSTD1 + 128 * 1024, WS_WTS = WS_RSTD2 + 128 * 1024;
constexpr size_t WS_LIST = 2 * MiB;
constexpr size_t WS_PART = 6 * MiB;
constexpr size_t WS_WIN = 10 * MiB, WS_WOUT = 30 * MiB;
constexpr size_t WS_WGU = 38 * MiB, WS_WD = 166 * MiB;
constexpr size_t WS_XB = 230 * MiB;
constexpr size_t WS_CG = 358 * MiB;
constexpr size_t WS_MIX = 422 * MiB;
constexpr size_t WS_HB = 550 * MiB;
constexpr size_t WS_HB8 = 678 * MiB;
constexpr size_t WS_WR = 742 * MiB;
constexpr size_t WS_X8 = 743 * MiB;
constexpr size_t WS_WIN8 = 807 * MiB;
constexpr size_t WS_O1S = 811 * MiB;
constexpr size_t WS_LISTW = 827 * MiB, WS_LISTR = 831 * MiB;
constexpr size_t WS_END = 835 * MiB;
constexpr float WSCALE = 32.f, H1SCALE = 4.f, YSCALE = 8.f;
constexpr int CW_TMO = 0, CW_CODE = 1, CW_BAR = 4096, CW_CNT = 8192;
constexpr int CW_GQ = 20480;
constexpr int CW_H8Q = 24576 + 1024;
constexpr int CW_CVQ = 24576, CW_DONE = 24576 + 64;
constexpr int CW_QA = 12288, CW_QC = 12288 + 512, CW_NMAX = 16384;
constexpr int RING_OFF = 0, RING_BYTES = 131072, LDSCTL_OFF = RING_BYTES, MISC_OFF = LDSCTL_OFF + 320, TAB_OFF = LDSCTL_OFF + 1024;
constexpr int LDS_BYTES = 147456;
constexpr int NPHASE = 8;
#ifndef MK_ONE_LAUNCH
#define MK_ONE_LAUNCH 1
#endif
#ifndef PROBE_DOUBLE
#define PROBE_DOUBLE 0
#endif
#ifndef PROBE_CLOCK
#define PROBE_CLOCK 0
#endif
#ifndef USE_NAIVE_ROUTER
#define USE_NAIVE_ROUTER 0
#endif
#ifndef USE_NAIVE_ATTN
#define USE_NAIVE_ATTN 0
#endif


typedef unsigned u32x4g __attribute__((ext_vector_type(4)));
__device__ __forceinline__ float wave_sum(float v) {
#pragma unroll
    for (int o = 1; o < 64; o <<= 1) v += __shfl_xor(v, o);
    return v;
}
__device__ __forceinline__ float bflo(unsigned w) { return __builtin_bit_cast(float, w << 16); }
__device__ __forceinline__ float bfhi(unsigned w) { return __builtin_bit_cast(float, w & 0xffff0000u); }
__device__ __forceinline__ float fexp2(float x) { return __builtin_amdgcn_exp2f(x); }

__device__ __forceinline__ void tr_item(const float* W, int N, const float* gk, int k0, int n0, bf16* dst, int dstK, LAS float* scr, int lane) {
    const int kr = lane >> 3, n4 = 4 * (lane & 7); f32x4 v[8];
#pragma unroll
    for (int i = 0; i < 8; ++i) v[i] = *(const GAS f32x4*)(W + (size_t)(k0 + 8 * i + kr) * N + n0 + n4);
#pragma unroll
    for (int i = 0; i < 8; ++i) { const int kk = 8 * i + kr; const float g = gk ? gk[k0 + kk] : 1.0f;
        scr[(n4 + 0) * 66 + kk] = v[i].x * g; scr[(n4 + 1) * 66 + kk] = v[i].y * g; scr[(n4 + 2) * 66 + kk] = v[i].z * g; scr[(n4 + 3) * 66 + kk] = v[i].w * g; }
    LDS_WAIT(); asm volatile("" ::: "memory");
    const int c = lane & 7;
#pragma unroll
    for (int j = 0; j < 4; ++j) { const int n = (lane >> 3) + 8 * j; const LAS float* s = scr + n * 66 + 8 * c;
        v4u o; o.x = pk2(s[0], s[1]); o.y = pk2(s[2], s[3]); o.z = pk2(s[4], s[5]); o.w = pk2(s[6], s[7]);
        *(GAS v4u*)(dst + (size_t)n * dstK + 8 * c) = o; }
    LDS_WAIT(); asm volatile("" ::: "memory");
}
__device__ __forceinline__ void tr8_load(const float* W, int N, int k0, int n0, int lane, f32x4 (&v)[8]) {
    const int kr = lane >> 3, n4 = 4 * (lane & 7);
#pragma unroll
    for (int i = 0; i < 8; ++i) v[i] = *(const GAS f32x4*)(W + (size_t)(k0 + 8 * i + kr) * N + n0 + n4);
}
__device__ __forceinline__ void tr8_finish(const f32x4 (&v)[8], const float* gk, float scale, int k0, unsigned char* dst, int dstK, LAS float* scr, int lane) {
    const int kr = lane >> 3, n4 = 4 * (lane & 7);
#pragma unroll
    for (int i = 0; i < 8; ++i) { const int kk = 8 * i + kr; const float g = (gk ? gk[k0 + kk] : 1.0f) * scale;
        scr[(n4 + 0) * 66 + kk] = v[i].x * g; scr[(n4 + 1) * 66 + kk] = v[i].y * g; scr[(n4 + 2) * 66 + kk] = v[i].z * g; scr[(n4 + 3) * 66 + kk] = v[i].w * g; }
    LDS_WAIT(); asm volatile("" ::: "memory");
    const int c = lane & 7;
#pragma unroll
    for (int j = 0; j < 4; ++j) { const int n = (lane >> 3) + 8 * j; const LAS float* s = scr + n * 66 + 8 * c;
        pg8::u32x2 o; o.x = pg8::pk4_fp8(s[0], s[1], s[2], s[3]); o.y = pg8::pk4_fp8(s[4], s[5], s[6], s[7]);
        *(GAS pg8::u32x2*)(dst + (size_t)n * dstK + 8 * c) = o; }
    LDS_WAIT(); asm volatile("" ::: "memory");
}
__device__ __forceinline__ void tr_item8(const float* W, int N, const float* gk, float scale, int k0, int n0, unsigned char* dst, int dstK, LAS float* scr, int lane) {
    f32x4 v[8]; tr8_load(W, N, k0, n0, lane, v); tr8_finish(v, gk, scale, k0, dst, dstK, scr, lane);
}
struct Ptrs {
    const float *x, *g1, *w_in, *lq1, *lk1, *lq2, *lk2, *subg, *cw, *cb, *lng, *lnb, *w_out, *g2, *wgr, *bgr, *wer, *ber, *w_gate, *w_up, *w_down, *gf;
    float* out; unsigned char* ws;
};
__device__ __forceinline__ void p0_prologue(const Ptrs& P, LAS unsigned char* lds, int lane, int wave, int gw, int NGW) {
    LAS float* scr = (LAS float*)(lds + RING_OFF + wave * 16384);
    bf16* WIN = (bf16*)(P.ws + WS_WIN); bf16* WOUT = (bf16*)(P.ws + WS_WOUT);
    constexpr int I_IN = 32 * 160, I_OUT = 32 * 64, NITEMS = I_IN + I_OUT;
    for (int it = gw; it < NITEMS; it += NGW) {
        if (it < I_IN) { const int kb = it / 160, nb = it % 160;
            if (nb < 96) tr_item(P.w_in, NIN, P.g1, 64 * kb, 32 * nb, WIN + (size_t)(32 * nb) * 2048 + 64 * kb, 2048, scr, lane);
            else { const int j0 = 32 * (nb - 96), jj = j0 & 1023, drow = 256 * (jj >> 7) + (jj & 127) + (j0 >= 1024 ? 128 : 0);
                tr_item8(P.w_in, NIN, P.g1, WSCALE, 64 * kb, 32 * nb, P.ws + WS_WIN8 + (size_t)drow * 2048 + 64 * kb, 2048, scr, lane); } }
        else { const int r = it - I_IN, kb = r >> 6, nb = r & 63; tr_item(P.w_out, 2048, nullptr, 64 * kb, 32 * nb, WOUT + (size_t)(32 * nb) * 2048 + 64 * kb, 2048, scr, lane); }
    }
    { bf16* WR = (bf16*)(P.ws + WS_WR);
      for (int it = gw; it < 32; it += NGW) tr_item(P.wer, 32, P.g2, 64 * it, 0, WR + 64 * it, 2048, scr, lane);
      for (int k = gw * 64 + lane; k < 2048; k += NGW * 64) { const float gk = P.g2[k]; const f32x4 w = *(const f32x4*)(P.wgr + (size_t)k * 4);
          WR[(size_t)128 * 2048 + k] = (bf16)f2bf(w.x * gk); WR[(size_t)129 * 2048 + k] = (bf16)f2bf(w.y * gk); WR[(size_t)130 * 2048 + k] = (bf16)f2bf(w.z * gk); WR[(size_t)131 * 2048 + k] = (bf16)f2bf(w.w * gk); } }
    bf16* XB = (bf16*)(P.ws + WS_XB); float* RS1 = (float*)(P.ws + WS_RSTD1);
    for (int m0 = gw; m0 < T; m0 += 2 * NGW) {
        f32x4 v[2][8]; float ss[2] = {0.f, 0.f};
#pragma unroll
        for (int q = 0; q < 2; ++q) { const int mr = (m0 + q * NGW < T) ? m0 + q * NGW : T - 1; const GAS f32x4* xr = (const GAS f32x4*)(P.x + (size_t)mr * D) + lane;
#pragma unroll
            for (int j = 0; j < 8; ++j) v[q][j] = xr[64 * j]; }
#pragma unroll
        for (int q = 0; q < 2; ++q) { const int m = m0 + q * NGW; if (m >= T) continue;
#pragma unroll
            for (int j = 0; j < 8; ++j) ss[q] += (v[q][j].x * v[q][j].x + v[q][j].y * v[q][j].y) + (v[q][j].z * v[q][j].z + v[q][j].w * v[q][j].w);
            ss[q] = wave_sum(ss[q]);
            if (lane == 0) RS1[m] = 1.0f / sqrtf(ss[q] * (1.0f / D) + EPS);
            GAS unsigned long long* o8 = (GAS unsigned long long*)(XB + (size_t)m * D) + lane; GAS unsigned* o4 = (GAS unsigned*)(P.ws + WS_X8 + (size_t)m * D) + lane;
#pragma unroll
            for (int j = 0; j < 8; ++j) { o8[64 * j] = (unsigned long long)pk2(v[q][j].x, v[q][j].y) | ((unsigned long long)pk2(v[q][j].z, v[q][j].w) << 32); o4[64 * j] = pg8::pk4_fp8(v[q][j].x, v[q][j].y, v[q][j].z, v[q][j].w); } }
    }
}

constexpr int CVT_ITEMS = 3 * 32768, CVT_CH = 4, CVT_CHUNK = CVT_CH * NWAVES, CVT_NCHUNK = CVT_ITEMS / CVT_CHUNK;
struct MoeItem { const float* src; const float* gk; unsigned char* dst; int N, k0, n0, dstK; };
__device__ __forceinline__ MoeItem moe_decode(const Ptrs& P, int r) {
    unsigned char* WGU = P.ws + WS_WGU; unsigned char* WD = P.ws + WS_WD; MoeItem m;
    const int mat = r >> 15, r2 = r & 32767, e = r2 >> 10, idx = r2 & 1023;
    if (mat < 2) { const int kb = idx >> 5, n0 = 32 * (idx & 31); const int drow = e * 2048 + 256 * (n0 >> 7) + (n0 & 127) + (mat == 1 ? 128 : 0);
        m.src = (mat == 0 ? P.w_gate : P.w_up) + (size_t)e * 2048 * 1024; m.N = 1024; m.gk = P.g2; m.k0 = 64 * kb; m.n0 = n0; m.dst = WGU + (size_t)drow * 2048 + 64 * kb; m.dstK = 2048; }
    else { const int kb = idx >> 6, nb = idx & 63; m.src = P.w_down + (size_t)e * 1024 * 2048; m.N = 2048; m.gk = nullptr; m.k0 = 64 * kb; m.n0 = 32 * nb; m.dst = WD + ((size_t)e * 2048 + 32 * nb) * 1024 + 64 * kb; m.dstK = 1024; }
    return m;
}
__device__ __forceinline__ void cvt_fill(const Ptrs& P, LAS unsigned char* lds, volatile LAS unsigned* slot, int max_chunks, const unsigned* donew, int G) {
    int tid_ = threadIdx.x; asm volatile("" : "+v"(tid_)); const int lane = tid_ & 63, wave = __builtin_amdgcn_readfirstlane(tid_ >> 6);
    LAS float* scr = (LAS float*)(lds + RING_OFF + wave * 16384); unsigned* ctr = (unsigned*)(P.ws + WS_CTL) + CW_CVQ;
    for (int n = 0; n < max_chunks; ++n) {
        if (threadIdx.x == 0) { unsigned v = 0xffffffffu;
            if (!(donew && (int)__hip_atomic_load(donew, __ATOMIC_RELAXED, __HIP_MEMORY_SCOPE_AGENT) >= G - 16)) v = __hip_atomic_fetch_add(ctr, 1u, __ATOMIC_RELAXED, __HIP_MEMORY_SCOPE_AGENT);
            *slot = v; }
        __syncthreads(); const unsigned c = *slot; __syncthreads();
        if (c >= (unsigned)CVT_NCHUNK) break;
#pragma unroll 1
        for (int j = 0; j < CVT_CH; j += 2) {
            const MoeItem m0 = moe_decode(P, (int)c * CVT_CHUNK + wave * CVT_CH + j), m1 = moe_decode(P, (int)c * CVT_CHUNK + wave * CVT_CH + j + 1);
            f32x4 v0[8], v1[8]; tr8_load(m0.src, m0.N, m0.k0, m0.n0, lane, v0); tr8_load(m1.src, m1.N, m1.k0, m1.n0, lane, v1);
            tr8_finish(v0, m0.gk, WSCALE, m0.k0, m0.dst, m0.dstK, scr, lane); tr8_finish(v1, m1.gk, WSCALE, m1.k0, m1.dst, m1.dstK, scr, lane); }
    }
}
__device__ __forceinline__ void h8_fill(const Ptrs& P, const bf16* HB, unsigned char* H8, volatile LAS unsigned* slot) {
    int tid_ = threadIdx.x; asm volatile("" : "+v"(tid_)); const int lane = tid_ & 63, wave = __builtin_amdgcn_readfirstlane(tid_ >> 6);
    unsigned* ctr = (unsigned*)(P.ws + WS_CTL) + CW_H8Q;
    for (;;) { const int c = attn_body::wg_pop(ctr, slot); if (c >= T / 64) break;
#pragma unroll 1
        for (int j = 0; j < 8; j += 4) { const int r0 = c * 64 + wave * 8 + j; u32x4g a[4][4];
#pragma unroll
            for (int q = 0; q < 4; ++q)
#pragma unroll
                for (int i = 0; i < 4; ++i) a[q][i] = *(const u32x4g*)(HB + (size_t)(r0 + q) * D + 16 * lane + 1024 * (i >> 1) + 8 * (i & 1));
#pragma unroll
            for (int q = 0; q < 4; ++q)
#pragma unroll
                for (int hj = 0; hj < 2; ++hj) { const u32x4g w0 = a[q][2 * hj], w1 = a[q][2 * hj + 1]; v4u o;
                    o.x = pg8::pk4_fp8(bflo(w0.x), bfhi(w0.x), bflo(w0.y), bfhi(w0.y)); o.y = pg8::pk4_fp8(bflo(w0.z), bfhi(w0.z), bflo(w0.w), bfhi(w0.w));
                    o.z = pg8::pk4_fp8(bflo(w1.x), bfhi(w1.x), bflo(w1.y), bfhi(w1.y)); o.w = pg8::pk4_fp8(bflo(w1.z), bfhi(w1.z), bflo(w1.w), bfhi(w1.w));
                    *(v4u*)(H8 + (size_t)(r0 + q) * D + 16 * lane + 1024 * hj) = o; } }
    }
}
__device__ __forceinline__ void phase_tail(const Ptrs& P, LAS unsigned char* lds, volatile LAS unsigned* slot, int ph, int G) {
    unsigned* donew = (unsigned*)(P.ws + WS_CTL) + CW_DONE + 64 * ph;
    __syncthreads();
    if (threadIdx.x == 0) __hip_atomic_fetch_add(donew, 1u, __ATOMIC_RELAXED, __HIP_MEMORY_SCOPE_AGENT);
    cvt_fill(P, lds, slot, 1 << 30, donew, G);
}

__device__ __forceinline__ void naive_attn(const Ptrs& P, const bf16* Q, const bf16* Kb, const bf16* Vb, bf16* MIX, int lane, int gw, int NGW) {
    const float s1 = wave_sum(P.lq1[lane] * P.lk1[lane]), s2 = wave_sum(P.lq2[lane] * P.lk2[lane]);
    const float lam0 = 0.2f, lam = expf(s1) - expf(s2) + lam0;
    const int r16 = lane & 15, c = (lane >> 4) & 1, vh = lane >> 5;
    for (int u = gw; u < 16384; u += NGW) {
        const int bh = u & 63, qb = 255 - (u >> 6), b = bh >> 3, h = bh & 7, i = qb * 16 + r16, jmax = qb * 16 + 15;
        const float sl2 = exp2f(-(float)(h + 1)) * LOG2E; const size_t rowb = (size_t)b * SEQ;
        float q[64], O[64];
        { const u32x4g* qp = (const u32x4g*)(Q + (rowb + i) * 1024 + h * 128 + c * 64);
#pragma unroll
          for (int d8 = 0; d8 < 8; ++d8) { const u32x4g w = qp[d8]; q[8 * d8 + 0] = bflo(w.x); q[8 * d8 + 1] = bfhi(w.x); q[8 * d8 + 2] = bflo(w.y); q[8 * d8 + 3] = bfhi(w.y);
              q[8 * d8 + 4] = bflo(w.z); q[8 * d8 + 5] = bfhi(w.z); q[8 * d8 + 6] = bflo(w.w); q[8 * d8 + 7] = bfhi(w.w); } }
#pragma unroll
        for (int d = 0; d < 64; ++d) O[d] = 0.f;
        float m = -1e30f, l = 0.f;
        for (int j = 0; j <= jmax; ++j) {
            const u32x4g* kp = (const u32x4g*)(Kb + (rowb + j) * 1024 + h * 128 + c * 64); float s = 0.f;
#pragma unroll
            for (int d8 = 0; d8 < 8; ++d8) { const u32x4g w = kp[d8];
                s += q[8 * d8 + 0] * bflo(w.x) + q[8 * d8 + 1] * bfhi(w.x) + q[8 * d8 + 2] * bflo(w.y) + q[8 * d8 + 3] * bfhi(w.y)
                   + q[8 * d8 + 4] * bflo(w.z) + q[8 * d8 + 5] * bfhi(w.z) + q[8 * d8 + 6] * bflo(w.w) + q[8 * d8 + 7] * bfhi(w.w); }
            s += sl2 * (float)(j - i);
            if (j <= i) {
                if (s > m) { const float al = fexp2(m - s); l *= al;
#pragma unroll
                    for (int d = 0; d < 64; ++d) O[d] *= al;
                    m = s; }
                const float p = fexp2(s - m); l += p;
                const u32x4g* vp = (const u32x4g*)(Vb + (rowb + j) * 1024 + h * 128 + vh * 64);
#pragma unroll
                for (int d8 = 0; d8 < 8; ++d8) { const u32x4g w = vp[d8];
                    O[8 * d8 + 0] += p * bflo(w.x); O[8 * d8 + 1] += p * bfhi(w.x); O[8 * d8 + 2] += p * bflo(w.y); O[8 * d8 + 3] += p * bfhi(w.y);
                    O[8 * d8 + 4] += p * bflo(w.z); O[8 * d8 + 5] += p * bfhi(w.z); O[8 * d8 + 6] += p * bflo(w.w); O[8 * d8 + 7] += p * bfhi(w.w); }
            }
        }
        const float il = 1.0f / l; float ss = 0.f;
#pragma unroll
        for (int d = 0; d < 64; ++d) { float o = O[d] * il; const float o2 = __shfl_xor(o, 16); o = o - lam * o2; O[d] = o; ss += o * o; }
        ss += __shfl_xor(ss, 32);
        const float r = (1.0f / sqrtf(ss * (1.0f / 128.0f) + EPS)) * (1.0f - lam0);
        if (c == 0) { u32x4g* op = (u32x4g*)(MIX + (rowb + i) * 2048 + h * 128 + vh * 64); const float* sg = P.subg + vh * 64;
#pragma unroll
            for (int d8 = 0; d8 < 8; ++d8) { u32x4g w; w.x = pk2(O[8 * d8 + 0] * r * sg[8 * d8 + 0], O[8 * d8 + 1] * r * sg[8 * d8 + 1]); w.y = pk2(O[8 * d8 + 2] * r * sg[8 * d8 + 2], O[8 * d8 + 3] * r * sg[8 * d8 + 3]);
                w.z = pk2(O[8 * d8 + 4] * r * sg[8 * d8 + 4], O[8 * d8 + 5] * r * sg[8 * d8 + 5]); w.w = pk2(O[8 * d8 + 6] * r * sg[8 * d8 + 6], O[8 * d8 + 7] * r * sg[8 * d8 + 7]); op[d8] = w; } }
    }
}

typedef float f32x2c __attribute__((ext_vector_type(2)));
__device__ __forceinline__ void conv_phase(const Ptrs& P, const bf16* CA, bf16* MIX, LAS unsigned char* lds, int blk, unsigned* qctr, volatile LAS unsigned* slot) {
    int tid_ = threadIdx.x; asm volatile("" : "+v"(tid_)); const int tid = tid_, lane = tid & 63, wave = __builtin_amdgcn_readfirstlane(tid >> 6);
    LAS unsigned* C = (LAS unsigned*)(lds + RING_OFF);
    f32x2c w[31];
#pragma unroll
    for (int j = 0; j < 31; ++j) w[j] = *(const f32x2c*)(P.cw + j * 1024 + 2 * tid);
    const f32x2c bias = *(const f32x2c*)(P.cb + 2 * tid);
    for (int qi = 0; qi < 8; ++qi) { const int xq = (blk + qi) & 7;
    for (;;) { const int n_ = attn_body::wg_pop(qctr + 64 * xq, slot); if (n_ >= 64) break;
        const int tile = xq + 8 * n_, b = tile >> 6, t0 = (tile & 63) * 64; const size_t rowb = (size_t)b * SEQ;
        const unsigned* up = (const unsigned*)(CA + rowb * 1024 + 2 * tid);
        f32x2c win[38]; unsigned hist[30];
#pragma unroll
        for (int k = 0; k < 30; ++k) { const int t = t0 - 30 + k; hist[k] = (t >= 0) ? up[(size_t)t * 512] : 0u; }
        unsigned nw[8];
#pragma unroll
        for (int i = 0; i < 8; ++i) nw[i] = up[(size_t)(t0 + i) * 512];
#pragma unroll
        for (int k = 0; k < 30; ++k) win[k] = (f32x2c){bflo(hist[k]), bfhi(hist[k])};
#pragma unroll 1
        for (int blk8 = 0; blk8 < 8; ++blk8) {
#pragma unroll
            for (int i = 0; i < 8; ++i) win[30 + i] = (f32x2c){bflo(nw[i]), bfhi(nw[i])};
            if (blk8 < 7) {
#pragma unroll
                for (int i = 0; i < 8; ++i) nw[i] = up[(size_t)(t0 + 8 * (blk8 + 1) + i) * 512];
            }
#pragma unroll
            for (int i = 0; i < 8; ++i) { f32x2c acc = bias;
#pragma unroll
                for (int j = 0; j < 31; ++j) acc = w[j] * win[i + j] + acc;
                C[(8 * blk8 + i) * 512 + tid] = pk2(acc.x, acc.y); }
#pragma unroll
            for (int k = 0; k < 30; ++k) win[k] = win[k + 8];
        }
        __syncthreads();
#pragma unroll 1
        for (int k = 0; k < 8; ++k) { const int rr = wave + 8 * k, t = t0 + rr; const LAS unsigned* row = C + rr * 512;
            const v4u x0 = *(const LAS v4u*)(row + 4 * lane), x1 = *(const LAS v4u*)(row + 256 + 4 * lane);
            float v[16] = {bflo(x0.x), bfhi(x0.x), bflo(x0.y), bfhi(x0.y), bflo(x0.z), bfhi(x0.z), bflo(x0.w), bfhi(x0.w), bflo(x1.x), bfhi(x1.x), bflo(x1.y), bfhi(x1.y), bflo(x1.z), bfhi(x1.z), bflo(x1.w), bfhi(x1.w)};
            float s = 0.f;
#pragma unroll
            for (int i = 0; i < 16; ++i) s += v[i];
            const float mean = wave_sum(s) * (1.0f / 1024.0f); float qq = 0.f;
#pragma unroll
            for (int i = 0; i < 16; ++i) { v[i] -= mean; qq += v[i] * v[i]; }
            const float rstd = 1.0f / sqrtf(wave_sum(qq) * (1.0f / 1024.0f) + EPS);
            float y[16];
#pragma unroll
            for (int i = 0; i < 16; ++i) { const int ch = (i < 8 ? 8 * lane + i : 512 + 8 * lane + (i - 8)); const float z = v[i] * rstd * P.lng[ch] + P.lnb[ch]; y[i] = z / (1.f + __expf(-z)); }
            bf16* op = MIX + (rowb + t) * 2048 + 1024 + 8 * lane;
            v4u o0, o1; o0.x = pk2(y[0], y[1]); o0.y = pk2(y[2], y[3]); o0.z = pk2(y[4], y[5]); o0.w = pk2(y[6], y[7]); o1.x = pk2(y[8], y[9]); o1.y = pk2(y[10], y[11]); o1.z = pk2(y[12], y[13]); o1.w = pk2(y[14], y[15]);
            *(GAS v4u*)op = o0; *(GAS v4u*)(op + 512) = o1; }
        __syncthreads();
    } }
}

__device__ __forceinline__ void router_phase(const Ptrs& P, const bf16* HB, int lane, int gw, int NGW) {
    float* RS2 = (float*)(P.ws + WS_RSTD2); float* WTS = (float*)(P.ws + WS_WTS); int* LIST = (int*)(P.ws + WS_LIST); unsigned* CNT = (unsigned*)(P.ws + WS_CTL) + CW_CNT;
    for (int tok = gw; tok < T; tok += NGW) {
        float hv[32]; const bf16* hp = HB + (size_t)tok * D; float ss = 0.f;
#pragma unroll
        for (int j = 0; j < 4; ++j) { const u32x4g w = *(const u32x4g*)(hp + 8 * lane + 512 * j);
            hv[8 * j + 0] = bflo(w.x); hv[8 * j + 1] = bfhi(w.x); hv[8 * j + 2] = bflo(w.y); hv[8 * j + 3] = bfhi(w.y); hv[8 * j + 4] = bflo(w.z); hv[8 * j + 5] = bfhi(w.z); hv[8 * j + 6] = bflo(w.w); hv[8 * j + 7] = bfhi(w.w); }
#pragma unroll
        for (int k = 0; k < 32; ++k) ss += hv[k] * hv[k];
        ss = wave_sum(ss); const float rstd = 1.0f / sqrtf(ss * (1.0f / D) + EPS);
        float lg[36];
#pragma unroll
        for (int o = 0; o < 36; ++o) lg[o] = 0.f;
#pragma unroll
        for (int j = 0; j < 4; ++j)
#pragma unroll 2
            for (int i = 0; i < 8; ++i) { const int e = 8 * lane + 512 * j + i; const float xv = hv[8 * j + i] * P.g2[e];
                const f32x4* wr = (const f32x4*)(P.wer + (size_t)e * 32); const f32x4 wg = *(const f32x4*)(P.wgr + (size_t)e * 4);
#pragma unroll
                for (int o4 = 0; o4 < 8; ++o4) { const f32x4 w = wr[o4]; lg[4 * o4 + 0] += xv * w.x; lg[4 * o4 + 1] += xv * w.y; lg[4 * o4 + 2] += xv * w.z; lg[4 * o4 + 3] += xv * w.w; }
                lg[32] += xv * wg.x; lg[33] += xv * wg.y; lg[34] += xv * wg.z; lg[35] += xv * wg.w; }
#pragma unroll
        for (int o = 0; o < 36; ++o) lg[o] = wave_sum(lg[o]) * rstd + (o < 32 ? P.ber[o] : P.bgr[o - 32]);
        int gs = 0; float gm = lg[32];
#pragma unroll
        for (int g = 1; g < 4; ++g) if (lg[32 + g] > gm) { gm = lg[32 + g]; gs = g; }
        float gsum = 0.f;
#pragma unroll
        for (int g = 0; g < 4; ++g) gsum += __expf(lg[32 + g] - gm);
        const float gw_ = 1.0f / gsum;
        float ev[8];
#pragma unroll
        for (int i = 0; i < 8; ++i) ev[i] = gs == 0 ? lg[i] : gs == 1 ? lg[8 + i] : gs == 2 ? lg[16 + i] : lg[24 + i];
        int i1 = 0; float v1 = ev[0];
#pragma unroll
        for (int i = 1; i < 8; ++i) if (ev[i] > v1) { v1 = ev[i]; i1 = i; }
        int i2 = -1; float v2 = -3.0e38f;
#pragma unroll
        for (int i = 0; i < 8; ++i) if (i != i1 && ev[i] > v2) { v2 = ev[i]; i2 = i; }
        const float e2 = __expf(v2 - v1), w1 = gw_ / (1.f + e2), w2 = gw_ * e2 / (1.f + e2);
        if (lane == 0) {
            RS2[tok] = rstd;
            const int ea = gs * 8 + i1, eb = gs * 8 + i2;
            const unsigned ra = __hip_atomic_fetch_add(CNT + 64 * ea, 1u, __ATOMIC_RELAXED, __HIP_MEMORY_SCOPE_AGENT);
            const unsigned rb = __hip_atomic_fetch_add(CNT + 64 * eb, 1u, __ATOMIC_RELAXED, __HIP_MEMORY_SCOPE_AGENT);
            LIST[(size_t)ea * T + ra] = 2 * tok; LIST[(size_t)eb * T + rb] = 2 * tok + 1; WTS[2 * tok] = w1; WTS[2 * tok + 1] = w2;
        }
    }
}
__device__ __forceinline__ void moe_tables(const Ptrs& P, LAS unsigned char* lds) {
    int tid = threadIdx.x; asm volatile("" : "+v"(tid));
    LAS int* cntL = (LAS int*)(lds + TAB_OFF); LAS int* ts = cntL + 32; unsigned* CNT = (unsigned*)(P.ws + WS_CTL) + CW_CNT;
    if (tid < 32) cntL[tid] = (int)__hip_atomic_load(CNT + 64 * tid, __ATOMIC_RELAXED, __HIP_MEMORY_SCOPE_AGENT);
    __syncthreads();
    if (tid == 0) { int s = 0; for (int e = 0; e < 32; ++e) { ts[e] = s; s += (cntL[e] + 255) >> 8; } ts[32] = s; }
    __syncthreads();
}

constexpr int STG_OFF = LDSCTL_OFF + 2048, STG_MAXU = 9;
static_assert(STG_OFF + STG_MAXU * (512 + 1024) <= LDS_BYTES, "MoE staging fits above the ring");
template <class Sched> __device__ __forceinline__ void moe_stage(const Sched& S, const int* list, const float* aux, LAS unsigned char* lds) {
    int tid = threadIdx.x; asm volatile("" : "+v"(tid));
    LAS unsigned short* ids = (LAS unsigned short*)(lds + STG_OFF); LAS float* ax = (LAS float*)(lds + STG_OFF + STG_MAXU * 512);
    LAS int* utab = (LAS int*)(lds + TAB_OFF) + 80;
#pragma unroll 1
    for (int o = 0; o < STG_MAXU; ++o) { pg8::Unit u; const bool ok = S.next(o, u); if (tid == 0) { utab[2 * o] = ok ? u.lbase : 0; utab[2 * o + 1] = ok ? u.nvalid : -1; } }
    __syncthreads();
    if (tid < 256) { int av[STG_MAXU]; float xv[STG_MAXU];
#pragma unroll
        for (int o = 0; o < STG_MAXU; ++o) { const int lb = utab[2 * o], nv = utab[2 * o + 1]; av[o] = 0; xv[o] = 0.f; if (nv >= 0) { const int ix = lb + (tid < nv ? tid : 0); av[o] = list[ix]; xv[o] = aux[ix]; } }
#pragma unroll
        for (int o = 0; o < STG_MAXU; ++o) { ids[o * 256 + tid] = (unsigned short)av[o]; ax[o * 256 + tid] = xv[o]; } }
    __syncthreads();
}

__device__ __forceinline__ float fp8f(unsigned w, int i) { return i == 0 ? __builtin_amdgcn_cvt_f32_fp8(w, 0) : i == 1 ? __builtin_amdgcn_cvt_f32_fp8(w, 1) : i == 2 ? __builtin_amdgcn_cvt_f32_fp8(w, 2) : __builtin_amdgcn_cvt_f32_fp8(w, 3); }
__device__ __forceinline__ void final_phase(const Ptrs& P, const bf16* HB, const unsigned char* Y8, int NGW) {
    int tid_ = threadIdx.x; asm volatile("" : "+v"(tid_)); const int lane = tid_ & 63, gw = (int)blockIdx.x * NWAVES + __builtin_amdgcn_readfirstlane(tid_ >> 6);
    for (int tok = gw; tok < T; tok += NGW) {
        const bf16* hp = HB + (size_t)tok * D; const unsigned char* y1 = Y8 + (size_t)tok * 4096; const unsigned char* y2 = y1 + 2048; float v[32]; float ss = 0.f;
#pragma unroll
        for (int j = 0; j < 4; ++j) { const int o = 8 * lane + 512 * j; const u32x4g a = *(const u32x4g*)(hp + o); const pg8::u32x2 b = *(const pg8::u32x2*)(y1 + o), c = *(const pg8::u32x2*)(y2 + o);
            const float ys = 1.0f / YSCALE;
            v[8 * j + 0] = bflo(a.x) + (fp8f(b.x, 0) + fp8f(c.x, 0)) * ys; v[8 * j + 1] = bfhi(a.x) + (fp8f(b.x, 1) + fp8f(c.x, 1)) * ys; v[8 * j + 2] = bflo(a.y) + (fp8f(b.x, 2) + fp8f(c.x, 2)) * ys; v[8 * j + 3] = bfhi(a.y) + (fp8f(b.x, 3) + fp8f(c.x, 3)) * ys;
            v[8 * j + 4] = bflo(a.z) + (fp8f(b.y, 0) + fp8f(c.y, 0)) * ys; v[8 * j + 5] = bfhi(a.z) + (fp8f(b.y, 1) + fp8f(c.y, 1)) * ys; v[8 * j + 6] = bflo(a.w) + (fp8f(b.y, 2) + fp8f(c.y, 2)) * ys; v[8 * j + 7] = bfhi(a.w) + (fp8f(b.y, 3) + fp8f(c.y, 3)) * ys; }
#pragma unroll
        for (int k = 0; k < 32; ++k) ss += v[k] * v[k];
        ss = wave_sum(ss); const float rstd = 1.0f / sqrtf(ss * (1.0f / D) + EPS);
        float* op = P.out + (size_t)tok * D;
#pragma unroll
        for (int j = 0; j < 4; ++j) { const int o = 8 * lane + 512 * j; const f32x4 g0 = *(const f32x4*)(P.gf + o), g1 = *(const f32x4*)(P.gf + o + 4);
            f32x4 r0 = {v[8 * j + 0] * rstd * g0.x, v[8 * j + 1] * rstd * g0.y, v[8 * j + 2] * rstd * g0.z, v[8 * j + 3] * rstd * g0.w};
            f32x4 r1 = {v[8 * j + 4] * rstd * g1.x, v[8 * j + 5] * rstd * g1.y, v[8 * j + 6] * rstd * g1.z, v[8 * j + 7] * rstd * g1.w};
            *(f32x4*)(op + o) = r0; *(f32x4*)(op + o + 4) = r1; }
    }
}

struct Args { const float* in[22]; float* out; unsigned char* ws; int ph_lo, ph_hi; };
__global__ void __launch_bounds__(NWAVES * 64, 2) fwd(Args args) {
    extern __shared__ __attribute__((aligned(16))) unsigned char lds_raw[];
    LAS unsigned char* lds = (LAS unsigned char*)lds_raw;
    volatile LAS unsigned* MISC = (volatile LAS unsigned*)(lds + MISC_OFF);
    const int tid = threadIdx.x, lane = tid & 63, wave = __builtin_amdgcn_readfirstlane(tid >> 6), G = gridDim.x;
    const int gw = blockIdx.x * NWAVES + wave, NGW = G * NWAVES;
    Ptrs P;
    P.x = args.in[0]; P.g1 = args.in[1]; P.w_in = args.in[2]; P.lq1 = args.in[3]; P.lk1 = args.in[4]; P.lq2 = args.in[5]; P.lk2 = args.in[6]; P.subg = args.in[7];
    P.cw = args.in[8]; P.cb = args.in[9]; P.lng = args.in[10]; P.lnb = args.in[11]; P.w_out = args.in[12]; P.g2 = args.in[13]; P.wgr = args.in[14]; P.bgr = args.in[15];
    P.wer = args.in[16]; P.ber = args.in[17]; P.w_gate = args.in[18]; P.w_up = args.in[19]; P.w_down = args.in[20]; P.gf = args.in[21]; P.out = args.out; P.ws = args.ws;
    unsigned char* ws = args.ws;
    bf16* WIN = (bf16*)(ws + WS_WIN); bf16* WOUT = (bf16*)(ws + WS_WOUT); unsigned char* WGU = ws + WS_WGU; unsigned char* WD = ws + WS_WD;
    bf16* XB = (bf16*)(ws + WS_XB); unsigned char* H1 = ws + WS_XB; unsigned char* HB8 = ws + WS_HB8; bf16* CGB = (bf16*)(ws + WS_CG); bf16* MIX = (bf16*)(ws + WS_MIX); bf16* HB = (bf16*)(ws + WS_HB);
    bf16* QB = (bf16*)args.out; bf16* KB = QB + (size_t)T * 1024; bf16* VB = KB + (size_t)T * 1024; bf16* CAB = VB + (size_t)T * 1024; bf16* YB = (bf16*)args.out;
    for (int u = tid; u < (LDS_BYTES - LDSCTL_OFF) / 4; u += NWAVES * 64) ((LAS unsigned*)(lds + LDSCTL_OFF))[u] = 0u;
    __syncthreads();
    const int lo = args.ph_lo, hi = args.ph_hi;
    XcdBarrier bar; bar.bar = (unsigned*)(ws + WS_CTL) + CW_BAR; bar.x = 0; bar.st = nullptr;
    if (hi - lo > 1) bar = xcd_barrier_post((unsigned*)(ws + WS_CTL) + CW_BAR, MISC + 8);
#define IN(k) (lo <= (k) && (k) < hi)
#if PROBE_PHASE >= 0
    unsigned long long pst_[NPHASE + 1]; pst_[0] = __builtin_amdgcn_s_memrealtime();
#define SEAM(k) do { if (IN(k) && IN((k) + 1)) xcd_barrier(bar); pst_[(k) + 1] = __builtin_amdgcn_s_memrealtime(); } while (0)
#else
#define SEAM(k) do { if (IN(k) && IN((k) + 1)) xcd_barrier(bar); } while (0)
#endif
#define REP(k) for (int rep_ = 0; rep_ <= ((PROBE_DOUBLE >> (k)) & 1); ++rep_)

    if (IN(0)) REP(0) { p0_prologue(P, lds, lane, wave, gw, NGW); }
    SEAM(0);
#if PROBE_CLOCK
    const long long pc0 = clock64(), pr0 = wall_clock64();
#endif
    if (IN(1)) {
        cvt_fill(P, lds, MISC + 12, (int)((blockIdx.x >> 3) % 8), nullptr, G);
        for (int pass = 0; pass < 2; ++pass) {
            if ((pass ^ (int)(blockIdx.x & 1)) == 0) { pg8::Gemm g{XB, WIN, 1, 3072, D, (unsigned*)(ws + WS_CTL) + 3002}; pg8::DynDense S; S.init(T, 3072, (unsigned*)(ws + WS_CTL) + CW_GQ + 0 * 512, (volatile LAS int*)(MISC + 16), (int)blockIdx.x);
                pg8::EpiIn E{QB, (size_t)T * 1024, CGB, (const float*)(ws + WS_RSTD1), C2, (unsigned*)(ws + WS_CTL) + CW_NMAX, 0, 1.0f};
                pg8::gemm_phase<pg8::EpiIn, pg8::DynDense, true, false>(lds + RING_OFF, g, S, E); }
            else { pg8::Gemm g{(const bf16*)(ws + WS_X8), (const bf16*)(ws + WS_WIN8), 2, 2048, D / 2, (unsigned*)(ws + WS_CTL) + 3002}; pg8::DynDenseG S; S.init(T, 2048, (unsigned*)(ws + WS_CTL) + CW_GQ + 1 * 512, (volatile LAS int*)(MISC + 16), (int)blockIdx.x);
                pg8::EpiGLU E{CAB, (const float*)(ws + WS_RSTD1), 1.0f / WSCALE};
                pg8::gemm_phase<pg8::EpiGLU, pg8::DynDenseG, true, true, true>(lds + RING_OFF, g, S, E); }
        }
#if PROBE_ATT == 6
        if (threadIdx.x == 0) atomicMax((unsigned*)(ws + WS_CTL) + CW_NMAX + 900, (unsigned)(__builtin_amdgcn_s_memrealtime() - pst_[1]));
#endif
#if PROBE_ATT == 7
        if (threadIdx.x == 0) atomicAdd((unsigned*)(ws + WS_CTL) + CW_NMAX + 900, (unsigned)(__builtin_amdgcn_s_memrealtime() - pst_[1]) >> 8);
#endif
#if PROBE_ATT == 5
        if (blockIdx.x == PROBE_BLK && threadIdx.x == 0) atomicAdd((unsigned*)(ws + WS_CTL) + CW_NMAX + 900, (unsigned)(__builtin_amdgcn_s_memrealtime() - pst_[1]));
#endif
        phase_tail(P, lds, MISC + 12, 1, G);
    }
#if PROBE_CLOCK
    if (IN(1) && tid == 0) { const unsigned dt = (unsigned)(wall_clock64() - pr0); atomicAdd((unsigned*)(ws + WS_CTL) + 3000, dt); atomicMax((unsigned*)(ws + WS_CTL) + 3001, dt); }
#endif
    SEAM(1);
    if (IN(2)) {
#if USE_NAIVE_ATTN
        naive_attn(P, QB, KB, VB, MIX, lane, gw, NGW);
#else
        { float s1 = 0.f, s2 = 0.f;
          for (int i = 0; i < 64; ++i) { s1 += P.lq1[i] * P.lk1[i]; s2 += P.lq2[i] * P.lk2[i]; }
          const float lam0 = 0.2f, lam = expf(s1) - expf(s2) + lam0;
          static_assert(attn_body::ATTN_LDS_BYTES <= RING_BYTES, "attention LDS");
          attn_body::attn_phase<8>((char*)lds_raw + RING_OFF, (int)blockIdx.x, (unsigned*)(ws + WS_CTL) + CW_QA, MISC + 12, lam, 1.0f - lam0, P.subg, (const unsigned*)(ws + WS_CTL) + CW_NMAX, (unsigned*)(ws + WS_O1S) + (size_t)blockIdx.x * 16384,
                                   (const attn_body::bf16*)QB, (const attn_body::bf16*)KB, (const attn_body::bf16*)VB, (attn_body::bf16*)MIX); }
#endif
        conv_phase(P, CAB, MIX, lds, (int)blockIdx.x, (unsigned*)(ws + WS_CTL) + CW_QC, MISC + 12);
#if PROBE_ATT == 2
        if (blockIdx.x == PROBE_BLK && threadIdx.x == 0) atomicAdd((unsigned*)(ws + WS_CTL) + CW_NMAX + 900, (unsigned)(__builtin_amdgcn_s_memrealtime() - pst_[2]));
#endif
        phase_tail(P, lds, MISC + 12, 2, G);
    }
    SEAM(2);
    if (IN(3)) {
        pg8::Gemm g{MIX, WOUT, 3, D, D, (unsigned*)(ws + WS_CTL) + 3002}; pg8::StaticOrder S; S.init(T, D, G, (int)blockIdx.x); S.rep = 1 + ((PROBE_DOUBLE >> 3) & 1);
        pg8::EpiOut E{HB, XB, (float*)(ws + WS_PART), nullptr};
        pg8::gemm_phase<pg8::EpiOut, pg8::StaticOrder, true, false>(lds + RING_OFF, g, S, E);
        phase_tail(P, lds, MISC + 12, 3, G);
    }
    SEAM(3);
#if PROBE_ATT == 9
    if (IN(4) && blockIdx.x == PROBE_BLK && threadIdx.x == 0) atomicAdd((unsigned*)(ws + WS_CTL) + CW_NMAX + 900, 10u * __hip_atomic_load((unsigned*)(ws + WS_CTL) + CW_CVQ, __ATOMIC_RELAXED, __HIP_MEMORY_SCOPE_AGENT));
#endif
#if USE_NAIVE_ROUTER
    if (IN(4)) { router_phase(P, HB, lane, gw, NGW); }
#else
    if (IN(4)) {
        pg8::Gemm g{HB, (const bf16*)(ws + WS_WR), T, 256, D}; pg8::StaticOrder S; S.init(T, 256, G, (int)blockIdx.x);
        pg8::EpiRouter E{(const float*)(ws + WS_PART), P.ber, P.bgr, (float*)(ws + WS_LISTR), (float*)(ws + WS_LISTW), (int*)(ws + WS_LIST), (unsigned*)(ws + WS_CTL) + CW_CNT, T};
        pg8::gemm_phase<pg8::EpiRouter, pg8::StaticOrder, true, false>(lds + RING_OFF, g, S, E);
        h8_fill(P, HB, HB8, MISC + 12);
        phase_tail(P, lds, MISC + 12, 4, G);
#if PROBE_ATT == 8
        if (blockIdx.x == PROBE_BLK && threadIdx.x == 0) atomicAdd((unsigned*)(ws + WS_CTL) + CW_NMAX + 900, 10u * __hip_atomic_load((unsigned*)(ws + WS_CTL) + CW_CVQ, __ATOMIC_RELAXED, __HIP_MEMORY_SCOPE_AGENT));
#endif
        cvt_fill(P, lds, MISC + 12, 1 << 30, nullptr, G);
    }
#endif
    SEAM(4);
    if (IN(5)) {
        moe_tables(P, lds);
        pg8::Gemm g{(const bf16*)HB8, (const bf16*)WGU, 5, 2048, D / 2, (unsigned*)(ws + WS_CTL) + 3002};
        pg8::MoeOrder S{(const LAS int*)(lds + TAB_OFF) + 32, (const LAS int*)(lds + TAB_OFF), (const int*)(ws + WS_LIST), G, (int)blockIdx.x, 1, T, (size_t)2048 * 2048, 0, (const LAS unsigned short*)(lds + STG_OFF)};
        moe_stage(S, (const int*)(ws + WS_LIST), (const float*)(ws + WS_LISTR), lds);
        pg8::EpiGU E{H1, (const LAS float*)(lds + STG_OFF + STG_MAXU * 512), 1.0f / WSCALE, H1SCALE};
        pg8::gemm_phase<pg8::EpiGU, pg8::MoeOrder, true, true, true>(lds + RING_OFF, g, S, E);
    }
    SEAM(5);
    if (IN(6)) {
        moe_tables(P, lds);
        pg8::Gemm g{(const bf16*)H1, (const bf16*)WD, 6, 2048, 512, (unsigned*)(ws + WS_CTL) + 3002};
        pg8::MoeOrder S{(const LAS int*)(lds + TAB_OFF) + 32, (const LAS int*)(lds + TAB_OFF), (const int*)(ws + WS_LIST), G, (int)blockIdx.x, 0, T, (size_t)2048 * 1024, 1, (const LAS unsigned short*)(lds + STG_OFF)};
        moe_stage(S, (const int*)(ws + WS_LIST), (const float*)(ws + WS_LISTW), lds);
        pg8::EpiDown E{ws + WS_MIX, (const LAS unsigned short*)(lds + STG_OFF), (const LAS float*)(lds + STG_OFF + STG_MAXU * 512), YSCALE / (WSCALE * H1SCALE)};
        pg8::gemm_phase<pg8::EpiDown, pg8::MoeOrder, true, true, true>(lds + RING_OFF, g, S, E);
    }
    SEAM(6);
    if (IN(7)) { final_phase(P, HB, ws + WS_MIX, NGW); }
#if PROBE_ATT
    if (blockIdx.x == 0) { const unsigned long long span = __hip_atomic_load((unsigned*)(ws + WS_CTL) + CW_NMAX + 900, __ATOMIC_RELAXED, __HIP_MEMORY_SCOPE_AGENT); const unsigned long long r1 = __builtin_amdgcn_s_memrealtime(); while (__builtin_amdgcn_s_memrealtime() - r1 < span) __builtin_amdgcn_s_sleep(8); }
#endif
#if PROBE_PHASE >= 0
    pst_[NPHASE] = __builtin_amdgcn_s_memrealtime();
    if (blockIdx.x == 0 && PROBE_PHASE < 100) { const unsigned long long span = pst_[(PROBE_PHASE < 100 ? PROBE_PHASE : 0) + 1] - pst_[PROBE_PHASE < 100 ? PROBE_PHASE : 0]; const unsigned long long r1 = __builtin_amdgcn_s_memrealtime(); while (__builtin_amdgcn_s_memrealtime() - r1 < span) __builtin_amdgcn_s_sleep(8); }
#endif
#if PROBE_KLOOP
    if (blockIdx.x == 0) { const long long pticks = (long long)__hip_atomic_load((unsigned*)(ws + WS_CTL) + 3002, __ATOMIC_RELAXED, __HIP_MEMORY_SCOPE_AGENT); const long long r1 = wall_clock64(); while (wall_clock64() - r1 < pticks) __builtin_amdgcn_s_sleep(8); }
#endif
#if PROBE_CLOCK
    if (blockIdx.x == 0) { const unsigned sum = __hip_atomic_load((unsigned*)(ws + WS_CTL) + 3000, __ATOMIC_RELAXED, __HIP_MEMORY_SCOPE_AGENT), mx = __hip_atomic_load((unsigned*)(ws + WS_CTL) + 3001, __ATOMIC_RELAXED, __HIP_MEMORY_SCOPE_AGENT);
        const long long pticks = (long long)mx - (long long)(sum / (unsigned)G); const long long r1 = wall_clock64(); while (wall_clock64() - r1 < pticks) __builtin_amdgcn_s_sleep(8); }
#endif
#undef IN
#undef SEAM
#undef REP
}

extern "C" void kernel_launch(void* const* d_in, const int* in_sizes, int n_in, void* d_out, int out_size, void* d_ws, size_t ws_size, hipStream_t stream) {
    static int grid = 0;
    if (grid == 0) {
        if (n_in != 22 || in_sizes[0] != T * D || out_size != T * D || ws_size < WS_END) { fprintf(stderr, "kernel_launch: unexpected shapes (n_in %d, in0 %d, out %d, ws %zu); nothing launched\n", n_in, n_in > 0 ? in_sizes[0] : -1, out_size, ws_size); grid = -1; return; }
        int dev = 0, cus = 0, per_cu = 0;
        if (hipGetDevice(&dev) != hipSuccess || hipDeviceGetAttribute(&cus, hipDeviceAttributeMultiprocessorCount, dev) != hipSuccess) { grid = -1; return; }
        if (hipFuncSetAttribute((const void*)fwd, hipFuncAttributeMaxDynamicSharedMemorySize, LDS_BYTES) != hipSuccess) { fprintf(stderr, "kernel_launch: hipFuncSetAttribute failed\n"); grid = -1; return; }
        if (hipOccupancyMaxActiveBlocksPerMultiprocessor(&per_cu, (const void*)fwd, NWAVES * 64, LDS_BYTES) != hipSuccess || per_cu < 1) fprintf(stderr, "kernel_launch: occupancy query reports %d\n", per_cu);
        (void)hipGetLastError();
        grid = cus;
    }
    if (grid < 0) return;
    if (hipMemsetAsync((char*)d_ws + WS_CTL, 0, CTL_ZERO_BYTES, stream) != hipSuccess) return;
    Args a{};
    for (int i = 0; i < 22; ++i) a.in[i] = (const float*)d_in[i];
    a.out = (float*)d_out; a.ws = (unsigned char*)d_ws;
#if MK_ONE_LAUNCH
    a.ph_lo = 0; a.ph_hi = NPHASE;
    hipLaunchKernelGGL(fwd, dim3(grid), dim3(NWAVES * 64), LDS_BYTES, stream, a);
#else
    for (int p = 0; p < NPHASE; ++p) { a.ph_lo = p; a.ph_hi = p + 1; hipLaunchKernelGGL(fwd, dim3(grid), dim3(NWAVES * 64), LDS_BYTES, stream, a); }
#endif
}
```

```cpp
#include <hip/hip_runtime.h>
#include <cstdio>
#include <cstdint>
#ifndef PROBE_KLOOP
#define PROBE_KLOOP 0
#endif
#ifndef PROBE_WHAT
#define PROBE_WHAT 0
#endif
#ifndef PROBE_PHASE
#define PROBE_PHASE -1
#endif
#ifndef PROBE_ATT
#define PROBE_ATT 0
#endif
#ifndef PROBE_BLK
#define PROBE_BLK 0
#endif
namespace pg8 {
#define PG8_LAS __attribute__((address_space(3)))
typedef unsigned short bf16_t;
typedef short bf16x8 __attribute__((ext_vector_type(8)));
typedef float f32x4 __attribute__((ext_vector_type(4)));
typedef unsigned u32x4 __attribute__((ext_vector_type(4)));
constexpr int BM = 256, BK = 64, HALF = 128, HTB = HALF * BK * 2  , STAGE_BYTES = 8 * HTB, NXCD = 8, WGM = 8;

__host__ __device__ __forceinline__ int lds_byte(int r, int c) { const int st = (r >> 4) * 2 + (c >> 5), rr = r & 15, cc = c & 31, ob = rr * 64 + cc * 2; return st * 1024 + (ob ^ (((ob >> 9) & 1) << 5)); }
__host__ __device__ __forceinline__ void stage_rc(int b, int& R, int& C) { const int st = b / 1024, sb = b % 1024, swz = sb ^ (((sb >> 9) & 1) << 5); R = (st >> 1) * 16 + swz / 64; C = (st & 1) * 32 + (swz % 64) / 2; }
__host__ __device__ __forceinline__ int perm32(int rho) { const int n = rho >> 4, i = rho & 15; return 8 * (i >> 2) + 4 * n + (i & 3); }

struct Unit { int pm, pn, e, nvalid, lbase, srow; };
struct Gemm { const bf16_t* A; const bf16_t* Bt; int M, N, K; unsigned* probe = nullptr; };

struct StaticOrder {
    int nM, nN, nwg, G, c, rep = 1;
    __host__ __device__ void init(int M, int N, int G_, int c_) { nM = M / BM; nN = N / BM; nwg = nM * nN; G = G_; c = c_; }
    __host__ __device__ bool next(int i, Unit& u) const {
        long L = (long)i * G + c; if (L >= (long)nwg * rep) return false; L %= nwg;
        int wgid = (int)L; { const int q = nwg / NXCD, r = nwg % NXCD, xcd = wgid % NXCD, off = wgid / NXCD; wgid = (xcd < r ? xcd * (q + 1) : r * (q + 1) + (xcd - r) * q) + off; }
        const int nig = WGM * nN, gid = wgid / nig, fm = gid * WGM, gsz = (nM - fm) < WGM ? (nM - fm) : WGM;
        u.pm = fm + ((wgid % nig) % gsz); u.pn = (wgid % nig) / gsz; return true;
    }
    __device__ __forceinline__ const char* bbase(const Gemm& g, const Unit& u, size_t tstep) const { return (const char*)g.Bt + (size_t)u.pn * tstep; }
    __device__ __forceinline__ unsigned goff(const Unit&, int, int, int) const { return 0u; }
    __device__ __forceinline__ void a_ready(const Unit&) const {}
    __device__ __forceinline__ void done(const Unit&) const {}
};

struct StaticOrderG : StaticOrder {
    __device__ __forceinline__ unsigned goff(const Unit& u, int r, int C, int K) const { return ((unsigned)(u.pm * BM + r) * (unsigned)K + (unsigned)C) * 2u; }
};

struct MoeOrder {
    const PG8_LAS int* tstart; const PG8_LAS int* cnt; const int* list; int G, c, shift, lcap; size_t estride; int sorted;
    __device__ __forceinline__ bool next(int i, Unit& u) const {
        const int ntiles = tstart[32]; const int x = c & 7, k = i * (G >> 3) + (c >> 3); const int rt = 2 * (k >> 1) + (x & 1); if (rt >= ntiles) return false;
        int e = 0;
#pragma unroll
        for (int q = 1; q < 32; ++q) e += (tstart[q] <= rt) ? 1 : 0;
        e = __builtin_amdgcn_readfirstlane(e);
        const int pm = __builtin_amdgcn_readfirstlane(rt - tstart[e]); const int rem = __builtin_amdgcn_readfirstlane(cnt[e]) - 256 * pm;
        u.pm = pm; u.pn = 2 * (x >> 1) + (k & 1); u.e = e; u.nvalid = rem < 256 ? rem : 256; u.lbase = e * lcap + 256 * pm; u.srow = 256 * rt; return true;
    }
    __device__ __forceinline__ const char* bbase(const Gemm& g, const Unit& u, size_t tstep) const { return (const char*)g.Bt + (size_t)u.e * estride + (size_t)u.pn * tstep; }
    __device__ __forceinline__ unsigned goff(const Unit& u, int r, int C, int K) const {
        if (sorted) return ((unsigned)(u.srow + r) * (unsigned)K + (unsigned)C) * 2u;
        const int a = list[u.lbase + (r < u.nvalid ? r : 0)];
        return ((unsigned)(a >> shift) * (unsigned)K + (unsigned)C) * 2u;
    }
    __device__ __forceinline__ void a_ready(const Unit&) const {}
    __device__ __forceinline__ void done(const Unit&) const {}
};

struct DynQ {
    unsigned* ctr; volatile PG8_LAS int* slot; int x0, qi; unsigned pend;
    __device__ __forceinline__ void qinit(unsigned* ctr_, volatile PG8_LAS int* slot_, int bx) { ctr = ctr_; slot = slot_; x0 = bx & 7; qi = 0; pend = 0u;
        if (threadIdx.x == 0) pend = __hip_atomic_fetch_add(ctr + 64 * x0, 1u, __ATOMIC_RELAXED, __HIP_MEMORY_SCOPE_AGENT); }
    template <class SizeF> __device__ __forceinline__ int qnext(int i, const SizeF& size_of) {
        const int par = i & 1;
        if (threadIdx.x == 0) { int res = -1;
            while (qi < 8) { const int x = (x0 + qi) & 7; if (pend < (unsigned)size_of(x)) { res = (x << 24) | (int)pend; break; }
                ++qi; if (qi < 8) pend = __hip_atomic_fetch_add(ctr + 64 * ((x0 + qi) & 7), 1u, __ATOMIC_RELAXED, __HIP_MEMORY_SCOPE_AGENT); }
            slot[par] = res;
            if (res >= 0) pend = __hip_atomic_fetch_add(ctr + 64 * ((x0 + qi) & 7), 1u, __ATOMIC_RELAXED, __HIP_MEMORY_SCOPE_AGENT); }
        asm volatile("s_waitcnt lgkmcnt(0)" ::: "memory"); __builtin_amdgcn_s_barrier(); asm volatile("" ::: "memory");
        return __builtin_amdgcn_readfirstlane(slot[par]);
    }
};
struct DynDense : DynQ {
    int nM, nN, nwg;
    __device__ __forceinline__ void init(int M, int N, unsigned* ctr_, volatile PG8_LAS int* slot_, int bx) { nM = M / BM; nN = N / BM; nwg = nM * nN; qinit(ctr_, slot_, bx); }
    __device__ __forceinline__ bool next(int i, Unit& u) {
        const int q = nwg / NXCD, r = nwg % NXCD;
        const int code = qnext(i, [=](int x) { return q + (x < r ? 1 : 0); }); if (code < 0) return false;
        const int x = code >> 24, k = code & 0xffffff; const int wgid = (x < r ? x * (q + 1) : r * (q + 1) + (x - r) * q) + k;
        const int nig = WGM * nN, gid = wgid / nig, fm = gid * WGM, gsz = (nM - fm) < WGM ? (nM - fm) : WGM;
        u.pm = fm + ((wgid % nig) % gsz); u.pn = (wgid % nig) / gsz; return true;
    }
    __device__ __forceinline__ const char* bbase(const Gemm& g, const Unit& u, size_t tstep) const { return (const char*)g.Bt + (size_t)u.pn * tstep; }
    __device__ __forceinline__ unsigned goff(const Unit&, int, int, int) const { return 0u; }
    __device__ __forceinline__ void a_ready(const Unit&) const {}
    __device__ __forceinline__ void done(const Unit&) const {}
};
struct DynDenseG : DynDense {
    __device__ __forceinline__ unsigned goff(const Unit& u, int r, int C, int K) const { return ((unsigned)(u.pm * BM + r) * (unsigned)K + (unsigned)C) * 2u; }
};

__device__ __forceinline__ unsigned cvt_pk_bf16(float lo, float hi) { unsigned r; asm volatile("v_cvt_pk_bf16_f32 %0, %1, %2" : "=v"(r) : "v"(lo), "v"(hi)); return r; }
__device__ __forceinline__ float bf_lo(unsigned w) { return __builtin_bit_cast(float, w << 16); }
__device__ __forceinline__ float bf_hi(unsigned w) { return __builtin_bit_cast(float, w & 0xffff0000u); }
__device__ __forceinline__ unsigned pk4_fp8(float a, float b, float c, float d) {
    a = __builtin_amdgcn_fmed3f(a, -440.f, 440.f); b = __builtin_amdgcn_fmed3f(b, -440.f, 440.f); c = __builtin_amdgcn_fmed3f(c, -440.f, 440.f); d = __builtin_amdgcn_fmed3f(d, -440.f, 440.f);
    int r = __builtin_amdgcn_cvt_pk_fp8_f32(a, b, 0, false); r = __builtin_amdgcn_cvt_pk_fp8_f32(c, d, r, true); return (unsigned)r; }
typedef unsigned u32x2 __attribute__((ext_vector_type(2)));
__device__ __forceinline__ void swap16(u32x2& a, u32x2& b) { auto r0 = __builtin_amdgcn_permlane16_swap(a.x, b.x, false, false); auto r1 = __builtin_amdgcn_permlane16_swap(a.y, b.y, false, false); a = (u32x2){r0[0], r1[0]}; b = (u32x2){r0[1], r1[1]}; }
typedef int v4i_t __attribute__((ext_vector_type(4)));

struct EpiIn {
    static constexpr bool PERM = true, AFTER_DRAIN = false;
    bf16_t* P0; size_t stride; bf16_t* CG; const float* rstd; float scale0; unsigned* nmax; int tbase; float oscale;
    __device__ __forceinline__ void operator()(const f32x4 (&acc)[2][2][4][2], const Unit& u, int wr, int wc, int fr, int fq) const {
        const int row0 = u.pm * BM + wr * 64 + fr, t = (u.pn >> 2) + tbase; bf16_t* base = (t < 4) ? P0 + (size_t)t * stride : CG;
        const float sc = ((t == 0) ? scale0 : 1.f) * oscale; const int col0 = (u.pn & 3) * BM + wc * 32 + 8 * fq;
        float mx[2] = {0.f, 0.f}; float rsv[2][4];
#pragma unroll
        for (int ai = 0; ai < 2; ++ai)
#pragma unroll
            for (int m = 0; m < 4; ++m) rsv[ai][m] = rstd[row0 + ai * HALF + m * 16];
#pragma unroll
        for (int ai = 0; ai < 2; ++ai)
#pragma unroll
            for (int m = 0; m < 4; ++m) { const int row = row0 + ai * HALF + m * 16; const float rs = rsv[ai][m] * sc; bf16_t* rowp = base + (size_t)row * 1024 + col0;
#pragma unroll
                for (int bj = 0; bj < 2; ++bj) { const f32x4 v0 = acc[ai][bj][m][0] * rs, v1 = acc[ai][bj][m][1] * rs;
                    u32x4 w; w.x = cvt_pk_bf16(v0[0], v0[1]); w.y = cvt_pk_bf16(v0[2], v0[3]); w.z = cvt_pk_bf16(v1[0], v1[1]); w.w = cvt_pk_bf16(v1[2], v1[3]);
                    *(u32x4*)(rowp + bj * HALF) = w;
                    if (t < 2) { float ss = (v0[0] * v0[0] + v0[1] * v0[1]) + (v0[2] * v0[2] + v0[3] * v0[3]) + (v1[0] * v1[0] + v1[1] * v1[1]) + (v1[2] * v1[2] + v1[3] * v1[3]);
                        ss += __shfl_xor(ss, 16); ss += __shfl_xor(ss, 32); mx[bj] = __builtin_fmaxf(mx[bj], ss); } } }
        if (t < 2) {
#pragma unroll
            for (int bj = 0; bj < 2; ++bj) { float v = mx[bj];
                v = __builtin_fmaxf(v, __shfl_xor(v, 1)); v = __builtin_fmaxf(v, __shfl_xor(v, 2)); v = __builtin_fmaxf(v, __shfl_xor(v, 4)); v = __builtin_fmaxf(v, __shfl_xor(v, 8));
                const int colb = (u.pn & 3) * BM + bj * HALF + wc * 32, g64 = colb >> 6, bh = (u.pm >> 4) * 8 + (g64 >> 1);
                if (fr == 0 && fq == 0) atomicMax(nmax + ((t * 64 + bh) * 2 + (g64 & 1)) * 2 + (wc & 1), __builtin_bit_cast(unsigned, v)); }
        }
    }
};
struct EpiGLU {
    static constexpr bool PERM = true, AFTER_DRAIN = false;
    bf16_t* U; const float* rstd; float oscale;
    __device__ __forceinline__ void operator()(const f32x4 (&acc)[2][2][4][2], const Unit& u, int wr, int wc, int fr, int fq) const {
        const int row0 = u.pm * BM + wr * 64 + fr, col0 = u.pn * HALF + wc * 32 + 8 * fq; float rsv[2][4];
#pragma unroll
        for (int ai = 0; ai < 2; ++ai)
#pragma unroll
            for (int m = 0; m < 4; ++m) rsv[ai][m] = rstd[row0 + ai * HALF + m * 16];
#pragma unroll
        for (int ai = 0; ai < 2; ++ai)
#pragma unroll
            for (int m = 0; m < 4; ++m) { const int row = row0 + ai * HALF + m * 16; const float rs = rsv[ai][m] * oscale;
                const f32x4 a0 = acc[ai][0][m][0] * rs, a1 = acc[ai][0][m][1] * rs, g0 = acc[ai][1][m][0] * rs, g1 = acc[ai][1][m][1] * rs;
#define PG8_SG(x) __builtin_amdgcn_rcpf(1.f + __builtin_amdgcn_exp2f(-1.4426950408889634f * (x)))
                u32x4 w; w.x = cvt_pk_bf16(a0[0] * PG8_SG(g0[0]), a0[1] * PG8_SG(g0[1])); w.y = cvt_pk_bf16(a0[2] * PG8_SG(g0[2]), a0[3] * PG8_SG(g0[3]));
                w.z = cvt_pk_bf16(a1[0] * PG8_SG(g1[0]), a1[1] * PG8_SG(g1[1])); w.w = cvt_pk_bf16(a1[2] * PG8_SG(g1[2]), a1[3] * PG8_SG(g1[3]));
#undef PG8_SG
                *(u32x4*)(U + (size_t)row * 1024 + col0) = w; }
    }
};
struct EpiOut {
    static constexpr bool PERM = true, AFTER_DRAIN = false;
    bf16_t* H; const bf16_t* XB; float* part; unsigned char* H8;
    __device__ __forceinline__ void operator()(const f32x4 (&acc)[2][2][4][2], const Unit& u, int wr, int wc, int fr, int fq) const {
        const int row0 = u.pm * BM + wr * 64 + fr, col0 = u.pn * BM + wc * 32 + 8 * fq;
#pragma unroll
        for (int ai = 0; ai < 2; ++ai) { u32x4 xbv[4][2];
#pragma unroll
            for (int m = 0; m < 4; ++m)
#pragma unroll
                for (int bj = 0; bj < 2; ++bj) xbv[m][bj] = *(const u32x4*)(XB + (size_t)(row0 + ai * HALF + m * 16) * 2048 + col0 + bj * HALF);
#pragma unroll
            for (int m = 0; m < 4; ++m) { const int row = row0 + ai * HALF + m * 16; const size_t off = (size_t)row * 2048 + col0; float ss = 0.f;
#pragma unroll
                for (int bj = 0; bj < 2; ++bj) { const u32x4 xb = xbv[m][bj];
                    f32x4 v0 = acc[ai][bj][m][0], v1 = acc[ai][bj][m][1];
                    v0[0] += bf_lo(xb.x); v0[1] += bf_hi(xb.x); v0[2] += bf_lo(xb.y); v0[3] += bf_hi(xb.y); v1[0] += bf_lo(xb.z); v1[1] += bf_hi(xb.z); v1[2] += bf_lo(xb.w); v1[3] += bf_hi(xb.w);
                    ss += (v0[0] * v0[0] + v0[1] * v0[1]) + (v0[2] * v0[2] + v0[3] * v0[3]) + (v1[0] * v1[0] + v1[1] * v1[1]) + (v1[2] * v1[2] + v1[3] * v1[3]);
                    u32x4 w; w.x = cvt_pk_bf16(v0[0], v0[1]); w.y = cvt_pk_bf16(v0[2], v0[3]); w.z = cvt_pk_bf16(v1[0], v1[1]); w.w = cvt_pk_bf16(v1[2], v1[3]);
                    *(u32x4*)(H + off + bj * HALF) = w;
                    if (H8) { u32x2 w8; w8.x = pk4_fp8(v0[0], v0[1], v0[2], v0[3]); w8.y = pk4_fp8(v1[0], v1[1], v1[2], v1[3]); *(u32x2*)(H8 + off + bj * HALF) = w8; } }
                ss += __shfl_xor(ss, 16); ss += __shfl_xor(ss, 32);
                if (fq == 0) part[(size_t)row * 32 + u.pn * 4 + wc] = ss; } }
    }
};
__device__ __forceinline__ float silu_f(float x) { return x * __builtin_amdgcn_rcpf(1.f + __builtin_amdgcn_exp2f(-1.4426950408889634f * x)); }
struct EpiGU {
    static constexpr bool PERM = true, AFTER_DRAIN = false;
    unsigned char* H1; const int* list; const float* listr; float wscale, oscale;
    __device__ __forceinline__ void operator()(const f32x4 (&acc)[2][2][4][2], const Unit& u, int wr, int wc, int fr, int fq) const {
        const int col0 = u.pn * HALF + wc * 32 + 8 * fq;
        float rsv[2][4];
#pragma unroll
        for (int ai = 0; ai < 2; ++ai)
#pragma unroll
            for (int m = 0; m < 4; ++m) { const int r = ai * HALF + wr * 64 + m * 16 + fr; rsv[ai][m] = listr[u.lbase + (r < u.nvalid ? r : 0)]; }
#pragma unroll
        for (int ai = 0; ai < 2; ++ai)
#pragma unroll
            for (int mp = 0; mp < 4; mp += 2) { u32x2 wv[2];
#pragma unroll
                for (int q = 0; q < 2; ++q) { const int m = mp + q; const float rs = rsv[ai][m] * wscale;
                    const f32x4 g0 = acc[ai][0][m][0] * rs, g1 = acc[ai][0][m][1] * rs, u0 = acc[ai][1][m][0] * (rs * oscale), u1 = acc[ai][1][m][1] * (rs * oscale);
                    wv[q].x = pk4_fp8(silu_f(g0[0]) * u0[0], silu_f(g0[1]) * u0[1], silu_f(g0[2]) * u0[2], silu_f(g0[3]) * u0[3]);
                    wv[q].y = pk4_fp8(silu_f(g1[0]) * u1[0], silu_f(g1[1]) * u1[1], silu_f(g1[2]) * u1[2], silu_f(g1[3]) * u1[3]); }
                swap16(wv[0], wv[1]);
                const int odd = fq & 1, r = ai * HALF + wr * 64 + (mp + odd) * 16 + fr;
                if (r < u.nvalid) { const u32x4 w = {wv[0].x, wv[0].y, wv[1].x, wv[1].y};
                    *(u32x4*)(H1 + (size_t)(u.srow + r) * 1024 + col0 - 8 * odd) = w; } }
    }
};
struct EpiDown {
    static constexpr bool PERM = true, AFTER_DRAIN = false;
    unsigned char* Y; const int* list; const float* listw; float oscale;
    __device__ __forceinline__ void operator()(const f32x4 (&acc)[2][2][4][2], const Unit& u, int wr, int wc, int fr, int fq) const {
        const int col0 = u.pn * BM + wc * 32 + 8 * fq;
        int av[2][4]; float wv[2][4];
#pragma unroll
        for (int ai = 0; ai < 2; ++ai)
#pragma unroll
            for (int m = 0; m < 4; ++m) { const int r = ai * HALF + wr * 64 + m * 16 + fr, ix = u.lbase + (r < u.nvalid ? r : 0); av[ai][m] = list[ix]; wv[ai][m] = listw[ix]; }
#pragma unroll
        for (int ai = 0; ai < 2; ++ai)
#pragma unroll
            for (int m = 0; m < 4; ++m) { const int r = ai * HALF + wr * 64 + m * 16 + fr; const int a = av[ai][m]; const float ws = wv[ai][m] * oscale;
                u32x2 w0, w1;
                { const f32x4 v0 = acc[ai][0][m][0] * ws, v1 = acc[ai][0][m][1] * ws; w0.x = pk4_fp8(v0[0], v0[1], v0[2], v0[3]); w0.y = pk4_fp8(v1[0], v1[1], v1[2], v1[3]); }
                { const f32x4 v0 = acc[ai][1][m][0] * ws, v1 = acc[ai][1][m][1] * ws; w1.x = pk4_fp8(v0[0], v0[1], v0[2], v0[3]); w1.y = pk4_fp8(v1[0], v1[1], v1[2], v1[3]); }
                swap16(w0, w1);
                if (r < u.nvalid) { const int odd = fq & 1; const u32x4 w = {w0.x, w0.y, w1.x, w1.y};
                    *(u32x4*)(Y + (size_t)a * 2048 + col0 + (odd ? HALF - 8 : 0)) = w; } }
    }
};
struct EpiRouter {
    static constexpr bool PERM = true, AFTER_DRAIN = false;
    const float* part; const float* ber; const float* bgr; float* listr; float* listw; int* list; unsigned* cnt; int lcap;
    __device__ __forceinline__ void operator()(const f32x4 (&acc)[2][2][4][2], const Unit& u, int wr, int wc, int fr, int fq) const {
        if (wc != 0) return;
#pragma unroll
        for (int ai = 0; ai < 2; ++ai)
#pragma unroll
            for (int m = 0; m < 4; ++m) { const int row = u.pm * BM + ai * HALF + wr * 64 + m * 16 + fr;
                const f32x4 p0 = *(const f32x4*)(part + (size_t)row * 32 + 8 * fq), p1 = *(const f32x4*)(part + (size_t)row * 32 + 8 * fq + 4);
                float ss = ((p0[0] + p0[1]) + (p0[2] + p0[3])) + ((p1[0] + p1[1]) + (p1[2] + p1[3]));
                ss += __shfl_xor(ss, 16); ss += __shfl_xor(ss, 32);
                const float rstd = 1.0f / sqrtf(ss * (1.0f / 2048.0f) + 1e-6f);
                const f32x4 gl = acc[ai][1][m][0]; float g[4];
#pragma unroll
                for (int i = 0; i < 4; ++i) g[i] = __shfl(gl[i], fr) * rstd + bgr[i];
                int gs = 0; float gm = g[0];
#pragma unroll
                for (int i = 1; i < 4; ++i) if (g[i] > gm) { gm = g[i]; gs = i; }
                float gsum = 0.f;
#pragma unroll
                for (int i = 0; i < 4; ++i) gsum += __expf(g[i] - gm);
                const float gw = 1.0f / gsum;
                if (fq == gs) { float ev[8];
#pragma unroll
                    for (int i = 0; i < 4; ++i) { ev[i] = acc[ai][0][m][0][i] * rstd + ber[8 * fq + i]; ev[4 + i] = acc[ai][0][m][1][i] * rstd + ber[8 * fq + 4 + i]; }
                    int i1 = 0; float v1 = ev[0];
#pragma unroll
                    for (int i = 1; i < 8; ++i) if (ev[i] > v1) { v1 = ev[i]; i1 = i; }
                    int i2 = -1; float v2 = -3.0e38f;
#pragma unroll
                    for (int i = 0; i < 8; ++i) if (i != i1 && ev[i] > v2) { v2 = ev[i]; i2 = i; }
                    const float e2 = __expf(v2 - v1), w1 = gw / (1.f + e2), w2 = gw * e2 / (1.f + e2);
                    const int ea = gs * 8 + i1, eb = gs * 8 + i2;
                    const unsigned ra = __hip_atomic_fetch_add(cnt + 64 * ea, 1u, __ATOMIC_RELAXED, __HIP_MEMORY_SCOPE_AGENT);
                    const unsigned rb = __hip_atomic_fetch_add(cnt + 64 * eb, 1u, __ATOMIC_RELAXED, __HIP_MEMORY_SCOPE_AGENT);
                    const size_t ia = (size_t)ea * lcap + ra, ib = (size_t)eb * lcap + rb;
                    list[ia] = 2 * row; list[ib] = 2 * row + 1; listw[ia] = w1; listw[ib] = w2; listr[ia] = rstd; listr[ib] = rstd; } }
    }
};

template <class Epi, class Sched, bool ALIGN_EPI, bool GATHER, bool FP8 = false>
__device__ __forceinline__ void gemm_phase(PG8_LAS unsigned char* lds, const Gemm g, Sched& S, const Epi& E) {
    int tid_ = threadIdx.x; asm volatile("" : "+v"(tid_));
    const int tid = tid_, wid = __builtin_amdgcn_readfirstlane(tid >> 6), lane = tid & 63, wr = wid >> 2, wc = wid & 3, fr = lane & 15, fq = lane >> 4;
    const int K = g.K, nt = K / BK;
    unsigned voffA[2], voffB[2]; int RA[2], CA[2];
#pragma unroll
    for (int i = 0; i < 2; ++i) { int R, C; stage_rc(tid * 16 + i * 8192, R, C); const int Rb = Epi::PERM ? ((R & ~31) + perm32(R & 31)) : R;
        voffA[i] = (unsigned)(R * K + C) * 2u; voffB[i] = (unsigned)(Rb * K + C) * 2u; RA[i] = R; CA[i] = C; }
    const size_t kstep = (size_t)(BK * 2);
    const size_t hstep = (size_t)HALF * K * 2;
    const size_t tstep = 2 * hstep;
    const unsigned ldsw = (unsigned)wid * 1024u;
    const int aoff = lds_byte(wr * 64 + fr, fq * 8), boff = lds_byte(wc * 32 + fr, fq * 8);
#define PG8_SA(b, h) (((b) * 2 + (h)) * HTB)
#define PG8_SB(b, h) ((4 + (b) * 2 + (h)) * HTB)
#define PG8_STAGE(bufoff, gbase, voff) do { _Pragma("unroll") for (int _i = 0; _i < 2; ++_i) \
        __builtin_amdgcn_global_load_lds((const unsigned*)((const char*)(gbase) + (voff)[_i]), (PG8_LAS unsigned*)(lds + (bufoff) + ldsw + _i * 8192), 16, 0, 0); } while (0)
#define PG8_STAGE_A(bufoff, kp, h) do { if constexpr (GATHER) { PG8_STAGE(bufoff, kp, cgo[h]); } else { PG8_STAGE(bufoff, (kp) + (h) * hstep, voffA); } } while (0)
#define PG8_LDA(dst, b, h) do { _Pragma("unroll") for (int m = 0; m < 4; ++m) _Pragma("unroll") for (int k = 0; k < 2; ++k) dst[m][k] = *(const PG8_LAS bf16x8*)(lds + PG8_SA(b, h) + aoff + m * 2048 + k * 1024); } while (0)
#define PG8_LDB(dst, b, h) do { _Pragma("unroll") for (int n = 0; n < 2; ++n) _Pragma("unroll") for (int k = 0; k < 2; ++k) dst[n][k] = *(const PG8_LAS bf16x8*)(lds + PG8_SB(b, h) + boff + n * 2048 + k * 1024); } while (0)
#define PG8_CAT(x, y) __builtin_shufflevector(__builtin_bit_cast(v4i_t, x), __builtin_bit_cast(v4i_t, y), 0, 1, 2, 3, 4, 5, 6, 7)
#define PG8_MMA(ai, bj, At, Bt) do { __builtin_amdgcn_s_setprio(1); \
        if constexpr (FP8) { _Pragma("unroll") for (int m = 0; m < 4; ++m) _Pragma("unroll") for (int n = 0; n < 2; ++n) \
            acc[ai][bj][m][n] = __builtin_amdgcn_mfma_scale_f32_16x16x128_f8f6f4(PG8_CAT(Bt[n][0], Bt[n][1]), PG8_CAT(At[m][0], At[m][1]), acc[ai][bj][m][n], 0, 0, 0, 0, 0, 0); } \
        else { _Pragma("unroll") for (int m = 0; m < 4; ++m) _Pragma("unroll") for (int n = 0; n < 2; ++n) _Pragma("unroll") for (int k = 0; k < 2; ++k) \
            acc[ai][bj][m][n] = __builtin_amdgcn_mfma_f32_16x16x32_bf16(Bt[n][k], At[m][k], acc[ai][bj][m][n], 0, 0, 0); } \
        __builtin_amdgcn_s_setprio(0); } while (0)
#define PG8_WAIT_V(n) asm volatile("s_waitcnt vmcnt(" #n ")" ::: "memory")
#define PG8_WAIT_L(n) asm volatile("s_waitcnt lgkmcnt(" #n ")" ::: "memory")
#define PG8_BAR __builtin_amdgcn_s_barrier()
#define PG8_SCHED __builtin_amdgcn_sched_barrier(0)
    Unit cur, nxt; int ui = 0;
#if PROBE_KLOOP
    unsigned pk_acc_ = 0u;
#endif
    if (!S.next(0, cur)) return;
    f32x4 acc[2][2][4][2];
#pragma unroll
    for (int a = 0; a < 2; ++a)
#pragma unroll
        for (int b = 0; b < 2; ++b)
#pragma unroll
            for (int m = 0; m < 4; ++m)
#pragma unroll
                for (int n = 0; n < 2; ++n) acc[a][b][m][n] = (f32x4){0.f, 0.f, 0.f, 0.f};
    bf16x8 At[4][2], B0[2][2], B1[2][2];
    unsigned cgo[2][2] = {{0u, 0u}, {0u, 0u}}, ngo[2][2] = {{0u, 0u}, {0u, 0u}};
    if constexpr (GATHER) {
#pragma unroll
        for (int h = 0; h < 2; ++h)
#pragma unroll
            for (int i = 0; i < 2; ++i) cgo[h][i] = S.goff(cur, h * HALF + RA[i], CA[i], K);
    }
    const char* cA = GATHER ? (const char*)g.A : (const char*)g.A + (size_t)cur.pm * tstep; const char* cB = S.bbase(g, cur, tstep);
    S.a_ready(cur);
    PG8_STAGE(PG8_SB(0, 0), cB, voffB); PG8_STAGE(PG8_SB(0, 1), cB + hstep, voffB); PG8_STAGE_A(PG8_SA(0, 0), cA, 0); PG8_STAGE_A(PG8_SA(0, 1), cA, 1);
    if (wr == 1) PG8_BAR;
    PG8_WAIT_V(2); PG8_BAR;
    PG8_STAGE(PG8_SB(1, 0), cB + kstep, voffB); PG8_STAGE_A(PG8_SA(1, 0), cA + kstep, 0); PG8_STAGE(PG8_SB(1, 1), cB + hstep + kstep, voffB);
    PG8_WAIT_V(6); PG8_BAR;
    for (;;) {
        const bool has_next = S.next(ui + 1, nxt);
        if constexpr (GATHER) {
            if (has_next) {
#pragma unroll
                for (int h = 0; h < 2; ++h)
#pragma unroll
                    for (int i = 0; i < 2; ++i) ngo[h][i] = S.goff(nxt, h * HALF + RA[i], CA[i], K);
            } else {
#pragma unroll
                for (int h = 0; h < 2; ++h)
#pragma unroll
                    for (int i = 0; i < 2; ++i) ngo[h][i] = cgo[h][i];
            }
        }
        const char* nA = GATHER ? (const char*)g.A : (has_next ? (const char*)g.A + (size_t)nxt.pm * tstep : cA); const char* nB = has_next ? S.bbase(g, nxt, tstep) : cB;
#if PROBE_KLOOP
        const unsigned long long pk0_ = __builtin_amdgcn_s_memrealtime();
#endif
        for (int t = 0; t < nt; t += 2) {
            const bool last = (t == nt - 2);
            const char* a1 = cA + (size_t)(t + 1) * kstep;
            const char* a2 = last ? nA : cA + (size_t)(t + 2) * kstep; const char* b2 = last ? nB : cB + (size_t)(t + 2) * kstep;
            const char* a3 = a2 + kstep; const char* b3 = b2 + kstep;
            if (last && has_next) S.a_ready(nxt);
            PG8_LDB(B0, 0, 0); PG8_LDB(B1, 0, 1); PG8_SCHED; PG8_LDA(At, 0, 0); PG8_STAGE_A(PG8_SA(1, 1), a1, 1);
            if constexpr (GATHER) { if (last) {
#pragma unroll
                for (int h = 0; h < 2; ++h)
#pragma unroll
                    for (int i = 0; i < 2; ++i) cgo[h][i] = ngo[h][i]; } }
            PG8_WAIT_V(8); PG8_WAIT_L(0); PG8_BAR; PG8_MMA(0, 0, At, B0); PG8_MMA(0, 1, At, B1); PG8_BAR; PG8_SCHED;
            PG8_LDA(At, 0, 1); PG8_STAGE(PG8_SB(0, 0), b2, voffB); PG8_STAGE(PG8_SB(0, 1), b2 + hstep, voffB); PG8_STAGE_A(PG8_SA(0, 0), a2, 0);
            PG8_WAIT_V(8); PG8_WAIT_L(0); PG8_BAR; PG8_MMA(1, 0, At, B0); PG8_MMA(1, 1, At, B1); PG8_BAR; PG8_SCHED;
            PG8_LDB(B0, 1, 0); PG8_LDB(B1, 1, 1); PG8_SCHED; PG8_LDA(At, 1, 0); PG8_STAGE_A(PG8_SA(0, 1), a2, 1);
            PG8_WAIT_V(8); PG8_WAIT_L(0); PG8_BAR; PG8_MMA(0, 0, At, B0); PG8_MMA(0, 1, At, B1); PG8_BAR; PG8_SCHED;
            PG8_LDA(At, 1, 1); PG8_STAGE(PG8_SB(1, 0), b3, voffB); PG8_STAGE(PG8_SB(1, 1), b3 + hstep, voffB); PG8_STAGE_A(PG8_SA(1, 0), a3, 0);
            PG8_WAIT_V(8); PG8_WAIT_L(0); PG8_BAR; PG8_MMA(1, 0, At, B0); PG8_MMA(1, 1, At, B1); PG8_BAR; PG8_SCHED;
        }
#if PROBE_KLOOP
        const unsigned long long pk1_ = __builtin_amdgcn_s_memrealtime(); if (PROBE_WHAT == 0) pk_acc_ += (unsigned)(pk1_ - pk0_);
#endif
        if constexpr (ALIGN_EPI) { if (wr == 0) PG8_BAR; }
#if PROBE_KLOOP
        const unsigned long long pk2_ = __builtin_amdgcn_s_memrealtime(); if (PROBE_WHAT == 1) pk_acc_ += (unsigned)(pk2_ - pk1_);
#endif
        E(acc, cur, wr, wc, fr, fq); S.done(cur);
#if PROBE_KLOOP
        asm volatile("s_waitcnt vmcnt(0)" ::: "memory"); if (PROBE_WHAT == 2) pk_acc_ += (unsigned)(__builtin_amdgcn_s_memrealtime() - pk2_);
#endif
        if (!has_next) break;
#pragma unroll
        for (int a = 0; a < 2; ++a)
#pragma unroll
            for (int b = 0; b < 2; ++b)
#pragma unroll
                for (int m = 0; m < 4; ++m)
#pragma unroll
                    for (int n = 0; n < 2; ++n) acc[a][b][m][n] = (f32x4){0.f, 0.f, 0.f, 0.f};
        cur = nxt; cA = nA; cB = nB; ++ui;
        if constexpr (ALIGN_EPI) { if (wr == 1) PG8_BAR; }
    }
#if PROBE_KLOOP
    if (blockIdx.x == PROBE_BLK && tid == 0 && g.M == PROBE_KLOOP) atomicAdd(g.probe, pk_acc_);
#endif
    PG8_WAIT_V(0);
    if constexpr (!ALIGN_EPI) { if (wr == 0) PG8_BAR; }
    PG8_BAR;
#undef PG8_SA
#undef PG8_SB
#undef PG8_STAGE
#undef PG8_STAGE_A
#undef PG8_LDA
#undef PG8_LDB
#undef PG8_MMA
#undef PG8_CAT
#undef PG8_WAIT_V
#undef PG8_WAIT_L
#undef PG8_BAR
#undef PG8_SCHED
}
}
#include <hip/hip_bf16.h>
#include <cmath>
namespace attn_body {
using bf16=__hip_bfloat16;
using bf16x8=__attribute__((ext_vector_type(8)))short;
using s16x4=__attribute__((ext_vector_type(4)))short;
using f32x16=__attribute__((ext_vector_type(16)))float;
using u32x4=__attribute__((ext_vector_type(4)))unsigned;
constexpr int BATCH=8,SEQ=4096,D=64,DM=1024;
constexpr int NW=8,QBLK=32,QB=QBLK*NW,KVBLK=64,NQB=SEQ/QB;
__device__ __forceinline__ int crow(int r,int hi){return (r&3)+8*(r>>2)+4*hi;}
#define SBAR() __builtin_amdgcn_sched_barrier(0)
__device__ __forceinline__ void cmask(f32x16&p0,f32x16&p1,int jb,int qrel,int hi){
  const float NEG=-INFINITY; const int lim=qrel-64*jb-4*hi;
  #pragma unroll
  for(int r=0;r<16;++r){const int cr=(r&3)+8*(r>>2); if(cr>lim)p0[r]=NEG; if(cr+32>lim)p1[r]=NEG;}
}

constexpr int NSLOT=3, SLOTB=8192;
constexpr int LDS_K=0, LDS_V=NSLOT*SLOTB, LDS_WS=3*NSLOT*SLOTB, LDS_OST=LDS_WS+NW*64*4, LDS_BYTES=LDS_OST+NW*4096;
__device__ __forceinline__ void glds16(const void*sbase,unsigned voff,unsigned lds_dst){unsigned keep;
  asm volatile("s_mov_b32 %0, m0\n\ts_mov_b32 m0, %3\n\ts_nop 0\n\tglobal_load_lds_dwordx4 %1, %2\n\ts_mov_b32 m0, %0":"=&s"(keep):"v"(voff),"s"(sbase),"s"(lds_dst):"memory");}
__device__ __forceinline__ float max3f(float a,float b,float c){float r;asm("v_max3_f32 %0, %1, %2, %3":"=v"(r):"v"(a),"v"(b),"v"(c));return r;}
__device__ __forceinline__ float max2f(float a,float b){float r;asm("v_max_f32_e32 %0, %1, %2":"=v"(r):"v"(a),"v"(b));return r;}
__device__ __forceinline__ float fsub_s(float a,float b){float r;asm("v_sub_f32_e32 %0, %1, %2":"=v"(r):"v"(a),"v"(b));return r;}
typedef float f32x2_t __attribute__((ext_vector_type(2))); typedef __bf16 bf16x2_t __attribute__((ext_vector_type(2)));
__device__ __forceinline__ unsigned cvtpk_s(float lo,float hi){f32x2_t v={lo,hi};bf16x2_t b=__builtin_convertvector(v,bf16x2_t);return __builtin_bit_cast(unsigned,b);}
#define WAIT_BAR(N) asm volatile("s_waitcnt vmcnt(" #N ") lgkmcnt(0)\n\ts_barrier":::"memory")
#define MFMA32(a,b,c) __builtin_amdgcn_mfma_f32_32x32x16_bf16(a,b,c,0,0,0)

__device__ __forceinline__ void qkt(f32x16&p0,f32x16&p1,const char*Kslot,const bf16x8*qr,int r32,int hi){
  const char*kb=Kslot+hi*1024+r32*16;
  #pragma unroll
  for(int d0=0;d0<4;++d0){
    const bf16x8 b0=*reinterpret_cast<const bf16x8*>(kb+d0*2048);
    const bf16x8 b1=*reinterpret_cast<const bf16x8*>(kb+d0*2048+512);
    p0=MFMA32(b0,qr[d0],p0);p1=MFMA32(b1,qr[d0],p1);}
}
typedef __attribute__((address_space(3))) const char* lds_cptr;
typedef short v4i16_t __attribute__((ext_vector_type(4)));
__device__ __forceinline__ void kload8(bf16x8*kf,lds_cptr kp){
  kf[0]=*(const __attribute__((address_space(3))) bf16x8*)(kp);      kf[1]=*(const __attribute__((address_space(3))) bf16x8*)(kp+512);
  kf[2]=*(const __attribute__((address_space(3))) bf16x8*)(kp+2048); kf[3]=*(const __attribute__((address_space(3))) bf16x8*)(kp+2560);
  kf[4]=*(const __attribute__((address_space(3))) bf16x8*)(kp+4096); kf[5]=*(const __attribute__((address_space(3))) bf16x8*)(kp+4608);
  kf[6]=*(const __attribute__((address_space(3))) bf16x8*)(kp+6144); kf[7]=*(const __attribute__((address_space(3))) bf16x8*)(kp+6656);
}
__device__ __forceinline__ void kload2(bf16x8*kf,lds_cptr kp,int j){ kf[2*j]=*(const __attribute__((address_space(3))) bf16x8*)(kp+j*2048); kf[2*j+1]=*(const __attribute__((address_space(3))) bf16x8*)(kp+j*2048+512); }
__device__ __forceinline__ s16x4 vtr(lds_cptr p){ return __builtin_bit_cast(s16x4,__builtin_amdgcn_ds_read_tr16_b64_v4i16((__attribute__((address_space(3))) v4i16_t*)p)); }
__device__ __forceinline__ float rowmax(const f32x16&p0,const f32x16&p1){
  float a=max3f(p0[0],p0[1],p1[0]),b=max3f(p0[2],p0[3],p1[1]);a=max3f(a,p1[2],p1[3]);
  #pragma unroll
  for(int r=4;r<16;r+=4){a=max3f(a,p0[r],p0[r+1]);b=max3f(b,p0[r+2],p0[r+3]);a=max3f(a,p1[r],p1[r+1]);b=max3f(b,p1[r+2],p1[r+3]);}
  const float m=max2f(a,b);
  auto rr=__builtin_amdgcn_permlane32_swap(__float_as_uint(m),__float_as_uint(m),false,false);
  return max2f(__uint_as_float(rr[0]),__uint_as_float(rr[1]));
}
__device__ __forceinline__ void pv(f32x16*o,int vb,bf16x8 pa0,bf16x8 pa1,bf16x8 pa2,bf16x8 pa3){
  #pragma unroll
  for(int d0=0;d0<4;++d0){s16x4 lo[4],hi[4];
    #pragma unroll
    for(int ks=0;ks<4;++ks){
      asm volatile("ds_read_b64_tr_b16 %0,%1 offset:%c2":"=&v"(lo[ks]):"v"(vb),"i"(d0*4096+ks*1024):"memory");
      asm volatile("ds_read_b64_tr_b16 %0,%1 offset:%c2":"=&v"(hi[ks]):"v"(vb),"i"(d0*4096+ks*1024+512):"memory");}
    asm volatile("s_waitcnt lgkmcnt(0)":::"memory");SBAR();
    #define PK(k) (bf16x8){lo[k][0],lo[k][1],lo[k][2],lo[k][3],hi[k][0],hi[k][1],hi[k][2],hi[k][3]}
    o[d0]=MFMA32(pa0,PK(0),o[d0]);
    o[d0]=MFMA32(pa1,PK(1),o[d0]);
    o[d0]=MFMA32(pa2,PK(2),o[d0]);
    o[d0]=MFMA32(pa3,PK(3),o[d0]);
    #undef PK
  }
}

template<int THRL> __device__ __forceinline__ void attn_sub(int b,int qkcol,int vcol,int qb,int cmap,float sl2,float lam,int ntcap,float oscale,const float*subg,unsigned*o1s,bf16*MIXh,const bf16*Q,const bf16*__restrict__ K,const bf16*__restrict__ V,char*shm,unsigned*pw_){
#if PROBE_ATT >= 3
  const unsigned long long ps0_=__builtin_amdgcn_s_memrealtime();
#endif
  const int tid=threadIdx.x,lane=tid&63,r32=lane&31,hi=lane>>5; const int wid=__builtin_amdgcn_readfirstlane(tid>>6);
  const long rowbase=(long)b*SEQ; const int q0=qb*QB;
  const bf16*Qw=Q+(rowbase+q0+wid*QBLK)*DM+qkcol;
  const bf16*Kh=K+rowbase*DM+qkcol,*Vh=V+rowbase*DM+vcol;
  const unsigned lds0=(unsigned)(uintptr_t)shm;
  float*wsf=(float*)(shm+LDS_WS)+wid*64;
  const unsigned koff=(unsigned)(lane*DM+wid*8)*2u, voffv=(unsigned)((16*(wid&3)+(lane>>2))*DM+(wid>>2)*32+(lane&3)*8)*2u;
  const unsigned kdst=lds0+LDS_K+wid*1024, vdst=lds0+LDS_V+wid*1024;
  const int NTR=(q0+QB)/KVBLK;
  const int NT=NTR<ntcap?NTR:ntcap;
  #define DMA_K(t,slot) glds16(Kh+(long)(NTR-1-(t))*KVBLK*DM,koff,(unsigned)__builtin_amdgcn_readfirstlane(kdst+(slot)))
  #define DMA_V(t,slot) do{ glds16(Vh+(long)(NTR-1-(t))*KVBLK*DM,voffv,(unsigned)__builtin_amdgcn_readfirstlane(vdst+2*(slot))); glds16(Vh+(long)(NTR-1-(t))*KVBLK*DM+64,voffv,(unsigned)__builtin_amdgcn_readfirstlane(vdst+2*(slot)+8192)); }while(0)
  const int vb0=(int)(lds0+LDS_V)+((lane>>4)&1)*32+(lane&3)*8+(4*hi+((lane&15)>>2))*64;
  const char*Kbase=shm+LDS_K; bf16x8 kf[8];
  const lds_cptr shm3=(lds_cptr)shm; const lds_cptr kp0=shm3+LDS_K+hi*1024+r32*16; const lds_cptr vp0=shm3+LDS_V+((lane>>4)&1)*32+(lane&3)*8+(4*hi+((lane&15)>>2))*64;
  DMA_K(0,0);DMA_V(0,0);DMA_K(1,SLOTB);
  bf16x8 qr[4];
  #pragma unroll
  for(int d0=0;d0<4;++d0)qr[d0]=*reinterpret_cast<const bf16x8*>(&Qw[(long)r32*DM+d0*16+hi*8]);
  const int qrel=wid*QBLK+r32;
  const unsigned lm=hi?0u:0xffffffffu;
  const unsigned kx0=cvtpk_s((float)r32,(float)r32), kx1=cvtpk_s((float)(r32+32),(float)(r32+32));
  unsigned bbx; { const unsigned sh=__float_as_uint(sl2)&0xffff0000u; const float sr=sl2-__uint_as_float(sh); bbx=((sh>>16)|(cvtpk_s(sr,0.f)<<16))&lm; }
  const float dlt=64.f*sl2;
  float cref=sl2*(float)(192-qrel);
  #define BIAS2(C0,C1,t) do{ const float c_=__builtin_fmaf(-dlt,(float)(t),cref); const unsigned h_=__float_as_uint(c_)&0xffff0000u; const float r1_=c_-__uint_as_float(h_); \
      const unsigned m_=__float_as_uint(r1_)&0xffff0000u; const float r2_=r1_-__uint_as_float(m_); \
      u32x4 b_=(u32x4){bbx,((h_>>16)|m_)&lm,(__float_as_uint(r2_)>>16)&lm,0u}; u32x4 a_=(u32x4){kx0,0x3F803F80u,0x00003F80u,0u}; asm volatile("":"+v"(a_),"+v"(b_)); \
      const f32x16 z_=f32x16{}; C0=MFMA32(__builtin_bit_cast(bf16x8,a_),__builtin_bit_cast(bf16x8,b_),z_); \
      a_.x=kx1; asm volatile("":"+v"(a_)); C1=MFMA32(__builtin_bit_cast(bf16x8,a_),__builtin_bit_cast(bf16x8,b_),z_); }while(0)
  float l_reg=0.f;f32x16 o[4];o[0]=f32x16{};o[1]=f32x16{};o[2]=f32x16{};o[3]=f32x16{};
  #define CMASK(P0,P1,t) do{int jb_=3-(t); if(jb_>=0)cmask(P0,P1,jb_,qrel,hi);}while(0)
  bool resc=false;
  #define START(P0,P1) do{ const float rm=rowmax(P0,P1); resc=false; \
    if(__any(rm>(float)THRL)){ const float dl=max2f(rm,0.f); cref=fsub_s(cref,dl); \
      _Pragma("unroll") for(int r=0;r<16;++r){P0[r]=fsub_s(P0[r],dl);P1[r]=fsub_s(P1[r],dl);} } \
    _Pragma("unroll") for(int r=0;r<16;++r)P0[r]=__builtin_amdgcn_exp2f(P0[r]); }while(0)
  #define RESC() do{ if(resc){ asm volatile("s_waitcnt lgkmcnt(0)":::"memory"); \
      _Pragma("unroll") for(int d_=0;d_<4;++d_) _Pragma("unroll") for(int r=0;r<16;++r)o[d_][r]*=wsf[crow(r,hi)]; } }while(0)
  f32x16 pA0,pA1,pB0,pB1;
  int sl_prev=0,sl_cur=0,sl_next=SLOTB;
  #define ROT() do{sl_prev=sl_cur;sl_cur=sl_next;sl_next=(sl_next==(NSLOT-1)*SLOTB)?0:sl_next+SLOTB;}while(0)
  DMA_K(2,2*SLOTB);
  WAIT_BAR(3);
  BIAS2(pA0,pA1,0);
  qkt(pA0,pA1,Kbase,qr,r32,hi);asm volatile("s_nop 15\n\ts_nop 7":"+v"(pA0),"+v"(pA1));CMASK(pA0,pA1,0);
  START(pA0,pA1);
  _Pragma("unroll") for(int r=0;r<16;++r)pA1[r]=__builtin_amdgcn_exp2f(pA1[r]);
  WAIT_BAR(0);
  DMA_K(3,0);DMA_V(1,SLOTB);
  ROT();
  kload8(kf,kp0+sl_cur);
  WAIT_BAR(3);
  s16x4 vlo[8],vhi[8]; u32x4 pw0,pw1,pw2,pw3;
  #define PKW(P,B) cvtpk_s(P[B],P[B+1])
  #define PAF(k) __builtin_bit_cast(bf16x8,pw##k)
  #define VFR(i) (bf16x8){vlo[i][0],vlo[i][1],vlo[i][2],vlo[i][3],vhi[i][0],vhi[i][1],vhi[i][2],vhi[i][3]}
  #define PIN(x) asm volatile("":"+v"(x))
  #define MX3(a,b,c) __builtin_fmaxf(__builtin_fmaxf((a),(b)),(c))
  #define GAPA(MF,A0,A1,A2,A3,W0,W1,PW) do{ MF; sacc+=A0; sacc+=A1; sacc+=A2; sacc+=A3; PIN(sacc); W0; W1; PIN(PW); SBAR(); }while(0)
  #define EX(v) __builtin_amdgcn_exp2f(v)
  #define GAPB(MF,X,B) do{ MF; X[B]=EX(X[B]); X[B+1]=EX(X[B+1]); PIN(X); SBAR(); }while(0)
  #define VRD2(i) do{ vlo[i]=vtr(vp_+(8192+((i)>>2)*4096+((i)&3)*1024)); vhi[i]=vtr(vp_+(8192+((i)>>2)*4096+((i)&3)*1024+512)); SBAR(); }while(0)
  #define VRD(i) do{ vlo[i]=vtr(vp_+(((i)>>2)*4096+((i)&3)*1024)); vhi[i]=vtr(vp_+(((i)>>2)*4096+((i)&3)*1024+512)); }while(0)
  #define KRD(G,j) do{ if(G){ kload2(kf,kp0+sl_next,j); SBAR(); } }while(0)
  #define STEP(C0,C1,P0,P1,t,GK,GV,GL) do{ SBAR(); \
    BIAS2(C0,C1,t); SBAR(); \
    const lds_cptr vp_=vp0+2*sl_prev; \
    VRD(0); SBAR(); float sacc=(P0[0]+P0[1]); \
    GAPA(C0=MFMA32(kf[0],qr[0],C0), P0[2],P0[3],P0[4],P0[5],     pw0[0]=PKW(P0,0), pw0[1]=PKW(P0,2), pw0); \
    VRD(4); SBAR(); GAPA(C1=MFMA32(kf[1],qr[0],C1), P0[6],P0[7],P0[8],P0[9],     pw0[2]=PKW(P0,4), pw0[3]=PKW(P0,6), pw0); \
    VRD(1); SBAR(); GAPA(C0=MFMA32(kf[2],qr[1],C0),   P0[10],P0[11],P0[12],P0[13], pw1[0]=PKW(P0,8), pw1[1]=PKW(P0,10), pw1); \
    VRD(5); SBAR(); GAPA(C1=MFMA32(kf[3],qr[1],C1),   P0[14],P0[15],P1[0],P1[1],   pw1[2]=PKW(P0,12),pw1[3]=PKW(P0,14), pw1); \
    VRD(2); SBAR(); GAPA(C0=MFMA32(kf[4],qr[2],C0),   P1[2],P1[3],P1[4],P1[5],     pw2[0]=PKW(P1,0), pw2[1]=PKW(P1,2), pw2); \
    VRD(6); SBAR(); GAPA(C1=MFMA32(kf[5],qr[2],C1),   P1[6],P1[7],P1[8],P1[9],     pw2[2]=PKW(P1,4), pw2[3]=PKW(P1,6), pw2); \
    VRD(3); SBAR(); GAPA(C0=MFMA32(kf[6],qr[3],C0),   P1[10],P1[11],P1[12],P1[13], pw3[0]=PKW(P1,8), pw3[1]=PKW(P1,10), pw3); \
    VRD(7); SBAR(); GAPA(C1=MFMA32(kf[7],qr[3],C1),   P1[14],P1[15],0.f,0.f,       pw3[2]=PKW(P1,12),pw3[3]=PKW(P1,14), pw3); \
    l_reg+=sacc; \
    if(GK){DMA_K((t)+3,sl_cur);} if(GV){DMA_V((t)+1,sl_next);} \
    CMASK(C0,C1,t); \
    { float a=MX3(C0[0],C0[1],C1[0]),b=MX3(C0[2],C0[3],C1[1]); a=MX3(a,C1[2],C1[3]); \
      _Pragma("unroll") for(int r=4;r<16;r+=4){a=MX3(a,C0[r],C0[r+1]);b=MX3(b,C0[r+2],C0[r+3]);a=MX3(a,C1[r],C1[r+1]);b=MX3(b,C1[r+2],C1[r+3]);} \
      float rm=__builtin_fmaxf(a,b); { auto rr=__builtin_amdgcn_permlane32_swap(__float_as_uint(rm),__float_as_uint(rm),false,false); rm=__builtin_fmaxf(__uint_as_float(rr[0]),__uint_as_float(rr[1])); } \
      resc=false; \
      if(__builtin_expect(__any(rm>(float)THRL),0)){ const float dl=__builtin_fmaxf(rm,0.f); cref-=dl; \
        _Pragma("unroll") for(int r=0;r<16;++r){C0[r]-=dl;C1[r]-=dl;} \
        const float f=__builtin_amdgcn_exp2f(-dl); l_reg*=f; if(hi==0)wsf[r32]=f; resc=true; } } \
    SBAR(); \
    GAPB(o[0]=MFMA32(PAF(0),VFR(0),o[0]), C0,0);  VRD2(0); \
    GAPB(o[1]=MFMA32(PAF(0),VFR(4),o[1]), C0,2);  VRD2(4); \
    KRD(GL,0); GAPB(o[0]=MFMA32(PAF(1),VFR(1),o[0]), C0,4);  VRD2(1); \
    KRD(GL,1); GAPB(o[1]=MFMA32(PAF(1),VFR(5),o[1]), C0,6);  VRD2(5); \
    KRD(GL,2); GAPB(o[0]=MFMA32(PAF(2),VFR(2),o[0]), C0,8);  VRD2(2); \
    KRD(GL,3); GAPB(o[1]=MFMA32(PAF(2),VFR(6),o[1]), C0,10); VRD2(6); \
    GAPB(o[0]=MFMA32(PAF(3),VFR(3),o[0]), C0,12); VRD2(3); \
    GAPB(o[1]=MFMA32(PAF(3),VFR(7),o[1]), C0,14); VRD2(7); \
    GAPB(o[2]=MFMA32(PAF(0),VFR(0),o[2]), C1,0); \
    GAPB(o[3]=MFMA32(PAF(0),VFR(4),o[3]), C1,2); \
    GAPB(o[2]=MFMA32(PAF(1),VFR(1),o[2]), C1,4); \
    GAPB(o[3]=MFMA32(PAF(1),VFR(5),o[3]), C1,6); \
    GAPB(o[2]=MFMA32(PAF(2),VFR(2),o[2]), C1,8); \
    GAPB(o[3]=MFMA32(PAF(2),VFR(6),o[3]), C1,10); \
    GAPB(o[2]=MFMA32(PAF(3),VFR(3),o[2]), C1,12); \
    GAPB(o[3]=MFMA32(PAF(3),VFR(7),o[3]), C1,14); \
    }while(0)
  #define ENDW(tt) do{ if((tt)+3<NT){WAIT_BAR(3);} else if((tt)+2<NT){WAIT_BAR(2);} else {WAIT_BAR(0);} }while(0)
#if PROBE_ATT == 3
  if(blockIdx.x==PROBE_BLK&&threadIdx.x==0)atomicAdd(pw_,(unsigned)(__builtin_amdgcn_s_memrealtime()-ps0_));
#endif
  int t=1;
  for(;t<5&&t+1<NT;t+=2){
    STEP(pB0,pB1,pA0,pA1,t,(t+3<NT),(t+1<NT),(t+1<NT));       ENDW(t);   RESC(); ROT();
    STEP(pA0,pA1,pB0,pB1,t+1,(t+4<NT),(t+2<NT),(t+2<NT));     ENDW(t+1); RESC(); ROT();
  }
  #undef CMASK
  #define CMASK(P0,P1,t) do{}while(0)
  for(;t+5<NT;t+=2){
    STEP(pB0,pB1,pA0,pA1,t,true,true,true);     WAIT_BAR(3); RESC(); ROT();
    STEP(pA0,pA1,pB0,pB1,t+1,true,true,true);   WAIT_BAR(3); RESC(); ROT();
  }
  for(;t+1<NT;t+=2){
    STEP(pB0,pB1,pA0,pA1,t,(t+3<NT),(t+1<NT),(t+1<NT));       ENDW(t);   RESC(); ROT();
    STEP(pA0,pA1,pB0,pB1,t+1,(t+4<NT),(t+2<NT),(t+2<NT));     ENDW(t+1); RESC(); ROT();
  }
  #undef CMASK
  #define CMASK(P0,P1,t) do{int jb_=3-(t); if(jb_>=0)cmask(P0,P1,jb_,qrel,hi);}while(0)
  STEP(pB0,pB1,pA0,pA1,NT-1,false,false,false); RESC();
#if PROBE_ATT == 4
  const unsigned long long ps1_=__builtin_amdgcn_s_memrealtime();
#endif
  { float sacc=pB0[0]+pB0[1]; _Pragma("unroll") for(int r=2;r<16;++r)sacc+=pB0[r]; _Pragma("unroll") for(int r=0;r<16;++r)sacc+=pB1[r]; l_reg+=sacc;
    pw0=(u32x4){PKW(pB0,0),PKW(pB0,2),PKW(pB0,4),PKW(pB0,6)};pw1=(u32x4){PKW(pB0,8),PKW(pB0,10),PKW(pB0,12),PKW(pB0,14)};pw2=(u32x4){PKW(pB1,0),PKW(pB1,2),PKW(pB1,4),PKW(pB1,6)};pw3=(u32x4){PKW(pB1,8),PKW(pB1,10),PKW(pB1,12),PKW(pB1,14)};
    SBAR(); pv(o,vb0+2*sl_cur,PAF(0),PAF(1),PAF(2),PAF(3)); }
  #undef PKW
  #undef PAF
  #undef VFR
  #undef PIN
  #undef MX3
  #undef GAPA
  #undef GAPB
  #undef EX
  #undef VRD
  #undef VRD2
  #undef KRD
  #undef STEP
  #undef ENDW
  { int tid_e=threadIdx.x; asm volatile("":"+v"(tid_e)); const int lane=tid_e&63,r32=lane&31,hi=lane>>5; const int wid=__builtin_amdgcn_readfirstlane(tid_e>>6);
    float*wsf=(float*)(shm+LDS_WS)+wid*64;
  {auto rr=__builtin_amdgcn_permlane32_swap(__float_as_uint(l_reg),__float_as_uint(l_reg),false,false);l_reg=__uint_as_float(rr[0])+__uint_as_float(rr[1]);}
  if(hi==0)wsf[32+r32]=l_reg;asm volatile("s_waitcnt lgkmcnt(0)":::"memory");
  float rli[16];
  #pragma unroll
  for(int r=0;r<16;++r)rli[r]=__builtin_amdgcn_rcpf(wsf[32+crow(r,hi)]);
  u32x4*ow=(u32x4*)(o1s+wid*2048)+lane;
  if(cmap==0){
    #pragma unroll
    for(int i=0;i<8;++i){ const int dq=i>>1,r0=8*(i&1); u32x4 w;
      w.x=cvtpk_s(o[dq][r0+0]*rli[r0+0],o[dq][r0+1]*rli[r0+1]); w.y=cvtpk_s(o[dq][r0+2]*rli[r0+2],o[dq][r0+3]*rli[r0+3]);
      w.z=cvtpk_s(o[dq][r0+4]*rli[r0+4],o[dq][r0+5]*rli[r0+5]); w.w=cvtpk_s(o[dq][r0+6]*rli[r0+6],o[dq][r0+7]*rli[r0+7]); ow[i*64]=w; }
  } else {
    bf16*stg=(bf16*)(shm+LDS_OST)+wid*2048;
    const int row=lane>>1,part=lane&1; float v[64]; float ss=0.f;
    unsigned o1w[32];
    #pragma unroll
    for(int i=0;i<8;++i){ const u32x4 w=ow[i*64]; o1w[4*i+0]=w.x; o1w[4*i+1]=w.y; o1w[4*i+2]=w.z; o1w[4*i+3]=w.w; }
    #pragma unroll
    for(int p_=0;p_<2;++p_){
      #pragma unroll
      for(int d0=0;d0<2;++d0){ const int dq=2*p_+d0;
        #pragma unroll
        for(int rp=0;rp<8;++rp){ const unsigned w=o1w[dq*8+rp];
          const float a0=__uint_as_float(w<<16)-lam*(o[dq][2*rp]*rli[2*rp]), a1=__uint_as_float(w&0xffff0000u)-lam*(o[dq][2*rp+1]*rli[2*rp+1]);
          stg[crow(2*rp,hi)*64+d0*32+r32]=__float2bfloat16(a0); stg[crow(2*rp+1,hi)*64+d0*32+r32]=__float2bfloat16(a1); } }
      asm volatile("s_waitcnt lgkmcnt(0)":::"memory");
      #pragma unroll
      for(int i=0;i<4;++i){ const u32x4 w=*(const u32x4*)(stg+row*64+part*32+8*i);
        v[32*p_+8*i+0]=__uint_as_float(w.x<<16); v[32*p_+8*i+1]=__uint_as_float(w.x&0xffff0000u); v[32*p_+8*i+2]=__uint_as_float(w.y<<16); v[32*p_+8*i+3]=__uint_as_float(w.y&0xffff0000u);
        v[32*p_+8*i+4]=__uint_as_float(w.z<<16); v[32*p_+8*i+5]=__uint_as_float(w.z&0xffff0000u); v[32*p_+8*i+6]=__uint_as_float(w.w<<16); v[32*p_+8*i+7]=__uint_as_float(w.w&0xffff0000u); }
      asm volatile("s_waitcnt lgkmcnt(0)":::"memory");
    }
    #pragma unroll
    for(int i=0;i<64;++i)ss+=v[i]*v[i];
    ss+=__uint_as_float((unsigned)__builtin_amdgcn_update_dpp(0,(int)__float_as_uint(ss),0xB1,0xF,0xF,false));
    const float rs=(1.0f/sqrtf(ss*(1.0f/128.0f)+1e-6f))*oscale;
    bf16*op=MIXh+((long)rowbase+q0+wid*QBLK+row)*2048+part*32;
    #pragma unroll
    for(int p_=0;p_<2;++p_){ const float*sg=subg+64*p_+32*part;
      #pragma unroll
      for(int i=0;i<4;++i){ u32x4 w; const float*vv=v+32*p_+8*i; const float*gg=sg+8*i;
        w.x=cvtpk_s(vv[0]*rs*gg[0],vv[1]*rs*gg[1]); w.y=cvtpk_s(vv[2]*rs*gg[2],vv[3]*rs*gg[3]); w.z=cvtpk_s(vv[4]*rs*gg[4],vv[5]*rs*gg[5]); w.w=cvtpk_s(vv[6]*rs*gg[6],vv[7]*rs*gg[7]);
        *(u32x4*)(op+64*p_+8*i)=w; } }
  }
  }
  asm volatile("s_waitcnt lgkmcnt(0)\n\ts_barrier":::"memory");
#if PROBE_ATT == 4
  if(blockIdx.x==PROBE_BLK&&threadIdx.x==0)atomicAdd(pw_,(unsigned)(__builtin_amdgcn_s_memrealtime()-ps1_));
#endif
  #undef DMA_K
  #undef DMA_V
  #undef CMASK
  #undef START
  #undef RESC
  #undef ROT
  #undef BIAS2
}
constexpr int ATTN_LDS_BYTES=LDS_BYTES;
template<int THRL> __device__ __forceinline__ void attn_unit4(int b,int h,int qb,float lam,float oscale,const float*subg,const unsigned*nmax,unsigned*o1s,const bf16*Q,const bf16*K,const bf16*V,bf16*MIX,char*shm){
  const float sl2=exp2f(-(float)(h+1))*1.4426950408889634f;
  int cap[2];
  #pragma unroll
  for(int c=0;c<2;++c){ const int bh=b*8+h; const unsigned*qn=nmax+((0*64+bh)*2+c)*2,*kn=nmax+((1*64+bh)*2+c)*2;
    const float U=1.02f*(sqrtf(__uint_as_float(qn[0])*__uint_as_float(kn[0]))+sqrtf(__uint_as_float(qn[1])*__uint_as_float(kn[1])));
    const float d0=(2.f*U+24.f+log2f(1.f/(1.f-exp2f(-sl2))))/sl2; float st=ceilf((d0+255.f)*(1.f/64.f)); st=st<4.f?4.f:(st>64.f?64.f:st);
    cap[c]=__builtin_amdgcn_readfirstlane((((int)st)+1)&~1); }
  for(int c=0;c<2;++c) attn_sub<THRL>(b,(2*h+c)*64,h*128,qb,c,sl2,lam,c?cap[1]:cap[0],oscale,subg,o1s,MIX+h*128,Q,K,V,shm,(unsigned*)nmax+900);
}
__device__ __forceinline__ int wg_pop(unsigned*ctr,volatile __attribute__((address_space(3))) unsigned*slot){
  if(threadIdx.x==0)*slot=__hip_atomic_fetch_add(ctr,1u,__ATOMIC_RELAXED,__HIP_MEMORY_SCOPE_AGENT);
  __syncthreads(); const unsigned n=*slot; __syncthreads(); return (int)n;
}
template<int THRL=8> __device__ __forceinline__ void attn_phase(char*lds,int bx,unsigned*qctr,volatile __attribute__((address_space(3))) unsigned*slot,float lam,float oscale,const float*subg,const unsigned*nmax,unsigned*o1s,const bf16*Q,const bf16*K,const bf16*V,bf16*MIX){
  for(int qi=0;qi<8;++qi){ const int x=(bx+qi)&7;
    for(;;){ const int n=wg_pop(qctr+64*x,slot); if(n>=128)break;
      const int sp_=n>>5,j_=n&31,h=7-(2*sp_+(j_&1)),qb=15-(j_>>1),b=(x+h)&7;
#if PROBE_ATT == 1
      const unsigned long long pa0_=__builtin_amdgcn_s_memrealtime();
#endif
      attn_unit4<THRL>(b,h,qb,lam,oscale,subg,nmax,o1s,Q,K,V,MIX,lds);
#if PROBE_ATT == 1
      if(blockIdx.x==PROBE_BLK&&threadIdx.x==0)atomicAdd((unsigned*)nmax+900,(unsigned)(__builtin_amdgcn_s_memrealtime()-pa0_));
#endif
    } }
}
#undef SBAR
#undef WAIT_BAR
#undef MFMA32
}
#define GAS __attribute__((address_space(1)))
#define LAS __attribute__((address_space(3)))
typedef unsigned short bf16;
typedef unsigned v4u __attribute__((ext_vector_type(4)));
typedef float f32x4 __attribute__((ext_vector_type(4)));
typedef short bf16x8 __attribute__((ext_vector_type(8)));
typedef GAS unsigned gu32;
typedef GAS unsigned long long gu64;
#define RLX_AGENT __ATOMIC_RELAXED, __HIP_MEMORY_SCOPE_AGENT
#define LDS_WAIT() asm volatile("s_waitcnt lgkmcnt(0)" ::: "memory")
#define VM_WAIT() asm volatile("s_waitcnt vmcnt(0)" ::: "memory")
__device__ __forceinline__ unsigned long long rt() { return __builtin_amdgcn_s_memrealtime(); }
__device__ __forceinline__ unsigned f2bf(float f) { unsigned u = __builtin_bit_cast(unsigned, f); return (u + 0x7fffu + ((u >> 16) & 1u)) >> 16; }
__device__ __forceinline__ unsigned pk2(float lo, float hi) { return f2bf(lo) | (f2bf(hi) << 16); }

#define XB_TMO      128
#define XB_XCNT(j)  (256  + 64 * (j))
#define XB_XSUB(j)  (1280 + 64 * (j))
#define XB_XGEN(j)  (2304 + 64 * (j))
#define XB_TOP      3328
#define XB_TOPGEN   3392
#define XCD_BAR_WORDS 3456
#define XB_SPIN_CAP (1u << 18)

__device__ __forceinline__ unsigned xb_ld(unsigned* p)              { return __hip_atomic_load(p, __ATOMIC_RELAXED, __HIP_MEMORY_SCOPE_AGENT); }
__device__ __forceinline__ unsigned xb_add(unsigned* p, unsigned v) { return __hip_atomic_fetch_add(p, v, __ATOMIC_RELAXED, __HIP_MEMORY_SCOPE_AGENT); }
__device__ __forceinline__ unsigned xb_xcc_id() { return (unsigned)__builtin_amdgcn_s_getreg((3 << 11) | 20) & 0xFu; }
#define XB_SPIN(cond, bar) do { unsigned _sp = 0; while (cond) { __builtin_amdgcn_s_sleep(1); \
    if ((++_sp & 255u) == 0u) { if (xb_ld(&(bar)[XB_TMO])) break; if (_sp > XB_SPIN_CAP) { atomicAdd(&(bar)[XB_TMO], 1u); break; } } } } while (0)

struct XcdBarrier {
    unsigned* bar; unsigned x;
    volatile LAS unsigned* st;
};

__device__ __forceinline__ XcdBarrier xcd_barrier_post(unsigned* bar, volatile LAS unsigned* st) {
    XcdBarrier b; b.bar = bar; b.x = xb_xcc_id(); b.st = st;
    if (threadIdx.x == 0) (void)xb_add(&bar[XB_XCNT(b.x)], 1u);
    return b;
}
__device__ __forceinline__ void xcd_barrier_complete(unsigned* bar, unsigned x, unsigned& nloc, unsigned& nx) {
    const unsigned G = gridDim.x * gridDim.y * gridDim.z;
    unsigned sum, cnt, mine, sp = 0u;
    for (;;) {
        sum = 0u; cnt = 0u; mine = 0u;
#pragma unroll
        for (unsigned j = 0; j < 16; ++j) { const unsigned c = xb_ld(&bar[XB_XCNT(j)]); sum += c; cnt += (c > 0u) ? 1u : 0u; mine = (j == x) ? c : mine; }
        if (sum == G) break;
        __builtin_amdgcn_s_sleep(1);
        if ((++sp & 255u) == 0u) { if (xb_ld(&bar[XB_TMO])) break; if (sp > XB_SPIN_CAP) { atomicAdd(&bar[XB_TMO], 1u); break; } }
    }
    nloc = mine > 0u ? mine : 1u; nx = cnt > 0u ? cnt : 1u;
}

__device__ __forceinline__ void xcd_barrier(const XcdBarrier& b) {
    asm volatile("s_waitcnt vmcnt(0)" ::: "memory");
    __syncthreads();
    if (threadIdx.x == 0) {
        unsigned* bar = b.bar;
        __builtin_amdgcn_s_waitcnt(0);
        unsigned nloc = b.st[0], nx = b.st[1];
        if (nloc == 0u) { xcd_barrier_complete(bar, b.x, nloc, nx); b.st[0] = nloc; b.st[1] = nx; }
        const unsigned old = xb_add(&bar[XB_XSUB(b.x)], 1u);
        const unsigned gen = old / nloc;
        if (old + 1u == (gen + 1u) * nloc) {
            __builtin_amdgcn_fence(__ATOMIC_RELEASE, "agent");
            asm volatile("s_waitcnt vmcnt(0)" ::: "memory");
            const unsigned og = xb_add(&bar[XB_TOP], 1u);
            const unsigned tg = og / nx;
            if (og + 1u == (tg + 1u) * nx) xb_add(&bar[XB_TOPGEN], 1u);
            else XB_SPIN(xb_ld(&bar[XB_TOPGEN]) == tg, bar);
            __builtin_amdgcn_fence(__ATOMIC_ACQUIRE, "agent");
            xb_add(&bar[XB_XGEN(b.x)], 1u);
            asm volatile("s_waitcnt vmcnt(0)" ::: "memory");
        } else {
            XB_SPIN(xb_ld(&bar[XB_XGEN(b.x)]) == gen, bar);
            __builtin_amdgcn_fence(__ATOMIC_ACQUIRE, "agent");
            asm volatile("s_waitcnt vmcnt(0)" ::: "memory");
        }
    }
    __syncthreads();
}

constexpr int NWAVES = 8;
constexpr int BATCH = 8, SEQ = 4096, T = BATCH * SEQ, D = 2048, NIN = 5120, NEXP = 32, NA = 2 * T;
constexpr float EPS = 1e-6f, LOG2E = 1.4426950408889634f, C2 = 0.125f * 1.4426950408889634f;
constexpr size_t MiB = 1u << 20;
constexpr size_t WS_CTL = 0, CTL_ZERO_BYTES = 1 * MiB;
constexpr size_t WS_RSTD1 = 1 * MiB, WS_RSTD2 = WS_RSTD1 + 128 * 1024, WS_WTS = WS_RSTD2 + 128 * 1024;
constexpr size_t WS_LIST = 2 * MiB;
constexpr size_t WS_PART = 6 * MiB;
constexpr size_t WS_WIN = 10 * MiB, WS_WOUT = 30 * MiB;
constexpr size_t WS_WGU = 38 * MiB, WS_WD = 166 * MiB;
constexpr size_t WS_XB = 230 * MiB;
constexpr size_t WS_CG = 358 * MiB;
constexpr size_t WS_MIX = 422 * MiB;
constexpr size_t WS_HB = 550 * MiB;
constexpr size_t WS_HB8 = 678 * MiB;
constexpr size_t WS_WR = 742 * MiB;
constexpr size_t WS_X8 = 743 * MiB;
constexpr size_t WS_WIN8 = 807 * MiB;
constexpr size_t WS_O1S = 811 * MiB;
constexpr size_t WS_LISTW = 827 * MiB, WS_LISTR = 831 * MiB;
constexpr size_t WS_END = 835 * MiB;
constexpr float WSCALE = 32.f, H1SCALE = 4.f, YSCALE = 8.f;
constexpr int CW_TMO = 0, CW_CODE = 1, CW_BAR = 4096, CW_CNT = 8192;
constexpr int CW_GQ = 20480;
constexpr int CW_H8Q = 24576 + 1024;
constexpr int CW_CVQ = 24576, CW_DONE = 24576 + 64;
constexpr int CW_QA = 12288, CW_QC = 12288 + 512, CW_NMAX = 16384;
constexpr int RING_OFF = 0, RING_BYTES = 131072, LDSCTL_OFF = RING_BYTES, MISC_OFF = LDSCTL_OFF + 320, TAB_OFF = LDSCTL_OFF + 1024;
constexpr int LDS_BYTES = 147456;
constexpr int NPHASE = 8;
#ifndef MK_ONE_LAUNCH
#define MK_ONE_LAUNCH 1
#endif
#ifndef PROBE_DOUBLE
#define PROBE_DOUBLE 0
#endif
#ifndef PROBE_CLOCK
#define PROBE_CLOCK 0
#endif
#ifndef USE_NAIVE_ROUTER
#define USE_NAIVE_ROUTER 0
#endif
#ifndef USE_NAIVE_ATTN
#define USE_NAIVE_ATTN 0
#endif


typedef unsigned u32x4g __attribute__((ext_vector_type(4)));
__device__ __forceinline__ float wave_sum(float v) {
#pragma unroll
    for (int o = 1; o < 64; o <<= 1) v += __shfl_xor(v, o);
    return v;
}
__device__ __forceinline__ float bflo(unsigned w) { return __builtin_bit_cast(float, w << 16); }
__device__ __forceinline__ float bfhi(unsigned w) { return __builtin_bit_cast(float, w & 0xffff0000u); }
__device__ __forceinline__ float fexp2(float x) { return __builtin_amdgcn_exp2f(x); }

__device__ __forceinline__ void tr_item(const float* W, int N, const float* gk, int k0, int n0, bf16* dst, int dstK, LAS float* scr, int lane) {
    const int kr = lane >> 3, n4 = 4 * (lane & 7); f32x4 v[8];
#pragma unroll
    for (int i = 0; i < 8; ++i) v[i] = *(const GAS f32x4*)(W + (size_t)(k0 + 8 * i + kr) * N + n0 + n4);
#pragma unroll
    for (int i = 0; i < 8; ++i) { const int kk = 8 * i + kr; const float g = gk ? gk[k0 + kk] : 1.0f;
        scr[(n4 + 0) * 66 + kk] = v[i].x * g; scr[(n4 + 1) * 66 + kk] = v[i].y * g; scr[(n4 + 2) * 66 + kk] = v[i].z * g; scr[(n4 + 3) * 66 + kk] = v[i].w * g; }
    LDS_WAIT(); asm volatile("" ::: "memory");
    const int c = lane & 7;
#pragma unroll
    for (int j = 0; j < 4; ++j) { const int n = (lane >> 3) + 8 * j; const LAS float* s = scr + n * 66 + 8 * c;
        v4u o; o.x = pk2(s[0], s[1]); o.y = pk2(s[2], s[3]); o.z = pk2(s[4], s[5]); o.w = pk2(s[6], s[7]);
        *(GAS v4u*)(dst + (size_t)n * dstK + 8 * c) = o; }
    LDS_WAIT(); asm volatile("" ::: "memory");
}
__device__ __forceinline__ void tr8_load(const float* W, int N, int k0, int n0, int lane, f32x4 (&v)[8]) {
    const int kr = lane >> 3, n4 = 4 * (lane & 7);
#pragma unroll
    for (int i = 0; i < 8; ++i) v[i] = *(const GAS f32x4*)(W + (size_t)(k0 + 8 * i + kr) * N + n0 + n4);
}
__device__ __forceinline__ void tr8_finish(const f32x4 (&v)[8], const float* gk, float scale, int k0, unsigned char* dst, int dstK, LAS float* scr, int lane) {
    const int kr = lane >> 3, n4 = 4 * (lane & 7);
#pragma unroll
    for (int i = 0; i < 8; ++i) { const int kk = 8 * i + kr; const float g = (gk ? gk[k0 + kk] : 1.0f) * scale;
        scr[(n4 + 0) * 66 + kk] = v[i].x * g; scr[(n4 + 1) * 66 + kk] = v[i].y * g; scr[(n4 + 2) * 66 + kk] = v[i].z * g; scr[(n4 + 3) * 66 + kk] = v[i].w * g; }
    LDS_WAIT(); asm volatile("" ::: "memory");
    const int c = lane & 7;
#pragma unroll
    for (int j = 0; j < 4; ++j) { const int n = (lane >> 3) + 8 * j; const LAS float* s = scr + n * 66 + 8 * c;
        pg8::u32x2 o; o.x = pg8::pk4_fp8(s[0], s[1], s[2], s[3]); o.y = pg8::pk4_fp8(s[4], s[5], s[6], s[7]);
        *(GAS pg8::u32x2*)(dst + (size_t)n * dstK + 8 * c) = o; }
    LDS_WAIT(); asm volatile("" ::: "memory");
}
__device__ __forceinline__ void tr_item8(const float* W, int N, const float* gk, float scale, int k0, int n0, unsigned char* dst, int dstK, LAS float* scr, int lane) {
    f32x4 v[8]; tr8_load(W, N, k0, n0, lane, v); tr8_finish(v, gk, scale, k0, dst, dstK, scr, lane);
}
struct Ptrs {
    const float *x, *g1, *w_in, *lq1, *lk1, *lq2, *lk2, *subg, *cw, *cb, *lng, *lnb, *w_out, *g2, *wgr, *bgr, *wer, *ber, *w_gate, *w_up, *w_down, *gf;
    float* out; unsigned char* ws;
};
__device__ __forceinline__ void p0_prologue(const Ptrs& P, LAS unsigned char* lds, int lane, int wave, int gw, int NGW) {
    LAS float* scr = (LAS float*)(lds + RING_OFF + wave * 16384);
    bf16* WIN = (bf16*)(P.ws + WS_WIN); bf16* WOUT = (bf16*)(P.ws + WS_WOUT);
    constexpr int I_IN = 32 * 160, I_OUT = 32 * 64, NITEMS = I_IN + I_OUT;
    for (int it = gw; it < NITEMS; it += NGW) {
        if (it < I_IN) { const int kb = it / 160, nb = it % 160;
            if (nb < 96) tr_item(P.w_in, NIN, P.g1, 64 * kb, 32 * nb, WIN + (size_t)(32 * nb) * 2048 + 64 * kb, 2048, scr, lane);
            else { const int j0 = 32 * (nb - 96), jj = j0 & 1023, drow = 256 * (jj >> 7) + (jj & 127) + (j0 >= 1024 ? 128 : 0);
                tr_item8(P.w_in, NIN, P.g1, WSCALE, 64 * kb, 32 * nb, P.ws + WS_WIN8 + (size_t)drow * 2048 + 64 * kb, 2048, scr, lane); } }
        else { const int r = it - I_IN, kb = r >> 6, nb = r & 63; tr_item(P.w_out, 2048, nullptr, 64 * kb, 32 * nb, WOUT + (size_t)(32 * nb) * 2048 + 64 * kb, 2048, scr, lane); }
    }
    { bf16* WR = (bf16*)(P.ws + WS_WR);
      for (int it = gw; it < 32; it += NGW) tr_item(P.wer, 32, P.g2, 64 * it, 0, WR + 64 * it, 2048, scr, lane);
      for (int k = gw * 64 + lane; k < 2048; k += NGW * 64) { const float gk = P.g2[k]; const f32x4 w = *(const f32x4*)(P.wgr + (size_t)k * 4);
          WR[(size_t)128 * 2048 + k] = (bf16)f2bf(w.x * gk); WR[(size_t)129 * 2048 + k] = (bf16)f2bf(w.y * gk); WR[(size_t)130 * 2048 + k] = (bf16)f2bf(w.z * gk); WR[(size_t)131 * 2048 + k] = (bf16)f2bf(w.w * gk); } }
    bf16* XB = (bf16*)(P.ws + WS_XB); float* RS1 = (float*)(P.ws + WS_RSTD1);
    for (int m0 = gw; m0 < T; m0 += 2 * NGW) {
        f32x4 v[2][8]; float ss[2] = {0.f, 0.f};
#pragma unroll
        for (int q = 0; q < 2; ++q) { const int mr = (m0 + q * NGW < T) ? m0 + q * NGW : T - 1; const GAS f32x4* xr = (const GAS f32x4*)(P.x + (size_t)mr * D) + lane;
#pragma unroll
            for (int j = 0; j < 8; ++j) v[q][j] = xr[64 * j]; }
#pragma unroll
        for (int q = 0; q < 2; ++q) { const int m = m0 + q * NGW; if (m >= T) continue;
#pragma unroll
            for (int j = 0; j < 8; ++j) ss[q] += (v[q][j].x * v[q][j].x + v[q][j].y * v[q][j].y) + (v[q][j].z * v[q][j].z + v[q][j].w * v[q][j].w);
            ss[q] = wave_sum(ss[q]);
            if (lane == 0) RS1[m] = 1.0f / sqrtf(ss[q] * (1.0f / D) + EPS);
            GAS unsigned long long* o8 = (GAS unsigned long long*)(XB + (size_t)m * D) + lane; GAS unsigned* o4 = (GAS unsigned*)(P.ws + WS_X8 + (size_t)m * D) + lane;
#pragma unroll
            for (int j = 0; j < 8; ++j) { o8[64 * j] = (unsigned long long)pk2(v[q][j].x, v[q][j].y) | ((unsigned long long)pk2(v[q][j].z, v[q][j].w) << 32); o4[64 * j] = pg8::pk4_fp8(v[q][j].x, v[q][j].y, v[q][j].z, v[q][j].w); } }
    }
}

constexpr int CVT_ITEMS = 3 * 32768, CVT_CH = 4, CVT_CHUNK = CVT_CH * NWAVES, CVT_NCHUNK = CVT_ITEMS / CVT_CHUNK;
struct MoeItem { const float* src; const float* gk; unsigned char* dst; int N, k0, n0, dstK; };
__device__ __forceinline__ MoeItem moe_decode(const Ptrs& P, int r) {
    unsigned char* WGU = P.ws + WS_WGU; unsigned char* WD = P.ws + WS_WD; MoeItem m;
    const int mat = r >> 15, r2 = r & 32767, e = r2 >> 10, idx = r2 & 1023;
    if (mat < 2) { const int kb = idx >> 5, n0 = 32 * (idx & 31); const int drow = e * 2048 + 256 * (n0 >> 7) + (n0 & 127) + (mat == 1 ? 128 : 0);
        m.src = (mat == 0 ? P.w_gate : P.w_up) + (size_t)e * 2048 * 1024; m.N = 1024; m.gk = P.g2; m.k0 = 64 * kb; m.n0 = n0; m.dst = WGU + (size_t)drow * 2048 + 64 * kb; m.dstK = 2048; }
    else { const int kb = idx >> 6, nb = idx & 63; m.src = P.w_down + (size_t)e * 1024 * 2048; m.N = 2048; m.gk = nullptr; m.k0 = 64 * kb; m.n0 = 32 * nb; m.dst = WD + ((size_t)e * 2048 + 32 * nb) * 1024 + 64 * kb; m.dstK = 1024; }
    return m;
}
__device__ __forceinline__ void cvt_fill(const Ptrs& P, LAS unsigned char* lds, volatile LAS unsigned* slot, int max_chunks, const unsigned* donew, int G) {
    int tid_ = threadIdx.x; asm volatile("" : "+v"(tid_)); const int lane = tid_ & 63, wave = __builtin_amdgcn_readfirstlane(tid_ >> 6);
    LAS float* scr = (LAS float*)(lds + RING_OFF + wave * 16384); unsigned* ctr = (unsigned*)(P.ws + WS_CTL) + CW_CVQ;
    for (int n = 0; n < max_chunks; ++n) {
        if (threadIdx.x == 0) { unsigned v = 0xffffffffu;
            if (!(donew && (int)__hip_atomic_load(donew, __ATOMIC_RELAXED, __HIP_MEMORY_SCOPE_AGENT) >= G - 16)) v = __hip_atomic_fetch_add(ctr, 1u, __ATOMIC_RELAXED, __HIP_MEMORY_SCOPE_AGENT);
            *slot = v; }
        __syncthreads(); const unsigned c = *slot; __syncthreads();
        if (c >= (unsigned)CVT_NCHUNK) break;
#pragma unroll 1
        for (int j = 0; j < CVT_CH; j += 2) {
            const MoeItem m0 = moe_decode(P, (int)c * CVT_CHUNK + wave * CVT_CH + j), m1 = moe_decode(P, (int)c * CVT_CHUNK + wave * CVT_CH + j + 1);
            f32x4 v0[8], v1[8]; tr8_load(m0.src, m0.N, m0.k0, m0.n0, lane, v0); tr8_load(m1.src, m1.N, m1.k0, m1.n0, lane, v1);
            tr8_finish(v0, m0.gk, WSCALE, m0.k0, m0.dst, m0.dstK, scr, lane); tr8_finish(v1, m1.gk, WSCALE, m1.k0, m1.dst, m1.dstK, scr, lane); }
    }
}
__device__ __forceinline__ void h8_fill(const Ptrs& P, const bf16* HB, unsigned char* H8, volatile LAS unsigned* slot) {
    int tid_ = threadIdx.x; asm volatile("" : "+v"(tid_)); const int lane = tid_ & 63, wave = __builtin_amdgcn_readfirstlane(tid_ >> 6);
    unsigned* ctr = (unsigned*)(P.ws + WS_CTL) + CW_H8Q;
    for (;;) { const int c = attn_body::wg_pop(ctr, slot); if (c >= T / 64) break;
#pragma unroll 1
        for (int j = 0; j < 8; j += 4) { const int r0 = c * 64 + wave * 8 + j; u32x4g a[4][4];
#pragma unroll
            for (int q = 0; q < 4; ++q)
#pragma unroll
                for (int i = 0; i < 4; ++i) a[q][i] = *(const u32x4g*)(HB + (size_t)(r0 + q) * D + 16 * lane + 1024 * (i >> 1) + 8 * (i & 1));
#pragma unroll
            for (int q = 0; q < 4; ++q)
#pragma unroll
                for (int hj = 0; hj < 2; ++hj) { const u32x4g w0 = a[q][2 * hj], w1 = a[q][2 * hj + 1]; v4u o;
                    o.x = pg8::pk4_fp8(bflo(w0.x), bfhi(w0.x), bflo(w0.y), bfhi(w0.y)); o.y = pg8::pk4_fp8(bflo(w0.z), bfhi(w0.z), bflo(w0.w), bfhi(w0.w));
                    o.z = pg8::pk4_fp8(bflo(w1.x), bfhi(w1.x), bflo(w1.y), bfhi(w1.y)); o.w = pg8::pk4_fp8(bflo(w1.z), bfhi(w1.z), bflo(w1.w), bfhi(w1.w));
                    *(v4u*)(H8 + (size_t)(r0 + q) * D + 16 * lane + 1024 * hj) = o; } }
    }
}
__device__ __forceinline__ void phase_tail(const Ptrs& P, LAS unsigned char* lds, volatile LAS unsigned* slot, int ph, int G) {
    unsigned* donew = (unsigned*)(P.ws + WS_CTL) + CW_DONE + 64 * ph;
    __syncthreads();
    if (threadIdx.x == 0) __hip_atomic_fetch_add(donew, 1u, __ATOMIC_RELAXED, __HIP_MEMORY_SCOPE_AGENT);
    cvt_fill(P, lds, slot, 1 << 30, donew, G);
}

__device__ __forceinline__ void naive_attn(const Ptrs& P, const bf16* Q, const bf16* Kb, const bf16* Vb, bf16* MIX, int lane, int gw, int NGW) {
    const float s1 = wave_sum(P.lq1[lane] * P.lk1[lane]), s2 = wave_sum(P.lq2[lane] * P.lk2[lane]);
    const float lam0 = 0.2f, lam = expf(s1) - expf(s2) + lam0;
    const int r16 = lane & 15, c = (lane >> 4) & 1, vh = lane >> 5;
    for (int u = gw; u < 16384; u += NGW) {
        const int bh = u & 63, qb = 255 - (u >> 6), b = bh >> 3, h = bh & 7, i = qb * 16 + r16, jmax = qb * 16 + 15;
        const float sl2 = exp2f(-(float)(h + 1)) * LOG2E; const size_t rowb = (size_t)b * SEQ;
        float q[64], O[64];
        { const u32x4g* qp = (const u32x4g*)(Q + (rowb + i) * 1024 + h * 128 + c * 64);
#pragma unroll
          for (int d8 = 0; d8 < 8; ++d8) { const u32x4g w = qp[d8]; q[8 * d8 + 0] = bflo(w.x); q[8 * d8 + 1] = bfhi(w.x); q[8 * d8 + 2] = bflo(w.y); q[8 * d8 + 3] = bfhi(w.y);
              q[8 * d8 + 4] = bflo(w.z); q[8 * d8 + 5] = bfhi(w.z); q[8 * d8 + 6] = bflo(w.w); q[8 * d8 + 7] = bfhi(w.w); } }
#pragma unroll
        for (int d = 0; d < 64; ++d) O[d] = 0.f;
        float m = -1e30f, l = 0.f;
        for (int j = 0; j <= jmax; ++j) {
            const u32x4g* kp = (const u32x4g*)(Kb + (rowb + j) * 1024 + h * 128 + c * 64); float s = 0.f;
#pragma unroll
            for (int d8 = 0; d8 < 8; ++d8) { const u32x4g w = kp[d8];
                s += q[8 * d8 + 0] * bflo(w.x) + q[8 * d8 + 1] * bfhi(w.x) + q[8 * d8 + 2] * bflo(w.y) + q[8 * d8 + 3] * bfhi(w.y)
                   + q[8 * d8 + 4] * bflo(w.z) + q[8 * d8 + 5] * bfhi(w.z) + q[8 * d8 + 6] * bflo(w.w) + q[8 * d8 + 7] * bfhi(w.w); }
            s += sl2 * (float)(j - i);
            if (j <= i) {
                if (s > m) { const float al = fexp2(m - s); l *= al;
#pragma unroll
                    for (int d = 0; d < 64; ++d) O[d] *= al;
                    m = s; }
                const float p = fexp2(s - m); l += p;
                const u32x4g* vp = (const u32x4g*)(Vb + (rowb + j) * 1024 + h * 128 + vh * 64);
#pragma unroll
                for (int d8 = 0; d8 < 8; ++d8) { const u32x4g w = vp[d8];
                    O[8 * d8 + 0] += p * bflo(w.x); O[8 * d8 + 1] += p * bfhi(w.x); O[8 * d8 + 2] += p * bflo(w.y); O[8 * d8 + 3] += p * bfhi(w.y);
                    O[8 * d8 + 4] += p * bflo(w.z); O[8 * d8 + 5] += p * bfhi(w.z); O[8 * d8 + 6] += p * bflo(w.w); O[8 * d8 + 7] += p * bfhi(w.w); }
            }
        }
        const float il = 1.0f / l; float ss = 0.f;
#pragma unroll
        for (int d = 0; d < 64; ++d) { float o = O[d] * il; const float o2 = __shfl_xor(o, 16); o = o - lam * o2; O[d] = o; ss += o * o; }
        ss += __shfl_xor(ss, 32);
        const float r = (1.0f / sqrtf(ss * (1.0f / 128.0f) + EPS)) * (1.0f - lam0);
        if (c == 0) { u32x4g* op = (u32x4g*)(MIX + (rowb + i) * 2048 + h * 128 + vh * 64); const float* sg = P.subg + vh * 64;
#pragma unroll
            for (int d8 = 0; d8 < 8; ++d8) { u32x4g w; w.x = pk2(O[8 * d8 + 0] * r * sg[8 * d8 + 0], O[8 * d8 + 1] * r * sg[8 * d8 + 1]); w.y = pk2(O[8 * d8 + 2] * r * sg[8 * d8 + 2], O[8 * d8 + 3] * r * sg[8 * d8 + 3]);
                w.z = pk2(O[8 * d8 + 4] * r * sg[8 * d8 + 4], O[8 * d8 + 5] * r * sg[8 * d8 + 5]); w.w = pk2(O[8 * d8 + 6] * r * sg[8 * d8 + 6], O[8 * d8 + 7] * r * sg[8 * d8 + 7]); op[d8] = w; } }
    }
}

typedef float f32x2c __attribute__((ext_vector_type(2)));
__device__ __forceinline__ void conv_phase(const Ptrs& P, const bf16* CA, bf16* MIX, LAS unsigned char* lds, int blk, unsigned* qctr, volatile LAS unsigned* slot) {
    int tid_ = threadIdx.x; asm volatile("" : "+v"(tid_)); const int tid = tid_, lane = tid & 63, wave = __builtin_amdgcn_readfirstlane(tid >> 6);
    LAS unsigned* C = (LAS unsigned*)(lds + RING_OFF);
    f32x2c w[31];
#pragma unroll
    for (int j = 0; j < 31; ++j) w[j] = *(const f32x2c*)(P.cw + j * 1024 + 2 * tid);
    const f32x2c bias = *(const f32x2c*)(P.cb + 2 * tid);
    for (int qi = 0; qi < 8; ++qi) { const int xq = (blk + qi) & 7;
    for (;;) { const int n_ = attn_body::wg_pop(qctr + 64 * xq, slot); if (n_ >= 64) break;
        const int tile = xq + 8 * n_, b = tile >> 6, t0 = (tile & 63) * 64; const size_t rowb = (size_t)b * SEQ;
        const unsigned* up = (const unsigned*)(CA + rowb * 1024 + 2 * tid);
        f32x2c win[38]; unsigned hist[30];
#pragma unroll
        for (int k = 0; k < 30; ++k) { const int t = t0 - 30 + k; hist[k] = (t >= 0) ? up[(size_t)t * 512] : 0u; }
        unsigned nw[8];
#pragma unroll
        for (int i = 0; i < 8; ++i) nw[i] = up[(size_t)(t0 + i) * 512];
#pragma unroll
        for (int k = 0; k < 30; ++k) win[k] = (f32x2c){bflo(hist[k]), bfhi(hist[k])};
#pragma unroll 1
        for (int blk8 = 0; blk8 < 8; ++blk8) {
#pragma unroll
            for (int i = 0; i < 8; ++i) win[30 + i] = (f32x2c){bflo(nw[i]), bfhi(nw[i])};
            if (blk8 < 7) {
#pragma unroll
                for (int i = 0; i < 8; ++i) nw[i] = up[(size_t)(t0 + 8 * (blk8 + 1) + i) * 512];
            }
#pragma unroll
            for (int i = 0; i < 8; ++i) { f32x2c acc = bias;
#pragma unroll
                for (int j = 0; j < 31; ++j) acc = w[j] * win[i + j] + acc;
                C[(8 * blk8 + i) * 512 + tid] = pk2(acc.x, acc.y); }
#pragma unroll
            for (int k = 0; k < 30; ++k) win[k] = win[k + 8];
        }
        __syncthreads();
#pragma unroll 1
        for (int k = 0; k < 8; ++k) { const int rr = wave + 8 * k, t = t0 + rr; const LAS unsigned* row = C + rr * 512;
            const v4u x0 = *(const LAS v4u*)(row + 4 * lane), x1 = *(const LAS v4u*)(row + 256 + 4 * lane);
            float v[16] = {bflo(x0.x), bfhi(x0.x), bflo(x0.y), bfhi(x0.y), bflo(x0.z), bfhi(x0.z), bflo(x0.w), bfhi(x0.w), bflo(x1.x), bfhi(x1.x), bflo(x1.y), bfhi(x1.y), bflo(x1.z), bfhi(x1.z), bflo(x1.w), bfhi(x1.w)};
            float s = 0.f;
#pragma unroll
            for (int i = 0; i < 16; ++i) s += v[i];
            const float mean = wave_sum(s) * (1.0f / 1024.0f); float qq = 0.f;
#pragma unroll
            for (int i = 0; i < 16; ++i) { v[i] -= mean; qq += v[i] * v[i]; }
            const float rstd = 1.0f / sqrtf(wave_sum(qq) * (1.0f / 1024.0f) + EPS);
            float y[16];
#pragma unroll
            for (int i = 0; i < 16; ++i) { const int ch = (i < 8 ? 8 * lane + i : 512 + 8 * lane + (i - 8)); const float z = v[i] * rstd * P.lng[ch] + P.lnb[ch]; y[i] = z / (1.f + __expf(-z)); }
            bf16* op = MIX + (rowb + t) * 2048 + 1024 + 8 * lane;
            v4u o0, o1; o0.x = pk2(y[0], y[1]); o0.y = pk2(y[2], y[3]); o0.z = pk2(y[4], y[5]); o0.w = pk2(y[6], y[7]); o1.x = pk2(y[8], y[9]); o1.y = pk2(y[10], y[11]); o1.z = pk2(y[12], y[13]); o1.w = pk2(y[14], y[15]);
            *(GAS v4u*)op = o0; *(GAS v4u*)(op + 512) = o1; }
        __syncthreads();
    } }
}

__device__ __forceinline__ void router_phase(const Ptrs& P, const bf16* HB, int lane, int gw, int NGW) {
    float* RS2 = (float*)(P.ws + WS_RSTD2); float* WTS = (float*)(P.ws + WS_WTS); int* LIST = (int*)(P.ws + WS_LIST); unsigned* CNT = (unsigned*)(P.ws + WS_CTL) + CW_CNT;
    for (int tok = gw; tok < T; tok += NGW) {
        float hv[32]; const bf16* hp = HB + (size_t)tok * D; float ss = 0.f;
#pragma unroll
        for (int j = 0; j < 4; ++j) { const u32x4g w = *(const u32x4g*)(hp + 8 * lane + 512 * j);
            hv[8 * j + 0] = bflo(w.x); hv[8 * j + 1] = bfhi(w.x); hv[8 * j + 2] = bflo(w.y); hv[8 * j + 3] = bfhi(w.y); hv[8 * j + 4] = bflo(w.z); hv[8 * j + 5] = bfhi(w.z); hv[8 * j + 6] = bflo(w.w); hv[8 * j + 7] = bfhi(w.w); }
#pragma unroll
        for (int k = 0; k < 32; ++k) ss += hv[k] * hv[k];
        ss = wave_sum(ss); const float rstd = 1.0f / sqrtf(ss * (1.0f / D) + EPS);
        float lg[36];
#pragma unroll
        for (int o = 0; o < 36; ++o) lg[o] = 0.f;
#pragma unroll
        for (int j = 0; j < 4; ++j)
#pragma unroll 2
            for (int i = 0; i < 8; ++i) { const int e = 8 * lane + 512 * j + i; const float xv = hv[8 * j + i] * P.g2[e];
                const f32x4* wr = (const f32x4*)(P.wer + (size_t)e * 32); const f32x4 wg = *(const f32x4*)(P.wgr + (size_t)e * 4);
#pragma unroll
                for (int o4 = 0; o4 < 8; ++o4) { const f32x4 w = wr[o4]; lg[4 * o4 + 0] += xv * w.x; lg[4 * o4 + 1] += xv * w.y; lg[4 * o4 + 2] += xv * w.z; lg[4 * o4 + 3] += xv * w.w; }
                lg[32] += xv * wg.x; lg[33] += xv * wg.y; lg[34] += xv * wg.z; lg[35] += xv * wg.w; }
#pragma unroll
        for (int o = 0; o < 36; ++o) lg[o] = wave_sum(lg[o]) * rstd + (o < 32 ? P.ber[o] : P.bgr[o - 32]);
        int gs = 0; float gm = lg[32];
#pragma unroll
        for (int g = 1; g < 4; ++g) if (lg[32 + g] > gm) { gm = lg[32 + g]; gs = g; }
        float gsum = 0.f;
#pragma unroll
        for (int g = 0; g < 4; ++g) gsum += __expf(lg[32 + g] - gm);
        const float gw_ = 1.0f / gsum;
        float ev[8];
#pragma unroll
        for (int i = 0; i < 8; ++i) ev[i] = gs == 0 ? lg[i] : gs == 1 ? lg[8 + i] : gs == 2 ? lg[16 + i] : lg[24 + i];
        int i1 = 0; float v1 = ev[0];
#pragma unroll
        for (int i = 1; i < 8; ++i) if (ev[i] > v1) { v1 = ev[i]; i1 = i; }
        int i2 = -1; float v2 = -3.0e38f;
#pragma unroll
        for (int i = 0; i < 8; ++i) if (i != i1 && ev[i] > v2) { v2 = ev[i]; i2 = i; }
        const float e2 = __expf(v2 - v1), w1 = gw_ / (1.f + e2), w2 = gw_ * e2 / (1.f + e2);
        if (lane == 0) {
            RS2[tok] = rstd;
            const int ea = gs * 8 + i1, eb = gs * 8 + i2;
            const unsigned ra = __hip_atomic_fetch_add(CNT + 64 * ea, 1u, __ATOMIC_RELAXED, __HIP_MEMORY_SCOPE_AGENT);
            const unsigned rb = __hip_atomic_fetch_add(CNT + 64 * eb, 1u, __ATOMIC_RELAXED, __HIP_MEMORY_SCOPE_AGENT);
            LIST[(size_t)ea * T + ra] = 2 * tok; LIST[(size_t)eb * T + rb] = 2 * tok + 1; WTS[2 * tok] = w1; WTS[2 * tok + 1] = w2;
        }
    }
}
__device__ __forceinline__ void moe_tables(const Ptrs& P, LAS unsigned char* lds) {
    int tid = threadIdx.x; asm volatile("" : "+v"(tid));
    LAS int* cntL = (LAS int*)(lds + TAB_OFF); LAS int* ts = cntL + 32; unsigned* CNT = (unsigned*)(P.ws + WS_CTL) + CW_CNT;
    if (tid < 32) cntL[tid] = (int)__hip_atomic_load(CNT + 64 * tid, __ATOMIC_RELAXED, __HIP_MEMORY_SCOPE_AGENT);
    __syncthreads();
    if (tid == 0) { int s = 0; for (int e = 0; e < 32; ++e) { ts[e] = s; s += (cntL[e] + 255) >> 8; } ts[32] = s; }
    __syncthreads();
}

__device__ __forceinline__ float fp8f(unsigned w, int i) { return i == 0 ? __builtin_amdgcn_cvt_f32_fp8(w, 0) : i == 1 ? __builtin_amdgcn_cvt_f32_fp8(w, 1) : i == 2 ? __builtin_amdgcn_cvt_f32_fp8(w, 2) : __builtin_amdgcn_cvt_f32_fp8(w, 3); }
__device__ __forceinline__ void final_phase(const Ptrs& P, const bf16* HB, const unsigned char* Y8, int NGW) {
    int tid_ = threadIdx.x; asm volatile("" : "+v"(tid_)); const int lane = tid_ & 63, gw = (int)blockIdx.x * NWAVES + __builtin_amdgcn_readfirstlane(tid_ >> 6);
    for (int tok = gw; tok < T; tok += NGW) {
        const bf16* hp = HB + (size_t)tok * D; const unsigned char* y1 = Y8 + (size_t)tok * 4096; const unsigned char* y2 = y1 + 2048; float v[32]; float ss = 0.f;
#pragma unroll
        for (int j = 0; j < 4; ++j) { const int o = 8 * lane + 512 * j; const u32x4g a = *(const u32x4g*)(hp + o); const pg8::u32x2 b = *(const pg8::u32x2*)(y1 + o), c = *(const pg8::u32x2*)(y2 + o);
            const float ys = 1.0f / YSCALE;
            v[8 * j + 0] = bflo(a.x) + (fp8f(b.x, 0) + fp8f(c.x, 0)) * ys; v[8 * j + 1] = bfhi(a.x) + (fp8f(b.x, 1) + fp8f(c.x, 1)) * ys; v[8 * j + 2] = bflo(a.y) + (fp8f(b.x, 2) + fp8f(c.x, 2)) * ys; v[8 * j + 3] = bfhi(a.y) + (fp8f(b.x, 3) + fp8f(c.x, 3)) * ys;
            v[8 * j + 4] = bflo(a.z) + (fp8f(b.y, 0) + fp8f(c.y, 0)) * ys; v[8 * j + 5] = bfhi(a.z) + (fp8f(b.y, 1) + fp8f(c.y, 1)) * ys; v[8 * j + 6] = bflo(a.w) + (fp8f(b.y, 2) + fp8f(c.y, 2)) * ys; v[8 * j + 7] = bfhi(a.w) + (fp8f(b.y, 3) + fp8f(c.y, 3)) * ys; }
#pragma unroll
        for (int k = 0; k < 32; ++k) ss += v[k] * v[k];
        ss = wave_sum(ss); const float rstd = 1.0f / sqrtf(ss * (1.0f / D) + EPS);
        float* op = P.out + (size_t)tok * D;
#pragma unroll
        for (int j = 0; j < 4; ++j) { const int o = 8 * lane + 512 * j; const f32x4 g0 = *(const f32x4*)(P.gf + o), g1 = *(const f32x4*)(P.gf + o + 4);
            f32x4 r0 = {v[8 * j + 0] * rstd * g0.x, v[8 * j + 1] * rstd * g0.y, v[8 * j + 2] * rstd * g0.z, v[8 * j + 3] * rstd * g0.w};
            f32x4 r1 = {v[8 * j + 4] * rstd * g1.x, v[8 * j + 5] * rstd * g1.y, v[8 * j + 6] * rstd * g1.z, v[8 * j + 7] * rstd * g1.w};
            *(f32x4*)(op + o) = r0; *(f32x4*)(op + o + 4) = r1; }
    }
}

struct Args { const float* in[22]; float* out; unsigned char* ws; int ph_lo, ph_hi; };
__global__ void __launch_bounds__(NWAVES * 64, 2) fwd(Args args) {
    extern __shared__ __attribute__((aligned(16))) unsigned char lds_raw[];
    LAS unsigned char* lds = (LAS unsigned char*)lds_raw;
    volatile LAS unsigned* MISC = (volatile LAS unsigned*)(lds + MISC_OFF);
    const int tid = threadIdx.x, lane = tid & 63, wave = __builtin_amdgcn_readfirstlane(tid >> 6), G = gridDim.x;
    const int gw = blockIdx.x * NWAVES + wave, NGW = G * NWAVES;
    Ptrs P;
    P.x = args.in[0]; P.g1 = args.in[1]; P.w_in = args.in[2]; P.lq1 = args.in[3]; P.lk1 = args.in[4]; P.lq2 = args.in[5]; P.lk2 = args.in[6]; P.subg = args.in[7];
    P.cw = args.in[8]; P.cb = args.in[9]; P.lng = args.in[10]; P.lnb = args.in[11]; P.w_out = args.in[12]; P.g2 = args.in[13]; P.wgr = args.in[14]; P.bgr = args.in[15];
    P.wer = args.in[16]; P.ber = args.in[17]; P.w_gate = args.in[18]; P.w_up = args.in[19]; P.w_down = args.in[20]; P.gf = args.in[21]; P.out = args.out; P.ws = args.ws;
    unsigned char* ws = args.ws;
    bf16* WIN = (bf16*)(ws + WS_WIN); bf16* WOUT = (bf16*)(ws + WS_WOUT); unsigned char* WGU = ws + WS_WGU; unsigned char* WD = ws + WS_WD;
    bf16* XB = (bf16*)(ws + WS_XB); unsigned char* H1 = ws + WS_XB; unsigned char* HB8 = ws + WS_HB8; bf16* CGB = (bf16*)(ws + WS_CG); bf16* MIX = (bf16*)(ws + WS_MIX); bf16* HB = (bf16*)(ws + WS_HB);
    bf16* QB = (bf16*)args.out; bf16* KB = QB + (size_t)T * 1024; bf16* VB = KB + (size_t)T * 1024; bf16* CAB = VB + (size_t)T * 1024; bf16* YB = (bf16*)args.out;
    for (int u = tid; u < (LDS_BYTES - LDSCTL_OFF) / 4; u += NWAVES * 64) ((LAS unsigned*)(lds + LDSCTL_OFF))[u] = 0u;
    __syncthreads();
    const int lo = args.ph_lo, hi = args.ph_hi;
    XcdBarrier bar; bar.bar = (unsigned*)(ws + WS_CTL) + CW_BAR; bar.x = 0; bar.st = nullptr;
    if (hi - lo > 1) bar = xcd_barrier_post((unsigned*)(ws + WS_CTL) + CW_BAR, MISC + 8);
#define IN(k) (lo <= (k) && (k) < hi)
#if PROBE_PHASE >= 0
    unsigned long long pst_[NPHASE + 1]; pst_[0] = __builtin_amdgcn_s_memrealtime();
#define SEAM(k) do { if (IN(k) && IN((k) + 1)) xcd_barrier(bar); pst_[(k) + 1] = __builtin_amdgcn_s_memrealtime(); } while (0)
#else
#define SEAM(k) do { if (IN(k) && IN((k) + 1)) xcd_barrier(bar); } while (0)
#endif
#define REP(k) for (int rep_ = 0; rep_ <= ((PROBE_DOUBLE >> (k)) & 1); ++rep_)

    if (IN(0)) REP(0) { p0_prologue(P, lds, lane, wave, gw, NGW); }
    SEAM(0);
#if PROBE_CLOCK
    const long long pc0 = clock64(), pr0 = wall_clock64();
#endif
    if (IN(1)) {
        cvt_fill(P, lds, MISC + 12, (int)((blockIdx.x >> 3) % 8), nullptr, G);
        for (int pass = 0; pass < 2; ++pass) {
            if ((pass ^ (int)(blockIdx.x & 1)) == 0) { pg8::Gemm g{XB, WIN, 1, 3072, D, (unsigned*)(ws + WS_CTL) + 3002}; pg8::DynDense S; S.init(T, 3072, (unsigned*)(ws + WS_CTL) + CW_GQ + 0 * 512, (volatile LAS int*)(MISC + 16), (int)blockIdx.x);
                pg8::EpiIn E{QB, (size_t)T * 1024, CGB, (const float*)(ws + WS_RSTD1), C2, (unsigned*)(ws + WS_CTL) + CW_NMAX, 0, 1.0f};
                pg8::gemm_phase<pg8::EpiIn, pg8::DynDense, true, false>(lds + RING_OFF, g, S, E); }
            else { pg8::Gemm g{(const bf16*)(ws + WS_X8), (const bf16*)(ws + WS_WIN8), 2, 2048, D / 2, (unsigned*)(ws + WS_CTL) + 3002}; pg8::DynDenseG S; S.init(T, 2048, (unsigned*)(ws + WS_CTL) + CW_GQ + 1 * 512, (volatile LAS int*)(MISC + 16), (int)blockIdx.x);
                pg8::EpiGLU E{CAB, (const float*)(ws + WS_RSTD1), 1.0f / WSCALE};
                pg8::gemm_phase<pg8::EpiGLU, pg8::DynDenseG, true, true, true>(lds + RING_OFF, g, S, E); }
        }
#if PROBE_ATT == 6
        if (threadIdx.x == 0) atomicMax((unsigned*)(ws + WS_CTL) + CW_NMAX + 900, (unsigned)(__builtin_amdgcn_s_memrealtime() - pst_[1]));
#endif
#if PROBE_ATT == 7
        if (threadIdx.x == 0) atomicAdd((unsigned*)(ws + WS_CTL) + CW_NMAX + 900, (unsigned)(__builtin_amdgcn_s_memrealtime() - pst_[1]) >> 8);
#endif
#if PROBE_ATT == 5
        if (blockIdx.x == PROBE_BLK && threadIdx.x == 0) atomicAdd((unsigned*)(ws + WS_CTL) + CW_NMAX + 900, (unsigned)(__builtin_amdgcn_s_memrealtime() - pst_[1]));
#endif
        phase_tail(P, lds, MISC + 12, 1, G);
    }
#if PROBE_CLOCK
    if (IN(1) && tid == 0) { const unsigned dt = (unsigned)(wall_clock64() - pr0); atomicAdd((unsigned*)(ws + WS_CTL) + 3000, dt); atomicMax((unsigned*)(ws + WS_CTL) + 3001, dt); }
#endif
    SEAM(1);
    if (IN(2)) {
#if USE_NAIVE_ATTN
        naive_attn(P, QB, KB, VB, MIX, lane, gw, NGW);
#else
        { float s1 = 0.f, s2 = 0.f;
          for (int i = 0; i < 64; ++i) { s1 += P.lq1[i] * P.lk1[i]; s2 += P.lq2[i] * P.lk2[i]; }
          const float lam0 = 0.2f, lam = expf(s1) - expf(s2) + lam0;
          static_assert(attn_body::ATTN_LDS_BYTES <= RING_BYTES, "attention LDS");
          attn_body::attn_phase<8>((char*)lds_raw + RING_OFF, (int)blockIdx.x, (unsigned*)(ws + WS_CTL) + CW_QA, MISC + 12, lam, 1.0f - lam0, P.subg, (const unsigned*)(ws + WS_CTL) + CW_NMAX, (unsigned*)(ws + WS_O1S) + (size_t)blockIdx.x * 16384,
                                   (const attn_body::bf16*)QB, (const attn_body::bf16*)KB, (const attn_body::bf16*)VB, (attn_body::bf16*)MIX); }
#endif
        conv_phase(P, CAB, MIX, lds, (int)blockIdx.x, (unsigned*)(ws + WS_CTL) + CW_QC, MISC + 12);
#if PROBE_ATT == 2
        if (blockIdx.x == PROBE_BLK && threadIdx.x == 0) atomicAdd((unsigned*)(ws + WS_CTL) + CW_NMAX + 900, (unsigned)(__builtin_amdgcn_s_memrealtime() - pst_[2]));
#endif
        phase_tail(P, lds, MISC + 12, 2, G);
    }
    SEAM(2);
    if (IN(3)) {
        pg8::Gemm g{MIX, WOUT, 3, D, D, (unsigned*)(ws + WS_CTL) + 3002}; pg8::StaticOrder S; S.init(T, D, G, (int)blockIdx.x); S.rep = 1 + ((PROBE_DOUBLE >> 3) & 1);
        pg8::EpiOut E{HB, XB, (float*)(ws + WS_PART), nullptr};
        pg8::gemm_phase<pg8::EpiOut, pg8::StaticOrder, true, false>(lds + RING_OFF, g, S, E);
        phase_tail(P, lds, MISC + 12, 3, G);
    }
    SEAM(3);
#if PROBE_ATT == 9
    if (IN(4) && blockIdx.x == PROBE_BLK && threadIdx.x == 0) atomicAdd((unsigned*)(ws + WS_CTL) + CW_NMAX + 900, 10u * __hip_atomic_load((unsigned*)(ws + WS_CTL) + CW_CVQ, __ATOMIC_RELAXED, __HIP_MEMORY_SCOPE_AGENT));
#endif
#if USE_NAIVE_ROUTER
    if (IN(4)) { router_phase(P, HB, lane, gw, NGW); }
#else
    if (IN(4)) {
        pg8::Gemm g{HB, (const bf16*)(ws + WS_WR), T, 256, D}; pg8::StaticOrder S; S.init(T, 256, G, (int)blockIdx.x);
        pg8::EpiRouter E{(const float*)(ws + WS_PART), P.ber, P.bgr, (float*)(ws + WS_LISTR), (float*)(ws + WS_LISTW), (int*)(ws + WS_LIST), (unsigned*)(ws + WS_CTL) + CW_CNT, T};
        pg8::gemm_phase<pg8::EpiRouter, pg8::StaticOrder, true, false>(lds + RING_OFF, g, S, E);
        h8_fill(P, HB, HB8, MISC + 12);
        phase_tail(P, lds, MISC + 12, 4, G);
#if PROBE_ATT == 8
        if (blockIdx.x == PROBE_BLK && threadIdx.x == 0) atomicAdd((unsigned*)(ws + WS_CTL) + CW_NMAX + 900, 10u * __hip_atomic_load((unsigned*)(ws + WS_CTL) + CW_CVQ, __ATOMIC_RELAXED, __HIP_MEMORY_SCOPE_AGENT));
#endif
        cvt_fill(P, lds, MISC + 12, 1 << 30, nullptr, G);
    }
#endif
    SEAM(4);
    if (IN(5)) {
        moe_tables(P, lds);
        pg8::Gemm g{(const bf16*)HB8, (const bf16*)WGU, 5, 2048, D / 2, (unsigned*)(ws + WS_CTL) + 3002};
        pg8::MoeOrder S{(const LAS int*)(lds + TAB_OFF) + 32, (const LAS int*)(lds + TAB_OFF), (const int*)(ws + WS_LIST), G, (int)blockIdx.x, 1, T, (size_t)2048 * 2048, 0};
        pg8::EpiGU E{H1, (const int*)(ws + WS_LIST), (const float*)(ws + WS_LISTR), 1.0f / WSCALE, H1SCALE};
        pg8::gemm_phase<pg8::EpiGU, pg8::MoeOrder, true, true, true>(lds + RING_OFF, g, S, E);
    }
    SEAM(5);
    if (IN(6)) {
        moe_tables(P, lds);
        pg8::Gemm g{(const bf16*)H1, (const bf16*)WD, 6, 2048, 512, (unsigned*)(ws + WS_CTL) + 3002};
        pg8::MoeOrder S{(const LAS int*)(lds + TAB_OFF) + 32, (const LAS int*)(lds + TAB_OFF), (const int*)(ws + WS_LIST), G, (int)blockIdx.x, 0, T, (size_t)2048 * 1024, 1};
        pg8::EpiDown E{ws + WS_MIX, (const int*)(ws + WS_LIST), (const float*)(ws + WS_LISTW), YSCALE / (WSCALE * H1SCALE)};
        pg8::gemm_phase<pg8::EpiDown, pg8::MoeOrder, true, true, true>(lds + RING_OFF, g, S, E);
    }
    SEAM(6);
    if (IN(7)) { final_phase(P, HB, ws + WS_MIX, NGW); }
#if PROBE_ATT
    if (blockIdx.x == 0) { const unsigned long long span = __hip_atomic_load((unsigned*)(ws + WS_CTL) + CW_NMAX + 900, __ATOMIC_RELAXED, __HIP_MEMORY_SCOPE_AGENT); const unsigned long long r1 = __builtin_amdgcn_s_memrealtime(); while (__builtin_amdgcn_s_memrealtime() - r1 < span) __builtin_amdgcn_s_sleep(8); }
#endif
#if PROBE_PHASE >= 0
    pst_[NPHASE] = __builtin_amdgcn_s_memrealtime();
    if (blockIdx.x == 0 && PROBE_PHASE < 100) { const unsigned long long span = pst_[(PROBE_PHASE < 100 ? PROBE_PHASE : 0) + 1] - pst_[PROBE_PHASE < 100 ? PROBE_PHASE : 0]; const unsigned long long r1 = __builtin_amdgcn_s_memrealtime(); while (__builtin_amdgcn_s_memrealtime() - r1 < span) __builtin_amdgcn_s_sleep(8); }
#endif
#if PROBE_KLOOP
    if (blockIdx.x == 0) { const long long pticks = (long long)__hip_atomic_load((unsigned*)(ws + WS_CTL) + 3002, __ATOMIC_RELAXED, __HIP_MEMORY_SCOPE_AGENT); const long long r1 = wall_clock64(); while (wall_clock64() - r1 < pticks) __builtin_amdgcn_s_sleep(8); }
#endif
#if PROBE_CLOCK
    if (blockIdx.x == 0) { const unsigned sum = __hip_atomic_load((unsigned*)(ws + WS_CTL) + 3000, __ATOMIC_RELAXED, __HIP_MEMORY_SCOPE_AGENT), mx = __hip_atomic_load((unsigned*)(ws + WS_CTL) + 3001, __ATOMIC_RELAXED, __HIP_MEMORY_SCOPE_AGENT);
        const long long pticks = (long long)mx - (long long)(sum / (unsigned)G); const long long r1 = wall_clock64(); while (wall_clock64() - r1 < pticks) __builtin_amdgcn_s_sleep(8); }
#endif
#undef IN
#undef SEAM
#undef REP
}

extern "C" void kernel_launch(void* const* d_in, const int* in_sizes, int n_in, void* d_out, int out_size, void* d_ws, size_t ws_size, hipStream_t stream) {
    static int grid = 0;
    if (grid == 0) {
        if (n_in != 22 || in_sizes[0] != T * D || out_size != T * D || ws_size < WS_END) { fprintf(stderr, "kernel_launch: unexpected shapes (n_in %d, in0 %d, out %d, ws %zu); nothing launched\n", n_in, n_in > 0 ? in_sizes[0] : -1, out_size, ws_size); grid = -1; return; }
        int dev = 0, cus = 0, per_cu = 0;
        if (hipGetDevice(&dev) != hipSuccess || hipDeviceGetAttribute(&cus, hipDeviceAttributeMultiprocessorCount, dev) != hipSuccess) { grid = -1; return; }
        if (hipFuncSetAttribute((const void*)fwd, hipFuncAttributeMaxDynamicSharedMemorySize, LDS_BYTES) != hipSuccess) { fprintf(stderr, "kernel_launch: hipFuncSetAttribute failed\n"); grid = -1; return; }
        if (hipOccupancyMaxActiveBlocksPerMultiprocessor(&per_cu, (const void*)fwd, NWAVES * 64, LDS_BYTES) != hipSuccess || per_cu < 1) fprintf(stderr, "kernel_launch: occupancy query reports %d\n", per_cu);
        (void)hipGetLastError();
        grid = cus;
    }
    if (grid < 0) return;
    if (hipMemsetAsync((char*)d_ws + WS_CTL, 0, CTL_ZERO_BYTES, stream) != hipSuccess) return;
    Args a{};
    for (int i = 0; i < 22; ++i) a.in[i] = (const float*)d_in[i];
    a.out = (float*)d_out; a.ws = (unsigned char*)d_ws;
#if MK_ONE_LAUNCH
    a.ph_lo = 0; a.ph_hi = NPHASE;
    hipLaunchKernelGGL(fwd, dim3(grid), dim3(NWAVES * 64), LDS_BYTES, stream, a);
#else
    for (int p = 0; p < NPHASE; ++p) { a.ph_lo = p; a.ph_hi = p + 1; hipLaunchKernelGGL(fwd, dim3(grid), dim3(NWAVES * 64), LDS_BYTES, stream, a); }
#endif
}
```

```cpp
#include <hip/hip_runtime.h>
#include <cstdio>
#include <cstdint>
#ifndef PROBE_KLOOP
#define PROBE_KLOOP 0
#endif
#ifndef PROBE_WHAT
#define PROBE_WHAT 0
#endif
#ifndef PROBE_PHASE
#define PROBE_PHASE -1
#endif
#ifndef PROBE_ATT
#define PROBE_ATT 0
#endif
#ifndef PROBE_BLK
#define PROBE_BLK 0
#endif
namespace pg8 {
#define PG8_LAS __attribute__((address_space(3)))
typedef unsigned short bf16_t;
typedef short bf16x8 __attribute__((ext_vector_type(8)));
typedef float f32x4 __attribute__((ext_vector_type(4)));
typedef unsigned u32x4 __attribute__((ext_vector_type(4)));
constexpr int BM = 256, BK = 64, HALF = 128, HTB = HALF * BK * 2  , STAGE_BYTES = 8 * HTB, NXCD = 8, WGM = 8;

__host__ __device__ __forceinline__ int lds_byte(int r, int c) { const int st = (r >> 4) * 2 + (c >> 5), rr = r & 15, cc = c & 31, ob = rr * 64 + cc * 2; return st * 1024 + (ob ^ (((ob >> 9) & 1) << 5)); }
__host__ __device__ __forceinline__ void stage_rc(int b, int& R, int& C) { const int st = b / 1024, sb = b % 1024, swz = sb ^ (((sb >> 9) & 1) << 5); R = (st >> 1) * 16 + swz / 64; C = (st & 1) * 32 + (swz % 64) / 2; }
__host__ __device__ __forceinline__ int perm32(int rho) { const int n = rho >> 4, i = rho & 15; return 8 * (i >> 2) + 4 * n + (i & 3); }

struct Unit { int pm, pn, e, nvalid, lbase, srow; };
struct Gemm { const bf16_t* A; const bf16_t* Bt; int M, N, K; unsigned* probe = nullptr; };

struct StaticOrder {
    int nM, nN, nwg, G, c, rep = 1;
    __host__ __device__ void init(int M, int N, int G_, int c_) { nM = M / BM; nN = N / BM; nwg = nM * nN; G = G_; c = c_; }
    __host__ __device__ bool next(int i, Unit& u) const {
        long L = (long)i * G + c; if (L >= (long)nwg * rep) return false; L %= nwg;
        int wgid = (int)L; { const int q = nwg / NXCD, r = nwg % NXCD, xcd = wgid % NXCD, off = wgid / NXCD; wgid = (xcd < r ? xcd * (q + 1) : r * (q + 1) + (xcd - r) * q) + off; }
        const int nig = WGM * nN, gid = wgid / nig, fm = gid * WGM, gsz = (nM - fm) < WGM ? (nM - fm) : WGM;
        u.pm = fm + ((wgid % nig) % gsz); u.pn = (wgid % nig) / gsz; return true;
    }
    __device__ __forceinline__ const char* bbase(const Gemm& g, const Unit& u, size_t tstep) const { return (const char*)g.Bt + (size_t)u.pn * tstep; }
    __device__ __forceinline__ unsigned goff(const Unit&, int, int, int) const { return 0u; }
    __device__ __forceinline__ void a_ready(const Unit&) const {}
    __device__ __forceinline__ void done(const Unit&) const {}
};

struct StaticOrderG : StaticOrder {
    __device__ __forceinline__ unsigned goff(const Unit& u, int r, int C, int K) const { return ((unsigned)(u.pm * BM + r) * (unsigned)K + (unsigned)C) * 2u; }
};

struct MoeOrder {
    const PG8_LAS int* tstart; const PG8_LAS int* cnt; const int* list; int G, c, shift, lcap; size_t estride; int sorted;
    __device__ __forceinline__ bool next(int i, Unit& u) const {
        const int ntiles = tstart[32]; const int x = c & 7, k = i * (G >> 3) + (c >> 3); const int rt = 2 * (k >> 1) + (x & 1); if (rt >= ntiles) return false;
        int e = 0;
#pragma unroll
        for (int q = 1; q < 32; ++q) e += (tstart[q] <= rt) ? 1 : 0;
        e = __builtin_amdgcn_readfirstlane(e);
        const int pm = __builtin_amdgcn_readfirstlane(rt - tstart[e]); const int rem = __builtin_amdgcn_readfirstlane(cnt[e]) - 256 * pm;
        u.pm = pm; u.pn = 2 * (x >> 1) + (k & 1); u.e = e; u.nvalid = rem < 256 ? rem : 256; u.lbase = e * lcap + 256 * pm; u.srow = 256 * rt; return true;
    }
    __device__ __forceinline__ const char* bbase(const Gemm& g, const Unit& u, size_t tstep) const { return (const char*)g.Bt + (size_t)u.e * estride + (size_t)u.pn * tstep; }
    __device__ __forceinline__ unsigned goff(const Unit& u, int r, int C, int K) const {
        if (sorted) return ((unsigned)(u.srow + r) * (unsigned)K + (unsigned)C) * 2u;
        const int a = list[u.lbase + (r < u.nvalid ? r : 0)];
        return ((unsigned)(a >> shift) * (unsigned)K + (unsigned)C) * 2u;
    }
    __device__ __forceinline__ void a_ready(const Unit&) const {}
    __device__ __forceinline__ void done(const Unit&) const {}
};

struct DynQ {
    unsigned* ctr; volatile PG8_LAS int* slot; int x0, qi; unsigned pend;
    __device__ __forceinline__ void qinit(unsigned* ctr_, volatile PG8_LAS int* slot_, int bx) { ctr = ctr_; slot = slot_; x0 = bx & 7; qi = 0; pend = 0u;
        if (threadIdx.x == 0) pend = __hip_atomic_fetch_add(ctr + 64 * x0, 1u, __ATOMIC_RELAXED, __HIP_MEMORY_SCOPE_AGENT); }
    template <class SizeF> __device__ __forceinline__ int qnext(int i, const SizeF& size_of) {
        const int par = i & 1;
        if (threadIdx.x == 0) { int res = -1;
            while (qi < 8) { const int x = (x0 + qi) & 7; if (pend < (unsigned)size_of(x)) { res = (x << 24) | (int)pend; break; }
                ++qi; if (qi < 8) pend = __hip_atomic_fetch_add(ctr + 64 * ((x0 + qi) & 7), 1u, __ATOMIC_RELAXED, __HIP_MEMORY_SCOPE_AGENT); }
            slot[par] = res;
            if (res >= 0) pend = __hip_atomic_fetch_add(ctr + 64 * ((x0 + qi) & 7), 1u, __ATOMIC_RELAXED, __HIP_MEMORY_SCOPE_AGENT); }
        asm volatile("s_waitcnt lgkmcnt(0)" ::: "memory"); __builtin_amdgcn_s_barrier(); asm volatile("" ::: "memory");
        return __builtin_amdgcn_readfirstlane(slot[par]);
    }
};
struct DynDense : DynQ {
    int nM, nN, nwg;
    __device__ __forceinline__ void init(int M, int N, unsigned* ctr_, volatile PG8_LAS int* slot_, int bx) { nM = M / BM; nN = N / BM; nwg = nM * nN; qinit(ctr_, slot_, bx); }
    __device__ __forceinline__ bool next(int i, Unit& u) {
        const int q = nwg / NXCD, r = nwg % NXCD;
        const int code = qnext(i, [=](int x) { return q + (x < r ? 1 : 0); }); if (code < 0) return false;
        const int x = code >> 24, k = code & 0xffffff; const int wgid = (x < r ? x * (q + 1) : r * (q + 1) + (x - r) * q) + k;
        const int nig = WGM * nN, gid = wgid / nig, fm = gid * WGM, gsz = (nM - fm) < WGM ? (nM - fm) : WGM;
        u.pm = fm + ((wgid % nig) % gsz); u.pn = (wgid % nig) / gsz; return true;
    }
    __device__ __forceinline__ const char* bbase(const Gemm& g, const Unit& u, size_t tstep) const { return (const char*)g.Bt + (size_t)u.pn * tstep; }
    __device__ __forceinline__ unsigned goff(const Unit&, int, int, int) const { return 0u; }
    __device__ __forceinline__ void a_ready(const Unit&) const {}
    __device__ __forceinline__ void done(const Unit&) const {}
};
struct DynDenseG : DynDense {
    __device__ __forceinline__ unsigned goff(const Unit& u, int r, int C, int K) const { return ((unsigned)(u.pm * BM + r) * (unsigned)K + (unsigned)C) * 2u; }
};

__device__ __forceinline__ unsigned cvt_pk_bf16(float lo, float hi) { unsigned r; asm volatile("v_cvt_pk_bf16_f32 %0, %1, %2" : "=v"(r) : "v"(lo), "v"(hi)); return r; }
__device__ __forceinline__ float bf_lo(unsigned w) { return __builtin_bit_cast(float, w << 16); }
__device__ __forceinline__ float bf_hi(unsigned w) { return __builtin_bit_cast(float, w & 0xffff0000u); }
__device__ __forceinline__ unsigned pk4_fp8(float a, float b, float c, float d) {
    a = __builtin_amdgcn_fmed3f(a, -440.f, 440.f); b = __builtin_amdgcn_fmed3f(b, -440.f, 440.f); c = __builtin_amdgcn_fmed3f(c, -440.f, 440.f); d = __builtin_amdgcn_fmed3f(d, -440.f, 440.f);
    int r = __builtin_amdgcn_cvt_pk_fp8_f32(a, b, 0, false); r = __builtin_amdgcn_cvt_pk_fp8_f32(c, d, r, true); return (unsigned)r; }
typedef unsigned u32x2 __attribute__((ext_vector_type(2)));
__device__ __forceinline__ void swap16(u32x2& a, u32x2& b) { auto r0 = __builtin_amdgcn_permlane16_swap(a.x, b.x, false, false); auto r1 = __builtin_amdgcn_permlane16_swap(a.y, b.y, false, false); a = (u32x2){r0[0], r1[0]}; b = (u32x2){r0[1], r1[1]}; }
typedef int v4i_t __attribute__((ext_vector_type(4)));

struct EpiIn {
    static constexpr bool PERM = true, AFTER_DRAIN = false;
    bf16_t* P0; size_t stride; bf16_t* CG; const float* rstd; float scale0; unsigned* nmax; int tbase; float oscale;
    __device__ __forceinline__ void operator()(const f32x4 (&acc)[2][2][4][2], const Unit& u, int wr, int wc, int fr, int fq) const {
        const int row0 = u.pm * BM + wr * 64 + fr, t = (u.pn >> 2) + tbase; bf16_t* base = (t < 4) ? P0 + (size_t)t * stride : CG;
        const float sc = ((t == 0) ? scale0 : 1.f) * oscale; const int col0 = (u.pn & 3) * BM + wc * 32 + 8 * fq;
        float mx[2] = {0.f, 0.f}; float rsv[2][4];
#pragma unroll
        for (int ai = 0; ai < 2; ++ai)
#pragma unroll
            for (int m = 0; m < 4; ++m) rsv[ai][m] = rstd[row0 + ai * HALF + m * 16];
#pragma unroll
        for (int ai = 0; ai < 2; ++ai)
#pragma unroll
            for (int m = 0; m < 4; ++m) { const int row = row0 + ai * HALF + m * 16; const float rs = rsv[ai][m] * sc; bf16_t* rowp = base + (size_t)row * 1024 + col0;
#pragma unroll
                for (int bj = 0; bj < 2; ++bj) { const f32x4 v0 = acc[ai][bj][m][0] * rs, v1 = acc[ai][bj][m][1] * rs;
                    u32x4 w; w.x = cvt_pk_bf16(v0[0], v0[1]); w.y = cvt_pk_bf16(v0[2], v0[3]); w.z = cvt_pk_bf16(v1[0], v1[1]); w.w = cvt_pk_bf16(v1[2], v1[3]);
                    *(u32x4*)(rowp + bj * HALF) = w;
                    if (t < 2) { float ss = (v0[0] * v0[0] + v0[1] * v0[1]) + (v0[2] * v0[2] + v0[3] * v0[3]) + (v1[0] * v1[0] + v1[1] * v1[1]) + (v1[2] * v1[2] + v1[3] * v1[3]);
                        ss += __shfl_xor(ss, 16); ss += __shfl_xor(ss, 32); mx[bj] = __builtin_fmaxf(mx[bj], ss); } } }
        if (t < 2) {
#pragma unroll
            for (int bj = 0; bj < 2; ++bj) { float v = mx[bj];
                v = __builtin_fmaxf(v, __shfl_xor(v, 1)); v = __builtin_fmaxf(v, __shfl_xor(v, 2)); v = __builtin_fmaxf(v, __shfl_xor(v, 4)); v = __builtin_fmaxf(v, __shfl_xor(v, 8));
                const int colb = (u.pn & 3) * BM + bj * HALF + wc * 32, g64 = colb >> 6, bh = (u.pm >> 4) * 8 + (g64 >> 1);
                if (fr == 0 && fq == 0) atomicMax(nmax + ((t * 64 + bh) * 2 + (g64 & 1)) * 2 + (wc & 1), __builtin_bit_cast(unsigned, v)); }
        }
    }
};
struct EpiGLU {
    static constexpr bool PERM = true, AFTER_DRAIN = false;
    bf16_t* U; const float* rstd; float oscale;
    __device__ __forceinline__ void operator()(const f32x4 (&acc)[2][2][4][2], const Unit& u, int wr, int wc, int fr, int fq) const {
        const int row0 = u.pm * BM + wr * 64 + fr, col0 = u.pn * HALF + wc * 32 + 8 * fq; float rsv[2][4];
#pragma unroll
        for (int ai = 0; ai < 2; ++ai)
#pragma unroll
            for (int m = 0; m < 4; ++m) rsv[ai][m] = rstd[row0 + ai * HALF + m * 16];
#pragma unroll
        for (int ai = 0; ai < 2; ++ai)
#pragma unroll
            for (int m = 0; m < 4; ++m) { const int row = row0 + ai * HALF + m * 16; const float rs = rsv[ai][m] * oscale;
                const f32x4 a0 = acc[ai][0][m][0] * rs, a1 = acc[ai][0][m][1] * rs, g0 = acc[ai][1][m][0] * rs, g1 = acc[ai][1][m][1] * rs;
#define PG8_SG(x) __builtin_amdgcn_rcpf(1.f + __builtin_amdgcn_exp2f(-1.4426950408889634f * (x)))
                u32x4 w; w.x = cvt_pk_bf16(a0[0] * PG8_SG(g0[0]), a0[1] * PG8_SG(g0[1])); w.y = cvt_pk_bf16(a0[2] * PG8_SG(g0[2]), a0[3] * PG8_SG(g0[3]));
                w.z = cvt_pk_bf16(a1[0] * PG8_SG(g1[0]), a1[1] * PG8_SG(g1[1])); w.w = cvt_pk_bf16(a1[2] * PG8_SG(g1[2]), a1[3] * PG8_SG(g1[3]));
#undef PG8_SG
                *(u32x4*)(U + (size_t)row * 1024 + col0) = w; }
    }
};
struct EpiOut {
    static constexpr bool PERM = true, AFTER_DRAIN = false;
    bf16_t* H; const bf16_t* XB; float* part; unsigned char* H8;
    __device__ __forceinline__ void operator()(const f32x4 (&acc)[2][2][4][2], const Unit& u, int wr, int wc, int fr, int fq) const {
        const int row0 = u.pm * BM + wr * 64 + fr, col0 = u.pn * BM + wc * 32 + 8 * fq;
#pragma unroll
        for (int ai = 0; ai < 2; ++ai) { u32x4 xbv[4][2];
#pragma unroll
            for (int m = 0; m < 4; ++m)
#pragma unroll
                for (int bj = 0; bj < 2; ++bj) xbv[m][bj] = *(const u32x4*)(XB + (size_t)(row0 + ai * HALF + m * 16) * 2048 + col0 + bj * HALF);
#pragma unroll
            for (int m = 0; m < 4; ++m) { const int row = row0 + ai * HALF + m * 16; const size_t off = (size_t)row * 2048 + col0; float ss = 0.f;
#pragma unroll
                for (int bj = 0; bj < 2; ++bj) { const u32x4 xb = xbv[m][bj];
                    f32x4 v0 = acc[ai][bj][m][0], v1 = acc[ai][bj][m][1];
                    v0[0] += bf_lo(xb.x); v0[1] += bf_hi(xb.x); v0[2] += bf_lo(xb.y); v0[3] += bf_hi(xb.y); v1[0] += bf_lo(xb.z); v1[1] += bf_hi(xb.z); v1[2] += bf_lo(xb.w); v1[3] += bf_hi(xb.w);
                    ss += (v0[0] * v0[0] + v0[1] * v0[1]) + (v0[2] * v0[2] + v0[3] * v0[3]) + (v1[0] * v1[0] + v1[1] * v1[1]) + (v1[2] * v1[2] + v1[3] * v1[3]);
                    u32x4 w; w.x = cvt_pk_bf16(v0[0], v0[1]); w.y = cvt_pk_bf16(v0[2], v0[3]); w.z = cvt_pk_bf16(v1[0], v1[1]); w.w = cvt_pk_bf16(v1[2], v1[3]);
                    *(u32x4*)(H + off + bj * HALF) = w;
                    if (H8) { u32x2 w8; w8.x = pk4_fp8(v0[0], v0[1], v0[2], v0[3]); w8.y = pk4_fp8(v1[0], v1[1], v1[2], v1[3]); *(u32x2*)(H8 + off + bj * HALF) = w8; } }
                ss += __shfl_xor(ss, 16); ss += __shfl_xor(ss, 32);
                if (fq == 0) part[(size_t)row * 32 + u.pn * 4 + wc] = ss; } }
    }
};
__device__ __forceinline__ float silu_f(float x) { return x * __builtin_amdgcn_rcpf(1.f + __builtin_amdgcn_exp2f(-1.4426950408889634f * x)); }
struct EpiGU {
    static constexpr bool PERM = true, AFTER_DRAIN = false;
    unsigned char* H1; const int* list; const float* listr; float wscale, oscale;
    __device__ __forceinline__ void operator()(const f32x4 (&acc)[2][2][4][2], const Unit& u, int wr, int wc, int fr, int fq) const {
        const int col0 = u.pn * HALF + wc * 32 + 8 * fq;
        float rsv[2][4];
#pragma unroll
        for (int ai = 0; ai < 2; ++ai)
#pragma unroll
            for (int m = 0; m < 4; ++m) { const int r = ai * HALF + wr * 64 + m * 16 + fr; rsv[ai][m] = listr[u.lbase + (r < u.nvalid ? r : 0)]; }
#pragma unroll
        for (int ai = 0; ai < 2; ++ai)
#pragma unroll
            for (int mp = 0; mp < 4; mp += 2) { u32x2 wv[2];
#pragma unroll
                for (int q = 0; q < 2; ++q) { const int m = mp + q; const float rs = rsv[ai][m] * wscale;
                    const f32x4 g0 = acc[ai][0][m][0] * rs, g1 = acc[ai][0][m][1] * rs, u0 = acc[ai][1][m][0] * (rs * oscale), u1 = acc[ai][1][m][1] * (rs * oscale);
                    wv[q].x = pk4_fp8(silu_f(g0[0]) * u0[0], silu_f(g0[1]) * u0[1], silu_f(g0[2]) * u0[2], silu_f(g0[3]) * u0[3]);
                    wv[q].y = pk4_fp8(silu_f(g1[0]) * u1[0], silu_f(g1[1]) * u1[1], silu_f(g1[2]) * u1[2], silu_f(g1[3]) * u1[3]); }
                swap16(wv[0], wv[1]);
                const int odd = fq & 1, r = ai * HALF + wr * 64 + (mp + odd) * 16 + fr;
                if (r < u.nvalid) { const u32x4 w = {wv[0].x, wv[0].y, wv[1].x, wv[1].y};
                    *(u32x4*)(H1 + (size_t)(u.srow + r) * 1024 + col0 - 8 * odd) = w; } }
    }
};
struct EpiDown {
    static constexpr bool PERM = true, AFTER_DRAIN = false;
    unsigned char* Y; const int* list; const float* listw; float oscale;
    __device__ __forceinline__ void operator()(const f32x4 (&acc)[2][2][4][2], const Unit& u, int wr, int wc, int fr, int fq) const {
        const int col0 = u.pn * BM + wc * 32 + 8 * fq;
        int av[2][4]; float wv[2][4];
#pragma unroll
        for (int ai = 0; ai < 2; ++ai)
#pragma unroll
            for (int m = 0; m < 4; ++m) { const int r = ai * HALF + wr * 64 + m * 16 + fr, ix = u.lbase + (r < u.nvalid ? r : 0); av[ai][m] = list[ix]; wv[ai][m] = listw[ix]; }
#pragma unroll
        for (int ai = 0; ai < 2; ++ai)
#pragma unroll
            for (int m = 0; m < 4; ++m) { const int r = ai * HALF + wr * 64 + m * 16 + fr; const int a = av[ai][m]; const float ws = wv[ai][m] * oscale;
                u32x2 w0, w1;
                { const f32x4 v0 = acc[ai][0][m][0] * ws, v1 = acc[ai][0][m][1] * ws; w0.x = pk4_fp8(v0[0], v0[1], v0[2], v0[3]); w0.y = pk4_fp8(v1[0], v1[1], v1[2], v1[3]); }
                { const f32x4 v0 = acc[ai][1][m][0] * ws, v1 = acc[ai][1][m][1] * ws; w1.x = pk4_fp8(v0[0], v0[1], v0[2], v0[3]); w1.y = pk4_fp8(v1[0], v1[1], v1[2], v1[3]); }
                swap16(w0, w1);
                if (r < u.nvalid) { const int odd = fq & 1; const u32x4 w = {w0.x, w0.y, w1.x, w1.y};
                    *(u32x4*)(Y + (size_t)a * 2048 + col0 + (odd ? HALF - 8 : 0)) = w; } }
    }
};
struct EpiRouter {
    static constexpr bool PERM = true, AFTER_DRAIN = false;
    const float* part; const float* ber; const float* bgr; float* listr; float* listw; int* list; unsigned* cnt; int lcap;
    __device__ __forceinline__ void operator()(const f32x4 (&acc)[2][2][4][2], const Unit& u, int wr, int wc, int fr, int fq) const {
        if (wc != 0) return;
#pragma unroll
        for (int ai = 0; ai < 2; ++ai)
#pragma unroll
            for (int m = 0; m < 4; ++m) { const int row = u.pm * BM + ai * HALF + wr * 64 + m * 16 + fr;
                const f32x4 p0 = *(const f32x4*)(part + (size_t)row * 32 + 8 * fq), p1 = *(const f32x4*)(part + (size_t)row * 32 + 8 * fq + 4);
                float ss = ((p0[0] + p0[1]) + (p0[2] + p0[3])) + ((p1[0] + p1[1]) + (p1[2] + p1[3]));
                ss += __shfl_xor(ss, 16); ss += __shfl_xor(ss, 32);
                const float rstd = 1.0f / sqrtf(ss * (1.0f / 2048.0f) + 1e-6f);
                const f32x4 gl = acc[ai][1][m][0]; float g[4];
#pragma unroll
                for (int i = 0; i < 4; ++i) g[i] = __shfl(gl[i], fr) * rstd + bgr[i];
                int gs = 0; float gm = g[0];
#pragma unroll
                for (int i = 1; i < 4; ++i) if (g[i] > gm) { gm = g[i]; gs = i; }
                float gsum = 0.f;
#pragma unroll
                for (int i = 0; i < 4; ++i) gsum += __expf(g[i] - gm);
                const float gw = 1.0f / gsum;
                if (fq == gs) { float ev[8];
#pragma unroll
                    for (int i = 0; i < 4; ++i) { ev[i] = acc[ai][0][m][0][i] * rstd + ber[8 * fq + i]; ev[4 + i] = acc[ai][0][m][1][i] * rstd + ber[8 * fq + 4 + i]; }
                    int i1 = 0; float v1 = ev[0];
#pragma unroll
                    for (int i = 1; i < 8; ++i) if (ev[i] > v1) { v1 = ev[i]; i1 = i; }
                    int i2 = -1; float v2 = -3.0e38f;
#pragma unroll
                    for (int i = 0; i < 8; ++i) if (i != i1 && ev[i] > v2) { v2 = ev[i]; i2 = i; }
                    const float e2 = __expf(v2 - v1), w1 = gw / (1.f + e2), w2 = gw * e2 / (1.f + e2);
                    const int ea = gs * 8 + i1, eb = gs * 8 + i2;
                    const unsigned ra = __hip_atomic_fetch_add(cnt + 64 * ea, 1u, __ATOMIC_RELAXED, __HIP_MEMORY_SCOPE_AGENT);
                    const unsigned rb = __hip_atomic_fetch_add(cnt + 64 * eb, 1u, __ATOMIC_RELAXED, __HIP_MEMORY_SCOPE_AGENT);
                    const size_t ia = (size_t)ea * lcap + ra, ib = (size_t)eb * lcap + rb;
                    list[ia] = 2 * row; list[ib] = 2 * row + 1; listw[ia] = w1; listw[ib] = w2; listr[ia] = rstd; listr[ib] = rstd; } }
    }
};

template <class Epi, class Sched, bool ALIGN_EPI, bool GATHER, bool FP8 = false>
__device__ __forceinline__ void gemm_phase(PG8_LAS unsigned char* lds, const Gemm g, Sched& S, const Epi& E) {
    int tid_ = threadIdx.x; asm volatile("" : "+v"(tid_));
    const int tid = tid_, wid = __builtin_amdgcn_readfirstlane(tid >> 6), lane = tid & 63, wr = wid >> 2, wc = wid & 3, fr = lane & 15, fq = lane >> 4;
    const int K = g.K, nt = K / BK;
    unsigned voffA[2], voffB[2]; int RA[2], CA[2];
#pragma unroll
    for (int i = 0; i < 2; ++i) { int R, C; stage_rc(tid * 16 + i * 8192, R, C); const int Rb = Epi::PERM ? ((R & ~31) + perm32(R & 31)) : R;
        voffA[i] = (unsigned)(R * K + C) * 2u; voffB[i] = (unsigned)(Rb * K + C) * 2u; RA[i] = R; CA[i] = C; }
    const size_t kstep = (size_t)(BK * 2);
    const size_t hstep = (size_t)HALF * K * 2;
    const size_t tstep = 2 * hstep;
    const unsigned ldsw = (unsigned)wid * 1024u;
    const int aoff = lds_byte(wr * 64 + fr, fq * 8), boff = lds_byte(wc * 32 + fr, fq * 8);
#define PG8_SA(b, h) (((b) * 2 + (h)) * HTB)
#define PG8_SB(b, h) ((4 + (b) * 2 + (h)) * HTB)
#define PG8_STAGE(bufoff, gbase, voff) do { _Pragma("unroll") for (int _i = 0; _i < 2; ++_i) \
        __builtin_amdgcn_global_load_lds((const unsigned*)((const char*)(gbase) + (voff)[_i]), (PG8_LAS unsigned*)(lds + (bufoff) + ldsw + _i * 8192), 16, 0, 0); } while (0)
#define PG8_STAGE_A(bufoff, kp, h) do { if constexpr (GATHER) { PG8_STAGE(bufoff, kp, cgo[h]); } else { PG8_STAGE(bufoff, (kp) + (h) * hstep, voffA); } } while (0)
#define PG8_LDA(dst, b, h) do { _Pragma("unroll") for (int m = 0; m < 4; ++m) _Pragma("unroll") for (int k = 0; k < 2; ++k) dst[m][k] = *(const PG8_LAS bf16x8*)(lds + PG8_SA(b, h) + aoff + m * 2048 + k * 1024); } while (0)
#define PG8_LDB(dst, b, h) do { _Pragma("unroll") for (int n = 0; n < 2; ++n) _Pragma("unroll") for (int k = 0; k < 2; ++k) dst[n][k] = *(const PG8_LAS bf16x8*)(lds + PG8_SB(b, h) + boff + n * 2048 + k * 1024); } while (0)
#define PG8_CAT(x, y) __builtin_shufflevector(__builtin_bit_cast(v4i_t, x), __builtin_bit_cast(v4i_t, y), 0, 1, 2, 3, 4, 5, 6, 7)
#define PG8_MMA(ai, bj, At, Bt) do { __builtin_amdgcn_s_setprio(1); \
        if constexpr (FP8) { _Pragma("unroll") for (int m = 0; m < 4; ++m) _Pragma("unroll") for (int n = 0; n < 2; ++n) \
            acc[ai][bj][m][n] = __builtin_amdgcn_mfma_scale_f32_16x16x128_f8f6f4(PG8_CAT(Bt[n][0], Bt[n][1]), PG8_CAT(At[m][0], At[m][1]), acc[ai][bj][m][n], 0, 0, 0, 0, 0, 0); } \
        else { _Pragma("unroll") for (int m = 0; m < 4; ++m) _Pragma("unroll") for (int n = 0; n < 2; ++n) _Pragma("unroll") for (int k = 0; k < 2; ++k) \
            acc[ai][bj][m][n] = __builtin_amdgcn_mfma_f32_16x16x32_bf16(Bt[n][k], At[m][k], acc[ai][bj][m][n], 0, 0, 0); } \
        __builtin_amdgcn_s_setprio(0); } while (0)
#define PG8_WAIT_V(n) asm volatile("s_waitcnt vmcnt(" #n ")" ::: "memory")
#define PG8_WAIT_L(n) asm volatile("s_waitcnt lgkmcnt(" #n ")" ::: "memory")
#define PG8_BAR __builtin_amdgcn_s_barrier()
#define PG8_SCHED __builtin_amdgcn_sched_barrier(0)
    Unit cur, nxt; int ui = 0;
#if PROBE_KLOOP
    unsigned pk_acc_ = 0u;
#endif
    if (!S.next(0, cur)) return;
    f32x4 acc[2][2][4][2];
#pragma unroll
    for (int a = 0; a < 2; ++a)
#pragma unroll
        for (int b = 0; b < 2; ++b)
#pragma unroll
            for (int m = 0; m < 4; ++m)
#pragma unroll
                for (int n = 0; n < 2; ++n) acc[a][b][m][n] = (f32x4){0.f, 0.f, 0.f, 0.f};
    bf16x8 At[4][2], B0[2][2], B1[2][2];
    unsigned cgo[2][2] = {{0u, 0u}, {0u, 0u}}, ngo[2][2] = {{0u, 0u}, {0u, 0u}};
    if constexpr (GATHER) {
#pragma unroll
        for (int h = 0; h < 2; ++h)
#pragma unroll
            for (int i = 0; i < 2; ++i) cgo[h][i] = S.goff(cur, h * HALF + RA[i], CA[i], K);
    }
    const char* cA = GATHER ? (const char*)g.A : (const char*)g.A + (size_t)cur.pm * tstep; const char* cB = S.bbase(g, cur, tstep);
    S.a_ready(cur);
    PG8_STAGE(PG8_SB(0, 0), cB, voffB); PG8_STAGE(PG8_SB(0, 1), cB + hstep, voffB); PG8_STAGE_A(PG8_SA(0, 0), cA, 0); PG8_STAGE_A(PG8_SA(0, 1), cA, 1);
    if (wr == 1) PG8_BAR;
    PG8_WAIT_V(2); PG8_BAR;
    PG8_STAGE(PG8_SB(1, 0), cB + kstep, voffB); PG8_STAGE_A(PG8_SA(1, 0), cA + kstep, 0); PG8_STAGE(PG8_SB(1, 1), cB + hstep + kstep, voffB);
    PG8_WAIT_V(6); PG8_BAR;
    for (;;) {
        const bool has_next = S.next(ui + 1, nxt);
        if constexpr (GATHER) {
            if (has_next) {
#pragma unroll
                for (int h = 0; h < 2; ++h)
#pragma unroll
                    for (int i = 0; i < 2; ++i) ngo[h][i] = S.goff(nxt, h * HALF + RA[i], CA[i], K);
            } else {
#pragma unroll
                for (int h = 0; h < 2; ++h)
#pragma unroll
                    for (int i = 0; i < 2; ++i) ngo[h][i] = cgo[h][i];
            }
        }
        const char* nA = GATHER ? (const char*)g.A : (has_next ? (const char*)g.A + (size_t)nxt.pm * tstep : cA); const char* nB = has_next ? S.bbase(g, nxt, tstep) : cB;
#if PROBE_KLOOP
        const unsigned long long pk0_ = __builtin_amdgcn_s_memrealtime();
#endif
        for (int t = 0; t < nt; t += 2) {
            const bool last = (t == nt - 2);
            const char* a1 = cA + (size_t)(t + 1) * kstep;
            const char* a2 = last ? nA : cA + (size_t)(t + 2) * kstep; const char* b2 = last ? nB : cB + (size_t)(t + 2) * kstep;
            const char* a3 = a2 + kstep; const char* b3 = b2 + kstep;
            if (last && has_next) S.a_ready(nxt);
            PG8_LDB(B0, 0, 0); PG8_LDB(B1, 0, 1); PG8_SCHED; PG8_LDA(At, 0, 0); PG8_STAGE_A(PG8_SA(1, 1), a1, 1);
            if constexpr (GATHER) { if (last) {
#pragma unroll
                for (int h = 0; h < 2; ++h)
#pragma unroll
                    for (int i = 0; i < 2; ++i) cgo[h][i] = ngo[h][i]; } }
            PG8_WAIT_V(8); PG8_WAIT_L(0); PG8_BAR; PG8_MMA(0, 0, At, B0); PG8_MMA(0, 1, At, B1); PG8_BAR; PG8_SCHED;
            PG8_LDA(At, 0, 1); PG8_STAGE(PG8_SB(0, 0), b2, voffB); PG8_STAGE(PG8_SB(0, 1), b2 + hstep, voffB); PG8_STAGE_A(PG8_SA(0, 0), a2, 0);
            PG8_WAIT_V(8); PG8_WAIT_L(0); PG8_BAR; PG8_MMA(1, 0, At, B0); PG8_MMA(1, 1, At, B1); PG8_BAR; PG8_SCHED;
            PG8_LDB(B0, 1, 0); PG8_LDB(B1, 1, 1); PG8_SCHED; PG8_LDA(At, 1, 0); PG8_STAGE_A(PG8_SA(0, 1), a2, 1);
            PG8_WAIT_V(8); PG8_WAIT_L(0); PG8_BAR; PG8_MMA(0, 0, At, B0); PG8_MMA(0, 1, At, B1); PG8_BAR; PG8_SCHED;
            PG8_LDA(At, 1, 1); PG8_STAGE(PG8_SB(1, 0), b3, voffB); PG8_STAGE(PG8_SB(1, 1), b3 + hstep, voffB); PG8_STAGE_A(PG8_SA(1, 0), a3, 0);
            PG8_WAIT_V(8); PG8_WAIT_L(0); PG8_BAR; PG8_MMA(1, 0, At, B0); PG8_MMA(1, 1, At, B1); PG8_BAR; PG8_SCHED;
        }
#if PROBE_KLOOP
        const unsigned long long pk1_ = __builtin_amdgcn_s_memrealtime(); if (PROBE_WHAT == 0) pk_acc_ += (unsigned)(pk1_ - pk0_);
#endif
        if constexpr (ALIGN_EPI) { if (wr == 0) PG8_BAR; }
#if PROBE_KLOOP
        const unsigned long long pk2_ = __builtin_amdgcn_s_memrealtime(); if (PROBE_WHAT == 1) pk_acc_ += (unsigned)(pk2_ - pk1_);
#endif
        E(acc, cur, wr, wc, fr, fq); S.done(cur);
#if PROBE_KLOOP
        asm volatile("s_waitcnt vmcnt(0)" ::: "memory"); if (PROBE_WHAT == 2) pk_acc_ += (unsigned)(__builtin_amdgcn_s_memrealtime() - pk2_);
#endif
        if (!has_next) break;
#pragma unroll
        for (int a = 0; a < 2; ++a)
#pragma unroll
            for (int b = 0; b < 2; ++b)
#pragma unroll
                for (int m = 0; m < 4; ++m)
#pragma unroll
                    for (int n = 0; n < 2; ++n) acc[a][b][m][n] = (f32x4){0.f, 0.f, 0.f, 0.f};
        cur = nxt; cA = nA; cB = nB; ++ui;
        if constexpr (ALIGN_EPI) { if (wr == 1) PG8_BAR; }
    }
#if PROBE_KLOOP
    if (blockIdx.x == PROBE_BLK && tid == 0 && g.M == PROBE_KLOOP) atomicAdd(g.probe, pk_acc_);
#endif
    PG8_WAIT_V(0);
    if constexpr (!ALIGN_EPI) { if (wr == 0) PG8_BAR; }
    PG8_BAR;
#undef PG8_SA
#undef PG8_SB
#undef PG8_STAGE
#undef PG8_STAGE_A
#undef PG8_LDA
#undef PG8_LDB
#undef PG8_MMA
#undef PG8_CAT
#undef PG8_WAIT_V
#undef PG8_WAIT_L
#undef PG8_BAR
#undef PG8_SCHED
}
}
#include <hip/hip_bf16.h>
#include <cmath>
namespace attn_body {
using bf16=__hip_bfloat16;
using bf16x8=__attribute__((ext_vector_type(8)))short;
using s16x4=__attribute__((ext_vector_type(4)))short;
using f32x16=__attribute__((ext_vector_type(16)))float;
using u32x4=__attribute__((ext_vector_type(4)))unsigned;
constexpr int BATCH=8,SEQ=4096,D=64,DM=1024;
constexpr int NW=8,QBLK=32,QB=QBLK*NW,KVBLK=64,NQB=SEQ/QB;
__device__ __forceinline__ int crow(int r,int hi){return (r&3)+8*(r>>2)+4*hi;}
#define SBAR() __builtin_amdgcn_sched_barrier(0)
__device__ __forceinline__ void cmask(f32x16&p0,f32x16&p1,int jb,int qrel,int hi){
  const float NEG=-INFINITY; const int lim=qrel-64*jb-4*hi;
  #pragma unroll
  for(int r=0;r<16;++r){const int cr=(r&3)+8*(r>>2); if(cr>lim)p0[r]=NEG; if(cr+32>lim)p1[r]=NEG;}
}

constexpr int NSLOT=3, SLOTB=8192;
constexpr int LDS_K=0, LDS_V=NSLOT*SLOTB, LDS_WS=3*NSLOT*SLOTB, LDS_OST=LDS_WS+NW*64*4, LDS_BYTES=LDS_OST+NW*4096;
__device__ __forceinline__ void glds16(const void*sbase,unsigned voff,unsigned lds_dst){unsigned keep;
  asm volatile("s_mov_b32 %0, m0\n\ts_mov_b32 m0, %3\n\ts_nop 0\n\tglobal_load_lds_dwordx4 %1, %2\n\ts_mov_b32 m0, %0":"=&s"(keep):"v"(voff),"s"(sbase),"s"(lds_dst):"memory");}
__device__ __forceinline__ float max3f(float a,float b,float c){float r;asm("v_max3_f32 %0, %1, %2, %3":"=v"(r):"v"(a),"v"(b),"v"(c));return r;}
__device__ __forceinline__ float max2f(float a,float b){float r;asm("v_max_f32_e32 %0, %1, %2":"=v"(r):"v"(a),"v"(b));return r;}
__device__ __forceinline__ float fsub_s(float a,float b){float r;asm("v_sub_f32_e32 %0, %1, %2":"=v"(r):"v"(a),"v"(b));return r;}
typedef float f32x2_t __attribute__((ext_vector_type(2))); typedef __bf16 bf16x2_t __attribute__((ext_vector_type(2)));
__device__ __forceinline__ unsigned cvtpk_s(float lo,float hi){f32x2_t v={lo,hi};bf16x2_t b=__builtin_convertvector(v,bf16x2_t);return __builtin_bit_cast(unsigned,b);}
#define WAIT_BAR(N) asm volatile("s_waitcnt vmcnt(" #N ") lgkmcnt(0)\n\ts_barrier":::"memory")
#define MFMA32(a,b,c) __builtin_amdgcn_mfma_f32_32x32x16_bf16(a,b,c,0,0,0)

__device__ __forceinline__ void qkt(f32x16&p0,f32x16&p1,const char*Kslot,const bf16x8*qr,int r32,int hi){
  const char*kb=Kslot+hi*1024+r32*16;
  #pragma unroll
  for(int d0=0;d0<4;++d0){
    const bf16x8 b0=*reinterpret_cast<const bf16x8*>(kb+d0*2048);
    const bf16x8 b1=*reinterpret_cast<const bf16x8*>(kb+d0*2048+512);
    p0=MFMA32(b0,qr[d0],p0);p1=MFMA32(b1,qr[d0],p1);}
}
typedef __attribute__((address_space(3))) const char* lds_cptr;
typedef short v4i16_t __attribute__((ext_vector_type(4)));
__device__ __forceinline__ void kload8(bf16x8*kf,lds_cptr kp){
  kf[0]=*(const __attribute__((address_space(3))) bf16x8*)(kp);      kf[1]=*(const __attribute__((address_space(3))) bf16x8*)(kp+512);
  kf[2]=*(const __attribute__((address_space(3))) bf16x8*)(kp+2048); kf[3]=*(const __attribute__((address_space(3))) bf16x8*)(kp+2560);
  kf[4]=*(const __attribute__((address_space(3))) bf16x8*)(kp+4096); kf[5]=*(const __attribute__((address_space(3))) bf16x8*)(kp+4608);
  kf[6]=*(const __attribute__((address_space(3))) bf16x8*)(kp+6144); kf[7]=*(const __attribute__((address_space(3))) bf16x8*)(kp+6656);
}
__device__ __forceinline__ void kload2(bf16x8*kf,lds_cptr kp,int j){ kf[2*j]=*(const __attribute__((address_space(3))) bf16x8*)(kp+j*2048); kf[2*j+1]=*(const __attribute__((address_space(3))) bf16x8*)(kp+j*2048+512); }
__device__ __forceinline__ s16x4 vtr(lds_cptr p){ return __builtin_bit_cast(s16x4,__builtin_amdgcn_ds_read_tr16_b64_v4i16((__attribute__((address_space(3))) v4i16_t*)p)); }
__device__ __forceinline__ float rowmax(const f32x16&p0,const f32x16&p1){
  float a=max3f(p0[0],p0[1],p1[0]),b=max3f(p0[2],p0[3],p1[1]);a=max3f(a,p1[2],p1[3]);
  #pragma unroll
  for(int r=4;r<16;r+=4){a=max3f(a,p0[r],p0[r+1]);b=max3f(b,p0[r+2],p0[r+3]);a=max3f(a,p1[r],p1[r+1]);b=max3f(b,p1[r+2],p1[r+3]);}
  const float m=max2f(a,b);
  auto rr=__builtin_amdgcn_permlane32_swap(__float_as_uint(m),__float_as_uint(m),false,false);
  return max2f(__uint_as_float(rr[0]),__uint_as_float(rr[1]));
}
__device__ __forceinline__ void pv(f32x16*o,int vb,bf16x8 pa0,bf16x8 pa1,bf16x8 pa2,bf16x8 pa3){
  #pragma unroll
  for(int d0=0;d0<4;++d0){s16x4 lo[4],hi[4];
    #pragma unroll
    for(int ks=0;ks<4;++ks){
      asm volatile("ds_read_b64_tr_b16 %0,%1 offset:%c2":"=&v"(lo[ks]):"v"(vb),"i"(d0*4096+ks*1024):"memory");
      asm volatile("ds_read_b64_tr_b16 %0,%1 offset:%c2":"=&v"(hi[ks]):"v"(vb),"i"(d0*4096+ks*1024+512):"memory");}
    asm volatile("s_waitcnt lgkmcnt(0)":::"memory");SBAR();
    #define PK(k) (bf16x8){lo[k][0],lo[k][1],lo[k][2],lo[k][3],hi[k][0],hi[k][1],hi[k][2],hi[k][3]}
    o[d0]=MFMA32(pa0,PK(0),o[d0]);
    o[d0]=MFMA32(pa1,PK(1),o[d0]);
    o[d0]=MFMA32(pa2,PK(2),o[d0]);
    o[d0]=MFMA32(pa3,PK(3),o[d0]);
    #undef PK
  }
}

template<int THRL> __device__ __forceinline__ void attn_sub(int b,int qkcol,int vcol,int qb,int cmap,float sl2,float lam,int ntcap,float Ub,float oscale,const float*subg,unsigned*o1s,bf16*MIXh,const bf16*Q,const bf16*__restrict__ K,const bf16*__restrict__ V,char*shm,unsigned*pw_){
#if PROBE_ATT >= 3
  const unsigned long long ps0_=__builtin_amdgcn_s_memrealtime();
#endif
  const int tid=threadIdx.x,lane=tid&63,r32=lane&31,hi=lane>>5; const int wid=__builtin_amdgcn_readfirstlane(tid>>6);
  const long rowbase=(long)b*SEQ; const int q0=qb*QB;
  const bf16*Qw=Q+(rowbase+q0+wid*QBLK)*DM+qkcol;
  const bf16*Kh=K+rowbase*DM+qkcol,*Vh=V+rowbase*DM+vcol;
  const unsigned lds0=(unsigned)(uintptr_t)shm;
  float*wsf=(float*)(shm+LDS_WS)+wid*64;
  const unsigned koff=(unsigned)(lane*DM+wid*8)*2u, voffv=(unsigned)((16*(wid&3)+(lane>>2))*DM+(wid>>2)*32+(lane&3)*8)*2u;
  const unsigned kdst=lds0+LDS_K+wid*1024, vdst=lds0+LDS_V+wid*1024;
  const int NTR=(q0+QB)/KVBLK;
  int NT=NTR<ntcap?NTR:ntcap;
  #define DMA_K(t,slot) glds16(Kh+(long)(NTR-1-(t))*KVBLK*DM,koff,(unsigned)__builtin_amdgcn_readfirstlane(kdst+(slot)))
  #define DMA_V(t,slot) do{ glds16(Vh+(long)(NTR-1-(t))*KVBLK*DM,voffv,(unsigned)__builtin_amdgcn_readfirstlane(vdst+2*(slot))); glds16(Vh+(long)(NTR-1-(t))*KVBLK*DM+64,voffv,(unsigned)__builtin_amdgcn_readfirstlane(vdst+2*(slot)+8192)); }while(0)
  const char*Kbase=shm+LDS_K; bf16x8 kf[8];
  const lds_cptr shm3=(lds_cptr)shm; const lds_cptr kp0=shm3+LDS_K+hi*1024+r32*16; const lds_cptr vp0=shm3+LDS_V+((lane>>4)&1)*32+(lane&3)*8+(4*hi+((lane&15)>>2))*64;
  #define vb0 ((int)(unsigned)(uintptr_t)vp0)
  DMA_K(0,0);DMA_V(0,0);DMA_K(1,SLOTB);
  bf16x8 qr[4];
  #pragma unroll
  for(int d0=0;d0<4;++d0)qr[d0]=*reinterpret_cast<const bf16x8*>(&Qw[(long)r32*DM+d0*16+hi*8]);
  const int qrel=wid*QBLK+r32;
  const unsigned lm=hi?0u:0xffffffffu;
  const int qw0=wid*QBLK;
  unsigned bbx; { const unsigned sh=__float_as_uint(sl2)&0xffff0000u; const float sr=sl2-__uint_as_float(sh); bbx=((sh>>16)|(cvtpk_s(sr,0.f)<<16))&lm; }
  const float dlt=64.f*sl2;
  float cref=sl2*(float)(192-qrel);
  #define BIAS2(C0,C1,t) do{ const float c_=__builtin_fmaf(-dlt,(float)(t),cref); const unsigned h_=__float_as_uint(c_)&0xffff0000u; const float r1_=c_-__uint_as_float(h_); \
      const unsigned m_=__float_as_uint(r1_)&0xffff0000u; const float r2_=r1_-__uint_as_float(m_); \
      int q_=qrel; asm volatile("":"+v"(q_)); const float rf_=(float)(q_-qw0); \
      u32x4 b_=(u32x4){bbx,((h_>>16)|m_)&lm,(__float_as_uint(r2_)>>16)&lm,0u}; u32x4 a_=(u32x4){cvtpk_s(rf_,rf_),0x3F803F80u,0x00003F80u,0u}; asm volatile("":"+v"(a_),"+v"(b_)); \
      const f32x16 z_=f32x16{}; C0=MFMA32(__builtin_bit_cast(bf16x8,a_),__builtin_bit_cast(bf16x8,b_),z_); \
      a_.x=cvtpk_s(rf_+32.f,rf_+32.f); asm volatile("":"+v"(a_)); C1=MFMA32(__builtin_bit_cast(bf16x8,a_),__builtin_bit_cast(bf16x8,b_),z_); }while(0)
  float l_reg=0.f;f32x16 o[4];o[0]=f32x16{};o[1]=f32x16{};o[2]=f32x16{};o[3]=f32x16{};
  #define CMASK(P0,P1,t) do{int jb_=3-(t); if(jb_>=0)cmask(P0,P1,jb_,qrel,hi);}while(0)
  bool resc=false;
  #define START(P0,P1) do{ const float rm=rowmax(P0,P1); resc=false; \
    if(__any(rm>(float)THRL)){ const float dl=max2f(rm,0.f); cref=fsub_s(cref,dl); \
      _Pragma("unroll") for(int r=0;r<16;++r){P0[r]=fsub_s(P0[r],dl);P1[r]=fsub_s(P1[r],dl);} } \
    _Pragma("unroll") for(int r=0;r<16;++r)P0[r]=__builtin_amdgcn_exp2f(P0[r]); }while(0)
  #define RESC() do{ if(resc){ asm volatile("s_waitcnt lgkmcnt(0)":::"memory"); \
      _Pragma("unroll") for(int d_=0;d_<4;++d_) _Pragma("unroll") for(int r=0;r<16;++r)o[d_][r]*=wsf[crow(r,hi)]; } }while(0)
  f32x16 pA0,pA1,pB0,pB1;
  int sl_prev=0,sl_cur=0,sl_next=SLOTB;
  #define ROT() do{sl_prev=sl_cur;sl_cur=sl_next;sl_next=(sl_next==(NSLOT-1)*SLOTB)?0:sl_next+SLOTB;}while(0)
  DMA_K(2,2*SLOTB);
  WAIT_BAR(3);
  BIAS2(pA0,pA1,0);
  qkt(pA0,pA1,Kbase,qr,r32,hi);asm volatile("s_nop 15\n\ts_nop 7":"+v"(pA0),"+v"(pA1));CMASK(pA0,pA1,0);
  START(pA0,pA1);
  _Pragma("unroll") for(int r=0;r<16;++r)pA1[r]=__builtin_amdgcn_exp2f(pA1[r]);
  WAIT_BAR(0);
  DMA_K(3,0);DMA_V(1,SLOTB);
  ROT();
  kload8(kf,kp0+sl_cur);
  WAIT_BAR(3);
  s16x4 vlo[8],vhi[8]; u32x4 pw0,pw1,pw2,pw3;
  #define PKW(P,B) cvtpk_s(P[B],P[B+1])
  #define PAF(k) __builtin_bit_cast(bf16x8,pw##k)
  #define VFR(i) (bf16x8){vlo[i][0],vlo[i][1],vlo[i][2],vlo[i][3],vhi[i][0],vhi[i][1],vhi[i][2],vhi[i][3]}
  #define PIN(x) asm volatile("":"+v"(x))
  #define MX3(a,b,c) __builtin_fmaxf(__builtin_fmaxf((a),(b)),(c))
  #define GAPA(MF,A0,A1,A2,A3,W0,W1,PW) do{ MF; sacc+=A0; sacc+=A1; sacc+=A2; sacc+=A3; PIN(sacc); W0; W1; PIN(PW); SBAR(); }while(0)
  #define EX(v) __builtin_amdgcn_exp2f(v)
  #define GAPB(MF,X,B) do{ MF; X[B]=EX(X[B]); X[B+1]=EX(X[B+1]); PIN(X); SBAR(); }while(0)
  #define VRD2(i) do{ vlo[i]=vtr(vp_+(8192+((i)>>2)*4096+((i)&3)*1024)); vhi[i]=vtr(vp_+(8192+((i)>>2)*4096+((i)&3)*1024+512)); SBAR(); }while(0)
  #define VRD(i) do{ vlo[i]=vtr(vp_+(((i)>>2)*4096+((i)&3)*1024)); vhi[i]=vtr(vp_+(((i)>>2)*4096+((i)&3)*1024+512)); }while(0)
  #define KRD(G,j) do{ if(G){ kload2(kf,kp0+sl_next,j); SBAR(); } }while(0)
  #define STEP(C0,C1,P0,P1,t,GK,GV,GL) do{ SBAR(); \
    BIAS2(C0,C1,t); SBAR(); \
    const lds_cptr vp_=vp0+2*sl_prev; \
    VRD(0); SBAR(); float sacc=(P0[0]+P0[1]); \
    GAPA(C0=MFMA32(kf[0],qr[0],C0), P0[2],P0[3],P0[4],P0[5],     pw0[0]=PKW(P0,0), pw0[1]=PKW(P0,2), pw0); \
    VRD(4); SBAR(); GAPA(C1=MFMA32(kf[1],qr[0],C1), P0[6],P0[7],P0[8],P0[9],     pw0[2]=PKW(P0,4), pw0[3]=PKW(P0,6), pw0); \
    VRD(1); SBAR(); GAPA(C0=MFMA32(kf[2],qr[1],C0),   P0[10],P0[11],P0[12],P0[13], pw1[0]=PKW(P0,8), pw1[1]=PKW(P0,10), pw1); \
    VRD(5); SBAR(); GAPA(C1=MFMA32(kf[3],qr[1],C1),   P0[14],P0[15],P1[0],P1[1],   pw1[2]=PKW(P0,12),pw1[3]=PKW(P0,14), pw1); \
    VRD(2); SBAR(); GAPA(C0=MFMA32(kf[4],qr[2],C0),   P1[2],P1[3],P1[4],P1[5],     pw2[0]=PKW(P1,0), pw2[1]=PKW(P1,2), pw2); \
    VRD(6); SBAR(); GAPA(C1=MFMA32(kf[5],qr[2],C1),   P1[6],P1[7],P1[8],P1[9],     pw2[2]=PKW(P1,4), pw2[3]=PKW(P1,6), pw2); \
    VRD(3); SBAR(); GAPA(C0=MFMA32(kf[6],qr[3],C0),   P1[10],P1[11],P1[12],P1[13], pw3[0]=PKW(P1,8), pw3[1]=PKW(P1,10), pw3); \
    VRD(7); SBAR(); GAPA(C1=MFMA32(kf[7],qr[3],C1),   P1[14],P1[15],0.f,0.f,       pw3[2]=PKW(P1,12),pw3[3]=PKW(P1,14), pw3); \
    l_reg+=sacc; \
    if(GK){DMA_K((t)+3,sl_cur);} if(GV){DMA_V((t)+1,sl_next);} \
    CMASK(C0,C1,t); \
    { float a=MX3(C0[0],C0[1],C1[0]),b=MX3(C0[2],C0[3],C1[1]); a=MX3(a,C1[2],C1[3]); \
      _Pragma("unroll") for(int r=4;r<16;r+=4){a=MX3(a,C0[r],C0[r+1]);b=MX3(b,C0[r+2],C0[r+3]);a=MX3(a,C1[r],C1[r+1]);b=MX3(b,C1[r+2],C1[r+3]);} \
      float rm=__builtin_fmaxf(a,b); { auto rr=__builtin_amdgcn_permlane32_swap(__float_as_uint(rm),__float_as_uint(rm),false,false); rm=__builtin_fmaxf(__uint_as_float(rr[0]),__uint_as_float(rr[1])); } \
      resc=false; \
      if(__builtin_expect(__any(rm>(float)THRL),0)){ const float dl=__builtin_fmaxf(rm,0.f); cref-=dl; \
        _Pragma("unroll") for(int r=0;r<16;++r){C0[r]-=dl;C1[r]-=dl;} \
        const float f=__builtin_amdgcn_exp2f(-dl); l_reg*=f; if(hi==0)wsf[r32]=f; resc=true; } } \
    SBAR(); \
    GAPB(o[0]=MFMA32(PAF(0),VFR(0),o[0]), C0,0);  VRD2(0); \
    GAPB(o[1]=MFMA32(PAF(0),VFR(4),o[1]), C0,2);  VRD2(4); \
    KRD(GL,0); GAPB(o[0]=MFMA32(PAF(1),VFR(1),o[0]), C0,4);  VRD2(1); \
    KRD(GL,1); GAPB(o[1]=MFMA32(PAF(1),VFR(5),o[1]), C0,6);  VRD2(5); \
    KRD(GL,2); GAPB(o[0]=MFMA32(PAF(2),VFR(2),o[0]), C0,8);  VRD2(2); \
    KRD(GL,3); GAPB(o[1]=MFMA32(PAF(2),VFR(6),o[1]), C0,10); VRD2(6); \
    GAPB(o[0]=MFMA32(PAF(3),VFR(3),o[0]), C0,12); VRD2(3); \
    GAPB(o[1]=MFMA32(PAF(3),VFR(7),o[1]), C0,14); VRD2(7); \
    GAPB(o[2]=MFMA32(PAF(0),VFR(0),o[2]), C1,0); \
    GAPB(o[3]=MFMA32(PAF(0),VFR(4),o[3]), C1,2); \
    GAPB(o[2]=MFMA32(PAF(1),VFR(1),o[2]), C1,4); \
    GAPB(o[3]=MFMA32(PAF(1),VFR(5),o[3]), C1,6); \
    GAPB(o[2]=MFMA32(PAF(2),VFR(2),o[2]), C1,8); \
    GAPB(o[3]=MFMA32(PAF(2),VFR(6),o[3]), C1,10); \
    GAPB(o[2]=MFMA32(PAF(3),VFR(3),o[2]), C1,12); \
    GAPB(o[3]=MFMA32(PAF(3),VFR(7),o[3]), C1,14); \
    }while(0)
  #define ENDW(tt) do{ if((tt)+3<NT){WAIT_BAR(3);} else if((tt)+2<NT){WAIT_BAR(2);} else {WAIT_BAR(0);} }while(0)
#if PROBE_ATT == 3
  if(blockIdx.x==PROBE_BLK&&threadIdx.x==0)atomicAdd(pw_,(unsigned)(__builtin_amdgcn_s_memrealtime()-ps0_));
#endif
  int t=1;
  for(;t<5&&t+1<NT;t+=2){
    STEP(pB0,pB1,pA0,pA1,t,(t+3<NT),(t+1<NT),(t+1<NT));       ENDW(t);   RESC(); ROT();
    STEP(pA0,pA1,pB0,pB1,t+1,(t+4<NT),(t+2<NT),(t+2<NT));     ENDW(t+1); RESC(); ROT();
  }
  if(t==5&&NT>=12){
    float lt=l_reg; {auto rr=__builtin_amdgcn_permlane32_swap(__float_as_uint(lt),__float_as_uint(lt),false,false);lt=__uint_as_float(rr[0])+__uint_as_float(rr[1]);}
    float dl2=(sl2*(float)(192-qrel)-cref)+__builtin_amdgcn_logf(lt);
    #define DPPMIN(ctl) dl2=__builtin_fminf(dl2,__uint_as_float((unsigned)__builtin_amdgcn_update_dpp(0,(int)__float_as_uint(dl2),ctl,0xF,0xF,false)))
    DPPMIN(0xB1); DPPMIN(0x4E); DPPMIN(0x141); DPPMIN(0x140);
    #undef DPPMIN
    { auto rr=__builtin_amdgcn_permlane16_swap(__float_as_uint(dl2),__float_as_uint(dl2),false,false); dl2=__builtin_fminf(__uint_as_float(rr[0]),__uint_as_float(rr[1])); }
    float*xw=(float*)(shm+LDS_OST);
    if(lane==0)xw[wid]=dl2;
    asm volatile("s_waitcnt lgkmcnt(0)\n\ts_barrier":::"memory");
    float dmin=xw[0];
    #pragma unroll
    for(int w_=1;w_<8;++w_)dmin=__builtin_fminf(dmin,xw[w_]);
    dmin=__uint_as_float(__builtin_amdgcn_readfirstlane(__float_as_uint(dmin)));
    const float d0_=(Ub-dmin+24.f+log2f(1.f/(1.f-exp2f(-sl2))))/sl2; float st_=ceilf((d0_+255.f)*(1.f/64.f)); st_=st_<10.f?10.f:(st_>64.f?64.f:st_);
    const int nc_=__builtin_amdgcn_readfirstlane((((int)st_)+1)&~1); if(nc_<NT)NT=nc_;
    asm volatile("s_waitcnt lgkmcnt(0)":::"memory");
  }
  #undef CMASK
  #define CMASK(P0,P1,t) do{}while(0)
  for(;t+5<NT;t+=2){
    STEP(pB0,pB1,pA0,pA1,t,true,true,true);     WAIT_BAR(3); RESC(); ROT();
    STEP(pA0,pA1,pB0,pB1,t+1,true,true,true);   WAIT_BAR(3); RESC(); ROT();
  }
  for(;t+1<NT;t+=2){
    STEP(pB0,pB1,pA0,pA1,t,(t+3<NT),(t+1<NT),(t+1<NT));       ENDW(t);   RESC(); ROT();
    STEP(pA0,pA1,pB0,pB1,t+1,(t+4<NT),(t+2<NT),(t+2<NT));     ENDW(t+1); RESC(); ROT();
  }
  #undef CMASK
  #define CMASK(P0,P1,t) do{int jb_=3-(t); if(jb_>=0)cmask(P0,P1,jb_,qrel,hi);}while(0)
  STEP(pB0,pB1,pA0,pA1,NT-1,false,false,false); RESC();
#if PROBE_ATT == 4
  const unsigned long long ps1_=__builtin_amdgcn_s_memrealtime();
#endif
  { float sacc=pB0[0]+pB0[1]; _Pragma("unroll") for(int r=2;r<16;++r)sacc+=pB0[r]; _Pragma("unroll") for(int r=0;r<16;++r)sacc+=pB1[r]; l_reg+=sacc;
    pw0=(u32x4){PKW(pB0,0),PKW(pB0,2),PKW(pB0,4),PKW(pB0,6)};pw1=(u32x4){PKW(pB0,8),PKW(pB0,10),PKW(pB0,12),PKW(pB0,14)};pw2=(u32x4){PKW(pB1,0),PKW(pB1,2),PKW(pB1,4),PKW(pB1,6)};pw3=(u32x4){PKW(pB1,8),PKW(pB1,10),PKW(pB1,12),PKW(pB1,14)};
    SBAR(); pv(o,vb0+2*sl_cur,PAF(0),PAF(1),PAF(2),PAF(3)); }
  #undef PKW
  #undef PAF
  #undef VFR
  #undef PIN
  #undef MX3
  #undef GAPA
  #undef GAPB
  #undef EX
  #undef VRD
  #undef VRD2
  #undef KRD
  #undef STEP
  #undef ENDW
  { int tid_e=threadIdx.x; asm volatile("":"+v"(tid_e)); const int lane=tid_e&63,r32=lane&31,hi=lane>>5; const int wid=__builtin_amdgcn_readfirstlane(tid_e>>6);
    float*wsf=(float*)(shm+LDS_WS)+wid*64;
  {auto rr=__builtin_amdgcn_permlane32_swap(__float_as_uint(l_reg),__float_as_uint(l_reg),false,false);l_reg=__uint_as_float(rr[0])+__uint_as_float(rr[1]);}
  if(hi==0)wsf[32+r32]=l_reg;asm volatile("s_waitcnt lgkmcnt(0)":::"memory");
  float rli[16];
  #pragma unroll
  for(int r=0;r<16;++r)rli[r]=__builtin_amdgcn_rcpf(wsf[32+crow(r,hi)]);
  u32x4*ow=(u32x4*)(o1s+wid*2048)+lane;
  if(cmap==0){
    #pragma unroll
    for(int i=0;i<8;++i){ const int dq=i>>1,r0=8*(i&1); u32x4 w;
      w.x=cvtpk_s(o[dq][r0+0]*rli[r0+0],o[dq][r0+1]*rli[r0+1]); w.y=cvtpk_s(o[dq][r0+2]*rli[r0+2],o[dq][r0+3]*rli[r0+3]);
      w.z=cvtpk_s(o[dq][r0+4]*rli[r0+4],o[dq][r0+5]*rli[r0+5]); w.w=cvtpk_s(o[dq][r0+6]*rli[r0+6],o[dq][r0+7]*rli[r0+7]); ow[i*64]=w; }
  } else {
    bf16*stg=(bf16*)(shm+LDS_OST)+wid*2048;
    const int row=lane>>1,part=lane&1; float v[64]; float ss=0.f;
    unsigned o1w[32];
    #pragma unroll
    for(int i=0;i<8;++i){ const u32x4 w=ow[i*64]; o1w[4*i+0]=w.x; o1w[4*i+1]=w.y; o1w[4*i+2]=w.z; o1w[4*i+3]=w.w; }
    #pragma unroll
    for(int p_=0;p_<2;++p_){
      #pragma unroll
      for(int d0=0;d0<2;++d0){ const int dq=2*p_+d0;
        #pragma unroll
        for(int rp=0;rp<8;++rp){ const unsigned w=o1w[dq*8+rp];
          const float a0=__uint_as_float(w<<16)-lam*(o[dq][2*rp]*rli[2*rp]), a1=__uint_as_float(w&0xffff0000u)-lam*(o[dq][2*rp+1]*rli[2*rp+1]);
          stg[crow(2*rp,hi)*64+d0*32+r32]=__float2bfloat16(a0); stg[crow(2*rp+1,hi)*64+d0*32+r32]=__float2bfloat16(a1); } }
      asm volatile("s_waitcnt lgkmcnt(0)":::"memory");
      #pragma unroll
      for(int i=0;i<4;++i){ const u32x4 w=*(const u32x4*)(stg+row*64+part*32+8*i);
        v[32*p_+8*i+0]=__uint_as_float(w.x<<16); v[32*p_+8*i+1]=__uint_as_float(w.x&0xffff0000u); v[32*p_+8*i+2]=__uint_as_float(w.y<<16); v[32*p_+8*i+3]=__uint_as_float(w.y&0xffff0000u);
        v[32*p_+8*i+4]=__uint_as_float(w.z<<16); v[32*p_+8*i+5]=__uint_as_float(w.z&0xffff0000u); v[32*p_+8*i+6]=__uint_as_float(w.w<<16); v[32*p_+8*i+7]=__uint_as_float(w.w&0xffff0000u); }
      asm volatile("s_waitcnt lgkmcnt(0)":::"memory");
    }
    #pragma unroll
    for(int i=0;i<64;++i)ss+=v[i]*v[i];
    ss+=__uint_as_float((unsigned)__builtin_amdgcn_update_dpp(0,(int)__float_as_uint(ss),0xB1,0xF,0xF,false));
    const float rs=(1.0f/sqrtf(ss*(1.0f/128.0f)+1e-6f))*oscale;
    bf16*op=MIXh+((long)rowbase+q0+wid*QBLK+row)*2048+part*32;
    #pragma unroll
    for(int p_=0;p_<2;++p_){ const float*sg=subg+64*p_+32*part;
      #pragma unroll
      for(int i=0;i<4;++i){ u32x4 w; const float*vv=v+32*p_+8*i; const float*gg=sg+8*i;
        w.x=cvtpk_s(vv[0]*rs*gg[0],vv[1]*rs*gg[1]); w.y=cvtpk_s(vv[2]*rs*gg[2],vv[3]*rs*gg[3]); w.z=cvtpk_s(vv[4]*rs*gg[4],vv[5]*rs*gg[5]); w.w=cvtpk_s(vv[6]*rs*gg[6],vv[7]*rs*gg[7]);
        *(u32x4*)(op+64*p_+8*i)=w; } }
  }
  }
  asm volatile("s_waitcnt lgkmcnt(0)\n\ts_barrier":::"memory");
#if PROBE_ATT == 4
  if(blockIdx.x==PROBE_BLK&&threadIdx.x==0)atomicAdd(pw_,(unsigned)(__builtin_amdgcn_s_memrealtime()-ps1_));
#endif
  #undef DMA_K
  #undef DMA_V
  #undef vb0
  #undef CMASK
  #undef START
  #undef RESC
  #undef ROT
  #undef BIAS2
}
constexpr int ATTN_LDS_BYTES=LDS_BYTES;
template<int THRL> __device__ __forceinline__ void attn_unit4(int b,int h,int qb,float lam,float oscale,const float*subg,const unsigned*nmax,unsigned*o1s,const bf16*Q,const bf16*K,const bf16*V,bf16*MIX,char*shm){
  const float sl2=exp2f(-(float)(h+1))*1.4426950408889634f;
  int cap[2]; float Uv[2];
  #pragma unroll
  for(int c=0;c<2;++c){ const int bh=b*8+h; const unsigned*qn=nmax+((0*64+bh)*2+c)*2,*kn=nmax+((1*64+bh)*2+c)*2;
    const float U=1.02f*(sqrtf(__uint_as_float(qn[0])*__uint_as_float(kn[0]))+sqrtf(__uint_as_float(qn[1])*__uint_as_float(kn[1])));
    const float d0=(2.f*U+24.f+log2f(1.f/(1.f-exp2f(-sl2))))/sl2; float st=ceilf((d0+255.f)*(1.f/64.f)); st=st<4.f?4.f:(st>64.f?64.f:st);
    cap[c]=__builtin_amdgcn_readfirstlane((((int)st)+1)&~1); Uv[c]=__uint_as_float(__builtin_amdgcn_readfirstlane(__float_as_uint(U))); }
  for(int c=0;c<2;++c) attn_sub<THRL>(b,(2*h+c)*64,h*128,qb,c,sl2,lam,c?cap[1]:cap[0],c?Uv[1]:Uv[0],oscale,subg,o1s,MIX+h*128,Q,K,V,shm,(unsigned*)nmax+900);
}
__device__ __forceinline__ int wg_pop(unsigned*ctr,volatile __attribute__((address_space(3))) unsigned*slot){
  if(threadIdx.x==0)*slot=__hip_atomic_fetch_add(ctr,1u,__ATOMIC_RELAXED,__HIP_MEMORY_SCOPE_AGENT);
  __syncthreads(); const unsigned n=*slot; __syncthreads(); return (int)n;
}
template<int THRL=8> __device__ __forceinline__ void attn_phase(char*lds,int bx,unsigned*qctr,volatile __attribute__((address_space(3))) unsigned*slot,float lam,float oscale,const float*subg,const unsigned*nmax,unsigned*o1s,const bf16*Q,const bf16*K,const bf16*V,bf16*MIX){
  for(int qi=0;qi<8;++qi){ const int x=(bx+qi)&7;
    for(;;){ const int n=wg_pop(qctr+64*x,slot); if(n>=128)break;
      const int qb=15-(n>>3),h=7-(n&7),b=(x+h)&7;
#if PROBE_ATT == 1
      const unsigned long long pa0_=__builtin_amdgcn_s_memrealtime();
#endif
      attn_unit4<THRL>(b,h,qb,lam,oscale,subg,nmax,o1s,Q,K,V,MIX,lds);
#if PROBE_ATT == 1
      if(blockIdx.x==PROBE_BLK&&threadIdx.x==0)atomicAdd((unsigned*)nmax+900,(unsigned)(__builtin_amdgcn_s_memrealtime()-pa0_));
#endif
    } }
}
#undef SBAR
#undef WAIT_BAR
#undef MFMA32
}
#define GAS __attribute__((address_space(1)))
#define LAS __attribute__((address_space(3)))
typedef unsigned short bf16;
typedef unsigned v4u __attribute__((ext_vector_type(4)));
typedef float f32x4 __attribute__((ext_vector_type(4)));
typedef short bf16x8 __attribute__((ext_vector_type(8)));
typedef GAS unsigned gu32;
typedef GAS unsigned long long gu64;
#define RLX_AGENT __ATOMIC_RELAXED, __HIP_MEMORY_SCOPE_AGENT
#define LDS_WAIT() asm volatile("s_waitcnt lgkmcnt(0)" ::: "memory")
#define VM_WAIT() asm volatile("s_waitcnt vmcnt(0)" ::: "memory")
__device__ __forceinline__ unsigned long long rt() { return __builtin_amdgcn_s_memrealtime(); }
__device__ __forceinline__ unsigned f2bf(float f) { unsigned u = __builtin_bit_cast(unsigned, f); return (u + 0x7fffu + ((u >> 16) & 1u)) >> 16; }
__device__ __forceinline__ unsigned pk2(float lo, float hi) { return f2bf(lo) | (f2bf(hi) << 16); }

#define XB_TMO      128
#define XB_XCNT(j)  (256  + 64 * (j))
#define XB_XSUB(j)  (1280 + 64 * (j))
#define XB_XGEN(j)  (2304 + 64 * (j))
#define XB_TOP      3328
#define XB_TOPGEN   3392
#define XCD_BAR_WORDS 3456
#define XB_SPIN_CAP (1u << 18)

__device__ __forceinline__ unsigned xb_ld(unsigned* p)              { return __hip_atomic_load(p, __ATOMIC_RELAXED, __HIP_MEMORY_SCOPE_AGENT); }
__device__ __forceinline__ unsigned xb_add(unsigned* p, unsigned v) { return __hip_atomic_fetch_add(p, v, __ATOMIC_RELAXED, __HIP_MEMORY_SCOPE_AGENT); }
__device__ __forceinline__ unsigned xb_xcc_id() { return (unsigned)__builtin_amdgcn_s_getreg((3 << 11) | 20) & 0xFu; }
#define XB_SPIN(cond, bar) do { unsigned _sp = 0; while (cond) { __builtin_amdgcn_s_sleep(1); \
    if ((++_sp & 255u) == 0u) { if (xb_ld(&(bar)[XB_TMO])) break; if (_sp > XB_SPIN_CAP) { atomicAdd(&(bar)[XB_TMO], 1u); break; } } } } while (0)

struct XcdBarrier {
    unsigned* bar; unsigned x;
    volatile LAS unsigned* st;
};

__device__ __forceinline__ XcdBarrier xcd_barrier_post(unsigned* bar, volatile LAS unsigned* st) {
    XcdBarrier b; b.bar = bar; b.x = xb_xcc_id(); b.st = st;
    if (threadIdx.x == 0) (void)xb_add(&bar[XB_XCNT(b.x)], 1u);
    return b;
}
__device__ __forceinline__ void xcd_barrier_complete(unsigned* bar, unsigned x, unsigned& nloc, unsigned& nx) {
    const unsigned G = gridDim.x * gridDim.y * gridDim.z;
    unsigned sum, cnt, mine, sp = 0u;
    for (;;) {
        sum = 0u; cnt = 0u; mine = 0u;
#pragma unroll
        for (unsigned j = 0; j < 16; ++j) { const unsigned c = xb_ld(&bar[XB_XCNT(j)]); sum += c; cnt += (c > 0u) ? 1u : 0u; mine = (j == x) ? c : mine; }
        if (sum == G) break;
        __builtin_amdgcn_s_sleep(1);
        if ((++sp & 255u) == 0u) { if (xb_ld(&bar[XB_TMO])) break; if (sp > XB_SPIN_CAP) { atomicAdd(&bar[XB_TMO], 1u); break; } }
    }
    nloc = mine > 0u ? mine : 1u; nx = cnt > 0u ? cnt : 1u;
}

__device__ __forceinline__ void xcd_barrier(const XcdBarrier& b) {
    asm volatile("s_waitcnt vmcnt(0)" ::: "memory");
    __syncthreads();
    if (threadIdx.x == 0) {
        unsigned* bar = b.bar;
        __builtin_amdgcn_s_waitcnt(0);
        unsigned nloc = b.st[0], nx = b.st[1];
        if (nloc == 0u) { xcd_barrier_complete(bar, b.x, nloc, nx); b.st[0] = nloc; b.st[1] = nx; }
        const unsigned old = xb_add(&bar[XB_XSUB(b.x)], 1u);
        const unsigned gen = old / nloc;
        if (old + 1u == (gen + 1u) * nloc) {
            __builtin_amdgcn_fence(__ATOMIC_RELEASE, "agent");
            asm volatile("s_waitcnt vmcnt(0)" ::: "memory");
            const unsigned og = xb_add(&bar[XB_TOP], 1u);
            const unsigned tg = og / nx;
            if (og + 1u == (tg + 1u) * nx) xb_add(&bar[XB_TOPGEN], 1u);
            else XB_SPIN(xb_ld(&bar[XB_TOPGEN]) == tg, bar);
            __builtin_amdgcn_fence(__ATOMIC_ACQUIRE, "agent");
            xb_add(&bar[XB_XGEN(b.x)], 1u);
            asm volatile("s_waitcnt vmcnt(0)" ::: "memory");
        } else {
            XB_SPIN(xb_ld(&bar[XB_XGEN(b.x)]) == gen, bar);
            __builtin_amdgcn_fence(__ATOMIC_ACQUIRE, "agent");
            asm volatile("s_waitcnt vmcnt(0)" ::: "memory");
        }
    }
    __syncthreads();
}

constexpr int NWAVES = 8;
constexpr int BATCH = 8, SEQ = 4096, T = BATCH * SEQ, D = 2048, NIN = 5120, NEXP = 32, NA = 2 * T;
constexpr float EPS = 1e-6f, LOG2E = 1.4426950408889634f, C2 = 0.125f * 1.4426950408889634f;
constexpr size_t MiB = 1u << 20;
constexpr size_t WS_CTL = 0, CTL_ZERO_BYTES = 1 * MiB;
constexpr size_t WS_RSTD1 = 1 * MiB, WS_RSTD2 = WS_RSTD1 + 128 * 1024, WS_WTS = WS_RSTD2 + 128 * 1024;
constexpr size_t WS_LIST = 2 * MiB;
constexpr size_t WS_PART = 6 * MiB;
constexpr size_t WS_WIN = 10 * MiB, WS_WOUT = 30 * MiB;
constexpr size_t WS_WGU = 38 * MiB, WS_WD = 166 * MiB;
constexpr size_t WS_XB = 230 * MiB;
constexpr size_t WS_CG = 358 * MiB;
constexpr size_t WS_MIX = 422 * MiB;
constexpr size_t WS_HB = 550 * MiB;
constexpr size_t WS_HB8 = 678 * MiB;
constexpr size_t WS_WR = 742 * MiB;
constexpr size_t WS_X8 = 743 * MiB;
constexpr size_t WS_WIN8 = 807 * MiB;
constexpr size_t WS_O1S = 811 * MiB;
constexpr size_t WS_LISTW = 827 * MiB, WS_LISTR = 831 * MiB;
constexpr size_t WS_END = 835 * MiB;
constexpr float WSCALE = 32.f, H1SCALE = 4.f, YSCALE = 8.f;
constexpr int CW_TMO = 0, CW_CODE = 1, CW_BAR = 4096, CW_CNT = 8192;
constexpr int CW_GQ = 20480;
constexpr int CW_H8Q = 24576 + 1024;
constexpr int CW_CVQ = 24576, CW_DONE = 24576 + 64;
constexpr int CW_QA = 12288, CW_QC = 12288 + 512, CW_NMAX = 16384;
constexpr int RING_OFF = 0, RING_BYTES = 131072, LDSCTL_OFF = RING_BYTES, MISC_OFF = LDSCTL_OFF + 320, TAB_OFF = LDSCTL_OFF + 1024;
constexpr int LDS_BYTES = 147456;
constexpr int NPHASE = 8;
#ifndef MK_ONE_LAUNCH
#define MK_ONE_LAUNCH 1
#endif
#ifndef PROBE_DOUBLE
#define PROBE_DOUBLE 0
#endif
#ifndef PROBE_CLOCK
#define PROBE_CLOCK 0
#endif
#ifndef USE_NAIVE_ROUTER
#define USE_NAIVE_ROUTER 0
#endif
#ifndef USE_NAIVE_ATTN
#define USE_NAIVE_ATTN 0
#endif


typedef unsigned u32x4g __attribute__((ext_vector_type(4)));
__device__ __forceinline__ float wave_sum(float v) {
#pragma unroll
    for (int o = 1; o < 64; o <<= 1) v += __shfl_xor(v, o);
    return v;
}
__device__ __forceinline__ float bflo(unsigned w) { return __builtin_bit_cast(float, w << 16); }
__device__ __forceinline__ float bfhi(unsigned w) { return __builtin_bit_cast(float, w & 0xffff0000u); }
__device__ __forceinline__ float fexp2(float x) { return __builtin_amdgcn_exp2f(x); }

__device__ __forceinline__ void tr_item(const float* W, int N, const float* gk, int k0, int n0, bf16* dst, int dstK, LAS float* scr, int lane) {
    const int kr = lane >> 3, n4 = 4 * (lane & 7); f32x4 v[8];
#pragma unroll
    for (int i = 0; i < 8; ++i) v[i] = *(const GAS f32x4*)(W + (size_t)(k0 + 8 * i + kr) * N + n0 + n4);
#pragma unroll
    for (int i = 0; i < 8; ++i) { const int kk = 8 * i + kr; const float g = gk ? gk[k0 + kk] : 1.0f;
        scr[(n4 + 0) * 66 + kk] = v[i].x * g; scr[(n4 + 1) * 66 + kk] = v[i].y * g; scr[(n4 + 2) * 66 + kk] = v[i].z * g; scr[(n4 + 3) * 66 + kk] = v[i].w * g; }
    LDS_WAIT(); asm volatile("" ::: "memory");
    const int c = lane & 7;
#pragma unroll
    for (int j = 0; j < 4; ++j) { const int n = (lane >> 3) + 8 * j; const LAS float* s = scr + n * 66 + 8 * c;
        v4u o; o.x = pk2(s[0], s[1]); o.y = pk2(s[2], s[3]); o.z = pk2(s[4], s[5]); o.w = pk2(s[6], s[7]);
        *(GAS v4u*)(dst + (size_t)n * dstK + 8 * c) = o; }
    LDS_WAIT(); asm volatile("" ::: "memory");
}
__device__ __forceinline__ void tr8_load(const float* W, int N, int k0, int n0, int lane, f32x4 (&v)[8]) {
    const int kr = lane >> 3, n4 = 4 * (lane & 7);
#pragma unroll
    for (int i = 0; i < 8; ++i) v[i] = *(const GAS f32x4*)(W + (size_t)(k0 + 8 * i + kr) * N + n0 + n4);
}
__device__ __forceinline__ void tr8_finish(const f32x4 (&v)[8], const float* gk, float scale, int k0, unsigned char* dst, int dstK, LAS float* scr, int lane) {
    const int kr = lane >> 3, n4 = 4 * (lane & 7);
#pragma unroll
    for (int i = 0; i < 8; ++i) { const int kk = 8 * i + kr; const float g = (gk ? gk[k0 + kk] : 1.0f) * scale;
        scr[(n4 + 0) * 66 + kk] = v[i].x * g; scr[(n4 + 1) * 66 + kk] = v[i].y * g; scr[(n4 + 2) * 66 + kk] = v[i].z * g; scr[(n4 + 3) * 66 + kk] = v[i].w * g; }
    LDS_WAIT(); asm volatile("" ::: "memory");
    const int c = lane & 7;
#pragma unroll
    for (int j = 0; j < 4; ++j) { const int n = (lane >> 3) + 8 * j; const LAS float* s = scr + n * 66 + 8 * c;
        pg8::u32x2 o; o.x = pg8::pk4_fp8(s[0], s[1], s[2], s[3]); o.y = pg8::pk4_fp8(s[4], s[5], s[6], s[7]);
        *(GAS pg8::u32x2*)(dst + (size_t)n * dstK + 8 * c) = o; }
    LDS_WAIT(); asm volatile("" ::: "memory");
}
__device__ __forceinline__ void tr_item8(const float* W, int N, const float* gk, float scale, int k0, int n0, unsigned char* dst, int dstK, LAS float* scr, int lane) {
    f32x4 v[8]; tr8_load(W, N, k0, n0, lane, v); tr8_finish(v, gk, scale, k0, dst, dstK, scr, lane);
}
struct Ptrs {
    const float *x, *g1, *w_in, *lq1, *lk1, *lq2, *lk2, *subg, *cw, *cb, *lng, *lnb, *w_out, *g2, *wgr, *bgr, *wer, *ber, *w_gate, *w_up, *w_down, *gf;
    float* out; unsigned char* ws;
};
__device__ __forceinline__ void p0_prologue(const Ptrs& P, LAS unsigned char* lds, int lane, int wave, int gw, int NGW) {
    LAS float* scr = (LAS float*)(lds + RING_OFF + wave * 16384);
    bf16* WIN = (bf16*)(P.ws + WS_WIN); bf16* WOUT = (bf16*)(P.ws + WS_WOUT);
    constexpr int I_IN = 32 * 160, I_OUT = 32 * 64, NITEMS = I_IN + I_OUT;
    for (int it = gw; it < NITEMS; it += NGW) {
        if (it < I_IN) { const int kb = it / 160, nb = it % 160;
            if (nb < 96) tr_item(P.w_in, NIN, P.g1, 64 * kb, 32 * nb, WIN + (size_t)(32 * nb) * 2048 + 64 * kb, 2048, scr, lane);
            else { const int j0 = 32 * (nb - 96), jj = j0 & 1023, drow = 256 * (jj >> 7) + (jj & 127) + (j0 >= 1024 ? 128 : 0);
                tr_item8(P.w_in, NIN, P.g1, WSCALE, 64 * kb, 32 * nb, P.ws + WS_WIN8 + (size_t)drow * 2048 + 64 * kb, 2048, scr, lane); } }
        else { const int r = it - I_IN, kb = r >> 6, nb = r & 63; tr_item(P.w_out, 2048, nullptr, 64 * kb, 32 * nb, WOUT + (size_t)(32 * nb) * 2048 + 64 * kb, 2048, scr, lane); }
    }
    { bf16* WR = (bf16*)(P.ws + WS_WR);
      for (int it = gw; it < 32; it += NGW) tr_item(P.wer, 32, P.g2, 64 * it, 0, WR + 64 * it, 2048, scr, lane);
      for (int k = gw * 64 + lane; k < 2048; k += NGW * 64) { const float gk = P.g2[k]; const f32x4 w = *(const f32x4*)(P.wgr + (size_t)k * 4);
          WR[(size_t)128 * 2048 + k] = (bf16)f2bf(w.x * gk); WR[(size_t)129 * 2048 + k] = (bf16)f2bf(w.y * gk); WR[(size_t)130 * 2048 + k] = (bf16)f2bf(w.z * gk); WR[(size_t)131 * 2048 + k] = (bf16)f2bf(w.w * gk); } }
    bf16* XB = (bf16*)(P.ws + WS_XB); float* RS1 = (float*)(P.ws + WS_RSTD1);
    for (int m0 = gw; m0 < T; m0 += 2 * NGW) {
        f32x4 v[2][8]; float ss[2] = {0.f, 0.f};
#pragma unroll
        for (int q = 0; q < 2; ++q) { const int mr = (m0 + q * NGW < T) ? m0 + q * NGW : T - 1; const GAS f32x4* xr = (const GAS f32x4*)(P.x + (size_t)mr * D) + lane;
#pragma unroll
            for (int j = 0; j < 8; ++j) v[q][j] = xr[64 * j]; }
#pragma unroll
        for (int q = 0; q < 2; ++q) { const int m = m0 + q * NGW; if (m >= T) continue;
#pragma unroll
            for (int j = 0; j < 8; ++j) ss[q] += (v[q][j].x * v[q][j].x + v[q][j].y * v[q][j].y) + (v[q][j].z * v[q][j].z + v[q][j].w * v[q][j].w);
            ss[q] = wave_sum(ss[q]);
            if (lane == 0) RS1[m] = 1.0f / sqrtf(ss[q] * (1.0f / D) + EPS);
            GAS unsigned long long* o8 = (GAS unsigned long long*)(XB + (size_t)m * D) + lane; GAS unsigned* o4 = (GAS unsigned*)(P.ws + WS_X8 + (size_t)m * D) + lane;
#pragma unroll
            for (int j = 0; j < 8; ++j) { o8[64 * j] = (unsigned long long)pk2(v[q][j].x, v[q][j].y) | ((unsigned long long)pk2(v[q][j].z, v[q][j].w) << 32); o4[64 * j] = pg8::pk4_fp8(v[q][j].x, v[q][j].y, v[q][j].z, v[q][j].w); } }
    }
}

constexpr int CVT_ITEMS = 3 * 32768, CVT_CH = 4, CVT_CHUNK = CVT_CH * NWAVES, CVT_NCHUNK = CVT_ITEMS / CVT_CHUNK;
struct MoeItem { const float* src; const float* gk; unsigned char* dst; int N, k0, n0, dstK; };
__device__ __forceinline__ MoeItem moe_decode(const Ptrs& P, int r) {
    unsigned char* WGU = P.ws + WS_WGU; unsigned char* WD = P.ws + WS_WD; MoeItem m;
    const int mat = r >> 15, r2 = r & 32767, e = r2 >> 10, idx = r2 & 1023;
    if (mat < 2) { const int kb = idx >> 5, n0 = 32 * (idx & 31); const int drow = e * 2048 + 256 * (n0 >> 7) + (n0 & 127) + (mat == 1 ? 128 : 0);
        m.src = (mat == 0 ? P.w_gate : P.w_up) + (size_t)e * 2048 * 1024; m.N = 1024; m.gk = P.g2; m.k0 = 64 * kb; m.n0 = n0; m.dst = WGU + (size_t)drow * 2048 + 64 * kb; m.dstK = 2048; }
    else { const int kb = idx >> 6, nb = idx & 63; m.src = P.w_down + (size_t)e * 1024 * 2048; m.N = 2048; m.gk = nullptr; m.k0 = 64 * kb; m.n0 = 32 * nb; m.dst = WD + ((size_t)e * 2048 + 32 * nb) * 1024 + 64 * kb; m.dstK = 1024; }
    return m;
}
__device__ __forceinline__ void cvt_fill(const Ptrs& P, LAS unsigned char* lds, volatile LAS unsigned* slot, int max_chunks, const unsigned* donew, int G) {
    int tid_ = threadIdx.x; asm volatile("" : "+v"(tid_)); const int lane = tid_ & 63, wave = __builtin_amdgcn_readfirstlane(tid_ >> 6);
    LAS float* scr = (LAS float*)(lds + RING_OFF + wave * 16384); unsigned* ctr = (unsigned*)(P.ws + WS_CTL) + CW_CVQ;
    for (int n = 0; n < max_chunks; ++n) {
        if (threadIdx.x == 0) { unsigned v = 0xffffffffu;
            if (!(donew && (int)__hip_atomic_load(donew, __ATOMIC_RELAXED, __HIP_MEMORY_SCOPE_AGENT) >= G - 16)) v = __hip_atomic_fetch_add(ctr, 1u, __ATOMIC_RELAXED, __HIP_MEMORY_SCOPE_AGENT);
            *slot = v; }
        __syncthreads(); const unsigned c = *slot; __syncthreads();
        if (c >= (unsigned)CVT_NCHUNK) break;
#pragma unroll 1
        for (int j = 0; j < CVT_CH; j += 2) {
            const MoeItem m0 = moe_decode(P, (int)c * CVT_CHUNK + wave * CVT_CH + j), m1 = moe_decode(P, (int)c * CVT_CHUNK + wave * CVT_CH + j + 1);
            f32x4 v0[8], v1[8]; tr8_load(m0.src, m0.N, m0.k0, m0.n0, lane, v0); tr8_load(m1.src, m1.N, m1.k0, m1.n0, lane, v1);
            tr8_finish(v0, m0.gk, WSCALE, m0.k0, m0.dst, m0.dstK, scr, lane); tr8_finish(v1, m1.gk, WSCALE, m1.k0, m1.dst, m1.dstK, scr, lane); }
    }
}
__device__ __forceinline__ void h8_fill(const Ptrs& P, const bf16* HB, unsigned char* H8, volatile LAS unsigned* slot) {
    int tid_ = threadIdx.x; asm volatile("" : "+v"(tid_)); const int lane = tid_ & 63, wave = __builtin_amdgcn_readfirstlane(tid_ >> 6);
    unsigned* ctr = (unsigned*)(P.ws + WS_CTL) + CW_H8Q;
    for (;;) { const int c = attn_body::wg_pop(ctr, slot); if (c >= T / 64) break;
#pragma unroll 1
        for (int j = 0; j < 8; j += 4) { const int r0 = c * 64 + wave * 8 + j; u32x4g a[4][4];
#pragma unroll
            for (int q = 0; q < 4; ++q)
#pragma unroll
                for (int i = 0; i < 4; ++i) a[q][i] = *(const u32x4g*)(HB + (size_t)(r0 + q) * D + 16 * lane + 1024 * (i >> 1) + 8 * (i & 1));
#pragma unroll
            for (int q = 0; q < 4; ++q)
#pragma unroll
                for (int hj = 0; hj < 2; ++hj) { const u32x4g w0 = a[q][2 * hj], w1 = a[q][2 * hj + 1]; v4u o;
                    o.x = pg8::pk4_fp8(bflo(w0.x), bfhi(w0.x), bflo(w0.y), bfhi(w0.y)); o.y = pg8::pk4_fp8(bflo(w0.z), bfhi(w0.z), bflo(w0.w), bfhi(w0.w));
                    o.z = pg8::pk4_fp8(bflo(w1.x), bfhi(w1.x), bflo(w1.y), bfhi(w1.y)); o.w = pg8::pk4_fp8(bflo(w1.z), bfhi(w1.z), bflo(w1.w), bfhi(w1.w));
                    *(v4u*)(H8 + (size_t)(r0 + q) * D + 16 * lane + 1024 * hj) = o; } }
    }
}
__device__ __forceinline__ void phase_tail(const Ptrs& P, LAS unsigned char* lds, volatile LAS unsigned* slot, int ph, int G) {
    unsigned* donew = (unsigned*)(P.ws + WS_CTL) + CW_DONE + 64 * ph;
    __syncthreads();
    if (threadIdx.x == 0) __hip_atomic_fetch_add(donew, 1u, __ATOMIC_RELAXED, __HIP_MEMORY_SCOPE_AGENT);
    cvt_fill(P, lds, slot, 1 << 30, donew, G);
}

__device__ __forceinline__ void naive_attn(const Ptrs& P, const bf16* Q, const bf16* Kb, const bf16* Vb, bf16* MIX, int lane, int gw, int NGW) {
    const float s1 = wave_sum(P.lq1[lane] * P.lk1[lane]), s2 = wave_sum(P.lq2[lane] * P.lk2[lane]);
    const float lam0 = 0.2f, lam = expf(s1) - expf(s2) + lam0;
    const int r16 = lane & 15, c = (lane >> 4) & 1, vh = lane >> 5;
    for (int u = gw; u < 16384; u += NGW) {
        const int bh = u & 63, qb = 255 - (u >> 6), b = bh >> 3, h = bh & 7, i = qb * 16 + r16, jmax = qb * 16 + 15;
        const float sl2 = exp2f(-(float)(h + 1)) * LOG2E; const size_t rowb = (size_t)b * SEQ;
        float q[64], O[64];
        { const u32x4g* qp = (const u32x4g*)(Q + (rowb + i) * 1024 + h * 128 + c * 64);
#pragma unroll
          for (int d8 = 0; d8 < 8; ++d8) { const u32x4g w = qp[d8]; q[8 * d8 + 0] = bflo(w.x); q[8 * d8 + 1] = bfhi(w.x); q[8 * d8 + 2] = bflo(w.y); q[8 * d8 + 3] = bfhi(w.y);
              q[8 * d8 + 4] = bflo(w.z); q[8 * d8 + 5] = bfhi(w.z); q[8 * d8 + 6] = bflo(w.w); q[8 * d8 + 7] = bfhi(w.w); } }
#pragma unroll
        for (int d = 0; d < 64; ++d) O[d] = 0.f;
        float m = -1e30f, l = 0.f;
        for (int j = 0; j <= jmax; ++j) {
            const u32x4g* kp = (const u32x4g*)(Kb + (rowb + j) * 1024 + h * 128 + c * 64); float s = 0.f;
#pragma unroll
            for (int d8 = 0; d8 < 8; ++d8) { const u32x4g w = kp[d8];
                s += q[8 * d8 + 0] * bflo(w.x) + q[8 * d8 + 1] * bfhi(w.x) + q[8 * d8 + 2] * bflo(w.y) + q[8 * d8 + 3] * bfhi(w.y)
                   + q[8 * d8 + 4] * bflo(w.z) + q[8 * d8 + 5] * bfhi(w.z) + q[8 * d8 + 6] * bflo(w.w) + q[8 * d8 + 7] * bfhi(w.w); }
            s += sl2 * (float)(j - i);
            if (j <= i) {
                if (s > m) { const float al = fexp2(m - s); l *= al;
#pragma unroll
                    for (int d = 0; d < 64; ++d) O[d] *= al;
                    m = s; }
                const float p = fexp2(s - m); l += p;
                const u32x4g* vp = (const u32x4g*)(Vb + (rowb + j) * 1024 + h * 128 + vh * 64);
#pragma unroll
                for (int d8 = 0; d8 < 8; ++d8) { const u32x4g w = vp[d8];
                    O[8 * d8 + 0] += p * bflo(w.x); O[8 * d8 + 1] += p * bfhi(w.x); O[8 * d8 + 2] += p * bflo(w.y); O[8 * d8 + 3] += p * bfhi(w.y);
                    O[8 * d8 + 4] += p * bflo(w.z); O[8 * d8 + 5] += p * bfhi(w.z); O[8 * d8 + 6] += p * bflo(w.w); O[8 * d8 + 7] += p * bfhi(w.w); }
            }
        }
        const float il = 1.0f / l; float ss = 0.f;
#pragma unroll
        for (int d = 0; d < 64; ++d) { float o = O[d] * il; const float o2 = __shfl_xor(o, 16); o = o - lam * o2; O[d] = o; ss += o * o; }
        ss += __shfl_xor(ss, 32);
        const float r = (1.0f / sqrtf(ss * (1.0f / 128.0f) + EPS)) * (1.0f - lam0);
        if (c == 0) { u32x4g* op = (u32x4g*)(MIX + (rowb + i) * 2048 + h * 128 + vh * 64); const float* sg = P.subg + vh * 64;
#pragma unroll
            for (int d8 = 0; d8 < 8; ++d8) { u32x4g w; w.x = pk2(O[8 * d8 + 0] * r * sg[8 * d8 + 0], O[8 * d8 + 1] * r * sg[8 * d8 + 1]); w.y = pk2(O[8 * d8 + 2] * r * sg[8 * d8 + 2], O[8 * d8 + 3] * r * sg[8 * d8 + 3]);
                w.z = pk2(O[8 * d8 + 4] * r * sg[8 * d8 + 4], O[8 * d8 + 5] * r * sg[8 * d8 + 5]); w.w = pk2(O[8 * d8 + 6] * r * sg[8 * d8 + 6], O[8 * d8 + 7] * r * sg[8 * d8 + 7]); op[d8] = w; } }
    }
}

typedef float f32x2c __attribute__((ext_vector_type(2)));
__device__ __forceinline__ void conv_phase(const Ptrs& P, const bf16* CA, bf16* MIX, LAS unsigned char* lds, int blk, unsigned* qctr, volatile LAS unsigned* slot) {
    int tid_ = threadIdx.x; asm volatile("" : "+v"(tid_)); const int tid = tid_, lane = tid & 63, wave = __builtin_amdgcn_readfirstlane(tid >> 6);
    LAS unsigned* C = (LAS unsigned*)(lds + RING_OFF);
    f32x2c w[31];
#pragma unroll
    for (int j = 0; j < 31; ++j) w[j] = *(const f32x2c*)(P.cw + j * 1024 + 2 * tid);
    const f32x2c bias = *(const f32x2c*)(P.cb + 2 * tid);
    for (int qi = 0; qi < 8; ++qi) { const int xq = (blk + qi) & 7;
    for (;;) { const int n_ = attn_body::wg_pop(qctr + 64 * xq, slot); if (n_ >= 64) break;
        const int tile = xq + 8 * n_, b = tile >> 6, t0 = (tile & 63) * 64; const size_t rowb = (size_t)b * SEQ;
        const unsigned* up = (const unsigned*)(CA + rowb * 1024 + 2 * tid);
        f32x2c win[38]; unsigned hist[30];
#pragma unroll
        for (int k = 0; k < 30; ++k) { const int t = t0 - 30 + k; hist[k] = (t >= 0) ? up[(size_t)t * 512] : 0u; }
        unsigned nw[8];
#pragma unroll
        for (int i = 0; i < 8; ++i) nw[i] = up[(size_t)(t0 + i) * 512];
#pragma unroll
        for (int k = 0; k < 30; ++k) win[k] = (f32x2c){bflo(hist[k]), bfhi(hist[k])};
#pragma unroll 1
        for (int blk8 = 0; blk8 < 8; ++blk8) {
#pragma unroll
            for (int i = 0; i < 8; ++i) win[30 + i] = (f32x2c){bflo(nw[i]), bfhi(nw[i])};
            if (blk8 < 7) {
#pragma unroll
                for (int i = 0; i < 8; ++i) nw[i] = up[(size_t)(t0 + 8 * (blk8 + 1) + i) * 512];
            }
#pragma unroll
            for (int i = 0; i < 8; ++i) { f32x2c acc = bias;
#pragma unroll
                for (int j = 0; j < 31; ++j) acc = w[j] * win[i + j] + acc;
                C[(8 * blk8 + i) * 512 + tid] = pk2(acc.x, acc.y); }
#pragma unroll
            for (int k = 0; k < 30; ++k) win[k] = win[k + 8];
        }
        __syncthreads();
#pragma unroll 1
        for (int k = 0; k < 8; ++k) { const int rr = wave + 8 * k, t = t0 + rr; const LAS unsigned* row = C + rr * 512;
            const v4u x0 = *(const LAS v4u*)(row + 4 * lane), x1 = *(const LAS v4u*)(row + 256 + 4 * lane);
            float v[16] = {bflo(x0.x), bfhi(x0.x), bflo(x0.y), bfhi(x0.y), bflo(x0.z), bfhi(x0.z), bflo(x0.w), bfhi(x0.w), bflo(x1.x), bfhi(x1.x), bflo(x1.y), bfhi(x1.y), bflo(x1.z), bfhi(x1.z), bflo(x1.w), bfhi(x1.w)};
            float s = 0.f;
#pragma unroll
            for (int i = 0; i < 16; ++i) s += v[i];
            const float mean = wave_sum(s) * (1.0f / 1024.0f); float qq = 0.f;
#pragma unroll
            for (int i = 0; i < 16; ++i) { v[i] -= mean; qq += v[i] * v[i]; }
            const float rstd = 1.0f / sqrtf(wave_sum(qq) * (1.0f / 1024.0f) + EPS);
            float y[16];
#pragma unroll
            for (int i = 0; i < 16; ++i) { const int ch = (i < 8 ? 8 * lane + i : 512 + 8 * lane + (i - 8)); const float z = v[i] * rstd * P.lng[ch] + P.lnb[ch]; y[i] = z / (1.f + __expf(-z)); }
            bf16* op = MIX + (rowb + t) * 2048 + 1024 + 8 * lane;
            v4u o0, o1; o0.x = pk2(y[0], y[1]); o0.y = pk2(y[2], y[3]); o0.z = pk2(y[4], y[5]); o0.w = pk2(y[6], y[7]); o1.x = pk2(y[8], y[9]); o1.y = pk2(y[10], y[11]); o1.z = pk2(y[12], y[13]); o1.w = pk2(y[14], y[15]);
            *(GAS v4u*)op = o0; *(GAS v4u*)(op + 512) = o1; }
        __syncthreads();
    } }
}

__device__ __forceinline__ void router_phase(const Ptrs& P, const bf16* HB, int lane, int gw, int NGW) {
    float* RS2 = (float*)(P.ws + WS_RSTD2); float* WTS = (float*)(P.ws + WS_WTS); int* LIST = (int*)(P.ws + WS_LIST); unsigned* CNT = (unsigned*)(P.ws + WS_CTL) + CW_CNT;
    for (int tok = gw; tok < T; tok += NGW) {
        float hv[32]; const bf16* hp = HB + (size_t)tok * D; float ss = 0.f;
#pragma unroll
        for (int j = 0; j < 4; ++j) { const u32x4g w = *(const u32x4g*)(hp + 8 * lane + 512 * j);
            hv[8 * j + 0] = bflo(w.x); hv[8 * j + 1] = bfhi(w.x); hv[8 * j + 2] = bflo(w.y); hv[8 * j + 3] = bfhi(w.y); hv[8 * j + 4] = bflo(w.z); hv[8 * j + 5] = bfhi(w.z); hv[8 * j + 6] = bflo(w.w); hv[8 * j + 7] = bfhi(w.w); }
#pragma unroll
        for (int k = 0; k < 32; ++k) ss += hv[k] * hv[k];
        ss = wave_sum(ss); const float rstd = 1.0f / sqrtf(ss * (1.0f / D) + EPS);
        float lg[36];
#pragma unroll
        for (int o = 0; o < 36; ++o) lg[o] = 0.f;
#pragma unroll
        for (int j = 0; j < 4; ++j)
#pragma unroll 2
            for (int i = 0; i < 8; ++i) { const int e = 8 * lane + 512 * j + i; const float xv = hv[8 * j + i] * P.g2[e];
                const f32x4* wr = (const f32x4*)(P.wer + (size_t)e * 32); const f32x4 wg = *(const f32x4*)(P.wgr + (size_t)e * 4);
#pragma unroll
                for (int o4 = 0; o4 < 8; ++o4) { const f32x4 w = wr[o4]; lg[4 * o4 + 0] += xv * w.x; lg[4 * o4 + 1] += xv * w.y; lg[4 * o4 + 2] += xv * w.z; lg[4 * o4 + 3] += xv * w.w; }
                lg[32] += xv * wg.x; lg[33] += xv * wg.y; lg[34] += xv * wg.z; lg[35] += xv * wg.w; }
#pragma unroll
        for (int o = 0; o < 36; ++o) lg[o] = wave_sum(lg[o]) * rstd + (o < 32 ? P.ber[o] : P.bgr[o - 32]);
        int gs = 0; float gm = lg[32];
#pragma unroll
        for (int g = 1; g < 4; ++g) if (lg[32 + g] > gm) { gm = lg[32 + g]; gs = g; }
        float gsum = 0.f;
#pragma unroll
        for (int g = 0; g < 4; ++g) gsum += __expf(lg[32 + g] - gm);
        const float gw_ = 1.0f / gsum;
        float ev[8];
#pragma unroll
        for (int i = 0; i < 8; ++i) ev[i] = gs == 0 ? lg[i] : gs == 1 ? lg[8 + i] : gs == 2 ? lg[16 + i] : lg[24 + i];
        int i1 = 0; float v1 = ev[0];
#pragma unroll
        for (int i = 1; i < 8; ++i) if (ev[i] > v1) { v1 = ev[i]; i1 = i; }
        int i2 = -1; float v2 = -3.0e38f;
#pragma unroll
        for (int i = 0; i < 8; ++i) if (i != i1 && ev[i] > v2) { v2 = ev[i]; i2 = i; }
        const float e2 = __expf(v2 - v1), w1 = gw_ / (1.f + e2), w2 = gw_ * e2 / (1.f + e2);
        if (lane == 0) {
            RS2[tok] = rstd;
            const int ea = gs * 8 + i1, eb = gs * 8 + i2;
            const unsigned ra = __hip_atomic_fetch_add(CNT + 64 * ea, 1u, __ATOMIC_RELAXED, __HIP_MEMORY_SCOPE_AGENT);
            const unsigned rb = __hip_atomic_fetch_add(CNT + 64 * eb, 1u, __ATOMIC_RELAXED, __HIP_MEMORY_SCOPE_AGENT);
            LIST[(size_t)ea * T + ra] = 2 * tok; LIST[(size_t)eb * T + rb] = 2 * tok + 1; WTS[2 * tok] = w1; WTS[2 * tok + 1] = w2;
        }
    }
}
__device__ __forceinline__ void moe_tables(const Ptrs& P, LAS unsigned char* lds) {
    int tid = threadIdx.x; asm volatile("" : "+v"(tid));
    LAS int* cntL = (LAS int*)(lds + TAB_OFF); LAS int* ts = cntL + 32; unsigned* CNT = (unsigned*)(P.ws + WS_CTL) + CW_CNT;
    if (tid < 32) cntL[tid] = (int)__hip_atomic_load(CNT + 64 * tid, __ATOMIC_RELAXED, __HIP_MEMORY_SCOPE_AGENT);
    __syncthreads();
    if (tid == 0) { int s = 0; for (int e = 0; e < 32; ++e) { ts[e] = s; s += (cntL[e] + 255) >> 8; } ts[32] = s; }
    __syncthreads();
}

__device__ __forceinline__ float fp8f(unsigned w, int i) { return i == 0 ? __builtin_amdgcn_cvt_f32_fp8(w, 0) : i == 1 ? __builtin_amdgcn_cvt_f32_fp8(w, 1) : i == 2 ? __builtin_amdgcn_cvt_f32_fp8(w, 2) : __builtin_amdgcn_cvt_f32_fp8(w, 3); }
__device__ __forceinline__ void final_phase(const Ptrs& P, const bf16* HB, const unsigned char* Y8, int NGW) {
    int tid_ = threadIdx.x; asm volatile("" : "+v"(tid_)); const int lane = tid_ & 63, gw = (int)blockIdx.x * NWAVES + __builtin_amdgcn_readfirstlane(tid_ >> 6);
    for (int tok = gw; tok < T; tok += NGW) {
        const bf16* hp = HB + (size_t)tok * D; const unsigned char* y1 = Y8 + (size_t)tok * 4096; const unsigned char* y2 = y1 + 2048; float v[32]; float ss = 0.f;
#pragma unroll
        for (int j = 0; j < 4; ++j) { const int o = 8 * lane + 512 * j; const u32x4g a = *(const u32x4g*)(hp + o); const pg8::u32x2 b = *(const pg8::u32x2*)(y1 + o), c = *(const pg8::u32x2*)(y2 + o);
            const float ys = 1.0f / YSCALE;
            v[8 * j + 0] = bflo(a.x) + (fp8f(b.x, 0) + fp8f(c.x, 0)) * ys; v[8 * j + 1] = bfhi(a.x) + (fp8f(b.x, 1) + fp8f(c.x, 1)) * ys; v[8 * j + 2] = bflo(a.y) + (fp8f(b.x, 2) + fp8f(c.x, 2)) * ys; v[8 * j + 3] = bfhi(a.y) + (fp8f(b.x, 3) + fp8f(c.x, 3)) * ys;
            v[8 * j + 4] = bflo(a.z) + (fp8f(b.y, 0) + fp8f(c.y, 0)) * ys; v[8 * j + 5] = bfhi(a.z) + (fp8f(b.y, 1) + fp8f(c.y, 1)) * ys; v[8 * j + 6] = bflo(a.w) + (fp8f(b.y, 2) + fp8f(c.y, 2)) * ys; v[8 * j + 7] = bfhi(a.w) + (fp8f(b.y, 3) + fp8f(c.y, 3)) * ys; }
#pragma unroll
        for (int k = 0; k < 32; ++k) ss += v[k] * v[k];
        ss = wave_sum(ss); const float rstd = 1.0f / sqrtf(ss * (1.0f / D) + EPS);
        float* op = P.out + (size_t)tok * D;
#pragma unroll
        for (int j = 0; j < 4; ++j) { const int o = 8 * lane + 512 * j; const f32x4 g0 = *(const f32x4*)(P.gf + o), g1 = *(const f32x4*)(P.gf + o + 4);
            f32x4 r0 = {v[8 * j + 0] * rstd * g0.x, v[8 * j + 1] * rstd * g0.y, v[8 * j + 2] * rstd * g0.z, v[8 * j + 3] * rstd * g0.w};
            f32x4 r1 = {v[8 * j + 4] * rstd * g1.x, v[8 * j + 5] * rstd * g1.y, v[8 * j + 6] * rstd * g1.z, v[8 * j + 7] * rstd * g1.w};
            *(f32x4*)(op + o) = r0; *(f32x4*)(op + o + 4) = r1; }
    }
}

struct Args { const float* in[22]; float* out; unsigned char* ws; int ph_lo, ph_hi; };
__global__ void __launch_bounds__(NWAVES * 64, 2) fwd(Args args) {
    extern __shared__ __attribute__((aligned(16))) unsigned char lds_raw[];
    LAS unsigned char* lds = (LAS unsigned char*)lds_raw;
    volatile LAS unsigned* MISC = (volatile LAS unsigned*)(lds + MISC_OFF);
    const int tid = threadIdx.x, lane = tid & 63, wave = __builtin_amdgcn_readfirstlane(tid >> 6), G = gridDim.x;
    const int gw = blockIdx.x * NWAVES + wave, NGW = G * NWAVES;
    Ptrs P;
    P.x = args.in[0]; P.g1 = args.in[1]; P.w_in = args.in[2]; P.lq1 = args.in[3]; P.lk1 = args.in[4]; P.lq2 = args.in[5]; P.lk2 = args.in[6]; P.subg = args.in[7];
    P.cw = args.in[8]; P.cb = args.in[9]; P.lng = args.in[10]; P.lnb = args.in[11]; P.w_out = args.in[12]; P.g2 = args.in[13]; P.wgr = args.in[14]; P.bgr = args.in[15];
    P.wer = args.in[16]; P.ber = args.in[17]; P.w_gate = args.in[18]; P.w_up = args.in[19]; P.w_down = args.in[20]; P.gf = args.in[21]; P.out = args.out; P.ws = args.ws;
    unsigned char* ws = args.ws;
#define WIN ((bf16*)(ws + WS_WIN))
#define WOUT ((bf16*)(ws + WS_WOUT))
#define WGU (ws + WS_WGU)
#define WD (ws + WS_WD)
#define XB ((bf16*)(ws + WS_XB))
#define H1 (ws + WS_XB)
#define HB8 (ws + WS_HB8)
#define CGB ((bf16*)(ws + WS_CG))
#define MIX ((bf16*)(ws + WS_MIX))
#define HB ((bf16*)(ws + WS_HB))
#define QB ((bf16*)P.out)
#define KB (QB + (size_t)T * 1024)
#define VB (QB + (size_t)T * 2048)
#define CAB (QB + (size_t)T * 3072)
#define YB ((bf16*)P.out)
#define RELOAD_ARGS() do { const __attribute__((address_space(4))) Args* ka_ = (const __attribute__((address_space(4))) Args*)__builtin_amdgcn_kernarg_segment_ptr(); asm volatile("" : "+s"(ka_)); \
    P.x = ka_->in[0]; P.g1 = ka_->in[1]; P.w_in = ka_->in[2]; P.lq1 = ka_->in[3]; P.lk1 = ka_->in[4]; P.lq2 = ka_->in[5]; P.lk2 = ka_->in[6]; P.subg = ka_->in[7]; \
    P.cw = ka_->in[8]; P.cb = ka_->in[9]; P.lng = ka_->in[10]; P.lnb = ka_->in[11]; P.w_out = ka_->in[12]; P.g2 = ka_->in[13]; P.wgr = ka_->in[14]; P.bgr = ka_->in[15]; \
    P.wer = ka_->in[16]; P.ber = ka_->in[17]; P.w_gate = ka_->in[18]; P.w_up = ka_->in[19]; P.w_down = ka_->in[20]; P.gf = ka_->in[21]; P.out = ka_->out; P.ws = ka_->ws; ws = ka_->ws; } while (0)
    for (int u = tid; u < (LDS_BYTES - LDSCTL_OFF) / 4; u += NWAVES * 64) ((LAS unsigned*)(lds + LDSCTL_OFF))[u] = 0u;
    __syncthreads();
    const int lo = args.ph_lo, hi = args.ph_hi;
    XcdBarrier bar; bar.bar = (unsigned*)(ws + WS_CTL) + CW_BAR; bar.x = 0; bar.st = nullptr;
    if (hi - lo > 1) bar = xcd_barrier_post((unsigned*)(ws + WS_CTL) + CW_BAR, MISC + 8);
#define IN(k) (lo <= (k) && (k) < hi)
#if PROBE_PHASE >= 0
    unsigned long long pst_[NPHASE + 1]; pst_[0] = __builtin_amdgcn_s_memrealtime();
#define SEAM(k) do { if (IN(k) && IN((k) + 1)) xcd_barrier(bar); pst_[(k) + 1] = __builtin_amdgcn_s_memrealtime(); } while (0)
#else
#define SEAM(k) do { if (IN(k) && IN((k) + 1)) xcd_barrier(bar); } while (0)
#endif
#define REP(k) for (int rep_ = 0; rep_ <= ((PROBE_DOUBLE >> (k)) & 1); ++rep_)

    if (IN(0)) REP(0) { p0_prologue(P, lds, lane, wave, gw, NGW); }
    SEAM(0);
#if PROBE_CLOCK
    const long long pc0 = clock64(), pr0 = wall_clock64();
#endif
    if (IN(1)) {
        cvt_fill(P, lds, MISC + 12, (int)((blockIdx.x >> 3) % 8), nullptr, G);
        for (int pass = 0; pass < 2; ++pass) {
            if ((pass ^ (int)(blockIdx.x & 1)) == 0) { pg8::Gemm g{XB, WIN, 1, 3072, D, (unsigned*)(ws + WS_CTL) + 3002}; pg8::DynDense S; S.init(T, 3072, (unsigned*)(ws + WS_CTL) + CW_GQ + 0 * 512, (volatile LAS int*)(MISC + 16), (int)blockIdx.x);
                pg8::EpiIn E{QB, (size_t)T * 1024, CGB, (const float*)(ws + WS_RSTD1), C2, (unsigned*)(ws + WS_CTL) + CW_NMAX, 0, 1.0f};
                pg8::gemm_phase<pg8::EpiIn, pg8::DynDense, true, false>(lds + RING_OFF, g, S, E); }
            else { pg8::Gemm g{(const bf16*)(ws + WS_X8), (const bf16*)(ws + WS_WIN8), 2, 2048, D / 2, (unsigned*)(ws + WS_CTL) + 3002}; pg8::DynDenseG S; S.init(T, 2048, (unsigned*)(ws + WS_CTL) + CW_GQ + 1 * 512, (volatile LAS int*)(MISC + 16), (int)blockIdx.x);
                pg8::EpiGLU E{CAB, (const float*)(ws + WS_RSTD1), 1.0f / WSCALE};
                pg8::gemm_phase<pg8::EpiGLU, pg8::DynDenseG, true, true, true>(lds + RING_OFF, g, S, E); }
        }
#if PROBE_ATT == 6
        if (threadIdx.x == 0) atomicMax((unsigned*)(ws + WS_CTL) + CW_NMAX + 900, (unsigned)(__builtin_amdgcn_s_memrealtime() - pst_[1]));
#endif
#if PROBE_ATT == 7
        if (threadIdx.x == 0) atomicAdd((unsigned*)(ws + WS_CTL) + CW_NMAX + 900, (unsigned)(__builtin_amdgcn_s_memrealtime() - pst_[1]) >> 8);
#endif
#if PROBE_ATT == 5
        if (blockIdx.x == PROBE_BLK && threadIdx.x == 0) atomicAdd((unsigned*)(ws + WS_CTL) + CW_NMAX + 900, (unsigned)(__builtin_amdgcn_s_memrealtime() - pst_[1]));
#endif
        phase_tail(P, lds, MISC + 12, 1, G);
    }
#if PROBE_CLOCK
    if (IN(1) && tid == 0) { const unsigned dt = (unsigned)(wall_clock64() - pr0); atomicAdd((unsigned*)(ws + WS_CTL) + 3000, dt); atomicMax((unsigned*)(ws + WS_CTL) + 3001, dt); }
#endif
    SEAM(1);
    if (IN(2)) {
#if USE_NAIVE_ATTN
        naive_attn(P, QB, KB, VB, MIX, lane, gw, NGW);
#else
        { float s1 = 0.f, s2 = 0.f;
          for (int i = 0; i < 64; ++i) { s1 += P.lq1[i] * P.lk1[i]; s2 += P.lq2[i] * P.lk2[i]; }
          const float lam0 = 0.2f, lam = expf(s1) - expf(s2) + lam0;
          static_assert(attn_body::ATTN_LDS_BYTES <= RING_BYTES, "attention LDS");
          attn_body::attn_phase<8>((char*)lds_raw + RING_OFF, (int)blockIdx.x, (unsigned*)(ws + WS_CTL) + CW_QA, MISC + 12, lam, 1.0f - lam0, P.subg, (const unsigned*)(ws + WS_CTL) + CW_NMAX, (unsigned*)(ws + WS_O1S) + (size_t)blockIdx.x * 16384,
                                   (const attn_body::bf16*)QB, (const attn_body::bf16*)KB, (const attn_body::bf16*)VB, (attn_body::bf16*)MIX); }
        RELOAD_ARGS();
#endif
        conv_phase(P, CAB, MIX, lds, (int)blockIdx.x, (unsigned*)(ws + WS_CTL) + CW_QC, MISC + 12);
#if PROBE_ATT == 2
        if (blockIdx.x == PROBE_BLK && threadIdx.x == 0) atomicAdd((unsigned*)(ws + WS_CTL) + CW_NMAX + 900, (unsigned)(__builtin_amdgcn_s_memrealtime() - pst_[2]));
#endif
        phase_tail(P, lds, MISC + 12, 2, G);
    }
    SEAM(2);
    if (IN(3)) {
        pg8::Gemm g{MIX, WOUT, 3, D, D, (unsigned*)(ws + WS_CTL) + 3002}; pg8::StaticOrder S; S.init(T, D, G, (int)blockIdx.x); S.rep = 1 + ((PROBE_DOUBLE >> 3) & 1);
        pg8::EpiOut E{HB, XB, (float*)(ws + WS_PART), nullptr};
        pg8::gemm_phase<pg8::EpiOut, pg8::StaticOrder, true, false>(lds + RING_OFF, g, S, E);
        phase_tail(P, lds, MISC + 12, 3, G);
    }
    SEAM(3);
#if PROBE_ATT == 9
    if (IN(4) && blockIdx.x == PROBE_BLK && threadIdx.x == 0) atomicAdd((unsigned*)(ws + WS_CTL) + CW_NMAX + 900, 10u * __hip_atomic_load((unsigned*)(ws + WS_CTL) + CW_CVQ, __ATOMIC_RELAXED, __HIP_MEMORY_SCOPE_AGENT));
#endif
#if USE_NAIVE_ROUTER
    if (IN(4)) { router_phase(P, HB, lane, gw, NGW); }
#else
    if (IN(4)) {
        pg8::Gemm g{HB, (const bf16*)(ws + WS_WR), T, 256, D}; pg8::StaticOrder S; S.init(T, 256, G, (int)blockIdx.x);
        pg8::EpiRouter E{(const float*)(ws + WS_PART), P.ber, P.bgr, (float*)(ws + WS_LISTR), (float*)(ws + WS_LISTW), (int*)(ws + WS_LIST), (unsigned*)(ws + WS_CTL) + CW_CNT, T};
        pg8::gemm_phase<pg8::EpiRouter, pg8::StaticOrder, true, false>(lds + RING_OFF, g, S, E);
        h8_fill(P, HB, HB8, MISC + 12);
        phase_tail(P, lds, MISC + 12, 4, G);
#if PROBE_ATT == 8
        if (blockIdx.x == PROBE_BLK && threadIdx.x == 0) atomicAdd((unsigned*)(ws + WS_CTL) + CW_NMAX + 900, 10u * __hip_atomic_load((unsigned*)(ws + WS_CTL) + CW_CVQ, __ATOMIC_RELAXED, __HIP_MEMORY_SCOPE_AGENT));
#endif
        cvt_fill(P, lds, MISC + 12, 1 << 30, nullptr, G);
    }
#endif
    SEAM(4);
    if (IN(5)) {
        moe_tables(P, lds);
        pg8::Gemm g{(const bf16*)HB8, (const bf16*)WGU, 5, 2048, D / 2, (unsigned*)(ws + WS_CTL) + 3002};
        pg8::MoeOrder S{(const LAS int*)(lds + TAB_OFF) + 32, (const LAS int*)(lds + TAB_OFF), (const int*)(ws + WS_LIST), G, (int)blockIdx.x, 1, T, (size_t)2048 * 2048, 0};
        pg8::EpiGU E{H1, (const int*)(ws + WS_LIST), (const float*)(ws + WS_LISTR), 1.0f / WSCALE, H1SCALE};
        pg8::gemm_phase<pg8::EpiGU, pg8::MoeOrder, true, true, true>(lds + RING_OFF, g, S, E);
    }
    SEAM(5);
    if (IN(6)) {
        moe_tables(P, lds);
        pg8::Gemm g{(const bf16*)H1, (const bf16*)WD, 6, 2048, 512, (unsigned*)(ws + WS_CTL) + 3002};
        pg8::MoeOrder S{(const LAS int*)(lds + TAB_OFF) + 32, (const LAS int*)(lds + TAB_OFF), (const int*)(ws + WS_LIST), G, (int)blockIdx.x, 0, T, (size_t)2048 * 1024, 1};
        pg8::EpiDown E{ws + WS_MIX, (const int*)(ws + WS_LIST), (const float*)(ws + WS_LISTW), YSCALE / (WSCALE * H1SCALE)};
        pg8::gemm_phase<pg8::EpiDown, pg8::MoeOrder, true, true, true>(lds + RING_OFF, g, S, E);
    }
    SEAM(6);
    if (IN(7)) { final_phase(P, HB, ws + WS_MIX, NGW); }
#if PROBE_ATT
    if (blockIdx.x == 0) { const unsigned long long span = __hip_atomic_load((unsigned*)(ws + WS_CTL) + CW_NMAX + 900, __ATOMIC_RELAXED, __HIP_MEMORY_SCOPE_AGENT); const unsigned long long r1 = __builtin_amdgcn_s_memrealtime(); while (__builtin_amdgcn_s_memrealtime() - r1 < span) __builtin_amdgcn_s_sleep(8); }
#endif
#if PROBE_PHASE >= 0
    pst_[NPHASE] = __builtin_amdgcn_s_memrealtime();
    if (blockIdx.x == 0 && PROBE_PHASE < 100) { const unsigned long long span = pst_[(PROBE_PHASE < 100 ? PROBE_PHASE : 0) + 1] - pst_[PROBE_PHASE < 100 ? PROBE_PHASE : 0]; const unsigned long long r1 = __builtin_amdgcn_s_memrealtime(); while (__builtin_amdgcn_s_memrealtime() - r1 < span) __builtin_amdgcn_s_sleep(8); }
#endif
#if PROBE_KLOOP
    if (blockIdx.x == 0) { const long long pticks = (long long)__hip_atomic_load((unsigned*)(ws + WS_CTL) + 3002, __ATOMIC_RELAXED, __HIP_MEMORY_SCOPE_AGENT); const long long r1 = wall_clock64(); while (wall_clock64() - r1 < pticks) __builtin_amdgcn_s_sleep(8); }
#endif
#if PROBE_CLOCK
    if (blockIdx.x == 0) { const unsigned sum = __hip_atomic_load((unsigned*)(ws + WS_CTL) + 3000, __ATOMIC_RELAXED, __HIP_MEMORY_SCOPE_AGENT), mx = __hip_atomic_load((unsigned*)(ws + WS_CTL) + 3001, __ATOMIC_RELAXED, __HIP_MEMORY_SCOPE_AGENT);
        const long long pticks = (long long)mx - (long long)(sum / (unsigned)G); const long long r1 = wall_clock64(); while (wall_clock64() - r1 < pticks) __builtin_amdgcn_s_sleep(8); }
#endif
#undef IN
#undef SEAM
#undef REP
}

extern "C" void kernel_launch(void* const* d_in, const int* in_sizes, int n_in, void* d_out, int out_size, void* d_ws, size_t ws_size, hipStream_t stream) {
    static int grid = 0;
    if (grid == 0) {
        if (n_in != 22 || in_sizes[0] != T * D || out_size != T * D || ws_size < WS_END) { fprintf(stderr, "kernel_launch: unexpected shapes (n_in %d, in0 %d, out %d, ws %zu); nothing launched\n", n_in, n_in > 0 ? in_sizes[0] : -1, out_size, ws_size); grid = -1; return; }
        int dev = 0, cus = 0, per_cu = 0;
        if (hipGetDevice(&dev) != hipSuccess || hipDeviceGetAttribute(&cus, hipDeviceAttributeMultiprocessorCount, dev) != hipSuccess) { grid = -1; return; }
        if (hipFuncSetAttribute((const void*)fwd, hipFuncAttributeMaxDynamicSharedMemorySize, LDS_BYTES) != hipSuccess) { fprintf(stderr, "kernel_launch: hipFuncSetAttribute failed\n"); grid = -1; return; }
        if (hipOccupancyMaxActiveBlocksPerMultiprocessor(&per_cu, (const void*)fwd, NWAVES * 64, LDS_BYTES) != hipSuccess || per_cu < 1) fprintf(stderr, "kernel_launch: occupancy query reports %d\n", per_cu);
        (void)hipGetLastError();
        grid = cus;
    }
    if (grid < 0) return;
    if (hipMemsetAsync((char*)d_ws + WS_CTL, 0, CTL_ZERO_BYTES, stream) != hipSuccess) return;
    Args a{};
    for (int i = 0; i < 22; ++i) a.in[i] = (const float*)d_in[i];
    a.out = (float*)d_out; a.ws = (unsigned char*)d_ws;
#if MK_ONE_LAUNCH
    a.ph_lo = 0; a.ph_hi = NPHASE;
    hipLaunchKernelGGL(fwd, dim3(grid), dim3(NWAVES * 64), LDS_BYTES, stream, a);
#else
    for (int p = 0; p < NPHASE; ++p) { a.ph_lo = p; a.ph_hi = p + 1; hipLaunchKernelGGL(fwd, dim3(grid), dim3(NWAVES * 64), LDS_BYTES, stream, a); }
#endif
}
```

```cpp
#include <hip/hip_runtime.h>
#include <cstdio>
#include <cstdint>
#ifndef PROBE_KLOOP
#define PROBE_KLOOP 0
#endif
#ifndef PROBE_WHAT
#define PROBE_WHAT 0
#endif
#ifndef PROBE_PHASE
#define PROBE_PHASE -1
#endif
#ifndef PROBE_ATT
#define PROBE_ATT 0
#endif
#ifndef PROBE_BLK
#define PROBE_BLK 0
#endif
namespace pg8 {
#define PG8_LAS __attribute__((address_space(3)))
typedef unsigned short bf16_t;
typedef short bf16x8 __attribute__((ext_vector_type(8)));
typedef float f32x4 __attribute__((ext_vector_type(4)));
typedef unsigned u32x4 __attribute__((ext_vector_type(4)));
constexpr int BM = 256, BK = 64, HALF = 128, HTB = HALF * BK * 2  , STAGE_BYTES = 8 * HTB, NXCD = 8, WGM = 8;

__host__ __device__ __forceinline__ int lds_byte(int r, int c) { const int st = (r >> 4) * 2 + (c >> 5), rr = r & 15, cc = c & 31, ob = rr * 64 + cc * 2; return st * 1024 + (ob ^ (((ob >> 9) & 1) << 5)); }
__host__ __device__ __forceinline__ void stage_rc(int b, int& R, int& C) { const int st = b / 1024, sb = b % 1024, swz = sb ^ (((sb >> 9) & 1) << 5); R = (st >> 1) * 16 + swz / 64; C = (st & 1) * 32 + (swz % 64) / 2; }
__host__ __device__ __forceinline__ int perm32(int rho) { const int n = rho >> 4, i = rho & 15; return 8 * (i >> 2) + 4 * n + (i & 3); }

struct Unit { int pm, pn, e, nvalid, lbase, srow; };
struct Gemm { const bf16_t* A; const bf16_t* Bt; int M, N, K; unsigned* probe = nullptr; };

struct StaticOrder {
    int nM, nN, nwg, G, c, rep = 1;
    __host__ __device__ void init(int M, int N, int G_, int c_) { nM = M / BM; nN = N / BM; nwg = nM * nN; G = G_; c = c_; }
    __host__ __device__ bool next(int i, Unit& u) const {
        long L = (long)i * G + c; if (L >= (long)nwg * rep) return false; L %= nwg;
        int wgid = (int)L; { const int q = nwg / NXCD, r = nwg % NXCD, xcd = wgid % NXCD, off = wgid / NXCD; wgid = (xcd < r ? xcd * (q + 1) : r * (q + 1) + (xcd - r) * q) + off; }
        const int nig = WGM * nN, gid = wgid / nig, fm = gid * WGM, gsz = (nM - fm) < WGM ? (nM - fm) : WGM;
        u.pm = fm + ((wgid % nig) % gsz); u.pn = (wgid % nig) / gsz; return true;
    }
    __device__ __forceinline__ const char* bbase(const Gemm& g, const Unit& u, size_t tstep) const { return (const char*)g.Bt + (size_t)u.pn * tstep; }
    __device__ __forceinline__ unsigned goff(const Unit&, int, int, int) const { return 0u; }
    __device__ __forceinline__ void a_ready(const Unit&) const {}
    __device__ __forceinline__ void done(const Unit&) const {}
};

struct StaticOrderG : StaticOrder {
    __device__ __forceinline__ unsigned goff(const Unit& u, int r, int C, int K) const { return ((unsigned)(u.pm * BM + r) * (unsigned)K + (unsigned)C) * 2u; }
};

struct MoeOrder {
    const PG8_LAS int* tstart; const PG8_LAS int* cnt; const int* list; int G, c, shift, lcap; size_t estride; int sorted;
    __device__ __forceinline__ bool next(int i, Unit& u) const {
        const int ntiles = tstart[32]; const int x = c & 7, k = i * (G >> 3) + (c >> 3); const int rt = 2 * (k >> 1) + (x & 1); if (rt >= ntiles) return false;
        int e = 0;
#pragma unroll
        for (int q = 1; q < 32; ++q) e += (tstart[q] <= rt) ? 1 : 0;
        e = __builtin_amdgcn_readfirstlane(e);
        const int pm = __builtin_amdgcn_readfirstlane(rt - tstart[e]); const int rem = __builtin_amdgcn_readfirstlane(cnt[e]) - 256 * pm;
        u.pm = pm; u.pn = 2 * (x >> 1) + (k & 1); u.e = e; u.nvalid = rem < 256 ? rem : 256; u.lbase = e * lcap + 256 * pm; u.srow = 256 * rt; return true;
    }
    __device__ __forceinline__ const char* bbase(const Gemm& g, const Unit& u, size_t tstep) const { return (const char*)g.Bt + (size_t)u.e * estride + (size_t)u.pn * tstep; }
    __device__ __forceinline__ unsigned goff(const Unit& u, int r, int C, int K) const {
        if (sorted) return ((unsigned)(u.srow + r) * (unsigned)K + (unsigned)C) * 2u;
        const int a = list[u.lbase + (r < u.nvalid ? r : 0)];
        return ((unsigned)(a >> shift) * (unsigned)K + (unsigned)C) * 2u;
    }
    __device__ __forceinline__ void a_ready(const Unit&) const {}
    __device__ __forceinline__ void done(const Unit&) const {}
};

struct DynQ {
    unsigned* ctr; volatile PG8_LAS int* slot; int x0, qi; unsigned pend;
    __device__ __forceinline__ void qinit(unsigned* ctr_, volatile PG8_LAS int* slot_, int bx) { ctr = ctr_; slot = slot_; x0 = bx & 7; qi = 0; pend = 0u;
        if (threadIdx.x == 0) pend = __hip_atomic_fetch_add(ctr + 64 * x0, 1u, __ATOMIC_RELAXED, __HIP_MEMORY_SCOPE_AGENT); }
    template <class SizeF> __device__ __forceinline__ int qnext(int i, const SizeF& size_of) {
        const int par = i & 1;
        if (threadIdx.x == 0) { int res = -1;
            while (qi < 8) { const int x = (x0 + qi) & 7; if (pend < (unsigned)size_of(x)) { res = (x << 24) | (int)pend; break; }
                ++qi; if (qi < 8) pend = __hip_atomic_fetch_add(ctr + 64 * ((x0 + qi) & 7), 1u, __ATOMIC_RELAXED, __HIP_MEMORY_SCOPE_AGENT); }
            slot[par] = res;
            if (res >= 0) pend = __hip_atomic_fetch_add(ctr + 64 * ((x0 + qi) & 7), 1u, __ATOMIC_RELAXED, __HIP_MEMORY_SCOPE_AGENT); }
        asm volatile("s_waitcnt lgkmcnt(0)" ::: "memory"); __builtin_amdgcn_s_barrier(); asm volatile("" ::: "memory");
        return __builtin_amdgcn_readfirstlane(slot[par]);
    }
};
struct DynDense : DynQ {
    int nM, nN, nwg;
    __device__ __forceinline__ void init(int M, int N, unsigned* ctr_, volatile PG8_LAS int* slot_, int bx) { nM = M / BM; nN = N / BM; nwg = nM * nN; qinit(ctr_, slot_, bx); }
    __device__ __forceinline__ bool next(int i, Unit& u) {
        const int q = nwg / NXCD, r = nwg % NXCD;
        const int code = qnext(i, [=](int x) { return q + (x < r ? 1 : 0); }); if (code < 0) return false;
        const int x = code >> 24, k = code & 0xffffff; const int wgid = (x < r ? x * (q + 1) : r * (q + 1) + (x - r) * q) + k;
        const int nig = WGM * nN, gid = wgid / nig, fm = gid * WGM, gsz = (nM - fm) < WGM ? (nM - fm) : WGM;
        u.pm = fm + ((wgid % nig) % gsz); u.pn = (wgid % nig) / gsz; return true;
    }
    __device__ __forceinline__ const char* bbase(const Gemm& g, const Unit& u, size_t tstep) const { return (const char*)g.Bt + (size_t)u.pn * tstep; }
    __device__ __forceinline__ unsigned goff(const Unit&, int, int, int) const { return 0u; }
    __device__ __forceinline__ void a_ready(const Unit&) const {}
    __device__ __forceinline__ void done(const Unit&) const {}
};
struct DynDenseG : DynDense {
    __device__ __forceinline__ unsigned goff(const Unit& u, int r, int C, int K) const { return ((unsigned)(u.pm * BM + r) * (unsigned)K + (unsigned)C) * 2u; }
};

__device__ __forceinline__ unsigned cvt_pk_bf16(float lo, float hi) { unsigned r; asm volatile("v_cvt_pk_bf16_f32 %0, %1, %2" : "=v"(r) : "v"(lo), "v"(hi)); return r; }
__device__ __forceinline__ float bf_lo(unsigned w) { return __builtin_bit_cast(float, w << 16); }
__device__ __forceinline__ float bf_hi(unsigned w) { return __builtin_bit_cast(float, w & 0xffff0000u); }
__device__ __forceinline__ unsigned pk4_fp8(float a, float b, float c, float d) {
    a = __builtin_amdgcn_fmed3f(a, -440.f, 440.f); b = __builtin_amdgcn_fmed3f(b, -440.f, 440.f); c = __builtin_amdgcn_fmed3f(c, -440.f, 440.f); d = __builtin_amdgcn_fmed3f(d, -440.f, 440.f);
    int r = __builtin_amdgcn_cvt_pk_fp8_f32(a, b, 0, false); r = __builtin_amdgcn_cvt_pk_fp8_f32(c, d, r, true); return (unsigned)r; }
typedef unsigned u32x2 __attribute__((ext_vector_type(2)));
__device__ __forceinline__ void swap16(u32x2& a, u32x2& b) { auto r0 = __builtin_amdgcn_permlane16_swap(a.x, b.x, false, false); auto r1 = __builtin_amdgcn_permlane16_swap(a.y, b.y, false, false); a = (u32x2){r0[0], r1[0]}; b = (u32x2){r0[1], r1[1]}; }
typedef int v4i_t __attribute__((ext_vector_type(4)));

struct EpiIn {
    static constexpr bool PERM = true, AFTER_DRAIN = false;
    bf16_t* P0; size_t stride; bf16_t* CG; const float* rstd; float scale0; unsigned* nmax; int tbase; float oscale;
    __device__ __forceinline__ void operator()(const f32x4 (&acc)[2][2][4][2], const Unit& u, int wr, int wc, int fr, int fq) const {
        const int row0 = u.pm * BM + wr * 64 + fr, t = (u.pn >> 2) + tbase; bf16_t* base = (t < 4) ? P0 + (size_t)t * stride : CG;
        const float sc = ((t == 0) ? scale0 : 1.f) * oscale; const int col0 = (u.pn & 3) * BM + wc * 32 + 8 * fq;
        float mx[2] = {0.f, 0.f}; float rsv[2][4];
#pragma unroll
        for (int ai = 0; ai < 2; ++ai)
#pragma unroll
            for (int m = 0; m < 4; ++m) rsv[ai][m] = rstd[row0 + ai * HALF + m * 16];
#pragma unroll
        for (int ai = 0; ai < 2; ++ai)
#pragma unroll
            for (int m = 0; m < 4; ++m) { const int row = row0 + ai * HALF + m * 16; const float rs = rsv[ai][m] * sc; bf16_t* rowp = base + (size_t)row * 1024 + col0;
#pragma unroll
                for (int bj = 0; bj < 2; ++bj) { const f32x4 v0 = acc[ai][bj][m][0] * rs, v1 = acc[ai][bj][m][1] * rs;
                    u32x4 w; w.x = cvt_pk_bf16(v0[0], v0[1]); w.y = cvt_pk_bf16(v0[2], v0[3]); w.z = cvt_pk_bf16(v1[0], v1[1]); w.w = cvt_pk_bf16(v1[2], v1[3]);
                    *(u32x4*)(rowp + bj * HALF) = w;
                    if (t < 2) { float ss = (v0[0] * v0[0] + v0[1] * v0[1]) + (v0[2] * v0[2] + v0[3] * v0[3]) + (v1[0] * v1[0] + v1[1] * v1[1]) + (v1[2] * v1[2] + v1[3] * v1[3]);
                        ss += __shfl_xor(ss, 16); ss += __shfl_xor(ss, 32); mx[bj] = __builtin_fmaxf(mx[bj], ss); } } }
        if (t < 2) {
#pragma unroll
            for (int bj = 0; bj < 2; ++bj) { float v = mx[bj];
                v = __builtin_fmaxf(v, __shfl_xor(v, 1)); v = __builtin_fmaxf(v, __shfl_xor(v, 2)); v = __builtin_fmaxf(v, __shfl_xor(v, 4)); v = __builtin_fmaxf(v, __shfl_xor(v, 8));
                const int colb = (u.pn & 3) * BM + bj * HALF + wc * 32, g64 = colb >> 6, bh = (u.pm >> 4) * 8 + (g64 >> 1);
                if (fr == 0 && fq == 0) atomicMax(nmax + ((t * 64 + bh) * 2 + (g64 & 1)) * 2 + (wc & 1), __builtin_bit_cast(unsigned, v)); }
        }
    }
};
struct EpiGLU {
    static constexpr bool PERM = true, AFTER_DRAIN = false;
    bf16_t* U; const float* rstd; float oscale;
    __device__ __forceinline__ void operator()(const f32x4 (&acc)[2][2][4][2], const Unit& u, int wr, int wc, int fr, int fq) const {
        const int row0 = u.pm * BM + wr * 64 + fr, col0 = u.pn * HALF + wc * 32 + 8 * fq; float rsv[2][4];
#pragma unroll
        for (int ai = 0; ai < 2; ++ai)
#pragma unroll
            for (int m = 0; m < 4; ++m) rsv[ai][m] = rstd[row0 + ai * HALF + m * 16];
#pragma unroll
        for (int ai = 0; ai < 2; ++ai)
#pragma unroll
            for (int m = 0; m < 4; ++m) { const int row = row0 + ai * HALF + m * 16; const float rs = rsv[ai][m] * oscale;
                const f32x4 a0 = acc[ai][0][m][0] * rs, a1 = acc[ai][0][m][1] * rs, g0 = acc[ai][1][m][0] * rs, g1 = acc[ai][1][m][1] * rs;
#define PG8_SG(x) __builtin_amdgcn_rcpf(1.f + __builtin_amdgcn_exp2f(-1.4426950408889634f * (x)))
                u32x4 w; w.x = cvt_pk_bf16(a0[0] * PG8_SG(g0[0]), a0[1] * PG8_SG(g0[1])); w.y = cvt_pk_bf16(a0[2] * PG8_SG(g0[2]), a0[3] * PG8_SG(g0[3]));
                w.z = cvt_pk_bf16(a1[0] * PG8_SG(g1[0]), a1[1] * PG8_SG(g1[1])); w.w = cvt_pk_bf16(a1[2] * PG8_SG(g1[2]), a1[3] * PG8_SG(g1[3]));
#undef PG8_SG
                *(u32x4*)(U + (size_t)row * 1024 + col0) = w; }
    }
};
struct EpiOut {
    static constexpr bool PERM = true, AFTER_DRAIN = false;
    bf16_t* H; const bf16_t* XB; float* part; unsigned char* H8;
    __device__ __forceinline__ void operator()(const f32x4 (&acc)[2][2][4][2], const Unit& u, int wr, int wc, int fr, int fq) const {
        const int row0 = u.pm * BM + wr * 64 + fr, col0 = u.pn * BM + wc * 32 + 8 * fq;
#pragma unroll
        for (int ai = 0; ai < 2; ++ai) { u32x4 xbv[4][2];
#pragma unroll
            for (int m = 0; m < 4; ++m)
#pragma unroll
                for (int bj = 0; bj < 2; ++bj) xbv[m][bj] = *(const u32x4*)(XB + (size_t)(row0 + ai * HALF + m * 16) * 2048 + col0 + bj * HALF);
#pragma unroll
            for (int m = 0; m < 4; ++m) { const int row = row0 + ai * HALF + m * 16; const size_t off = (size_t)row * 2048 + col0; float ss = 0.f;
#pragma unroll
                for (int bj = 0; bj < 2; ++bj) { const u32x4 xb = xbv[m][bj];
                    f32x4 v0 = acc[ai][bj][m][0], v1 = acc[ai][bj][m][1];
                    v0[0] += bf_lo(xb.x); v0[1] += bf_hi(xb.x); v0[2] += bf_lo(xb.y); v0[3] += bf_hi(xb.y); v1[0] += bf_lo(xb.z); v1[1] += bf_hi(xb.z); v1[2] += bf_lo(xb.w); v1[3] += bf_hi(xb.w);
                    ss += (v0[0] * v0[0] + v0[1] * v0[1]) + (v0[2] * v0[2] + v0[3] * v0[3]) + (v1[0] * v1[0] + v1[1] * v1[1]) + (v1[2] * v1[2] + v1[3] * v1[3]);
                    u32x4 w; w.x = cvt_pk_bf16(v0[0], v0[1]); w.y = cvt_pk_bf16(v0[2], v0[3]); w.z = cvt_pk_bf16(v1[0], v1[1]); w.w = cvt_pk_bf16(v1[2], v1[3]);
                    *(u32x4*)(H + off + bj * HALF) = w;
                    if (H8) { u32x2 w8; w8.x = pk4_fp8(v0[0], v0[1], v0[2], v0[3]); w8.y = pk4_fp8(v1[0], v1[1], v1[2], v1[3]); *(u32x2*)(H8 + off + bj * HALF) = w8; } }
                ss += __shfl_xor(ss, 16); ss += __shfl_xor(ss, 32);
                if (fq == 0) part[(size_t)row * 32 + u.pn * 4 + wc] = ss; } }
    }
};
__device__ __forceinline__ float silu_f(float x) { return x * __builtin_amdgcn_rcpf(1.f + __builtin_amdgcn_exp2f(-1.4426950408889634f * x)); }
struct EpiGU {
    static constexpr bool PERM = true, AFTER_DRAIN = false;
    unsigned char* H1; const int* list; const float* listr; float wscale, oscale;
    __device__ __forceinline__ void operator()(const f32x4 (&acc)[2][2][4][2], const Unit& u, int wr, int wc, int fr, int fq) const {
        const int col0 = u.pn * HALF + wc * 32 + 8 * fq;
        float rsv[2][4];
#pragma unroll
        for (int ai = 0; ai < 2; ++ai)
#pragma unroll
            for (int m = 0; m < 4; ++m) { const int r = ai * HALF + wr * 64 + m * 16 + fr; rsv[ai][m] = listr[u.lbase + (r < u.nvalid ? r : 0)]; }
#pragma unroll
        for (int ai = 0; ai < 2; ++ai)
#pragma unroll
            for (int mp = 0; mp < 4; mp += 2) { u32x2 wv[2];
#pragma unroll
                for (int q = 0; q < 2; ++q) { const int m = mp + q; const float rs = rsv[ai][m] * wscale;
                    const f32x4 g0 = acc[ai][0][m][0] * rs, g1 = acc[ai][0][m][1] * rs, u0 = acc[ai][1][m][0] * (rs * oscale), u1 = acc[ai][1][m][1] * (rs * oscale);
                    wv[q].x = pk4_fp8(silu_f(g0[0]) * u0[0], silu_f(g0[1]) * u0[1], silu_f(g0[2]) * u0[2], silu_f(g0[3]) * u0[3]);
                    wv[q].y = pk4_fp8(silu_f(g1[0]) * u1[0], silu_f(g1[1]) * u1[1], silu_f(g1[2]) * u1[2], silu_f(g1[3]) * u1[3]); }
                swap16(wv[0], wv[1]);
                const int odd = fq & 1, r = ai * HALF + wr * 64 + (mp + odd) * 16 + fr;
                if (r < u.nvalid) { const u32x4 w = {wv[0].x, wv[0].y, wv[1].x, wv[1].y};
                    *(u32x4*)(H1 + (size_t)(u.srow + r) * 1024 + col0 - 8 * odd) = w; } }
    }
};
struct EpiDown {
    static constexpr bool PERM = true, AFTER_DRAIN = false;
    unsigned char* Y; const int* list; const float* listw; float oscale;
    __device__ __forceinline__ void operator()(const f32x4 (&acc)[2][2][4][2], const Unit& u, int wr, int wc, int fr, int fq) const {
        const int col0 = u.pn * BM + wc * 32 + 8 * fq;
        int av[2][4]; float wv[2][4];
#pragma unroll
        for (int ai = 0; ai < 2; ++ai)
#pragma unroll
            for (int m = 0; m < 4; ++m) { const int r = ai * HALF + wr * 64 + m * 16 + fr, ix = u.lbase + (r < u.nvalid ? r : 0); av[ai][m] = list[ix]; wv[ai][m] = listw[ix]; }
#pragma unroll
        for (int ai = 0; ai < 2; ++ai)
#pragma unroll
            for (int m = 0; m < 4; ++m) { const int r = ai * HALF + wr * 64 + m * 16 + fr; const int a = av[ai][m]; const float ws = wv[ai][m] * oscale;
                u32x2 w0, w1;
                { const f32x4 v0 = acc[ai][0][m][0] * ws, v1 = acc[ai][0][m][1] * ws; w0.x = pk4_fp8(v0[0], v0[1], v0[2], v0[3]); w0.y = pk4_fp8(v1[0], v1[1], v1[2], v1[3]); }
                { const f32x4 v0 = acc[ai][1][m][0] * ws, v1 = acc[ai][1][m][1] * ws; w1.x = pk4_fp8(v0[0], v0[1], v0[2], v0[3]); w1.y = pk4_fp8(v1[0], v1[1], v1[2], v1[3]); }
                swap16(w0, w1);
                if (r < u.nvalid) { const int odd = fq & 1; const u32x4 w = {w0.x, w0.y, w1.x, w1.y};
                    *(u32x4*)(Y + (size_t)a * 2048 + col0 + (odd ? HALF - 8 : 0)) = w; } }
    }
};
struct EpiRouter {
    static constexpr bool PERM = true, AFTER_DRAIN = false;
    const float* part; const float* ber; const float* bgr; float* listr; float* listw; int* list; unsigned* cnt; int lcap;
    __device__ __forceinline__ void operator()(const f32x4 (&acc)[2][2][4][2], const Unit& u, int wr, int wc, int fr, int fq) const {
        if (wc != 0) return;
#pragma unroll
        for (int ai = 0; ai < 2; ++ai)
#pragma unroll
            for (int m = 0; m < 4; ++m) { const int row = u.pm * BM + ai * HALF + wr * 64 + m * 16 + fr;
                const f32x4 p0 = *(const f32x4*)(part + (size_t)row * 32 + 8 * fq), p1 = *(const f32x4*)(part + (size_t)row * 32 + 8 * fq + 4);
                float ss = ((p0[0] + p0[1]) + (p0[2] + p0[3])) + ((p1[0] + p1[1]) + (p1[2] + p1[3]));
                ss += __shfl_xor(ss, 16); ss += __shfl_xor(ss, 32);
                const float rstd = 1.0f / sqrtf(ss * (1.0f / 2048.0f) + 1e-6f);
                const f32x4 gl = acc[ai][1][m][0]; float g[4];
#pragma unroll
                for (int i = 0; i < 4; ++i) g[i] = __shfl(gl[i], fr) * rstd + bgr[i];
                int gs = 0; float gm = g[0];
#pragma unroll
                for (int i = 1; i < 4; ++i) if (g[i] > gm) { gm = g[i]; gs = i; }
                float gsum = 0.f;
#pragma unroll
                for (int i = 0; i < 4; ++i) gsum += __expf(g[i] - gm);
                const float gw = 1.0f / gsum;
                if (fq == gs) { float ev[8];
#pragma unroll
                    for (int i = 0; i < 4; ++i) { ev[i] = acc[ai][0][m][0][i] * rstd + ber[8 * fq + i]; ev[4 + i] = acc[ai][0][m][1][i] * rstd + ber[8 * fq + 4 + i]; }
                    int i1 = 0; float v1 = ev[0];
#pragma unroll
                    for (int i = 1; i < 8; ++i) if (ev[i] > v1) { v1 = ev[i]; i1 = i; }
                    int i2 = -1; float v2 = -3.0e38f;
#pragma unroll
                    for (int i = 0; i < 8; ++i) if (i != i1 && ev[i] > v2) { v2 = ev[i]; i2 = i; }
                    const float e2 = __expf(v2 - v1), w1 = gw / (1.f + e2), w2 = gw * e2 / (1.f + e2);
                    const int ea = gs * 8 + i1, eb = gs * 8 + i2;
                    const unsigned ra = __hip_atomic_fetch_add(cnt + 64 * ea, 1u, __ATOMIC_RELAXED, __HIP_MEMORY_SCOPE_AGENT);
                    const unsigned rb = __hip_atomic_fetch_add(cnt + 64 * eb, 1u, __ATOMIC_RELAXED, __HIP_MEMORY_SCOPE_AGENT);
                    const size_t ia = (size_t)ea * lcap + ra, ib = (size_t)eb * lcap + rb;
                    list[ia] = 2 * row; list[ib] = 2 * row + 1; listw[ia] = w1; listw[ib] = w2; listr[ia] = rstd; listr[ib] = rstd; } }
    }
};

template <class Epi, class Sched, bool ALIGN_EPI, bool GATHER, bool FP8 = false>
__device__ __forceinline__ void gemm_phase(PG8_LAS unsigned char* lds, const Gemm g, Sched& S, const Epi& E) {
    int tid_ = threadIdx.x; asm volatile("" : "+v"(tid_));
    const int tid = tid_, wid = __builtin_amdgcn_readfirstlane(tid >> 6), lane = tid & 63, wr = wid >> 2, wc = wid & 3, fr = lane & 15, fq = lane >> 4;
    const int K = g.K, nt = K / BK;
    unsigned voffA[2], voffB[2]; int RA[2], CA[2];
#pragma unroll
    for (int i = 0; i < 2; ++i) { int R, C; stage_rc(tid * 16 + i * 8192, R, C); const int Rb = Epi::PERM ? ((R & ~31) + perm32(R & 31)) : R;
        voffA[i] = (unsigned)(R * K + C) * 2u; voffB[i] = (unsigned)(Rb * K + C) * 2u; RA[i] = R; CA[i] = C; }
    const size_t kstep = (size_t)(BK * 2);
    const size_t hstep = (size_t)HALF * K * 2;
    const size_t tstep = 2 * hstep;
    const unsigned ldsw = (unsigned)wid * 1024u;
    const int aoff = lds_byte(wr * 64 + fr, fq * 8), boff = lds_byte(wc * 32 + fr, fq * 8);
#define PG8_SA(b, h) (((b) * 2 + (h)) * HTB)
#define PG8_SB(b, h) ((4 + (b) * 2 + (h)) * HTB)
#define PG8_STAGE(bufoff, gbase, voff) do { _Pragma("unroll") for (int _i = 0; _i < 2; ++_i) \
        __builtin_amdgcn_global_load_lds((const unsigned*)((const char*)(gbase) + (voff)[_i]), (PG8_LAS unsigned*)(lds + (bufoff) + ldsw + _i * 8192), 16, 0, 0); } while (0)
#define PG8_STAGE_A(bufoff, kp, h) do { if constexpr (GATHER) { PG8_STAGE(bufoff, kp, cgo[h]); } else { PG8_STAGE(bufoff, (kp) + (h) * hstep, voffA); } } while (0)
#define PG8_LDA(dst, b, h) do { _Pragma("unroll") for (int m = 0; m < 4; ++m) _Pragma("unroll") for (int k = 0; k < 2; ++k) dst[m][k] = *(const PG8_LAS bf16x8*)(lds + PG8_SA(b, h) + aoff + m * 2048 + k * 1024); } while (0)
#define PG8_LDB(dst, b, h) do { _Pragma("unroll") for (int n = 0; n < 2; ++n) _Pragma("unroll") for (int k = 0; k < 2; ++k) dst[n][k] = *(const PG8_LAS bf16x8*)(lds + PG8_SB(b, h) + boff + n * 2048 + k * 1024); } while (0)
#define PG8_CAT(x, y) __builtin_shufflevector(__builtin_bit_cast(v4i_t, x), __builtin_bit_cast(v4i_t, y), 0, 1, 2, 3, 4, 5, 6, 7)
#define PG8_MMA(ai, bj, At, Bt) do { __builtin_amdgcn_s_setprio(1); \
        if constexpr (FP8) { _Pragma("unroll") for (int m = 0; m < 4; ++m) _Pragma("unroll") for (int n = 0; n < 2; ++n) \
            acc[ai][bj][m][n] = __builtin_amdgcn_mfma_scale_f32_16x16x128_f8f6f4(PG8_CAT(Bt[n][0], Bt[n][1]), PG8_CAT(At[m][0], At[m][1]), acc[ai][bj][m][n], 0, 0, 0, 0, 0, 0); } \
        else { _Pragma("unroll") for (int m = 0; m < 4; ++m) _Pragma("unroll") for (int n = 0; n < 2; ++n) _Pragma("unroll") for (int k = 0; k < 2; ++k) \
            acc[ai][bj][m][n] = __builtin_amdgcn_mfma_f32_16x16x32_bf16(Bt[n][k], At[m][k], acc[ai][bj][m][n], 0, 0, 0); } \
        __builtin_amdgcn_s_setprio(0); } while (0)
#define PG8_WAIT_V(n) asm volatile("s_waitcnt vmcnt(" #n ")" ::: "memory")
#define PG8_WAIT_L(n) asm volatile("s_waitcnt lgkmcnt(" #n ")" ::: "memory")
#define PG8_BAR __builtin_amdgcn_s_barrier()
#define PG8_SCHED __builtin_amdgcn_sched_barrier(0)
    Unit cur, nxt; int ui = 0;
#if PROBE_KLOOP
    unsigned pk_acc_ = 0u;
#endif
    if (!S.next(0, cur)) return;
    f32x4 acc[2][2][4][2];
#pragma unroll
    for (int a = 0; a < 2; ++a)
#pragma unroll
        for (int b = 0; b < 2; ++b)
#pragma unroll
            for (int m = 0; m < 4; ++m)
#pragma unroll
                for (int n = 0; n < 2; ++n) acc[a][b][m][n] = (f32x4){0.f, 0.f, 0.f, 0.f};
    bf16x8 At[4][2], B0[2][2], B1[2][2];
    unsigned cgo[2][2] = {{0u, 0u}, {0u, 0u}}, ngo[2][2] = {{0u, 0u}, {0u, 0u}};
    if constexpr (GATHER) {
#pragma unroll
        for (int h = 0; h < 2; ++h)
#pragma unroll
            for (int i = 0; i < 2; ++i) cgo[h][i] = S.goff(cur, h * HALF + RA[i], CA[i], K);
    }
    const char* cA = GATHER ? (const char*)g.A : (const char*)g.A + (size_t)cur.pm * tstep; const char* cB = S.bbase(g, cur, tstep);
    S.a_ready(cur);
    PG8_STAGE(PG8_SB(0, 0), cB, voffB); PG8_STAGE(PG8_SB(0, 1), cB + hstep, voffB); PG8_STAGE_A(PG8_SA(0, 0), cA, 0); PG8_STAGE_A(PG8_SA(0, 1), cA, 1);
    if (wr == 1) PG8_BAR;
    PG8_WAIT_V(2); PG8_BAR;
    PG8_STAGE(PG8_SB(1, 0), cB + kstep, voffB); PG8_STAGE_A(PG8_SA(1, 0), cA + kstep, 0); PG8_STAGE(PG8_SB(1, 1), cB + hstep + kstep, voffB);
    PG8_WAIT_V(6); PG8_BAR;
    for (;;) {
        const bool has_next = S.next(ui + 1, nxt);
        if constexpr (GATHER) {
            if (has_next) {
#pragma unroll
                for (int h = 0; h < 2; ++h)
#pragma unroll
                    for (int i = 0; i < 2; ++i) ngo[h][i] = S.goff(nxt, h * HALF + RA[i], CA[i], K);
            } else {
#pragma unroll
                for (int h = 0; h < 2; ++h)
#pragma unroll
                    for (int i = 0; i < 2; ++i) ngo[h][i] = cgo[h][i];
            }
        }
        const char* nA = GATHER ? (const char*)g.A : (has_next ? (const char*)g.A + (size_t)nxt.pm * tstep : cA); const char* nB = has_next ? S.bbase(g, nxt, tstep) : cB;
#if PROBE_KLOOP
        const unsigned long long pk0_ = __builtin_amdgcn_s_memrealtime();
#endif
        for (int t = 0; t < nt; t += 2) {
            const bool last = (t == nt - 2);
            const char* a1 = cA + (size_t)(t + 1) * kstep;
            const char* a2 = last ? nA : cA + (size_t)(t + 2) * kstep; const char* b2 = last ? nB : cB + (size_t)(t + 2) * kstep;
            const char* a3 = a2 + kstep; const char* b3 = b2 + kstep;
            if (last && has_next) S.a_ready(nxt);
            PG8_LDB(B0, 0, 0); PG8_LDB(B1, 0, 1); PG8_SCHED; PG8_LDA(At, 0, 0); PG8_STAGE_A(PG8_SA(1, 1), a1, 1);
            if constexpr (GATHER) { if (last) {
#pragma unroll
                for (int h = 0; h < 2; ++h)
#pragma unroll
                    for (int i = 0; i < 2; ++i) cgo[h][i] = ngo[h][i]; } }
            PG8_WAIT_V(8); PG8_WAIT_L(0); PG8_BAR; PG8_MMA(0, 0, At, B0); PG8_MMA(0, 1, At, B1); PG8_BAR; PG8_SCHED;
            PG8_LDA(At, 0, 1); PG8_STAGE(PG8_SB(0, 0), b2, voffB); PG8_STAGE(PG8_SB(0, 1), b2 + hstep, voffB); PG8_STAGE_A(PG8_SA(0, 0), a2, 0);
            PG8_WAIT_V(8); PG8_WAIT_L(0); PG8_BAR; PG8_MMA(1, 0, At, B0); PG8_MMA(1, 1, At, B1); PG8_BAR; PG8_SCHED;
            PG8_LDB(B0, 1, 0); PG8_LDB(B1, 1, 1); PG8_SCHED; PG8_LDA(At, 1, 0); PG8_STAGE_A(PG8_SA(0, 1), a2, 1);
            PG8_WAIT_V(8); PG8_WAIT_L(0); PG8_BAR; PG8_MMA(0, 0, At, B0); PG8_MMA(0, 1, At, B1); PG8_BAR; PG8_SCHED;
            PG8_LDA(At, 1, 1); PG8_STAGE(PG8_SB(1, 0), b3, voffB); PG8_STAGE(PG8_SB(1, 1), b3 + hstep, voffB); PG8_STAGE_A(PG8_SA(1, 0), a3, 0);
            PG8_WAIT_V(8); PG8_WAIT_L(0); PG8_BAR; PG8_MMA(1, 0, At, B0); PG8_MMA(1, 1, At, B1); PG8_BAR; PG8_SCHED;
        }
#if PROBE_KLOOP
        const unsigned long long pk1_ = __builtin_amdgcn_s_memrealtime(); if (PROBE_WHAT == 0) pk_acc_ += (unsigned)(pk1_ - pk0_);
#endif
        if constexpr (ALIGN_EPI) { if (wr == 0) PG8_BAR; }
#if PROBE_KLOOP
        const unsigned long long pk2_ = __builtin_amdgcn_s_memrealtime(); if (PROBE_WHAT == 1) pk_acc_ += (unsigned)(pk2_ - pk1_);
#endif
        E(acc, cur, wr, wc, fr, fq); S.done(cur);
#if PROBE_KLOOP
        asm volatile("s_waitcnt vmcnt(0)" ::: "memory"); if (PROBE_WHAT == 2) pk_acc_ += (unsigned)(__builtin_amdgcn_s_memrealtime() - pk2_);
#endif
        if (!has_next) break;
#pragma unroll
        for (int a = 0; a < 2; ++a)
#pragma unroll
            for (int b = 0; b < 2; ++b)
#pragma unroll
                for (int m = 0; m < 4; ++m)
#pragma unroll
                    for (int n = 0; n < 2; ++n) acc[a][b][m][n] = (f32x4){0.f, 0.f, 0.f, 0.f};
        cur = nxt; cA = nA; cB = nB; ++ui;
        if constexpr (ALIGN_EPI) { if (wr == 1) PG8_BAR; }
    }
#if PROBE_KLOOP
    if (blockIdx.x == PROBE_BLK && tid == 0 && g.M == PROBE_KLOOP) atomicAdd(g.probe, pk_acc_);
#endif
    PG8_WAIT_V(0);
    if constexpr (!ALIGN_EPI) { if (wr == 0) PG8_BAR; }
    PG8_BAR;
#undef PG8_SA
#undef PG8_SB
#undef PG8_STAGE
#undef PG8_STAGE_A
#undef PG8_LDA
#undef PG8_LDB
#undef PG8_MMA
#undef PG8_CAT
#undef PG8_WAIT_V
#undef PG8_WAIT_L
#undef PG8_BAR
#undef PG8_SCHED
}
}
#include <hip/hip_bf16.h>
#include <cmath>
namespace attn_body {
using bf16=__hip_bfloat16;
using bf16x8=__attribute__((ext_vector_type(8)))short;
using s16x4=__attribute__((ext_vector_type(4)))short;
using f32x16=__attribute__((ext_vector_type(16)))float;
using u32x4=__attribute__((ext_vector_type(4)))unsigned;
constexpr int BATCH=8,SEQ=4096,D=64,DM=1024;
constexpr int NW=8,QBLK=32,QB=QBLK*NW,KVBLK=64,NQB=SEQ/QB;
__device__ __forceinline__ int crow(int r,int hi){return (r&3)+8*(r>>2)+4*hi;}
#define SBAR() __builtin_amdgcn_sched_barrier(0)
__device__ __forceinline__ void cmask(f32x16&p0,f32x16&p1,int jb,int qrel,int hi){
  const float NEG=-INFINITY; const int lim=qrel-64*jb-4*hi;
  #pragma unroll
  for(int r=0;r<16;++r){const int cr=(r&3)+8*(r>>2); if(cr>lim)p0[r]=NEG; if(cr+32>lim)p1[r]=NEG;}
}

constexpr int NSLOT=3, SLOTB=8192;
constexpr int LDS_K=0, LDS_V=NSLOT*SLOTB, LDS_WS=3*NSLOT*SLOTB, LDS_OST=LDS_WS+NW*64*4, LDS_BYTES=LDS_OST+NW*4096;
__device__ __forceinline__ void glds16(const void*sbase,unsigned voff,unsigned lds_dst){unsigned keep;
  asm volatile("s_mov_b32 %0, m0\n\ts_mov_b32 m0, %3\n\ts_nop 0\n\tglobal_load_lds_dwordx4 %1, %2\n\ts_mov_b32 m0, %0":"=&s"(keep):"v"(voff),"s"(sbase),"s"(lds_dst):"memory");}
__device__ __forceinline__ float max3f(float a,float b,float c){float r;asm("v_max3_f32 %0, %1, %2, %3":"=v"(r):"v"(a),"v"(b),"v"(c));return r;}
__device__ __forceinline__ float max2f(float a,float b){float r;asm("v_max_f32_e32 %0, %1, %2":"=v"(r):"v"(a),"v"(b));return r;}
__device__ __forceinline__ float fsub_s(float a,float b){float r;asm("v_sub_f32_e32 %0, %1, %2":"=v"(r):"v"(a),"v"(b));return r;}
typedef float f32x2_t __attribute__((ext_vector_type(2))); typedef __bf16 bf16x2_t __attribute__((ext_vector_type(2)));
__device__ __forceinline__ unsigned cvtpk_s(float lo,float hi){f32x2_t v={lo,hi};bf16x2_t b=__builtin_convertvector(v,bf16x2_t);return __builtin_bit_cast(unsigned,b);}
#define WAIT_BAR(N) asm volatile("s_waitcnt vmcnt(" #N ") lgkmcnt(0)\n\ts_barrier":::"memory")
#define MFMA32(a,b,c) __builtin_amdgcn_mfma_f32_32x32x16_bf16(a,b,c,0,0,0)

__device__ __forceinline__ void qkt(f32x16&p0,f32x16&p1,const char*Kslot,const bf16x8*qr,int r32,int hi){
  const char*kb=Kslot+hi*1024+r32*16;
  #pragma unroll
  for(int d0=0;d0<4;++d0){
    const bf16x8 b0=*reinterpret_cast<const bf16x8*>(kb+d0*2048);
    const bf16x8 b1=*reinterpret_cast<const bf16x8*>(kb+d0*2048+512);
    p0=MFMA32(b0,qr[d0],p0);p1=MFMA32(b1,qr[d0],p1);}
}
typedef __attribute__((address_space(3))) const char* lds_cptr;
typedef short v4i16_t __attribute__((ext_vector_type(4)));
__device__ __forceinline__ void kload8(bf16x8*kf,lds_cptr kp){
  kf[0]=*(const __attribute__((address_space(3))) bf16x8*)(kp);      kf[1]=*(const __attribute__((address_space(3))) bf16x8*)(kp+512);
  kf[2]=*(const __attribute__((address_space(3))) bf16x8*)(kp+2048); kf[3]=*(const __attribute__((address_space(3))) bf16x8*)(kp+2560);
  kf[4]=*(const __attribute__((address_space(3))) bf16x8*)(kp+4096); kf[5]=*(const __attribute__((address_space(3))) bf16x8*)(kp+4608);
  kf[6]=*(const __attribute__((address_space(3))) bf16x8*)(kp+6144); kf[7]=*(const __attribute__((address_space(3))) bf16x8*)(kp+6656);
}
__device__ __forceinline__ void kload2(bf16x8*kf,lds_cptr kp,int j){ kf[2*j]=*(const __attribute__((address_space(3))) bf16x8*)(kp+j*2048); kf[2*j+1]=*(const __attribute__((address_space(3))) bf16x8*)(kp+j*2048+512); }
__device__ __forceinline__ s16x4 vtr(lds_cptr p){ return __builtin_bit_cast(s16x4,__builtin_amdgcn_ds_read_tr16_b64_v4i16((__attribute__((address_space(3))) v4i16_t*)p)); }
__device__ __forceinline__ float rowmax(const f32x16&p0,const f32x16&p1){
  float a=max3f(p0[0],p0[1],p1[0]),b=max3f(p0[2],p0[3],p1[1]);a=max3f(a,p1[2],p1[3]);
  #pragma unroll
  for(int r=4;r<16;r+=4){a=max3f(a,p0[r],p0[r+1]);b=max3f(b,p0[r+2],p0[r+3]);a=max3f(a,p1[r],p1[r+1]);b=max3f(b,p1[r+2],p1[r+3]);}
  const float m=max2f(a,b);
  auto rr=__builtin_amdgcn_permlane32_swap(__float_as_uint(m),__float_as_uint(m),false,false);
  return max2f(__uint_as_float(rr[0]),__uint_as_float(rr[1]));
}
__device__ __forceinline__ void pv(f32x16*o,int vb,bf16x8 pa0,bf16x8 pa1,bf16x8 pa2,bf16x8 pa3){
  #pragma unroll
  for(int d0=0;d0<4;++d0){s16x4 lo[4],hi[4];
    #pragma unroll
    for(int ks=0;ks<4;++ks){
      asm volatile("ds_read_b64_tr_b16 %0,%1 offset:%c2":"=&v"(lo[ks]):"v"(vb),"i"(d0*4096+ks*1024):"memory");
      asm volatile("ds_read_b64_tr_b16 %0,%1 offset:%c2":"=&v"(hi[ks]):"v"(vb),"i"(d0*4096+ks*1024+512):"memory");}
    asm volatile("s_waitcnt lgkmcnt(0)":::"memory");SBAR();
    #define PK(k) (bf16x8){lo[k][0],lo[k][1],lo[k][2],lo[k][3],hi[k][0],hi[k][1],hi[k][2],hi[k][3]}
    o[d0]=MFMA32(pa0,PK(0),o[d0]);
    o[d0]=MFMA32(pa1,PK(1),o[d0]);
    o[d0]=MFMA32(pa2,PK(2),o[d0]);
    o[d0]=MFMA32(pa3,PK(3),o[d0]);
    #undef PK
  }
}

template<int THRL> __device__ __forceinline__ void attn_sub(int b,int qkcol,int vcol,int qb,int cmap,float sl2,float lam,int ntcap,float Ub,float oscale,const float*subg,unsigned*o1s,bf16*MIXh,const bf16*Q,const bf16*__restrict__ K,const bf16*__restrict__ V,char*shm,unsigned*pw_){
#if PROBE_ATT >= 3
  const unsigned long long ps0_=__builtin_amdgcn_s_memrealtime();
#endif
  const int tid=threadIdx.x,lane=tid&63,r32=lane&31,hi=lane>>5; const int wid=__builtin_amdgcn_readfirstlane(tid>>6);
  const long rowbase=(long)b*SEQ; const int q0=qb*QB;
  const bf16*Qw=Q+(rowbase+q0+wid*QBLK)*DM+qkcol;
  const bf16*Kh=K+rowbase*DM+qkcol,*Vh=V+rowbase*DM+vcol;
  const unsigned lds0=(unsigned)(uintptr_t)shm;
  float*wsf=(float*)(shm+LDS_WS)+wid*64;
  const unsigned koff=(unsigned)(lane*DM+wid*8)*2u, voffv=(unsigned)((16*(wid&3)+(lane>>2))*DM+(wid>>2)*32+(lane&3)*8)*2u;
  const unsigned kdst=lds0+LDS_K+wid*1024, vdst=lds0+LDS_V+wid*1024;
  const int NTR=(q0+QB)/KVBLK;
  int NT=NTR<ntcap?NTR:ntcap;
  #define DMA_K(t,slot) glds16(Kh+(long)(NTR-1-(t))*KVBLK*DM,koff,(unsigned)__builtin_amdgcn_readfirstlane(kdst+(slot)))
  #define DMA_V(t,slot) do{ glds16(Vh+(long)(NTR-1-(t))*KVBLK*DM,voffv,(unsigned)__builtin_amdgcn_readfirstlane(vdst+2*(slot))); glds16(Vh+(long)(NTR-1-(t))*KVBLK*DM+64,voffv,(unsigned)__builtin_amdgcn_readfirstlane(vdst+2*(slot)+8192)); }while(0)
  const char*Kbase=shm+LDS_K; bf16x8 kf[8];
  const lds_cptr shm3=(lds_cptr)shm; const lds_cptr kp0=shm3+LDS_K+hi*1024+r32*16; const lds_cptr vp0=shm3+LDS_V+((lane>>4)&1)*32+(lane&3)*8+(4*hi+((lane&15)>>2))*64;
  #define vb0 ((int)(unsigned)(uintptr_t)vp0)
  DMA_K(0,0);DMA_V(0,0);DMA_K(1,SLOTB);
  bf16x8 qr[4];
  #pragma unroll
  for(int d0=0;d0<4;++d0)qr[d0]=*reinterpret_cast<const bf16x8*>(&Qw[(long)r32*DM+d0*16+hi*8]);
  const int qrel=wid*QBLK+r32;
  const unsigned lm=hi?0u:0xffffffffu;
  const int qw0=wid*QBLK;
  unsigned bbx; { const unsigned sh=__float_as_uint(sl2)&0xffff0000u; const float sr=sl2-__uint_as_float(sh); bbx=((sh>>16)|(cvtpk_s(sr,0.f)<<16))&lm; }
  const float dlt=64.f*sl2;
  float cref=sl2*(float)(192-qrel);
  #define BIAS2(C0,C1,t) do{ const float c_=__builtin_fmaf(-dlt,(float)(t),cref); const unsigned h_=__float_as_uint(c_)&0xffff0000u; const float r1_=c_-__uint_as_float(h_); \
      const unsigned m_=__float_as_uint(r1_)&0xffff0000u; const float r2_=r1_-__uint_as_float(m_); \
      int q_=qrel; asm volatile("":"+v"(q_)); const float rf_=(float)(q_-qw0); \
      u32x4 b_=(u32x4){bbx,((h_>>16)|m_)&lm,(__float_as_uint(r2_)>>16)&lm,0u}; u32x4 a_=(u32x4){cvtpk_s(rf_,rf_),0x3F803F80u,0x00003F80u,0u}; asm volatile("":"+v"(a_),"+v"(b_)); \
      const f32x16 z_=f32x16{}; C0=MFMA32(__builtin_bit_cast(bf16x8,a_),__builtin_bit_cast(bf16x8,b_),z_); \
      a_.x=cvtpk_s(rf_+32.f,rf_+32.f); asm volatile("":"+v"(a_)); C1=MFMA32(__builtin_bit_cast(bf16x8,a_),__builtin_bit_cast(bf16x8,b_),z_); }while(0)
  float l_reg=0.f;f32x16 o[4];o[0]=f32x16{};o[1]=f32x16{};o[2]=f32x16{};o[3]=f32x16{};
  #define CMASK(P0,P1,t) do{int jb_=3-(t); if(jb_>=0)cmask(P0,P1,jb_,qrel,hi);}while(0)
  bool resc=false;
  #define START(P0,P1) do{ const float rm=rowmax(P0,P1); resc=false; \
    if(__any(rm>(float)THRL)){ const float dl=max2f(rm,0.f); cref=fsub_s(cref,dl); \
      _Pragma("unroll") for(int r=0;r<16;++r){P0[r]=fsub_s(P0[r],dl);P1[r]=fsub_s(P1[r],dl);} } \
    _Pragma("unroll") for(int r=0;r<16;++r)P0[r]=__builtin_amdgcn_exp2f(P0[r]); }while(0)
  #define RESC() do{ if(resc){ asm volatile("s_waitcnt lgkmcnt(0)":::"memory"); \
      _Pragma("unroll") for(int d_=0;d_<4;++d_) _Pragma("unroll") for(int r=0;r<16;++r)o[d_][r]*=wsf[crow(r,hi)]; } }while(0)
  f32x16 pA0,pA1,pB0,pB1;
  int sl_prev=0,sl_cur=0,sl_next=SLOTB;
  #define ROT() do{sl_prev=sl_cur;sl_cur=sl_next;sl_next=(sl_next==(NSLOT-1)*SLOTB)?0:sl_next+SLOTB;}while(0)
  DMA_K(2,2*SLOTB);
  WAIT_BAR(3);
  BIAS2(pA0,pA1,0);
  qkt(pA0,pA1,Kbase,qr,r32,hi);asm volatile("s_nop 15\n\ts_nop 7":"+v"(pA0),"+v"(pA1));CMASK(pA0,pA1,0);
  START(pA0,pA1);
  _Pragma("unroll") for(int r=0;r<16;++r)pA1[r]=__builtin_amdgcn_exp2f(pA1[r]);
  WAIT_BAR(0);
  DMA_K(3,0);DMA_V(1,SLOTB);
  ROT();
  kload8(kf,kp0+sl_cur);
  WAIT_BAR(3);
  s16x4 vlo[8],vhi[8]; u32x4 pw0,pw1,pw2,pw3;
  #define PKW(P,B) cvtpk_s(P[B],P[B+1])
  #define PAF(k) __builtin_bit_cast(bf16x8,pw##k)
  #define VFR(i) (bf16x8){vlo[i][0],vlo[i][1],vlo[i][2],vlo[i][3],vhi[i][0],vhi[i][1],vhi[i][2],vhi[i][3]}
  #define PIN(x) asm volatile("":"+v"(x))
  #define MX3(a,b,c) __builtin_fmaxf(__builtin_fmaxf((a),(b)),(c))
  #define GAPA(MF,A0,A1,A2,A3,W0,W1,PW) do{ MF; sacc+=A0; sacc+=A1; sacc+=A2; sacc+=A3; PIN(sacc); W0; W1; PIN(PW); SBAR(); }while(0)
  #define EX(v) __builtin_amdgcn_exp2f(v)
  #define GAPB(MF,X,B) do{ MF; X[B]=EX(X[B]); X[B+1]=EX(X[B+1]); PIN(X); SBAR(); }while(0)
  #define VRD2(i) do{ vlo[i]=vtr(vp_+(8192+((i)>>2)*4096+((i)&3)*1024)); vhi[i]=vtr(vp_+(8192+((i)>>2)*4096+((i)&3)*1024+512)); SBAR(); }while(0)
  #define VRD(i) do{ vlo[i]=vtr(vp_+(((i)>>2)*4096+((i)&3)*1024)); vhi[i]=vtr(vp_+(((i)>>2)*4096+((i)&3)*1024+512)); }while(0)
  #define KRD(G,j) do{ if(G){ kload2(kf,kp0+sl_next,j); SBAR(); } }while(0)
  #define STEP(C0,C1,P0,P1,t,GK,GV,GL) do{ SBAR(); \
    BIAS2(C0,C1,t); SBAR(); \
    const lds_cptr vp_=vp0+2*sl_prev; \
    VRD(0); SBAR(); float sacc=(P0[0]+P0[1]); \
    GAPA(C0=MFMA32(kf[0],qr[0],C0), P0[2],P0[3],P0[4],P0[5],     pw0[0]=PKW(P0,0), pw0[1]=PKW(P0,2), pw0); \
    VRD(4); SBAR(); GAPA(C1=MFMA32(kf[1],qr[0],C1), P0[6],P0[7],P0[8],P0[9],     pw0[2]=PKW(P0,4), pw0[3]=PKW(P0,6), pw0); \
    VRD(1); SBAR(); GAPA(C0=MFMA32(kf[2],qr[1],C0),   P0[10],P0[11],P0[12],P0[13], pw1[0]=PKW(P0,8), pw1[1]=PKW(P0,10), pw1); \
    VRD(5); SBAR(); GAPA(C1=MFMA32(kf[3],qr[1],C1),   P0[14],P0[15],P1[0],P1[1],   pw1[2]=PKW(P0,12),pw1[3]=PKW(P0,14), pw1); \
    VRD(2); SBAR(); GAPA(C0=MFMA32(kf[4],qr[2],C0),   P1[2],P1[3],P1[4],P1[5],     pw2[0]=PKW(P1,0), pw2[1]=PKW(P1,2), pw2); \
    VRD(6); SBAR(); GAPA(C1=MFMA32(kf[5],qr[2],C1),   P1[6],P1[7],P1[8],P1[9],     pw2[2]=PKW(P1,4), pw2[3]=PKW(P1,6), pw2); \
    VRD(3); SBAR(); GAPA(C0=MFMA32(kf[6],qr[3],C0),   P1[10],P1[11],P1[12],P1[13], pw3[0]=PKW(P1,8), pw3[1]=PKW(P1,10), pw3); \
    VRD(7); SBAR(); GAPA(C1=MFMA32(kf[7],qr[3],C1),   P1[14],P1[15],0.f,0.f,       pw3[2]=PKW(P1,12),pw3[3]=PKW(P1,14), pw3); \
    l_reg+=sacc; \
    if(GK){DMA_K((t)+3,sl_cur);} if(GV){DMA_V((t)+1,sl_next);} \
    CMASK(C0,C1,t); \
    { float a=MX3(C0[0],C0[1],C1[0]),b=MX3(C0[2],C0[3],C1[1]); a=MX3(a,C1[2],C1[3]); \
      _Pragma("unroll") for(int r=4;r<16;r+=4){a=MX3(a,C0[r],C0[r+1]);b=MX3(b,C0[r+2],C0[r+3]);a=MX3(a,C1[r],C1[r+1]);b=MX3(b,C1[r+2],C1[r+3]);} \
      float rm=__builtin_fmaxf(a,b); { auto rr=__builtin_amdgcn_permlane32_swap(__float_as_uint(rm),__float_as_uint(rm),false,false); rm=__builtin_fmaxf(__uint_as_float(rr[0]),__uint_as_float(rr[1])); } \
      resc=false; \
      if(__builtin_expect(__any(rm>(float)THRL),0)){ const float dl=__builtin_fmaxf(rm,0.f); cref-=dl; \
        _Pragma("unroll") for(int r=0;r<16;++r){C0[r]-=dl;C1[r]-=dl;} \
        const float f=__builtin_amdgcn_exp2f(-dl); l_reg*=f; if(hi==0)wsf[r32]=f; resc=true; } } \
    SBAR(); \
    GAPB(o[0]=MFMA32(PAF(0),VFR(0),o[0]), C0,0);  VRD2(0); \
    GAPB(o[1]=MFMA32(PAF(0),VFR(4),o[1]), C0,2);  VRD2(4); \
    KRD(GL,0); GAPB(o[0]=MFMA32(PAF(1),VFR(1),o[0]), C0,4);  VRD2(1); \
    KRD(GL,1); GAPB(o[1]=MFMA32(PAF(1),VFR(5),o[1]), C0,6);  VRD2(5); \
    KRD(GL,2); GAPB(o[0]=MFMA32(PAF(2),VFR(2),o[0]), C0,8);  VRD2(2); \
    KRD(GL,3); GAPB(o[1]=MFMA32(PAF(2),VFR(6),o[1]), C0,10); VRD2(6); \
    GAPB(o[0]=MFMA32(PAF(3),VFR(3),o[0]), C0,12); VRD2(3); \
    GAPB(o[1]=MFMA32(PAF(3),VFR(7),o[1]), C0,14); VRD2(7); \
    GAPB(o[2]=MFMA32(PAF(0),VFR(0),o[2]), C1,0); \
    GAPB(o[3]=MFMA32(PAF(0),VFR(4),o[3]), C1,2); \
    GAPB(o[2]=MFMA32(PAF(1),VFR(1),o[2]), C1,4); \
    GAPB(o[3]=MFMA32(PAF(1),VFR(5),o[3]), C1,6); \
    GAPB(o[2]=MFMA32(PAF(2),VFR(2),o[2]), C1,8); \
    GAPB(o[3]=MFMA32(PAF(2),VFR(6),o[3]), C1,10); \
    GAPB(o[2]=MFMA32(PAF(3),VFR(3),o[2]), C1,12); \
    GAPB(o[3]=MFMA32(PAF(3),VFR(7),o[3]), C1,14); \
    }while(0)
  #define ENDW(tt) do{ if((tt)+3<NT){WAIT_BAR(3);} else if((tt)+2<NT){WAIT_BAR(2);} else {WAIT_BAR(0);} }while(0)
#if PROBE_ATT == 3
  if(blockIdx.x==PROBE_BLK&&threadIdx.x==0)atomicAdd(pw_,(unsigned)(__builtin_amdgcn_s_memrealtime()-ps0_));
#endif
  int t=1;
  for(;t<5&&t+1<NT;t+=2){
    STEP(pB0,pB1,pA0,pA1,t,(t+3<NT),(t+1<NT),(t+1<NT));       ENDW(t);   RESC(); ROT();
    STEP(pA0,pA1,pB0,pB1,t+1,(t+4<NT),(t+2<NT),(t+2<NT));     ENDW(t+1); RESC(); ROT();
  }
  if(t==5&&NT>=12){
    float lt=l_reg; {auto rr=__builtin_amdgcn_permlane32_swap(__float_as_uint(lt),__float_as_uint(lt),false,false);lt=__uint_as_float(rr[0])+__uint_as_float(rr[1]);}
    float dl2=(sl2*(float)(192-qrel)-cref)+__builtin_amdgcn_logf(lt);
    #define DPPMIN(ctl) dl2=__builtin_fminf(dl2,__uint_as_float((unsigned)__builtin_amdgcn_update_dpp(0,(int)__float_as_uint(dl2),ctl,0xF,0xF,false)))
    DPPMIN(0xB1); DPPMIN(0x4E); DPPMIN(0x141); DPPMIN(0x140);
    #undef DPPMIN
    { auto rr=__builtin_amdgcn_permlane16_swap(__float_as_uint(dl2),__float_as_uint(dl2),false,false); dl2=__builtin_fminf(__uint_as_float(rr[0]),__uint_as_float(rr[1])); }
    float*xw=(float*)(shm+LDS_OST);
    if(lane==0)xw[wid]=dl2;
    asm volatile("s_waitcnt lgkmcnt(0)\n\ts_barrier":::"memory");
    float dmin=xw[0];
    #pragma unroll
    for(int w_=1;w_<8;++w_)dmin=__builtin_fminf(dmin,xw[w_]);
    dmin=__uint_as_float(__builtin_amdgcn_readfirstlane(__float_as_uint(dmin)));
    const float d0_=(Ub-dmin+24.f+log2f(1.f/(1.f-exp2f(-sl2))))/sl2; float st_=ceilf((d0_+255.f)*(1.f/64.f)); st_=st_<10.f?10.f:(st_>64.f?64.f:st_);
    const int nc_=__builtin_amdgcn_readfirstlane((((int)st_)+1)&~1); if(nc_<NT)NT=nc_;
    asm volatile("s_waitcnt lgkmcnt(0)":::"memory");
  }
  #undef CMASK
  #define CMASK(P0,P1,t) do{}while(0)
  for(;t+5<NT;t+=2){
    STEP(pB0,pB1,pA0,pA1,t,true,true,true);     WAIT_BAR(3); RESC(); ROT();
    STEP(pA0,pA1,pB0,pB1,t+1,true,true,true);   WAIT_BAR(3); RESC(); ROT();
  }
  for(;t+1<NT;t+=2){
    STEP(pB0,pB1,pA0,pA1,t,(t+3<NT),(t+1<NT),(t+1<NT));       ENDW(t);   RESC(); ROT();
    STEP(pA0,pA1,pB0,pB1,t+1,(t+4<NT),(t+2<NT),(t+2<NT));     ENDW(t+1); RESC(); ROT();
  }
  #undef CMASK
  #define CMASK(P0,P1,t) do{int jb_=3-(t); if(jb_>=0)cmask(P0,P1,jb_,qrel,hi);}while(0)
  STEP(pB0,pB1,pA0,pA1,NT-1,false,false,false); RESC();
#if PROBE_ATT == 4
  const unsigned long long ps1_=__builtin_amdgcn_s_memrealtime();
#endif
  { float sacc=pB0[0]+pB0[1]; _Pragma("unroll") for(int r=2;r<16;++r)sacc+=pB0[r]; _Pragma("unroll") for(int r=0;r<16;++r)sacc+=pB1[r]; l_reg+=sacc;
    pw0=(u32x4){PKW(pB0,0),PKW(pB0,2),PKW(pB0,4),PKW(pB0,6)};pw1=(u32x4){PKW(pB0,8),PKW(pB0,10),PKW(pB0,12),PKW(pB0,14)};pw2=(u32x4){PKW(pB1,0),PKW(pB1,2),PKW(pB1,4),PKW(pB1,6)};pw3=(u32x4){PKW(pB1,8),PKW(pB1,10),PKW(pB1,12),PKW(pB1,14)};
    SBAR(); pv(o,vb0+2*sl_cur,PAF(0),PAF(1),PAF(2),PAF(3)); }
  #undef PKW
  #undef PAF
  #undef VFR
  #undef PIN
  #undef MX3
  #undef GAPA
  #undef GAPB
  #undef EX
  #undef VRD
  #undef VRD2
  #undef KRD
  #undef STEP
  #undef ENDW
  { int tid_e=threadIdx.x; asm volatile("":"+v"(tid_e)); const int lane=tid_e&63,r32=lane&31,hi=lane>>5; const int wid=__builtin_amdgcn_readfirstlane(tid_e>>6);
    float*wsf=(float*)(shm+LDS_WS)+wid*64;
  {auto rr=__builtin_amdgcn_permlane32_swap(__float_as_uint(l_reg),__float_as_uint(l_reg),false,false);l_reg=__uint_as_float(rr[0])+__uint_as_float(rr[1]);}
  if(hi==0)wsf[32+r32]=l_reg;asm volatile("s_waitcnt lgkmcnt(0)":::"memory");
  float rli[16];
  #pragma unroll
  for(int r=0;r<16;++r)rli[r]=__builtin_amdgcn_rcpf(wsf[32+crow(r,hi)]);
  u32x4*ow=(u32x4*)(o1s+wid*2048)+lane;
  if(cmap==0){
    #pragma unroll
    for(int i=0;i<8;++i){ const int dq=i>>1,r0=8*(i&1); u32x4 w;
      w.x=cvtpk_s(o[dq][r0+0]*rli[r0+0],o[dq][r0+1]*rli[r0+1]); w.y=cvtpk_s(o[dq][r0+2]*rli[r0+2],o[dq][r0+3]*rli[r0+3]);
      w.z=cvtpk_s(o[dq][r0+4]*rli[r0+4],o[dq][r0+5]*rli[r0+5]); w.w=cvtpk_s(o[dq][r0+6]*rli[r0+6],o[dq][r0+7]*rli[r0+7]); ow[i*64]=w; }
  } else {
    bf16*stg=(bf16*)(shm+LDS_OST)+wid*2048;
    const int row=lane>>1,part=lane&1; float v[64]; float ss=0.f;
    unsigned o1w[32];
    #pragma unroll
    for(int i=0;i<8;++i){ const u32x4 w=ow[i*64]; o1w[4*i+0]=w.x; o1w[4*i+1]=w.y; o1w[4*i+2]=w.z; o1w[4*i+3]=w.w; }
    #pragma unroll
    for(int p_=0;p_<2;++p_){
      #pragma unroll
      for(int d0=0;d0<2;++d0){ const int dq=2*p_+d0;
        #pragma unroll
        for(int rp=0;rp<8;++rp){ const unsigned w=o1w[dq*8+rp];
          const float a0=__uint_as_float(w<<16)-lam*(o[dq][2*rp]*rli[2*rp]), a1=__uint_as_float(w&0xffff0000u)-lam*(o[dq][2*rp+1]*rli[2*rp+1]);
          stg[crow(2*rp,hi)*64+d0*32+r32]=__float2bfloat16(a0); stg[crow(2*rp+1,hi)*64+d0*32+r32]=__float2bfloat16(a1); } }
      asm volatile("s_waitcnt lgkmcnt(0)":::"memory");
      #pragma unroll
      for(int i=0;i<4;++i){ const u32x4 w=*(const u32x4*)(stg+row*64+part*32+8*i);
        v[32*p_+8*i+0]=__uint_as_float(w.x<<16); v[32*p_+8*i+1]=__uint_as_float(w.x&0xffff0000u); v[32*p_+8*i+2]=__uint_as_float(w.y<<16); v[32*p_+8*i+3]=__uint_as_float(w.y&0xffff0000u);
        v[32*p_+8*i+4]=__uint_as_float(w.z<<16); v[32*p_+8*i+5]=__uint_as_float(w.z&0xffff0000u); v[32*p_+8*i+6]=__uint_as_float(w.w<<16); v[32*p_+8*i+7]=__uint_as_float(w.w&0xffff0000u); }
      asm volatile("s_waitcnt lgkmcnt(0)":::"memory");
    }
    #pragma unroll
    for(int i=0;i<64;++i)ss+=v[i]*v[i];
    ss+=__uint_as_float((unsigned)__builtin_amdgcn_update_dpp(0,(int)__float_as_uint(ss),0xB1,0xF,0xF,false));
    const float rs=(1.0f/sqrtf(ss*(1.0f/128.0f)+1e-6f))*oscale;
    bf16*op=MIXh+((long)rowbase+q0+wid*QBLK+row)*2048+part*32;
    #pragma unroll
    for(int p_=0;p_<2;++p_){ const float*sg=subg+64*p_+32*part;
      #pragma unroll
      for(int i=0;i<4;++i){ u32x4 w; const float*vv=v+32*p_+8*i; const float*gg=sg+8*i;
        w.x=cvtpk_s(vv[0]*rs*gg[0],vv[1]*rs*gg[1]); w.y=cvtpk_s(vv[2]*rs*gg[2],vv[3]*rs*gg[3]); w.z=cvtpk_s(vv[4]*rs*gg[4],vv[5]*rs*gg[5]); w.w=cvtpk_s(vv[6]*rs*gg[6],vv[7]*rs*gg[7]);
        *(u32x4*)(op+64*p_+8*i)=w; } }
  }
  }
  asm volatile("s_waitcnt lgkmcnt(0)\n\ts_barrier":::"memory");
#if PROBE_ATT == 4
  if(blockIdx.x==PROBE_BLK&&threadIdx.x==0)atomicAdd(pw_,(unsigned)(__builtin_amdgcn_s_memrealtime()-ps1_));
#endif
  #undef DMA_K
  #undef DMA_V
  #undef vb0
  #undef CMASK
  #undef START
  #undef RESC
  #undef ROT
  #undef BIAS2
}
constexpr int ATTN_LDS_BYTES=LDS_BYTES;
template<int THRL> __device__ __forceinline__ void attn_unit4(int b,int h,int qb,float lam,float oscale,const float*subg,const unsigned*nmax,unsigned*o1s,const bf16*Q,const bf16*K,const bf16*V,bf16*MIX,char*shm){
  const float sl2=exp2f(-(float)(h+1))*1.4426950408889634f;
  int cap[2]; float Uv[2];
  #pragma unroll
  for(int c=0;c<2;++c){ const int bh=b*8+h; const unsigned*qn=nmax+((0*64+bh)*2+c)*2,*kn=nmax+((1*64+bh)*2+c)*2;
    const float U=1.02f*(sqrtf(__uint_as_float(qn[0])*__uint_as_float(kn[0]))+sqrtf(__uint_as_float(qn[1])*__uint_as_float(kn[1])));
    const float d0=(2.f*U+24.f+log2f(1.f/(1.f-exp2f(-sl2))))/sl2; float st=ceilf((d0+255.f)*(1.f/64.f)); st=st<4.f?4.f:(st>64.f?64.f:st);
    cap[c]=__builtin_amdgcn_readfirstlane((((int)st)+1)&~1); Uv[c]=__uint_as_float(__builtin_amdgcn_readfirstlane(__float_as_uint(U))); }
  for(int c=0;c<2;++c) attn_sub<THRL>(b,(2*h+c)*64,h*128,qb,c,sl2,lam,c?cap[1]:cap[0],c?Uv[1]:Uv[0],oscale,subg,o1s,MIX+h*128,Q,K,V,shm,(unsigned*)nmax+900);
}
__device__ __forceinline__ int wg_pop(unsigned*ctr,volatile __attribute__((address_space(3))) unsigned*slot){
  if(threadIdx.x==0)*slot=__hip_atomic_fetch_add(ctr,1u,__ATOMIC_RELAXED,__HIP_MEMORY_SCOPE_AGENT);
  __syncthreads(); const unsigned n=*slot; __syncthreads(); return (int)n;
}
template<int THRL=8> __device__ __forceinline__ void attn_phase(char*lds,int bx,unsigned*qctr,volatile __attribute__((address_space(3))) unsigned*slot,float lam,float oscale,const float*subg,const unsigned*nmax,unsigned*o1s,const bf16*Q,const bf16*K,const bf16*V,bf16*MIX){
  for(int qi=0;qi<8;++qi){ const int x=(bx+qi)&7;
    for(;;){ const int n=wg_pop(qctr+64*x,slot); if(n>=128)break;
      const int qb=15-(n>>3),h=7-(n&7),b=(x+h)&7;
#if PROBE_ATT == 1
      const unsigned long long pa0_=__builtin_amdgcn_s_memrealtime();
#endif
      attn_unit4<THRL>(b,h,qb,lam,oscale,subg,nmax,o1s,Q,K,V,MIX,lds);
#if PROBE_ATT == 1
      if(blockIdx.x==PROBE_BLK&&threadIdx.x==0)atomicAdd((unsigned*)nmax+900,(unsigned)(__builtin_amdgcn_s_memrealtime()-pa0_));
#endif
    } }
}
#undef SBAR
#undef WAIT_BAR
#undef MFMA32
}
#define GAS __attribute__((address_space(1)))
#define LAS __attribute__((address_space(3)))
typedef unsigned short bf16;
typedef unsigned v4u __attribute__((ext_vector_type(4)));
typedef float f32x4 __attribute__((ext_vector_type(4)));
typedef short bf16x8 __attribute__((ext_vector_type(8)));
typedef GAS unsigned gu32;
typedef GAS unsigned long long gu64;
#define RLX_AGENT __ATOMIC_RELAXED, __HIP_MEMORY_SCOPE_AGENT
#define LDS_WAIT() asm volatile("s_waitcnt lgkmcnt(0)" ::: "memory")
#define VM_WAIT() asm volatile("s_waitcnt vmcnt(0)" ::: "memory")
__device__ __forceinline__ unsigned long long rt() { return __builtin_amdgcn_s_memrealtime(); }
__device__ __forceinline__ unsigned f2bf(float f) { unsigned u = __builtin_bit_cast(unsigned, f); return (u + 0x7fffu + ((u >> 16) & 1u)) >> 16; }
__device__ __forceinline__ unsigned pk2(float lo, float hi) { return f2bf(lo) | (f2bf(hi) << 16); }

#define XB_TMO      128
#define XB_XCNT(j)  (256  + 64 * (j))
#define XB_XSUB(j)  (1280 + 64 * (j))
#define XB_XGEN(j)  (2304 + 64 * (j))
#define XB_TOP      3328
#define XB_TOPGEN   3392
#define XCD_BAR_WORDS 3456
#define XB_SPIN_CAP (1u << 18)

__device__ __forceinline__ unsigned xb_ld(unsigned* p)              { return __hip_atomic_load(p, __ATOMIC_RELAXED, __HIP_MEMORY_SCOPE_AGENT); }
__device__ __forceinline__ unsigned xb_add(unsigned* p, unsigned v) { return __hip_atomic_fetch_add(p, v, __ATOMIC_RELAXED, __HIP_MEMORY_SCOPE_AGENT); }
__device__ __forceinline__ unsigned xb_xcc_id() { return (unsigned)__builtin_amdgcn_s_getreg((3 << 11) | 20) & 0xFu; }
#define XB_SPIN(cond, bar) do { unsigned _sp = 0; while (cond) { __builtin_amdgcn_s_sleep(1); \
    if ((++_sp & 255u) == 0u) { if (xb_ld(&(bar)[XB_TMO])) break; if (_sp > XB_SPIN_CAP) { atomicAdd(&(bar)[XB_TMO], 1u); break; } } } } while (0)

struct XcdBarrier {
    unsigned* bar; unsigned x;
    volatile LAS unsigned* st;
};

__device__ __forceinline__ XcdBarrier xcd_barrier_post(unsigned* bar, volatile LAS unsigned* st) {
    XcdBarrier b; b.bar = bar; b.x = xb_xcc_id(); b.st = st;
    if (threadIdx.x == 0) (void)xb_add(&bar[XB_XCNT(b.x)], 1u);
    return b;
}
__device__ __forceinline__ void xcd_barrier_complete(unsigned* bar, unsigned x, unsigned& nloc, unsigned& nx) {
    const unsigned G = gridDim.x * gridDim.y * gridDim.z;
    unsigned sum, cnt, mine, sp = 0u;
    for (;;) {
        sum = 0u; cnt = 0u; mine = 0u;
#pragma unroll
        for (unsigned j = 0; j < 16; ++j) { const unsigned c = xb_ld(&bar[XB_XCNT(j)]); sum += c; cnt += (c > 0u) ? 1u : 0u; mine = (j == x) ? c : mine; }
        if (sum == G) break;
        __builtin_amdgcn_s_sleep(1);
        if ((++sp & 255u) == 0u) { if (xb_ld(&bar[XB_TMO])) break; if (sp > XB_SPIN_CAP) { atomicAdd(&bar[XB_TMO], 1u); break; } }
    }
    nloc = mine > 0u ? mine : 1u; nx = cnt > 0u ? cnt : 1u;
}

__device__ __forceinline__ void xcd_barrier(const XcdBarrier& b) {
    asm volatile("s_waitcnt vmcnt(0)" ::: "memory");
    __syncthreads();
    if (threadIdx.x == 0) {
        unsigned* bar = b.bar;
        __builtin_amdgcn_s_waitcnt(0);
        unsigned nloc = b.st[0], nx = b.st[1];
        if (nloc == 0u) { xcd_barrier_complete(bar, b.x, nloc, nx); b.st[0] = nloc; b.st[1] = nx; }
        const unsigned old = xb_add(&bar[XB_XSUB(b.x)], 1u);
        const unsigned gen = old / nloc;
        if (old + 1u == (gen + 1u) * nloc) {
            __builtin_amdgcn_fence(__ATOMIC_RELEASE, "agent");
            asm volatile("s_waitcnt vmcnt(0)" ::: "memory");
            const unsigned og = xb_add(&bar[XB_TOP], 1u);
            const unsigned tg = og / nx;
            if (og + 1u == (tg + 1u) * nx) xb_add(&bar[XB_TOPGEN], 1u);
            else XB_SPIN(xb_ld(&bar[XB_TOPGEN]) == tg, bar);
            __builtin_amdgcn_fence(__ATOMIC_ACQUIRE, "agent");
            xb_add(&bar[XB_XGEN(b.x)], 1u);
            asm volatile("s_waitcnt vmcnt(0)" ::: "memory");
        } else {
            XB_SPIN(xb_ld(&bar[XB_XGEN(b.x)]) == gen, bar);
            __builtin_amdgcn_fence(__ATOMIC_ACQUIRE, "agent");
            asm volatile("s_waitcnt vmcnt(0)" ::: "memory");
        }
    }
    __syncthreads();
}

constexpr int NWAVES = 8;
constexpr int BATCH = 8, SEQ = 4096, T = BATCH * SEQ, D = 2048, NIN = 5120, NEXP = 32, NA = 2 * T;
constexpr float EPS = 1e-6f, LOG2E = 1.4426950408889634f, C2 = 0.125f * 1.4426950408889634f;
constexpr size_t MiB = 1u << 20;
constexpr size_t WS_CTL = 0, CTL_ZERO_BYTES = 1 * MiB;
constexpr size_t WS_RSTD1 = 1 * MiB, WS_RSTD2 = WS_RSTD1 + 128 * 1024, WS_WTS = WS_RSTD2 + 128 * 1024;
constexpr size_t WS_LIST = 2 * MiB;
constexpr size_t WS_PART = 6 * MiB;
constexpr size_t WS_WIN = 10 * MiB, WS_WOUT = 30 * MiB;
constexpr size_t WS_WGU = 38 * MiB, WS_WD = 166 * MiB;
constexpr size_t WS_XB = 230 * MiB;
constexpr size_t WS_CG = 358 * MiB;
constexpr size_t WS_MIX = 422 * MiB;
constexpr size_t WS_HB = 550 * MiB;
constexpr size_t WS_HB8 = 678 * MiB;
constexpr size_t WS_WR = 742 * MiB;
constexpr size_t WS_X8 = 743 * MiB;
constexpr size_t WS_WIN8 = 807 * MiB;
constexpr size_t WS_O1S = 811 * MiB;
constexpr size_t WS_LISTW = 827 * MiB, WS_LISTR = 831 * MiB;
constexpr size_t WS_END = 835 * MiB;
constexpr float WSCALE = 32.f, H1SCALE = 4.f, YSCALE = 8.f;
constexpr int CW_TMO = 0, CW_CODE = 1, CW_BAR = 4096, CW_CNT = 8192;
constexpr int CW_GQ = 20480;
constexpr int CW_H8Q = 24576 + 1024;
constexpr int CW_CVQ = 24576, CW_DONE = 24576 + 64;
constexpr int CW_QA = 12288, CW_QC = 12288 + 512, CW_NMAX = 16384;
constexpr int RING_OFF = 0, RING_BYTES = 131072, LDSCTL_OFF = RING_BYTES, MISC_OFF = LDSCTL_OFF + 320, TAB_OFF = LDSCTL_OFF + 1024;
constexpr int LDS_BYTES = 147456;
constexpr int NPHASE = 8;
#ifndef MK_ONE_LAUNCH
#define MK_ONE_LAUNCH 1
#endif
#ifndef PROBE_DOUBLE
#define PROBE_DOUBLE 0
#endif
#ifndef PROBE_CLOCK
#define PROBE_CLOCK 0
#endif
#ifndef USE_NAIVE_ROUTER
#define USE_NAIVE_ROUTER 0
#endif
#ifndef USE_NAIVE_ATTN
#define USE_NAIVE_ATTN 0
#endif


typedef unsigned u32x4g __attribute__((ext_vector_type(4)));
__device__ __forceinline__ float wave_sum(float v) {
#pragma unroll
    for (int o = 1; o < 64; o <<= 1) v += __shfl_xor(v, o);
    return v;
}
__device__ __forceinline__ float bflo(unsigned w) { return __builtin_bit_cast(float, w << 16); }
__device__ __forceinline__ float bfhi(unsigned w) { return __builtin_bit_cast(float, w & 0xffff0000u); }
__device__ __forceinline__ float fexp2(float x) { return __builtin_amdgcn_exp2f(x); }

__device__ __forceinline__ void tr_item(const float* W, int N, const float* gk, int k0, int n0, bf16* dst, int dstK, LAS float* scr, int lane) {
    const int kr = lane >> 3, n4 = 4 * (lane & 7); f32x4 v[8];
#pragma unroll
    for (int i = 0; i < 8; ++i) v[i] = *(const GAS f32x4*)(W + (size_t)(k0 + 8 * i + kr) * N + n0 + n4);
#pragma unroll
    for (int i = 0; i < 8; ++i) { const int kk = 8 * i + kr; const float g = gk ? gk[k0 + kk] : 1.0f;
        scr[(n4 + 0) * 66 + kk] = v[i].x * g; scr[(n4 + 1) * 66 + kk] = v[i].y * g; scr[(n4 + 2) * 66 + kk] = v[i].z * g; scr[(n4 + 3) * 66 + kk] = v[i].w * g; }
    LDS_WAIT(); asm volatile("" ::: "memory");
    const int c = lane & 7;
#pragma unroll
    for (int j = 0; j < 4; ++j) { const int n = (lane >> 3) + 8 * j; const LAS float* s = scr + n * 66 + 8 * c;
        v4u o; o.x = pk2(s[0], s[1]); o.y = pk2(s[2], s[3]); o.z = pk2(s[4], s[5]); o.w = pk2(s[6], s[7]);
        *(GAS v4u*)(dst + (size_t)n * dstK + 8 * c) = o; }
    LDS_WAIT(); asm volatile("" ::: "memory");
}
__device__ __forceinline__ void tr8_load(const float* W, int N, int k0, int n0, int lane, f32x4 (&v)[8]) {
    const int kr = lane >> 3, n4 = 4 * (lane & 7);
#pragma unroll
    for (int i = 0; i < 8; ++i) v[i] = *(const GAS f32x4*)(W + (size_t)(k0 + 8 * i + kr) * N + n0 + n4);
}
__device__ __forceinline__ void tr8_finish(const f32x4 (&v)[8], const float* gk, float scale, int k0, unsigned char* dst, int dstK, LAS float* scr, int lane) {
    const int kr = lane >> 3, n4 = 4 * (lane & 7);
#pragma unroll
    for (int i = 0; i < 8; ++i) { const int kk = 8 * i + kr; const float g = (gk ? gk[k0 + kk] : 1.0f) * scale;
        scr[(n4 + 0) * 66 + kk] = v[i].x * g; scr[(n4 + 1) * 66 + kk] = v[i].y * g; scr[(n4 + 2) * 66 + kk] = v[i].z * g; scr[(n4 + 3) * 66 + kk] = v[i].w * g; }
    LDS_WAIT(); asm volatile("" ::: "memory");
    const int c = lane & 7;
#pragma unroll
    for (int j = 0; j < 4; ++j) { const int n = (lane >> 3) + 8 * j; const LAS float* s = scr + n * 66 + 8 * c;
        pg8::u32x2 o; o.x = pg8::pk4_fp8(s[0], s[1], s[2], s[3]); o.y = pg8::pk4_fp8(s[4], s[5], s[6], s[7]);
        *(GAS pg8::u32x2*)(dst + (size_t)n * dstK + 8 * c) = o; }
    LDS_WAIT(); asm volatile("" ::: "memory");
}
__device__ __forceinline__ void tr_item8(const float* W, int N, const float* gk, float scale, int k0, int n0, unsigned char* dst, int dstK, LAS float* scr, int lane) {
    f32x4 v[8]; tr8_load(W, N, k0, n0, lane, v); tr8_finish(v, gk, scale, k0, dst, dstK, scr, lane);
}
struct Ptrs {
    const float *x, *g1, *w_in, *lq1, *lk1, *lq2, *lk2, *subg, *cw, *cb, *lng, *lnb, *w_out, *g2, *wgr, *bgr, *wer, *ber, *w_gate, *w_up, *w_down, *gf;
    float* out; unsigned char* ws;
};
__device__ __forceinline__ void p0_prologue(const Ptrs& P, LAS unsigned char* lds, int lane, int wave, int gw, int NGW) {
    LAS float* scr = (LAS float*)(lds + RING_OFF + wave * 16384);
    bf16* WIN = (bf16*)(P.ws + WS_WIN); bf16* WOUT = (bf16*)(P.ws + WS_WOUT);
    constexpr int I_IN = 32 * 160, I_OUT = 32 * 64, NITEMS = I_IN + I_OUT;
    for (int it = gw; it < NITEMS; it += NGW) {
        if (it < I_IN) { const int kb = it / 160, nb = it % 160;
            if (nb < 96) tr_item(P.w_in, NIN, P.g1, 64 * kb, 32 * nb, WIN + (size_t)(32 * nb) * 2048 + 64 * kb, 2048, scr, lane);
            else { const int j0 = 32 * (nb - 96), jj = j0 & 1023, drow = 256 * (jj >> 7) + (jj & 127) + (j0 >= 1024 ? 128 : 0);
                tr_item8(P.w_in, NIN, P.g1, WSCALE, 64 * kb, 32 * nb, P.ws + WS_WIN8 + (size_t)drow * 2048 + 64 * kb, 2048, scr, lane); } }
        else { const int r = it - I_IN, kb = r >> 6, nb = r & 63; tr_item(P.w_out, 2048, nullptr, 64 * kb, 32 * nb, WOUT + (size_t)(32 * nb) * 2048 + 64 * kb, 2048, scr, lane); }
    }
    { bf16* WR = (bf16*)(P.ws + WS_WR);
      for (int it = gw; it < 32; it += NGW) tr_item(P.wer, 32, P.g2, 64 * it, 0, WR + 64 * it, 2048, scr, lane);
      for (int k = gw * 64 + lane; k < 2048; k += NGW * 64) { const float gk = P.g2[k]; const f32x4 w = *(const f32x4*)(P.wgr + (size_t)k * 4);
          WR[(size_t)128 * 2048 + k] = (bf16)f2bf(w.x * gk); WR[(size_t)129 * 2048 + k] = (bf16)f2bf(w.y * gk); WR[(size_t)130 * 2048 + k] = (bf16)f2bf(w.z * gk); WR[(size_t)131 * 2048 + k] = (bf16)f2bf(w.w * gk); } }
    bf16* XB = (bf16*)(P.ws + WS_XB); float* RS1 = (float*)(P.ws + WS_RSTD1);
    for (int m0 = gw; m0 < T; m0 += 2 * NGW) {
        f32x4 v[2][8]; float ss[2] = {0.f, 0.f};
#pragma unroll
        for (int q = 0; q < 2; ++q) { const int mr = (m0 + q * NGW < T) ? m0 + q * NGW : T - 1; const GAS f32x4* xr = (const GAS f32x4*)(P.x + (size_t)mr * D) + lane;
#pragma unroll
            for (int j = 0; j < 8; ++j) v[q][j] = xr[64 * j]; }
#pragma unroll
        for (int q = 0; q < 2; ++q) { const int m = m0 + q * NGW; if (m >= T) continue;
#pragma unroll
            for (int j = 0; j < 8; ++j) ss[q] += (v[q][j].x * v[q][j].x + v[q][j].y * v[q][j].y) + (v[q][j].z * v[q][j].z + v[q][j].w * v[q][j].w);
            ss[q] = wave_sum(ss[q]);
            if (lane == 0) RS1[m] = 1.0f / sqrtf(ss[q] * (1.0f / D) + EPS);
            GAS unsigned long long* o8 = (GAS unsigned long long*)(XB + (size_t)m * D) + lane; GAS unsigned* o4 = (GAS unsigned*)(P.ws + WS_X8 + (size_t)m * D) + lane;
#pragma unroll
            for (int j = 0; j < 8; ++j) { o8[64 * j] = (unsigned long long)pk2(v[q][j].x, v[q][j].y) | ((unsigned long long)pk2(v[q][j].z, v[q][j].w) << 32); o4[64 * j] = pg8::pk4_fp8(v[q][j].x, v[q][j].y, v[q][j].z, v[q][j].w); } }
    }
}

constexpr int CVT_ITEMS = 3 * 32768, CVT_CH = 4, CVT_CHUNK = CVT_CH * NWAVES, CVT_NCHUNK = CVT_ITEMS / CVT_CHUNK;
struct MoeItem { const float* src; const float* gk; unsigned char* dst; int N, k0, n0, dstK; };
__device__ __forceinline__ MoeItem moe_decode(const Ptrs& P, int r) {
    unsigned char* WGU = P.ws + WS_WGU; unsigned char* WD = P.ws + WS_WD; MoeItem m;
    const int mat = r >> 15, r2 = r & 32767, e = r2 >> 10, idx = r2 & 1023;
    if (mat < 2) { const int kb = idx >> 5, n0 = 32 * (idx & 31); const int drow = e * 2048 + 256 * (n0 >> 7) + (n0 & 127) + (mat == 1 ? 128 : 0);
        m.src = (mat == 0 ? P.w_gate : P.w_up) + (size_t)e * 2048 * 1024; m.N = 1024; m.gk = P.g2; m.k0 = 64 * kb; m.n0 = n0; m.dst = WGU + (size_t)drow * 2048 + 64 * kb; m.dstK = 2048; }
    else { const int kb = idx >> 6, nb = idx & 63; m.src = P.w_down + (size_t)e * 1024 * 2048; m.N = 2048; m.gk = nullptr; m.k0 = 64 * kb; m.n0 = 32 * nb; m.dst = WD + ((size_t)e * 2048 + 32 * nb) * 1024 + 64 * kb; m.dstK = 1024; }
    return m;
}
__device__ __forceinline__ void cvt_fill(const Ptrs& P, LAS unsigned char* lds, volatile LAS unsigned* slot, int max_chunks, const unsigned* donew, int G) {
    int tid_ = threadIdx.x; asm volatile("" : "+v"(tid_)); const int lane = tid_ & 63, wave = __builtin_amdgcn_readfirstlane(tid_ >> 6);
    LAS float* scr = (LAS float*)(lds + RING_OFF + wave * 16384); unsigned* ctr = (unsigned*)(P.ws + WS_CTL) + CW_CVQ;
    for (int n = 0; n < max_chunks; ++n) {
        if (threadIdx.x == 0) { unsigned v = 0xffffffffu;
            if (!(donew && (int)__hip_atomic_load(donew, __ATOMIC_RELAXED, __HIP_MEMORY_SCOPE_AGENT) >= G - 16)) v = __hip_atomic_fetch_add(ctr, 1u, __ATOMIC_RELAXED, __HIP_MEMORY_SCOPE_AGENT);
            *slot = v; }
        __syncthreads(); const unsigned c = *slot; __syncthreads();
        if (c >= (unsigned)CVT_NCHUNK) break;
#pragma unroll 1
        for (int j = 0; j < CVT_CH; j += 2) {
            const MoeItem m0 = moe_decode(P, (int)c * CVT_CHUNK + wave * CVT_CH + j), m1 = moe_decode(P, (int)c * CVT_CHUNK + wave * CVT_CH + j + 1);
            f32x4 v0[8], v1[8]; tr8_load(m0.src, m0.N, m0.k0, m0.n0, lane, v0); tr8_load(m1.src, m1.N, m1.k0, m1.n0, lane, v1);
            tr8_finish(v0, m0.gk, WSCALE, m0.k0, m0.dst, m0.dstK, scr, lane); tr8_finish(v1, m1.gk, WSCALE, m1.k0, m1.dst, m1.dstK, scr, lane); }
    }
}
__device__ __forceinline__ void h8_fill(const Ptrs& P, const bf16* HB, unsigned char* H8, volatile LAS unsigned* slot) {
    int tid_ = threadIdx.x; asm volatile("" : "+v"(tid_)); const int lane = tid_ & 63, wave = __builtin_amdgcn_readfirstlane(tid_ >> 6);
    unsigned* ctr = (unsigned*)(P.ws + WS_CTL) + CW_H8Q;
    for (;;) { const int c = attn_body::wg_pop(ctr, slot); if (c >= T / 64) break;
#pragma unroll 1
        for (int j = 0; j < 8; j += 4) { const int r0 = c * 64 + wave * 8 + j; u32x4g a[4][4];
#pragma unroll
            for (int q = 0; q < 4; ++q)
#pragma unroll
                for (int i = 0; i < 4; ++i) a[q][i] = *(const u32x4g*)(HB + (size_t)(r0 + q) * D + 16 * lane + 1024 * (i >> 1) + 8 * (i & 1));
#pragma unroll
            for (int q = 0; q < 4; ++q)
#pragma unroll
                for (int hj = 0; hj < 2; ++hj) { const u32x4g w0 = a[q][2 * hj], w1 = a[q][2 * hj + 1]; v4u o;
                    o.x = pg8::pk4_fp8(bflo(w0.x), bfhi(w0.x), bflo(w0.y), bfhi(w0.y)); o.y = pg8::pk4_fp8(bflo(w0.z), bfhi(w0.z), bflo(w0.w), bfhi(w0.w));
                    o.z = pg8::pk4_fp8(bflo(w1.x), bfhi(w1.x), bflo(w1.y), bfhi(w1.y)); o.w = pg8::pk4_fp8(bflo(w1.z), bfhi(w1.z), bflo(w1.w), bfhi(w1.w));
                    *(v4u*)(H8 + (size_t)(r0 + q) * D + 16 * lane + 1024 * hj) = o; } }
    }
}
__device__ __forceinline__ void router_skinny(const Ptrs& P, const bf16* HB, unsigned char* H8, LAS unsigned char* lds, int G) {
    int tid_ = threadIdx.x; asm volatile("" : "+v"(tid_)); const int tid = tid_, lane = tid & 63, wave = __builtin_amdgcn_readfirstlane(tid >> 6), fr = lane & 15, fq = lane >> 4;
    constexpr int BROW = 1040, BBUF = 48 * BROW;
    const bf16* WR = (const bf16*)(P.ws + WS_WR);
    LAS unsigned char* Bb = lds + RING_OFF; LAS float* LX = (LAS float*)(lds + RING_OFF + 2 * BBUF) + wave * (16 * 37);
    const float* part = (const float*)(P.ws + WS_PART); float* listr = (float*)(P.ws + WS_LISTR); float* listw = (float*)(P.ws + WS_LISTW); int* list = (int*)(P.ws + WS_LIST);
    unsigned* cnt = (unsigned*)(P.ws + WS_CTL) + CW_CNT;
    int brow[6], bcol[6];
#pragma unroll
    for (int i = 0; i < 6; ++i) { const int pc = tid + 512 * i; brow[i] = pc >> 6; bcol[i] = pc & 63; }
    for (int u = blockIdx.x; u < T / 128; u += G) {
        const int r0 = u * 128 + wave * 16;
        const bf16* arow = HB + (size_t)(r0 + fr) * D + 16 * fq;
        unsigned char* orow = H8 + (size_t)(r0 + fr) * D + 16 * fq;
        u32x4g bs[6], a[2][16]; pg8::f32x4 acc[3];
#pragma unroll
        for (int nb = 0; nb < 3; ++nb) acc[nb] = (pg8::f32x4){0.f, 0.f, 0.f, 0.f};
#define RS_LOADB(c) do { _Pragma("unroll") for (int i = 0; i < 6; ++i) { const int sr = brow[i] < 32 ? brow[i] : 128 + ((brow[i] - 32) & 3); \
            bs[i] = *(const u32x4g*)(WR + (size_t)sr * D + 512 * (c) + 8 * bcol[i]); } } while (0)
#define RS_STOREB(c) do { _Pragma("unroll") for (int i = 0; i < 6; ++i) *(LAS u32x4g*)(Bb + ((c) & 1) * BBUF + brow[i] * BROW + bcol[i] * 16) = bs[i]; } while (0)
#define RS_LOADA(c) do { _Pragma("unroll") for (int s = 0; s < 16; ++s) a[(c) & 1][s] = *(const u32x4g*)(arow + 512 * (c) + 64 * (s >> 1) + 8 * (s & 1)); } while (0)
        RS_LOADB(0); RS_LOADA(0); RS_STOREB(0);
#pragma unroll
        for (int c = 0; c < 4; ++c) {
            __syncthreads();
            if (c < 3) { RS_LOADB(c + 1); RS_LOADA(c + 1); }
#pragma unroll
            for (int s = 0; s < 16; ++s) {
                const pg8::bf16x8 af = __builtin_bit_cast(pg8::bf16x8, a[c & 1][s]);
#pragma unroll
                for (int nb = 0; nb < 3; ++nb) {
                    const pg8::bf16x8 bf = *(const LAS pg8::bf16x8*)(Bb + (c & 1) * BBUF + (16 * nb + fr) * BROW + (64 * (s >> 1) + 16 * fq + 8 * (s & 1)) * 2);
                    acc[nb] = __builtin_amdgcn_mfma_f32_16x16x32_bf16(af, bf, acc[nb], 0, 0, 0); }
            }
            if (c < 3) RS_STOREB(c + 1);
#pragma unroll
            for (int s = 0; s < 16; s += 2) { const u32x4g w0 = a[c & 1][s], w1 = a[c & 1][s + 1]; v4u o;
                o.x = pg8::pk4_fp8(bflo(w0.x), bfhi(w0.x), bflo(w0.y), bfhi(w0.y)); o.y = pg8::pk4_fp8(bflo(w0.z), bfhi(w0.z), bflo(w0.w), bfhi(w0.w));
                o.z = pg8::pk4_fp8(bflo(w1.x), bfhi(w1.x), bflo(w1.y), bfhi(w1.y)); o.w = pg8::pk4_fp8(bflo(w1.z), bfhi(w1.z), bflo(w1.w), bfhi(w1.w));
                *(v4u*)(orow + 512 * c + 64 * (s >> 1)) = o; }
        }
#undef RS_LOADB
#undef RS_STOREB
#undef RS_LOADA
#pragma unroll
        for (int nb = 0; nb < 3; ++nb)
#pragma unroll
            for (int r = 0; r < 4; ++r) if (nb < 2 || fr < 4) LX[(4 * fq + r) * 37 + 16 * nb + fr] = acc[nb][r];
        __syncthreads();
        if (lane < 16) { const int row = r0 + lane; const LAS float* lx = LX + lane * 37;
            float sq[4];
#pragma unroll
            for (int q = 0; q < 4; ++q) { const pg8::f32x4 p0 = *(const pg8::f32x4*)(part + (size_t)row * 32 + 8 * q), p1 = *(const pg8::f32x4*)(part + (size_t)row * 32 + 8 * q + 4);
                sq[q] = ((p0[0] + p0[1]) + (p0[2] + p0[3])) + ((p1[0] + p1[1]) + (p1[2] + p1[3])); }
            const float ss = (sq[0] + sq[1]) + (sq[2] + sq[3]);
            const float rstd = 1.0f / sqrtf(ss * (1.0f / 2048.0f) + 1e-6f);
            float g[4];
#pragma unroll
            for (int i = 0; i < 4; ++i) g[i] = lx[32 + i] * rstd + P.bgr[i];
            int gs = 0; float gm = g[0];
#pragma unroll
            for (int i = 1; i < 4; ++i) if (g[i] > gm) { gm = g[i]; gs = i; }
            float gsum = 0.f;
#pragma unroll
            for (int i = 0; i < 4; ++i) gsum += __expf(g[i] - gm);
            const float gw = 1.0f / gsum;
            float ev[8];
#pragma unroll
            for (int i = 0; i < 8; ++i) ev[i] = lx[8 * gs + i] * rstd + P.ber[8 * gs + i];
            int i1 = 0; float v1 = ev[0];
#pragma unroll
            for (int i = 1; i < 8; ++i) if (ev[i] > v1) { v1 = ev[i]; i1 = i; }
            int i2 = -1; float v2 = -3.0e38f;
#pragma unroll
            for (int i = 0; i < 8; ++i) if (i != i1 && ev[i] > v2) { v2 = ev[i]; i2 = i; }
            const float e2 = __expf(v2 - v1), w1 = gw / (1.f + e2), w2 = gw * e2 / (1.f + e2);
            const int ea = gs * 8 + i1, eb = gs * 8 + i2;
            const unsigned ra = __hip_atomic_fetch_add(cnt + 64 * ea, 1u, __ATOMIC_RELAXED, __HIP_MEMORY_SCOPE_AGENT);
            const unsigned rb = __hip_atomic_fetch_add(cnt + 64 * eb, 1u, __ATOMIC_RELAXED, __HIP_MEMORY_SCOPE_AGENT);
            const size_t ia = (size_t)ea * T + ra, ib = (size_t)eb * T + rb;
            list[ia] = 2 * row; list[ib] = 2 * row + 1; listw[ia] = w1; listw[ib] = w2; listr[ia] = rstd; listr[ib] = rstd; }
    }
    __syncthreads();
}
__device__ __forceinline__ void phase_tail(const Ptrs& P, LAS unsigned char* lds, volatile LAS unsigned* slot, int ph, int G) {
    unsigned* donew = (unsigned*)(P.ws + WS_CTL) + CW_DONE + 64 * ph;
    __syncthreads();
    if (threadIdx.x == 0) __hip_atomic_fetch_add(donew, 1u, __ATOMIC_RELAXED, __HIP_MEMORY_SCOPE_AGENT);
    cvt_fill(P, lds, slot, 1 << 30, donew, G);
}

__device__ __forceinline__ void naive_attn(const Ptrs& P, const bf16* Q, const bf16* Kb, const bf16* Vb, bf16* MIX, int lane, int gw, int NGW) {
    const float s1 = wave_sum(P.lq1[lane] * P.lk1[lane]), s2 = wave_sum(P.lq2[lane] * P.lk2[lane]);
    const float lam0 = 0.2f, lam = expf(s1) - expf(s2) + lam0;
    const int r16 = lane & 15, c = (lane >> 4) & 1, vh = lane >> 5;
    for (int u = gw; u < 16384; u += NGW) {
        const int bh = u & 63, qb = 255 - (u >> 6), b = bh >> 3, h = bh & 7, i = qb * 16 + r16, jmax = qb * 16 + 15;
        const float sl2 = exp2f(-(float)(h + 1)) * LOG2E; const size_t rowb = (size_t)b * SEQ;
        float q[64], O[64];
        { const u32x4g* qp = (const u32x4g*)(Q + (rowb + i) * 1024 + h * 128 + c * 64);
#pragma unroll
          for (int d8 = 0; d8 < 8; ++d8) { const u32x4g w = qp[d8]; q[8 * d8 + 0] = bflo(w.x); q[8 * d8 + 1] = bfhi(w.x); q[8 * d8 + 2] = bflo(w.y); q[8 * d8 + 3] = bfhi(w.y);
              q[8 * d8 + 4] = bflo(w.z); q[8 * d8 + 5] = bfhi(w.z); q[8 * d8 + 6] = bflo(w.w); q[8 * d8 + 7] = bfhi(w.w); } }
#pragma unroll
        for (int d = 0; d < 64; ++d) O[d] = 0.f;
        float m = -1e30f, l = 0.f;
        for (int j = 0; j <= jmax; ++j) {
            const u32x4g* kp = (const u32x4g*)(Kb + (rowb + j) * 1024 + h * 128 + c * 64); float s = 0.f;
#pragma unroll
            for (int d8 = 0; d8 < 8; ++d8) { const u32x4g w = kp[d8];
                s += q[8 * d8 + 0] * bflo(w.x) + q[8 * d8 + 1] * bfhi(w.x) + q[8 * d8 + 2] * bflo(w.y) + q[8 * d8 + 3] * bfhi(w.y)
                   + q[8 * d8 + 4] * bflo(w.z) + q[8 * d8 + 5] * bfhi(w.z) + q[8 * d8 + 6] * bflo(w.w) + q[8 * d8 + 7] * bfhi(w.w); }
            s += sl2 * (float)(j - i);
            if (j <= i) {
                if (s > m) { const float al = fexp2(m - s); l *= al;
#pragma unroll
                    for (int d = 0; d < 64; ++d) O[d] *= al;
                    m = s; }
                const float p = fexp2(s - m); l += p;
                const u32x4g* vp = (const u32x4g*)(Vb + (rowb + j) * 1024 + h * 128 + vh * 64);
#pragma unroll
                for (int d8 = 0; d8 < 8; ++d8) { const u32x4g w = vp[d8];
                    O[8 * d8 + 0] += p * bflo(w.x); O[8 * d8 + 1] += p * bfhi(w.x); O[8 * d8 + 2] += p * bflo(w.y); O[8 * d8 + 3] += p * bfhi(w.y);
                    O[8 * d8 + 4] += p * bflo(w.z); O[8 * d8 + 5] += p * bfhi(w.z); O[8 * d8 + 6] += p * bflo(w.w); O[8 * d8 + 7] += p * bfhi(w.w); }
            }
        }
        const float il = 1.0f / l; float ss = 0.f;
#pragma unroll
        for (int d = 0; d < 64; ++d) { float o = O[d] * il; const float o2 = __shfl_xor(o, 16); o = o - lam * o2; O[d] = o; ss += o * o; }
        ss += __shfl_xor(ss, 32);
        const float r = (1.0f / sqrtf(ss * (1.0f / 128.0f) + EPS)) * (1.0f - lam0);
        if (c == 0) { u32x4g* op = (u32x4g*)(MIX + (rowb + i) * 2048 + h * 128 + vh * 64); const float* sg = P.subg + vh * 64;
#pragma unroll
            for (int d8 = 0; d8 < 8; ++d8) { u32x4g w; w.x = pk2(O[8 * d8 + 0] * r * sg[8 * d8 + 0], O[8 * d8 + 1] * r * sg[8 * d8 + 1]); w.y = pk2(O[8 * d8 + 2] * r * sg[8 * d8 + 2], O[8 * d8 + 3] * r * sg[8 * d8 + 3]);
                w.z = pk2(O[8 * d8 + 4] * r * sg[8 * d8 + 4], O[8 * d8 + 5] * r * sg[8 * d8 + 5]); w.w = pk2(O[8 * d8 + 6] * r * sg[8 * d8 + 6], O[8 * d8 + 7] * r * sg[8 * d8 + 7]); op[d8] = w; } }
    }
}

typedef float f32x2c __attribute__((ext_vector_type(2)));
__device__ __forceinline__ void conv_phase(const Ptrs& P, const bf16* CA, bf16* MIX, LAS unsigned char* lds, int blk, unsigned* qctr, volatile LAS unsigned* slot) {
    int tid_ = threadIdx.x; asm volatile("" : "+v"(tid_)); const int tid = tid_, lane = tid & 63, wave = __builtin_amdgcn_readfirstlane(tid >> 6);
    LAS unsigned* C = (LAS unsigned*)(lds + RING_OFF);
    f32x2c w[31];
#pragma unroll
    for (int j = 0; j < 31; ++j) w[j] = *(const f32x2c*)(P.cw + j * 1024 + 2 * tid);
    const f32x2c bias = *(const f32x2c*)(P.cb + 2 * tid);
    for (int qi = 0; qi < 8; ++qi) { const int xq = (blk + qi) & 7;
    for (;;) { const int n_ = attn_body::wg_pop(qctr + 64 * xq, slot); if (n_ >= 64) break;
        const int tile = xq + 8 * n_, b = tile >> 6, t0 = (tile & 63) * 64; const size_t rowb = (size_t)b * SEQ;
        const unsigned* up = (const unsigned*)(CA + rowb * 1024 + 2 * tid);
        f32x2c win[38]; unsigned hist[30];
#pragma unroll
        for (int k = 0; k < 30; ++k) { const int t = t0 - 30 + k; hist[k] = (t >= 0) ? up[(size_t)t * 512] : 0u; }
        unsigned nw[8];
#pragma unroll
        for (int i = 0; i < 8; ++i) nw[i] = up[(size_t)(t0 + i) * 512];
#pragma unroll
        for (int k = 0; k < 30; ++k) win[k] = (f32x2c){bflo(hist[k]), bfhi(hist[k])};
#pragma unroll 1
        for (int blk8 = 0; blk8 < 8; ++blk8) {
#pragma unroll
            for (int i = 0; i < 8; ++i) win[30 + i] = (f32x2c){bflo(nw[i]), bfhi(nw[i])};
            if (blk8 < 7) {
#pragma unroll
                for (int i = 0; i < 8; ++i) nw[i] = up[(size_t)(t0 + 8 * (blk8 + 1) + i) * 512];
            }
#pragma unroll
            for (int i = 0; i < 8; ++i) { f32x2c acc = bias;
#pragma unroll
                for (int j = 0; j < 31; ++j) acc = w[j] * win[i + j] + acc;
                C[(8 * blk8 + i) * 512 + tid] = pk2(acc.x, acc.y); }
#pragma unroll
            for (int k = 0; k < 30; ++k) win[k] = win[k + 8];
        }
        __syncthreads();
#pragma unroll 1
        for (int k = 0; k < 8; ++k) { const int rr = wave + 8 * k, t = t0 + rr; const LAS unsigned* row = C + rr * 512;
            const v4u x0 = *(const LAS v4u*)(row + 4 * lane), x1 = *(const LAS v4u*)(row + 256 + 4 * lane);
            float v[16] = {bflo(x0.x), bfhi(x0.x), bflo(x0.y), bfhi(x0.y), bflo(x0.z), bfhi(x0.z), bflo(x0.w), bfhi(x0.w), bflo(x1.x), bfhi(x1.x), bflo(x1.y), bfhi(x1.y), bflo(x1.z), bfhi(x1.z), bflo(x1.w), bfhi(x1.w)};
            float s = 0.f;
#pragma unroll
            for (int i = 0; i < 16; ++i) s += v[i];
            const float mean = wave_sum(s) * (1.0f / 1024.0f); float qq = 0.f;
#pragma unroll
            for (int i = 0; i < 16; ++i) { v[i] -= mean; qq += v[i] * v[i]; }
            const float rstd = 1.0f / sqrtf(wave_sum(qq) * (1.0f / 1024.0f) + EPS);
            float y[16];
#pragma unroll
            for (int i = 0; i < 16; ++i) { const int ch = (i < 8 ? 8 * lane + i : 512 + 8 * lane + (i - 8)); const float z = v[i] * rstd * P.lng[ch] + P.lnb[ch]; y[i] = z / (1.f + __expf(-z)); }
            bf16* op = MIX + (rowb + t) * 2048 + 1024 + 8 * lane;
            v4u o0, o1; o0.x = pk2(y[0], y[1]); o0.y = pk2(y[2], y[3]); o0.z = pk2(y[4], y[5]); o0.w = pk2(y[6], y[7]); o1.x = pk2(y[8], y[9]); o1.y = pk2(y[10], y[11]); o1.z = pk2(y[12], y[13]); o1.w = pk2(y[14], y[15]);
            *(GAS v4u*)op = o0; *(GAS v4u*)(op + 512) = o1; }
        __syncthreads();
    } }
}

__device__ __forceinline__ void router_phase(const Ptrs& P, const bf16* HB, int lane, int gw, int NGW) {
    float* RS2 = (float*)(P.ws + WS_RSTD2); float* WTS = (float*)(P.ws + WS_WTS); int* LIST = (int*)(P.ws + WS_LIST); unsigned* CNT = (unsigned*)(P.ws + WS_CTL) + CW_CNT;
    for (int tok = gw; tok < T; tok += NGW) {
        float hv[32]; const bf16* hp = HB + (size_t)tok * D; float ss = 0.f;
#pragma unroll
        for (int j = 0; j < 4; ++j) { const u32x4g w = *(const u32x4g*)(hp + 8 * lane + 512 * j);
            hv[8 * j + 0] = bflo(w.x); hv[8 * j + 1] = bfhi(w.x); hv[8 * j + 2] = bflo(w.y); hv[8 * j + 3] = bfhi(w.y); hv[8 * j + 4] = bflo(w.z); hv[8 * j + 5] = bfhi(w.z); hv[8 * j + 6] = bflo(w.w); hv[8 * j + 7] = bfhi(w.w); }
#pragma unroll
        for (int k = 0; k < 32; ++k) ss += hv[k] * hv[k];
        ss = wave_sum(ss); const float rstd = 1.0f / sqrtf(ss * (1.0f / D) + EPS);
        float lg[36];
#pragma unroll
        for (int o = 0; o < 36; ++o) lg[o] = 0.f;
#pragma unroll
        for (int j = 0; j < 4; ++j)
#pragma unroll 2
            for (int i = 0; i < 8; ++i) { const int e = 8 * lane + 512 * j + i; const float xv = hv[8 * j + i] * P.g2[e];
                const f32x4* wr = (const f32x4*)(P.wer + (size_t)e * 32); const f32x4 wg = *(const f32x4*)(P.wgr + (size_t)e * 4);
#pragma unroll
                for (int o4 = 0; o4 < 8; ++o4) { const f32x4 w = wr[o4]; lg[4 * o4 + 0] += xv * w.x; lg[4 * o4 + 1] += xv * w.y; lg[4 * o4 + 2] += xv * w.z; lg[4 * o4 + 3] += xv * w.w; }
                lg[32] += xv * wg.x; lg[33] += xv * wg.y; lg[34] += xv * wg.z; lg[35] += xv * wg.w; }
#pragma unroll
        for (int o = 0; o < 36; ++o) lg[o] = wave_sum(lg[o]) * rstd + (o < 32 ? P.ber[o] : P.bgr[o - 32]);
        int gs = 0; float gm = lg[32];
#pragma unroll
        for (int g = 1; g < 4; ++g) if (lg[32 + g] > gm) { gm = lg[32 + g]; gs = g; }
        float gsum = 0.f;
#pragma unroll
        for (int g = 0; g < 4; ++g) gsum += __expf(lg[32 + g] - gm);
        const float gw_ = 1.0f / gsum;
        float ev[8];
#pragma unroll
        for (int i = 0; i < 8; ++i) ev[i] = gs == 0 ? lg[i] : gs == 1 ? lg[8 + i] : gs == 2 ? lg[16 + i] : lg[24 + i];
        int i1 = 0; float v1 = ev[0];
#pragma unroll
        for (int i = 1; i < 8; ++i) if (ev[i] > v1) { v1 = ev[i]; i1 = i; }
        int i2 = -1; float v2 = -3.0e38f;
#pragma unroll
        for (int i = 0; i < 8; ++i) if (i != i1 && ev[i] > v2) { v2 = ev[i]; i2 = i; }
        const float e2 = __expf(v2 - v1), w1 = gw_ / (1.f + e2), w2 = gw_ * e2 / (1.f + e2);
        if (lane == 0) {
            RS2[tok] = rstd;
            const int ea = gs * 8 + i1, eb = gs * 8 + i2;
            const unsigned ra = __hip_atomic_fetch_add(CNT + 64 * ea, 1u, __ATOMIC_RELAXED, __HIP_MEMORY_SCOPE_AGENT);
            const unsigned rb = __hip_atomic_fetch_add(CNT + 64 * eb, 1u, __ATOMIC_RELAXED, __HIP_MEMORY_SCOPE_AGENT);
            LIST[(size_t)ea * T + ra] = 2 * tok; LIST[(size_t)eb * T + rb] = 2 * tok + 1; WTS[2 * tok] = w1; WTS[2 * tok + 1] = w2;
        }
    }
}
__device__ __forceinline__ void moe_tables(const Ptrs& P, LAS unsigned char* lds) {
    int tid = threadIdx.x; asm volatile("" : "+v"(tid));
    LAS int* cntL = (LAS int*)(lds + TAB_OFF); LAS int* ts = cntL + 32; unsigned* CNT = (unsigned*)(P.ws + WS_CTL) + CW_CNT;
    if (tid < 32) cntL[tid] = (int)__hip_atomic_load(CNT + 64 * tid, __ATOMIC_RELAXED, __HIP_MEMORY_SCOPE_AGENT);
    __syncthreads();
    if (tid == 0) { int s = 0; for (int e = 0; e < 32; ++e) { ts[e] = s; s += (cntL[e] + 255) >> 8; } ts[32] = s; }
    __syncthreads();
}

__device__ __forceinline__ float fp8f(unsigned w, int i) { return i == 0 ? __builtin_amdgcn_cvt_f32_fp8(w, 0) : i == 1 ? __builtin_amdgcn_cvt_f32_fp8(w, 1) : i == 2 ? __builtin_amdgcn_cvt_f32_fp8(w, 2) : __builtin_amdgcn_cvt_f32_fp8(w, 3); }
__device__ __forceinline__ void final_phase(const Ptrs& P, const bf16* HB, const unsigned char* Y8, int NGW) {
    int tid_ = threadIdx.x; asm volatile("" : "+v"(tid_)); const int lane = tid_ & 63, gw = (int)blockIdx.x * NWAVES + __builtin_amdgcn_readfirstlane(tid_ >> 6);
    for (int tok = gw; tok < T; tok += NGW) {
        const bf16* hp = HB + (size_t)tok * D; const unsigned char* y1 = Y8 + (size_t)tok * 4096; const unsigned char* y2 = y1 + 2048; float v[32]; float ss = 0.f;
#pragma unroll
        for (int j = 0; j < 4; ++j) { const int o = 8 * lane + 512 * j; const u32x4g a = *(const u32x4g*)(hp + o); const pg8::u32x2 b = *(const pg8::u32x2*)(y1 + o), c = *(const pg8::u32x2*)(y2 + o);
            const float ys = 1.0f / YSCALE;
            v[8 * j + 0] = bflo(a.x) + (fp8f(b.x, 0) + fp8f(c.x, 0)) * ys; v[8 * j + 1] = bfhi(a.x) + (fp8f(b.x, 1) + fp8f(c.x, 1)) * ys; v[8 * j + 2] = bflo(a.y) + (fp8f(b.x, 2) + fp8f(c.x, 2)) * ys; v[8 * j + 3] = bfhi(a.y) + (fp8f(b.x, 3) + fp8f(c.x, 3)) * ys;
            v[8 * j + 4] = bflo(a.z) + (fp8f(b.y, 0) + fp8f(c.y, 0)) * ys; v[8 * j + 5] = bfhi(a.z) + (fp8f(b.y, 1) + fp8f(c.y, 1)) * ys; v[8 * j + 6] = bflo(a.w) + (fp8f(b.y, 2) + fp8f(c.y, 2)) * ys; v[8 * j + 7] = bfhi(a.w) + (fp8f(b.y, 3) + fp8f(c.y, 3)) * ys; }
#pragma unroll
        for (int k = 0; k < 32; ++k) ss += v[k] * v[k];
        ss = wave_sum(ss); const float rstd = 1.0f / sqrtf(ss * (1.0f / D) + EPS);
        float* op = P.out + (size_t)tok * D;
#pragma unroll
        for (int j = 0; j < 4; ++j) { const int o = 8 * lane + 512 * j; const f32x4 g0 = *(const f32x4*)(P.gf + o), g1 = *(const f32x4*)(P.gf + o + 4);
            f32x4 r0 = {v[8 * j + 0] * rstd * g0.x, v[8 * j + 1] * rstd * g0.y, v[8 * j + 2] * rstd * g0.z, v[8 * j + 3] * rstd * g0.w};
            f32x4 r1 = {v[8 * j + 4] * rstd * g1.x, v[8 * j + 5] * rstd * g1.y, v[8 * j + 6] * rstd * g1.z, v[8 * j + 7] * rstd * g1.w};
            *(f32x4*)(op + o) = r0; *(f32x4*)(op + o + 4) = r1; }
    }
}

struct Args { const float* in[22]; float* out; unsigned char* ws; int ph_lo, ph_hi; };
__global__ void __launch_bounds__(NWAVES * 64, 2) fwd(Args args) {
    extern __shared__ __attribute__((aligned(16))) unsigned char lds_raw[];
    LAS unsigned char* lds = (LAS unsigned char*)lds_raw;
    volatile LAS unsigned* MISC = (volatile LAS unsigned*)(lds + MISC_OFF);
    const int tid = threadIdx.x, lane = tid & 63, wave = __builtin_amdgcn_readfirstlane(tid >> 6), G = gridDim.x;
    const int gw = blockIdx.x * NWAVES + wave, NGW = G * NWAVES;
    Ptrs P;
    P.x = args.in[0]; P.g1 = args.in[1]; P.w_in = args.in[2]; P.lq1 = args.in[3]; P.lk1 = args.in[4]; P.lq2 = args.in[5]; P.lk2 = args.in[6]; P.subg = args.in[7];
    P.cw = args.in[8]; P.cb = args.in[9]; P.lng = args.in[10]; P.lnb = args.in[11]; P.w_out = args.in[12]; P.g2 = args.in[13]; P.wgr = args.in[14]; P.bgr = args.in[15];
    P.wer = args.in[16]; P.ber = args.in[17]; P.w_gate = args.in[18]; P.w_up = args.in[19]; P.w_down = args.in[20]; P.gf = args.in[21]; P.out = args.out; P.ws = args.ws;
    unsigned char* ws = args.ws;
#define WIN ((bf16*)(ws + WS_WIN))
#define WOUT ((bf16*)(ws + WS_WOUT))
#define WGU (ws + WS_WGU)
#define WD (ws + WS_WD)
#define XB ((bf16*)(ws + WS_XB))
#define H1 (ws + WS_XB)
#define HB8 (ws + WS_HB8)
#define CGB ((bf16*)(ws + WS_CG))
#define MIX ((bf16*)(ws + WS_MIX))
#define HB ((bf16*)(ws + WS_HB))
#define QB ((bf16*)P.out)
#define KB (QB + (size_t)T * 1024)
#define VB (QB + (size_t)T * 2048)
#define CAB (QB + (size_t)T * 3072)
#define YB ((bf16*)P.out)
#define RELOAD_ARGS() do { const __attribute__((address_space(4))) Args* ka_ = (const __attribute__((address_space(4))) Args*)__builtin_amdgcn_kernarg_segment_ptr(); asm volatile("" : "+s"(ka_)); \
    P.x = ka_->in[0]; P.g1 = ka_->in[1]; P.w_in = ka_->in[2]; P.lq1 = ka_->in[3]; P.lk1 = ka_->in[4]; P.lq2 = ka_->in[5]; P.lk2 = ka_->in[6]; P.subg = ka_->in[7]; \
    P.cw = ka_->in[8]; P.cb = ka_->in[9]; P.lng = ka_->in[10]; P.lnb = ka_->in[11]; P.w_out = ka_->in[12]; P.g2 = ka_->in[13]; P.wgr = ka_->in[14]; P.bgr = ka_->in[15]; \
    P.wer = ka_->in[16]; P.ber = ka_->in[17]; P.w_gate = ka_->in[18]; P.w_up = ka_->in[19]; P.w_down = ka_->in[20]; P.gf = ka_->in[21]; P.out = ka_->out; P.ws = ka_->ws; ws = ka_->ws; } while (0)
    for (int u = tid; u < (LDS_BYTES - LDSCTL_OFF) / 4; u += NWAVES * 64) ((LAS unsigned*)(lds + LDSCTL_OFF))[u] = 0u;
    __syncthreads();
    const int lo = args.ph_lo, hi = args.ph_hi;
    XcdBarrier bar; bar.bar = (unsigned*)(ws + WS_CTL) + CW_BAR; bar.x = 0; bar.st = nullptr;
    if (hi - lo > 1) bar = xcd_barrier_post((unsigned*)(ws + WS_CTL) + CW_BAR, MISC + 8);
#define IN(k) (lo <= (k) && (k) < hi)
#if PROBE_PHASE >= 0
    unsigned long long pst_[NPHASE + 1]; pst_[0] = __builtin_amdgcn_s_memrealtime();
#define SEAM(k) do { if (IN(k) && IN((k) + 1)) xcd_barrier(bar); pst_[(k) + 1] = __builtin_amdgcn_s_memrealtime(); } while (0)
#else
#define SEAM(k) do { if (IN(k) && IN((k) + 1)) xcd_barrier(bar); } while (0)
#endif
#define REP(k) for (int rep_ = 0; rep_ <= ((PROBE_DOUBLE >> (k)) & 1); ++rep_)

    if (IN(0)) REP(0) { p0_prologue(P, lds, lane, wave, gw, NGW); }
    SEAM(0);
#if PROBE_CLOCK
    const long long pc0 = clock64(), pr0 = wall_clock64();
#endif
    if (IN(1)) {
        cvt_fill(P, lds, MISC + 12, (int)((blockIdx.x >> 3) % 8), nullptr, G);
        for (int pass = 0; pass < 2; ++pass) {
            if ((pass ^ (int)(blockIdx.x & 1)) == 0) { pg8::Gemm g{XB, WIN, 1, 3072, D, (unsigned*)(ws + WS_CTL) + 3002}; pg8::DynDense S; S.init(T, 3072, (unsigned*)(ws + WS_CTL) + CW_GQ + 0 * 512, (volatile LAS int*)(MISC + 16), (int)blockIdx.x);
                pg8::EpiIn E{QB, (size_t)T * 1024, CGB, (const float*)(ws + WS_RSTD1), C2, (unsigned*)(ws + WS_CTL) + CW_NMAX, 0, 1.0f};
                pg8::gemm_phase<pg8::EpiIn, pg8::DynDense, true, false>(lds + RING_OFF, g, S, E); }
            else { pg8::Gemm g{(const bf16*)(ws + WS_X8), (const bf16*)(ws + WS_WIN8), 2, 2048, D / 2, (unsigned*)(ws + WS_CTL) + 3002}; pg8::DynDenseG S; S.init(T, 2048, (unsigned*)(ws + WS_CTL) + CW_GQ + 1 * 512, (volatile LAS int*)(MISC + 16), (int)blockIdx.x);
                pg8::EpiGLU E{CAB, (const float*)(ws + WS_RSTD1), 1.0f / WSCALE};
                pg8::gemm_phase<pg8::EpiGLU, pg8::DynDenseG, true, true, true>(lds + RING_OFF, g, S, E); }
        }
#if PROBE_ATT == 6
        if (threadIdx.x == 0) atomicMax((unsigned*)(ws + WS_CTL) + CW_NMAX + 900, (unsigned)(__builtin_amdgcn_s_memrealtime() - pst_[1]));
#endif
#if PROBE_ATT == 7
        if (threadIdx.x == 0) atomicAdd((unsigned*)(ws + WS_CTL) + CW_NMAX + 900, (unsigned)(__builtin_amdgcn_s_memrealtime() - pst_[1]) >> 8);
#endif
#if PROBE_ATT == 5
        if (blockIdx.x == PROBE_BLK && threadIdx.x == 0) atomicAdd((unsigned*)(ws + WS_CTL) + CW_NMAX + 900, (unsigned)(__builtin_amdgcn_s_memrealtime() - pst_[1]));
#endif
        phase_tail(P, lds, MISC + 12, 1, G);
    }
#if PROBE_CLOCK
    if (IN(1) && tid == 0) { const unsigned dt = (unsigned)(wall_clock64() - pr0); atomicAdd((unsigned*)(ws + WS_CTL) + 3000, dt); atomicMax((unsigned*)(ws + WS_CTL) + 3001, dt); }
#endif
    SEAM(1);
    if (IN(2)) {
#if USE_NAIVE_ATTN
        naive_attn(P, QB, KB, VB, MIX, lane, gw, NGW);
#else
        { float s1 = 0.f, s2 = 0.f;
          for (int i = 0; i < 64; ++i) { s1 += P.lq1[i] * P.lk1[i]; s2 += P.lq2[i] * P.lk2[i]; }
          const float lam0 = 0.2f, lam = expf(s1) - expf(s2) + lam0;
          static_assert(attn_body::ATTN_LDS_BYTES <= RING_BYTES, "attention LDS");
          attn_body::attn_phase<8>((char*)lds_raw + RING_OFF, (int)blockIdx.x, (unsigned*)(ws + WS_CTL) + CW_QA, MISC + 12, lam, 1.0f - lam0, P.subg, (const unsigned*)(ws + WS_CTL) + CW_NMAX, (unsigned*)(ws + WS_O1S) + (size_t)blockIdx.x * 16384,
                                   (const attn_body::bf16*)QB, (const attn_body::bf16*)KB, (const attn_body::bf16*)VB, (attn_body::bf16*)MIX); }
        RELOAD_ARGS();
#endif
        conv_phase(P, CAB, MIX, lds, (int)blockIdx.x, (unsigned*)(ws + WS_CTL) + CW_QC, MISC + 12);
#if PROBE_ATT == 2
        if (blockIdx.x == PROBE_BLK && threadIdx.x == 0) atomicAdd((unsigned*)(ws + WS_CTL) + CW_NMAX + 900, (unsigned)(__builtin_amdgcn_s_memrealtime() - pst_[2]));
#endif
        phase_tail(P, lds, MISC + 12, 2, G);
    }
    SEAM(2);
    if (IN(3)) {
        pg8::Gemm g{MIX, WOUT, 3, D, D, (unsigned*)(ws + WS_CTL) + 3002}; pg8::StaticOrder S; S.init(T, D, G, (int)blockIdx.x); S.rep = 1 + ((PROBE_DOUBLE >> 3) & 1);
        pg8::EpiOut E{HB, XB, (float*)(ws + WS_PART), nullptr};
        pg8::gemm_phase<pg8::EpiOut, pg8::StaticOrder, true, false>(lds + RING_OFF, g, S, E);
        phase_tail(P, lds, MISC + 12, 3, G);
    }
    SEAM(3);
#if PROBE_ATT == 9
    if (IN(4) && blockIdx.x == PROBE_BLK && threadIdx.x == 0) atomicAdd((unsigned*)(ws + WS_CTL) + CW_NMAX + 900, 10u * __hip_atomic_load((unsigned*)(ws + WS_CTL) + CW_CVQ, __ATOMIC_RELAXED, __HIP_MEMORY_SCOPE_AGENT));
#endif
#if USE_NAIVE_ROUTER
    if (IN(4)) { router_phase(P, HB, lane, gw, NGW); }
#else
    if (IN(4)) {
        router_skinny(P, HB, HB8, lds, G);
        phase_tail(P, lds, MISC + 12, 4, G);
#if PROBE_ATT == 8
        if (blockIdx.x == PROBE_BLK && threadIdx.x == 0) atomicAdd((unsigned*)(ws + WS_CTL) + CW_NMAX + 900, 10u * __hip_atomic_load((unsigned*)(ws + WS_CTL) + CW_CVQ, __ATOMIC_RELAXED, __HIP_MEMORY_SCOPE_AGENT));
#endif
        cvt_fill(P, lds, MISC + 12, 1 << 30, nullptr, G);
    }
#endif
    SEAM(4);
    if (IN(5)) {
        moe_tables(P, lds);
        pg8::Gemm g{(const bf16*)HB8, (const bf16*)WGU, 5, 2048, D / 2, (unsigned*)(ws + WS_CTL) + 3002};
        pg8::MoeOrder S{(const LAS int*)(lds + TAB_OFF) + 32, (const LAS int*)(lds + TAB_OFF), (const int*)(ws + WS_LIST), G, (int)blockIdx.x, 1, T, (size_t)2048 * 2048, 0};
        pg8::EpiGU E{H1, (const int*)(ws + WS_LIST), (const float*)(ws + WS_LISTR), 1.0f / WSCALE, H1SCALE};
        pg8::gemm_phase<pg8::EpiGU, pg8::MoeOrder, true, true, true>(lds + RING_OFF, g, S, E);
    }
    SEAM(5);
    if (IN(6)) {
        moe_tables(P, lds);
        pg8::Gemm g{(const bf16*)H1, (const bf16*)WD, 6, 2048, 512, (unsigned*)(ws + WS_CTL) + 3002};
        pg8::MoeOrder S{(const LAS int*)(lds + TAB_OFF) + 32, (const LAS int*)(lds + TAB_OFF), (const int*)(ws + WS_LIST), G, (int)blockIdx.x, 0, T, (size_t)2048 * 1024, 1};
        pg8::EpiDown E{ws + WS_MIX, (const int*)(ws + WS_LIST), (const float*)(ws + WS_LISTW), YSCALE / (WSCALE * H1SCALE)};
        pg8::gemm_phase<pg8::EpiDown, pg8::MoeOrder, true, true, true>(lds + RING_OFF, g, S, E);
    }
    SEAM(6);
    if (IN(7)) { final_phase(P, HB, ws + WS_MIX, NGW); }
#if PROBE_ATT
    if (blockIdx.x == 0) { const unsigned long long span = __hip_atomic_load((unsigned*)(ws + WS_CTL) + CW_NMAX + 900, __ATOMIC_RELAXED, __HIP_MEMORY_SCOPE_AGENT); const unsigned long long r1 = __builtin_amdgcn_s_memrealtime(); while (__builtin_amdgcn_s_memrealtime() - r1 < span) __builtin_amdgcn_s_sleep(8); }
#endif
#if PROBE_PHASE >= 0
    pst_[NPHASE] = __builtin_amdgcn_s_memrealtime();
    if (blockIdx.x == 0 && PROBE_PHASE < 100) { const unsigned long long span = pst_[(PROBE_PHASE < 100 ? PROBE_PHASE : 0) + 1] - pst_[PROBE_PHASE < 100 ? PROBE_PHASE : 0]; const unsigned long long r1 = __builtin_amdgcn_s_memrealtime(); while (__builtin_amdgcn_s_memrealtime() - r1 < span) __builtin_amdgcn_s_sleep(8); }
#endif
#if PROBE_KLOOP
    if (blockIdx.x == 0) { const long long pticks = (long long)__hip_atomic_load((unsigned*)(ws + WS_CTL) + 3002, __ATOMIC_RELAXED, __HIP_MEMORY_SCOPE_AGENT); const long long r1 = wall_clock64(); while (wall_clock64() - r1 < pticks) __builtin_amdgcn_s_sleep(8); }
#endif
#if PROBE_CLOCK
    if (blockIdx.x == 0) { const unsigned sum = __hip_atomic_load((unsigned*)(ws + WS_CTL) + 3000, __ATOMIC_RELAXED, __HIP_MEMORY_SCOPE_AGENT), mx = __hip_atomic_load((unsigned*)(ws + WS_CTL) + 3001, __ATOMIC_RELAXED, __HIP_MEMORY_SCOPE_AGENT);
        const long long pticks = (long long)mx - (long long)(sum / (unsigned)G); const long long r1 = wall_clock64(); while (wall_clock64() - r1 < pticks) __builtin_amdgcn_s_sleep(8); }
#endif
#undef IN
#undef SEAM
#undef REP
}

extern "C" void kernel_launch(void* const* d_in, const int* in_sizes, int n_in, void* d_out, int out_size, void* d_ws, size_t ws_size, hipStream_t stream) {
    static int grid = 0;
    if (grid == 0) {
        if (n_in != 22 || in_sizes[0] != T * D || out_size != T * D || ws_size < WS_END) { fprintf(stderr, "kernel_launch: unexpected shapes (n_in %d, in0 %d, out %d, ws %zu); nothing launched\n", n_in, n_in > 0 ? in_sizes[0] : -1, out_size, ws_size); grid = -1; return; }
        int dev = 0, cus = 0, per_cu = 0;
        if (hipGetDevice(&dev) != hipSuccess || hipDeviceGetAttribute(&cus, hipDeviceAttributeMultiprocessorCount, dev) != hipSuccess) { grid = -1; return; }
        if (hipFuncSetAttribute((const void*)fwd, hipFuncAttributeMaxDynamicSharedMemorySize, LDS_BYTES) != hipSuccess) { fprintf(stderr, "kernel_launch: hipFuncSetAttribute failed\n"); grid = -1; return; }
        if (hipOccupancyMaxActiveBlocksPerMultiprocessor(&per_cu, (const void*)fwd, NWAVES * 64, LDS_BYTES) != hipSuccess || per_cu < 1) fprintf(stderr, "kernel_launch: occupancy query reports %d\n", per_cu);
        (void)hipGetLastError();
        grid = cus;
    }
    if (grid < 0) return;
    if (hipMemsetAsync((char*)d_ws + WS_CTL, 0, CTL_ZERO_BYTES, stream) != hipSuccess) return;
    Args a{};
    for (int i = 0; i < 22; ++i) a.in[i] = (const float*)d_in[i];
    a.out = (float*)d_out; a.ws = (unsigned char*)d_ws;
#if MK_ONE_LAUNCH
    a.ph_lo = 0; a.ph_hi = NPHASE;
    hipLaunchKernelGGL(fwd, dim3(grid), dim3(NWAVES * 64), LDS_BYTES, stream, a);
#else
    for (int p = 0; p < NPHASE; ++p) { a.ph_lo = p; a.ph_hi = p + 1; hipLaunchKernelGGL(fwd, dim3(grid), dim3(NWAVES * 64), LDS_BYTES, stream, a); }
#endif
}
```

```cpp
#include <hip/hip_runtime.h>
#include <cstdio>
#include <cstdint>
#ifndef PROBE_KLOOP
#define PROBE_KLOOP 0
#endif
#ifndef PROBE_WHAT
#define PROBE_WHAT 0
#endif
#ifndef PROBE_PHASE
#define PROBE_PHASE -1
#endif
#ifndef PROBE_ATT
#define PROBE_ATT 0
#endif
#ifndef PROBE_BLK
#define PROBE_BLK 0
#endif
namespace pg8 {
#define PG8_LAS __attribute__((address_space(3)))
typedef unsigned short bf16_t;
typedef short bf16x8 __attribute__((ext_vector_type(8)));
typedef float f32x4 __attribute__((ext_vector_type(4)));
typedef unsigned u32x4 __attribute__((ext_vector_type(4)));
constexpr int BM = 256, BK = 64, HALF = 128, HTB = HALF * BK * 2  , STAGE_BYTES = 8 * HTB, NXCD = 8, WGM = 8;

__host__ __device__ __forceinline__ int lds_byte(int r, int c) { const int st = (r >> 4) * 2 + (c >> 5), rr = r & 15, cc = c & 31, ob = rr * 64 + cc * 2; return st * 1024 + (ob ^ (((ob >> 9) & 1) << 5)); }
__host__ __device__ __forceinline__ void stage_rc(int b, int& R, int& C) { const int st = b / 1024, sb = b % 1024, swz = sb ^ (((sb >> 9) & 1) << 5); R = (st >> 1) * 16 + swz / 64; C = (st & 1) * 32 + (swz % 64) / 2; }
__host__ __device__ __forceinline__ int perm32(int rho) { const int n = rho >> 4, i = rho & 15; return 8 * (i >> 2) + 4 * n + (i & 3); }

struct Unit { int pm, pn, e, nvalid, lbase, srow; };
struct Gemm { const bf16_t* A; const bf16_t* Bt; int M, N, K; unsigned* probe = nullptr; };

struct StaticOrder {
    int nM, nN, nwg, G, c, rep = 1;
    __host__ __device__ void init(int M, int N, int G_, int c_) { nM = M / BM; nN = N / BM; nwg = nM * nN; G = G_; c = c_; }
    __host__ __device__ bool next(int i, Unit& u) const {
        long L = (long)i * G + c; if (L >= (long)nwg * rep) return false; L %= nwg;
        int wgid = (int)L; { const int q = nwg / NXCD, r = nwg % NXCD, xcd = wgid % NXCD, off = wgid / NXCD; wgid = (xcd < r ? xcd * (q + 1) : r * (q + 1) + (xcd - r) * q) + off; }
        const int nig = WGM * nN, gid = wgid / nig, fm = gid * WGM, gsz = (nM - fm) < WGM ? (nM - fm) : WGM;
        u.pm = fm + ((wgid % nig) % gsz); u.pn = (wgid % nig) / gsz; return true;
    }
    __device__ __forceinline__ const char* bbase(const Gemm& g, const Unit& u, size_t tstep) const { return (const char*)g.Bt + (size_t)u.pn * tstep; }
    __device__ __forceinline__ unsigned goff(const Unit&, int, int, int) const { return 0u; }
    __device__ __forceinline__ void a_ready(const Unit&) const {}
    __device__ __forceinline__ void done(const Unit&) const {}
};

struct StaticOrderG : StaticOrder {
    __device__ __forceinline__ unsigned goff(const Unit& u, int r, int C, int K) const { return ((unsigned)(u.pm * BM + r) * (unsigned)K + (unsigned)C) * 2u; }
};

struct MoeOrder {
    const PG8_LAS int* tstart; const PG8_LAS int* cnt; const int* list; int G, c, shift, lcap; size_t estride; int sorted;
    __device__ __forceinline__ bool next(int i, Unit& u) const {
        const int ntiles = tstart[32]; const int x = c & 7, k = i * (G >> 3) + (c >> 3); const int rt = 2 * (k >> 1) + (x & 1); if (rt >= ntiles) return false;
        int e = 0;
#pragma unroll
        for (int q = 1; q < 32; ++q) e += (tstart[q] <= rt) ? 1 : 0;
        e = __builtin_amdgcn_readfirstlane(e);
        const int pm = __builtin_amdgcn_readfirstlane(rt - tstart[e]); const int rem = __builtin_amdgcn_readfirstlane(cnt[e]) - 256 * pm;
        u.pm = pm; u.pn = 2 * (x >> 1) + (k & 1); u.e = e; u.nvalid = rem < 256 ? rem : 256; u.lbase = e * lcap + 256 * pm; u.srow = 256 * rt; return true;
    }
    __device__ __forceinline__ const char* bbase(const Gemm& g, const Unit& u, size_t tstep) const { return (const char*)g.Bt + (size_t)u.e * estride + (size_t)u.pn * tstep; }
    __device__ __forceinline__ unsigned goff(const Unit& u, int r, int C, int K) const {
        if (sorted) return ((unsigned)(u.srow + r) * (unsigned)K + (unsigned)C) * 2u;
        const int a = list[u.lbase + (r < u.nvalid ? r : 0)];
        return ((unsigned)(a >> shift) * (unsigned)K + (unsigned)C) * 2u;
    }
    __device__ __forceinline__ void a_ready(const Unit&) const {}
    __device__ __forceinline__ void done(const Unit&) const {}
};

struct DynQ {
    unsigned* ctr; volatile PG8_LAS int* slot; int x0, qi; unsigned pend;
    __device__ __forceinline__ void qinit(unsigned* ctr_, volatile PG8_LAS int* slot_, int bx) { ctr = ctr_; slot = slot_; x0 = bx & 7; qi = 0; pend = 0u;
        if (threadIdx.x == 0) pend = __hip_atomic_fetch_add(ctr + 64 * x0, 1u, __ATOMIC_RELAXED, __HIP_MEMORY_SCOPE_AGENT); }
    template <class SizeF> __device__ __forceinline__ int qnext(int i, const SizeF& size_of) {
        const int par = i & 1;
        if (threadIdx.x == 0) { int res = -1;
            while (qi < 8) { const int x = (x0 + qi) & 7; if (pend < (unsigned)size_of(x)) { res = (x << 24) | (int)pend; break; }
                ++qi; if (qi < 8) pend = __hip_atomic_fetch_add(ctr + 64 * ((x0 + qi) & 7), 1u, __ATOMIC_RELAXED, __HIP_MEMORY_SCOPE_AGENT); }
            slot[par] = res;
            if (res >= 0) pend = __hip_atomic_fetch_add(ctr + 64 * ((x0 + qi) & 7), 1u, __ATOMIC_RELAXED, __HIP_MEMORY_SCOPE_AGENT); }
        asm volatile("s_waitcnt lgkmcnt(0)" ::: "memory"); __builtin_amdgcn_s_barrier(); asm volatile("" ::: "memory");
        return __builtin_amdgcn_readfirstlane(slot[par]);
    }
};
struct DynDense : DynQ {
    int nM, nN, nwg;
    __device__ __forceinline__ void init(int M, int N, unsigned* ctr_, volatile PG8_LAS int* slot_, int bx) { nM = M / BM; nN = N / BM; nwg = nM * nN; qinit(ctr_, slot_, bx); }
    __device__ __forceinline__ bool next(int i, Unit& u) {
        const int q = nwg / NXCD, r = nwg % NXCD;
        const int code = qnext(i, [=](int x) { return q + (x < r ? 1 : 0); }); if (code < 0) return false;
        const int x = code >> 24, k = code & 0xffffff; const int wgid = (x < r ? x * (q + 1) : r * (q + 1) + (x - r) * q) + k;
        const int nig = WGM * nN, gid = wgid / nig, fm = gid * WGM, gsz = (nM - fm) < WGM ? (nM - fm) : WGM;
        u.pm = fm + ((wgid % nig) % gsz); u.pn = (wgid % nig) / gsz; return true;
    }
    __device__ __forceinline__ const char* bbase(const Gemm& g, const Unit& u, size_t tstep) const { return (const char*)g.Bt + (size_t)u.pn * tstep; }
    __device__ __forceinline__ unsigned goff(const Unit&, int, int, int) const { return 0u; }
    __device__ __forceinline__ void a_ready(const Unit&) const {}
    __device__ __forceinline__ void done(const Unit&) const {}
};
struct DynDenseG : DynDense {
    __device__ __forceinline__ unsigned goff(const Unit& u, int r, int C, int K) const { return ((unsigned)(u.pm * BM + r) * (unsigned)K + (unsigned)C) * 2u; }
};

__device__ __forceinline__ unsigned cvt_pk_bf16(float lo, float hi) { unsigned r; asm volatile("v_cvt_pk_bf16_f32 %0, %1, %2" : "=v"(r) : "v"(lo), "v"(hi)); return r; }
__device__ __forceinline__ float bf_lo(unsigned w) { return __builtin_bit_cast(float, w << 16); }
__device__ __forceinline__ float bf_hi(unsigned w) { return __builtin_bit_cast(float, w & 0xffff0000u); }
__device__ __forceinline__ unsigned pk4_fp8(float a, float b, float c, float d) {
    a = __builtin_amdgcn_fmed3f(a, -440.f, 440.f); b = __builtin_amdgcn_fmed3f(b, -440.f, 440.f); c = __builtin_amdgcn_fmed3f(c, -440.f, 440.f); d = __builtin_amdgcn_fmed3f(d, -440.f, 440.f);
    int r = __builtin_amdgcn_cvt_pk_fp8_f32(a, b, 0, false); r = __builtin_amdgcn_cvt_pk_fp8_f32(c, d, r, true); return (unsigned)r; }
typedef unsigned u32x2 __attribute__((ext_vector_type(2)));
__device__ __forceinline__ void swap16(u32x2& a, u32x2& b) { auto r0 = __builtin_amdgcn_permlane16_swap(a.x, b.x, false, false); auto r1 = __builtin_amdgcn_permlane16_swap(a.y, b.y, false, false); a = (u32x2){r0[0], r1[0]}; b = (u32x2){r0[1], r1[1]}; }
typedef int v4i_t __attribute__((ext_vector_type(4)));

struct EpiIn {
    static constexpr bool PERM = true, AFTER_DRAIN = false;
    bf16_t* P0; size_t stride; bf16_t* CG; const float* rstd; float scale0; unsigned* nmax; int tbase; float oscale;
    __device__ __forceinline__ void operator()(const f32x4 (&acc)[2][2][4][2], const Unit& u, int wr, int wc, int fr, int fq) const {
        const int row0 = u.pm * BM + wr * 64 + fr, t = (u.pn >> 2) + tbase; bf16_t* base = (t < 4) ? P0 + (size_t)t * stride : CG;
        const float sc = ((t == 0) ? scale0 : 1.f) * oscale; const int col0 = (u.pn & 3) * BM + wc * 32 + 8 * fq;
        float mx[2] = {0.f, 0.f}; float rsv[2][4];
#pragma unroll
        for (int ai = 0; ai < 2; ++ai)
#pragma unroll
            for (int m = 0; m < 4; ++m) rsv[ai][m] = rstd[row0 + ai * HALF + m * 16];
#pragma unroll
        for (int ai = 0; ai < 2; ++ai)
#pragma unroll
            for (int m = 0; m < 4; ++m) { const int row = row0 + ai * HALF + m * 16; const float rs = rsv[ai][m] * sc; bf16_t* rowp = base + (size_t)row * 1024 + col0;
#pragma unroll
                for (int bj = 0; bj < 2; ++bj) { const f32x4 v0 = acc[ai][bj][m][0] * rs, v1 = acc[ai][bj][m][1] * rs;
                    u32x4 w; w.x = cvt_pk_bf16(v0[0], v0[1]); w.y = cvt_pk_bf16(v0[2], v0[3]); w.z = cvt_pk_bf16(v1[0], v1[1]); w.w = cvt_pk_bf16(v1[2], v1[3]);
                    *(u32x4*)(rowp + bj * HALF) = w;
                    if (t < 2) { float ss = (v0[0] * v0[0] + v0[1] * v0[1]) + (v0[2] * v0[2] + v0[3] * v0[3]) + (v1[0] * v1[0] + v1[1] * v1[1]) + (v1[2] * v1[2] + v1[3] * v1[3]);
                        ss += __shfl_xor(ss, 16); ss += __shfl_xor(ss, 32); mx[bj] = __builtin_fmaxf(mx[bj], ss); } } }
        if (t < 2) {
#pragma unroll
            for (int bj = 0; bj < 2; ++bj) { float v = mx[bj];
                v = __builtin_fmaxf(v, __shfl_xor(v, 1)); v = __builtin_fmaxf(v, __shfl_xor(v, 2)); v = __builtin_fmaxf(v, __shfl_xor(v, 4)); v = __builtin_fmaxf(v, __shfl_xor(v, 8));
                const int colb = (u.pn & 3) * BM + bj * HALF + wc * 32, g64 = colb >> 6, bh = (u.pm >> 4) * 8 + (g64 >> 1);
                if (fr == 0 && fq == 0) atomicMax(nmax + ((t * 64 + bh) * 2 + (g64 & 1)) * 2 + (wc & 1), __builtin_bit_cast(unsigned, v)); }
        }
    }
};
struct EpiGLU {
    static constexpr bool PERM = true, AFTER_DRAIN = false;
    bf16_t* U; const float* rstd; float oscale;
    __device__ __forceinline__ void operator()(const f32x4 (&acc)[2][2][4][2], const Unit& u, int wr, int wc, int fr, int fq) const {
        const int row0 = u.pm * BM + wr * 64 + fr, col0 = u.pn * HALF + wc * 32 + 8 * fq; float rsv[2][4];
#pragma unroll
        for (int ai = 0; ai < 2; ++ai)
#pragma unroll
            for (int m = 0; m < 4; ++m) rsv[ai][m] = rstd[row0 + ai * HALF + m * 16];
#pragma unroll
        for (int ai = 0; ai < 2; ++ai)
#pragma unroll
            for (int m = 0; m < 4; ++m) { const int row = row0 + ai * HALF + m * 16; const float rs = rsv[ai][m] * oscale;
                const f32x4 a0 = acc[ai][0][m][0] * rs, a1 = acc[ai][0][m][1] * rs, g0 = acc[ai][1][m][0] * rs, g1 = acc[ai][1][m][1] * rs;
#define PG8_SG(x) __builtin_amdgcn_rcpf(1.f + __builtin_amdgcn_exp2f(-1.4426950408889634f * (x)))
                u32x4 w; w.x = cvt_pk_bf16(a0[0] * PG8_SG(g0[0]), a0[1] * PG8_SG(g0[1])); w.y = cvt_pk_bf16(a0[2] * PG8_SG(g0[2]), a0[3] * PG8_SG(g0[3]));
                w.z = cvt_pk_bf16(a1[0] * PG8_SG(g1[0]), a1[1] * PG8_SG(g1[1])); w.w = cvt_pk_bf16(a1[2] * PG8_SG(g1[2]), a1[3] * PG8_SG(g1[3]));
#undef PG8_SG
                *(u32x4*)(U + (size_t)row * 1024 + col0) = w; }
    }
};
struct EpiOut {
    static constexpr bool PERM = true, AFTER_DRAIN = false;
    bf16_t* H; const bf16_t* XB; float* part; unsigned char* H8;
    __device__ __forceinline__ void operator()(const f32x4 (&acc)[2][2][4][2], const Unit& u, int wr, int wc, int fr, int fq) const {
        const int row0 = u.pm * BM + wr * 64 + fr, col0 = u.pn * BM + wc * 32 + 8 * fq;
#pragma unroll
        for (int ai = 0; ai < 2; ++ai) { u32x4 xbv[4][2];
#pragma unroll
            for (int m = 0; m < 4; ++m)
#pragma unroll
                for (int bj = 0; bj < 2; ++bj) xbv[m][bj] = *(const u32x4*)(XB + (size_t)(row0 + ai * HALF + m * 16) * 2048 + col0 + bj * HALF);
#pragma unroll
            for (int m = 0; m < 4; ++m) { const int row = row0 + ai * HALF + m * 16; const size_t off = (size_t)row * 2048 + col0; float ss = 0.f;
#pragma unroll
                for (int bj = 0; bj < 2; ++bj) { const u32x4 xb = xbv[m][bj];
                    f32x4 v0 = acc[ai][bj][m][0], v1 = acc[ai][bj][m][1];
                    v0[0] += bf_lo(xb.x); v0[1] += bf_hi(xb.x); v0[2] += bf_lo(xb.y); v0[3] += bf_hi(xb.y); v1[0] += bf_lo(xb.z); v1[1] += bf_hi(xb.z); v1[2] += bf_lo(xb.w); v1[3] += bf_hi(xb.w);
                    ss += (v0[0] * v0[0] + v0[1] * v0[1]) + (v0[2] * v0[2] + v0[3] * v0[3]) + (v1[0] * v1[0] + v1[1] * v1[1]) + (v1[2] * v1[2] + v1[3] * v1[3]);
                    u32x4 w; w.x = cvt_pk_bf16(v0[0], v0[1]); w.y = cvt_pk_bf16(v0[2], v0[3]); w.z = cvt_pk_bf16(v1[0], v1[1]); w.w = cvt_pk_bf16(v1[2], v1[3]);
                    *(u32x4*)(H + off + bj * HALF) = w;
                    if (H8) { u32x2 w8; w8.x = pk4_fp8(v0[0], v0[1], v0[2], v0[3]); w8.y = pk4_fp8(v1[0], v1[1], v1[2], v1[3]); *(u32x2*)(H8 + off + bj * HALF) = w8; } }
                ss += __shfl_xor(ss, 16); ss += __shfl_xor(ss, 32);
                if (fq == 0) part[(size_t)row * 32 + u.pn * 4 + wc] = ss; } }
    }
};
__device__ __forceinline__ float silu_f(float x) { return x * __builtin_amdgcn_rcpf(1.f + __builtin_amdgcn_exp2f(-1.4426950408889634f * x)); }
struct EpiGU {
    static constexpr bool PERM = true, AFTER_DRAIN = false;
    unsigned char* H1; const int* list; const float* listr; float wscale, oscale;
    __device__ __forceinline__ void operator()(const f32x4 (&acc)[2][2][4][2], const Unit& u, int wr, int wc, int fr, int fq) const {
        const int col0 = u.pn * HALF + wc * 32 + 8 * fq;
        float rsv[2][4];
#pragma unroll
        for (int ai = 0; ai < 2; ++ai)
#pragma unroll
            for (int m = 0; m < 4; ++m) { const int r = ai * HALF + wr * 64 + m * 16 + fr; rsv[ai][m] = listr[u.lbase + (r < u.nvalid ? r : 0)]; }
#pragma unroll
        for (int ai = 0; ai < 2; ++ai)
#pragma unroll
            for (int mp = 0; mp < 4; mp += 2) { u32x2 wv[2];
#pragma unroll
                for (int q = 0; q < 2; ++q) { const int m = mp + q; const float rs = rsv[ai][m] * wscale;
                    const f32x4 g0 = acc[ai][0][m][0] * rs, g1 = acc[ai][0][m][1] * rs, u0 = acc[ai][1][m][0] * (rs * oscale), u1 = acc[ai][1][m][1] * (rs * oscale);
                    wv[q].x = pk4_fp8(silu_f(g0[0]) * u0[0], silu_f(g0[1]) * u0[1], silu_f(g0[2]) * u0[2], silu_f(g0[3]) * u0[3]);
                    wv[q].y = pk4_fp8(silu_f(g1[0]) * u1[0], silu_f(g1[1]) * u1[1], silu_f(g1[2]) * u1[2], silu_f(g1[3]) * u1[3]); }
                swap16(wv[0], wv[1]);
                const int odd = fq & 1, r = ai * HALF + wr * 64 + (mp + odd) * 16 + fr;
                if (r < u.nvalid) { const u32x4 w = {wv[0].x, wv[0].y, wv[1].x, wv[1].y};
                    *(u32x4*)(H1 + (size_t)(u.srow + r) * 1024 + col0 - 8 * odd) = w; } }
    }
};
struct EpiDown {
    static constexpr bool PERM = true, AFTER_DRAIN = false;
    unsigned char* Y; const int* list; const float* listw; float oscale;
    __device__ __forceinline__ void operator()(const f32x4 (&acc)[2][2][4][2], const Unit& u, int wr, int wc, int fr, int fq) const {
        const int col0 = u.pn * BM + wc * 32 + 8 * fq;
        int av[2][4]; float wv[2][4];
#pragma unroll
        for (int ai = 0; ai < 2; ++ai)
#pragma unroll
            for (int m = 0; m < 4; ++m) { const int r = ai * HALF + wr * 64 + m * 16 + fr, ix = u.lbase + (r < u.nvalid ? r : 0); av[ai][m] = list[ix]; wv[ai][m] = listw[ix]; }
#pragma unroll
        for (int ai = 0; ai < 2; ++ai)
#pragma unroll
            for (int m = 0; m < 4; ++m) { const int r = ai * HALF + wr * 64 + m * 16 + fr; const int a = av[ai][m]; const float ws = wv[ai][m] * oscale;
                u32x2 w0, w1;
                { const f32x4 v0 = acc[ai][0][m][0] * ws, v1 = acc[ai][0][m][1] * ws; w0.x = pk4_fp8(v0[0], v0[1], v0[2], v0[3]); w0.y = pk4_fp8(v1[0], v1[1], v1[2], v1[3]); }
                { const f32x4 v0 = acc[ai][1][m][0] * ws, v1 = acc[ai][1][m][1] * ws; w1.x = pk4_fp8(v0[0], v0[1], v0[2], v0[3]); w1.y = pk4_fp8(v1[0], v1[1], v1[2], v1[3]); }
                swap16(w0, w1);
                if (r < u.nvalid) { const int odd = fq & 1; const u32x4 w = {w0.x, w0.y, w1.x, w1.y};
                    *(u32x4*)(Y + (size_t)a * 2048 + col0 + (odd ? HALF - 8 : 0)) = w; } }
    }
};
struct EpiRouter {
    static constexpr bool PERM = true, AFTER_DRAIN = false;
    const float* part; const float* ber; const float* bgr; float* listr; float* listw; int* list; unsigned* cnt; int lcap;
    __device__ __forceinline__ void operator()(const f32x4 (&acc)[2][2][4][2], const Unit& u, int wr, int wc, int fr, int fq) const {
        if (wc != 0) return;
#pragma unroll
        for (int ai = 0; ai < 2; ++ai)
#pragma unroll
            for (int m = 0; m < 4; ++m) { const int row = u.pm * BM + ai * HALF + wr * 64 + m * 16 + fr;
                const f32x4 p0 = *(const f32x4*)(part + (size_t)row * 32 + 8 * fq), p1 = *(const f32x4*)(part + (size_t)row * 32 + 8 * fq + 4);
                float ss = ((p0[0] + p0[1]) + (p0[2] + p0[3])) + ((p1[0] + p1[1]) + (p1[2] + p1[3]));
                ss += __shfl_xor(ss, 16); ss += __shfl_xor(ss, 32);
                const float rstd = 1.0f / sqrtf(ss * (1.0f / 2048.0f) + 1e-6f);
                const f32x4 gl = acc[ai][1][m][0]; float g[4];
#pragma unroll
                for (int i = 0; i < 4; ++i) g[i] = __shfl(gl[i], fr) * rstd + bgr[i];
                int gs = 0; float gm = g[0];
#pragma unroll
                for (int i = 1; i < 4; ++i) if (g[i] > gm) { gm = g[i]; gs = i; }
                float gsum = 0.f;
#pragma unroll
                for (int i = 0; i < 4; ++i) gsum += __expf(g[i] - gm);
                const float gw = 1.0f / gsum;
                if (fq == gs) { float ev[8];
#pragma unroll
                    for (int i = 0; i < 4; ++i) { ev[i] = acc[ai][0][m][0][i] * rstd + ber[8 * fq + i]; ev[4 + i] = acc[ai][0][m][1][i] * rstd + ber[8 * fq + 4 + i]; }
                    int i1 = 0; float v1 = ev[0];
#pragma unroll
                    for (int i = 1; i < 8; ++i) if (ev[i] > v1) { v1 = ev[i]; i1 = i; }
                    int i2 = -1; float v2 = -3.0e38f;
#pragma unroll
                    for (int i = 0; i < 8; ++i) if (i != i1 && ev[i] > v2) { v2 = ev[i]; i2 = i; }
                    const float e2 = __expf(v2 - v1), w1 = gw / (1.f + e2), w2 = gw * e2 / (1.f + e2);
                    const int ea = gs * 8 + i1, eb = gs * 8 + i2;
                    const unsigned ra = __hip_atomic_fetch_add(cnt + 64 * ea, 1u, __ATOMIC_RELAXED, __HIP_MEMORY_SCOPE_AGENT);
                    const unsigned rb = __hip_atomic_fetch_add(cnt + 64 * eb, 1u, __ATOMIC_RELAXED, __HIP_MEMORY_SCOPE_AGENT);
                    const size_t ia = (size_t)ea * lcap + ra, ib = (size_t)eb * lcap + rb;
                    list[ia] = 2 * row; list[ib] = 2 * row + 1; listw[ia] = w1; listw[ib] = w2; listr[ia] = rstd; listr[ib] = rstd; } }
    }
};

template <class Epi, class Sched, bool ALIGN_EPI, bool GATHER, bool FP8 = false>
__device__ __forceinline__ void gemm_phase(PG8_LAS unsigned char* lds, const Gemm g, Sched& S, const Epi& E) {
    int tid_ = threadIdx.x; asm volatile("" : "+v"(tid_));
    const int tid = tid_, wid = __builtin_amdgcn_readfirstlane(tid >> 6), lane = tid & 63, wr = wid >> 2, wc = wid & 3, fr = lane & 15, fq = lane >> 4;
    const int K = g.K, nt = K / BK;
    unsigned voffA[2], voffB[2]; int RA[2], CA[2];
#pragma unroll
    for (int i = 0; i < 2; ++i) { int R, C; stage_rc(tid * 16 + i * 8192, R, C); const int Rb = Epi::PERM ? ((R & ~31) + perm32(R & 31)) : R;
        voffA[i] = (unsigned)(R * K + C) * 2u; voffB[i] = (unsigned)(Rb * K + C) * 2u; RA[i] = R; CA[i] = C; }
    const size_t kstep = (size_t)(BK * 2);
    const size_t hstep = (size_t)HALF * K * 2;
    const size_t tstep = 2 * hstep;
    const unsigned ldsw = (unsigned)wid * 1024u;
    const int aoff = lds_byte(wr * 64 + fr, fq * 8), boff = lds_byte(wc * 32 + fr, fq * 8);
#define PG8_SA(b, h) (((b) * 2 + (h)) * HTB)
#define PG8_SB(b, h) ((4 + (b) * 2 + (h)) * HTB)
#define PG8_STAGE(bufoff, gbase, voff) do { _Pragma("unroll") for (int _i = 0; _i < 2; ++_i) \
        __builtin_amdgcn_global_load_lds((const unsigned*)((const char*)(gbase) + (voff)[_i]), (PG8_LAS unsigned*)(lds + (bufoff) + ldsw + _i * 8192), 16, 0, 0); } while (0)
#define PG8_STAGE_A(bufoff, kp, h) do { if constexpr (GATHER) { PG8_STAGE(bufoff, kp, cgo[h]); } else { PG8_STAGE(bufoff, (kp) + (h) * hstep, voffA); } } while (0)
#define PG8_LDA(dst, b, h) do { _Pragma("unroll") for (int m = 0; m < 4; ++m) _Pragma("unroll") for (int k = 0; k < 2; ++k) dst[m][k] = *(const PG8_LAS bf16x8*)(lds + PG8_SA(b, h) + aoff + m * 2048 + k * 1024); } while (0)
#define PG8_LDB(dst, b, h) do { _Pragma("unroll") for (int n = 0; n < 2; ++n) _Pragma("unroll") for (int k = 0; k < 2; ++k) dst[n][k] = *(const PG8_LAS bf16x8*)(lds + PG8_SB(b, h) + boff + n * 2048 + k * 1024); } while (0)
#define PG8_CAT(x, y) __builtin_shufflevector(__builtin_bit_cast(v4i_t, x), __builtin_bit_cast(v4i_t, y), 0, 1, 2, 3, 4, 5, 6, 7)
#define PG8_MMA(ai, bj, At, Bt) do { __builtin_amdgcn_s_setprio(1); \
        if constexpr (FP8) { _Pragma("unroll") for (int m = 0; m < 4; ++m) _Pragma("unroll") for (int n = 0; n < 2; ++n) \
            acc[ai][bj][m][n] = __builtin_amdgcn_mfma_scale_f32_16x16x128_f8f6f4(PG8_CAT(Bt[n][0], Bt[n][1]), PG8_CAT(At[m][0], At[m][1]), acc[ai][bj][m][n], 0, 0, 0, 0, 0, 0); } \
        else { _Pragma("unroll") for (int m = 0; m < 4; ++m) _Pragma("unroll") for (int n = 0; n < 2; ++n) _Pragma("unroll") for (int k = 0; k < 2; ++k) \
            acc[ai][bj][m][n] = __builtin_amdgcn_mfma_f32_16x16x32_bf16(Bt[n][k], At[m][k], acc[ai][bj][m][n], 0, 0, 0); } \
        __builtin_amdgcn_s_setprio(0); } while (0)
#define PG8_WAIT_V(n) asm volatile("s_waitcnt vmcnt(" #n ")" ::: "memory")
#define PG8_WAIT_L(n) asm volatile("s_waitcnt lgkmcnt(" #n ")" ::: "memory")
#define PG8_BAR __builtin_amdgcn_s_barrier()
#define PG8_SCHED __builtin_amdgcn_sched_barrier(0)
    Unit cur, nxt; int ui = 0;
#if PROBE_KLOOP
    unsigned pk_acc_ = 0u;
#endif
    if (!S.next(0, cur)) return;
    f32x4 acc[2][2][4][2];
#pragma unroll
    for (int a = 0; a < 2; ++a)
#pragma unroll
        for (int b = 0; b < 2; ++b)
#pragma unroll
            for (int m = 0; m < 4; ++m)
#pragma unroll
                for (int n = 0; n < 2; ++n) acc[a][b][m][n] = (f32x4){0.f, 0.f, 0.f, 0.f};
    bf16x8 At[4][2], B0[2][2], B1[2][2];
    unsigned cgo[2][2] = {{0u, 0u}, {0u, 0u}}, ngo[2][2] = {{0u, 0u}, {0u, 0u}};
    if constexpr (GATHER) {
#pragma unroll
        for (int h = 0; h < 2; ++h)
#pragma unroll
            for (int i = 0; i < 2; ++i) cgo[h][i] = S.goff(cur, h * HALF + RA[i], CA[i], K);
    }
    const char* cA = GATHER ? (const char*)g.A : (const char*)g.A + (size_t)cur.pm * tstep; const char* cB = S.bbase(g, cur, tstep);
    S.a_ready(cur);
    PG8_STAGE(PG8_SB(0, 0), cB, voffB); PG8_STAGE(PG8_SB(0, 1), cB + hstep, voffB); PG8_STAGE_A(PG8_SA(0, 0), cA, 0); PG8_STAGE_A(PG8_SA(0, 1), cA, 1);
    if (wr == 1) PG8_BAR;
    PG8_WAIT_V(2); PG8_BAR;
    PG8_STAGE(PG8_SB(1, 0), cB + kstep, voffB); PG8_STAGE_A(PG8_SA(1, 0), cA + kstep, 0); PG8_STAGE(PG8_SB(1, 1), cB + hstep + kstep, voffB);
    PG8_WAIT_V(6); PG8_BAR;
    for (;;) {
        const bool has_next = S.next(ui + 1, nxt);
        if constexpr (GATHER) {
            if (has_next) {
#pragma unroll
                for (int h = 0; h < 2; ++h)
#pragma unroll
                    for (int i = 0; i < 2; ++i) ngo[h][i] = S.goff(nxt, h * HALF + RA[i], CA[i], K);
            } else {
#pragma unroll
                for (int h = 0; h < 2; ++h)
#pragma unroll
                    for (int i = 0; i < 2; ++i) ngo[h][i] = cgo[h][i];
            }
        }
        const char* nA = GATHER ? (const char*)g.A : (has_next ? (const char*)g.A + (size_t)nxt.pm * tstep : cA); const char* nB = has_next ? S.bbase(g, nxt, tstep) : cB;
#if PROBE_KLOOP
        const unsigned long long pk0_ = __builtin_amdgcn_s_memrealtime();
#endif
        for (int t = 0; t < nt; t += 2) {
            const bool last = (t == nt - 2);
            const char* a1 = cA + (size_t)(t + 1) * kstep;
            const char* a2 = last ? nA : cA + (size_t)(t + 2) * kstep; const char* b2 = last ? nB : cB + (size_t)(t + 2) * kstep;
            const char* a3 = a2 + kstep; const char* b3 = b2 + kstep;
            if (last && has_next) S.a_ready(nxt);
            PG8_LDB(B0, 0, 0); PG8_LDB(B1, 0, 1); PG8_SCHED; PG8_LDA(At, 0, 0); PG8_STAGE_A(PG8_SA(1, 1), a1, 1);
            if constexpr (GATHER) { if (last) {
#pragma unroll
                for (int h = 0; h < 2; ++h)
#pragma unroll
                    for (int i = 0; i < 2; ++i) cgo[h][i] = ngo[h][i]; } }
            PG8_WAIT_V(8); PG8_WAIT_L(0); PG8_BAR; PG8_MMA(0, 0, At, B0); PG8_MMA(0, 1, At, B1); PG8_BAR; PG8_SCHED;
            PG8_LDA(At, 0, 1); PG8_STAGE(PG8_SB(0, 0), b2, voffB); PG8_STAGE(PG8_SB(0, 1), b2 + hstep, voffB); PG8_STAGE_A(PG8_SA(0, 0), a2, 0);
            PG8_WAIT_V(8); PG8_WAIT_L(0); PG8_BAR; PG8_MMA(1, 0, At, B0); PG8_MMA(1, 1, At, B1); PG8_BAR; PG8_SCHED;
            PG8_LDB(B0, 1, 0); PG8_LDB(B1, 1, 1); PG8_SCHED; PG8_LDA(At, 1, 0); PG8_STAGE_A(PG8_SA(0, 1), a2, 1);
            PG8_WAIT_V(8); PG8_WAIT_L(0); PG8_BAR; PG8_MMA(0, 0, At, B0); PG8_MMA(0, 1, At, B1); PG8_BAR; PG8_SCHED;
            PG8_LDA(At, 1, 1); PG8_STAGE(PG8_SB(1, 0), b3, voffB); PG8_STAGE(PG8_SB(1, 1), b3 + hstep, voffB); PG8_STAGE_A(PG8_SA(1, 0), a3, 0);
            PG8_WAIT_V(8); PG8_WAIT_L(0); PG8_BAR; PG8_MMA(1, 0, At, B0); PG8_MMA(1, 1, At, B1); PG8_BAR; PG8_SCHED;
        }
#if PROBE_KLOOP
        const unsigned long long pk1_ = __builtin_amdgcn_s_memrealtime(); if (PROBE_WHAT == 0) pk_acc_ += (unsigned)(pk1_ - pk0_);
#endif
        if constexpr (ALIGN_EPI) { if (wr == 0) PG8_BAR; }
#if PROBE_KLOOP
        const unsigned long long pk2_ = __builtin_amdgcn_s_memrealtime(); if (PROBE_WHAT == 1) pk_acc_ += (unsigned)(pk2_ - pk1_);
#endif
        E(acc, cur, wr, wc, fr, fq); S.done(cur);
#if PROBE_KLOOP
        asm volatile("s_waitcnt vmcnt(0)" ::: "memory"); if (PROBE_WHAT == 2) pk_acc_ += (unsigned)(__builtin_amdgcn_s_memrealtime() - pk2_);
#endif
        if (!has_next) break;
#pragma unroll
        for (int a = 0; a < 2; ++a)
#pragma unroll
            for (int b = 0; b < 2; ++b)
#pragma unroll
                for (int m = 0; m < 4; ++m)
#pragma unroll
                    for (int n = 0; n < 2; ++n) acc[a][b][m][n] = (f32x4){0.f, 0.f, 0.f, 0.f};
        cur = nxt; cA = nA; cB = nB; ++ui;
        if constexpr (ALIGN_EPI) { if (wr == 1) PG8_BAR; }
    }
#if PROBE_KLOOP
    if (blockIdx.x == PROBE_BLK && tid == 0 && g.M == PROBE_KLOOP) atomicAdd(g.probe, pk_acc_);
#endif
    PG8_WAIT_V(0);
    if constexpr (!ALIGN_EPI) { if (wr == 0) PG8_BAR; }
    PG8_BAR;
#undef PG8_SA
#undef PG8_SB
#undef PG8_STAGE
#undef PG8_STAGE_A
#undef PG8_LDA
#undef PG8_LDB
#undef PG8_MMA
#undef PG8_CAT
#undef PG8_WAIT_V
#undef PG8_WAIT_L
#undef PG8_BAR
#undef PG8_SCHED
}
}
#include <hip/hip_bf16.h>
#include <cmath>
namespace attn_body {
using bf16=__hip_bfloat16;
using bf16x8=__attribute__((ext_vector_type(8)))short;
using s16x4=__attribute__((ext_vector_type(4)))short;
using f32x16=__attribute__((ext_vector_type(16)))float;
using u32x4=__attribute__((ext_vector_type(4)))unsigned;
constexpr int BATCH=8,SEQ=4096,D=64,DM=1024;
constexpr int NW=8,QBLK=32,QB=QBLK*NW,KVBLK=64,NQB=SEQ/QB;
__device__ __forceinline__ int crow(int r,int hi){return (r&3)+8*(r>>2)+4*hi;}
#define SBAR() __builtin_amdgcn_sched_barrier(0)
__device__ __forceinline__ void cmask(f32x16&p0,f32x16&p1,int jb,int qrel,int hi){
  const float NEG=-INFINITY; const int lim=qrel-64*jb-4*hi;
  #pragma unroll
  for(int r=0;r<16;++r){const int cr=(r&3)+8*(r>>2); if(cr>lim)p0[r]=NEG; if(cr+32>lim)p1[r]=NEG;}
}

constexpr int NSLOT=3, SLOTB=8192;
constexpr int LDS_K=0, LDS_V=NSLOT*SLOTB, LDS_WS=3*NSLOT*SLOTB, LDS_OST=LDS_WS+NW*64*4, LDS_BYTES=LDS_OST+NW*4096;
__device__ __forceinline__ void glds16(const void*sbase,unsigned voff,unsigned lds_dst){unsigned keep;
  asm volatile("s_mov_b32 %0, m0\n\ts_mov_b32 m0, %3\n\ts_nop 0\n\tglobal_load_lds_dwordx4 %1, %2\n\ts_mov_b32 m0, %0":"=&s"(keep):"v"(voff),"s"(sbase),"s"(lds_dst):"memory");}
__device__ __forceinline__ float max3f(float a,float b,float c){float r;asm("v_max3_f32 %0, %1, %2, %3":"=v"(r):"v"(a),"v"(b),"v"(c));return r;}
__device__ __forceinline__ float max2f(float a,float b){float r;asm("v_max_f32_e32 %0, %1, %2":"=v"(r):"v"(a),"v"(b));return r;}
__device__ __forceinline__ float fsub_s(float a,float b){float r;asm("v_sub_f32_e32 %0, %1, %2":"=v"(r):"v"(a),"v"(b));return r;}
typedef float f32x2_t __attribute__((ext_vector_type(2))); typedef __bf16 bf16x2_t __attribute__((ext_vector_type(2)));
__device__ __forceinline__ unsigned cvtpk_s(float lo,float hi){f32x2_t v={lo,hi};bf16x2_t b=__builtin_convertvector(v,bf16x2_t);return __builtin_bit_cast(unsigned,b);}
#define WAIT_BAR(N) asm volatile("s_waitcnt vmcnt(" #N ") lgkmcnt(0)\n\ts_barrier":::"memory")
#define MFMA32(a,b,c) __builtin_amdgcn_mfma_f32_32x32x16_bf16(a,b,c,0,0,0)

__device__ __forceinline__ void qkt(f32x16&p0,f32x16&p1,const char*Kslot,const bf16x8*qr,int r32,int hi){
  const char*kb=Kslot+hi*1024+r32*16;
  #pragma unroll
  for(int d0=0;d0<4;++d0){
    const bf16x8 b0=*reinterpret_cast<const bf16x8*>(kb+d0*2048);
    const bf16x8 b1=*reinterpret_cast<const bf16x8*>(kb+d0*2048+512);
    p0=MFMA32(b0,qr[d0],p0);p1=MFMA32(b1,qr[d0],p1);}
}
typedef __attribute__((address_space(3))) const char* lds_cptr;
typedef short v4i16_t __attribute__((ext_vector_type(4)));
__device__ __forceinline__ void kload8(bf16x8*kf,lds_cptr kp){
  kf[0]=*(const __attribute__((address_space(3))) bf16x8*)(kp);      kf[1]=*(const __attribute__((address_space(3))) bf16x8*)(kp+512);
  kf[2]=*(const __attribute__((address_space(3))) bf16x8*)(kp+2048); kf[3]=*(const __attribute__((address_space(3))) bf16x8*)(kp+2560);
  kf[4]=*(const __attribute__((address_space(3))) bf16x8*)(kp+4096); kf[5]=*(const __attribute__((address_space(3))) bf16x8*)(kp+4608);
  kf[6]=*(const __attribute__((address_space(3))) bf16x8*)(kp+6144); kf[7]=*(const __attribute__((address_space(3))) bf16x8*)(kp+6656);
}
__device__ __forceinline__ void kload2(bf16x8*kf,lds_cptr kp,int j){ kf[2*j]=*(const __attribute__((address_space(3))) bf16x8*)(kp+j*2048); kf[2*j+1]=*(const __attribute__((address_space(3))) bf16x8*)(kp+j*2048+512); }
__device__ __forceinline__ s16x4 vtr(lds_cptr p){ return __builtin_bit_cast(s16x4,__builtin_amdgcn_ds_read_tr16_b64_v4i16((__attribute__((address_space(3))) v4i16_t*)p)); }
__device__ __forceinline__ float rowmax(const f32x16&p0,const f32x16&p1){
  float a=max3f(p0[0],p0[1],p1[0]),b=max3f(p0[2],p0[3],p1[1]);a=max3f(a,p1[2],p1[3]);
  #pragma unroll
  for(int r=4;r<16;r+=4){a=max3f(a,p0[r],p0[r+1]);b=max3f(b,p0[r+2],p0[r+3]);a=max3f(a,p1[r],p1[r+1]);b=max3f(b,p1[r+2],p1[r+3]);}
  const float m=max2f(a,b);
  auto rr=__builtin_amdgcn_permlane32_swap(__float_as_uint(m),__float_as_uint(m),false,false);
  return max2f(__uint_as_float(rr[0]),__uint_as_float(rr[1]));
}
__device__ __forceinline__ void pv(f32x16*o,int vb,bf16x8 pa0,bf16x8 pa1,bf16x8 pa2,bf16x8 pa3){
  #pragma unroll
  for(int d0=0;d0<4;++d0){s16x4 lo[4],hi[4];
    #pragma unroll
    for(int ks=0;ks<4;++ks){
      asm volatile("ds_read_b64_tr_b16 %0,%1 offset:%c2":"=&v"(lo[ks]):"v"(vb),"i"(d0*4096+ks*1024):"memory");
      asm volatile("ds_read_b64_tr_b16 %0,%1 offset:%c2":"=&v"(hi[ks]):"v"(vb),"i"(d0*4096+ks*1024+512):"memory");}
    asm volatile("s_waitcnt lgkmcnt(0)":::"memory");SBAR();
    #define PK(k) (bf16x8){lo[k][0],lo[k][1],lo[k][2],lo[k][3],hi[k][0],hi[k][1],hi[k][2],hi[k][3]}
    o[d0]=MFMA32(pa0,PK(0),o[d0]);
    o[d0]=MFMA32(pa1,PK(1),o[d0]);
    o[d0]=MFMA32(pa2,PK(2),o[d0]);
    o[d0]=MFMA32(pa3,PK(3),o[d0]);
    #undef PK
  }
}

template<int THRL> __device__ __forceinline__ void attn_sub(int b,int qkcol,int vcol,int qb,int cmap,float sl2,float lam,int ntcap,float Ub,float oscale,const float*subg,unsigned*o1s,bf16*MIXh,const bf16*Q,const bf16*__restrict__ K,const bf16*__restrict__ V,char*shm,unsigned*pw_){
#if PROBE_ATT >= 3
  const unsigned long long ps0_=__builtin_amdgcn_s_memrealtime();
#endif
  const int tid=threadIdx.x,lane=tid&63,r32=lane&31,hi=lane>>5; const int wid=__builtin_amdgcn_readfirstlane(tid>>6);
  const long rowbase=(long)b*SEQ; const int q0=qb*QB;
  const bf16*Qw=Q+(rowbase+q0+wid*QBLK)*DM+qkcol;
  const bf16*Kh=K+rowbase*DM+qkcol,*Vh=V+rowbase*DM+vcol;
  const unsigned lds0=(unsigned)(uintptr_t)shm;
  float*wsf=(float*)(shm+LDS_WS)+wid*64;
  const unsigned koff=(unsigned)(lane*DM+wid*8)*2u, voffv=(unsigned)((16*(wid&3)+(lane>>2))*DM+(wid>>2)*32+(lane&3)*8)*2u;
  const unsigned kdst=lds0+LDS_K+wid*1024, vdst=lds0+LDS_V+wid*1024;
  const int NTR=(q0+QB)/KVBLK;
  int NT=NTR<ntcap?NTR:ntcap;
  #define DMA_K(t,slot) glds16(Kh+(long)(NTR-1-(t))*KVBLK*DM,koff,(unsigned)__builtin_amdgcn_readfirstlane(kdst+(slot)))
  #define DMA_V(t,slot) do{ glds16(Vh+(long)(NTR-1-(t))*KVBLK*DM,voffv,(unsigned)__builtin_amdgcn_readfirstlane(vdst+2*(slot))); glds16(Vh+(long)(NTR-1-(t))*KVBLK*DM+64,voffv,(unsigned)__builtin_amdgcn_readfirstlane(vdst+2*(slot)+8192)); }while(0)
  const char*Kbase=shm+LDS_K; bf16x8 kf[8];
  const lds_cptr shm3=(lds_cptr)shm; const lds_cptr kp0=shm3+LDS_K+hi*1024+r32*16; const lds_cptr vp0=shm3+LDS_V+((lane>>4)&1)*32+(lane&3)*8+(4*hi+((lane&15)>>2))*64;
  #define vb0 ((int)(unsigned)(uintptr_t)vp0)
  DMA_K(0,0);DMA_V(0,0);DMA_K(1,SLOTB);
  bf16x8 qr[4];
  #pragma unroll
  for(int d0=0;d0<4;++d0)qr[d0]=*reinterpret_cast<const bf16x8*>(&Qw[(long)r32*DM+d0*16+hi*8]);
  const int qrel=wid*QBLK+r32;
  const unsigned lm=hi?0u:0xffffffffu;
  const int qw0=wid*QBLK;
  unsigned bbx; { const unsigned sh=__float_as_uint(sl2)&0xffff0000u; const float sr=sl2-__uint_as_float(sh); bbx=((sh>>16)|(cvtpk_s(sr,0.f)<<16))&lm; }
  const float dlt=64.f*sl2;
  float cref=sl2*(float)(192-qrel);
  #define BIAS2(C0,C1,t) do{ const float c_=__builtin_fmaf(-dlt,(float)(t),cref); const unsigned h_=__float_as_uint(c_)&0xffff0000u; const float r1_=c_-__uint_as_float(h_); \
      const unsigned m_=__float_as_uint(r1_)&0xffff0000u; const float r2_=r1_-__uint_as_float(m_); \
      int q_=qrel; asm volatile("":"+v"(q_)); const float rf_=(float)(q_-qw0); \
      u32x4 b_=(u32x4){bbx,((h_>>16)|m_)&lm,(__float_as_uint(r2_)>>16)&lm,0u}; u32x4 a_=(u32x4){cvtpk_s(rf_,rf_),0x3F803F80u,0x00003F80u,0u}; asm volatile("":"+v"(a_),"+v"(b_)); \
      const f32x16 z_=f32x16{}; C0=MFMA32(__builtin_bit_cast(bf16x8,a_),__builtin_bit_cast(bf16x8,b_),z_); \
      a_.x=cvtpk_s(rf_+32.f,rf_+32.f); asm volatile("":"+v"(a_)); C1=MFMA32(__builtin_bit_cast(bf16x8,a_),__builtin_bit_cast(bf16x8,b_),z_); }while(0)
  float l_reg=0.f;f32x16 o[4];o[0]=f32x16{};o[1]=f32x16{};o[2]=f32x16{};o[3]=f32x16{};
  #define CMASK(P0,P1,t) do{int jb_=3-(t); if(jb_>=0)cmask(P0,P1,jb_,qrel,hi);}while(0)
  bool resc=false;
  #define START(P0,P1) do{ const float rm=rowmax(P0,P1); resc=false; \
    if(__any(rm>(float)THRL)){ const float dl=max2f(rm,0.f); cref=fsub_s(cref,dl); \
      _Pragma("unroll") for(int r=0;r<16;++r){P0[r]=fsub_s(P0[r],dl);P1[r]=fsub_s(P1[r],dl);} } \
    _Pragma("unroll") for(int r=0;r<16;++r)P0[r]=__builtin_amdgcn_exp2f(P0[r]); }while(0)
  #define RESC() do{ if(resc){ asm volatile("s_waitcnt lgkmcnt(0)":::"memory"); \
      _Pragma("unroll") for(int d_=0;d_<4;++d_) _Pragma("unroll") for(int r=0;r<16;++r)o[d_][r]*=wsf[crow(r,hi)]; } }while(0)
  f32x16 pA0,pA1,pB0,pB1;
  int sl_prev=0,sl_cur=0,sl_next=SLOTB;
  #define ROT() do{sl_prev=sl_cur;sl_cur=sl_next;sl_next=(sl_next==(NSLOT-1)*SLOTB)?0:sl_next+SLOTB;}while(0)
  DMA_K(2,2*SLOTB);
  WAIT_BAR(3);
  BIAS2(pA0,pA1,0);
  qkt(pA0,pA1,Kbase,qr,r32,hi);asm volatile("s_nop 15\n\ts_nop 7":"+v"(pA0),"+v"(pA1));CMASK(pA0,pA1,0);
  START(pA0,pA1);
  _Pragma("unroll") for(int r=0;r<16;++r)pA1[r]=__builtin_amdgcn_exp2f(pA1[r]);
  WAIT_BAR(0);
  DMA_K(3,0);DMA_V(1,SLOTB);
  ROT();
  kload8(kf,kp0+sl_cur);
  WAIT_BAR(3);
  s16x4 vlo[8],vhi[8]; u32x4 pw0,pw1,pw2,pw3;
  #define PKW(P,B) cvtpk_s(P[B],P[B+1])
  #define PAF(k) __builtin_bit_cast(bf16x8,pw##k)
  #define VFR(i) (bf16x8){vlo[i][0],vlo[i][1],vlo[i][2],vlo[i][3],vhi[i][0],vhi[i][1],vhi[i][2],vhi[i][3]}
  #define PIN(x) asm volatile("":"+v"(x))
  #define MX3(a,b,c) __builtin_fmaxf(__builtin_fmaxf((a),(b)),(c))
  #define GAPA(MF,A0,A1,A2,A3,W0,W1,PW) do{ MF; sacc+=A0; sacc+=A1; sacc+=A2; sacc+=A3; PIN(sacc); W0; W1; PIN(PW); SBAR(); }while(0)
  #define EX(v) __builtin_amdgcn_exp2f(v)
  #define GAPB(MF,X,B) do{ MF; X[B]=EX(X[B]); X[B+1]=EX(X[B+1]); PIN(X); SBAR(); }while(0)
  #define VRD2(i) do{ vlo[i]=vtr(vp_+(8192+((i)>>2)*4096+((i)&3)*1024)); vhi[i]=vtr(vp_+(8192+((i)>>2)*4096+((i)&3)*1024+512)); SBAR(); }while(0)
  #define VRD(i) do{ vlo[i]=vtr(vp_+(((i)>>2)*4096+((i)&3)*1024)); vhi[i]=vtr(vp_+(((i)>>2)*4096+((i)&3)*1024+512)); }while(0)
  #define KRD(G,j) do{ if(G){ kload2(kf,kp0+sl_next,j); SBAR(); } }while(0)
  #define STEP(C0,C1,P0,P1,t,GK,GV,GL) do{ SBAR(); \
    BIAS2(C0,C1,t); SBAR(); \
    const lds_cptr vp_=vp0+2*sl_prev; \
    VRD(0); SBAR(); float sacc=(P0[0]+P0[1]); \
    GAPA(C0=MFMA32(kf[0],qr[0],C0), P0[2],P0[3],P0[4],P0[5],     pw0[0]=PKW(P0,0), pw0[1]=PKW(P0,2), pw0); \
    VRD(4); SBAR(); GAPA(C1=MFMA32(kf[1],qr[0],C1), P0[6],P0[7],P0[8],P0[9],     pw0[2]=PKW(P0,4), pw0[3]=PKW(P0,6), pw0); \
    VRD(1); SBAR(); GAPA(C0=MFMA32(kf[2],qr[1],C0),   P0[10],P0[11],P0[12],P0[13], pw1[0]=PKW(P0,8), pw1[1]=PKW(P0,10), pw1); \
    VRD(5); SBAR(); GAPA(C1=MFMA32(kf[3],qr[1],C1),   P0[14],P0[15],P1[0],P1[1],   pw1[2]=PKW(P0,12),pw1[3]=PKW(P0,14), pw1); \
    VRD(2); SBAR(); GAPA(C0=MFMA32(kf[4],qr[2],C0),   P1[2],P1[3],P1[4],P1[5],     pw2[0]=PKW(P1,0), pw2[1]=PKW(P1,2), pw2); \
    VRD(6); SBAR(); GAPA(C1=MFMA32(kf[5],qr[2],C1),   P1[6],P1[7],P1[8],P1[9],     pw2[2]=PKW(P1,4), pw2[3]=PKW(P1,6), pw2); \
    VRD(3); SBAR(); GAPA(C0=MFMA32(kf[6],qr[3],C0),   P1[10],P1[11],P1[12],P1[13], pw3[0]=PKW(P1,8), pw3[1]=PKW(P1,10), pw3); \
    VRD(7); SBAR(); GAPA(C1=MFMA32(kf[7],qr[3],C1),   P1[14],P1[15],0.f,0.f,       pw3[2]=PKW(P1,12),pw3[3]=PKW(P1,14), pw3); \
    l_reg+=sacc; \
    if(GK){DMA_K((t)+3,sl_cur);} if(GV){DMA_V((t)+1,sl_next);} \
    CMASK(C0,C1,t); \
    { float a=MX3(C0[0],C0[1],C1[0]),b=MX3(C0[2],C0[3],C1[1]); a=MX3(a,C1[2],C1[3]); \
      _Pragma("unroll") for(int r=4;r<16;r+=4){a=MX3(a,C0[r],C0[r+1]);b=MX3(b,C0[r+2],C0[r+3]);a=MX3(a,C1[r],C1[r+1]);b=MX3(b,C1[r+2],C1[r+3]);} \
      float rm=__builtin_fmaxf(a,b); { auto rr=__builtin_amdgcn_permlane32_swap(__float_as_uint(rm),__float_as_uint(rm),false,false); rm=__builtin_fmaxf(__uint_as_float(rr[0]),__uint_as_float(rr[1])); } \
      resc=false; \
      if(__builtin_expect(__any(rm>(float)THRL),0)){ const float dl=__builtin_fmaxf(rm,0.f); cref-=dl; \
        _Pragma("unroll") for(int r=0;r<16;++r){C0[r]-=dl;C1[r]-=dl;} \
        const float f=__builtin_amdgcn_exp2f(-dl); l_reg*=f; if(hi==0)wsf[r32]=f; resc=true; } } \
    SBAR(); \
    GAPB(o[0]=MFMA32(PAF(0),VFR(0),o[0]), C0,0);  VRD2(0); \
    GAPB(o[1]=MFMA32(PAF(0),VFR(4),o[1]), C0,2);  VRD2(4); \
    KRD(GL,0); GAPB(o[0]=MFMA32(PAF(1),VFR(1),o[0]), C0,4);  VRD2(1); \
    KRD(GL,1); GAPB(o[1]=MFMA32(PAF(1),VFR(5),o[1]), C0,6);  VRD2(5); \
    KRD(GL,2); GAPB(o[0]=MFMA32(PAF(2),VFR(2),o[0]), C0,8);  VRD2(2); \
    KRD(GL,3); GAPB(o[1]=MFMA32(PAF(2),VFR(6),o[1]), C0,10); VRD2(6); \
    GAPB(o[0]=MFMA32(PAF(3),VFR(3),o[0]), C0,12); VRD2(3); \
    GAPB(o[1]=MFMA32(PAF(3),VFR(7),o[1]), C0,14); VRD2(7); \
    GAPB(o[2]=MFMA32(PAF(0),VFR(0),o[2]), C1,0); \
    GAPB(o[3]=MFMA32(PAF(0),VFR(4),o[3]), C1,2); \
    GAPB(o[2]=MFMA32(PAF(1),VFR(1),o[2]), C1,4); \
    GAPB(o[3]=MFMA32(PAF(1),VFR(5),o[3]), C1,6); \
    GAPB(o[2]=MFMA32(PAF(2),VFR(2),o[2]), C1,8); \
    GAPB(o[3]=MFMA32(PAF(2),VFR(6),o[3]), C1,10); \
    GAPB(o[2]=MFMA32(PAF(3),VFR(3),o[2]), C1,12); \
    GAPB(o[3]=MFMA32(PAF(3),VFR(7),o[3]), C1,14); \
    }while(0)
  #define ENDW(tt) do{ if((tt)+3<NT){WAIT_BAR(3);} else if((tt)+2<NT){WAIT_BAR(2);} else {WAIT_BAR(0);} }while(0)
#if PROBE_ATT == 3
  if(blockIdx.x==PROBE_BLK&&threadIdx.x==0)atomicAdd(pw_,(unsigned)(__builtin_amdgcn_s_memrealtime()-ps0_));
#endif
  int t=1;
  for(;t<5&&t+1<NT;t+=2){
    STEP(pB0,pB1,pA0,pA1,t,(t+3<NT),(t+1<NT),(t+1<NT));       ENDW(t);   RESC(); ROT();
    STEP(pA0,pA1,pB0,pB1,t+1,(t+4<NT),(t+2<NT),(t+2<NT));     ENDW(t+1); RESC(); ROT();
  }
  if(t==5&&NT>=12){
    float lt=l_reg; {auto rr=__builtin_amdgcn_permlane32_swap(__float_as_uint(lt),__float_as_uint(lt),false,false);lt=__uint_as_float(rr[0])+__uint_as_float(rr[1]);}
    float dl2=(sl2*(float)(192-qrel)-cref)+__builtin_amdgcn_logf(lt);
    #define DPPMIN(ctl) dl2=__builtin_fminf(dl2,__uint_as_float((unsigned)__builtin_amdgcn_update_dpp(0,(int)__float_as_uint(dl2),ctl,0xF,0xF,false)))
    DPPMIN(0xB1); DPPMIN(0x4E); DPPMIN(0x141); DPPMIN(0x140);
    #undef DPPMIN
    { auto rr=__builtin_amdgcn_permlane16_swap(__float_as_uint(dl2),__float_as_uint(dl2),false,false); dl2=__builtin_fminf(__uint_as_float(rr[0]),__uint_as_float(rr[1])); }
    float*xw=(float*)(shm+LDS_OST);
    if(lane==0)xw[wid]=dl2;
    asm volatile("s_waitcnt lgkmcnt(0)\n\ts_barrier":::"memory");
    float dmin=xw[0];
    #pragma unroll
    for(int w_=1;w_<8;++w_)dmin=__builtin_fminf(dmin,xw[w_]);
    dmin=__uint_as_float(__builtin_amdgcn_readfirstlane(__float_as_uint(dmin)));
    const float d0_=(Ub-dmin+24.f+log2f(1.f/(1.f-exp2f(-sl2))))/sl2; float st_=ceilf((d0_+255.f)*(1.f/64.f)); st_=st_<10.f?10.f:(st_>64.f?64.f:st_);
    const int nc_=__builtin_amdgcn_readfirstlane((((int)st_)+1)&~1); if(nc_<NT)NT=nc_;
    asm volatile("s_waitcnt lgkmcnt(0)":::"memory");
  }
  #undef CMASK
  #define CMASK(P0,P1,t) do{}while(0)
  for(;t+5<NT;t+=2){
    STEP(pB0,pB1,pA0,pA1,t,true,true,true);     WAIT_BAR(3); RESC(); ROT();
    STEP(pA0,pA1,pB0,pB1,t+1,true,true,true);   WAIT_BAR(3); RESC(); ROT();
  }
  for(;t+1<NT;t+=2){
    STEP(pB0,pB1,pA0,pA1,t,(t+3<NT),(t+1<NT),(t+1<NT));       ENDW(t);   RESC(); ROT();
    STEP(pA0,pA1,pB0,pB1,t+1,(t+4<NT),(t+2<NT),(t+2<NT));     ENDW(t+1); RESC(); ROT();
  }
  #undef CMASK
  #define CMASK(P0,P1,t) do{int jb_=3-(t); if(jb_>=0)cmask(P0,P1,jb_,qrel,hi);}while(0)
  STEP(pB0,pB1,pA0,pA1,NT-1,false,false,false); RESC();
#if PROBE_ATT == 4
  const unsigned long long ps1_=__builtin_amdgcn_s_memrealtime();
#endif
  { float sacc=pB0[0]+pB0[1]; _Pragma("unroll") for(int r=2;r<16;++r)sacc+=pB0[r]; _Pragma("unroll") for(int r=0;r<16;++r)sacc+=pB1[r]; l_reg+=sacc;
    pw0=(u32x4){PKW(pB0,0),PKW(pB0,2),PKW(pB0,4),PKW(pB0,6)};pw1=(u32x4){PKW(pB0,8),PKW(pB0,10),PKW(pB0,12),PKW(pB0,14)};pw2=(u32x4){PKW(pB1,0),PKW(pB1,2),PKW(pB1,4),PKW(pB1,6)};pw3=(u32x4){PKW(pB1,8),PKW(pB1,10),PKW(pB1,12),PKW(pB1,14)};
    SBAR(); pv(o,vb0+2*sl_cur,PAF(0),PAF(1),PAF(2),PAF(3)); }
  #undef PKW
  #undef PAF
  #undef VFR
  #undef PIN
  #undef MX3
  #undef GAPA
  #undef GAPB
  #undef EX
  #undef VRD
  #undef VRD2
  #undef KRD
  #undef STEP
  #undef ENDW
  { int tid_e=threadIdx.x; asm volatile("":"+v"(tid_e)); const int lane=tid_e&63,r32=lane&31,hi=lane>>5; const int wid=__builtin_amdgcn_readfirstlane(tid_e>>6);
    float*wsf=(float*)(shm+LDS_WS)+wid*64;
  {auto rr=__builtin_amdgcn_permlane32_swap(__float_as_uint(l_reg),__float_as_uint(l_reg),false,false);l_reg=__uint_as_float(rr[0])+__uint_as_float(rr[1]);}
  if(hi==0)wsf[32+r32]=l_reg;asm volatile("s_waitcnt lgkmcnt(0)":::"memory");
  float rli[16];
  #pragma unroll
  for(int r=0;r<16;++r)rli[r]=__builtin_amdgcn_rcpf(wsf[32+crow(r,hi)]);
  u32x4*ow=(u32x4*)(o1s+wid*2048)+lane;
  if(cmap==0){
    #pragma unroll
    for(int i=0;i<8;++i){ const int dq=i>>1,r0=8*(i&1); u32x4 w;
      w.x=cvtpk_s(o[dq][r0+0]*rli[r0+0],o[dq][r0+1]*rli[r0+1]); w.y=cvtpk_s(o[dq][r0+2]*rli[r0+2],o[dq][r0+3]*rli[r0+3]);
      w.z=cvtpk_s(o[dq][r0+4]*rli[r0+4],o[dq][r0+5]*rli[r0+5]); w.w=cvtpk_s(o[dq][r0+6]*rli[r0+6],o[dq][r0+7]*rli[r0+7]); ow[i*64]=w; }
  } else {
    bf16*stg=(bf16*)(shm+LDS_OST)+wid*2048;
    const int row=lane>>1,part=lane&1; float v[64]; float ss=0.f;
    unsigned o1w[32];
    #pragma unroll
    for(int i=0;i<8;++i){ const u32x4 w=ow[i*64]; o1w[4*i+0]=w.x; o1w[4*i+1]=w.y; o1w[4*i+2]=w.z; o1w[4*i+3]=w.w; }
    #pragma unroll
    for(int p_=0;p_<2;++p_){
      #pragma unroll
      for(int d0=0;d0<2;++d0){ const int dq=2*p_+d0;
        #pragma unroll
        for(int rp=0;rp<8;++rp){ const unsigned w=o1w[dq*8+rp];
          const float a0=__uint_as_float(w<<16)-lam*(o[dq][2*rp]*rli[2*rp]), a1=__uint_as_float(w&0xffff0000u)-lam*(o[dq][2*rp+1]*rli[2*rp+1]);
          stg[crow(2*rp,hi)*64+d0*32+r32]=__float2bfloat16(a0); stg[crow(2*rp+1,hi)*64+d0*32+r32]=__float2bfloat16(a1); } }
      asm volatile("s_waitcnt lgkmcnt(0)":::"memory");
      #pragma unroll
      for(int i=0;i<4;++i){ const u32x4 w=*(const u32x4*)(stg+row*64+part*32+8*i);
        v[32*p_+8*i+0]=__uint_as_float(w.x<<16); v[32*p_+8*i+1]=__uint_as_float(w.x&0xffff0000u); v[32*p_+8*i+2]=__uint_as_float(w.y<<16); v[32*p_+8*i+3]=__uint_as_float(w.y&0xffff0000u);
        v[32*p_+8*i+4]=__uint_as_float(w.z<<16); v[32*p_+8*i+5]=__uint_as_float(w.z&0xffff0000u); v[32*p_+8*i+6]=__uint_as_float(w.w<<16); v[32*p_+8*i+7]=__uint_as_float(w.w&0xffff0000u); }
      asm volatile("s_waitcnt lgkmcnt(0)":::"memory");
    }
    #pragma unroll
    for(int i=0;i<64;++i)ss+=v[i]*v[i];
    ss+=__uint_as_float((unsigned)__builtin_amdgcn_update_dpp(0,(int)__float_as_uint(ss),0xB1,0xF,0xF,false));
    const float rs=(1.0f/sqrtf(ss*(1.0f/128.0f)+1e-6f))*oscale;
    bf16*op=MIXh+((long)rowbase+q0+wid*QBLK+row)*2048+part*32;
    #pragma unroll
    for(int p_=0;p_<2;++p_){ const float*sg=subg+64*p_+32*part;
      #pragma unroll
      for(int i=0;i<4;++i){ u32x4 w; const float*vv=v+32*p_+8*i; const float*gg=sg+8*i;
        w.x=cvtpk_s(vv[0]*rs*gg[0],vv[1]*rs*gg[1]); w.y=cvtpk_s(vv[2]*rs*gg[2],vv[3]*rs*gg[3]); w.z=cvtpk_s(vv[4]*rs*gg[4],vv[5]*rs*gg[5]); w.w=cvtpk_s(vv[6]*rs*gg[6],vv[7]*rs*gg[7]);
        *(u32x4*)(op+64*p_+8*i)=w; } }
  }
  }
  asm volatile("s_waitcnt lgkmcnt(0)\n\ts_barrier":::"memory");
#if PROBE_ATT == 4
  if(blockIdx.x==PROBE_BLK&&threadIdx.x==0)atomicAdd(pw_,(unsigned)(__builtin_amdgcn_s_memrealtime()-ps1_));
#endif
  #undef DMA_K
  #undef DMA_V
  #undef vb0
  #undef CMASK
  #undef START
  #undef RESC
  #undef ROT
  #undef BIAS2
}
constexpr int ATTN_LDS_BYTES=LDS_BYTES;
template<int THRL> __device__ __forceinline__ void attn_unit4(int b,int h,int qb,float lam,float oscale,const float*subg,const unsigned*nmax,unsigned*o1s,const bf16*Q,const bf16*K,const bf16*V,bf16*MIX,char*shm){
  const float sl2=exp2f(-(float)(h+1))*1.4426950408889634f;
  int cap[2]; float Uv[2];
  #pragma unroll
  for(int c=0;c<2;++c){ const int bh=b*8+h; const unsigned*qn=nmax+((0*64+bh)*2+c)*2,*kn=nmax+((1*64+bh)*2+c)*2;
    const float U=1.02f*(sqrtf(__uint_as_float(qn[0])*__uint_as_float(kn[0]))+sqrtf(__uint_as_float(qn[1])*__uint_as_float(kn[1])));
    const float d0=(2.f*U+24.f+log2f(1.f/(1.f-exp2f(-sl2))))/sl2; float st=ceilf((d0+255.f)*(1.f/64.f)); st=st<4.f?4.f:(st>64.f?64.f:st);
    cap[c]=__builtin_amdgcn_readfirstlane((((int)st)+1)&~1); Uv[c]=__uint_as_float(__builtin_amdgcn_readfirstlane(__float_as_uint(U))); }
  for(int c=0;c<2;++c) attn_sub<THRL>(b,(2*h+c)*64,h*128,qb,c,sl2,lam,c?cap[1]:cap[0],c?Uv[1]:Uv[0],oscale,subg,o1s,MIX+h*128,Q,K,V,shm,(unsigned*)nmax+900);
}
__device__ __forceinline__ int wg_pop(unsigned*ctr,volatile __attribute__((address_space(3))) unsigned*slot){
  if(threadIdx.x==0)*slot=__hip_atomic_fetch_add(ctr,1u,__ATOMIC_RELAXED,__HIP_MEMORY_SCOPE_AGENT);
  __syncthreads(); const unsigned n=*slot; __syncthreads(); return (int)n;
}
template<int THRL=8> __device__ __forceinline__ void attn_phase(char*lds,int bx,unsigned*qctr,volatile __attribute__((address_space(3))) unsigned*slot,float lam,float oscale,const float*subg,const unsigned*nmax,unsigned*o1s,const bf16*Q,const bf16*K,const bf16*V,bf16*MIX){
  for(int qi=0;qi<8;++qi){ const int x=(bx+qi)&7;
    for(;;){ const int n=wg_pop(qctr+64*x,slot); if(n>=128)break;
      const int qb=15-(n>>3),h=7-(n&7),b=(x+h)&7;
#if PROBE_ATT == 1
      const unsigned long long pa0_=__builtin_amdgcn_s_memrealtime();
#endif
      attn_unit4<THRL>(b,h,qb,lam,oscale,subg,nmax,o1s,Q,K,V,MIX,lds);
#if PROBE_ATT == 1
      if(blockIdx.x==PROBE_BLK&&threadIdx.x==0)atomicAdd((unsigned*)nmax+900,(unsigned)(__builtin_amdgcn_s_memrealtime()-pa0_));
#endif
    } }
}
#undef SBAR
#undef WAIT_BAR
#undef MFMA32
}
#define GAS __attribute__((address_space(1)))
#define LAS __attribute__((address_space(3)))
typedef unsigned short bf16;
typedef unsigned v4u __attribute__((ext_vector_type(4)));
typedef float f32x4 __attribute__((ext_vector_type(4)));
typedef short bf16x8 __attribute__((ext_vector_type(8)));
typedef GAS unsigned gu32;
typedef GAS unsigned long long gu64;
#define RLX_AGENT __ATOMIC_RELAXED, __HIP_MEMORY_SCOPE_AGENT
#define LDS_WAIT() asm volatile("s_waitcnt lgkmcnt(0)" ::: "memory")
#define VM_WAIT() asm volatile("s_waitcnt vmcnt(0)" ::: "memory")
__device__ __forceinline__ unsigned long long rt() { return __builtin_amdgcn_s_memrealtime(); }
__device__ __forceinline__ unsigned f2bf(float f) { unsigned u = __builtin_bit_cast(unsigned, f); return (u + 0x7fffu + ((u >> 16) & 1u)) >> 16; }
__device__ __forceinline__ unsigned pk2(float lo, float hi) { return f2bf(lo) | (f2bf(hi) << 16); }

#define XB_TMO      128
#define XB_XCNT(j)  (256  + 64 * (j))
#define XB_XSUB(j)  (1280 + 64 * (j))
#define XB_XGEN(j)  (2304 + 64 * (j))
#define XB_TOP      3328
#define XB_TOPGEN   3392
#define XCD_BAR_WORDS 3456
#define XB_SPIN_CAP (1u << 18)

__device__ __forceinline__ unsigned xb_ld(unsigned* p)              { return __hip_atomic_load(p, __ATOMIC_RELAXED, __HIP_MEMORY_SCOPE_AGENT); }
__device__ __forceinline__ unsigned xb_add(unsigned* p, unsigned v) { return __hip_atomic_fetch_add(p, v, __ATOMIC_RELAXED, __HIP_MEMORY_SCOPE_AGENT); }
__device__ __forceinline__ unsigned xb_xcc_id() { return (unsigned)__builtin_amdgcn_s_getreg((3 << 11) | 20) & 0xFu; }
#define XB_SPIN(cond, bar) do { unsigned _sp = 0; while (cond) { __builtin_amdgcn_s_sleep(1); \
    if ((++_sp & 255u) == 0u) { if (xb_ld(&(bar)[XB_TMO])) break; if (_sp > XB_SPIN_CAP) { atomicAdd(&(bar)[XB_TMO], 1u); break; } } } } while (0)

struct XcdBarrier {
    unsigned* bar; unsigned x;
    volatile LAS unsigned* st;
};

__device__ __forceinline__ XcdBarrier xcd_barrier_post(unsigned* bar, volatile LAS unsigned* st) {
    XcdBarrier b; b.bar = bar; b.x = xb_xcc_id(); b.st = st;
    if (threadIdx.x == 0) (void)xb_add(&bar[XB_XCNT(b.x)], 1u);
    return b;
}
__device__ __forceinline__ void xcd_barrier_complete(unsigned* bar, unsigned x, unsigned& nloc, unsigned& nx) {
    const unsigned G = gridDim.x * gridDim.y * gridDim.z;
    unsigned sum, cnt, mine, sp = 0u;
    for (;;) {
        sum = 0u; cnt = 0u; mine = 0u;
#pragma unroll
        for (unsigned j = 0; j < 16; ++j) { const unsigned c = xb_ld(&bar[XB_XCNT(j)]); sum += c; cnt += (c > 0u) ? 1u : 0u; mine = (j == x) ? c : mine; }
        if (sum == G) break;
        __builtin_amdgcn_s_sleep(1);
        if ((++sp & 255u) == 0u) { if (xb_ld(&bar[XB_TMO])) break; if (sp > XB_SPIN_CAP) { atomicAdd(&bar[XB_TMO], 1u); break; } }
    }
    nloc = mine > 0u ? mine : 1u; nx = cnt > 0u ? cnt : 1u;
}

__device__ __forceinline__ void xcd_barrier(const XcdBarrier& b) {
    asm volatile("s_waitcnt vmcnt(0)" ::: "memory");
    __syncthreads();
    if (threadIdx.x == 0) {
        unsigned* bar = b.bar;
        __builtin_amdgcn_s_waitcnt(0);
        unsigned nloc = b.st[0], nx = b.st[1];
        if (nloc == 0u) { xcd_barrier_complete(bar, b.x, nloc, nx); b.st[0] = nloc; b.st[1] = nx; }
        const unsigned old = xb_add(&bar[XB_XSUB(b.x)], 1u);
        const unsigned gen = old / nloc;
        if (old + 1u == (gen + 1u) * nloc) {
            __builtin_amdgcn_fence(__ATOMIC_RELEASE, "agent");
            asm volatile("s_waitcnt vmcnt(0)" ::: "memory");
            const unsigned og = xb_add(&bar[XB_TOP], 1u);
            const unsigned tg = og / nx;
            if (og + 1u == (tg + 1u) * nx) xb_add(&bar[XB_TOPGEN], 1u);
            else XB_SPIN(xb_ld(&bar[XB_TOPGEN]) == tg, bar);
            __builtin_amdgcn_fence(__ATOMIC_ACQUIRE, "agent");
            xb_add(&bar[XB_XGEN(b.x)], 1u);
            asm volatile("s_waitcnt vmcnt(0)" ::: "memory");
        } else {
            XB_SPIN(xb_ld(&bar[XB_XGEN(b.x)]) == gen, bar);
            __builtin_amdgcn_fence(__ATOMIC_ACQUIRE, "agent");
            asm volatile("s_waitcnt vmcnt(0)" ::: "memory");
        }
    }
    __syncthreads();
}

constexpr int NWAVES = 8;
constexpr int BATCH = 8, SEQ = 4096, T = BATCH * SEQ, D = 2048, NIN = 5120, NEXP = 32, NA = 2 * T;
constexpr float EPS = 1e-6f, LOG2E = 1.4426950408889634f, C2 = 0.125f * 1.4426950408889634f;
constexpr size_t MiB = 1u << 20;
constexpr size_t WS_CTL = 0, CTL_ZERO_BYTES = 1 * MiB;
constexpr size_t WS_RSTD1 = 1 * MiB, WS_RSTD2 = WS_RSTD1 + 128 * 1024, WS_WTS = WS_RSTD2 + 128 * 1024;
constexpr size_t WS_LIST = 2 * MiB;
constexpr size_t WS_PART = 6 * MiB;
constexpr size_t WS_WIN = 10 * MiB, WS_WOUT = 30 * MiB;
constexpr size_t WS_WGU = 38 * MiB, WS_WD = 166 * MiB;
constexpr size_t WS_XB = 230 * MiB;
constexpr size_t WS_CG = 358 * MiB;
constexpr size_t WS_MIX = 422 * MiB;
constexpr size_t WS_HB = 550 * MiB;
constexpr size_t WS_HB8 = 678 * MiB;
constexpr size_t WS_WR = 742 * MiB;
constexpr size_t WS_X8 = 743 * MiB;
constexpr size_t WS_WIN8 = 807 * MiB;
constexpr size_t WS_O1S = 811 * MiB;
constexpr size_t WS_LISTW = 827 * MiB, WS_LISTR = 831 * MiB;
constexpr size_t WS_END = 835 * MiB;
constexpr float WSCALE = 32.f, H1SCALE = 4.f, YSCALE = 8.f;
constexpr int CW_TMO = 0, CW_CODE = 1, CW_BAR = 4096, CW_CNT = 8192;
constexpr int CW_GQ = 20480;
constexpr int CW_H8Q = 24576 + 1024;
constexpr int CW_CVQ = 24576, CW_DONE = 24576 + 64;
constexpr int CW_QA = 12288, CW_QC = 12288 + 512, CW_NMAX = 16384;
constexpr int RING_OFF = 0, RING_BYTES = 131072, LDSCTL_OFF = RING_BYTES, MISC_OFF = LDSCTL_OFF + 320, TAB_OFF = LDSCTL_OFF + 1024;
constexpr int LDS_BYTES = 147456;
constexpr int NPHASE = 8;
#ifndef MK_ONE_LAUNCH
#define MK_ONE_LAUNCH 1
#endif
#ifndef PROBE_DOUBLE
#define PROBE_DOUBLE 0
#endif
#ifndef PROBE_CLOCK
#define PROBE_CLOCK 0
#endif
#ifndef USE_NAIVE_ROUTER
#define USE_NAIVE_ROUTER 0
#endif
#ifndef USE_NAIVE_ATTN
#define USE_NAIVE_ATTN 0
#endif


typedef unsigned u32x4g __attribute__((ext_vector_type(4)));
__device__ __forceinline__ float wave_sum(float v) {
#pragma unroll
    for (int o = 1; o < 64; o <<= 1) v += __shfl_xor(v, o);
    return v;
}
__device__ __forceinline__ float bflo(unsigned w) { return __builtin_bit_cast(float, w << 16); }
__device__ __forceinline__ float bfhi(unsigned w) { return __builtin_bit_cast(float, w & 0xffff0000u); }
__device__ __forceinline__ float fexp2(float x) { return __builtin_amdgcn_exp2f(x); }

__device__ __forceinline__ void tr_item(const float* W, int N, const float* gk, int k0, int n0, bf16* dst, int dstK, LAS float* scr, int lane) {
    const int kr = lane >> 3, n4 = 4 * (lane & 7); f32x4 v[8];
#pragma unroll
    for (int i = 0; i < 8; ++i) v[i] = *(const GAS f32x4*)(W + (size_t)(k0 + 8 * i + kr) * N + n0 + n4);
#pragma unroll
    for (int i = 0; i < 8; ++i) { const int kk = 8 * i + kr; const float g = gk ? gk[k0 + kk] : 1.0f;
        scr[(n4 + 0) * 66 + kk] = v[i].x * g; scr[(n4 + 1) * 66 + kk] = v[i].y * g; scr[(n4 + 2) * 66 + kk] = v[i].z * g; scr[(n4 + 3) * 66 + kk] = v[i].w * g; }
    LDS_WAIT(); asm volatile("" ::: "memory");
    const int c = lane & 7;
#pragma unroll
    for (int j = 0; j < 4; ++j) { const int n = (lane >> 3) + 8 * j; const LAS float* s = scr + n * 66 + 8 * c;
        v4u o; o.x = pk2(s[0], s[1]); o.y = pk2(s[2], s[3]); o.z = pk2(s[4], s[5]); o.w = pk2(s[6], s[7]);
        *(GAS v4u*)(dst + (size_t)n * dstK + 8 * c) = o; }
    LDS_WAIT(); asm volatile("" ::: "memory");
}
__device__ __forceinline__ void tr8_load(const float* W, int N, int k0, int n0, int lane, f32x4 (&v)[8]) {
    const int kr = lane >> 3, n4 = 4 * (lane & 7);
#pragma unroll
    for (int i = 0; i < 8; ++i) v[i] = *(const GAS f32x4*)(W + (size_t)(k0 + 8 * i + kr) * N + n0 + n4);
}
__device__ __forceinline__ void tr8_finish(const f32x4 (&v)[8], const float* gk, float scale, int k0, unsigned char* dst, int dstK, LAS float* scr, int lane) {
    const int kr = lane >> 3, n4 = 4 * (lane & 7);
#pragma unroll
    for (int i = 0; i < 8; ++i) { const int kk = 8 * i + kr; const float g = (gk ? gk[k0 + kk] : 1.0f) * scale;
        scr[(n4 + 0) * 66 + kk] = v[i].x * g; scr[(n4 + 1) * 66 + kk] = v[i].y * g; scr[(n4 + 2) * 66 + kk] = v[i].z * g; scr[(n4 + 3) * 66 + kk] = v[i].w * g; }
    LDS_WAIT(); asm volatile("" ::: "memory");
    const int c = lane & 7;
#pragma unroll
    for (int j = 0; j < 4; ++j) { const int n = (lane >> 3) + 8 * j; const LAS float* s = scr + n * 66 + 8 * c;
        pg8::u32x2 o; o.x = pg8::pk4_fp8(s[0], s[1], s[2], s[3]); o.y = pg8::pk4_fp8(s[4], s[5], s[6], s[7]);
        *(GAS pg8::u32x2*)(dst + (size_t)n * dstK + 8 * c) = o; }
    LDS_WAIT(); asm volatile("" ::: "memory");
}
__device__ __forceinline__ void tr_item8(const float* W, int N, const float* gk, float scale, int k0, int n0, unsigned char* dst, int dstK, LAS float* scr, int lane) {
    f32x4 v[8]; tr8_load(W, N, k0, n0, lane, v); tr8_finish(v, gk, scale, k0, dst, dstK, scr, lane);
}
struct Ptrs {
    const float *x, *g1, *w_in, *lq1, *lk1, *lq2, *lk2, *subg, *cw, *cb, *lng, *lnb, *w_out, *g2, *wgr, *bgr, *wer, *ber, *w_gate, *w_up, *w_down, *gf;
    float* out; unsigned char* ws;
};
__device__ __forceinline__ void p0_prologue(const Ptrs& P, LAS unsigned char* lds, int lane, int wave, int gw, int NGW) {
    LAS float* scr = (LAS float*)(lds + RING_OFF + wave * 16384);
    bf16* WIN = (bf16*)(P.ws + WS_WIN); bf16* WOUT = (bf16*)(P.ws + WS_WOUT);
    constexpr int I_IN = 32 * 160, I_OUT = 32 * 64, NITEMS = I_IN + I_OUT;
    for (int it = gw; it < NITEMS; it += NGW) {
        if (it < I_IN) { const int kb = it / 160, nb = it % 160;
            if (nb < 96) tr_item(P.w_in, NIN, P.g1, 64 * kb, 32 * nb, WIN + (size_t)(32 * nb) * 2048 + 64 * kb, 2048, scr, lane);
            else { const int j0 = 32 * (nb - 96), jj = j0 & 1023, drow = 256 * (jj >> 7) + (jj & 127) + (j0 >= 1024 ? 128 : 0);
                tr_item8(P.w_in, NIN, P.g1, WSCALE, 64 * kb, 32 * nb, P.ws + WS_WIN8 + (size_t)drow * 2048 + 64 * kb, 2048, scr, lane); } }
        else { const int r = it - I_IN, kb = r >> 6, nb = r & 63; tr_item(P.w_out, 2048, nullptr, 64 * kb, 32 * nb, WOUT + (size_t)(32 * nb) * 2048 + 64 * kb, 2048, scr, lane); }
    }
    { bf16* WR = (bf16*)(P.ws + WS_WR);
      for (int it = gw; it < 32; it += NGW) tr_item(P.wer, 32, P.g2, 64 * it, 0, WR + 64 * it, 2048, scr, lane);
      for (int k = gw * 64 + lane; k < 2048; k += NGW * 64) { const float gk = P.g2[k]; const f32x4 w = *(const f32x4*)(P.wgr + (size_t)k * 4);
          WR[(size_t)128 * 2048 + k] = (bf16)f2bf(w.x * gk); WR[(size_t)129 * 2048 + k] = (bf16)f2bf(w.y * gk); WR[(size_t)130 * 2048 + k] = (bf16)f2bf(w.z * gk); WR[(size_t)131 * 2048 + k] = (bf16)f2bf(w.w * gk); } }
    bf16* XB = (bf16*)(P.ws + WS_XB); float* RS1 = (float*)(P.ws + WS_RSTD1);
    for (int m0 = gw; m0 < T; m0 += 2 * NGW) {
        f32x4 v[2][8]; float ss[2] = {0.f, 0.f};
#pragma unroll
        for (int q = 0; q < 2; ++q) { const int mr = (m0 + q * NGW < T) ? m0 + q * NGW : T - 1; const GAS f32x4* xr = (const GAS f32x4*)(P.x + (size_t)mr * D) + lane;
#pragma unroll
            for (int j = 0; j < 8; ++j) v[q][j] = xr[64 * j]; }
#pragma unroll
        for (int q = 0; q < 2; ++q) { const int m = m0 + q * NGW; if (m >= T) continue;
#pragma unroll
            for (int j = 0; j < 8; ++j) ss[q] += (v[q][j].x * v[q][j].x + v[q][j].y * v[q][j].y) + (v[q][j].z * v[q][j].z + v[q][j].w * v[q][j].w);
            ss[q] = wave_sum(ss[q]);
            if (lane == 0) RS1[m] = 1.0f / sqrtf(ss[q] * (1.0f / D) + EPS);
            GAS unsigned long long* o8 = (GAS unsigned long long*)(XB + (size_t)m * D) + lane; GAS unsigned* o4 = (GAS unsigned*)(P.ws + WS_X8 + (size_t)m * D) + lane;
#pragma unroll
            for (int j = 0; j < 8; ++j) { o8[64 * j] = (unsigned long long)pk2(v[q][j].x, v[q][j].y) | ((unsigned long long)pk2(v[q][j].z, v[q][j].w) << 32); o4[64 * j] = pg8::pk4_fp8(v[q][j].x, v[q][j].y, v[q][j].z, v[q][j].w); } }
    }
}

constexpr int CVT_ITEMS = 3 * 32768, CVT_CH = 4, CVT_CHUNK = CVT_CH * NWAVES, CVT_NCHUNK = CVT_ITEMS / CVT_CHUNK;
struct MoeItem { const float* src; const float* gk; unsigned char* dst; int N, k0, n0, dstK; };
__device__ __forceinline__ MoeItem moe_decode(const Ptrs& P, int r) {
    unsigned char* WGU = P.ws + WS_WGU; unsigned char* WD = P.ws + WS_WD; MoeItem m;
    const int mat = r >> 15, r2 = r & 32767, e = r2 >> 10, idx = r2 & 1023;
    if (mat < 2) { const int kb = idx >> 5, n0 = 32 * (idx & 31); const int drow = e * 2048 + 256 * (n0 >> 7) + (n0 & 127) + (mat == 1 ? 128 : 0);
        m.src = (mat == 0 ? P.w_gate : P.w_up) + (size_t)e * 2048 * 1024; m.N = 1024; m.gk = P.g2; m.k0 = 64 * kb; m.n0 = n0; m.dst = WGU + (size_t)drow * 2048 + 64 * kb; m.dstK = 2048; }
    else { const int kb = idx >> 6, nb = idx & 63; m.src = P.w_down + (size_t)e * 1024 * 2048; m.N = 2048; m.gk = nullptr; m.k0 = 64 * kb; m.n0 = 32 * nb; m.dst = WD + ((size_t)e * 2048 + 32 * nb) * 1024 + 64 * kb; m.dstK = 1024; }
    return m;
}
__device__ __forceinline__ void cvt_fill(const Ptrs& P, LAS unsigned char* lds, volatile LAS unsigned* slot, int max_chunks, const unsigned* donew, int G) {
    int tid_ = threadIdx.x; asm volatile("" : "+v"(tid_)); const int lane = tid_ & 63, wave = __builtin_amdgcn_readfirstlane(tid_ >> 6);
    LAS float* scr = (LAS float*)(lds + RING_OFF + wave * 16384); unsigned* ctr = (unsigned*)(P.ws + WS_CTL) + CW_CVQ;
    for (int n = 0; n < max_chunks; ++n) {
        if (threadIdx.x == 0) { unsigned v = 0xffffffffu;
            if (!(donew && (int)__hip_atomic_load(donew, __ATOMIC_RELAXED, __HIP_MEMORY_SCOPE_AGENT) >= G - 16)) v = __hip_atomic_fetch_add(ctr, 1u, __ATOMIC_RELAXED, __HIP_MEMORY_SCOPE_AGENT);
            *slot = v; }
        __syncthreads(); const unsigned c = *slot; __syncthreads();
        if (c >= (unsigned)CVT_NCHUNK) break;
#pragma unroll 1
        for (int j = 0; j < CVT_CH; j += 2) {
            const MoeItem m0 = moe_decode(P, (int)c * CVT_CHUNK + wave * CVT_CH + j), m1 = moe_decode(P, (int)c * CVT_CHUNK + wave * CVT_CH + j + 1);
            f32x4 v0[8], v1[8]; tr8_load(m0.src, m0.N, m0.k0, m0.n0, lane, v0); tr8_load(m1.src, m1.N, m1.k0, m1.n0, lane, v1);
            tr8_finish(v0, m0.gk, WSCALE, m0.k0, m0.dst, m0.dstK, scr, lane); tr8_finish(v1, m1.gk, WSCALE, m1.k0, m1.dst, m1.dstK, scr, lane); }
    }
}
__device__ __forceinline__ void h8_fill(const Ptrs& P, const bf16* HB, unsigned char* H8, volatile LAS unsigned* slot) {
    int tid_ = threadIdx.x; asm volatile("" : "+v"(tid_)); const int lane = tid_ & 63, wave = __builtin_amdgcn_readfirstlane(tid_ >> 6);
    unsigned* ctr = (unsigned*)(P.ws + WS_CTL) + CW_H8Q;
    for (;;) { const int c = attn_body::wg_pop(ctr, slot); if (c >= T / 64) break;
#pragma unroll 1
        for (int j = 0; j < 8; j += 4) { const int r0 = c * 64 + wave * 8 + j; u32x4g a[4][4];
#pragma unroll
            for (int q = 0; q < 4; ++q)
#pragma unroll
                for (int i = 0; i < 4; ++i) a[q][i] = *(const u32x4g*)(HB + (size_t)(r0 + q) * D + 16 * lane + 1024 * (i >> 1) + 8 * (i & 1));
#pragma unroll
            for (int q = 0; q < 4; ++q)
#pragma unroll
                for (int hj = 0; hj < 2; ++hj) { const u32x4g w0 = a[q][2 * hj], w1 = a[q][2 * hj + 1]; v4u o;
                    o.x = pg8::pk4_fp8(bflo(w0.x), bfhi(w0.x), bflo(w0.y), bfhi(w0.y)); o.y = pg8::pk4_fp8(bflo(w0.z), bfhi(w0.z), bflo(w0.w), bfhi(w0.w));
                    o.z = pg8::pk4_fp8(bflo(w1.x), bfhi(w1.x), bflo(w1.y), bfhi(w1.y)); o.w = pg8::pk4_fp8(bflo(w1.z), bfhi(w1.z), bflo(w1.w), bfhi(w1.w));
                    *(v4u*)(H8 + (size_t)(r0 + q) * D + 16 * lane + 1024 * hj) = o; } }
    }
}
__device__ __forceinline__ void router_skinny(const Ptrs& P, const bf16* HB, unsigned char* H8, LAS unsigned char* lds, int G) {
    int tid_ = threadIdx.x; asm volatile("" : "+v"(tid_)); const int tid = tid_, lane = tid & 63, wave = __builtin_amdgcn_readfirstlane(tid >> 6), fr = lane & 15, fq = lane >> 4;
    constexpr int BROW = 1040, BBUF = 48 * BROW;
    const bf16* WR = (const bf16*)(P.ws + WS_WR);
    LAS unsigned char* Bb = lds + RING_OFF; LAS float* LX = (LAS float*)(lds + RING_OFF + 2 * BBUF) + wave * (16 * 37);
    LAS unsigned* cntL = (LAS unsigned*)(lds + RING_OFF + 2 * BBUF + 8 * 16 * 37 * 4); LAS unsigned* baseL = cntL + 32;
    const float* part = (const float*)(P.ws + WS_PART); float* listr = (float*)(P.ws + WS_LISTR); float* listw = (float*)(P.ws + WS_LISTW); int* list = (int*)(P.ws + WS_LIST);
    unsigned* cnt = (unsigned*)(P.ws + WS_CTL) + CW_CNT;
    int brow[6], bcol[6];
#pragma unroll
    for (int i = 0; i < 6; ++i) { const int pc = tid + 512 * i; brow[i] = pc >> 6; bcol[i] = pc & 63; }
    for (int u = blockIdx.x; u < T / 128; u += G) {
        const int r0 = u * 128 + wave * 16;
        const bf16* arow = HB + (size_t)(r0 + fr) * D + 16 * fq;
        unsigned char* orow = H8 + (size_t)(r0 + fr) * D + 16 * fq;
        u32x4g bs[6], a[2][16]; pg8::f32x4 acc[3];
#pragma unroll
        for (int nb = 0; nb < 3; ++nb) acc[nb] = (pg8::f32x4){0.f, 0.f, 0.f, 0.f};
#define RS_LOADB(c) do { _Pragma("unroll") for (int i = 0; i < 6; ++i) { const int sr = brow[i] < 32 ? brow[i] : 128 + ((brow[i] - 32) & 3); \
            bs[i] = *(const u32x4g*)(WR + (size_t)sr * D + 512 * (c) + 8 * bcol[i]); } } while (0)
#define RS_STOREB(c) do { _Pragma("unroll") for (int i = 0; i < 6; ++i) *(LAS u32x4g*)(Bb + ((c) & 1) * BBUF + brow[i] * BROW + bcol[i] * 16) = bs[i]; } while (0)
#define RS_LOADA(c) do { _Pragma("unroll") for (int s = 0; s < 16; ++s) a[(c) & 1][s] = *(const u32x4g*)(arow + 512 * (c) + 64 * (s >> 1) + 8 * (s & 1)); } while (0)
        RS_LOADB(0); RS_LOADA(0); RS_STOREB(0);
#pragma unroll
        for (int c = 0; c < 4; ++c) {
            __syncthreads();
            if (c < 3) { RS_LOADB(c + 1); RS_LOADA(c + 1); }
#pragma unroll
            for (int s = 0; s < 16; ++s) {
                const pg8::bf16x8 af = __builtin_bit_cast(pg8::bf16x8, a[c & 1][s]);
#pragma unroll
                for (int nb = 0; nb < 3; ++nb) {
                    const pg8::bf16x8 bf = *(const LAS pg8::bf16x8*)(Bb + (c & 1) * BBUF + (16 * nb + fr) * BROW + (64 * (s >> 1) + 16 * fq + 8 * (s & 1)) * 2);
                    acc[nb] = __builtin_amdgcn_mfma_f32_16x16x32_bf16(af, bf, acc[nb], 0, 0, 0); }
            }
            if (c < 3) RS_STOREB(c + 1);
#pragma unroll
            for (int s = 0; s < 16; s += 2) { const u32x4g w0 = a[c & 1][s], w1 = a[c & 1][s + 1]; v4u o;
                o.x = pg8::pk4_fp8(bflo(w0.x), bfhi(w0.x), bflo(w0.y), bfhi(w0.y)); o.y = pg8::pk4_fp8(bflo(w0.z), bfhi(w0.z), bflo(w0.w), bfhi(w0.w));
                o.z = pg8::pk4_fp8(bflo(w1.x), bfhi(w1.x), bflo(w1.y), bfhi(w1.y)); o.w = pg8::pk4_fp8(bflo(w1.z), bfhi(w1.z), bflo(w1.w), bfhi(w1.w));
                *(v4u*)(orow + 512 * c + 64 * (s >> 1)) = o; }
        }
#undef RS_LOADB
#undef RS_STOREB
#undef RS_LOADA
#pragma unroll
        for (int nb = 0; nb < 3; ++nb)
#pragma unroll
            for (int r = 0; r < 4; ++r) if (nb < 2 || fr < 4) LX[(4 * fq + r) * 37 + 16 * nb + fr] = acc[nb][r];
        if (tid < 32) cntL[tid] = 0u;
        __syncthreads();
        int ea = 0, eb = 0, row = 0; unsigned ra = 0u, rb = 0u; float w1 = 0.f, w2 = 0.f, rstd = 0.f;
        if (lane < 16) { row = r0 + lane; const LAS float* lx = LX + lane * 37;
            float sq[4];
#pragma unroll
            for (int q = 0; q < 4; ++q) { const pg8::f32x4 p0 = *(const pg8::f32x4*)(part + (size_t)row * 32 + 8 * q), p1 = *(const pg8::f32x4*)(part + (size_t)row * 32 + 8 * q + 4);
                sq[q] = ((p0[0] + p0[1]) + (p0[2] + p0[3])) + ((p1[0] + p1[1]) + (p1[2] + p1[3])); }
            const float ss = (sq[0] + sq[1]) + (sq[2] + sq[3]);
            rstd = 1.0f / sqrtf(ss * (1.0f / 2048.0f) + 1e-6f);
            float g[4];
#pragma unroll
            for (int i = 0; i < 4; ++i) g[i] = lx[32 + i] * rstd + P.bgr[i];
            int gs = 0; float gm = g[0];
#pragma unroll
            for (int i = 1; i < 4; ++i) if (g[i] > gm) { gm = g[i]; gs = i; }
            float gsum = 0.f;
#pragma unroll
            for (int i = 0; i < 4; ++i) gsum += __expf(g[i] - gm);
            const float gw = 1.0f / gsum;
            float ev[8];
#pragma unroll
            for (int i = 0; i < 8; ++i) ev[i] = lx[8 * gs + i] * rstd + P.ber[8 * gs + i];
            int i1 = 0; float v1 = ev[0];
#pragma unroll
            for (int i = 1; i < 8; ++i) if (ev[i] > v1) { v1 = ev[i]; i1 = i; }
            int i2 = -1; float v2 = -3.0e38f;
#pragma unroll
            for (int i = 0; i < 8; ++i) if (i != i1 && ev[i] > v2) { v2 = ev[i]; i2 = i; }
            const float e2 = __expf(v2 - v1); w1 = gw / (1.f + e2); w2 = gw * e2 / (1.f + e2);
            ea = gs * 8 + i1; eb = gs * 8 + i2;
            ra = __hip_atomic_fetch_add(cntL + ea, 1u, __ATOMIC_RELAXED, __HIP_MEMORY_SCOPE_WORKGROUP);
            rb = __hip_atomic_fetch_add(cntL + eb, 1u, __ATOMIC_RELAXED, __HIP_MEMORY_SCOPE_WORKGROUP); }
        __syncthreads();
        if (tid < 32) { const unsigned n = cntL[tid]; baseL[tid] = n ? __hip_atomic_fetch_add(cnt + 64 * tid, n, __ATOMIC_RELAXED, __HIP_MEMORY_SCOPE_AGENT) : 0u; }
        __syncthreads();
        if (lane < 16) { const size_t ia = (size_t)ea * T + baseL[ea] + ra, ib = (size_t)eb * T + baseL[eb] + rb;
            list[ia] = 2 * row; list[ib] = 2 * row + 1; listw[ia] = w1; listw[ib] = w2; listr[ia] = rstd; listr[ib] = rstd; }
    }
    __syncthreads();
}
__device__ __forceinline__ void phase_tail(const Ptrs& P, LAS unsigned char* lds, volatile LAS unsigned* slot, int ph, int G) {
    unsigned* donew = (unsigned*)(P.ws + WS_CTL) + CW_DONE + 64 * ph;
    __syncthreads();
    if (threadIdx.x == 0) __hip_atomic_fetch_add(donew, 1u, __ATOMIC_RELAXED, __HIP_MEMORY_SCOPE_AGENT);
    cvt_fill(P, lds, slot, 1 << 30, donew, G);
}

__device__ __forceinline__ void naive_attn(const Ptrs& P, const bf16* Q, const bf16* Kb, const bf16* Vb, bf16* MIX, int lane, int gw, int NGW) {
    const float s1 = wave_sum(P.lq1[lane] * P.lk1[lane]), s2 = wave_sum(P.lq2[lane] * P.lk2[lane]);
    const float lam0 = 0.2f, lam = expf(s1) - expf(s2) + lam0;
    const int r16 = lane & 15, c = (lane >> 4) & 1, vh = lane >> 5;
    for (int u = gw; u < 16384; u += NGW) {
        const int bh = u & 63, qb = 255 - (u >> 6), b = bh >> 3, h = bh & 7, i = qb * 16 + r16, jmax = qb * 16 + 15;
        const float sl2 = exp2f(-(float)(h + 1)) * LOG2E; const size_t rowb = (size_t)b * SEQ;
        float q[64], O[64];
        { const u32x4g* qp = (const u32x4g*)(Q + (rowb + i) * 1024 + h * 128 + c * 64);
#pragma unroll
          for (int d8 = 0; d8 < 8; ++d8) { const u32x4g w = qp[d8]; q[8 * d8 + 0] = bflo(w.x); q[8 * d8 + 1] = bfhi(w.x); q[8 * d8 + 2] = bflo(w.y); q[8 * d8 + 3] = bfhi(w.y);
              q[8 * d8 + 4] = bflo(w.z); q[8 * d8 + 5] = bfhi(w.z); q[8 * d8 + 6] = bflo(w.w); q[8 * d8 + 7] = bfhi(w.w); } }
#pragma unroll
        for (int d = 0; d < 64; ++d) O[d] = 0.f;
        float m = -1e30f, l = 0.f;
        for (int j = 0; j <= jmax; ++j) {
            const u32x4g* kp = (const u32x4g*)(Kb + (rowb + j) * 1024 + h * 128 + c * 64); float s = 0.f;
#pragma unroll
            for (int d8 = 0; d8 < 8; ++d8) { const u32x4g w = kp[d8];
                s += q[8 * d8 + 0] * bflo(w.x) + q[8 * d8 + 1] * bfhi(w.x) + q[8 * d8 + 2] * bflo(w.y) + q[8 * d8 + 3] * bfhi(w.y)
                   + q[8 * d8 + 4] * bflo(w.z) + q[8 * d8 + 5] * bfhi(w.z) + q[8 * d8 + 6] * bflo(w.w) + q[8 * d8 + 7] * bfhi(w.w); }
            s += sl2 * (float)(j - i);
            if (j <= i) {
                if (s > m) { const float al = fexp2(m - s); l *= al;
#pragma unroll
                    for (int d = 0; d < 64; ++d) O[d] *= al;
                    m = s; }
                const float p = fexp2(s - m); l += p;
                const u32x4g* vp = (const u32x4g*)(Vb + (rowb + j) * 1024 + h * 128 + vh * 64);
#pragma unroll
                for (int d8 = 0; d8 < 8; ++d8) { const u32x4g w = vp[d8];
                    O[8 * d8 + 0] += p * bflo(w.x); O[8 * d8 + 1] += p * bfhi(w.x); O[8 * d8 + 2] += p * bflo(w.y); O[8 * d8 + 3] += p * bfhi(w.y);
                    O[8 * d8 + 4] += p * bflo(w.z); O[8 * d8 + 5] += p * bfhi(w.z); O[8 * d8 + 6] += p * bflo(w.w); O[8 * d8 + 7] += p * bfhi(w.w); }
            }
        }
        const float il = 1.0f / l; float ss = 0.f;
#pragma unroll
        for (int d = 0; d < 64; ++d) { float o = O[d] * il; const float o2 = __shfl_xor(o, 16); o = o - lam * o2; O[d] = o; ss += o * o; }
        ss += __shfl_xor(ss, 32);
        const float r = (1.0f / sqrtf(ss * (1.0f / 128.0f) + EPS)) * (1.0f - lam0);
        if (c == 0) { u32x4g* op = (u32x4g*)(MIX + (rowb + i) * 2048 + h * 128 + vh * 64); const float* sg = P.subg + vh * 64;
#pragma unroll
            for (int d8 = 0; d8 < 8; ++d8) { u32x4g w; w.x = pk2(O[8 * d8 + 0] * r * sg[8 * d8 + 0], O[8 * d8 + 1] * r * sg[8 * d8 + 1]); w.y = pk2(O[8 * d8 + 2] * r * sg[8 * d8 + 2], O[8 * d8 + 3] * r * sg[8 * d8 + 3]);
                w.z = pk2(O[8 * d8 + 4] * r * sg[8 * d8 + 4], O[8 * d8 + 5] * r * sg[8 * d8 + 5]); w.w = pk2(O[8 * d8 + 6] * r * sg[8 * d8 + 6], O[8 * d8 + 7] * r * sg[8 * d8 + 7]); op[d8] = w; } }
    }
}

typedef float f32x2c __attribute__((ext_vector_type(2)));
__device__ __forceinline__ void conv_phase(const Ptrs& P, const bf16* CA, bf16* MIX, LAS unsigned char* lds, int blk, unsigned* qctr, volatile LAS unsigned* slot) {
    int tid_ = threadIdx.x; asm volatile("" : "+v"(tid_)); const int tid = tid_, lane = tid & 63, wave = __builtin_amdgcn_readfirstlane(tid >> 6);
    LAS unsigned* C = (LAS unsigned*)(lds + RING_OFF);
    f32x2c w[31];
#pragma unroll
    for (int j = 0; j < 31; ++j) w[j] = *(const f32x2c*)(P.cw + j * 1024 + 2 * tid);
    const f32x2c bias = *(const f32x2c*)(P.cb + 2 * tid);
    for (int qi = 0; qi < 8; ++qi) { const int xq = (blk + qi) & 7;
    for (;;) { const int n_ = attn_body::wg_pop(qctr + 64 * xq, slot); if (n_ >= 64) break;
        const int tile = xq + 8 * n_, b = tile >> 6, t0 = (tile & 63) * 64; const size_t rowb = (size_t)b * SEQ;
        const unsigned* up = (const unsigned*)(CA + rowb * 1024 + 2 * tid);
        f32x2c win[38]; unsigned hist[30];
#pragma unroll
        for (int k = 0; k < 30; ++k) { const int t = t0 - 30 + k; hist[k] = (t >= 0) ? up[(size_t)t * 512] : 0u; }
        unsigned nw[8];
#pragma unroll
        for (int i = 0; i < 8; ++i) nw[i] = up[(size_t)(t0 + i) * 512];
#pragma unroll
        for (int k = 0; k < 30; ++k) win[k] = (f32x2c){bflo(hist[k]), bfhi(hist[k])};
#pragma unroll 1
        for (int blk8 = 0; blk8 < 8; ++blk8) {
#pragma unroll
            for (int i = 0; i < 8; ++i) win[30 + i] = (f32x2c){bflo(nw[i]), bfhi(nw[i])};
            if (blk8 < 7) {
#pragma unroll
                for (int i = 0; i < 8; ++i) nw[i] = up[(size_t)(t0 + 8 * (blk8 + 1) + i) * 512];
            }
#pragma unroll
            for (int i = 0; i < 8; ++i) { f32x2c acc = bias;
#pragma unroll
                for (int j = 0; j < 31; ++j) acc = w[j] * win[i + j] + acc;
                C[(8 * blk8 + i) * 512 + tid] = pk2(acc.x, acc.y); }
#pragma unroll
            for (int k = 0; k < 30; ++k) win[k] = win[k + 8];
        }
        __syncthreads();
#pragma unroll 1
        for (int k = 0; k < 8; ++k) { const int rr = wave + 8 * k, t = t0 + rr; const LAS unsigned* row = C + rr * 512;
            const v4u x0 = *(const LAS v4u*)(row + 4 * lane), x1 = *(const LAS v4u*)(row + 256 + 4 * lane);
            float v[16] = {bflo(x0.x), bfhi(x0.x), bflo(x0.y), bfhi(x0.y), bflo(x0.z), bfhi(x0.z), bflo(x0.w), bfhi(x0.w), bflo(x1.x), bfhi(x1.x), bflo(x1.y), bfhi(x1.y), bflo(x1.z), bfhi(x1.z), bflo(x1.w), bfhi(x1.w)};
            float s = 0.f;
#pragma unroll
            for (int i = 0; i < 16; ++i) s += v[i];
            const float mean = wave_sum(s) * (1.0f / 1024.0f); float qq = 0.f;
#pragma unroll
            for (int i = 0; i < 16; ++i) { v[i] -= mean; qq += v[i] * v[i]; }
            const float rstd = 1.0f / sqrtf(wave_sum(qq) * (1.0f / 1024.0f) + EPS);
            float y[16];
#pragma unroll
            for (int i = 0; i < 16; ++i) { const int ch = (i < 8 ? 8 * lane + i : 512 + 8 * lane + (i - 8)); const float z = v[i] * rstd * P.lng[ch] + P.lnb[ch]; y[i] = z / (1.f + __expf(-z)); }
            bf16* op = MIX + (rowb + t) * 2048 + 1024 + 8 * lane;
            v4u o0, o1; o0.x = pk2(y[0], y[1]); o0.y = pk2(y[2], y[3]); o0.z = pk2(y[4], y[5]); o0.w = pk2(y[6], y[7]); o1.x = pk2(y[8], y[9]); o1.y = pk2(y[10], y[11]); o1.z = pk2(y[12], y[13]); o1.w = pk2(y[14], y[15]);
            *(GAS v4u*)op = o0; *(GAS v4u*)(op + 512) = o1; }
        __syncthreads();
    } }
}

__device__ __forceinline__ void router_phase(const Ptrs& P, const bf16* HB, int lane, int gw, int NGW) {
    float* RS2 = (float*)(P.ws + WS_RSTD2); float* WTS = (float*)(P.ws + WS_WTS); int* LIST = (int*)(P.ws + WS_LIST); unsigned* CNT = (unsigned*)(P.ws + WS_CTL) + CW_CNT;
    for (int tok = gw; tok < T; tok += NGW) {
        float hv[32]; const bf16* hp = HB + (size_t)tok * D; float ss = 0.f;
#pragma unroll
        for (int j = 0; j < 4; ++j) { const u32x4g w = *(const u32x4g*)(hp + 8 * lane + 512 * j);
            hv[8 * j + 0] = bflo(w.x); hv[8 * j + 1] = bfhi(w.x); hv[8 * j + 2] = bflo(w.y); hv[8 * j + 3] = bfhi(w.y); hv[8 * j + 4] = bflo(w.z); hv[8 * j + 5] = bfhi(w.z); hv[8 * j + 6] = bflo(w.w); hv[8 * j + 7] = bfhi(w.w); }
#pragma unroll
        for (int k = 0; k < 32; ++k) ss += hv[k] * hv[k];
        ss = wave_sum(ss); const float rstd = 1.0f / sqrtf(ss * (1.0f / D) + EPS);
        float lg[36];
#pragma unroll
        for (int o = 0; o < 36; ++o) lg[o] = 0.f;
#pragma unroll
        for (int j = 0; j < 4; ++j)
#pragma unroll 2
            for (int i = 0; i < 8; ++i) { const int e = 8 * lane + 512 * j + i; const float xv = hv[8 * j + i] * P.g2[e];
                const f32x4* wr = (const f32x4*)(P.wer + (size_t)e * 32); const f32x4 wg = *(const f32x4*)(P.wgr + (size_t)e * 4);
#pragma unroll
                for (int o4 = 0; o4 < 8; ++o4) { const f32x4 w = wr[o4]; lg[4 * o4 + 0] += xv * w.x; lg[4 * o4 + 1] += xv * w.y; lg[4 * o4 + 2] += xv * w.z; lg[4 * o4 + 3] += xv * w.w; }
                lg[32] += xv * wg.x; lg[33] += xv * wg.y; lg[34] += xv * wg.z; lg[35] += xv * wg.w; }
#pragma unroll
        for (int o = 0; o < 36; ++o) lg[o] = wave_sum(lg[o]) * rstd + (o < 32 ? P.ber[o] : P.bgr[o - 32]);
        int gs = 0; float gm = lg[32];
#pragma unroll
        for (int g = 1; g < 4; ++g) if (lg[32 + g] > gm) { gm = lg[32 + g]; gs = g; }
        float gsum = 0.f;
#pragma unroll
        for (int g = 0; g < 4; ++g) gsum += __expf(lg[32 + g] - gm);
        const float gw_ = 1.0f / gsum;
        float ev[8];
#pragma unroll
        for (int i = 0; i < 8; ++i) ev[i] = gs == 0 ? lg[i] : gs == 1 ? lg[8 + i] : gs == 2 ? lg[16 + i] : lg[24 + i];
        int i1 = 0; float v1 = ev[0];
#pragma unroll
        for (int i = 1; i < 8; ++i) if (ev[i] > v1) { v1 = ev[i]; i1 = i; }
        int i2 = -1; float v2 = -3.0e38f;
#pragma unroll
        for (int i = 0; i < 8; ++i) if (i != i1 && ev[i] > v2) { v2 = ev[i]; i2 = i; }
        const float e2 = __expf(v2 - v1), w1 = gw_ / (1.f + e2), w2 = gw_ * e2 / (1.f + e2);
        if (lane == 0) {
            RS2[tok] = rstd;
            const int ea = gs * 8 + i1, eb = gs * 8 + i2;
            const unsigned ra = __hip_atomic_fetch_add(CNT + 64 * ea, 1u, __ATOMIC_RELAXED, __HIP_MEMORY_SCOPE_AGENT);
            const unsigned rb = __hip_atomic_fetch_add(CNT + 64 * eb, 1u, __ATOMIC_RELAXED, __HIP_MEMORY_SCOPE_AGENT);
            LIST[(size_t)ea * T + ra] = 2 * tok; LIST[(size_t)eb * T + rb] = 2 * tok + 1; WTS[2 * tok] = w1; WTS[2 * tok + 1] = w2;
        }
    }
}
__device__ __forceinline__ void moe_tables(const Ptrs& P, LAS unsigned char* lds) {
    int tid = threadIdx.x; asm volatile("" : "+v"(tid));
    LAS int* cntL = (LAS int*)(lds + TAB_OFF); LAS int* ts = cntL + 32; unsigned* CNT = (unsigned*)(P.ws + WS_CTL) + CW_CNT;
    if (tid < 32) cntL[tid] = (int)__hip_atomic_load(CNT + 64 * tid, __ATOMIC_RELAXED, __HIP_MEMORY_SCOPE_AGENT);
    __syncthreads();
    if (tid == 0) { int s = 0; for (int e = 0; e < 32; ++e) { ts[e] = s; s += (cntL[e] + 255) >> 8; } ts[32] = s; }
    __syncthreads();
}

__device__ __forceinline__ float fp8f(unsigned w, int i) { return i == 0 ? __builtin_amdgcn_cvt_f32_fp8(w, 0) : i == 1 ? __builtin_amdgcn_cvt_f32_fp8(w, 1) : i == 2 ? __builtin_amdgcn_cvt_f32_fp8(w, 2) : __builtin_amdgcn_cvt_f32_fp8(w, 3); }
__device__ __forceinline__ void final_phase(const Ptrs& P, const bf16* HB, const unsigned char* Y8, int NGW) {
    int tid_ = threadIdx.x; asm volatile("" : "+v"(tid_)); const int lane = tid_ & 63, gw = (int)blockIdx.x * NWAVES + __builtin_amdgcn_readfirstlane(tid_ >> 6);
    for (int tok = gw; tok < T; tok += NGW) {
        const bf16* hp = HB + (size_t)tok * D; const unsigned char* y1 = Y8 + (size_t)tok * 4096; const unsigned char* y2 = y1 + 2048; float v[32]; float ss = 0.f;
#pragma unroll
        for (int j = 0; j < 4; ++j) { const int o = 8 * lane + 512 * j; const u32x4g a = *(const u32x4g*)(hp + o); const pg8::u32x2 b = *(const pg8::u32x2*)(y1 + o), c = *(const pg8::u32x2*)(y2 + o);
            const float ys = 1.0f / YSCALE;
            v[8 * j + 0] = bflo(a.x) + (fp8f(b.x, 0) + fp8f(c.x, 0)) * ys; v[8 * j + 1] = bfhi(a.x) + (fp8f(b.x, 1) + fp8f(c.x, 1)) * ys; v[8 * j + 2] = bflo(a.y) + (fp8f(b.x, 2) + fp8f(c.x, 2)) * ys; v[8 * j + 3] = bfhi(a.y) + (fp8f(b.x, 3) + fp8f(c.x, 3)) * ys;
            v[8 * j + 4] = bflo(a.z) + (fp8f(b.y, 0) + fp8f(c.y, 0)) * ys; v[8 * j + 5] = bfhi(a.z) + (fp8f(b.y, 1) + fp8f(c.y, 1)) * ys; v[8 * j + 6] = bflo(a.w) + (fp8f(b.y, 2) + fp8f(c.y, 2)) * ys; v[8 * j + 7] = bfhi(a.w) + (fp8f(b.y, 3) + fp8f(c.y, 3)) * ys; }
#pragma unroll
        for (int k = 0; k < 32; ++k) ss += v[k] * v[k];
        ss = wave_sum(ss); const float rstd = 1.0f / sqrtf(ss * (1.0f / D) + EPS);
        float* op = P.out + (size_t)tok * D;
#pragma unroll
        for (int j = 0; j < 4; ++j) { const int o = 8 * lane + 512 * j; const f32x4 g0 = *(const f32x4*)(P.gf + o), g1 = *(const f32x4*)(P.gf + o + 4);
            f32x4 r0 = {v[8 * j + 0] * rstd * g0.x, v[8 * j + 1] * rstd * g0.y, v[8 * j + 2] * rstd * g0.z, v[8 * j + 3] * rstd * g0.w};
            f32x4 r1 = {v[8 * j + 4] * rstd * g1.x, v[8 * j + 5] * rstd * g1.y, v[8 * j + 6] * rstd * g1.z, v[8 * j + 7] * rstd * g1.w};
            *(f32x4*)(op + o) = r0; *(f32x4*)(op + o + 4) = r1; }
    }
}

struct Args { const float* in[22]; float* out; unsigned char* ws; int ph_lo, ph_hi; };
__global__ void __launch_bounds__(NWAVES * 64, 2) fwd(Args args) {
    extern __shared__ __attribute__((aligned(16))) unsigned char lds_raw[];
    LAS unsigned char* lds = (LAS unsigned char*)lds_raw;
    volatile LAS unsigned* MISC = (volatile LAS unsigned*)(lds + MISC_OFF);
    const int tid = threadIdx.x, lane = tid & 63, wave = __builtin_amdgcn_readfirstlane(tid >> 6), G = gridDim.x;
    const int gw = blockIdx.x * NWAVES + wave, NGW = G * NWAVES;
    Ptrs P;
    P.x = args.in[0]; P.g1 = args.in[1]; P.w_in = args.in[2]; P.lq1 = args.in[3]; P.lk1 = args.in[4]; P.lq2 = args.in[5]; P.lk2 = args.in[6]; P.subg = args.in[7];
    P.cw = args.in[8]; P.cb = args.in[9]; P.lng = args.in[10]; P.lnb = args.in[11]; P.w_out = args.in[12]; P.g2 = args.in[13]; P.wgr = args.in[14]; P.bgr = args.in[15];
    P.wer = args.in[16]; P.ber = args.in[17]; P.w_gate = args.in[18]; P.w_up = args.in[19]; P.w_down = args.in[20]; P.gf = args.in[21]; P.out = args.out; P.ws = args.ws;
    unsigned char* ws = args.ws;
#define WIN ((bf16*)(ws + WS_WIN))
#define WOUT ((bf16*)(ws + WS_WOUT))
#define WGU (ws + WS_WGU)
#define WD (ws + WS_WD)
#define XB ((bf16*)(ws + WS_XB))
#define H1 (ws + WS_XB)
#define HB8 (ws + WS_HB8)
#define CGB ((bf16*)(ws + WS_CG))
#define MIX ((bf16*)(ws + WS_MIX))
#define HB ((bf16*)(ws + WS_HB))
#define QB ((bf16*)P.out)
#define KB (QB + (size_t)T * 1024)
#define VB (QB + (size_t)T * 2048)
#define CAB (QB + (size_t)T * 3072)
#define YB ((bf16*)P.out)
#define RELOAD_ARGS() do { const __attribute__((address_space(4))) Args* ka_ = (const __attribute__((address_space(4))) Args*)__builtin_amdgcn_kernarg_segment_ptr(); asm volatile("" : "+s"(ka_)); \
    P.x = ka_->in[0]; P.g1 = ka_->in[1]; P.w_in = ka_->in[2]; P.lq1 = ka_->in[3]; P.lk1 = ka_->in[4]; P.lq2 = ka_->in[5]; P.lk2 = ka_->in[6]; P.subg = ka_->in[7]; \
    P.cw = ka_->in[8]; P.cb = ka_->in[9]; P.lng = ka_->in[10]; P.lnb = ka_->in[11]; P.w_out = ka_->in[12]; P.g2 = ka_->in[13]; P.wgr = ka_->in[14]; P.bgr = ka_->in[15]; \
    P.wer = ka_->in[16]; P.ber = ka_->in[17]; P.w_gate = ka_->in[18]; P.w_up = ka_->in[19]; P.w_down = ka_->in[20]; P.gf = ka_->in[21]; P.out = ka_->out; P.ws = ka_->ws; ws = ka_->ws; } while (0)
    for (int u = tid; u < (LDS_BYTES - LDSCTL_OFF) / 4; u += NWAVES * 64) ((LAS unsigned*)(lds + LDSCTL_OFF))[u] = 0u;
    __syncthreads();
    const int lo = args.ph_lo, hi = args.ph_hi;
    XcdBarrier bar; bar.bar = (unsigned*)(ws + WS_CTL) + CW_BAR; bar.x = 0; bar.st = nullptr;
    if (hi - lo > 1) bar = xcd_barrier_post((unsigned*)(ws + WS_CTL) + CW_BAR, MISC + 8);
#define IN(k) (lo <= (k) && (k) < hi)
#if PROBE_PHASE >= 0
    unsigned long long pst_[NPHASE + 1]; pst_[0] = __builtin_amdgcn_s_memrealtime();
#define SEAM(k) do { if (IN(k) && IN((k) + 1)) xcd_barrier(bar); pst_[(k) + 1] = __builtin_amdgcn_s_memrealtime(); } while (0)
#else
#define SEAM(k) do { if (IN(k) && IN((k) + 1)) xcd_barrier(bar); } while (0)
#endif
#define REP(k) for (int rep_ = 0; rep_ <= ((PROBE_DOUBLE >> (k)) & 1); ++rep_)

    if (IN(0)) REP(0) { p0_prologue(P, lds, lane, wave, gw, NGW); }
    SEAM(0);
#if PROBE_CLOCK
    const long long pc0 = clock64(), pr0 = wall_clock64();
#endif
    if (IN(1)) {
        cvt_fill(P, lds, MISC + 12, (int)((blockIdx.x >> 3) % 8), nullptr, G);
        for (int pass = 0; pass < 2; ++pass) {
            if ((pass ^ (int)(blockIdx.x & 1)) == 0) { pg8::Gemm g{XB, WIN, 1, 3072, D, (unsigned*)(ws + WS_CTL) + 3002}; pg8::DynDense S; S.init(T, 3072, (unsigned*)(ws + WS_CTL) + CW_GQ + 0 * 512, (volatile LAS int*)(MISC + 16), (int)blockIdx.x);
                pg8::EpiIn E{QB, (size_t)T * 1024, CGB, (const float*)(ws + WS_RSTD1), C2, (unsigned*)(ws + WS_CTL) + CW_NMAX, 0, 1.0f};
                pg8::gemm_phase<pg8::EpiIn, pg8::DynDense, true, false>(lds + RING_OFF, g, S, E); }
            else { pg8::Gemm g{(const bf16*)(ws + WS_X8), (const bf16*)(ws + WS_WIN8), 2, 2048, D / 2, (unsigned*)(ws + WS_CTL) + 3002}; pg8::DynDenseG S; S.init(T, 2048, (unsigned*)(ws + WS_CTL) + CW_GQ + 1 * 512, (volatile LAS int*)(MISC + 16), (int)blockIdx.x);
                pg8::EpiGLU E{CAB, (const float*)(ws + WS_RSTD1), 1.0f / WSCALE};
                pg8::gemm_phase<pg8::EpiGLU, pg8::DynDenseG, true, true, true>(lds + RING_OFF, g, S, E); }
        }
#if PROBE_ATT == 6
        if (threadIdx.x == 0) atomicMax((unsigned*)(ws + WS_CTL) + CW_NMAX + 900, (unsigned)(__builtin_amdgcn_s_memrealtime() - pst_[1]));
#endif
#if PROBE_ATT == 7
        if (threadIdx.x == 0) atomicAdd((unsigned*)(ws + WS_CTL) + CW_NMAX + 900, (unsigned)(__builtin_amdgcn_s_memrealtime() - pst_[1]) >> 8);
#endif
#if PROBE_ATT == 5
        if (blockIdx.x == PROBE_BLK && threadIdx.x == 0) atomicAdd((unsigned*)(ws + WS_CTL) + CW_NMAX + 900, (unsigned)(__builtin_amdgcn_s_memrealtime() - pst_[1]));
#endif
        phase_tail(P, lds, MISC + 12, 1, G);
    }
#if PROBE_CLOCK
    if (IN(1) && tid == 0) { const unsigned dt = (unsigned)(wall_clock64() - pr0); atomicAdd((unsigned*)(ws + WS_CTL) + 3000, dt); atomicMax((unsigned*)(ws + WS_CTL) + 3001, dt); }
#endif
    SEAM(1);
    if (IN(2)) {
#if USE_NAIVE_ATTN
        naive_attn(P, QB, KB, VB, MIX, lane, gw, NGW);
#else
        { float s1 = 0.f, s2 = 0.f;
          for (int i = 0; i < 64; ++i) { s1 += P.lq1[i] * P.lk1[i]; s2 += P.lq2[i] * P.lk2[i]; }
          const float lam0 = 0.2f, lam = expf(s1) - expf(s2) + lam0;
          static_assert(attn_body::ATTN_LDS_BYTES <= RING_BYTES, "attention LDS");
          attn_body::attn_phase<8>((char*)lds_raw + RING_OFF, (int)blockIdx.x, (unsigned*)(ws + WS_CTL) + CW_QA, MISC + 12, lam, 1.0f - lam0, P.subg, (const unsigned*)(ws + WS_CTL) + CW_NMAX, (unsigned*)(ws + WS_O1S) + (size_t)blockIdx.x * 16384,
                                   (const attn_body::bf16*)QB, (const attn_body::bf16*)KB, (const attn_body::bf16*)VB, (attn_body::bf16*)MIX); }
        RELOAD_ARGS();
#endif
        conv_phase(P, CAB, MIX, lds, (int)blockIdx.x, (unsigned*)(ws + WS_CTL) + CW_QC, MISC + 12);
#if PROBE_ATT == 2
        if (blockIdx.x == PROBE_BLK && threadIdx.x == 0) atomicAdd((unsigned*)(ws + WS_CTL) + CW_NMAX + 900, (unsigned)(__builtin_amdgcn_s_memrealtime() - pst_[2]));
#endif
        phase_tail(P, lds, MISC + 12, 2, G);
    }
    SEAM(2);
    if (IN(3)) {
        pg8::Gemm g{MIX, WOUT, 3, D, D, (unsigned*)(ws + WS_CTL) + 3002}; pg8::StaticOrder S; S.init(T, D, G, (int)blockIdx.x); S.rep = 1 + ((PROBE_DOUBLE >> 3) & 1);
        pg8::EpiOut E{HB, XB, (float*)(ws + WS_PART), nullptr};
        pg8::gemm_phase<pg8::EpiOut, pg8::StaticOrder, true, false>(lds + RING_OFF, g, S, E);
        phase_tail(P, lds, MISC + 12, 3, G);
    }
    SEAM(3);
#if PROBE_ATT == 9
    if (IN(4) && blockIdx.x == PROBE_BLK && threadIdx.x == 0) atomicAdd((unsigned*)(ws + WS_CTL) + CW_NMAX + 900, 10u * __hip_atomic_load((unsigned*)(ws + WS_CTL) + CW_CVQ, __ATOMIC_RELAXED, __HIP_MEMORY_SCOPE_AGENT));
#endif
#if USE_NAIVE_ROUTER
    if (IN(4)) { router_phase(P, HB, lane, gw, NGW); }
#else
    if (IN(4)) {
        router_skinny(P, HB, HB8, lds, G);
        phase_tail(P, lds, MISC + 12, 4, G);
#if PROBE_ATT == 8
        if (blockIdx.x == PROBE_BLK && threadIdx.x == 0) atomicAdd((unsigned*)(ws + WS_CTL) + CW_NMAX + 900, 10u * __hip_atomic_load((unsigned*)(ws + WS_CTL) + CW_CVQ, __ATOMIC_RELAXED, __HIP_MEMORY_SCOPE_AGENT));
#endif
        cvt_fill(P, lds, MISC + 12, 1 << 30, nullptr, G);
    }
#endif
    SEAM(4);
    if (IN(5)) {
        moe_tables(P, lds);
        pg8::Gemm g{(const bf16*)HB8, (const bf16*)WGU, 5, 2048, D / 2, (unsigned*)(ws + WS_CTL) + 3002};
        pg8::MoeOrder S{(const LAS int*)(lds + TAB_OFF) + 32, (const LAS int*)(lds + TAB_OFF), (const int*)(ws + WS_LIST), G, (int)blockIdx.x, 1, T, (size_t)2048 * 2048, 0};
        pg8::EpiGU E{H1, (const int*)(ws + WS_LIST), (const float*)(ws + WS_LISTR), 1.0f / WSCALE, H1SCALE};
        pg8::gemm_phase<pg8::EpiGU, pg8::MoeOrder, true, true, true>(lds + RING_OFF, g, S, E);
    }
    SEAM(5);
    if (IN(6)) {
        moe_tables(P, lds);
        pg8::Gemm g{(const bf16*)H1, (const bf16*)WD, 6, 2048, 512, (unsigned*)(ws + WS_CTL) + 3002};
        pg8::MoeOrder S{(const LAS int*)(lds + TAB_OFF) + 32, (const LAS int*)(lds + TAB_OFF), (const int*)(ws + WS_LIST), G, (int)blockIdx.x, 0, T, (size_t)2048 * 1024, 1};
        pg8::EpiDown E{ws + WS_MIX, (const int*)(ws + WS_LIST), (const float*)(ws + WS_LISTW), YSCALE / (WSCALE * H1SCALE)};
        pg8::gemm_phase<pg8::EpiDown, pg8::MoeOrder, true, true, true>(lds + RING_OFF, g, S, E);
    }
    SEAM(6);
    if (IN(7)) { final_phase(P, HB, ws + WS_MIX, NGW); }
#if PROBE_ATT
    if (blockIdx.x == 0) { const unsigned long long span = __hip_atomic_load((unsigned*)(ws + WS_CTL) + CW_NMAX + 900, __ATOMIC_RELAXED, __HIP_MEMORY_SCOPE_AGENT); const unsigned long long r1 = __builtin_amdgcn_s_memrealtime(); while (__builtin_amdgcn_s_memrealtime() - r1 < span) __builtin_amdgcn_s_sleep(8); }
#endif
#if PROBE_PHASE >= 0
    pst_[NPHASE] = __builtin_amdgcn_s_memrealtime();
    if (blockIdx.x == 0 && PROBE_PHASE < 100) { const unsigned long long span = pst_[(PROBE_PHASE < 100 ? PROBE_PHASE : 0) + 1] - pst_[PROBE_PHASE < 100 ? PROBE_PHASE : 0]; const unsigned long long r1 = __builtin_amdgcn_s_memrealtime(); while (__builtin_amdgcn_s_memrealtime() - r1 < span) __builtin_amdgcn_s_sleep(8); }
#endif
#if PROBE_KLOOP
    if (blockIdx.x == 0) { const long long pticks = (long long)__hip_atomic_load((unsigned*)(ws + WS_CTL) + 3002, __ATOMIC_RELAXED, __HIP_MEMORY_SCOPE_AGENT); const long long r1 = wall_clock64(); while (wall_clock64() - r1 < pticks) __builtin_amdgcn_s_sleep(8); }
#endif
#if PROBE_CLOCK
    if (blockIdx.x == 0) { const unsigned sum = __hip_atomic_load((unsigned*)(ws + WS_CTL) + 3000, __ATOMIC_RELAXED, __HIP_MEMORY_SCOPE_AGENT), mx = __hip_atomic_load((unsigned*)(ws + WS_CTL) + 3001, __ATOMIC_RELAXED, __HIP_MEMORY_SCOPE_AGENT);
        const long long pticks = (long long)mx - (long long)(sum / (unsigned)G); const long long r1 = wall_clock64(); while (wall_clock64() - r1 < pticks) __builtin_amdgcn_s_sleep(8); }
#endif
#undef IN
#undef SEAM
#undef REP
}

extern "C" void kernel_launch(void* const* d_in, const int* in_sizes, int n_in, void* d_out, int out_size, void* d_ws, size_t ws_size, hipStream_t stream) {
    static int grid = 0;
    if (grid == 0) {
        if (n_in != 22 || in_sizes[0] != T * D || out_size != T * D || ws_size < WS_END) { fprintf(stderr, "kernel_launch: unexpected shapes (n_in %d, in0 %d, out %d, ws %zu); nothing launched\n", n_in, n_in > 0 ? in_sizes[0] : -1, out_size, ws_size); grid = -1; return; }
        int dev = 0, cus = 0, per_cu = 0;
        if (hipGetDevice(&dev) != hipSuccess || hipDeviceGetAttribute(&cus, hipDeviceAttributeMultiprocessorCount, dev) != hipSuccess) { grid = -1; return; }
        if (hipFuncSetAttribute((const void*)fwd, hipFuncAttributeMaxDynamicSharedMemorySize, LDS_BYTES) != hipSuccess) { fprintf(stderr, "kernel_launch: hipFuncSetAttribute failed\n"); grid = -1; return; }
        if (hipOccupancyMaxActiveBlocksPerMultiprocessor(&per_cu, (const void*)fwd, NWAVES * 64, LDS_BYTES) != hipSuccess || per_cu < 1) fprintf(stderr, "kernel_launch: occupancy query reports %d\n", per_cu);
        (void)hipGetLastError();
        grid = cus;
    }
    if (grid < 0) return;
    if (hipMemsetAsync((char*)d_ws + WS_CTL, 0, CTL_ZERO_BYTES, stream) != hipSuccess) return;
    Args a{};
    for (int i = 0; i < 22; ++i) a.in[i] = (const float*)d_in[i];
    a.out = (float*)d_out; a.ws = (unsigned char*)d_ws;
#if MK_ONE_LAUNCH
    a.ph_lo = 0; a.ph_hi = NPHASE;
    hipLaunchKernelGGL(fwd, dim3(grid), dim3(NWAVES * 64), LDS_BYTES, stream, a);
#else
    for (int p = 0; p < NPHASE; ++p) { a.ph_lo = p; a.ph_hi = p + 1; hipLaunchKernelGGL(fwd, dim3(grid), dim3(NWAVES * 64), LDS_BYTES, stream, a); }
#endif
}
```

```cpp
#include <hip/hip_runtime.h>
#include <cstdio>
#include <cstdint>
#ifndef PROBE_KLOOP
#define PROBE_KLOOP 0
#endif
#ifndef PROBE_WHAT
#define PROBE_WHAT 0
#endif
#ifndef PROBE_PHASE
#define PROBE_PHASE -1
#endif
#ifndef PROBE_ATT
#define PROBE_ATT 0
#endif
#ifndef PROBE_BLK
#define PROBE_BLK 0
#endif
namespace pg8 {
#define PG8_LAS __attribute__((address_space(3)))
typedef unsigned short bf16_t;
typedef short bf16x8 __attribute__((ext_vector_type(8)));
typedef float f32x4 __attribute__((ext_vector_type(4)));
typedef unsigned u32x4 __attribute__((ext_vector_type(4)));
constexpr int BM = 256, BK = 64, HALF = 128, HTB = HALF * BK * 2  , STAGE_BYTES = 8 * HTB, NXCD = 8, WGM = 8;

__host__ __device__ __forceinline__ int lds_byte(int r, int c) { const int st = (r >> 4) * 2 + (c >> 5), rr = r & 15, cc = c & 31, ob = rr * 64 + cc * 2; return st * 1024 + (ob ^ (((ob >> 9) & 1) << 5)); }
__host__ __device__ __forceinline__ void stage_rc(int b, int& R, int& C) { const int st = b / 1024, sb = b % 1024, swz = sb ^ (((sb >> 9) & 1) << 5); R = (st >> 1) * 16 + swz / 64; C = (st & 1) * 32 + (swz % 64) / 2; }
__host__ __device__ __forceinline__ int perm32(int rho) { const int n = rho >> 4, i = rho & 15; return 8 * (i >> 2) + 4 * n + (i & 3); }

struct Unit { int pm, pn, e, nvalid, lbase, srow; };
struct Gemm { const bf16_t* A; const bf16_t* Bt; int M, N, K; unsigned* probe = nullptr; };

struct StaticOrder {
    int nM, nN, nwg, G, c, rep = 1;
    __host__ __device__ void init(int M, int N, int G_, int c_) { nM = M / BM; nN = N / BM; nwg = nM * nN; G = G_; c = c_; }
    __host__ __device__ bool next(int i, Unit& u) const {
        long L = (long)i * G + c; if (L >= (long)nwg * rep) return false; L %= nwg;
        int wgid = (int)L; { const int q = nwg / NXCD, r = nwg % NXCD, xcd = wgid % NXCD, off = wgid / NXCD; wgid = (xcd < r ? xcd * (q + 1) : r * (q + 1) + (xcd - r) * q) + off; }
        const int nig = WGM * nN, gid = wgid / nig, fm = gid * WGM, gsz = (nM - fm) < WGM ? (nM - fm) : WGM;
        u.pm = fm + ((wgid % nig) % gsz); u.pn = (wgid % nig) / gsz; return true;
    }
    __device__ __forceinline__ const char* bbase(const Gemm& g, const Unit& u, size_t tstep) const { return (const char*)g.Bt + (size_t)u.pn * tstep; }
    __device__ __forceinline__ unsigned goff(const Unit&, int, int, int) const { return 0u; }
    __device__ __forceinline__ void a_ready(const Unit&) const {}
    __device__ __forceinline__ void done(const Unit&) const {}
};

struct StaticOrderG : StaticOrder {
    __device__ __forceinline__ unsigned goff(const Unit& u, int r, int C, int K) const { return ((unsigned)(u.pm * BM + r) * (unsigned)K + (unsigned)C) * 2u; }
};

struct MoeOrder {
    const PG8_LAS int* tstart; const PG8_LAS int* cnt; const int* list; int G, c, shift, lcap; size_t estride; int sorted;
    __device__ __forceinline__ bool next(int i, Unit& u) const {
        const int ntiles = tstart[32]; const int x = c & 7, k = i * (G >> 3) + (c >> 3); const int rt = 2 * (k >> 1) + (x & 1); if (rt >= ntiles) return false;
        int e = 0;
#pragma unroll
        for (int q = 1; q < 32; ++q) e += (tstart[q] <= rt) ? 1 : 0;
        e = __builtin_amdgcn_readfirstlane(e);
        const int pm = __builtin_amdgcn_readfirstlane(rt - tstart[e]); const int rem = __builtin_amdgcn_readfirstlane(cnt[e]) - 256 * pm;
        u.pm = pm; u.pn = 2 * (x >> 1) + (k & 1); u.e = e; u.nvalid = rem < 256 ? rem : 256; u.lbase = e * lcap + 256 * pm; u.srow = 256 * rt; return true;
    }
    __device__ __forceinline__ const char* bbase(const Gemm& g, const Unit& u, size_t tstep) const { return (const char*)g.Bt + (size_t)u.e * estride + (size_t)u.pn * tstep; }
    __device__ __forceinline__ unsigned goff(const Unit& u, int r, int C, int K) const {
        if (sorted) return ((unsigned)(u.srow + r) * (unsigned)K + (unsigned)C) * 2u;
        const int a = list[u.lbase + (r < u.nvalid ? r : 0)];
        return ((unsigned)(a >> shift) * (unsigned)K + (unsigned)C) * 2u;
    }
    __device__ __forceinline__ void a_ready(const Unit&) const {}
    __device__ __forceinline__ void done(const Unit&) const {}
};

struct DynQ {
    unsigned* ctr; volatile PG8_LAS int* slot; int x0, qi; unsigned pend;
    __device__ __forceinline__ void qinit(unsigned* ctr_, volatile PG8_LAS int* slot_, int bx) { ctr = ctr_; slot = slot_; x0 = bx & 7; qi = 0; pend = 0u;
        if (threadIdx.x == 0) pend = __hip_atomic_fetch_add(ctr + 64 * x0, 1u, __ATOMIC_RELAXED, __HIP_MEMORY_SCOPE_AGENT); }
    template <class SizeF> __device__ __forceinline__ int qnext(int i, const SizeF& size_of) {
        const int par = i & 1;
        if (threadIdx.x == 0) { int res = -1;
            while (qi < 8) { const int x = (x0 + qi) & 7; if (pend < (unsigned)size_of(x)) { res = (x << 24) | (int)pend; break; }
                ++qi; if (qi < 8) pend = __hip_atomic_fetch_add(ctr + 64 * ((x0 + qi) & 7), 1u, __ATOMIC_RELAXED, __HIP_MEMORY_SCOPE_AGENT); }
            slot[par] = res;
            if (res >= 0) pend = __hip_atomic_fetch_add(ctr + 64 * ((x0 + qi) & 7), 1u, __ATOMIC_RELAXED, __HIP_MEMORY_SCOPE_AGENT); }
        asm volatile("s_waitcnt lgkmcnt(0)" ::: "memory"); __builtin_amdgcn_s_barrier(); asm volatile("" ::: "memory");
        return __builtin_amdgcn_readfirstlane(slot[par]);
    }
};
struct DynDense : DynQ {
    int nM, nN, nwg;
    __device__ __forceinline__ void init(int M, int N, unsigned* ctr_, volatile PG8_LAS int* slot_, int bx) { nM = M / BM; nN = N / BM; nwg = nM * nN; qinit(ctr_, slot_, bx); }
    __device__ __forceinline__ bool next(int i, Unit& u) {
        const int q = nwg / NXCD, r = nwg % NXCD;
        const int code = qnext(i, [=](int x) { return q + (x < r ? 1 : 0); }); if (code < 0) return false;
        const int x = code >> 24, k = code & 0xffffff; const int wgid = (x < r ? x * (q + 1) : r * (q + 1) + (x - r) * q) + k;
        const int nig = WGM * nN, gid = wgid / nig, fm = gid * WGM, gsz = (nM - fm) < WGM ? (nM - fm) : WGM;
        u.pm = fm + ((wgid % nig) % gsz); u.pn = (wgid % nig) / gsz; return true;
    }
    __device__ __forceinline__ const char* bbase(const Gemm& g, const Unit& u, size_t tstep) const { return (const char*)g.Bt + (size_t)u.pn * tstep; }
    __device__ __forceinline__ unsigned goff(const Unit&, int, int, int) const { return 0u; }
    __device__ __forceinline__ void a_ready(const Unit&) const {}
    __device__ __forceinline__ void done(const Unit&) const {}
};
struct DynDenseG : DynDense {
    __device__ __forceinline__ unsigned goff(const Unit& u, int r, int C, int K) const { return ((unsigned)(u.pm * BM + r) * (unsigned)K + (unsigned)C) * 2u; }
};

__device__ __forceinline__ unsigned cvt_pk_bf16(float lo, float hi) { unsigned r; asm volatile("v_cvt_pk_bf16_f32 %0, %1, %2" : "=v"(r) : "v"(lo), "v"(hi)); return r; }
__device__ __forceinline__ float bf_lo(unsigned w) { return __builtin_bit_cast(float, w << 16); }
__device__ __forceinline__ float bf_hi(unsigned w) { return __builtin_bit_cast(float, w & 0xffff0000u); }
__device__ __forceinline__ unsigned pk4_fp8(float a, float b, float c, float d) {
    a = __builtin_amdgcn_fmed3f(a, -440.f, 440.f); b = __builtin_amdgcn_fmed3f(b, -440.f, 440.f); c = __builtin_amdgcn_fmed3f(c, -440.f, 440.f); d = __builtin_amdgcn_fmed3f(d, -440.f, 440.f);
    int r = __builtin_amdgcn_cvt_pk_fp8_f32(a, b, 0, false); r = __builtin_amdgcn_cvt_pk_fp8_f32(c, d, r, true); return (unsigned)r; }
typedef unsigned u32x2 __attribute__((ext_vector_type(2)));
__device__ __forceinline__ void swap16(u32x2& a, u32x2& b) { auto r0 = __builtin_amdgcn_permlane16_swap(a.x, b.x, false, false); auto r1 = __builtin_amdgcn_permlane16_swap(a.y, b.y, false, false); a = (u32x2){r0[0], r1[0]}; b = (u32x2){r0[1], r1[1]}; }
typedef int v4i_t __attribute__((ext_vector_type(4)));

struct EpiIn {
    static constexpr bool PERM = true, AFTER_DRAIN = false;
    bf16_t* P0; size_t stride; bf16_t* CG; const float* rstd; float scale0; unsigned* nmax; int tbase; float oscale;
    __device__ __forceinline__ void operator()(const f32x4 (&acc)[2][2][4][2], const Unit& u, int wr, int wc, int fr, int fq) const {
        const int row0 = u.pm * BM + wr * 64 + fr, t = (u.pn >> 2) + tbase; bf16_t* base = (t < 4) ? P0 + (size_t)t * stride : CG;
        const float sc = ((t == 0) ? scale0 : 1.f) * oscale; const int col0 = (u.pn & 3) * BM + wc * 32 + 8 * fq;
        float mx[2] = {0.f, 0.f}; float rsv[2][4];
#pragma unroll
        for (int ai = 0; ai < 2; ++ai)
#pragma unroll
            for (int m = 0; m < 4; ++m) rsv[ai][m] = rstd[row0 + ai * HALF + m * 16];
#pragma unroll
        for (int ai = 0; ai < 2; ++ai)
#pragma unroll
            for (int m = 0; m < 4; ++m) { const int row = row0 + ai * HALF + m * 16; const float rs = rsv[ai][m] * sc; bf16_t* rowp = base + (size_t)row * 1024 + col0;
#pragma unroll
                for (int bj = 0; bj < 2; ++bj) { const f32x4 v0 = acc[ai][bj][m][0] * rs, v1 = acc[ai][bj][m][1] * rs;
                    u32x4 w; w.x = cvt_pk_bf16(v0[0], v0[1]); w.y = cvt_pk_bf16(v0[2], v0[3]); w.z = cvt_pk_bf16(v1[0], v1[1]); w.w = cvt_pk_bf16(v1[2], v1[3]);
                    *(u32x4*)(rowp + bj * HALF) = w;
                    if (t < 2) { float ss = (v0[0] * v0[0] + v0[1] * v0[1]) + (v0[2] * v0[2] + v0[3] * v0[3]) + (v1[0] * v1[0] + v1[1] * v1[1]) + (v1[2] * v1[2] + v1[3] * v1[3]);
                        ss += __shfl_xor(ss, 16); ss += __shfl_xor(ss, 32); mx[bj] = __builtin_fmaxf(mx[bj], ss); } } }
        if (t < 2) {
#pragma unroll
            for (int bj = 0; bj < 2; ++bj) { float v = mx[bj];
                v = __builtin_fmaxf(v, __shfl_xor(v, 1)); v = __builtin_fmaxf(v, __shfl_xor(v, 2)); v = __builtin_fmaxf(v, __shfl_xor(v, 4)); v = __builtin_fmaxf(v, __shfl_xor(v, 8));
                const int colb = (u.pn & 3) * BM + bj * HALF + wc * 32, g64 = colb >> 6, bh = (u.pm >> 4) * 8 + (g64 >> 1);
                if (fr == 0 && fq == 0) atomicMax(nmax + ((t * 64 + bh) * 2 + (g64 & 1)) * 2 + (wc & 1), __builtin_bit_cast(unsigned, v)); }
        }
    }
};
struct EpiGLU {
    static constexpr bool PERM = true, AFTER_DRAIN = false;
    bf16_t* U; const float* rstd; float oscale;
    __device__ __forceinline__ void operator()(const f32x4 (&acc)[2][2][4][2], const Unit& u, int wr, int wc, int fr, int fq) const {
        const int row0 = u.pm * BM + wr * 64 + fr, col0 = u.pn * HALF + wc * 32 + 8 * fq; float rsv[2][4];
#pragma unroll
        for (int ai = 0; ai < 2; ++ai)
#pragma unroll
            for (int m = 0; m < 4; ++m) rsv[ai][m] = rstd[row0 + ai * HALF + m * 16];
#pragma unroll
        for (int ai = 0; ai < 2; ++ai)
#pragma unroll
            for (int m = 0; m < 4; ++m) { const int row = row0 + ai * HALF + m * 16; const float rs = rsv[ai][m] * oscale;
                const f32x4 a0 = acc[ai][0][m][0] * rs, a1 = acc[ai][0][m][1] * rs, g0 = acc[ai][1][m][0] * rs, g1 = acc[ai][1][m][1] * rs;
#define PG8_SG(x) __builtin_amdgcn_rcpf(1.f + __builtin_amdgcn_exp2f(-1.4426950408889634f * (x)))
                u32x4 w; w.x = cvt_pk_bf16(a0[0] * PG8_SG(g0[0]), a0[1] * PG8_SG(g0[1])); w.y = cvt_pk_bf16(a0[2] * PG8_SG(g0[2]), a0[3] * PG8_SG(g0[3]));
                w.z = cvt_pk_bf16(a1[0] * PG8_SG(g1[0]), a1[1] * PG8_SG(g1[1])); w.w = cvt_pk_bf16(a1[2] * PG8_SG(g1[2]), a1[3] * PG8_SG(g1[3]));
#undef PG8_SG
                *(u32x4*)(U + (size_t)row * 1024 + col0) = w; }
    }
};
struct EpiOut {
    static constexpr bool PERM = true, AFTER_DRAIN = false;
    bf16_t* H; const bf16_t* XB; float* part; unsigned char* H8;
    __device__ __forceinline__ void operator()(const f32x4 (&acc)[2][2][4][2], const Unit& u, int wr, int wc, int fr, int fq) const {
        const int row0 = u.pm * BM + wr * 64 + fr, col0 = u.pn * BM + wc * 32 + 8 * fq;
#pragma unroll
        for (int ai = 0; ai < 2; ++ai) { u32x4 xbv[4][2];
#pragma unroll
            for (int m = 0; m < 4; ++m)
#pragma unroll
                for (int bj = 0; bj < 2; ++bj) xbv[m][bj] = *(const u32x4*)(XB + (size_t)(row0 + ai * HALF + m * 16) * 2048 + col0 + bj * HALF);
#pragma unroll
            for (int m = 0; m < 4; ++m) { const int row = row0 + ai * HALF + m * 16; const size_t off = (size_t)row * 2048 + col0; float ss = 0.f;
#pragma unroll
                for (int bj = 0; bj < 2; ++bj) { const u32x4 xb = xbv[m][bj];
                    f32x4 v0 = acc[ai][bj][m][0], v1 = acc[ai][bj][m][1];
                    v0[0] += bf_lo(xb.x); v0[1] += bf_hi(xb.x); v0[2] += bf_lo(xb.y); v0[3] += bf_hi(xb.y); v1[0] += bf_lo(xb.z); v1[1] += bf_hi(xb.z); v1[2] += bf_lo(xb.w); v1[3] += bf_hi(xb.w);
                    ss += (v0[0] * v0[0] + v0[1] * v0[1]) + (v0[2] * v0[2] + v0[3] * v0[3]) + (v1[0] * v1[0] + v1[1] * v1[1]) + (v1[2] * v1[2] + v1[3] * v1[3]);
                    u32x4 w; w.x = cvt_pk_bf16(v0[0], v0[1]); w.y = cvt_pk_bf16(v0[2], v0[3]); w.z = cvt_pk_bf16(v1[0], v1[1]); w.w = cvt_pk_bf16(v1[2], v1[3]);
                    *(u32x4*)(H + off + bj * HALF) = w;
                    if (H8) { u32x2 w8; w8.x = pk4_fp8(v0[0], v0[1], v0[2], v0[3]); w8.y = pk4_fp8(v1[0], v1[1], v1[2], v1[3]); *(u32x2*)(H8 + off + bj * HALF) = w8; } }
                ss += __shfl_xor(ss, 16); ss += __shfl_xor(ss, 32);
                if (fq == 0) part[(size_t)row * 32 + u.pn * 4 + wc] = ss; } }
    }
};
__device__ __forceinline__ float silu_f(float x) { return x * __builtin_amdgcn_rcpf(1.f + __builtin_amdgcn_exp2f(-1.4426950408889634f * x)); }
struct EpiGU {
    static constexpr bool PERM = true, AFTER_DRAIN = false;
    unsigned char* H1; const int* list; const float* listr; float wscale, oscale;
    __device__ __forceinline__ void operator()(const f32x4 (&acc)[2][2][4][2], const Unit& u, int wr, int wc, int fr, int fq) const {
        const int col0 = u.pn * HALF + wc * 32 + 8 * fq;
        float rsv[2][4];
#pragma unroll
        for (int ai = 0; ai < 2; ++ai)
#pragma unroll
            for (int m = 0; m < 4; ++m) { const int r = ai * HALF + wr * 64 + m * 16 + fr; rsv[ai][m] = listr[u.lbase + (r < u.nvalid ? r : 0)]; }
#pragma unroll
        for (int ai = 0; ai < 2; ++ai)
#pragma unroll
            for (int mp = 0; mp < 4; mp += 2) { u32x2 wv[2];
#pragma unroll
                for (int q = 0; q < 2; ++q) { const int m = mp + q; const float rs = rsv[ai][m] * wscale;
                    const f32x4 g0 = acc[ai][0][m][0] * rs, g1 = acc[ai][0][m][1] * rs, u0 = acc[ai][1][m][0] * (rs * oscale), u1 = acc[ai][1][m][1] * (rs * oscale);
                    wv[q].x = pk4_fp8(silu_f(g0[0]) * u0[0], silu_f(g0[1]) * u0[1], silu_f(g0[2]) * u0[2], silu_f(g0[3]) * u0[3]);
                    wv[q].y = pk4_fp8(silu_f(g1[0]) * u1[0], silu_f(g1[1]) * u1[1], silu_f(g1[2]) * u1[2], silu_f(g1[3]) * u1[3]); }
                swap16(wv[0], wv[1]);
                const int odd = fq & 1, r = ai * HALF + wr * 64 + (mp + odd) * 16 + fr;
                if (r < u.nvalid) { const u32x4 w = {wv[0].x, wv[0].y, wv[1].x, wv[1].y};
                    *(u32x4*)(H1 + (size_t)(u.srow + r) * 1024 + col0 - 8 * odd) = w; } }
    }
};
struct EpiDown {
    static constexpr bool PERM = true, AFTER_DRAIN = false;
    unsigned char* Y; const int* list; const float* listw; float oscale;
    __device__ __forceinline__ void operator()(const f32x4 (&acc)[2][2][4][2], const Unit& u, int wr, int wc, int fr, int fq) const {
        const int col0 = u.pn * BM + wc * 32 + 8 * fq;
        int av[2][4]; float wv[2][4];
#pragma unroll
        for (int ai = 0; ai < 2; ++ai)
#pragma unroll
            for (int m = 0; m < 4; ++m) { const int r = ai * HALF + wr * 64 + m * 16 + fr, ix = u.lbase + (r < u.nvalid ? r : 0); av[ai][m] = list[ix]; wv[ai][m] = listw[ix]; }
#pragma unroll
        for (int ai = 0; ai < 2; ++ai)
#pragma unroll
            for (int m = 0; m < 4; ++m) { const int r = ai * HALF + wr * 64 + m * 16 + fr; const int a = av[ai][m]; const float ws = wv[ai][m] * oscale;
                u32x2 w0, w1;
                { const f32x4 v0 = acc[ai][0][m][0] * ws, v1 = acc[ai][0][m][1] * ws; w0.x = pk4_fp8(v0[0], v0[1], v0[2], v0[3]); w0.y = pk4_fp8(v1[0], v1[1], v1[2], v1[3]); }
                { const f32x4 v0 = acc[ai][1][m][0] * ws, v1 = acc[ai][1][m][1] * ws; w1.x = pk4_fp8(v0[0], v0[1], v0[2], v0[3]); w1.y = pk4_fp8(v1[0], v1[1], v1[2], v1[3]); }
                swap16(w0, w1);
                if (r < u.nvalid) { const int odd = fq & 1; const u32x4 w = {w0.x, w0.y, w1.x, w1.y};
                    *(u32x4*)(Y + (size_t)a * 2048 + col0 + (odd ? HALF - 8 : 0)) = w; } }
    }
};
struct EpiRouter {
    static constexpr bool PERM = true, AFTER_DRAIN = false;
    const float* part; const float* ber; const float* bgr; float* listr; float* listw; int* list; unsigned* cnt; int lcap;
    __device__ __forceinline__ void operator()(const f32x4 (&acc)[2][2][4][2], const Unit& u, int wr, int wc, int fr, int fq) const {
        if (wc != 0) return;
#pragma unroll
        for (int ai = 0; ai < 2; ++ai)
#pragma unroll
            for (int m = 0; m < 4; ++m) { const int row = u.pm * BM + ai * HALF + wr * 64 + m * 16 + fr;
                const f32x4 p0 = *(const f32x4*)(part + (size_t)row * 32 + 8 * fq), p1 = *(const f32x4*)(part + (size_t)row * 32 + 8 * fq + 4);
                float ss = ((p0[0] + p0[1]) + (p0[2] + p0[3])) + ((p1[0] + p1[1]) + (p1[2] + p1[3]));
                ss += __shfl_xor(ss, 16); ss += __shfl_xor(ss, 32);
                const float rstd = 1.0f / sqrtf(ss * (1.0f / 2048.0f) + 1e-6f);
                const f32x4 gl = acc[ai][1][m][0]; float g[4];
#pragma unroll
                for (int i = 0; i < 4; ++i) g[i] = __shfl(gl[i], fr) * rstd + bgr[i];
                int gs = 0; float gm = g[0];
#pragma unroll
                for (int i = 1; i < 4; ++i) if (g[i] > gm) { gm = g[i]; gs = i; }
                float gsum = 0.f;
#pragma unroll
                for (int i = 0; i < 4; ++i) gsum += __expf(g[i] - gm);
                const float gw = 1.0f / gsum;
                if (fq == gs) { float ev[8];
#pragma unroll
                    for (int i = 0; i < 4; ++i) { ev[i] = acc[ai][0][m][0][i] * rstd + ber[8 * fq + i]; ev[4 + i] = acc[ai][0][m][1][i] * rstd + ber[8 * fq + 4 + i]; }
                    int i1 = 0; float v1 = ev[0];
#pragma unroll
                    for (int i = 1; i < 8; ++i) if (ev[i] > v1) { v1 = ev[i]; i1 = i; }
                    int i2 = -1; float v2 = -3.0e38f;
#pragma unroll
                    for (int i = 0; i < 8; ++i) if (i != i1 && ev[i] > v2) { v2 = ev[i]; i2 = i; }
                    const float e2 = __expf(v2 - v1), w1 = gw / (1.f + e2), w2 = gw * e2 / (1.f + e2);
                    const int ea = gs * 8 + i1, eb = gs * 8 + i2;
                    const unsigned ra = __hip_atomic_fetch_add(cnt + 64 * ea, 1u, __ATOMIC_RELAXED, __HIP_MEMORY_SCOPE_AGENT);
                    const unsigned rb = __hip_atomic_fetch_add(cnt + 64 * eb, 1u, __ATOMIC_RELAXED, __HIP_MEMORY_SCOPE_AGENT);
                    const size_t ia = (size_t)ea * lcap + ra, ib = (size_t)eb * lcap + rb;
                    list[ia] = 2 * row; list[ib] = 2 * row + 1; listw[ia] = w1; listw[ib] = w2; listr[ia] = rstd; listr[ib] = rstd; } }
    }
};

template <class Epi, class Sched, bool ALIGN_EPI, bool GATHER, bool FP8 = false>
__device__ __forceinline__ void gemm_phase(PG8_LAS unsigned char* lds, const Gemm g, Sched& S, const Epi& E) {
    int tid_ = threadIdx.x; asm volatile("" : "+v"(tid_));
    const int tid = tid_, wid = __builtin_amdgcn_readfirstlane(tid >> 6), lane = tid & 63, wr = wid >> 2, wc = wid & 3, fr = lane & 15, fq = lane >> 4;
    const int K = g.K, nt = K / BK;
    unsigned voffA[2], voffB[2]; int RA[2], CA[2];
#pragma unroll
    for (int i = 0; i < 2; ++i) { int R, C; stage_rc(tid * 16 + i * 8192, R, C); const int Rb = Epi::PERM ? ((R & ~31) + perm32(R & 31)) : R;
        voffA[i] = (unsigned)(R * K + C) * 2u; voffB[i] = (unsigned)(Rb * K + C) * 2u; RA[i] = R; CA[i] = C; }
    const size_t kstep = (size_t)(BK * 2);
    const size_t hstep = (size_t)HALF * K * 2;
    const size_t tstep = 2 * hstep;
    const unsigned ldsw = (unsigned)wid * 1024u;
    const int aoff = lds_byte(wr * 64 + fr, fq * 8), boff = lds_byte(wc * 32 + fr, fq * 8);
#define PG8_SA(b, h) (((b) * 2 + (h)) * HTB)
#define PG8_SB(b, h) ((4 + (b) * 2 + (h)) * HTB)
#define PG8_STAGE(bufoff, gbase, voff) do { _Pragma("unroll") for (int _i = 0; _i < 2; ++_i) \
        __builtin_amdgcn_global_load_lds((const unsigned*)((const char*)(gbase) + (voff)[_i]), (PG8_LAS unsigned*)(lds + (bufoff) + ldsw + _i * 8192), 16, 0, 0); } while (0)
#define PG8_STAGE_A(bufoff, kp, h) do { if constexpr (GATHER) { PG8_STAGE(bufoff, kp, cgo[h]); } else { PG8_STAGE(bufoff, (kp) + (h) * hstep, voffA); } } while (0)
#define PG8_LDA(dst, b, h) do { _Pragma("unroll") for (int m = 0; m < 4; ++m) _Pragma("unroll") for (int k = 0; k < 2; ++k) dst[m][k] = *(const PG8_LAS bf16x8*)(lds + PG8_SA(b, h) + aoff + m * 2048 + k * 1024); } while (0)
#define PG8_LDB(dst, b, h) do { _Pragma("unroll") for (int n = 0; n < 2; ++n) _Pragma("unroll") for (int k = 0; k < 2; ++k) dst[n][k] = *(const PG8_LAS bf16x8*)(lds + PG8_SB(b, h) + boff + n * 2048 + k * 1024); } while (0)
#define PG8_CAT(x, y) __builtin_shufflevector(__builtin_bit_cast(v4i_t, x), __builtin_bit_cast(v4i_t, y), 0, 1, 2, 3, 4, 5, 6, 7)
#define PG8_MMA(ai, bj, At, Bt) do { __builtin_amdgcn_s_setprio(1); \
        if constexpr (FP8) { _Pragma("unroll") for (int m = 0; m < 4; ++m) _Pragma("unroll") for (int n = 0; n < 2; ++n) \
            acc[ai][bj][m][n] = __builtin_amdgcn_mfma_scale_f32_16x16x128_f8f6f4(PG8_CAT(Bt[n][0], Bt[n][1]), PG8_CAT(At[m][0], At[m][1]), acc[ai][bj][m][n], 0, 0, 0, 0, 0, 0); } \
        else { _Pragma("unroll") for (int m = 0; m < 4; ++m) _Pragma("unroll") for (int n = 0; n < 2; ++n) _Pragma("unroll") for (int k = 0; k < 2; ++k) \
            acc[ai][bj][m][n] = __builtin_amdgcn_mfma_f32_16x16x32_bf16(Bt[n][k], At[m][k], acc[ai][bj][m][n], 0, 0, 0); } \
        __builtin_amdgcn_s_setprio(0); } while (0)
#define PG8_WAIT_V(n) asm volatile("s_waitcnt vmcnt(" #n ")" ::: "memory")
#define PG8_WAIT_L(n) asm volatile("s_waitcnt lgkmcnt(" #n ")" ::: "memory")
#define PG8_BAR __builtin_amdgcn_s_barrier()
#define PG8_SCHED __builtin_amdgcn_sched_barrier(0)
    Unit cur, nxt; int ui = 0;
#if PROBE_KLOOP
    unsigned pk_acc_ = 0u;
#endif
    if (!S.next(0, cur)) return;
    f32x4 acc[2][2][4][2];
#pragma unroll
    for (int a = 0; a < 2; ++a)
#pragma unroll
        for (int b = 0; b < 2; ++b)
#pragma unroll
            for (int m = 0; m < 4; ++m)
#pragma unroll
                for (int n = 0; n < 2; ++n) acc[a][b][m][n] = (f32x4){0.f, 0.f, 0.f, 0.f};
    bf16x8 At[4][2], B0[2][2], B1[2][2];
    unsigned cgo[2][2] = {{0u, 0u}, {0u, 0u}}, ngo[2][2] = {{0u, 0u}, {0u, 0u}};
    if constexpr (GATHER) {
#pragma unroll
        for (int h = 0; h < 2; ++h)
#pragma unroll
            for (int i = 0; i < 2; ++i) cgo[h][i] = S.goff(cur, h * HALF + RA[i], CA[i], K);
    }
    const char* cA = GATHER ? (const char*)g.A : (const char*)g.A + (size_t)cur.pm * tstep; const char* cB = S.bbase(g, cur, tstep);
    S.a_ready(cur);
    PG8_STAGE(PG8_SB(0, 0), cB, voffB); PG8_STAGE(PG8_SB(0, 1), cB + hstep, voffB); PG8_STAGE_A(PG8_SA(0, 0), cA, 0); PG8_STAGE_A(PG8_SA(0, 1), cA, 1);
    if (wr == 1) PG8_BAR;
    PG8_WAIT_V(2); PG8_BAR;
    PG8_STAGE(PG8_SB(1, 0), cB + kstep, voffB); PG8_STAGE_A(PG8_SA(1, 0), cA + kstep, 0); PG8_STAGE(PG8_SB(1, 1), cB + hstep + kstep, voffB);
    PG8_WAIT_V(6); PG8_BAR;
    for (;;) {
        const bool has_next = S.next(ui + 1, nxt);
        if constexpr (GATHER) {
            if (has_next) {
#pragma unroll
                for (int h = 0; h < 2; ++h)
#pragma unroll
                    for (int i = 0; i < 2; ++i) ngo[h][i] = S.goff(nxt, h * HALF + RA[i], CA[i], K);
            } else {
#pragma unroll
                for (int h = 0; h < 2; ++h)
#pragma unroll
                    for (int i = 0; i < 2; ++i) ngo[h][i] = cgo[h][i];
            }
        }
        const char* nA = GATHER ? (const char*)g.A : (has_next ? (const char*)g.A + (size_t)nxt.pm * tstep : cA); const char* nB = has_next ? S.bbase(g, nxt, tstep) : cB;
#if PROBE_KLOOP
        const unsigned long long pk0_ = __builtin_amdgcn_s_memrealtime();
#endif
        for (int t = 0; t < nt; t += 2) {
            const bool last = (t == nt - 2);
            const char* a1 = cA + (size_t)(t + 1) * kstep;
            const char* a2 = last ? nA : cA + (size_t)(t + 2) * kstep; const char* b2 = last ? nB : cB + (size_t)(t + 2) * kstep;
            const char* a3 = a2 + kstep; const char* b3 = b2 + kstep;
            if (last && has_next) S.a_ready(nxt);
            PG8_LDB(B0, 0, 0); PG8_LDB(B1, 0, 1); PG8_SCHED; PG8_LDA(At, 0, 0); PG8_STAGE_A(PG8_SA(1, 1), a1, 1);
            if constexpr (GATHER) { if (last) {
#pragma unroll
                for (int h = 0; h < 2; ++h)
#pragma unroll
                    for (int i = 0; i < 2; ++i) cgo[h][i] = ngo[h][i]; } }
            PG8_WAIT_V(8); PG8_WAIT_L(0); PG8_BAR; PG8_MMA(0, 0, At, B0); PG8_MMA(0, 1, At, B1); PG8_BAR; PG8_SCHED;
            PG8_LDA(At, 0, 1); PG8_STAGE(PG8_SB(0, 0), b2, voffB); PG8_STAGE(PG8_SB(0, 1), b2 + hstep, voffB); PG8_STAGE_A(PG8_SA(0, 0), a2, 0);
            PG8_WAIT_V(8); PG8_WAIT_L(0); PG8_BAR; PG8_MMA(1, 0, At, B0); PG8_MMA(1, 1, At, B1); PG8_BAR; PG8_SCHED;
            PG8_LDB(B0, 1, 0); PG8_LDB(B1, 1, 1); PG8_SCHED; PG8_LDA(At, 1, 0); PG8_STAGE_A(PG8_SA(0, 1), a2, 1);
            PG8_WAIT_V(8); PG8_WAIT_L(0); PG8_BAR; PG8_MMA(0, 0, At, B0); PG8_MMA(0, 1, At, B1); PG8_BAR; PG8_SCHED;
            PG8_LDA(At, 1, 1); PG8_STAGE(PG8_SB(1, 0), b3, voffB); PG8_STAGE(PG8_SB(1, 1), b3 + hstep, voffB); PG8_STAGE_A(PG8_SA(1, 0), a3, 0);
            PG8_WAIT_V(8); PG8_WAIT_L(0); PG8_BAR; PG8_MMA(1, 0, At, B0); PG8_MMA(1, 1, At, B1); PG8_BAR; PG8_SCHED;
        }
#if PROBE_KLOOP
        const unsigned long long pk1_ = __builtin_amdgcn_s_memrealtime(); if (PROBE_WHAT == 0) pk_acc_ += (unsigned)(pk1_ - pk0_);
#endif
        if constexpr (ALIGN_EPI) { if (wr == 0) PG8_BAR; }
#if PROBE_KLOOP
        const unsigned long long pk2_ = __builtin_amdgcn_s_memrealtime(); if (PROBE_WHAT == 1) pk_acc_ += (unsigned)(pk2_ - pk1_);
#endif
        E(acc, cur, wr, wc, fr, fq); S.done(cur);
#if PROBE_KLOOP
        asm volatile("s_waitcnt vmcnt(0)" ::: "memory"); if (PROBE_WHAT == 2) pk_acc_ += (unsigned)(__builtin_amdgcn_s_memrealtime() - pk2_);
#endif
        if (!has_next) break;
#pragma unroll
        for (int a = 0; a < 2; ++a)
#pragma unroll
            for (int b = 0; b < 2; ++b)
#pragma unroll
                for (int m = 0; m < 4; ++m)
#pragma unroll
                    for (int n = 0; n < 2; ++n) acc[a][b][m][n] = (f32x4){0.f, 0.f, 0.f, 0.f};
        cur = nxt; cA = nA; cB = nB; ++ui;
        if constexpr (ALIGN_EPI) { if (wr == 1) PG8_BAR; }
    }
#if PROBE_KLOOP
    if (blockIdx.x == PROBE_BLK && tid == 0 && g.M == PROBE_KLOOP) atomicAdd(g.probe, pk_acc_);
#endif
    PG8_WAIT_V(0);
    if constexpr (!ALIGN_EPI) { if (wr == 0) PG8_BAR; }
    PG8_BAR;
#undef PG8_SA
#undef PG8_SB
#undef PG8_STAGE
#undef PG8_STAGE_A
#undef PG8_LDA
#undef PG8_LDB
#undef PG8_MMA
#undef PG8_CAT
#undef PG8_WAIT_V
#undef PG8_WAIT_L
#undef PG8_BAR
#undef PG8_SCHED
}
}
#include <hip/hip_bf16.h>
#include <cmath>
namespace attn_body {
using bf16=__hip_bfloat16;
using bf16x8=__attribute__((ext_vector_type(8)))short;
using s16x4=__attribute__((ext_vector_type(4)))short;
using f32x16=__attribute__((ext_vector_type(16)))float;
using u32x4=__attribute__((ext_vector_type(4)))unsigned;
constexpr int BATCH=8,SEQ=4096,D=64,DM=1024;
constexpr int NW=8,QBLK=32,QB=QBLK*NW,KVBLK=64,NQB=SEQ/QB;
__device__ __forceinline__ int crow(int r,int hi){return (r&3)+8*(r>>2)+4*hi;}
#define SBAR() __builtin_amdgcn_sched_barrier(0)
__device__ __forceinline__ void cmask(f32x16&p0,f32x16&p1,int jb,int qrel,int hi){
  const float NEG=-INFINITY; const int lim=qrel-64*jb-4*hi;
  #pragma unroll
  for(int r=0;r<16;++r){const int cr=(r&3)+8*(r>>2); if(cr>lim)p0[r]=NEG; if(cr+32>lim)p1[r]=NEG;}
}

constexpr int NSLOT=3, SLOTB=8192;
constexpr int LDS_K=0, LDS_V=NSLOT*SLOTB, LDS_WS=3*NSLOT*SLOTB, LDS_OST=LDS_WS+NW*64*4, LDS_BYTES=LDS_OST+NW*4096;
__device__ __forceinline__ void glds16(const void*sbase,unsigned voff,unsigned lds_dst){unsigned keep;
  asm volatile("s_mov_b32 %0, m0\n\ts_mov_b32 m0, %3\n\ts_nop 0\n\tglobal_load_lds_dwordx4 %1, %2\n\ts_mov_b32 m0, %0":"=&s"(keep):"v"(voff),"s"(sbase),"s"(lds_dst):"memory");}
__device__ __forceinline__ float max3f(float a,float b,float c){float r;asm("v_max3_f32 %0, %1, %2, %3":"=v"(r):"v"(a),"v"(b),"v"(c));return r;}
__device__ __forceinline__ float max2f(float a,float b){float r;asm("v_max_f32_e32 %0, %1, %2":"=v"(r):"v"(a),"v"(b));return r;}
__device__ __forceinline__ float fsub_s(float a,float b){float r;asm("v_sub_f32_e32 %0, %1, %2":"=v"(r):"v"(a),"v"(b));return r;}
typedef float f32x2_t __attribute__((ext_vector_type(2))); typedef __bf16 bf16x2_t __attribute__((ext_vector_type(2)));
__device__ __forceinline__ unsigned cvtpk_s(float lo,float hi){f32x2_t v={lo,hi};bf16x2_t b=__builtin_convertvector(v,bf16x2_t);return __builtin_bit_cast(unsigned,b);}
#define WAIT_BAR(N) asm volatile("s_waitcnt vmcnt(" #N ") lgkmcnt(0)\n\ts_barrier":::"memory")
#define MFMA32(a,b,c) __builtin_amdgcn_mfma_f32_32x32x16_bf16(a,b,c,0,0,0)

__device__ __forceinline__ void qkt(f32x16&p0,f32x16&p1,const char*Kslot,const bf16x8*qr,int r32,int hi){
  const char*kb=Kslot+hi*1024+r32*16;
  #pragma unroll
  for(int d0=0;d0<4;++d0){
    const bf16x8 b0=*reinterpret_cast<const bf16x8*>(kb+d0*2048);
    const bf16x8 b1=*reinterpret_cast<const bf16x8*>(kb+d0*2048+512);
    p0=MFMA32(b0,qr[d0],p0);p1=MFMA32(b1,qr[d0],p1);}
}
typedef __attribute__((address_space(3))) const char* lds_cptr;
typedef short v4i16_t __attribute__((ext_vector_type(4)));
__device__ __forceinline__ void kload8(bf16x8*kf,lds_cptr kp){
  kf[0]=*(const __attribute__((address_space(3))) bf16x8*)(kp);      kf[1]=*(const __attribute__((address_space(3))) bf16x8*)(kp+512);
  kf[2]=*(const __attribute__((address_space(3))) bf16x8*)(kp+2048); kf[3]=*(const __attribute__((address_space(3))) bf16x8*)(kp+2560);
  kf[4]=*(const __attribute__((address_space(3))) bf16x8*)(kp+4096); kf[5]=*(const __attribute__((address_space(3))) bf16x8*)(kp+4608);
  kf[6]=*(const __attribute__((address_space(3))) bf16x8*)(kp+6144); kf[7]=*(const __attribute__((address_space(3))) bf16x8*)(kp+6656);
}
__device__ __forceinline__ void kload2(bf16x8*kf,lds_cptr kp,int j){ kf[2*j]=*(const __attribute__((address_space(3))) bf16x8*)(kp+j*2048); kf[2*j+1]=*(const __attribute__((address_space(3))) bf16x8*)(kp+j*2048+512); }
__device__ __forceinline__ s16x4 vtr(lds_cptr p){ return __builtin_bit_cast(s16x4,__builtin_amdgcn_ds_read_tr16_b64_v4i16((__attribute__((address_space(3))) v4i16_t*)p)); }
__device__ __forceinline__ float rowmax(const f32x16&p0,const f32x16&p1){
  float a=max3f(p0[0],p0[1],p1[0]),b=max3f(p0[2],p0[3],p1[1]);a=max3f(a,p1[2],p1[3]);
  #pragma unroll
  for(int r=4;r<16;r+=4){a=max3f(a,p0[r],p0[r+1]);b=max3f(b,p0[r+2],p0[r+3]);a=max3f(a,p1[r],p1[r+1]);b=max3f(b,p1[r+2],p1[r+3]);}
  const float m=max2f(a,b);
  auto rr=__builtin_amdgcn_permlane32_swap(__float_as_uint(m),__float_as_uint(m),false,false);
  return max2f(__uint_as_float(rr[0]),__uint_as_float(rr[1]));
}
__device__ __forceinline__ void pv(f32x16*o,int vb,bf16x8 pa0,bf16x8 pa1,bf16x8 pa2,bf16x8 pa3){
  #pragma unroll
  for(int d0=0;d0<4;++d0){s16x4 lo[4],hi[4];
    #pragma unroll
    for(int ks=0;ks<4;++ks){
      asm volatile("ds_read_b64_tr_b16 %0,%1 offset:%c2":"=&v"(lo[ks]):"v"(vb),"i"(d0*4096+ks*1024):"memory");
      asm volatile("ds_read_b64_tr_b16 %0,%1 offset:%c2":"=&v"(hi[ks]):"v"(vb),"i"(d0*4096+ks*1024+512):"memory");}
    asm volatile("s_waitcnt lgkmcnt(0)":::"memory");SBAR();
    #define PK(k) (bf16x8){lo[k][0],lo[k][1],lo[k][2],lo[k][3],hi[k][0],hi[k][1],hi[k][2],hi[k][3]}
    o[d0]=MFMA32(pa0,PK(0),o[d0]);
    o[d0]=MFMA32(pa1,PK(1),o[d0]);
    o[d0]=MFMA32(pa2,PK(2),o[d0]);
    o[d0]=MFMA32(pa3,PK(3),o[d0]);
    #undef PK
  }
}

template<int THRL> __device__ __forceinline__ void attn_sub(int b,int qkcol,int vcol,int qb,int cmap,float sl2,float lam,int ntcap,float Ub,float oscale,const float*subg,unsigned*o1s,bf16*MIXh,const bf16*Q,const bf16*__restrict__ K,const bf16*__restrict__ V,char*shm,unsigned*pw_){
#if PROBE_ATT >= 3
  const unsigned long long ps0_=__builtin_amdgcn_s_memrealtime();
#endif
  const int tid=threadIdx.x,lane=tid&63,r32=lane&31,hi=lane>>5; const int wid=__builtin_amdgcn_readfirstlane(tid>>6);
  const long rowbase=(long)b*SEQ; const int q0=qb*QB;
  const bf16*Qw=Q+(rowbase+q0+wid*QBLK)*DM+qkcol;
  const bf16*Kh=K+rowbase*DM+qkcol,*Vh=V+rowbase*DM+vcol;
  const unsigned lds0=(unsigned)(uintptr_t)shm;
  float*wsf=(float*)(shm+LDS_WS)+wid*64;
  const unsigned koff=(unsigned)(lane*DM+wid*8)*2u, voffv=(unsigned)((16*(wid&3)+(lane>>2))*DM+(wid>>2)*32+(lane&3)*8)*2u;
  const unsigned kdst=lds0+LDS_K+wid*1024, vdst=lds0+LDS_V+wid*1024;
  const int NTR=(q0+QB)/KVBLK;
  int NT=NTR<ntcap?NTR:ntcap;
  #define DMA_K(t,slot) glds16(Kh+(long)(NTR-1-(t))*KVBLK*DM,koff,(unsigned)__builtin_amdgcn_readfirstlane(kdst+(slot)))
  #define DMA_V(t,slot) do{ glds16(Vh+(long)(NTR-1-(t))*KVBLK*DM,voffv,(unsigned)__builtin_amdgcn_readfirstlane(vdst+2*(slot))); glds16(Vh+(long)(NTR-1-(t))*KVBLK*DM+64,voffv,(unsigned)__builtin_amdgcn_readfirstlane(vdst+2*(slot)+8192)); }while(0)
  const char*Kbase=shm+LDS_K; bf16x8 kf[8];
  const lds_cptr shm3=(lds_cptr)shm; const lds_cptr kp0=shm3+LDS_K+hi*1024+r32*16; const lds_cptr vp0=shm3+LDS_V+((lane>>4)&1)*32+(lane&3)*8+(4*hi+((lane&15)>>2))*64;
  #define vb0 ((int)(unsigned)(uintptr_t)vp0)
  DMA_K(0,0);DMA_V(0,0);DMA_K(1,SLOTB);
  bf16x8 qr[4];
  #pragma unroll
  for(int d0=0;d0<4;++d0)qr[d0]=*reinterpret_cast<const bf16x8*>(&Qw[(long)r32*DM+d0*16+hi*8]);
  const int qrel=wid*QBLK+r32;
  const unsigned lm=hi?0u:0xffffffffu;
  const int qw0=wid*QBLK;
  unsigned bbx; { const unsigned sh=__float_as_uint(sl2)&0xffff0000u; const float sr=sl2-__uint_as_float(sh); bbx=((sh>>16)|(cvtpk_s(sr,0.f)<<16))&lm; }
  const float dlt=64.f*sl2;
  float cref=sl2*(float)(192-qrel);
  #define BIAS2(C0,C1,t) do{ const float c_=__builtin_fmaf(-dlt,(float)(t),cref); const unsigned h_=__float_as_uint(c_)&0xffff0000u; const float r1_=c_-__uint_as_float(h_); \
      const unsigned m_=__float_as_uint(r1_)&0xffff0000u; const float r2_=r1_-__uint_as_float(m_); \
      int q_=qrel; asm volatile("":"+v"(q_)); const float rf_=(float)(q_-qw0); \
      u32x4 b_=(u32x4){bbx,((h_>>16)|m_)&lm,(__float_as_uint(r2_)>>16)&lm,0u}; u32x4 a_=(u32x4){cvtpk_s(rf_,rf_),0x3F803F80u,0x00003F80u,0u}; asm volatile("":"+v"(a_),"+v"(b_)); \
      const f32x16 z_=f32x16{}; C0=MFMA32(__builtin_bit_cast(bf16x8,a_),__builtin_bit_cast(bf16x8,b_),z_); \
      a_.x=cvtpk_s(rf_+32.f,rf_+32.f); asm volatile("":"+v"(a_)); C1=MFMA32(__builtin_bit_cast(bf16x8,a_),__builtin_bit_cast(bf16x8,b_),z_); }while(0)
  float l_reg=0.f;f32x16 o[4];o[0]=f32x16{};o[1]=f32x16{};o[2]=f32x16{};o[3]=f32x16{};
  #define CMASK(P0,P1,t) do{int jb_=3-(t); if(jb_>=0)cmask(P0,P1,jb_,qrel,hi);}while(0)
  bool resc=false;
  #define START(P0,P1) do{ const float rm=rowmax(P0,P1); resc=false; \
    if(__any(rm>(float)THRL)){ const float dl=max2f(rm,0.f); cref=fsub_s(cref,dl); \
      _Pragma("unroll") for(int r=0;r<16;++r){P0[r]=fsub_s(P0[r],dl);P1[r]=fsub_s(P1[r],dl);} } \
    _Pragma("unroll") for(int r=0;r<16;++r)P0[r]=__builtin_amdgcn_exp2f(P0[r]); }while(0)
  #define RESC() do{ if(resc){ asm volatile("s_waitcnt lgkmcnt(0)":::"memory"); \
      _Pragma("unroll") for(int d_=0;d_<4;++d_) _Pragma("unroll") for(int r=0;r<16;++r)o[d_][r]*=wsf[crow(r,hi)]; } }while(0)
  f32x16 pA0,pA1,pB0,pB1;
  int sl_prev=0,sl_cur=0,sl_next=SLOTB;
  #define ROT() do{sl_prev=sl_cur;sl_cur=sl_next;sl_next=(sl_next==(NSLOT-1)*SLOTB)?0:sl_next+SLOTB;}while(0)
  DMA_K(2,2*SLOTB);
  WAIT_BAR(3);
  BIAS2(pA0,pA1,0);
  qkt(pA0,pA1,Kbase,qr,r32,hi);asm volatile("s_nop 15\n\ts_nop 7":"+v"(pA0),"+v"(pA1));CMASK(pA0,pA1,0);
  START(pA0,pA1);
  _Pragma("unroll") for(int r=0;r<16;++r)pA1[r]=__builtin_amdgcn_exp2f(pA1[r]);
  WAIT_BAR(0);
  DMA_K(3,0);DMA_V(1,SLOTB);
  ROT();
  kload8(kf,kp0+sl_cur);
  WAIT_BAR(3);
  s16x4 vlo[8],vhi[8]; u32x4 pw0,pw1,pw2,pw3;
  #define PKW(P,B) cvtpk_s(P[B],P[B+1])
  #define PAF(k) __builtin_bit_cast(bf16x8,pw##k)
  #define VFR(i) (bf16x8){vlo[i][0],vlo[i][1],vlo[i][2],vlo[i][3],vhi[i][0],vhi[i][1],vhi[i][2],vhi[i][3]}
  #define PIN(x) asm volatile("":"+v"(x))
  #define MX3(a,b,c) __builtin_fmaxf(__builtin_fmaxf((a),(b)),(c))
  #define GAPA(MF,A0,A1,A2,A3,W0,W1,PW) do{ MF; sacc+=A0; sacc+=A1; sacc+=A2; sacc+=A3; PIN(sacc); W0; W1; PIN(PW); SBAR(); }while(0)
  #define EX(v) __builtin_amdgcn_exp2f(v)
  #define GAPB(MF,X,B) do{ MF; X[B]=EX(X[B]); X[B+1]=EX(X[B+1]); PIN(X); SBAR(); }while(0)
  #define VRD2(i) do{ vlo[i]=vtr(vp_+(8192+((i)>>2)*4096+((i)&3)*1024)); vhi[i]=vtr(vp_+(8192+((i)>>2)*4096+((i)&3)*1024+512)); SBAR(); }while(0)
  #define VRD(i) do{ vlo[i]=vtr(vp_+(((i)>>2)*4096+((i)&3)*1024)); vhi[i]=vtr(vp_+(((i)>>2)*4096+((i)&3)*1024+512)); }while(0)
  #define KRD(G,j) do{ if(G){ kload2(kf,kp0+sl_next,j); SBAR(); } }while(0)
  #define STEP(C0,C1,P0,P1,t,GK,GV,GL) do{ SBAR(); \
    BIAS2(C0,C1,t); SBAR(); \
    const lds_cptr vp_=vp0+2*sl_prev; \
    VRD(0); SBAR(); float sacc=(P0[0]+P0[1]); \
    GAPA(C0=MFMA32(kf[0],qr[0],C0), P0[2],P0[3],P0[4],P0[5],     pw0[0]=PKW(P0,0), pw0[1]=PKW(P0,2), pw0); \
    VRD(4); SBAR(); GAPA(C1=MFMA32(kf[1],qr[0],C1), P0[6],P0[7],P0[8],P0[9],     pw0[2]=PKW(P0,4), pw0[3]=PKW(P0,6), pw0); \
    VRD(1); SBAR(); GAPA(C0=MFMA32(kf[2],qr[1],C0),   P0[10],P0[11],P0[12],P0[13], pw1[0]=PKW(P0,8), pw1[1]=PKW(P0,10), pw1); \
    VRD(5); SBAR(); GAPA(C1=MFMA32(kf[3],qr[1],C1),   P0[14],P0[15],P1[0],P1[1],   pw1[2]=PKW(P0,12),pw1[3]=PKW(P0,14), pw1); \
    VRD(2); SBAR(); GAPA(C0=MFMA32(kf[4],qr[2],C0),   P1[2],P1[3],P1[4],P1[5],     pw2[0]=PKW(P1,0), pw2[1]=PKW(P1,2), pw2); \
    VRD(6); SBAR(); GAPA(C1=MFMA32(kf[5],qr[2],C1),   P1[6],P1[7],P1[8],P1[9],     pw2[2]=PKW(P1,4), pw2[3]=PKW(P1,6), pw2); \
    VRD(3); SBAR(); GAPA(C0=MFMA32(kf[6],qr[3],C0),   P1[10],P1[11],P1[12],P1[13], pw3[0]=PKW(P1,8), pw3[1]=PKW(P1,10), pw3); \
    VRD(7); SBAR(); GAPA(C1=MFMA32(kf[7],qr[3],C1),   P1[14],P1[15],0.f,0.f,       pw3[2]=PKW(P1,12),pw3[3]=PKW(P1,14), pw3); \
    l_reg+=sacc; \
    if(GK){DMA_K((t)+3,sl_cur);} if(GV){DMA_V((t)+1,sl_next);} \
    CMASK(C0,C1,t); \
    { float a=MX3(C0[0],C0[1],C1[0]),b=MX3(C0[2],C0[3],C1[1]); a=MX3(a,C1[2],C1[3]); \
      _Pragma("unroll") for(int r=4;r<16;r+=4){a=MX3(a,C0[r],C0[r+1]);b=MX3(b,C0[r+2],C0[r+3]);a=MX3(a,C1[r],C1[r+1]);b=MX3(b,C1[r+2],C1[r+3]);} \
      float rm=__builtin_fmaxf(a,b); { auto rr=__builtin_amdgcn_permlane32_swap(__float_as_uint(rm),__float_as_uint(rm),false,false); rm=__builtin_fmaxf(__uint_as_float(rr[0]),__uint_as_float(rr[1])); } \
      resc=false; \
      if(__builtin_expect(__any(rm>(float)THRL),0)){ const float dl=__builtin_fmaxf(rm,0.f); cref-=dl; \
        _Pragma("unroll") for(int r=0;r<16;++r){C0[r]-=dl;C1[r]-=dl;} \
        const float f=__builtin_amdgcn_exp2f(-dl); l_reg*=f; if(hi==0)wsf[r32]=f; resc=true; } } \
    SBAR(); \
    GAPB(o[0]=MFMA32(PAF(0),VFR(0),o[0]), C0,0);  VRD2(0); \
    GAPB(o[1]=MFMA32(PAF(0),VFR(4),o[1]), C0,2);  VRD2(4); \
    KRD(GL,0); GAPB(o[0]=MFMA32(PAF(1),VFR(1),o[0]), C0,4);  VRD2(1); \
    KRD(GL,1); GAPB(o[1]=MFMA32(PAF(1),VFR(5),o[1]), C0,6);  VRD2(5); \
    KRD(GL,2); GAPB(o[0]=MFMA32(PAF(2),VFR(2),o[0]), C0,8);  VRD2(2); \
    KRD(GL,3); GAPB(o[1]=MFMA32(PAF(2),VFR(6),o[1]), C0,10); VRD2(6); \
    GAPB(o[0]=MFMA32(PAF(3),VFR(3),o[0]), C0,12); VRD2(3); \
    GAPB(o[1]=MFMA32(PAF(3),VFR(7),o[1]), C0,14); VRD2(7); \
    GAPB(o[2]=MFMA32(PAF(0),VFR(0),o[2]), C1,0); \
    GAPB(o[3]=MFMA32(PAF(0),VFR(4),o[3]), C1,2); \
    GAPB(o[2]=MFMA32(PAF(1),VFR(1),o[2]), C1,4); \
    GAPB(o[3]=MFMA32(PAF(1),VFR(5),o[3]), C1,6); \
    GAPB(o[2]=MFMA32(PAF(2),VFR(2),o[2]), C1,8); \
    GAPB(o[3]=MFMA32(PAF(2),VFR(6),o[3]), C1,10); \
    GAPB(o[2]=MFMA32(PAF(3),VFR(3),o[2]), C1,12); \
    GAPB(o[3]=MFMA32(PAF(3),VFR(7),o[3]), C1,14); \
    }while(0)
  #define ENDW(tt) do{ if((tt)+3<NT){WAIT_BAR(3);} else if((tt)+2<NT){WAIT_BAR(2);} else {WAIT_BAR(0);} }while(0)
#if PROBE_ATT == 3
  if(blockIdx.x==PROBE_BLK&&threadIdx.x==0)atomicAdd(pw_,(unsigned)(__builtin_amdgcn_s_memrealtime()-ps0_));
#endif
  int t=1;
  for(;t<5&&t+1<NT;t+=2){
    STEP(pB0,pB1,pA0,pA1,t,(t+3<NT),(t+1<NT),(t+1<NT));       ENDW(t);   RESC(); ROT();
    STEP(pA0,pA1,pB0,pB1,t+1,(t+4<NT),(t+2<NT),(t+2<NT));     ENDW(t+1); RESC(); ROT();
  }
  if(t==5&&NT>=12){
    float lt=l_reg; {auto rr=__builtin_amdgcn_permlane32_swap(__float_as_uint(lt),__float_as_uint(lt),false,false);lt=__uint_as_float(rr[0])+__uint_as_float(rr[1]);}
    float dl2=(sl2*(float)(192-qrel)-cref)+__builtin_amdgcn_logf(lt);
    #define DPPMIN(ctl) dl2=__builtin_fminf(dl2,__uint_as_float((unsigned)__builtin_amdgcn_update_dpp(0,(int)__float_as_uint(dl2),ctl,0xF,0xF,false)))
    DPPMIN(0xB1); DPPMIN(0x4E); DPPMIN(0x141); DPPMIN(0x140);
    #undef DPPMIN
    { auto rr=__builtin_amdgcn_permlane16_swap(__float_as_uint(dl2),__float_as_uint(dl2),false,false); dl2=__builtin_fminf(__uint_as_float(rr[0]),__uint_as_float(rr[1])); }
    float*xw=(float*)(shm+LDS_OST);
    if(lane==0)xw[wid]=dl2;
    asm volatile("s_waitcnt lgkmcnt(0)\n\ts_barrier":::"memory");
    float dmin=xw[0];
    #pragma unroll
    for(int w_=1;w_<8;++w_)dmin=__builtin_fminf(dmin,xw[w_]);
    dmin=__uint_as_float(__builtin_amdgcn_readfirstlane(__float_as_uint(dmin)));
    const float d0_=(Ub-dmin+24.f+log2f(1.f/(1.f-exp2f(-sl2))))/sl2; float st_=ceilf((d0_+255.f)*(1.f/64.f)); st_=st_<10.f?10.f:(st_>64.f?64.f:st_);
    const int nc_=__builtin_amdgcn_readfirstlane((((int)st_)+1)&~1); if(nc_<NT)NT=nc_;
    asm volatile("s_waitcnt lgkmcnt(0)":::"memory");
  }
  #undef CMASK
  #define CMASK(P0,P1,t) do{}while(0)
  for(;t+5<NT;t+=2){
    STEP(pB0,pB1,pA0,pA1,t,true,true,true);     WAIT_BAR(3); RESC(); ROT();
    STEP(pA0,pA1,pB0,pB1,t+1,true,true,true);   WAIT_BAR(3); RESC(); ROT();
  }
  for(;t+1<NT;t+=2){
    STEP(pB0,pB1,pA0,pA1,t,(t+3<NT),(t+1<NT),(t+1<NT));       ENDW(t);   RESC(); ROT();
    STEP(pA0,pA1,pB0,pB1,t+1,(t+4<NT),(t+2<NT),(t+2<NT));     ENDW(t+1); RESC(); ROT();
  }
  #undef CMASK
  #define CMASK(P0,P1,t) do{int jb_=3-(t); if(jb_>=0)cmask(P0,P1,jb_,qrel,hi);}while(0)
  STEP(pB0,pB1,pA0,pA1,NT-1,false,false,false); RESC();
#if PROBE_ATT == 4
  const unsigned long long ps1_=__builtin_amdgcn_s_memrealtime();
#endif
  { float sacc=pB0[0]+pB0[1]; _Pragma("unroll") for(int r=2;r<16;++r)sacc+=pB0[r]; _Pragma("unroll") for(int r=0;r<16;++r)sacc+=pB1[r]; l_reg+=sacc;
    pw0=(u32x4){PKW(pB0,0),PKW(pB0,2),PKW(pB0,4),PKW(pB0,6)};pw1=(u32x4){PKW(pB0,8),PKW(pB0,10),PKW(pB0,12),PKW(pB0,14)};pw2=(u32x4){PKW(pB1,0),PKW(pB1,2),PKW(pB1,4),PKW(pB1,6)};pw3=(u32x4){PKW(pB1,8),PKW(pB1,10),PKW(pB1,12),PKW(pB1,14)};
    SBAR(); pv(o,vb0+2*sl_cur,PAF(0),PAF(1),PAF(2),PAF(3)); }
  #undef PKW
  #undef PAF
  #undef VFR
  #undef PIN
  #undef MX3
  #undef GAPA
  #undef GAPB
  #undef EX
  #undef VRD
  #undef VRD2
  #undef KRD
  #undef STEP
  #undef ENDW
  { int tid_e=threadIdx.x; asm volatile("":"+v"(tid_e)); const int lane=tid_e&63,r32=lane&31,hi=lane>>5; const int wid=__builtin_amdgcn_readfirstlane(tid_e>>6);
    float*wsf=(float*)(shm+LDS_WS)+wid*64;
  {auto rr=__builtin_amdgcn_permlane32_swap(__float_as_uint(l_reg),__float_as_uint(l_reg),false,false);l_reg=__uint_as_float(rr[0])+__uint_as_float(rr[1]);}
  if(hi==0)wsf[32+r32]=l_reg;asm volatile("s_waitcnt lgkmcnt(0)":::"memory");
  float rli[16];
  #pragma unroll
  for(int r=0;r<16;++r)rli[r]=__builtin_amdgcn_rcpf(wsf[32+crow(r,hi)]);
  u32x4*ow=(u32x4*)(o1s+wid*2048)+lane;
  if(cmap==0){
    #pragma unroll
    for(int i=0;i<8;++i){ const int dq=i>>1,r0=8*(i&1); u32x4 w;
      w.x=cvtpk_s(o[dq][r0+0]*rli[r0+0],o[dq][r0+1]*rli[r0+1]); w.y=cvtpk_s(o[dq][r0+2]*rli[r0+2],o[dq][r0+3]*rli[r0+3]);
      w.z=cvtpk_s(o[dq][r0+4]*rli[r0+4],o[dq][r0+5]*rli[r0+5]); w.w=cvtpk_s(o[dq][r0+6]*rli[r0+6],o[dq][r0+7]*rli[r0+7]); ow[i*64]=w; }
  } else {
    bf16*stg=(bf16*)(shm+LDS_OST)+wid*2048;
    const int row=lane>>1,part=lane&1; float v[64]; float ss=0.f;
    unsigned o1w[32];
    #pragma unroll
    for(int i=0;i<8;++i){ const u32x4 w=ow[i*64]; o1w[4*i+0]=w.x; o1w[4*i+1]=w.y; o1w[4*i+2]=w.z; o1w[4*i+3]=w.w; }
    #pragma unroll
    for(int p_=0;p_<2;++p_){
      #pragma unroll
      for(int d0=0;d0<2;++d0){ const int dq=2*p_+d0;
        #pragma unroll
        for(int rp=0;rp<8;++rp){ const unsigned w=o1w[dq*8+rp];
          const float a0=__uint_as_float(w<<16)-lam*(o[dq][2*rp]*rli[2*rp]), a1=__uint_as_float(w&0xffff0000u)-lam*(o[dq][2*rp+1]*rli[2*rp+1]);
          stg[crow(2*rp,hi)*64+d0*32+r32]=__float2bfloat16(a0); stg[crow(2*rp+1,hi)*64+d0*32+r32]=__float2bfloat16(a1); } }
      asm volatile("s_waitcnt lgkmcnt(0)":::"memory");
      #pragma unroll
      for(int i=0;i<4;++i){ const u32x4 w=*(const u32x4*)(stg+row*64+part*32+8*i);
        v[32*p_+8*i+0]=__uint_as_float(w.x<<16); v[32*p_+8*i+1]=__uint_as_float(w.x&0xffff0000u); v[32*p_+8*i+2]=__uint_as_float(w.y<<16); v[32*p_+8*i+3]=__uint_as_float(w.y&0xffff0000u);
        v[32*p_+8*i+4]=__uint_as_float(w.z<<16); v[32*p_+8*i+5]=__uint_as_float(w.z&0xffff0000u); v[32*p_+8*i+6]=__uint_as_float(w.w<<16); v[32*p_+8*i+7]=__uint_as_float(w.w&0xffff0000u); }
      asm volatile("s_waitcnt lgkmcnt(0)":::"memory");
    }
    #pragma unroll
    for(int i=0;i<64;++i)ss+=v[i]*v[i];
    ss+=__uint_as_float((unsigned)__builtin_amdgcn_update_dpp(0,(int)__float_as_uint(ss),0xB1,0xF,0xF,false));
    const float rs=(1.0f/sqrtf(ss*(1.0f/128.0f)+1e-6f))*oscale;
    bf16*op=MIXh+((long)rowbase+q0+wid*QBLK+row)*2048+part*32;
    #pragma unroll
    for(int p_=0;p_<2;++p_){ const float*sg=subg+64*p_+32*part;
      #pragma unroll
      for(int i=0;i<4;++i){ u32x4 w; const float*vv=v+32*p_+8*i; const float*gg=sg+8*i;
        w.x=cvtpk_s(vv[0]*rs*gg[0],vv[1]*rs*gg[1]); w.y=cvtpk_s(vv[2]*rs*gg[2],vv[3]*rs*gg[3]); w.z=cvtpk_s(vv[4]*rs*gg[4],vv[5]*rs*gg[5]); w.w=cvtpk_s(vv[6]*rs*gg[6],vv[7]*rs*gg[7]);
        *(u32x4*)(op+64*p_+8*i)=w; } }
  }
  }
  asm volatile("s_waitcnt lgkmcnt(0)\n\ts_barrier":::"memory");
#if PROBE_ATT == 4
  if(blockIdx.x==PROBE_BLK&&threadIdx.x==0)atomicAdd(pw_,(unsigned)(__builtin_amdgcn_s_memrealtime()-ps1_));
#endif
  #undef DMA_K
  #undef DMA_V
  #undef vb0
  #undef CMASK
  #undef START
  #undef RESC
  #undef ROT
  #undef BIAS2
}
constexpr int ATTN_LDS_BYTES=LDS_BYTES;
template<int THRL> __device__ __forceinline__ void attn_unit4(int b,int h,int qb,float lam,float oscale,const float*subg,const unsigned*nmax,unsigned*o1s,const bf16*Q,const bf16*K,const bf16*V,bf16*MIX,char*shm){
  const float sl2=exp2f(-(float)(h+1))*1.4426950408889634f;
  int cap[2]; float Uv[2];
  #pragma unroll
  for(int c=0;c<2;++c){ const int bh=b*8+h; const unsigned*qn=nmax+((0*64+bh)*2+c)*2,*kn=nmax+((1*64+bh)*2+c)*2;
    const float U=1.02f*(sqrtf(__uint_as_float(qn[0])*__uint_as_float(kn[0]))+sqrtf(__uint_as_float(qn[1])*__uint_as_float(kn[1])));
    const float d0=(2.f*U+24.f+log2f(1.f/(1.f-exp2f(-sl2))))/sl2; float st=ceilf((d0+255.f)*(1.f/64.f)); st=st<4.f?4.f:(st>64.f?64.f:st);
    cap[c]=__builtin_amdgcn_readfirstlane((((int)st)+1)&~1); Uv[c]=__uint_as_float(__builtin_amdgcn_readfirstlane(__float_as_uint(U))); }
  for(int c=0;c<2;++c) attn_sub<THRL>(b,(2*h+c)*64,h*128,qb,c,sl2,lam,c?cap[1]:cap[0],c?Uv[1]:Uv[0],oscale,subg,o1s,MIX+h*128,Q,K,V,shm,(unsigned*)nmax+900);
}
__device__ __forceinline__ int wg_pop(unsigned*ctr,volatile __attribute__((address_space(3))) unsigned*slot){
  if(threadIdx.x==0)*slot=__hip_atomic_fetch_add(ctr,1u,__ATOMIC_RELAXED,__HIP_MEMORY_SCOPE_AGENT);
  __syncthreads(); const unsigned n=*slot; __syncthreads(); return (int)n;
}
template<int THRL=8> __device__ __forceinline__ void attn_phase(char*lds,int bx,unsigned*qctr,volatile __attribute__((address_space(3))) unsigned*slot,float lam,float oscale,const float*subg,const unsigned*nmax,unsigned*o1s,const bf16*Q,const bf16*K,const bf16*V,bf16*MIX){
  for(int qi=0;qi<8;++qi){ const int x=(bx+qi)&7;
    for(;;){ const int n=wg_pop(qctr+64*x,slot); if(n>=128)break;
      const int qb=15-(n>>3),h=7-(n&7),b=(x+h)&7;
#if PROBE_ATT == 1
      const unsigned long long pa0_=__builtin_amdgcn_s_memrealtime();
#endif
      attn_unit4<THRL>(b,h,qb,lam,oscale,subg,nmax,o1s,Q,K,V,MIX,lds);
#if PROBE_ATT == 1
      if(blockIdx.x==PROBE_BLK&&threadIdx.x==0)atomicAdd((unsigned*)nmax+900,(unsigned)(__builtin_amdgcn_s_memrealtime()-pa0_));
#endif
    } }
}
#undef SBAR
#undef WAIT_BAR
#undef MFMA32
}
#define GAS __attribute__((address_space(1)))
#define LAS __attribute__((address_space(3)))
typedef unsigned short bf16;
typedef unsigned v4u __attribute__((ext_vector_type(4)));
typedef float f32x4 __attribute__((ext_vector_type(4)));
typedef short bf16x8 __attribute__((ext_vector_type(8)));
typedef GAS unsigned gu32;
typedef GAS unsigned long long gu64;
#define RLX_AGENT __ATOMIC_RELAXED, __HIP_MEMORY_SCOPE_AGENT
#define LDS_WAIT() asm volatile("s_waitcnt lgkmcnt(0)" ::: "memory")
#define VM_WAIT() asm volatile("s_waitcnt vmcnt(0)" ::: "memory")
__device__ __forceinline__ unsigned long long rt() { return __builtin_amdgcn_s_memrealtime(); }
__device__ __forceinline__ unsigned f2bf(float f) { unsigned u = __builtin_bit_cast(unsigned, f); return (u + 0x7fffu + ((u >> 16) & 1u)) >> 16; }
__device__ __forceinline__ unsigned pk2(float lo, float hi) { return f2bf(lo) | (f2bf(hi) << 16); }

#define XB_TMO      128
#define XB_XCNT(j)  (256  + 64 * (j))
#define XB_XSUB(j)  (1280 + 64 * (j))
#define XB_XGEN(j)  (2304 + 64 * (j))
#define XB_TOP      3328
#define XB_TOPGEN   3392
#define XCD_BAR_WORDS 3456
#define XB_SPIN_CAP (1u << 18)

__device__ __forceinline__ unsigned xb_ld(unsigned* p)              { return __hip_atomic_load(p, __ATOMIC_RELAXED, __HIP_MEMORY_SCOPE_AGENT); }
__device__ __forceinline__ unsigned xb_add(unsigned* p, unsigned v) { return __hip_atomic_fetch_add(p, v, __ATOMIC_RELAXED, __HIP_MEMORY_SCOPE_AGENT); }
__device__ __forceinline__ unsigned xb_xcc_id() { return (unsigned)__builtin_amdgcn_s_getreg((3 << 11) | 20) & 0xFu; }
#define XB_SPIN(cond, bar) do { unsigned _sp = 0; while (cond) { __builtin_amdgcn_s_sleep(1); \
    if ((++_sp & 255u) == 0u) { if (xb_ld(&(bar)[XB_TMO])) break; if (_sp > XB_SPIN_CAP) { atomicAdd(&(bar)[XB_TMO], 1u); break; } } } } while (0)

struct XcdBarrier {
    unsigned* bar; unsigned x;
    volatile LAS unsigned* st;
};

__device__ __forceinline__ XcdBarrier xcd_barrier_post(unsigned* bar, volatile LAS unsigned* st) {
    XcdBarrier b; b.bar = bar; b.x = xb_xcc_id(); b.st = st;
    if (threadIdx.x == 0) (void)xb_add(&bar[XB_XCNT(b.x)], 1u);
    return b;
}
__device__ __forceinline__ void xcd_barrier_complete(unsigned* bar, unsigned x, unsigned& nloc, unsigned& nx) {
    const unsigned G = gridDim.x * gridDim.y * gridDim.z;
    unsigned sum, cnt, mine, sp = 0u;
    for (;;) {
        sum = 0u; cnt = 0u; mine = 0u;
#pragma unroll
        for (unsigned j = 0; j < 16; ++j) { const unsigned c = xb_ld(&bar[XB_XCNT(j)]); sum += c; cnt += (c > 0u) ? 1u : 0u; mine = (j == x) ? c : mine; }
        if (sum == G) break;
        __builtin_amdgcn_s_sleep(1);
        if ((++sp & 255u) == 0u) { if (xb_ld(&bar[XB_TMO])) break; if (sp > XB_SPIN_CAP) { atomicAdd(&bar[XB_TMO], 1u); break; } }
    }
    nloc = mine > 0u ? mine : 1u; nx = cnt > 0u ? cnt : 1u;
}

__device__ __forceinline__ void xcd_barrier(const XcdBarrier& b) {
    asm volatile("s_waitcnt vmcnt(0)" ::: "memory");
    __syncthreads();
    if (threadIdx.x == 0) {
        unsigned* bar = b.bar;
        __builtin_amdgcn_s_waitcnt(0);
        unsigned nloc = b.st[0], nx = b.st[1];
        if (nloc == 0u) { xcd_barrier_complete(bar, b.x, nloc, nx); b.st[0] = nloc; b.st[1] = nx; }
        const unsigned old = xb_add(&bar[XB_XSUB(b.x)], 1u);
        const unsigned gen = old / nloc;
        if (old + 1u == (gen + 1u) * nloc) {
            __builtin_amdgcn_fence(__ATOMIC_RELEASE, "agent");
            asm volatile("s_waitcnt vmcnt(0)" ::: "memory");
            const unsigned og = xb_add(&bar[XB_TOP], 1u);
            const unsigned tg = og / nx;
            if (og + 1u == (tg + 1u) * nx) xb_add(&bar[XB_TOPGEN], 1u);
            else XB_SPIN(xb_ld(&bar[XB_TOPGEN]) == tg, bar);
            __builtin_amdgcn_fence(__ATOMIC_ACQUIRE, "agent");
            xb_add(&bar[XB_XGEN(b.x)], 1u);
            asm volatile("s_waitcnt vmcnt(0)" ::: "memory");
        } else {
            XB_SPIN(xb_ld(&bar[XB_XGEN(b.x)]) == gen, bar);
            __builtin_amdgcn_fence(__ATOMIC_ACQUIRE, "agent");
            asm volatile("s_waitcnt vmcnt(0)" ::: "memory");
        }
    }
    __syncthreads();
}

constexpr int NWAVES = 8;
constexpr int BATCH = 8, SEQ = 4096, T = BATCH * SEQ, D = 2048, NIN = 5120, NEXP = 32, NA = 2 * T;
constexpr float EPS = 1e-6f, LOG2E = 1.4426950408889634f, C2 = 0.125f * 1.4426950408889634f;
constexpr size_t MiB = 1u << 20;
constexpr size_t WS_CTL = 0, CTL_ZERO_BYTES = 1 * MiB;
constexpr size_t WS_RSTD1 = 1 * MiB, WS_RSTD2 = WS_RSTD1 + 128 * 1024, WS_WTS = WS_RSTD2 + 128 * 1024;
constexpr size_t WS_LIST = 2 * MiB;
constexpr size_t WS_PART = 6 * MiB;
constexpr size_t WS_WIN = 10 * MiB, WS_WOUT = 30 * MiB;
constexpr size_t WS_WGU = 38 * MiB, WS_WD = 166 * MiB;
constexpr size_t WS_XB = 230 * MiB;
constexpr size_t WS_CG = 358 * MiB;
constexpr size_t WS_MIX = 422 * MiB;
constexpr size_t WS_HB = 550 * MiB;
constexpr size_t WS_HB8 = 678 * MiB;
constexpr size_t WS_WR = 742 * MiB;
constexpr size_t WS_X8 = 743 * MiB;
constexpr size_t WS_WIN8 = 807 * MiB;
constexpr size_t WS_O1S = 811 * MiB;
constexpr size_t WS_LISTW = 827 * MiB, WS_LISTR = 831 * MiB;
constexpr size_t WS_END = 835 * MiB;
constexpr float WSCALE = 32.f, H1SCALE = 4.f, YSCALE = 8.f;
constexpr int CW_TMO = 0, CW_CODE = 1, CW_BAR = 4096, CW_CNT = 8192;
constexpr int CW_GQ = 20480;
constexpr int CW_H8Q = 24576 + 1024;
constexpr int CW_CVQ = 24576, CW_DONE = 24576 + 64;
constexpr int CW_QA = 12288, CW_QC = 12288 + 512, CW_NMAX = 16384;
constexpr int RING_OFF = 0, RING_BYTES = 131072, LDSCTL_OFF = RING_BYTES, MISC_OFF = LDSCTL_OFF + 320, TAB_OFF = LDSCTL_OFF + 1024;
constexpr int LDS_BYTES = 147456;
constexpr int NPHASE = 8;
#ifndef MK_ONE_LAUNCH
#define MK_ONE_LAUNCH 1
#endif
#ifndef PROBE_DOUBLE
#define PROBE_DOUBLE 0
#endif
#ifndef PROBE_CLOCK
#define PROBE_CLOCK 0
#endif
#ifndef USE_NAIVE_ROUTER
#define USE_NAIVE_ROUTER 0
#endif
#ifndef USE_NAIVE_ATTN
#define USE_NAIVE_ATTN 0
#endif


typedef unsigned u32x4g __attribute__((ext_vector_type(4)));
__device__ __forceinline__ float wave_sum(float v) {
#pragma unroll
    for (int o = 1; o < 64; o <<= 1) v += __shfl_xor(v, o);
    return v;
}
__device__ __forceinline__ float bflo(unsigned w) { return __builtin_bit_cast(float, w << 16); }
__device__ __forceinline__ float bfhi(unsigned w) { return __builtin_bit_cast(float, w & 0xffff0000u); }
__device__ __forceinline__ float fexp2(float x) { return __builtin_amdgcn_exp2f(x); }

__device__ __forceinline__ void tr_item(const float* W, int N, const float* gk, int k0, int n0, bf16* dst, int dstK, LAS float* scr, int lane) {
    const int kr = lane >> 3, n4 = 4 * (lane & 7); f32x4 v[8];
#pragma unroll
    for (int i = 0; i < 8; ++i) v[i] = *(const GAS f32x4*)(W + (size_t)(k0 + 8 * i + kr) * N + n0 + n4);
#pragma unroll
    for (int i = 0; i < 8; ++i) { const int kk = 8 * i + kr; const float g = gk ? gk[k0 + kk] : 1.0f;
        scr[(n4 + 0) * 66 + kk] = v[i].x * g; scr[(n4 + 1) * 66 + kk] = v[i].y * g; scr[(n4 + 2) * 66 + kk] = v[i].z * g; scr[(n4 + 3) * 66 + kk] = v[i].w * g; }
    LDS_WAIT(); asm volatile("" ::: "memory");
    const int c = lane & 7;
#pragma unroll
    for (int j = 0; j < 4; ++j) { const int n = (lane >> 3) + 8 * j; const LAS float* s = scr + n * 66 + 8 * c;
        v4u o; o.x = pk2(s[0], s[1]); o.y = pk2(s[2], s[3]); o.z = pk2(s[4], s[5]); o.w = pk2(s[6], s[7]);
        *(GAS v4u*)(dst + (size_t)n * dstK + 8 * c) = o; }
    LDS_WAIT(); asm volatile("" ::: "memory");
}
__device__ __forceinline__ void tr8_load(const float* W, int N, int k0, int n0, int lane, f32x4 (&v)[8]) {
    const int kr = lane >> 3, n4 = 4 * (lane & 7);
#pragma unroll
    for (int i = 0; i < 8; ++i) v[i] = *(const GAS f32x4*)(W + (size_t)(k0 + 8 * i + kr) * N + n0 + n4);
}
__device__ __forceinline__ void tr8_finish(const f32x4 (&v)[8], const float* gk, float scale, int k0, unsigned char* dst, int dstK, LAS float* scr, int lane) {
    const int kr = lane >> 3, n4 = 4 * (lane & 7);
#pragma unroll
    for (int i = 0; i < 8; ++i) { const int kk = 8 * i + kr; const float g = (gk ? gk[k0 + kk] : 1.0f) * scale;
        scr[(n4 + 0) * 66 + kk] = v[i].x * g; scr[(n4 + 1) * 66 + kk] = v[i].y * g; scr[(n4 + 2) * 66 + kk] = v[i].z * g; scr[(n4 + 3) * 66 + kk] = v[i].w * g; }
    LDS_WAIT(); asm volatile("" ::: "memory");
    const int c = lane & 7;
#pragma unroll
    for (int j = 0; j < 4; ++j) { const int n = (lane >> 3) + 8 * j; const LAS float* s = scr + n * 66 + 8 * c;
        pg8::u32x2 o; o.x = pg8::pk4_fp8(s[0], s[1], s[2], s[3]); o.y = pg8::pk4_fp8(s[4], s[5], s[6], s[7]);
        *(GAS pg8::u32x2*)(dst + (size_t)n * dstK + 8 * c) = o; }
    LDS_WAIT(); asm volatile("" ::: "memory");
}
__device__ __forceinline__ void tr_item8(const float* W, int N, const float* gk, float scale, int k0, int n0, unsigned char* dst, int dstK, LAS float* scr, int lane) {
    f32x4 v[8]; tr8_load(W, N, k0, n0, lane, v); tr8_finish(v, gk, scale, k0, dst, dstK, scr, lane);
}
struct Ptrs {
    const float *x, *g1, *w_in, *lq1, *lk1, *lq2, *lk2, *subg, *cw, *cb, *lng, *lnb, *w_out, *g2, *wgr, *bgr, *wer, *ber, *w_gate, *w_up, *w_down, *gf;
    float* out; unsigned char* ws;
};
__device__ __forceinline__ void p0_prologue(const Ptrs& P, LAS unsigned char* lds, int lane, int wave, int gw, int NGW) {
    LAS float* scr = (LAS float*)(lds + RING_OFF + wave * 16384);
    bf16* WIN = (bf16*)(P.ws + WS_WIN); bf16* WOUT = (bf16*)(P.ws + WS_WOUT);
    constexpr int I_IN = 32 * 160, I_OUT = 32 * 64, NITEMS = I_IN + I_OUT;
    for (int it = gw; it < NITEMS; it += NGW) {
        if (it < I_IN) { const int kb = it / 160, nb = it % 160;
            if (nb < 96) tr_item(P.w_in, NIN, P.g1, 64 * kb, 32 * nb, WIN + (size_t)(32 * nb) * 2048 + 64 * kb, 2048, scr, lane);
            else { const int j0 = 32 * (nb - 96), jj = j0 & 1023, drow = 256 * (jj >> 7) + (jj & 127) + (j0 >= 1024 ? 128 : 0);
                tr_item8(P.w_in, NIN, P.g1, WSCALE, 64 * kb, 32 * nb, P.ws + WS_WIN8 + (size_t)drow * 2048 + 64 * kb, 2048, scr, lane); } }
        else { const int r = it - I_IN, kb = r >> 6, nb = r & 63; tr_item(P.w_out, 2048, nullptr, 64 * kb, 32 * nb, WOUT + (size_t)(32 * nb) * 2048 + 64 * kb, 2048, scr, lane); }
    }
    { bf16* WR = (bf16*)(P.ws + WS_WR);
      for (int it = gw; it < 32; it += NGW) tr_item(P.wer, 32, P.g2, 64 * it, 0, WR + 64 * it, 2048, scr, lane);
      for (int k = gw * 64 + lane; k < 2048; k += NGW * 64) { const float gk = P.g2[k]; const f32x4 w = *(const f32x4*)(P.wgr + (size_t)k * 4);
          WR[(size_t)128 * 2048 + k] = (bf16)f2bf(w.x * gk); WR[(size_t)129 * 2048 + k] = (bf16)f2bf(w.y * gk); WR[(size_t)130 * 2048 + k] = (bf16)f2bf(w.z * gk); WR[(size_t)131 * 2048 + k] = (bf16)f2bf(w.w * gk); } }
    bf16* XB = (bf16*)(P.ws + WS_XB); float* RS1 = (float*)(P.ws + WS_RSTD1);
    for (int m0 = gw; m0 < T; m0 += 2 * NGW) {
        f32x4 v[2][8]; float ss[2] = {0.f, 0.f};
#pragma unroll
        for (int q = 0; q < 2; ++q) { const int mr = (m0 + q * NGW < T) ? m0 + q * NGW : T - 1; const GAS f32x4* xr = (const GAS f32x4*)(P.x + (size_t)mr * D) + lane;
#pragma unroll
            for (int j = 0; j < 8; ++j) v[q][j] = xr[64 * j]; }
#pragma unroll
        for (int q = 0; q < 2; ++q) { const int m = m0 + q * NGW; if (m >= T) continue;
#pragma unroll
            for (int j = 0; j < 8; ++j) ss[q] += (v[q][j].x * v[q][j].x + v[q][j].y * v[q][j].y) + (v[q][j].z * v[q][j].z + v[q][j].w * v[q][j].w);
            ss[q] = wave_sum(ss[q]);
            if (lane == 0) RS1[m] = 1.0f / sqrtf(ss[q] * (1.0f / D) + EPS);
            GAS unsigned long long* o8 = (GAS unsigned long long*)(XB + (size_t)m * D) + lane; GAS unsigned* o4 = (GAS unsigned*)(P.ws + WS_X8 + (size_t)m * D) + lane;
#pragma unroll
            for (int j = 0; j < 8; ++j) { o8[64 * j] = (unsigned long long)pk2(v[q][j].x, v[q][j].y) | ((unsigned long long)pk2(v[q][j].z, v[q][j].w) << 32); o4[64 * j] = pg8::pk4_fp8(v[q][j].x, v[q][j].y, v[q][j].z, v[q][j].w); } }
    }
}

constexpr int CVT_ITEMS = 3 * 32768, CVT_CH = 4, CVT_CHUNK = CVT_CH * NWAVES, CVT_NCHUNK = CVT_ITEMS / CVT_CHUNK;
struct MoeItem { const float* src; const float* gk; unsigned char* dst; int N, k0, n0, dstK; };
__device__ __forceinline__ MoeItem moe_decode(const Ptrs& P, int r) {
    unsigned char* WGU = P.ws + WS_WGU; unsigned char* WD = P.ws + WS_WD; MoeItem m;
    const int mat = r >> 15, r2 = r & 32767, e = r2 >> 10, idx = r2 & 1023;
    if (mat < 2) { const int kb = idx >> 5, n0 = 32 * (idx & 31); const int drow = e * 2048 + 256 * (n0 >> 7) + (n0 & 127) + (mat == 1 ? 128 : 0);
        m.src = (mat == 0 ? P.w_gate : P.w_up) + (size_t)e * 2048 * 1024; m.N = 1024; m.gk = P.g2; m.k0 = 64 * kb; m.n0 = n0; m.dst = WGU + (size_t)drow * 2048 + 64 * kb; m.dstK = 2048; }
    else { const int kb = idx >> 6, nb = idx & 63; m.src = P.w_down + (size_t)e * 1024 * 2048; m.N = 2048; m.gk = nullptr; m.k0 = 64 * kb; m.n0 = 32 * nb; m.dst = WD + ((size_t)e * 2048 + 32 * nb) * 1024 + 64 * kb; m.dstK = 1024; }
    return m;
}
__device__ __forceinline__ void cvt_fill(const Ptrs& P, LAS unsigned char* lds, volatile LAS unsigned* slot, int max_chunks, const unsigned* donew, int G) {
    int tid_ = threadIdx.x; asm volatile("" : "+v"(tid_)); const int lane = tid_ & 63, wave = __builtin_amdgcn_readfirstlane(tid_ >> 6);
    LAS float* scr = (LAS float*)(lds + RING_OFF + wave * 16384); unsigned* ctr = (unsigned*)(P.ws + WS_CTL) + CW_CVQ;
    for (int n = 0; n < max_chunks; ++n) {
        if (threadIdx.x == 0) { unsigned v = 0xffffffffu;
            if (!(donew && (int)__hip_atomic_load(donew, __ATOMIC_RELAXED, __HIP_MEMORY_SCOPE_AGENT) >= G - 16)) v = __hip_atomic_fetch_add(ctr, 1u, __ATOMIC_RELAXED, __HIP_MEMORY_SCOPE_AGENT);
            *slot = v; }
        __syncthreads(); const unsigned c = *slot; __syncthreads();
        if (c >= (unsigned)CVT_NCHUNK) break;
#pragma unroll 1
        for (int j = 0; j < CVT_CH; j += 2) {
            const MoeItem m0 = moe_decode(P, (int)c * CVT_CHUNK + wave * CVT_CH + j), m1 = moe_decode(P, (int)c * CVT_CHUNK + wave * CVT_CH + j + 1);
            f32x4 v0[8], v1[8]; tr8_load(m0.src, m0.N, m0.k0, m0.n0, lane, v0); tr8_load(m1.src, m1.N, m1.k0, m1.n0, lane, v1);
            tr8_finish(v0, m0.gk, WSCALE, m0.k0, m0.dst, m0.dstK, scr, lane); tr8_finish(v1, m1.gk, WSCALE, m1.k0, m1.dst, m1.dstK, scr, lane); }
    }
}
__device__ __forceinline__ void h8_fill(const Ptrs& P, const bf16* HB, unsigned char* H8, volatile LAS unsigned* slot) {
    int tid_ = threadIdx.x; asm volatile("" : "+v"(tid_)); const int lane = tid_ & 63, wave = __builtin_amdgcn_readfirstlane(tid_ >> 6);
    unsigned* ctr = (unsigned*)(P.ws + WS_CTL) + CW_H8Q;
    for (;;) { const int c = attn_body::wg_pop(ctr, slot); if (c >= T / 64) break;
#pragma unroll 1
        for (int j = 0; j < 8; j += 4) { const int r0 = c * 64 + wave * 8 + j; u32x4g a[4][4];
#pragma unroll
            for (int q = 0; q < 4; ++q)
#pragma unroll
                for (int i = 0; i < 4; ++i) a[q][i] = *(const u32x4g*)(HB + (size_t)(r0 + q) * D + 16 * lane + 1024 * (i >> 1) + 8 * (i & 1));
#pragma unroll
            for (int q = 0; q < 4; ++q)
#pragma unroll
                for (int hj = 0; hj < 2; ++hj) { const u32x4g w0 = a[q][2 * hj], w1 = a[q][2 * hj + 1]; v4u o;
                    o.x = pg8::pk4_fp8(bflo(w0.x), bfhi(w0.x), bflo(w0.y), bfhi(w0.y)); o.y = pg8::pk4_fp8(bflo(w0.z), bfhi(w0.z), bflo(w0.w), bfhi(w0.w));
                    o.z = pg8::pk4_fp8(bflo(w1.x), bfhi(w1.x), bflo(w1.y), bfhi(w1.y)); o.w = pg8::pk4_fp8(bflo(w1.z), bfhi(w1.z), bflo(w1.w), bfhi(w1.w));
                    *(v4u*)(H8 + (size_t)(r0 + q) * D + 16 * lane + 1024 * hj) = o; } }
    }
}
__device__ __forceinline__ void router_skinny(const Ptrs& P, const bf16* HB, unsigned char* H8, LAS unsigned char* lds, int G) {
    int tid_ = threadIdx.x; asm volatile("" : "+v"(tid_)); const int tid = tid_, lane = tid & 63, wave = __builtin_amdgcn_readfirstlane(tid >> 6), fr = lane & 15, fq = lane >> 4;
    constexpr int BROW = 1040, BBUF = 48 * BROW;
    const bf16* WR = (const bf16*)(P.ws + WS_WR);
    LAS unsigned char* Bb = lds + RING_OFF; LAS float* LX = (LAS float*)(lds + RING_OFF + 2 * BBUF) + wave * (16 * 37);
    LAS unsigned* cntL = (LAS unsigned*)(lds + RING_OFF + 2 * BBUF + 8 * 16 * 37 * 4); LAS unsigned* baseL = cntL + 32;
    const float* part = (const float*)(P.ws + WS_PART); float* listr = (float*)(P.ws + WS_LISTR); float* listw = (float*)(P.ws + WS_LISTW); int* list = (int*)(P.ws + WS_LIST);
    unsigned* cnt = (unsigned*)(P.ws + WS_CTL) + CW_CNT;
    int brow[6], bcol[6];
#pragma unroll
    for (int i = 0; i < 6; ++i) { const int pc = tid + 512 * i; brow[i] = pc >> 6; bcol[i] = pc & 63; }
    for (int u = blockIdx.x; u < T / 128; u += G) {
        const int r0 = u * 128 + wave * 16;
        const bf16* arow = HB + (size_t)(r0 + fr) * D + 16 * fq;
        unsigned char* orow = H8 + (size_t)(r0 + fr) * D + 16 * fq;
        u32x4g bs[6], a[2][16]; pg8::f32x4 acc[3];
#pragma unroll
        for (int nb = 0; nb < 3; ++nb) acc[nb] = (pg8::f32x4){0.f, 0.f, 0.f, 0.f};
#define RS_LOADB(c) do { _Pragma("unroll") for (int i = 0; i < 6; ++i) { const int sr = brow[i] < 32 ? brow[i] : 128 + ((brow[i] - 32) & 3); \
            bs[i] = *(const u32x4g*)(WR + (size_t)sr * D + 512 * (c) + 8 * bcol[i]); } } while (0)
#define RS_STOREB(c) do { _Pragma("unroll") for (int i = 0; i < 6; ++i) *(LAS u32x4g*)(Bb + ((c) & 1) * BBUF + brow[i] * BROW + bcol[i] * 16) = bs[i]; } while (0)
#define RS_LOADA(c) do { _Pragma("unroll") for (int s = 0; s < 16; ++s) a[(c) & 1][s] = *(const u32x4g*)(arow + 512 * (c) + 64 * (s >> 1) + 8 * (s & 1)); } while (0)
        RS_LOADB(0); RS_LOADA(0); RS_STOREB(0);
#pragma unroll
        for (int c = 0; c < 4; ++c) {
            __syncthreads();
            if (c < 3) { RS_LOADB(c + 1); RS_LOADA(c + 1); }
#pragma unroll
            for (int s = 0; s < 16; ++s) {
                const pg8::bf16x8 af = __builtin_bit_cast(pg8::bf16x8, a[c & 1][s]);
#pragma unroll
                for (int nb = 0; nb < 3; ++nb) {
                    const pg8::bf16x8 bf = *(const LAS pg8::bf16x8*)(Bb + (c & 1) * BBUF + (16 * nb + fr) * BROW + (64 * (s >> 1) + 16 * fq + 8 * (s & 1)) * 2);
                    acc[nb] = __builtin_amdgcn_mfma_f32_16x16x32_bf16(af, bf, acc[nb], 0, 0, 0); }
            }
            if (c < 3) RS_STOREB(c + 1);
#pragma unroll
            for (int s = 0; s < 16; s += 2) { const u32x4g w0 = a[c & 1][s], w1 = a[c & 1][s + 1]; v4u o;
                o.x = pg8::pk4_fp8(bflo(w0.x), bfhi(w0.x), bflo(w0.y), bfhi(w0.y)); o.y = pg8::pk4_fp8(bflo(w0.z), bfhi(w0.z), bflo(w0.w), bfhi(w0.w));
                o.z = pg8::pk4_fp8(bflo(w1.x), bfhi(w1.x), bflo(w1.y), bfhi(w1.y)); o.w = pg8::pk4_fp8(bflo(w1.z), bfhi(w1.z), bflo(w1.w), bfhi(w1.w));
                *(v4u*)(orow + 512 * c + 64 * (s >> 1)) = o; }
        }
#undef RS_LOADB
#undef RS_STOREB
#undef RS_LOADA
#pragma unroll
        for (int nb = 0; nb < 3; ++nb)
#pragma unroll
            for (int r = 0; r < 4; ++r) if (nb < 2 || fr < 4) LX[(4 * fq + r) * 37 + 16 * nb + fr] = acc[nb][r];
        if (tid < 32) cntL[tid] = 0u;
        __syncthreads();
        int ea = 0, eb = 0, row = 0; unsigned ra = 0u, rb = 0u; float w1 = 0.f, w2 = 0.f, rstd = 0.f;
        if (lane < 16) { row = r0 + lane; const LAS float* lx = LX + lane * 37;
            float sq[4];
#pragma unroll
            for (int q = 0; q < 4; ++q) { const pg8::f32x4 p0 = *(const pg8::f32x4*)(part + (size_t)row * 32 + 8 * q), p1 = *(const pg8::f32x4*)(part + (size_t)row * 32 + 8 * q + 4);
                sq[q] = ((p0[0] + p0[1]) + (p0[2] + p0[3])) + ((p1[0] + p1[1]) + (p1[2] + p1[3])); }
            const float ss = (sq[0] + sq[1]) + (sq[2] + sq[3]);
            rstd = 1.0f / sqrtf(ss * (1.0f / 2048.0f) + 1e-6f);
            float g[4];
#pragma unroll
            for (int i = 0; i < 4; ++i) g[i] = lx[32 + i] * rstd + P.bgr[i];
            int gs = 0; float gm = g[0];
#pragma unroll
            for (int i = 1; i < 4; ++i) if (g[i] > gm) { gm = g[i]; gs = i; }
            float gsum = 0.f;
#pragma unroll
            for (int i = 0; i < 4; ++i) gsum += __expf(g[i] - gm);
            const float gw = 1.0f / gsum;
            float ev[8];
#pragma unroll
            for (int i = 0; i < 8; ++i) ev[i] = lx[8 * gs + i] * rstd + P.ber[8 * gs + i];
            int i1 = 0; float v1 = ev[0];
#pragma unroll
            for (int i = 1; i < 8; ++i) if (ev[i] > v1) { v1 = ev[i]; i1 = i; }
            int i2 = -1; float v2 = -3.0e38f;
#pragma unroll
            for (int i = 0; i < 8; ++i) if (i != i1 && ev[i] > v2) { v2 = ev[i]; i2 = i; }
            const float e2 = __expf(v2 - v1); w1 = gw / (1.f + e2); w2 = gw * e2 / (1.f + e2);
            ea = gs * 8 + i1; eb = gs * 8 + i2;
            ra = __hip_atomic_fetch_add(cntL + ea, 1u, __ATOMIC_RELAXED, __HIP_MEMORY_SCOPE_WORKGROUP);
            rb = __hip_atomic_fetch_add(cntL + eb, 1u, __ATOMIC_RELAXED, __HIP_MEMORY_SCOPE_WORKGROUP); }
        __syncthreads();
        if (tid < 32) { const unsigned n = cntL[tid]; baseL[tid] = n ? __hip_atomic_fetch_add(cnt + 64 * tid, n, __ATOMIC_RELAXED, __HIP_MEMORY_SCOPE_AGENT) : 0u; }
        __syncthreads();
        if (lane < 16) { const size_t ia = (size_t)ea * T + baseL[ea] + ra, ib = (size_t)eb * T + baseL[eb] + rb;
            list[ia] = 2 * row; list[ib] = 2 * row + 1; listw[ia] = w1; listw[ib] = w2; listr[ia] = rstd; listr[ib] = rstd; }
    }
    __syncthreads();
}
__device__ __forceinline__ void phase_tail(const Ptrs& P, LAS unsigned char* lds, volatile LAS unsigned* slot, int ph, int G) {
    unsigned* donew = (unsigned*)(P.ws + WS_CTL) + CW_DONE + 64 * ph;
    __syncthreads();
    if (threadIdx.x == 0) __hip_atomic_fetch_add(donew, 1u, __ATOMIC_RELAXED, __HIP_MEMORY_SCOPE_AGENT);
    cvt_fill(P, lds, slot, 1 << 30, donew, G);
}

__device__ __forceinline__ void naive_attn(const Ptrs& P, const bf16* Q, const bf16* Kb, const bf16* Vb, bf16* MIX, int lane, int gw, int NGW) {
    const float s1 = wave_sum(P.lq1[lane] * P.lk1[lane]), s2 = wave_sum(P.lq2[lane] * P.lk2[lane]);
    const float lam0 = 0.2f, lam = expf(s1) - expf(s2) + lam0;
    const int r16 = lane & 15, c = (lane >> 4) & 1, vh = lane >> 5;
    for (int u = gw; u < 16384; u += NGW) {
        const int bh = u & 63, qb = 255 - (u >> 6), b = bh >> 3, h = bh & 7, i = qb * 16 + r16, jmax = qb * 16 + 15;
        const float sl2 = exp2f(-(float)(h + 1)) * LOG2E; const size_t rowb = (size_t)b * SEQ;
        float q[64], O[64];
        { const u32x4g* qp = (const u32x4g*)(Q + (rowb + i) * 1024 + h * 128 + c * 64);
#pragma unroll
          for (int d8 = 0; d8 < 8; ++d8) { const u32x4g w = qp[d8]; q[8 * d8 + 0] = bflo(w.x); q[8 * d8 + 1] = bfhi(w.x); q[8 * d8 + 2] = bflo(w.y); q[8 * d8 + 3] = bfhi(w.y);
              q[8 * d8 + 4] = bflo(w.z); q[8 * d8 + 5] = bfhi(w.z); q[8 * d8 + 6] = bflo(w.w); q[8 * d8 + 7] = bfhi(w.w); } }
#pragma unroll
        for (int d = 0; d < 64; ++d) O[d] = 0.f;
        float m = -1e30f, l = 0.f;
        for (int j = 0; j <= jmax; ++j) {
            const u32x4g* kp = (const u32x4g*)(Kb + (rowb + j) * 1024 + h * 128 + c * 64); float s = 0.f;
#pragma unroll
            for (int d8 = 0; d8 < 8; ++d8) { const u32x4g w = kp[d8];
                s += q[8 * d8 + 0] * bflo(w.x) + q[8 * d8 + 1] * bfhi(w.x) + q[8 * d8 + 2] * bflo(w.y) + q[8 * d8 + 3] * bfhi(w.y)
                   + q[8 * d8 + 4] * bflo(w.z) + q[8 * d8 + 5] * bfhi(w.z) + q[8 * d8 + 6] * bflo(w.w) + q[8 * d8 + 7] * bfhi(w.w); }
            s += sl2 * (float)(j - i);
            if (j <= i) {
                if (s > m) { const float al = fexp2(m - s); l *= al;
#pragma unroll
                    for (int d = 0; d < 64; ++d) O[d] *= al;
                    m = s; }
                const float p = fexp2(s - m); l += p;
                const u32x4g* vp = (const u32x4g*)(Vb + (rowb + j) * 1024 + h * 128 + vh * 64);
#pragma unroll
                for (int d8 = 0; d8 < 8; ++d8) { const u32x4g w = vp[d8];
                    O[8 * d8 + 0] += p * bflo(w.x); O[8 * d8 + 1] += p * bfhi(w.x); O[8 * d8 + 2] += p * bflo(w.y); O[8 * d8 + 3] += p * bfhi(w.y);
                    O[8 * d8 + 4] += p * bflo(w.z); O[8 * d8 + 5] += p * bfhi(w.z); O[8 * d8 + 6] += p * bflo(w.w); O[8 * d8 + 7] += p * bfhi(w.w); }
            }
        }
        const float il = 1.0f / l; float ss = 0.f;
#pragma unroll
        for (int d = 0; d < 64; ++d) { float o = O[d] * il; const float o2 = __shfl_xor(o, 16); o = o - lam * o2; O[d] = o; ss += o * o; }
        ss += __shfl_xor(ss, 32);
        const float r = (1.0f / sqrtf(ss * (1.0f / 128.0f) + EPS)) * (1.0f - lam0);
        if (c == 0) { u32x4g* op = (u32x4g*)(MIX + (rowb + i) * 2048 + h * 128 + vh * 64); const float* sg = P.subg + vh * 64;
#pragma unroll
            for (int d8 = 0; d8 < 8; ++d8) { u32x4g w; w.x = pk2(O[8 * d8 + 0] * r * sg[8 * d8 + 0], O[8 * d8 + 1] * r * sg[8 * d8 + 1]); w.y = pk2(O[8 * d8 + 2] * r * sg[8 * d8 + 2], O[8 * d8 + 3] * r * sg[8 * d8 + 3]);
                w.z = pk2(O[8 * d8 + 4] * r * sg[8 * d8 + 4], O[8 * d8 + 5] * r * sg[8 * d8 + 5]); w.w = pk2(O[8 * d8 + 6] * r * sg[8 * d8 + 6], O[8 * d8 + 7] * r * sg[8 * d8 + 7]); op[d8] = w; } }
    }
}

typedef float f32x2c __attribute__((ext_vector_type(2)));
__device__ __forceinline__ void conv_phase(const Ptrs& P, const bf16* CA, bf16* MIX, LAS unsigned char* lds, int blk, unsigned* qctr, volatile LAS unsigned* slot) {
    int tid_ = threadIdx.x; asm volatile("" : "+v"(tid_)); const int tid = tid_, lane = tid & 63, wave = __builtin_amdgcn_readfirstlane(tid >> 6);
    LAS unsigned* C = (LAS unsigned*)(lds + RING_OFF);
    f32x2c w[31];
#pragma unroll
    for (int j = 0; j < 31; ++j) w[j] = *(const f32x2c*)(P.cw + j * 1024 + 2 * tid);
    const f32x2c bias = *(const f32x2c*)(P.cb + 2 * tid);
    for (int qi = 0; qi < 8; ++qi) { const int xq = (blk + qi) & 7;
    for (;;) { const int n_ = attn_body::wg_pop(qctr + 64 * xq, slot); if (n_ >= 64) break;
        const int tile = xq + 8 * n_, b = tile >> 6, t0 = (tile & 63) * 64; const size_t rowb = (size_t)b * SEQ;
        const unsigned* up = (const unsigned*)(CA + rowb * 1024 + 2 * tid);
        f32x2c win[38]; unsigned hist[30];
#pragma unroll
        for (int k = 0; k < 30; ++k) { const int t = t0 - 30 + k; hist[k] = (t >= 0) ? up[(size_t)t * 512] : 0u; }
        unsigned nw[8];
#pragma unroll
        for (int i = 0; i < 8; ++i) nw[i] = up[(size_t)(t0 + i) * 512];
#pragma unroll
        for (int k = 0; k < 30; ++k) win[k] = (f32x2c){bflo(hist[k]), bfhi(hist[k])};
#pragma unroll 1
        for (int blk8 = 0; blk8 < 8; ++blk8) {
#pragma unroll
            for (int i = 0; i < 8; ++i) win[30 + i] = (f32x2c){bflo(nw[i]), bfhi(nw[i])};
            if (blk8 < 7) {
#pragma unroll
                for (int i = 0; i < 8; ++i) nw[i] = up[(size_t)(t0 + 8 * (blk8 + 1) + i) * 512];
            }
#pragma unroll
            for (int i = 0; i < 8; ++i) { f32x2c acc = bias;
#pragma unroll
                for (int j = 0; j < 31; ++j) acc = w[j] * win[i + j] + acc;
                C[(8 * blk8 + i) * 512 + tid] = pk2(acc.x, acc.y); }
#pragma unroll
            for (int k = 0; k < 30; ++k) win[k] = win[k + 8];
        }
        __syncthreads();
#pragma unroll 1
        for (int k = 0; k < 8; ++k) { const int rr = wave + 8 * k, t = t0 + rr; const LAS unsigned* row = C + rr * 512;
            const v4u x0 = *(const LAS v4u*)(row + 4 * lane), x1 = *(const LAS v4u*)(row + 256 + 4 * lane);
            float v[16] = {bflo(x0.x), bfhi(x0.x), bflo(x0.y), bfhi(x0.y), bflo(x0.z), bfhi(x0.z), bflo(x0.w), bfhi(x0.w), bflo(x1.x), bfhi(x1.x), bflo(x1.y), bfhi(x1.y), bflo(x1.z), bfhi(x1.z), bflo(x1.w), bfhi(x1.w)};
            float s = 0.f;
#pragma unroll
            for (int i = 0; i < 16; ++i) s += v[i];
            const float mean = wave_sum(s) * (1.0f / 1024.0f); float qq = 0.f;
#pragma unroll
            for (int i = 0; i < 16; ++i) { v[i] -= mean; qq += v[i] * v[i]; }
            const float rstd = 1.0f / sqrtf(wave_sum(qq) * (1.0f / 1024.0f) + EPS);
            float y[16];
#pragma unroll
            for (int i = 0; i < 16; ++i) { const int ch = (i < 8 ? 8 * lane + i : 512 + 8 * lane + (i - 8)); const float z = v[i] * rstd * P.lng[ch] + P.lnb[ch]; y[i] = z / (1.f + __expf(-z)); }
            bf16* op = MIX + (rowb + t) * 2048 + 1024 + 8 * lane;
            v4u o0, o1; o0.x = pk2(y[0], y[1]); o0.y = pk2(y[2], y[3]); o0.z = pk2(y[4], y[5]); o0.w = pk2(y[6], y[7]); o1.x = pk2(y[8], y[9]); o1.y = pk2(y[10], y[11]); o1.z = pk2(y[12], y[13]); o1.w = pk2(y[14], y[15]);
            *(GAS v4u*)op = o0; *(GAS v4u*)(op + 512) = o1; }
        __syncthreads();
    } }
}

__device__ __forceinline__ void router_phase(const Ptrs& P, const bf16* HB, int lane, int gw, int NGW) {
    float* RS2 = (float*)(P.ws + WS_RSTD2); float* WTS = (float*)(P.ws + WS_WTS); int* LIST = (int*)(P.ws + WS_LIST); unsigned* CNT = (unsigned*)(P.ws + WS_CTL) + CW_CNT;
    for (int tok = gw; tok < T; tok += NGW) {
        float hv[32]; const bf16* hp = HB + (size_t)tok * D; float ss = 0.f;
#pragma unroll
        for (int j = 0; j < 4; ++j) { const u32x4g w = *(const u32x4g*)(hp + 8 * lane + 512 * j);
            hv[8 * j + 0] = bflo(w.x); hv[8 * j + 1] = bfhi(w.x); hv[8 * j + 2] = bflo(w.y); hv[8 * j + 3] = bfhi(w.y); hv[8 * j + 4] = bflo(w.z); hv[8 * j + 5] = bfhi(w.z); hv[8 * j + 6] = bflo(w.w); hv[8 * j + 7] = bfhi(w.w); }
#pragma unroll
        for (int k = 0; k < 32; ++k) ss += hv[k] * hv[k];
        ss = wave_sum(ss); const float rstd = 1.0f / sqrtf(ss * (1.0f / D) + EPS);
        float lg[36];
#pragma unroll
        for (int o = 0; o < 36; ++o) lg[o] = 0.f;
#pragma unroll
        for (int j = 0; j < 4; ++j)
#pragma unroll 2
            for (int i = 0; i < 8; ++i) { const int e = 8 * lane + 512 * j + i; const float xv = hv[8 * j + i] * P.g2[e];
                const f32x4* wr = (const f32x4*)(P.wer + (size_t)e * 32); const f32x4 wg = *(const f32x4*)(P.wgr + (size_t)e * 4);
#pragma unroll
                for (int o4 = 0; o4 < 8; ++o4) { const f32x4 w = wr[o4]; lg[4 * o4 + 0] += xv * w.x; lg[4 * o4 + 1] += xv * w.y; lg[4 * o4 + 2] += xv * w.z; lg[4 * o4 + 3] += xv * w.w; }
                lg[32] += xv * wg.x; lg[33] += xv * wg.y; lg[34] += xv * wg.z; lg[35] += xv * wg.w; }
#pragma unroll
        for (int o = 0; o < 36; ++o) lg[o] = wave_sum(lg[o]) * rstd + (o < 32 ? P.ber[o] : P.bgr[o - 32]);
        int gs = 0; float gm = lg[32];
#pragma unroll
        for (int g = 1; g < 4; ++g) if (lg[32 + g] > gm) { gm = lg[32 + g]; gs = g; }
        float gsum = 0.f;
#pragma unroll
        for (int g = 0; g < 4; ++g) gsum += __expf(lg[32 + g] - gm);
        const float gw_ = 1.0f / gsum;
        float ev[8];
#pragma unroll
        for (int i = 0; i < 8; ++i) ev[i] = gs == 0 ? lg[i] : gs == 1 ? lg[8 + i] : gs == 2 ? lg[16 + i] : lg[24 + i];
        int i1 = 0; float v1 = ev[0];
#pragma unroll
        for (int i = 1; i < 8; ++i) if (ev[i] > v1) { v1 = ev[i]; i1 = i; }
        int i2 = -1; float v2 = -3.0e38f;
#pragma unroll
        for (int i = 0; i < 8; ++i) if (i != i1 && ev[i] > v2) { v2 = ev[i]; i2 = i; }
        const float e2 = __expf(v2 - v1), w1 = gw_ / (1.f + e2), w2 = gw_ * e2 / (1.f + e2);
        if (lane == 0) {
            RS2[tok] = rstd;
            const int ea = gs * 8 + i1, eb = gs * 8 + i2;
            const unsigned ra = __hip_atomic_fetch_add(CNT + 64 * ea, 1u, __ATOMIC_RELAXED, __HIP_MEMORY_SCOPE_AGENT);
            const unsigned rb = __hip_atomic_fetch_add(CNT + 64 * eb, 1u, __ATOMIC_RELAXED, __HIP_MEMORY_SCOPE_AGENT);
            LIST[(size_t)ea * T + ra] = 2 * tok; LIST[(size_t)eb * T + rb] = 2 * tok + 1; WTS[2 * tok] = w1; WTS[2 * tok + 1] = w2;
        }
    }
}
__device__ __forceinline__ void moe_tables(const Ptrs& P, LAS unsigned char* lds) {
    int tid = threadIdx.x; asm volatile("" : "+v"(tid));
    LAS int* cntL = (LAS int*)(lds + TAB_OFF); LAS int* ts = cntL + 32; unsigned* CNT = (unsigned*)(P.ws + WS_CTL) + CW_CNT;
    if (tid < 32) cntL[tid] = (int)__hip_atomic_load(CNT + 64 * tid, __ATOMIC_RELAXED, __HIP_MEMORY_SCOPE_AGENT);
    __syncthreads();
    if (tid == 0) { int s = 0; for (int e = 0; e < 32; ++e) { ts[e] = s; s += (cntL[e] + 255) >> 8; } ts[32] = s; }
    __syncthreads();
}

__device__ __forceinline__ float fp8f(unsigned w, int i) { return i == 0 ? __builtin_amdgcn_cvt_f32_fp8(w, 0) : i == 1 ? __builtin_amdgcn_cvt_f32_fp8(w, 1) : i == 2 ? __builtin_amdgcn_cvt_f32_fp8(w, 2) : __builtin_amdgcn_cvt_f32_fp8(w, 3); }
__device__ __forceinline__ void final_phase(const Ptrs& P, const bf16* HB, const unsigned char* Y8, int NGW) {
    int tid_ = threadIdx.x; asm volatile("" : "+v"(tid_)); const int lane = tid_ & 63, gw = (int)blockIdx.x * NWAVES + __builtin_amdgcn_readfirstlane(tid_ >> 6);
    for (int tok = gw; tok < T; tok += NGW) {
        const bf16* hp = HB + (size_t)tok * D; const unsigned char* y1 = Y8 + (size_t)tok * 4096; const unsigned char* y2 = y1 + 2048; float v[32]; float ss = 0.f;
#pragma unroll
        for (int j = 0; j < 4; ++j) { const int o = 8 * lane + 512 * j; const u32x4g a = *(const u32x4g*)(hp + o); const pg8::u32x2 b = *(const pg8::u32x2*)(y1 + o), c = *(const pg8::u32x2*)(y2 + o);
            const float ys = 1.0f / YSCALE;
            v[8 * j + 0] = bflo(a.x) + (fp8f(b.x, 0) + fp8f(c.x, 0)) * ys; v[8 * j + 1] = bfhi(a.x) + (fp8f(b.x, 1) + fp8f(c.x, 1)) * ys; v[8 * j + 2] = bflo(a.y) + (fp8f(b.x, 2) + fp8f(c.x, 2)) * ys; v[8 * j + 3] = bfhi(a.y) + (fp8f(b.x, 3) + fp8f(c.x, 3)) * ys;
            v[8 * j + 4] = bflo(a.z) + (fp8f(b.y, 0) + fp8f(c.y, 0)) * ys; v[8 * j + 5] = bfhi(a.z) + (fp8f(b.y, 1) + fp8f(c.y, 1)) * ys; v[8 * j + 6] = bflo(a.w) + (fp8f(b.y, 2) + fp8f(c.y, 2)) * ys; v[8 * j + 7] = bfhi(a.w) + (fp8f(b.y, 3) + fp8f(c.y, 3)) * ys; }
#pragma unroll
        for (int k = 0; k < 32; ++k) ss += v[k] * v[k];
        ss = wave_sum(ss); const float rstd = 1.0f / sqrtf(ss * (1.0f / D) + EPS);
        float* op = P.out + (size_t)tok * D;
#pragma unroll
        for (int j = 0; j < 4; ++j) { const int o = 8 * lane + 512 * j; const f32x4 g0 = *(const f32x4*)(P.gf + o), g1 = *(const f32x4*)(P.gf + o + 4);
            f32x4 r0 = {v[8 * j + 0] * rstd * g0.x, v[8 * j + 1] * rstd * g0.y, v[8 * j + 2] * rstd * g0.z, v[8 * j + 3] * rstd * g0.w};
            f32x4 r1 = {v[8 * j + 4] * rstd * g1.x, v[8 * j + 5] * rstd * g1.y, v[8 * j + 6] * rstd * g1.z, v[8 * j + 7] * rstd * g1.w};
            *(f32x4*)(op + o) = r0; *(f32x4*)(op + o + 4) = r1; }
    }
}

struct Args { const float* in[22]; float* out; unsigned char* ws; int ph_lo, ph_hi; };
__global__ void __launch_bounds__(NWAVES * 64, 2) fwd(Args args) {
    extern __shared__ __attribute__((aligned(16))) unsigned char lds_raw[];
    LAS unsigned char* lds = (LAS unsigned char*)lds_raw;
    volatile LAS unsigned* MISC = (volatile LAS unsigned*)(lds + MISC_OFF);
    const int tid = threadIdx.x, lane = tid & 63, wave = __builtin_amdgcn_readfirstlane(tid >> 6), G = gridDim.x;
    const int gw = blockIdx.x * NWAVES + wave, NGW = G * NWAVES;
    Ptrs P;
    P.x = args.in[0]; P.g1 = args.in[1]; P.w_in = args.in[2]; P.lq1 = args.in[3]; P.lk1 = args.in[4]; P.lq2 = args.in[5]; P.lk2 = args.in[6]; P.subg = args.in[7];
    P.cw = args.in[8]; P.cb = args.in[9]; P.lng = args.in[10]; P.lnb = args.in[11]; P.w_out = args.in[12]; P.g2 = args.in[13]; P.wgr = args.in[14]; P.bgr = args.in[15];
    P.wer = args.in[16]; P.ber = args.in[17]; P.w_gate = args.in[18]; P.w_up = args.in[19]; P.w_down = args.in[20]; P.gf = args.in[21]; P.out = args.out; P.ws = args.ws;
    unsigned char* ws = args.ws;
#define WIN ((bf16*)(ws + WS_WIN))
#define WOUT ((bf16*)(ws + WS_WOUT))
#define WGU (ws + WS_WGU)
#define WD (ws + WS_WD)
#define XB ((bf16*)(ws + WS_XB))
#define H1 (ws + WS_XB)
#define HB8 (ws + WS_HB8)
#define CGB ((bf16*)(ws + WS_CG))
#define MIX ((bf16*)(ws + WS_MIX))
#define HB ((bf16*)(ws + WS_HB))
#define QB ((bf16*)P.out)
#define KB (QB + (size_t)T * 1024)
#define VB (QB + (size_t)T * 2048)
#define CAB (QB + (size_t)T * 3072)
#define YB ((bf16*)P.out)
#define RELOAD_ARGS() do { const __attribute__((address_space(4))) Args* ka_ = (const __attribute__((address_space(4))) Args*)__builtin_amdgcn_kernarg_segment_ptr(); asm volatile("" : "+s"(ka_)); \
    P.x = ka_->in[0]; P.g1 = ka_->in[1]; P.w_in = ka_->in[2]; P.lq1 = ka_->in[3]; P.lk1 = ka_->in[4]; P.lq2 = ka_->in[5]; P.lk2 = ka_->in[6]; P.subg = ka_->in[7]; \
    P.cw = ka_->in[8]; P.cb = ka_->in[9]; P.lng = ka_->in[10]; P.lnb = ka_->in[11]; P.w_out = ka_->in[12]; P.g2 = ka_->in[13]; P.wgr = ka_->in[14]; P.bgr = ka_->in[15]; \
    P.wer = ka_->in[16]; P.ber = ka_->in[17]; P.w_gate = ka_->in[18]; P.w_up = ka_->in[19]; P.w_down = ka_->in[20]; P.gf = ka_->in[21]; P.out = ka_->out; P.ws = ka_->ws; ws = ka_->ws; } while (0)
    for (int u = tid; u < (LDS_BYTES - LDSCTL_OFF) / 4; u += NWAVES * 64) ((LAS unsigned*)(lds + LDSCTL_OFF))[u] = 0u;
    __syncthreads();
    const int lo = args.ph_lo, hi = args.ph_hi;
    XcdBarrier bar; bar.bar = (unsigned*)(ws + WS_CTL) + CW_BAR; bar.x = 0; bar.st = nullptr;
    if (hi - lo > 1) bar = xcd_barrier_post((unsigned*)(ws + WS_CTL) + CW_BAR, MISC + 8);
#define IN(k) (lo <= (k) && (k) < hi)
#if PROBE_PHASE >= 0
    unsigned long long pst_[NPHASE + 1]; pst_[0] = __builtin_amdgcn_s_memrealtime();
#define SEAM(k) do { if (IN(k) && IN((k) + 1)) xcd_barrier(bar); pst_[(k) + 1] = __builtin_amdgcn_s_memrealtime(); } while (0)
#else
#define SEAM(k) do { if (IN(k) && IN((k) + 1)) xcd_barrier(bar); } while (0)
#endif
#define REP(k) for (int rep_ = 0; rep_ <= ((PROBE_DOUBLE >> (k)) & 1); ++rep_)

    if (IN(0)) REP(0) { p0_prologue(P, lds, lane, wave, gw, NGW); }
    SEAM(0);
#if PROBE_CLOCK
    const long long pc0 = clock64(), pr0 = wall_clock64();
#endif
    if (IN(1)) {
        cvt_fill(P, lds, MISC + 12, (int)((blockIdx.x >> 3) % 8), nullptr, G);
        for (int pass = 0; pass < 2; ++pass) {
            if ((pass ^ (int)(blockIdx.x & 1)) == 0) { pg8::Gemm g{XB, WIN, 1, 3072, D, (unsigned*)(ws + WS_CTL) + 3002}; pg8::DynDense S; S.init(T, 3072, (unsigned*)(ws + WS_CTL) + CW_GQ + 0 * 512, (volatile LAS int*)(MISC + 16), (int)blockIdx.x);
                pg8::EpiIn E{QB, (size_t)T * 1024, CGB, (const float*)(ws + WS_RSTD1), C2, (unsigned*)(ws + WS_CTL) + CW_NMAX, 0, 1.0f};
                pg8::gemm_phase<pg8::EpiIn, pg8::DynDense, true, false>(lds + RING_OFF, g, S, E); }
            else { pg8::Gemm g{(const bf16*)(ws + WS_X8), (const bf16*)(ws + WS_WIN8), 2, 2048, D / 2, (unsigned*)(ws + WS_CTL) + 3002}; pg8::DynDenseG S; S.init(T, 2048, (unsigned*)(ws + WS_CTL) + CW_GQ + 1 * 512, (volatile LAS int*)(MISC + 16), (int)blockIdx.x);
                pg8::EpiGLU E{CAB, (const float*)(ws + WS_RSTD1), 1.0f / WSCALE};
                pg8::gemm_phase<pg8::EpiGLU, pg8::DynDenseG, true, true, true>(lds + RING_OFF, g, S, E); }
        }
#if PROBE_ATT == 6
        if (threadIdx.x == 0) atomicMax((unsigned*)(ws + WS_CTL) + CW_NMAX + 900, (unsigned)(__builtin_amdgcn_s_memrealtime() - pst_[1]));
#endif
#if PROBE_ATT == 7
        if (threadIdx.x == 0) atomicAdd((unsigned*)(ws + WS_CTL) + CW_NMAX + 900, (unsigned)(__builtin_amdgcn_s_memrealtime() - pst_[1]) >> 8);
#endif
#if PROBE_ATT == 5
        if (blockIdx.x == PROBE_BLK && threadIdx.x == 0) atomicAdd((unsigned*)(ws + WS_CTL) + CW_NMAX + 900, (unsigned)(__builtin_amdgcn_s_memrealtime() - pst_[1]));
#endif
        phase_tail(P, lds, MISC + 12, 1, G);
    }
#if PROBE_CLOCK
    if (IN(1) && tid == 0) { const unsigned dt = (unsigned)(wall_clock64() - pr0); atomicAdd((unsigned*)(ws + WS_CTL) + 3000, dt); atomicMax((unsigned*)(ws + WS_CTL) + 3001, dt); }
#endif
    SEAM(1);
    if (IN(2)) {
#if USE_NAIVE_ATTN
        naive_attn(P, QB, KB, VB, MIX, lane, gw, NGW);
#else
        { float s1 = 0.f, s2 = 0.f;
          for (int i = 0; i < 64; ++i) { s1 += P.lq1[i] * P.lk1[i]; s2 += P.lq2[i] * P.lk2[i]; }
          const float lam0 = 0.2f, lam = expf(s1) - expf(s2) + lam0;
          static_assert(attn_body::ATTN_LDS_BYTES <= RING_BYTES, "attention LDS");
          attn_body::attn_phase<8>((char*)lds_raw + RING_OFF, (int)blockIdx.x, (unsigned*)(ws + WS_CTL) + CW_QA, MISC + 12, lam, 1.0f - lam0, P.subg, (const unsigned*)(ws + WS_CTL) + CW_NMAX, (unsigned*)(ws + WS_O1S) + (size_t)blockIdx.x * 16384,
                                   (const attn_body::bf16*)QB, (const attn_body::bf16*)KB, (const attn_body::bf16*)VB, (attn_body::bf16*)MIX); }
        RELOAD_ARGS();
#endif
        conv_phase(P, CAB, MIX, lds, (int)blockIdx.x, (unsigned*)(ws + WS_CTL) + CW_QC, MISC + 12);
#if PROBE_ATT == 2
        if (blockIdx.x == PROBE_BLK && threadIdx.x == 0) atomicAdd((unsigned*)(ws + WS_CTL) + CW_NMAX + 900, (unsigned)(__builtin_amdgcn_s_memrealtime() - pst_[2]));
#endif
        phase_tail(P, lds, MISC + 12, 2, G);
    }
    SEAM(2);
    if (IN(3)) {
        pg8::Gemm g{MIX, WOUT, 3, D, D, (unsigned*)(ws + WS_CTL) + 3002}; pg8::StaticOrder S; S.init(T, D, G, (int)blockIdx.x); S.rep = 1 + ((PROBE_DOUBLE >> 3) & 1);
        pg8::EpiOut E{HB, XB, (float*)(ws + WS_PART), nullptr};
        pg8::gemm_phase<pg8::EpiOut, pg8::StaticOrder, true, false>(lds + RING_OFF, g, S, E);
        phase_tail(P, lds, MISC + 12, 3, G);
    }
    SEAM(3);
#if PROBE_ATT == 9
    if (IN(4) && blockIdx.x == PROBE_BLK && threadIdx.x == 0) atomicAdd((unsigned*)(ws + WS_CTL) + CW_NMAX + 900, 10u * __hip_atomic_load((unsigned*)(ws + WS_CTL) + CW_CVQ, __ATOMIC_RELAXED, __HIP_MEMORY_SCOPE_AGENT));
#endif
#if USE_NAIVE_ROUTER
    if (IN(4)) { router_phase(P, HB, lane, gw, NGW); }
#else
    if (IN(4)) {
        router_skinny(P, HB, HB8, lds, G);
#if PROBE_ATT == 11
        if (threadIdx.x == 0) atomicMax((unsigned*)(ws + WS_CTL) + CW_NMAX + 900, (unsigned)(__builtin_amdgcn_s_memrealtime() - pst_[4]));
#endif
#if PROBE_ATT == 10
        if (blockIdx.x == PROBE_BLK && threadIdx.x == 0) atomicAdd((unsigned*)(ws + WS_CTL) + CW_NMAX + 900, (unsigned)(__builtin_amdgcn_s_memrealtime() - pst_[4]));
#endif
#if PROBE_ATT == 8
        if (blockIdx.x == PROBE_BLK && threadIdx.x == 0) atomicAdd((unsigned*)(ws + WS_CTL) + CW_NMAX + 900, 10u * __hip_atomic_load((unsigned*)(ws + WS_CTL) + CW_CVQ, __ATOMIC_RELAXED, __HIP_MEMORY_SCOPE_AGENT));
#endif
        cvt_fill(P, lds, MISC + 12, 1 << 30, nullptr, G);
    }
#endif
    SEAM(4);
    if (IN(5)) {
        moe_tables(P, lds);
        pg8::Gemm g{(const bf16*)HB8, (const bf16*)WGU, 5, 2048, D / 2, (unsigned*)(ws + WS_CTL) + 3002};
        pg8::MoeOrder S{(const LAS int*)(lds + TAB_OFF) + 32, (const LAS int*)(lds + TAB_OFF), (const int*)(ws + WS_LIST), G, (int)blockIdx.x, 1, T, (size_t)2048 * 2048, 0};
        pg8::EpiGU E{H1, (const int*)(ws + WS_LIST), (const float*)(ws + WS_LISTR), 1.0f / WSCALE, H1SCALE};
        pg8::gemm_phase<pg8::EpiGU, pg8::MoeOrder, true, true, true>(lds + RING_OFF, g, S, E);
    }
    SEAM(5);
    if (IN(6)) {
        moe_tables(P, lds);
        pg8::Gemm g{(const bf16*)H1, (const bf16*)WD, 6, 2048, 512, (unsigned*)(ws + WS_CTL) + 3002};
        pg8::MoeOrder S{(const LAS int*)(lds + TAB_OFF) + 32, (const LAS int*)(lds + TAB_OFF), (const int*)(ws + WS_LIST), G, (int)blockIdx.x, 0, T, (size_t)2048 * 1024, 1};
        pg8::EpiDown E{ws + WS_MIX, (const int*)(ws + WS_LIST), (const float*)(ws + WS_LISTW), YSCALE / (WSCALE * H1SCALE)};
        pg8::gemm_phase<pg8::EpiDown, pg8::MoeOrder, true, true, true>(lds + RING_OFF, g, S, E);
    }
    SEAM(6);
    if (IN(7)) { final_phase(P, HB, ws + WS_MIX, NGW); }
#if PROBE_ATT
    if (blockIdx.x == 0) { const unsigned long long span = __hip_atomic_load((unsigned*)(ws + WS_CTL) + CW_NMAX + 900, __ATOMIC_RELAXED, __HIP_MEMORY_SCOPE_AGENT); const unsigned long long r1 = __builtin_amdgcn_s_memrealtime(); while (__builtin_amdgcn_s_memrealtime() - r1 < span) __builtin_amdgcn_s_sleep(8); }
#endif
#if PROBE_PHASE >= 0
    pst_[NPHASE] = __builtin_amdgcn_s_memrealtime();
    if (blockIdx.x == 0 && PROBE_PHASE < 100) { const unsigned long long span = pst_[(PROBE_PHASE < 100 ? PROBE_PHASE : 0) + 1] - pst_[PROBE_PHASE < 100 ? PROBE_PHASE : 0]; const unsigned long long r1 = __builtin_amdgcn_s_memrealtime(); while (__builtin_amdgcn_s_memrealtime() - r1 < span) __builtin_amdgcn_s_sleep(8); }
#endif
#if PROBE_KLOOP
    if (blockIdx.x == 0) { const long long pticks = (long long)__hip_atomic_load((unsigned*)(ws + WS_CTL) + 3002, __ATOMIC_RELAXED, __HIP_MEMORY_SCOPE_AGENT); const long long r1 = wall_clock64(); while (wall_clock64() - r1 < pticks) __builtin_amdgcn_s_sleep(8); }
#endif
#if PROBE_CLOCK
    if (blockIdx.x == 0) { const unsigned sum = __hip_atomic_load((unsigned*)(ws + WS_CTL) + 3000, __ATOMIC_RELAXED, __HIP_MEMORY_SCOPE_AGENT), mx = __hip_atomic_load((unsigned*)(ws + WS_CTL) + 3001, __ATOMIC_RELAXED, __HIP_MEMORY_SCOPE_AGENT);
        const long long pticks = (long long)mx - (long long)(sum / (unsigned)G); const long long r1 = wall_clock64(); while (wall_clock64() - r1 < pticks) __builtin_amdgcn_s_sleep(8); }
#endif
#undef IN
#undef SEAM
#undef REP
}

extern "C" void kernel_launch(void* const* d_in, const int* in_sizes, int n_in, void* d_out, int out_size, void* d_ws, size_t ws_size, hipStream_t stream) {
    static int grid = 0;
    if (grid == 0) {
        if (n_in != 22 || in_sizes[0] != T * D || out_size != T * D || ws_size < WS_END) { fprintf(stderr, "kernel_launch: unexpected shapes (n_in %d, in0 %d, out %d, ws %zu); nothing launched\n", n_in, n_in > 0 ? in_sizes[0] : -1, out_size, ws_size); grid = -1; return; }
        int dev = 0, cus = 0, per_cu = 0;
        if (hipGetDevice(&dev) != hipSuccess || hipDeviceGetAttribute(&cus, hipDeviceAttributeMultiprocessorCount, dev) != hipSuccess) { grid = -1; return; }
        if (hipFuncSetAttribute((const void*)fwd, hipFuncAttributeMaxDynamicSharedMemorySize, LDS_BYTES) != hipSuccess) { fprintf(stderr, "kernel_launch: hipFuncSetAttribute failed\n"); grid = -1; return; }
        if (hipOccupancyMaxActiveBlocksPerMultiprocessor(&per_cu, (const void*)fwd, NWAVES * 64, LDS_BYTES) != hipSuccess || per_cu < 1) fprintf(stderr, "kernel_launch: occupancy query reports %d\n", per_cu);
        (void)hipGetLastError();
        grid = cus;
    }
    if (grid < 0) return;
    if (hipMemsetAsync((char*)d_ws + WS_CTL, 0, CTL_ZERO_BYTES, stream) != hipSuccess) return;
    Args a{};
    for (int i = 0; i < 22; ++i) a.in[i] = (const float*)d_in[i];
    a.out = (float*)d_out; a.ws = (unsigned char*)d_ws;
#if MK_ONE_LAUNCH
    a.ph_lo = 0; a.ph_hi = NPHASE;
    hipLaunchKernelGGL(fwd, dim3(grid), dim3(NWAVES * 64), LDS_BYTES, stream, a);
#else
    for (int p = 0; p < NPHASE; ++p) { a.ph_lo = p; a.ph_hi = p + 1; hipLaunchKernelGGL(fwd, dim3(grid), dim3(NWAVES * 64), LDS_BYTES, stream, a); }
#endif
}
```

```cpp
#include <hip/hip_runtime.h>
#include <cstdio>
#include <cstdint>
#ifndef PROBE_KLOOP
#define PROBE_KLOOP 0
#endif
#ifndef PROBE_WHAT
#define PROBE_WHAT 0
#endif
#ifndef PROBE_PHASE
#define PROBE_PHASE -1
#endif
#ifndef PROBE_ATT
#define PROBE_ATT 0
#endif
#ifndef PROBE_BLK
#define PROBE_BLK 0
#endif
namespace pg8 {
#define PG8_LAS __attribute__((address_space(3)))
typedef unsigned short bf16_t;
typedef short bf16x8 __attribute__((ext_vector_type(8)));
typedef float f32x4 __attribute__((ext_vector_type(4)));
typedef unsigned u32x4 __attribute__((ext_vector_type(4)));
constexpr int BM = 256, BK = 64, HALF = 128, HTB = HALF * BK * 2  , STAGE_BYTES = 8 * HTB, NXCD = 8, WGM = 8;

__host__ __device__ __forceinline__ int lds_byte(int r, int c) { const int st = (r >> 4) * 2 + (c >> 5), rr = r & 15, cc = c & 31, ob = rr * 64 + cc * 2; return st * 1024 + (ob ^ (((ob >> 9) & 1) << 5)); }
__host__ __device__ __forceinline__ void stage_rc(int b, int& R, int& C) { const int st = b / 1024, sb = b % 1024, swz = sb ^ (((sb >> 9) & 1) << 5); R = (st >> 1) * 16 + swz / 64; C = (st & 1) * 32 + (swz % 64) / 2; }
__host__ __device__ __forceinline__ int perm32(int rho) { const int n = rho >> 4, i = rho & 15; return 8 * (i >> 2) + 4 * n + (i & 3); }

struct Unit { int pm, pn, e, nvalid, lbase, srow; };
struct Gemm { const bf16_t* A; const bf16_t* Bt; int M, N, K; unsigned* probe = nullptr; };

struct StaticOrder {
    int nM, nN, nwg, G, c, rep = 1;
    __host__ __device__ void init(int M, int N, int G_, int c_) { nM = M / BM; nN = N / BM; nwg = nM * nN; G = G_; c = c_; }
    __host__ __device__ bool next(int i, Unit& u) const {
        long L = (long)i * G + c; if (L >= (long)nwg * rep) return false; L %= nwg;
        int wgid = (int)L; { const int q = nwg / NXCD, r = nwg % NXCD, xcd = wgid % NXCD, off = wgid / NXCD; wgid = (xcd < r ? xcd * (q + 1) : r * (q + 1) + (xcd - r) * q) + off; }
        const int nig = WGM * nN, gid = wgid / nig, fm = gid * WGM, gsz = (nM - fm) < WGM ? (nM - fm) : WGM;
        u.pm = fm + ((wgid % nig) % gsz); u.pn = (wgid % nig) / gsz; return true;
    }
    __device__ __forceinline__ const char* bbase(const Gemm& g, const Unit& u, size_t tstep) const { return (const char*)g.Bt + (size_t)u.pn * tstep; }
    __device__ __forceinline__ unsigned goff(const Unit&, int, int, int) const { return 0u; }
    __device__ __forceinline__ void a_ready(const Unit&) const {}
    __device__ __forceinline__ void done(const Unit&) const {}
};

struct StaticOrderG : StaticOrder {
    __device__ __forceinline__ unsigned goff(const Unit& u, int r, int C, int K) const { return ((unsigned)(u.pm * BM + r) * (unsigned)K + (unsigned)C) * 2u; }
};

struct MoeOrder {
    const PG8_LAS int* tstart; const PG8_LAS int* cnt; const int* list; int G, c, shift, lcap; size_t estride; int sorted;
    __device__ __forceinline__ bool next(int i, Unit& u) const {
        const int ntiles = tstart[32]; const int x = c & 7, k = i * (G >> 3) + (c >> 3); const int rt = 2 * (k >> 1) + (x & 1); if (rt >= ntiles) return false;
        int e = 0;
#pragma unroll
        for (int q = 1; q < 32; ++q) e += (tstart[q] <= rt) ? 1 : 0;
        e = __builtin_amdgcn_readfirstlane(e);
        const int pm = __builtin_amdgcn_readfirstlane(rt - tstart[e]); const int rem = __builtin_amdgcn_readfirstlane(cnt[e]) - 256 * pm;
        u.pm = pm; u.pn = 2 * (x >> 1) + (k & 1); u.e = e; u.nvalid = rem < 256 ? rem : 256; u.lbase = e * lcap + 256 * pm; u.srow = 256 * rt; return true;
    }
    __device__ __forceinline__ const char* bbase(const Gemm& g, const Unit& u, size_t tstep) const { return (const char*)g.Bt + (size_t)u.e * estride + (size_t)u.pn * tstep; }
    __device__ __forceinline__ unsigned goff(const Unit& u, int r, int C, int K) const {
        if (sorted) return ((unsigned)(u.srow + r) * (unsigned)K + (unsigned)C) * 2u;
        const int a = list[u.lbase + (r < u.nvalid ? r : 0)];
        return ((unsigned)(a >> shift) * (unsigned)K + (unsigned)C) * 2u;
    }
    __device__ __forceinline__ void a_ready(const Unit&) const {}
    __device__ __forceinline__ void done(const Unit&) const {}
};

struct DynQ {
    unsigned* ctr; volatile PG8_LAS int* slot; int x0, qi; unsigned pend;
    __device__ __forceinline__ void qinit(unsigned* ctr_, volatile PG8_LAS int* slot_, int bx) { ctr = ctr_; slot = slot_; x0 = bx & 7; qi = 0; pend = 0u;
        if (threadIdx.x == 0) pend = __hip_atomic_fetch_add(ctr + 64 * x0, 1u, __ATOMIC_RELAXED, __HIP_MEMORY_SCOPE_AGENT); }
    template <class SizeF> __device__ __forceinline__ int qnext(int i, const SizeF& size_of) {
        const int par = i & 1;
        if (threadIdx.x == 0) { int res = -1;
            while (qi < 8) { const int x = (x0 + qi) & 7; if (pend < (unsigned)size_of(x)) { res = (x << 24) | (int)pend; break; }
                ++qi; if (qi < 8) pend = __hip_atomic_fetch_add(ctr + 64 * ((x0 + qi) & 7), 1u, __ATOMIC_RELAXED, __HIP_MEMORY_SCOPE_AGENT); }
            slot[par] = res;
            if (res >= 0) pend = __hip_atomic_fetch_add(ctr + 64 * ((x0 + qi) & 7), 1u, __ATOMIC_RELAXED, __HIP_MEMORY_SCOPE_AGENT); }
        asm volatile("s_waitcnt lgkmcnt(0)" ::: "memory"); __builtin_amdgcn_s_barrier(); asm volatile("" ::: "memory");
        return __builtin_amdgcn_readfirstlane(slot[par]);
    }
};
struct DynDense : DynQ {
    int nM, nN, nwg;
    __device__ __forceinline__ void init(int M, int N, unsigned* ctr_, volatile PG8_LAS int* slot_, int bx) { nM = M / BM; nN = N / BM; nwg = nM * nN; qinit(ctr_, slot_, bx); }
    __device__ __forceinline__ bool next(int i, Unit& u) {
        const int q = nwg / NXCD, r = nwg % NXCD;
        const int code = qnext(i, [=](int x) { return q + (x < r ? 1 : 0); }); if (code < 0) return false;
        const int x = code >> 24, k = code & 0xffffff; const int wgid = (x < r ? x * (q + 1) : r * (q + 1) + (x - r) * q) + k;
        const int nig = WGM * nN, gid = wgid / nig, fm = gid * WGM, gsz = (nM - fm) < WGM ? (nM - fm) : WGM;
        u.pm = fm + ((wgid % nig) % gsz); u.pn = (wgid % nig) / gsz; return true;
    }
    __device__ __forceinline__ const char* bbase(const Gemm& g, const Unit& u, size_t tstep) const { return (const char*)g.Bt + (size_t)u.pn * tstep; }
    __device__ __forceinline__ unsigned goff(const Unit&, int, int, int) const { return 0u; }
    __device__ __forceinline__ void a_ready(const Unit&) const {}
    __device__ __forceinline__ void done(const Unit&) const {}
};
struct DynDenseG : DynDense {
    __device__ __forceinline__ unsigned goff(const Unit& u, int r, int C, int K) const { return ((unsigned)(u.pm * BM + r) * (unsigned)K + (unsigned)C) * 2u; }
};

__device__ __forceinline__ unsigned cvt_pk_bf16(float lo, float hi) { unsigned r; asm volatile("v_cvt_pk_bf16_f32 %0, %1, %2" : "=v"(r) : "v"(lo), "v"(hi)); return r; }
__device__ __forceinline__ float bf_lo(unsigned w) { return __builtin_bit_cast(float, w << 16); }
__device__ __forceinline__ float bf_hi(unsigned w) { return __builtin_bit_cast(float, w & 0xffff0000u); }
__device__ __forceinline__ unsigned pk4_fp8(float a, float b, float c, float d) {
    a = __builtin_amdgcn_fmed3f(a, -440.f, 440.f); b = __builtin_amdgcn_fmed3f(b, -440.f, 440.f); c = __builtin_amdgcn_fmed3f(c, -440.f, 440.f); d = __builtin_amdgcn_fmed3f(d, -440.f, 440.f);
    int r = __builtin_amdgcn_cvt_pk_fp8_f32(a, b, 0, false); r = __builtin_amdgcn_cvt_pk_fp8_f32(c, d, r, true); return (unsigned)r; }
typedef unsigned u32x2 __attribute__((ext_vector_type(2)));
__device__ __forceinline__ void swap16(u32x2& a, u32x2& b) { auto r0 = __builtin_amdgcn_permlane16_swap(a.x, b.x, false, false); auto r1 = __builtin_amdgcn_permlane16_swap(a.y, b.y, false, false); a = (u32x2){r0[0], r1[0]}; b = (u32x2){r0[1], r1[1]}; }
typedef int v4i_t __attribute__((ext_vector_type(4)));

struct EpiIn {
    static constexpr bool PERM = true, AFTER_DRAIN = false;
    bf16_t* P0; size_t stride; bf16_t* CG; const float* rstd; float scale0; unsigned* nmax; int tbase; float oscale;
    __device__ __forceinline__ void operator()(const f32x4 (&acc)[2][2][4][2], const Unit& u, int wr, int wc, int fr, int fq) const {
        const int row0 = u.pm * BM + wr * 64 + fr, t = (u.pn >> 2) + tbase; bf16_t* base = (t < 4) ? P0 + (size_t)t * stride : CG;
        const float sc = ((t == 0) ? scale0 : 1.f) * oscale; const int col0 = (u.pn & 3) * BM + wc * 32 + 8 * fq;
        float mx[2] = {0.f, 0.f}; float rsv[2][4];
#pragma unroll
        for (int ai = 0; ai < 2; ++ai)
#pragma unroll
            for (int m = 0; m < 4; ++m) rsv[ai][m] = rstd[row0 + ai * HALF + m * 16];
#pragma unroll
        for (int ai = 0; ai < 2; ++ai)
#pragma unroll
            for (int m = 0; m < 4; ++m) { const int row = row0 + ai * HALF + m * 16; const float rs = rsv[ai][m] * sc; bf16_t* rowp = base + (size_t)row * 1024 + col0;
#pragma unroll
                for (int bj = 0; bj < 2; ++bj) { const f32x4 v0 = acc[ai][bj][m][0] * rs, v1 = acc[ai][bj][m][1] * rs;
                    u32x4 w; w.x = cvt_pk_bf16(v0[0], v0[1]); w.y = cvt_pk_bf16(v0[2], v0[3]); w.z = cvt_pk_bf16(v1[0], v1[1]); w.w = cvt_pk_bf16(v1[2], v1[3]);
                    *(u32x4*)(rowp + bj * HALF) = w;
                    if (t < 2) { float ss = (v0[0] * v0[0] + v0[1] * v0[1]) + (v0[2] * v0[2] + v0[3] * v0[3]) + (v1[0] * v1[0] + v1[1] * v1[1]) + (v1[2] * v1[2] + v1[3] * v1[3]);
                        ss += __shfl_xor(ss, 16); ss += __shfl_xor(ss, 32); mx[bj] = __builtin_fmaxf(mx[bj], ss); } } }
        if (t < 2) {
#pragma unroll
            for (int bj = 0; bj < 2; ++bj) { float v = mx[bj];
                v = __builtin_fmaxf(v, __shfl_xor(v, 1)); v = __builtin_fmaxf(v, __shfl_xor(v, 2)); v = __builtin_fmaxf(v, __shfl_xor(v, 4)); v = __builtin_fmaxf(v, __shfl_xor(v, 8));
                const int colb = (u.pn & 3) * BM + bj * HALF + wc * 32, g64 = colb >> 6, bh = (u.pm >> 4) * 8 + (g64 >> 1);
                if (fr == 0 && fq == 0) atomicMax(nmax + ((t * 64 + bh) * 2 + (g64 & 1)) * 2 + (wc & 1), __builtin_bit_cast(unsigned, v)); }
        }
    }
};
struct EpiGLU {
    static constexpr bool PERM = true, AFTER_DRAIN = false;
    bf16_t* U; const float* rstd; float oscale;
    __device__ __forceinline__ void operator()(const f32x4 (&acc)[2][2][4][2], const Unit& u, int wr, int wc, int fr, int fq) const {
        const int row0 = u.pm * BM + wr * 64 + fr, col0 = u.pn * HALF + wc * 32 + 8 * fq; float rsv[2][4];
#pragma unroll
        for (int ai = 0; ai < 2; ++ai)
#pragma unroll
            for (int m = 0; m < 4; ++m) rsv[ai][m] = rstd[row0 + ai * HALF + m * 16];
#pragma unroll
        for (int ai = 0; ai < 2; ++ai)
#pragma unroll
            for (int m = 0; m < 4; ++m) { const int row = row0 + ai * HALF + m * 16; const float rs = rsv[ai][m] * oscale;
                const f32x4 a0 = acc[ai][0][m][0] * rs, a1 = acc[ai][0][m][1] * rs, g0 = acc[ai][1][m][0] * rs, g1 = acc[ai][1][m][1] * rs;
#define PG8_SG(x) __builtin_amdgcn_rcpf(1.f + __builtin_amdgcn_exp2f(-1.4426950408889634f * (x)))
                u32x4 w; w.x = cvt_pk_bf16(a0[0] * PG8_SG(g0[0]), a0[1] * PG8_SG(g0[1])); w.y = cvt_pk_bf16(a0[2] * PG8_SG(g0[2]), a0[3] * PG8_SG(g0[3]));
                w.z = cvt_pk_bf16(a1[0] * PG8_SG(g1[0]), a1[1] * PG8_SG(g1[1])); w.w = cvt_pk_bf16(a1[2] * PG8_SG(g1[2]), a1[3] * PG8_SG(g1[3]));
#undef PG8_SG
                *(u32x4*)(U + (size_t)row * 1024 + col0) = w; }
    }
};
struct EpiOut {
    static constexpr bool PERM = true, AFTER_DRAIN = false;
    bf16_t* H; const bf16_t* XB; float* part; unsigned char* H8;
    __device__ __forceinline__ void operator()(const f32x4 (&acc)[2][2][4][2], const Unit& u, int wr, int wc, int fr, int fq) const {
        const int row0 = u.pm * BM + wr * 64 + fr, col0 = u.pn * BM + wc * 32 + 8 * fq;
#pragma unroll
        for (int ai = 0; ai < 2; ++ai) { u32x4 xbv[4][2];
#pragma unroll
            for (int m = 0; m < 4; ++m)
#pragma unroll
                for (int bj = 0; bj < 2; ++bj) xbv[m][bj] = *(const u32x4*)(XB + (size_t)(row0 + ai * HALF + m * 16) * 2048 + col0 + bj * HALF);
#pragma unroll
            for (int m = 0; m < 4; ++m) { const int row = row0 + ai * HALF + m * 16; const size_t off = (size_t)row * 2048 + col0; float ss = 0.f;
#pragma unroll
                for (int bj = 0; bj < 2; ++bj) { const u32x4 xb = xbv[m][bj];
                    f32x4 v0 = acc[ai][bj][m][0], v1 = acc[ai][bj][m][1];
                    v0[0] += bf_lo(xb.x); v0[1] += bf_hi(xb.x); v0[2] += bf_lo(xb.y); v0[3] += bf_hi(xb.y); v1[0] += bf_lo(xb.z); v1[1] += bf_hi(xb.z); v1[2] += bf_lo(xb.w); v1[3] += bf_hi(xb.w);
                    ss += (v0[0] * v0[0] + v0[1] * v0[1]) + (v0[2] * v0[2] + v0[3] * v0[3]) + (v1[0] * v1[0] + v1[1] * v1[1]) + (v1[2] * v1[2] + v1[3] * v1[3]);
                    u32x4 w; w.x = cvt_pk_bf16(v0[0], v0[1]); w.y = cvt_pk_bf16(v0[2], v0[3]); w.z = cvt_pk_bf16(v1[0], v1[1]); w.w = cvt_pk_bf16(v1[2], v1[3]);
                    *(u32x4*)(H + off + bj * HALF) = w;
                    if (H8) { u32x2 w8; w8.x = pk4_fp8(v0[0], v0[1], v0[2], v0[3]); w8.y = pk4_fp8(v1[0], v1[1], v1[2], v1[3]); *(u32x2*)(H8 + off + bj * HALF) = w8; } }
                ss += __shfl_xor(ss, 16); ss += __shfl_xor(ss, 32);
                if (fq == 0) part[(size_t)row * 32 + u.pn * 4 + wc] = ss; } }
    }
};
__device__ __forceinline__ float silu_f(float x) { return x * __builtin_amdgcn_rcpf(1.f + __builtin_amdgcn_exp2f(-1.4426950408889634f * x)); }
struct EpiGU {
    static constexpr bool PERM = true, AFTER_DRAIN = false;
    unsigned char* H1; const int* list; const float* listr; float wscale, oscale;
    __device__ __forceinline__ void operator()(const f32x4 (&acc)[2][2][4][2], const Unit& u, int wr, int wc, int fr, int fq) const {
        const int col0 = u.pn * HALF + wc * 32 + 8 * fq;
        float rsv[2][4];
#pragma unroll
        for (int ai = 0; ai < 2; ++ai)
#pragma unroll
            for (int m = 0; m < 4; ++m) { const int r = ai * HALF + wr * 64 + m * 16 + fr; rsv[ai][m] = listr[u.lbase + (r < u.nvalid ? r : 0)]; }
#pragma unroll
        for (int ai = 0; ai < 2; ++ai)
#pragma unroll
            for (int mp = 0; mp < 4; mp += 2) { u32x2 wv[2];
#pragma unroll
                for (int q = 0; q < 2; ++q) { const int m = mp + q; const float rs = rsv[ai][m] * wscale;
                    const f32x4 g0 = acc[ai][0][m][0] * rs, g1 = acc[ai][0][m][1] * rs, u0 = acc[ai][1][m][0] * (rs * oscale), u1 = acc[ai][1][m][1] * (rs * oscale);
                    wv[q].x = pk4_fp8(silu_f(g0[0]) * u0[0], silu_f(g0[1]) * u0[1], silu_f(g0[2]) * u0[2], silu_f(g0[3]) * u0[3]);
                    wv[q].y = pk4_fp8(silu_f(g1[0]) * u1[0], silu_f(g1[1]) * u1[1], silu_f(g1[2]) * u1[2], silu_f(g1[3]) * u1[3]); }
                swap16(wv[0], wv[1]);
                const int odd = fq & 1, r = ai * HALF + wr * 64 + (mp + odd) * 16 + fr;
                if (r < u.nvalid) { const u32x4 w = {wv[0].x, wv[0].y, wv[1].x, wv[1].y};
                    *(u32x4*)(H1 + (size_t)(u.srow + r) * 1024 + col0 - 8 * odd) = w; } }
    }
};
struct EpiDown {
    static constexpr bool PERM = true, AFTER_DRAIN = false;
    unsigned char* Y; const int* list; const float* listw; float oscale;
    __device__ __forceinline__ void operator()(const f32x4 (&acc)[2][2][4][2], const Unit& u, int wr, int wc, int fr, int fq) const {
        const int col0 = u.pn * BM + wc * 32 + 8 * fq;
        int av[2][4]; float wv[2][4];
#pragma unroll
        for (int ai = 0; ai < 2; ++ai)
#pragma unroll
            for (int m = 0; m < 4; ++m) { const int r = ai * HALF + wr * 64 + m * 16 + fr, ix = u.lbase + (r < u.nvalid ? r : 0); av[ai][m] = list[ix]; wv[ai][m] = listw[ix]; }
#pragma unroll
        for (int ai = 0; ai < 2; ++ai)
#pragma unroll
            for (int m = 0; m < 4; ++m) { const int r = ai * HALF + wr * 64 + m * 16 + fr; const int a = av[ai][m]; const float ws = wv[ai][m] * oscale;
                u32x2 w0, w1;
                { const f32x4 v0 = acc[ai][0][m][0] * ws, v1 = acc[ai][0][m][1] * ws; w0.x = pk4_fp8(v0[0], v0[1], v0[2], v0[3]); w0.y = pk4_fp8(v1[0], v1[1], v1[2], v1[3]); }
                { const f32x4 v0 = acc[ai][1][m][0] * ws, v1 = acc[ai][1][m][1] * ws; w1.x = pk4_fp8(v0[0], v0[1], v0[2], v0[3]); w1.y = pk4_fp8(v1[0], v1[1], v1[2], v1[3]); }
                swap16(w0, w1);
                if (r < u.nvalid) { const int odd = fq & 1; const u32x4 w = {w0.x, w0.y, w1.x, w1.y};
                    *(u32x4*)(Y + (size_t)a * 2048 + col0 + (odd ? HALF - 8 : 0)) = w; } }
    }
};
struct EpiRouter {
    static constexpr bool PERM = true, AFTER_DRAIN = false;
    const float* part; const float* ber; const float* bgr; float* listr; float* listw; int* list; unsigned* cnt; int lcap;
    __device__ __forceinline__ void operator()(const f32x4 (&acc)[2][2][4][2], const Unit& u, int wr, int wc, int fr, int fq) const {
        if (wc != 0) return;
#pragma unroll
        for (int ai = 0; ai < 2; ++ai)
#pragma unroll
            for (int m = 0; m < 4; ++m) { const int row = u.pm * BM + ai * HALF + wr * 64 + m * 16 + fr;
                const f32x4 p0 = *(const f32x4*)(part + (size_t)row * 32 + 8 * fq), p1 = *(const f32x4*)(part + (size_t)row * 32 + 8 * fq + 4);
                float ss = ((p0[0] + p0[1]) + (p0[2] + p0[3])) + ((p1[0] + p1[1]) + (p1[2] + p1[3]));
                ss += __shfl_xor(ss, 16); ss += __shfl_xor(ss, 32);
                const float rstd = 1.0f / sqrtf(ss * (1.0f / 2048.0f) + 1e-6f);
                const f32x4 gl = acc[ai][1][m][0]; float g[4];
#pragma unroll
                for (int i = 0; i < 4; ++i) g[i] = __shfl(gl[i], fr) * rstd + bgr[i];
                int gs = 0; float gm = g[0];
#pragma unroll
                for (int i = 1; i < 4; ++i) if (g[i] > gm) { gm = g[i]; gs = i; }
                float gsum = 0.f;
#pragma unroll
                for (int i = 0; i < 4; ++i) gsum += __expf(g[i] - gm);
                const float gw = 1.0f / gsum;
                if (fq == gs) { float ev[8];
#pragma unroll
                    for (int i = 0; i < 4; ++i) { ev[i] = acc[ai][0][m][0][i] * rstd + ber[8 * fq + i]; ev[4 + i] = acc[ai][0][m][1][i] * rstd + ber[8 * fq + 4 + i]; }
                    int i1 = 0; float v1 = ev[0];
#pragma unroll
                    for (int i = 1; i < 8; ++i) if (ev[i] > v1) { v1 = ev[i]; i1 = i; }
                    int i2 = -1; float v2 = -3.0e38f;
#pragma unroll
                    for (int i = 0; i < 8; ++i) if (i != i1 && ev[i] > v2) { v2 = ev[i]; i2 = i; }
                    const float e2 = __expf(v2 - v1), w1 = gw / (1.f + e2), w2 = gw * e2 / (1.f + e2);
                    const int ea = gs * 8 + i1, eb = gs * 8 + i2;
                    const unsigned ra = __hip_atomic_fetch_add(cnt + 64 * ea, 1u, __ATOMIC_RELAXED, __HIP_MEMORY_SCOPE_AGENT);
                    const unsigned rb = __hip_atomic_fetch_add(cnt + 64 * eb, 1u, __ATOMIC_RELAXED, __HIP_MEMORY_SCOPE_AGENT);
                    const size_t ia = (size_t)ea * lcap + ra, ib = (size_t)eb * lcap + rb;
                    list[ia] = 2 * row; list[ib] = 2 * row + 1; listw[ia] = w1; listw[ib] = w2; listr[ia] = rstd; listr[ib] = rstd; } }
    }
};

template <class Epi, class Sched, bool ALIGN_EPI, bool GATHER, bool FP8 = false>
__device__ __forceinline__ void gemm_phase(PG8_LAS unsigned char* lds, const Gemm g, Sched& S, const Epi& E) {
    int tid_ = threadIdx.x; asm volatile("" : "+v"(tid_));
    const int tid = tid_, wid = __builtin_amdgcn_readfirstlane(tid >> 6), lane = tid & 63, wr = wid >> 2, wc = wid & 3, fr = lane & 15, fq = lane >> 4;
    const int K = g.K, nt = K / BK;
    unsigned voffA[2], voffB[2]; int RA[2], CA[2];
#pragma unroll
    for (int i = 0; i < 2; ++i) { int R, C; stage_rc(tid * 16 + i * 8192, R, C); const int Rb = Epi::PERM ? ((R & ~31) + perm32(R & 31)) : R;
        voffA[i] = (unsigned)(R * K + C) * 2u; voffB[i] = (unsigned)(Rb * K + C) * 2u; RA[i] = R; CA[i] = C; }
    const size_t kstep = (size_t)(BK * 2);
    const size_t hstep = (size_t)HALF * K * 2;
    const size_t tstep = 2 * hstep;
    const unsigned ldsw = (unsigned)wid * 1024u;
    const int aoff = lds_byte(wr * 64 + fr, fq * 8), boff = lds_byte(wc * 32 + fr, fq * 8);
#define PG8_SA(b, h) (((b) * 2 + (h)) * HTB)
#define PG8_SB(b, h) ((4 + (b) * 2 + (h)) * HTB)
#define PG8_STAGE(bufoff, gbase, voff) do { _Pragma("unroll") for (int _i = 0; _i < 2; ++_i) \
        __builtin_amdgcn_global_load_lds((const unsigned*)((const char*)(gbase) + (voff)[_i]), (PG8_LAS unsigned*)(lds + (bufoff) + ldsw + _i * 8192), 16, 0, 0); } while (0)
#define PG8_STAGE_A(bufoff, kp, h) do { if constexpr (GATHER) { PG8_STAGE(bufoff, kp, cgo[h]); } else { PG8_STAGE(bufoff, (kp) + (h) * hstep, voffA); } } while (0)
#define PG8_LDA(dst, b, h) do { _Pragma("unroll") for (int m = 0; m < 4; ++m) _Pragma("unroll") for (int k = 0; k < 2; ++k) dst[m][k] = *(const PG8_LAS bf16x8*)(lds + PG8_SA(b, h) + aoff + m * 2048 + k * 1024); } while (0)
#define PG8_LDB(dst, b, h) do { _Pragma("unroll") for (int n = 0; n < 2; ++n) _Pragma("unroll") for (int k = 0; k < 2; ++k) dst[n][k] = *(const PG8_LAS bf16x8*)(lds + PG8_SB(b, h) + boff + n * 2048 + k * 1024); } while (0)
#define PG8_CAT(x, y) __builtin_shufflevector(__builtin_bit_cast(v4i_t, x), __builtin_bit_cast(v4i_t, y), 0, 1, 2, 3, 4, 5, 6, 7)
#define PG8_MMA(ai, bj, At, Bt) do { __builtin_amdgcn_s_setprio(1); \
        if constexpr (FP8) { _Pragma("unroll") for (int m = 0; m < 4; ++m) _Pragma("unroll") for (int n = 0; n < 2; ++n) \
            acc[ai][bj][m][n] = __builtin_amdgcn_mfma_scale_f32_16x16x128_f8f6f4(PG8_CAT(Bt[n][0], Bt[n][1]), PG8_CAT(At[m][0], At[m][1]), acc[ai][bj][m][n], 0, 0, 0, 0, 0, 0); } \
        else { _Pragma("unroll") for (int m = 0; m < 4; ++m) _Pragma("unroll") for (int n = 0; n < 2; ++n) _Pragma("unroll") for (int k = 0; k < 2; ++k) \
            acc[ai][bj][m][n] = __builtin_amdgcn_mfma_f32_16x16x32_bf16(Bt[n][k], At[m][k], acc[ai][bj][m][n], 0, 0, 0); } \
        __builtin_amdgcn_s_setprio(0); } while (0)
#define PG8_WAIT_V(n) asm volatile("s_waitcnt vmcnt(" #n ")" ::: "memory")
#define PG8_WAIT_L(n) asm volatile("s_waitcnt lgkmcnt(" #n ")" ::: "memory")
#define PG8_BAR __builtin_amdgcn_s_barrier()
#define PG8_SCHED __builtin_amdgcn_sched_barrier(0)
    Unit cur, nxt; int ui = 0;
#if PROBE_KLOOP
    unsigned pk_acc_ = 0u;
#endif
    if (!S.next(0, cur)) return;
    f32x4 acc[2][2][4][2];
#pragma unroll
    for (int a = 0; a < 2; ++a)
#pragma unroll
        for (int b = 0; b < 2; ++b)
#pragma unroll
            for (int m = 0; m < 4; ++m)
#pragma unroll
                for (int n = 0; n < 2; ++n) acc[a][b][m][n] = (f32x4){0.f, 0.f, 0.f, 0.f};
    bf16x8 At[4][2], B0[2][2], B1[2][2];
    unsigned cgo[2][2] = {{0u, 0u}, {0u, 0u}}, ngo[2][2] = {{0u, 0u}, {0u, 0u}};
    if constexpr (GATHER) {
#pragma unroll
        for (int h = 0; h < 2; ++h)
#pragma unroll
            for (int i = 0; i < 2; ++i) cgo[h][i] = S.goff(cur, h * HALF + RA[i], CA[i], K);
    }
    const char* cA = GATHER ? (const char*)g.A : (const char*)g.A + (size_t)cur.pm * tstep; const char* cB = S.bbase(g, cur, tstep);
    S.a_ready(cur);
    PG8_STAGE(PG8_SB(0, 0), cB, voffB); PG8_STAGE(PG8_SB(0, 1), cB + hstep, voffB); PG8_STAGE_A(PG8_SA(0, 0), cA, 0); PG8_STAGE_A(PG8_SA(0, 1), cA, 1);
    if (wr == 1) PG8_BAR;
    PG8_WAIT_V(2); PG8_BAR;
    PG8_STAGE(PG8_SB(1, 0), cB + kstep, voffB); PG8_STAGE_A(PG8_SA(1, 0), cA + kstep, 0); PG8_STAGE(PG8_SB(1, 1), cB + hstep + kstep, voffB);
    PG8_WAIT_V(6); PG8_BAR;
    for (;;) {
        const bool has_next = S.next(ui + 1, nxt);
        if constexpr (GATHER) {
            if (has_next) {
#pragma unroll
                for (int h = 0; h < 2; ++h)
#pragma unroll
                    for (int i = 0; i < 2; ++i) ngo[h][i] = S.goff(nxt, h * HALF + RA[i], CA[i], K);
            } else {
#pragma unroll
                for (int h = 0; h < 2; ++h)
#pragma unroll
                    for (int i = 0; i < 2; ++i) ngo[h][i] = cgo[h][i];
            }
        }
        const char* nA = GATHER ? (const char*)g.A : (has_next ? (const char*)g.A + (size_t)nxt.pm * tstep : cA); const char* nB = has_next ? S.bbase(g, nxt, tstep) : cB;
#if PROBE_KLOOP
        const unsigned long long pk0_ = __builtin_amdgcn_s_memrealtime();
#endif
        for (int t = 0; t < nt; t += 2) {
            const bool last = (t == nt - 2);
            const char* a1 = cA + (size_t)(t + 1) * kstep;
            const char* a2 = last ? nA : cA + (size_t)(t + 2) * kstep; const char* b2 = last ? nB : cB + (size_t)(t + 2) * kstep;
            const char* a3 = a2 + kstep; const char* b3 = b2 + kstep;
            if (last && has_next) S.a_ready(nxt);
            PG8_LDB(B0, 0, 0); PG8_LDB(B1, 0, 1); PG8_SCHED; PG8_LDA(At, 0, 0); PG8_STAGE_A(PG8_SA(1, 1), a1, 1);
            if constexpr (GATHER) { if (last) {
#pragma unroll
                for (int h = 0; h < 2; ++h)
#pragma unroll
                    for (int i = 0; i < 2; ++i) cgo[h][i] = ngo[h][i]; } }
            PG8_WAIT_V(8); PG8_WAIT_L(0); PG8_BAR; PG8_MMA(0, 0, At, B0); PG8_MMA(0, 1, At, B1); PG8_BAR; PG8_SCHED;
            PG8_LDA(At, 0, 1); PG8_STAGE(PG8_SB(0, 0), b2, voffB); PG8_STAGE(PG8_SB(0, 1), b2 + hstep, voffB); PG8_STAGE_A(PG8_SA(0, 0), a2, 0);
            PG8_WAIT_V(8); PG8_WAIT_L(0); PG8_BAR; PG8_MMA(1, 0, At, B0); PG8_MMA(1, 1, At, B1); PG8_BAR; PG8_SCHED;
            PG8_LDB(B0, 1, 0); PG8_LDB(B1, 1, 1); PG8_SCHED; PG8_LDA(At, 1, 0); PG8_STAGE_A(PG8_SA(0, 1), a2, 1);
            PG8_WAIT_V(8); PG8_WAIT_L(0); PG8_BAR; PG8_MMA(0, 0, At, B0); PG8_MMA(0, 1, At, B1); PG8_BAR; PG8_SCHED;
            PG8_LDA(At, 1, 1); PG8_STAGE(PG8_SB(1, 0), b3, voffB); PG8_STAGE(PG8_SB(1, 1), b3 + hstep, voffB); PG8_STAGE_A(PG8_SA(1, 0), a3, 0);
            PG8_WAIT_V(8); PG8_WAIT_L(0); PG8_BAR; PG8_MMA(1, 0, At, B0); PG8_MMA(1, 1, At, B1); PG8_BAR; PG8_SCHED;
        }
#if PROBE_KLOOP
        const unsigned long long pk1_ = __builtin_amdgcn_s_memrealtime(); if (PROBE_WHAT == 0) pk_acc_ += (unsigned)(pk1_ - pk0_);
#endif
        if constexpr (ALIGN_EPI) { if (wr == 0) PG8_BAR; }
#if PROBE_KLOOP
        const unsigned long long pk2_ = __builtin_amdgcn_s_memrealtime(); if (PROBE_WHAT == 1) pk_acc_ += (unsigned)(pk2_ - pk1_);
#endif
        E(acc, cur, wr, wc, fr, fq); S.done(cur);
#if PROBE_KLOOP
        asm volatile("s_waitcnt vmcnt(0)" ::: "memory"); if (PROBE_WHAT == 2) pk_acc_ += (unsigned)(__builtin_amdgcn_s_memrealtime() - pk2_);
#endif
        if (!has_next) break;
#pragma unroll
        for (int a = 0; a < 2; ++a)
#pragma unroll
            for (int b = 0; b < 2; ++b)
#pragma unroll
                for (int m = 0; m < 4; ++m)
#pragma unroll
                    for (int n = 0; n < 2; ++n) acc[a][b][m][n] = (f32x4){0.f, 0.f, 0.f, 0.f};
        cur = nxt; cA = nA; cB = nB; ++ui;
        if constexpr (ALIGN_EPI) { if (wr == 1) PG8_BAR; }
    }
#if PROBE_KLOOP
    if (blockIdx.x == PROBE_BLK && tid == 0 && g.M == PROBE_KLOOP) atomicAdd(g.probe, pk_acc_);
#endif
    PG8_WAIT_V(0);
    if constexpr (!ALIGN_EPI) { if (wr == 0) PG8_BAR; }
    PG8_BAR;
#undef PG8_SA
#undef PG8_SB
#undef PG8_STAGE
#undef PG8_STAGE_A
#undef PG8_LDA
#undef PG8_LDB
#undef PG8_MMA
#undef PG8_CAT
#undef PG8_WAIT_V
#undef PG8_WAIT_L
#undef PG8_BAR
#undef PG8_SCHED
}
}
#include <hip/hip_bf16.h>
#include <cmath>
namespace attn_body {
using bf16=__hip_bfloat16;
using bf16x8=__attribute__((ext_vector_type(8)))short;
using s16x4=__attribute__((ext_vector_type(4)))short;
using f32x16=__attribute__((ext_vector_type(16)))float;
using u32x4=__attribute__((ext_vector_type(4)))unsigned;
constexpr int BATCH=8,SEQ=4096,D=64,DM=1024;
constexpr int NW=8,QBLK=32,QB=QBLK*NW,KVBLK=64,NQB=SEQ/QB;
__device__ __forceinline__ int crow(int r,int hi){return (r&3)+8*(r>>2)+4*hi;}
#define SBAR() __builtin_amdgcn_sched_barrier(0)
__device__ __forceinline__ void cmask(f32x16&p0,f32x16&p1,int jb,int qrel,int hi){
  const float NEG=-INFINITY; const int lim=qrel-64*jb-4*hi;
  #pragma unroll
  for(int r=0;r<16;++r){const int cr=(r&3)+8*(r>>2); if(cr>lim)p0[r]=NEG; if(cr+32>lim)p1[r]=NEG;}
}

constexpr int NSLOT=3, SLOTB=8192;
constexpr int LDS_K=0, LDS_V=NSLOT*SLOTB, LDS_WS=3*NSLOT*SLOTB, LDS_OST=LDS_WS+NW*64*4, LDS_BYTES=LDS_OST+NW*4096;
__device__ __forceinline__ void glds16(const void*sbase,unsigned voff,unsigned lds_dst){unsigned keep;
  asm volatile("s_mov_b32 %0, m0\n\ts_mov_b32 m0, %3\n\ts_nop 0\n\tglobal_load_lds_dwordx4 %1, %2\n\ts_mov_b32 m0, %0":"=&s"(keep):"v"(voff),"s"(sbase),"s"(lds_dst):"memory");}
__device__ __forceinline__ float max3f(float a,float b,float c){float r;asm("v_max3_f32 %0, %1, %2, %3":"=v"(r):"v"(a),"v"(b),"v"(c));return r;}
__device__ __forceinline__ float max2f(float a,float b){float r;asm("v_max_f32_e32 %0, %1, %2":"=v"(r):"v"(a),"v"(b));return r;}
__device__ __forceinline__ float fsub_s(float a,float b){float r;asm("v_sub_f32_e32 %0, %1, %2":"=v"(r):"v"(a),"v"(b));return r;}
typedef float f32x2_t __attribute__((ext_vector_type(2))); typedef __bf16 bf16x2_t __attribute__((ext_vector_type(2)));
__device__ __forceinline__ unsigned cvtpk_s(float lo,float hi){f32x2_t v={lo,hi};bf16x2_t b=__builtin_convertvector(v,bf16x2_t);return __builtin_bit_cast(unsigned,b);}
#define WAIT_BAR(N) asm volatile("s_waitcnt vmcnt(" #N ") lgkmcnt(0)\n\ts_barrier":::"memory")
#define MFMA32(a,b,c) __builtin_amdgcn_mfma_f32_32x32x16_bf16(a,b,c,0,0,0)

__device__ __forceinline__ void qkt(f32x16&p0,f32x16&p1,const char*Kslot,const bf16x8*qr,int r32,int hi){
  const char*kb=Kslot+hi*1024+r32*16;
  #pragma unroll
  for(int d0=0;d0<4;++d0){
    const bf16x8 b0=*reinterpret_cast<const bf16x8*>(kb+d0*2048);
    const bf16x8 b1=*reinterpret_cast<const bf16x8*>(kb+d0*2048+512);
    p0=MFMA32(b0,qr[d0],p0);p1=MFMA32(b1,qr[d0],p1);}
}
typedef __attribute__((address_space(3))) const char* lds_cptr;
typedef short v4i16_t __attribute__((ext_vector_type(4)));
__device__ __forceinline__ void kload8(bf16x8*kf,lds_cptr kp){
  kf[0]=*(const __attribute__((address_space(3))) bf16x8*)(kp);      kf[1]=*(const __attribute__((address_space(3))) bf16x8*)(kp+512);
  kf[2]=*(const __attribute__((address_space(3))) bf16x8*)(kp+2048); kf[3]=*(const __attribute__((address_space(3))) bf16x8*)(kp+2560);
  kf[4]=*(const __attribute__((address_space(3))) bf16x8*)(kp+4096); kf[5]=*(const __attribute__((address_space(3))) bf16x8*)(kp+4608);
  kf[6]=*(const __attribute__((address_space(3))) bf16x8*)(kp+6144); kf[7]=*(const __attribute__((address_space(3))) bf16x8*)(kp+6656);
}
__device__ __forceinline__ void kload2(bf16x8*kf,lds_cptr kp,int j){ kf[2*j]=*(const __attribute__((address_space(3))) bf16x8*)(kp+j*2048); kf[2*j+1]=*(const __attribute__((address_space(3))) bf16x8*)(kp+j*2048+512); }
__device__ __forceinline__ s16x4 vtr(lds_cptr p){ return __builtin_bit_cast(s16x4,__builtin_amdgcn_ds_read_tr16_b64_v4i16((__attribute__((address_space(3))) v4i16_t*)p)); }
__device__ __forceinline__ float rowmax(const f32x16&p0,const f32x16&p1){
  float a=max3f(p0[0],p0[1],p1[0]),b=max3f(p0[2],p0[3],p1[1]);a=max3f(a,p1[2],p1[3]);
  #pragma unroll
  for(int r=4;r<16;r+=4){a=max3f(a,p0[r],p0[r+1]);b=max3f(b,p0[r+2],p0[r+3]);a=max3f(a,p1[r],p1[r+1]);b=max3f(b,p1[r+2],p1[r+3]);}
  const float m=max2f(a,b);
  auto rr=__builtin_amdgcn_permlane32_swap(__float_as_uint(m),__float_as_uint(m),false,false);
  return max2f(__uint_as_float(rr[0]),__uint_as_float(rr[1]));
}
__device__ __forceinline__ void pv(f32x16*o,int vb,bf16x8 pa0,bf16x8 pa1,bf16x8 pa2,bf16x8 pa3){
  #pragma unroll
  for(int d0=0;d0<4;++d0){s16x4 lo[4],hi[4];
    #pragma unroll
    for(int ks=0;ks<4;++ks){
      asm volatile("ds_read_b64_tr_b16 %0,%1 offset:%c2":"=&v"(lo[ks]):"v"(vb),"i"(d0*4096+ks*1024):"memory");
      asm volatile("ds_read_b64_tr_b16 %0,%1 offset:%c2":"=&v"(hi[ks]):"v"(vb),"i"(d0*4096+ks*1024+512):"memory");}
    asm volatile("s_waitcnt lgkmcnt(0)":::"memory");SBAR();
    #define PK(k) (bf16x8){lo[k][0],lo[k][1],lo[k][2],lo[k][3],hi[k][0],hi[k][1],hi[k][2],hi[k][3]}
    o[d0]=MFMA32(pa0,PK(0),o[d0]);
    o[d0]=MFMA32(pa1,PK(1),o[d0]);
    o[d0]=MFMA32(pa2,PK(2),o[d0]);
    o[d0]=MFMA32(pa3,PK(3),o[d0]);
    #undef PK
  }
}

template<int THRL> __device__ __forceinline__ void attn_sub(int b,int qkcol,int vcol,int qb,int cmap,float sl2,float lam,int ntcap,float Ub,float oscale,const float*subg,unsigned*o1s,bf16*MIXh,const bf16*Q,const bf16*__restrict__ K,const bf16*__restrict__ V,char*shm,unsigned*pw_){
#if PROBE_ATT >= 3
  const unsigned long long ps0_=__builtin_amdgcn_s_memrealtime();
#endif
  const int tid=threadIdx.x,lane=tid&63,r32=lane&31,hi=lane>>5; const int wid=__builtin_amdgcn_readfirstlane(tid>>6);
  const long rowbase=(long)b*SEQ; const int q0=qb*QB;
  const bf16*Qw=Q+(rowbase+q0+wid*QBLK)*DM+qkcol;
  const bf16*Kh=K+rowbase*DM+qkcol,*Vh=V+rowbase*DM+vcol;
  const unsigned lds0=(unsigned)(uintptr_t)shm;
  float*wsf=(float*)(shm+LDS_WS)+wid*64;
  const unsigned koff=(unsigned)(lane*DM+wid*8)*2u, voffv=(unsigned)((16*(wid&3)+(lane>>2))*DM+(wid>>2)*32+(lane&3)*8)*2u;
  const unsigned kdst=lds0+LDS_K+wid*1024, vdst=lds0+LDS_V+wid*1024;
  const int NTR=(q0+QB)/KVBLK;
  int NT=NTR<ntcap?NTR:ntcap;
  #define DMA_K(t,slot) glds16(Kh+(long)(NTR-1-(t))*KVBLK*DM,koff,(unsigned)__builtin_amdgcn_readfirstlane(kdst+(slot)))
  #define DMA_V(t,slot) do{ glds16(Vh+(long)(NTR-1-(t))*KVBLK*DM,voffv,(unsigned)__builtin_amdgcn_readfirstlane(vdst+2*(slot))); glds16(Vh+(long)(NTR-1-(t))*KVBLK*DM+64,voffv,(unsigned)__builtin_amdgcn_readfirstlane(vdst+2*(slot)+8192)); }while(0)
  const char*Kbase=shm+LDS_K; bf16x8 kf[8];
  const lds_cptr shm3=(lds_cptr)shm; const lds_cptr kp0=shm3+LDS_K+hi*1024+r32*16; const lds_cptr vp0=shm3+LDS_V+((lane>>4)&1)*32+(lane&3)*8+(4*hi+((lane&15)>>2))*64;
  #define vb0 ((int)(unsigned)(uintptr_t)vp0)
  DMA_K(0,0);DMA_V(0,0);DMA_K(1,SLOTB);
  bf16x8 qr[4];
  #pragma unroll
  for(int d0=0;d0<4;++d0)qr[d0]=*reinterpret_cast<const bf16x8*>(&Qw[(long)r32*DM+d0*16+hi*8]);
  const int qrel=wid*QBLK+r32;
  const unsigned lm=hi?0u:0xffffffffu;
  const int qw0=wid*QBLK;
  unsigned bbx; { const unsigned sh=__float_as_uint(sl2)&0xffff0000u; const float sr=sl2-__uint_as_float(sh); bbx=((sh>>16)|(cvtpk_s(sr,0.f)<<16))&lm; }
  const float dlt=64.f*sl2;
  float cref=sl2*(float)(192-qrel);
  #define BIAS2(C0,C1,t) do{ const float c_=__builtin_fmaf(-dlt,(float)(t),cref); const unsigned h_=__float_as_uint(c_)&0xffff0000u; const float r1_=c_-__uint_as_float(h_); \
      const unsigned m_=__float_as_uint(r1_)&0xffff0000u; const float r2_=r1_-__uint_as_float(m_); \
      int q_=qrel; asm volatile("":"+v"(q_)); const float rf_=(float)(q_-qw0); \
      u32x4 b_=(u32x4){bbx,((h_>>16)|m_)&lm,(__float_as_uint(r2_)>>16)&lm,0u}; u32x4 a_=(u32x4){cvtpk_s(rf_,rf_),0x3F803F80u,0x00003F80u,0u}; asm volatile("":"+v"(a_),"+v"(b_)); \
      const f32x16 z_=f32x16{}; C0=MFMA32(__builtin_bit_cast(bf16x8,a_),__builtin_bit_cast(bf16x8,b_),z_); \
      a_.x=cvtpk_s(rf_+32.f,rf_+32.f); asm volatile("":"+v"(a_)); C1=MFMA32(__builtin_bit_cast(bf16x8,a_),__builtin_bit_cast(bf16x8,b_),z_); }while(0)
  float l_reg=0.f;f32x16 o[4];o[0]=f32x16{};o[1]=f32x16{};o[2]=f32x16{};o[3]=f32x16{};
  #define CMASK(P0,P1,t) do{int jb_=3-(t); if(jb_>=0)cmask(P0,P1,jb_,qrel,hi);}while(0)
  bool resc=false;
  #define START(P0,P1) do{ const float rm=rowmax(P0,P1); resc=false; \
    if(__any(rm>(float)THRL)){ const float dl=max2f(rm,0.f); cref=fsub_s(cref,dl); \
      _Pragma("unroll") for(int r=0;r<16;++r){P0[r]=fsub_s(P0[r],dl);P1[r]=fsub_s(P1[r],dl);} } \
    _Pragma("unroll") for(int r=0;r<16;++r)P0[r]=__builtin_amdgcn_exp2f(P0[r]); }while(0)
  #define RESC() do{ if(resc){ asm volatile("s_waitcnt lgkmcnt(0)":::"memory"); \
      _Pragma("unroll") for(int d_=0;d_<4;++d_) _Pragma("unroll") for(int r=0;r<16;++r)o[d_][r]*=wsf[crow(r,hi)]; } }while(0)
  f32x16 pA0,pA1,pB0,pB1;
  int sl_prev=0,sl_cur=0,sl_next=SLOTB;
  #define ROT() do{sl_prev=sl_cur;sl_cur=sl_next;sl_next=(sl_next==(NSLOT-1)*SLOTB)?0:sl_next+SLOTB;}while(0)
  DMA_K(2,2*SLOTB);
  WAIT_BAR(3);
  BIAS2(pA0,pA1,0);
  qkt(pA0,pA1,Kbase,qr,r32,hi);asm volatile("s_nop 15\n\ts_nop 7":"+v"(pA0),"+v"(pA1));CMASK(pA0,pA1,0);
  START(pA0,pA1);
  _Pragma("unroll") for(int r=0;r<16;++r)pA1[r]=__builtin_amdgcn_exp2f(pA1[r]);
  WAIT_BAR(0);
  DMA_K(3,0);DMA_V(1,SLOTB);
  ROT();
  kload8(kf,kp0+sl_cur);
  WAIT_BAR(3);
  s16x4 vlo[8],vhi[8]; u32x4 pw0,pw1,pw2,pw3;
  #define PKW(P,B) cvtpk_s(P[B],P[B+1])
  #define PAF(k) __builtin_bit_cast(bf16x8,pw##k)
  #define VFR(i) (bf16x8){vlo[i][0],vlo[i][1],vlo[i][2],vlo[i][3],vhi[i][0],vhi[i][1],vhi[i][2],vhi[i][3]}
  #define PIN(x) asm volatile("":"+v"(x))
  #define MX3(a,b,c) __builtin_fmaxf(__builtin_fmaxf((a),(b)),(c))
  #define GAPA(MF,A0,A1,A2,A3,W0,W1,PW) do{ MF; sacc+=A0; sacc+=A1; sacc+=A2; sacc+=A3; PIN(sacc); W0; W1; PIN(PW); SBAR(); }while(0)
  #define EX(v) __builtin_amdgcn_exp2f(v)
  #define GAPB(MF,X,B) do{ MF; X[B]=EX(X[B]); X[B+1]=EX(X[B+1]); PIN(X); SBAR(); }while(0)
  #define VRD2(i) do{ vlo[i]=vtr(vp_+(8192+((i)>>2)*4096+((i)&3)*1024)); vhi[i]=vtr(vp_+(8192+((i)>>2)*4096+((i)&3)*1024+512)); SBAR(); }while(0)
  #define VRD(i) do{ vlo[i]=vtr(vp_+(((i)>>2)*4096+((i)&3)*1024)); vhi[i]=vtr(vp_+(((i)>>2)*4096+((i)&3)*1024+512)); }while(0)
  #define KRD(G,j) do{ if(G){ kload2(kf,kp0+sl_next,j); SBAR(); } }while(0)
  #define STEP(C0,C1,P0,P1,t,GK,GV,GL) do{ SBAR(); \
    BIAS2(C0,C1,t); SBAR(); \
    const lds_cptr vp_=vp0+2*sl_prev; \
    VRD(0); SBAR(); float sacc=(P0[0]+P0[1]); \
    GAPA(C0=MFMA32(kf[0],qr[0],C0), P0[2],P0[3],P0[4],P0[5],     pw0[0]=PKW(P0,0), pw0[1]=PKW(P0,2), pw0); \
    VRD(4); SBAR(); GAPA(C1=MFMA32(kf[1],qr[0],C1), P0[6],P0[7],P0[8],P0[9],     pw0[2]=PKW(P0,4), pw0[3]=PKW(P0,6), pw0); \
    VRD(1); SBAR(); GAPA(C0=MFMA32(kf[2],qr[1],C0),   P0[10],P0[11],P0[12],P0[13], pw1[0]=PKW(P0,8), pw1[1]=PKW(P0,10), pw1); \
    VRD(5); SBAR(); GAPA(C1=MFMA32(kf[3],qr[1],C1),   P0[14],P0[15],P1[0],P1[1],   pw1[2]=PKW(P0,12),pw1[3]=PKW(P0,14), pw1); \
    VRD(2); SBAR(); GAPA(C0=MFMA32(kf[4],qr[2],C0),   P1[2],P1[3],P1[4],P1[5],     pw2[0]=PKW(P1,0), pw2[1]=PKW(P1,2), pw2); \
    VRD(6); SBAR(); GAPA(C1=MFMA32(kf[5],qr[2],C1),   P1[6],P1[7],P1[8],P1[9],     pw2[2]=PKW(P1,4), pw2[3]=PKW(P1,6), pw2); \
    VRD(3); SBAR(); GAPA(C0=MFMA32(kf[6],qr[3],C0),   P1[10],P1[11],P1[12],P1[13], pw3[0]=PKW(P1,8), pw3[1]=PKW(P1,10), pw3); \
    VRD(7); SBAR(); GAPA(C1=MFMA32(kf[7],qr[3],C1),   P1[14],P1[15],0.f,0.f,       pw3[2]=PKW(P1,12),pw3[3]=PKW(P1,14), pw3); \
    l_reg+=sacc; \
    if(GK){DMA_K((t)+3,sl_cur);} if(GV){DMA_V((t)+1,sl_next);} \
    CMASK(C0,C1,t); \
    { float a=MX3(C0[0],C0[1],C1[0]),b=MX3(C0[2],C0[3],C1[1]); a=MX3(a,C1[2],C1[3]); \
      _Pragma("unroll") for(int r=4;r<16;r+=4){a=MX3(a,C0[r],C0[r+1]);b=MX3(b,C0[r+2],C0[r+3]);a=MX3(a,C1[r],C1[r+1]);b=MX3(b,C1[r+2],C1[r+3]);} \
      float rm=__builtin_fmaxf(a,b); { auto rr=__builtin_amdgcn_permlane32_swap(__float_as_uint(rm),__float_as_uint(rm),false,false); rm=__builtin_fmaxf(__uint_as_float(rr[0]),__uint_as_float(rr[1])); } \
      resc=false; \
      if(__builtin_expect(__any(rm>(float)THRL),0)){ const float dl=__builtin_fmaxf(rm,0.f); cref-=dl; \
        _Pragma("unroll") for(int r=0;r<16;++r){C0[r]-=dl;C1[r]-=dl;} \
        const float f=__builtin_amdgcn_exp2f(-dl); l_reg*=f; if(hi==0)wsf[r32]=f; resc=true; } } \
    SBAR(); \
    GAPB(o[0]=MFMA32(PAF(0),VFR(0),o[0]), C0,0);  VRD2(0); \
    GAPB(o[1]=MFMA32(PAF(0),VFR(4),o[1]), C0,2);  VRD2(4); \
    KRD(GL,0); GAPB(o[0]=MFMA32(PAF(1),VFR(1),o[0]), C0,4);  VRD2(1); \
    KRD(GL,1); GAPB(o[1]=MFMA32(PAF(1),VFR(5),o[1]), C0,6);  VRD2(5); \
    KRD(GL,2); GAPB(o[0]=MFMA32(PAF(2),VFR(2),o[0]), C0,8);  VRD2(2); \
    KRD(GL,3); GAPB(o[1]=MFMA32(PAF(2),VFR(6),o[1]), C0,10); VRD2(6); \
    GAPB(o[0]=MFMA32(PAF(3),VFR(3),o[0]), C0,12); VRD2(3); \
    GAPB(o[1]=MFMA32(PAF(3),VFR(7),o[1]), C0,14); VRD2(7); \
    GAPB(o[2]=MFMA32(PAF(0),VFR(0),o[2]), C1,0); \
    GAPB(o[3]=MFMA32(PAF(0),VFR(4),o[3]), C1,2); \
    GAPB(o[2]=MFMA32(PAF(1),VFR(1),o[2]), C1,4); \
    GAPB(o[3]=MFMA32(PAF(1),VFR(5),o[3]), C1,6); \
    GAPB(o[2]=MFMA32(PAF(2),VFR(2),o[2]), C1,8); \
    GAPB(o[3]=MFMA32(PAF(2),VFR(6),o[3]), C1,10); \
    GAPB(o[2]=MFMA32(PAF(3),VFR(3),o[2]), C1,12); \
    GAPB(o[3]=MFMA32(PAF(3),VFR(7),o[3]), C1,14); \
    }while(0)
  #define ENDW(tt) do{ if((tt)+3<NT){WAIT_BAR(3);} else if((tt)+2<NT){WAIT_BAR(2);} else {WAIT_BAR(0);} }while(0)
#if PROBE_ATT == 3
  if(blockIdx.x==PROBE_BLK&&threadIdx.x==0)atomicAdd(pw_,(unsigned)(__builtin_amdgcn_s_memrealtime()-ps0_));
#endif
  int t=1;
  for(;t<5&&t+1<NT;t+=2){
    STEP(pB0,pB1,pA0,pA1,t,(t+3<NT),(t+1<NT),(t+1<NT));       ENDW(t);   RESC(); ROT();
    STEP(pA0,pA1,pB0,pB1,t+1,(t+4<NT),(t+2<NT),(t+2<NT));     ENDW(t+1); RESC(); ROT();
  }
  if(t==5&&NT>=12){
    float lt=l_reg; {auto rr=__builtin_amdgcn_permlane32_swap(__float_as_uint(lt),__float_as_uint(lt),false,false);lt=__uint_as_float(rr[0])+__uint_as_float(rr[1]);}
    float dl2=(sl2*(float)(192-qrel)-cref)+__builtin_amdgcn_logf(lt);
    #define DPPMIN(ctl) dl2=__builtin_fminf(dl2,__uint_as_float((unsigned)__builtin_amdgcn_update_dpp(0,(int)__float_as_uint(dl2),ctl,0xF,0xF,false)))
    DPPMIN(0xB1); DPPMIN(0x4E); DPPMIN(0x141); DPPMIN(0x140);
    #undef DPPMIN
    { auto rr=__builtin_amdgcn_permlane16_swap(__float_as_uint(dl2),__float_as_uint(dl2),false,false); dl2=__builtin_fminf(__uint_as_float(rr[0]),__uint_as_float(rr[1])); }
    float*xw=(float*)(shm+LDS_OST);
    if(lane==0)xw[wid]=dl2;
    asm volatile("s_waitcnt lgkmcnt(0)\n\ts_barrier":::"memory");
    float dmin=xw[0];
    #pragma unroll
    for(int w_=1;w_<8;++w_)dmin=__builtin_fminf(dmin,xw[w_]);
    dmin=__uint_as_float(__builtin_amdgcn_readfirstlane(__float_as_uint(dmin)));
    const float d0_=(Ub-dmin+24.f+log2f(1.f/(1.f-exp2f(-sl2))))/sl2; float st_=ceilf((d0_+255.f)*(1.f/64.f)); st_=st_<10.f?10.f:(st_>64.f?64.f:st_);
    const int nc_=__builtin_amdgcn_readfirstlane((((int)st_)+1)&~1); if(nc_<NT)NT=nc_;
    asm volatile("s_waitcnt lgkmcnt(0)":::"memory");
  }
  #undef CMASK
  #define CMASK(P0,P1,t) do{}while(0)
  for(;t+5<NT;t+=2){
    STEP(pB0,pB1,pA0,pA1,t,true,true,true);     WAIT_BAR(3); RESC(); ROT();
    STEP(pA0,pA1,pB0,pB1,t+1,true,true,true);   WAIT_BAR(3); RESC(); ROT();
  }
  for(;t+1<NT;t+=2){
    STEP(pB0,pB1,pA0,pA1,t,(t+3<NT),(t+1<NT),(t+1<NT));       ENDW(t);   RESC(); ROT();
    STEP(pA0,pA1,pB0,pB1,t+1,(t+4<NT),(t+2<NT),(t+2<NT));     ENDW(t+1); RESC(); ROT();
  }
  #undef CMASK
  #define CMASK(P0,P1,t) do{int jb_=3-(t); if(jb_>=0)cmask(P0,P1,jb_,qrel,hi);}while(0)
  STEP(pB0,pB1,pA0,pA1,NT-1,false,false,false); RESC();
#if PROBE_ATT == 4
  const unsigned long long ps1_=__builtin_amdgcn_s_memrealtime();
#endif
  { float sacc=pB0[0]+pB0[1]; _Pragma("unroll") for(int r=2;r<16;++r)sacc+=pB0[r]; _Pragma("unroll") for(int r=0;r<16;++r)sacc+=pB1[r]; l_reg+=sacc;
    pw0=(u32x4){PKW(pB0,0),PKW(pB0,2),PKW(pB0,4),PKW(pB0,6)};pw1=(u32x4){PKW(pB0,8),PKW(pB0,10),PKW(pB0,12),PKW(pB0,14)};pw2=(u32x4){PKW(pB1,0),PKW(pB1,2),PKW(pB1,4),PKW(pB1,6)};pw3=(u32x4){PKW(pB1,8),PKW(pB1,10),PKW(pB1,12),PKW(pB1,14)};
    SBAR(); pv(o,vb0+2*sl_cur,PAF(0),PAF(1),PAF(2),PAF(3)); }
  #undef PKW
  #undef PAF
  #undef VFR
  #undef PIN
  #undef MX3
  #undef GAPA
  #undef GAPB
  #undef EX
  #undef VRD
  #undef VRD2
  #undef KRD
  #undef STEP
  #undef ENDW
  { int tid_e=threadIdx.x; asm volatile("":"+v"(tid_e)); const int lane=tid_e&63,r32=lane&31,hi=lane>>5; const int wid=__builtin_amdgcn_readfirstlane(tid_e>>6);
    float*wsf=(float*)(shm+LDS_WS)+wid*64;
  {auto rr=__builtin_amdgcn_permlane32_swap(__float_as_uint(l_reg),__float_as_uint(l_reg),false,false);l_reg=__uint_as_float(rr[0])+__uint_as_float(rr[1]);}
  if(hi==0)wsf[32+r32]=l_reg;asm volatile("s_waitcnt lgkmcnt(0)":::"memory");
  float rli[16];
  #pragma unroll
  for(int r=0;r<16;++r)rli[r]=__builtin_amdgcn_rcpf(wsf[32+crow(r,hi)]);
  u32x4*ow=(u32x4*)(o1s+wid*2048)+lane;
  if(cmap==0){
    #pragma unroll
    for(int i=0;i<8;++i){ const int dq=i>>1,r0=8*(i&1); u32x4 w;
      w.x=cvtpk_s(o[dq][r0+0]*rli[r0+0],o[dq][r0+1]*rli[r0+1]); w.y=cvtpk_s(o[dq][r0+2]*rli[r0+2],o[dq][r0+3]*rli[r0+3]);
      w.z=cvtpk_s(o[dq][r0+4]*rli[r0+4],o[dq][r0+5]*rli[r0+5]); w.w=cvtpk_s(o[dq][r0+6]*rli[r0+6],o[dq][r0+7]*rli[r0+7]); ow[i*64]=w; }
  } else {
    bf16*stg=(bf16*)(shm+LDS_OST)+wid*2048;
    const int row=lane>>1,part=lane&1; float v[64]; float ss=0.f;
    unsigned o1w[32];
    #pragma unroll
    for(int i=0;i<8;++i){ const u32x4 w=ow[i*64]; o1w[4*i+0]=w.x; o1w[4*i+1]=w.y; o1w[4*i+2]=w.z; o1w[4*i+3]=w.w; }
    #pragma unroll
    for(int p_=0;p_<2;++p_){
      #pragma unroll
      for(int d0=0;d0<2;++d0){ const int dq=2*p_+d0;
        #pragma unroll
        for(int rp=0;rp<8;++rp){ const unsigned w=o1w[dq*8+rp];
          const float a0=__uint_as_float(w<<16)-lam*(o[dq][2*rp]*rli[2*rp]), a1=__uint_as_float(w&0xffff0000u)-lam*(o[dq][2*rp+1]*rli[2*rp+1]);
          stg[crow(2*rp,hi)*64+d0*32+r32]=__float2bfloat16(a0); stg[crow(2*rp+1,hi)*64+d0*32+r32]=__float2bfloat16(a1); } }
      asm volatile("s_waitcnt lgkmcnt(0)":::"memory");
      #pragma unroll
      for(int i=0;i<4;++i){ const u32x4 w=*(const u32x4*)(stg+row*64+part*32+8*i);
        v[32*p_+8*i+0]=__uint_as_float(w.x<<16); v[32*p_+8*i+1]=__uint_as_float(w.x&0xffff0000u); v[32*p_+8*i+2]=__uint_as_float(w.y<<16); v[32*p_+8*i+3]=__uint_as_float(w.y&0xffff0000u);
        v[32*p_+8*i+4]=__uint_as_float(w.z<<16); v[32*p_+8*i+5]=__uint_as_float(w.z&0xffff0000u); v[32*p_+8*i+6]=__uint_as_float(w.w<<16); v[32*p_+8*i+7]=__uint_as_float(w.w&0xffff0000u); }
      asm volatile("s_waitcnt lgkmcnt(0)":::"memory");
    }
    #pragma unroll
    for(int i=0;i<64;++i)ss+=v[i]*v[i];
    ss+=__uint_as_float((unsigned)__builtin_amdgcn_update_dpp(0,(int)__float_as_uint(ss),0xB1,0xF,0xF,false));
    const float rs=(1.0f/sqrtf(ss*(1.0f/128.0f)+1e-6f))*oscale;
    bf16*op=MIXh+((long)rowbase+q0+wid*QBLK+row)*2048+part*32;
    #pragma unroll
    for(int p_=0;p_<2;++p_){ const float*sg=subg+64*p_+32*part;
      #pragma unroll
      for(int i=0;i<4;++i){ u32x4 w; const float*vv=v+32*p_+8*i; const float*gg=sg+8*i;
        w.x=cvtpk_s(vv[0]*rs*gg[0],vv[1]*rs*gg[1]); w.y=cvtpk_s(vv[2]*rs*gg[2],vv[3]*rs*gg[3]); w.z=cvtpk_s(vv[4]*rs*gg[4],vv[5]*rs*gg[5]); w.w=cvtpk_s(vv[6]*rs*gg[6],vv[7]*rs*gg[7]);
        *(u32x4*)(op+64*p_+8*i)=w; } }
  }
  }
  asm volatile("s_waitcnt lgkmcnt(0)\n\ts_barrier":::"memory");
#if PROBE_ATT == 4
  if(blockIdx.x==PROBE_BLK&&threadIdx.x==0)atomicAdd(pw_,(unsigned)(__builtin_amdgcn_s_memrealtime()-ps1_));
#endif
  #undef DMA_K
  #undef DMA_V
  #undef vb0
  #undef CMASK
  #undef START
  #undef RESC
  #undef ROT
  #undef BIAS2
}
constexpr int ATTN_LDS_BYTES=LDS_BYTES;
template<int THRL> __device__ __forceinline__ void attn_unit4(int b,int h,int qb,float lam,float oscale,const float*subg,const unsigned*nmax,unsigned*o1s,const bf16*Q,const bf16*K,const bf16*V,bf16*MIX,char*shm){
  const float sl2=exp2f(-(float)(h+1))*1.4426950408889634f;
  int cap[2]; float Uv[2];
  #pragma unroll
  for(int c=0;c<2;++c){ const int bh=b*8+h; const unsigned*qn=nmax+((0*64+bh)*2+c)*2,*kn=nmax+((1*64+bh)*2+c)*2;
    const float U=1.02f*(sqrtf(__uint_as_float(qn[0])*__uint_as_float(kn[0]))+sqrtf(__uint_as_float(qn[1])*__uint_as_float(kn[1])));
    const float d0=(2.f*U+24.f+log2f(1.f/(1.f-exp2f(-sl2))))/sl2; float st=ceilf((d0+255.f)*(1.f/64.f)); st=st<4.f?4.f:(st>64.f?64.f:st);
    cap[c]=__builtin_amdgcn_readfirstlane((((int)st)+1)&~1); Uv[c]=__uint_as_float(__builtin_amdgcn_readfirstlane(__float_as_uint(U))); }
  for(int c=0;c<2;++c) attn_sub<THRL>(b,(2*h+c)*64,h*128,qb,c,sl2,lam,c?cap[1]:cap[0],c?Uv[1]:Uv[0],oscale,subg,o1s,MIX+h*128,Q,K,V,shm,(unsigned*)nmax+900);
}
__device__ __forceinline__ int wg_pop(unsigned*ctr,volatile __attribute__((address_space(3))) unsigned*slot){
  if(threadIdx.x==0)*slot=__hip_atomic_fetch_add(ctr,1u,__ATOMIC_RELAXED,__HIP_MEMORY_SCOPE_AGENT);
  __syncthreads(); const unsigned n=*slot; __syncthreads(); return (int)n;
}
template<int THRL=8> __device__ __forceinline__ void attn_phase(char*lds,int bx,unsigned*qctr,volatile __attribute__((address_space(3))) unsigned*slot,float lam,float oscale,const float*subg,const unsigned*nmax,unsigned*o1s,const bf16*Q,const bf16*K,const bf16*V,bf16*MIX){
  for(int qi=0;qi<8;++qi){ const int x=(bx+qi)&7;
    for(;;){ const int n=wg_pop(qctr+64*x,slot); if(n>=128)break;
      const int qb=15-(n>>3),h=7-(n&7),b=(x+h)&7;
#if PROBE_ATT == 1
      const unsigned long long pa0_=__builtin_amdgcn_s_memrealtime();
#endif
      attn_unit4<THRL>(b,h,qb,lam,oscale,subg,nmax,o1s,Q,K,V,MIX,lds);
#if PROBE_ATT == 1
      if(blockIdx.x==PROBE_BLK&&threadIdx.x==0)atomicAdd((unsigned*)nmax+900,(unsigned)(__builtin_amdgcn_s_memrealtime()-pa0_));
#endif
    } }
}
#undef SBAR
#undef WAIT_BAR
#undef MFMA32
}
#define GAS __attribute__((address_space(1)))
#define LAS __attribute__((address_space(3)))
typedef unsigned short bf16;
typedef unsigned v4u __attribute__((ext_vector_type(4)));
typedef float f32x4 __attribute__((ext_vector_type(4)));
typedef short bf16x8 __attribute__((ext_vector_type(8)));
typedef GAS unsigned gu32;
typedef GAS unsigned long long gu64;
#define RLX_AGENT __ATOMIC_RELAXED, __HIP_MEMORY_SCOPE_AGENT
#define LDS_WAIT() asm volatile("s_waitcnt lgkmcnt(0)" ::: "memory")
#define VM_WAIT() asm volatile("s_waitcnt vmcnt(0)" ::: "memory")
__device__ __forceinline__ unsigned long long rt() { return __builtin_amdgcn_s_memrealtime(); }
__device__ __forceinline__ unsigned f2bf(float f) { unsigned u = __builtin_bit_cast(unsigned, f); return (u + 0x7fffu + ((u >> 16) & 1u)) >> 16; }
__device__ __forceinline__ unsigned pk2(float lo, float hi) { return f2bf(lo) | (f2bf(hi) << 16); }

#define XB_TMO      128
#define XB_XCNT(j)  (256  + 64 * (j))
#define XB_XSUB(j)  (1280 + 64 * (j))
#define XB_XGEN(j)  (2304 + 64 * (j))
#define XB_TOP      3328
#define XB_TOPGEN   3392
#define XCD_BAR_WORDS 3456
#define XB_SPIN_CAP (1u << 18)

__device__ __forceinline__ unsigned xb_ld(unsigned* p)              { return __hip_atomic_load(p, __ATOMIC_RELAXED, __HIP_MEMORY_SCOPE_AGENT); }
__device__ __forceinline__ unsigned xb_add(unsigned* p, unsigned v) { return __hip_atomic_fetch_add(p, v, __ATOMIC_RELAXED, __HIP_MEMORY_SCOPE_AGENT); }
__device__ __forceinline__ unsigned xb_xcc_id() { return (unsigned)__builtin_amdgcn_s_getreg((3 << 11) | 20) & 0xFu; }
#define XB_SPIN(cond, bar) do { unsigned _sp = 0; while (cond) { __builtin_amdgcn_s_sleep(1); \
    if ((++_sp & 255u) == 0u) { if (xb_ld(&(bar)[XB_TMO])) break; if (_sp > XB_SPIN_CAP) { atomicAdd(&(bar)[XB_TMO], 1u); break; } } } } while (0)

struct XcdBarrier {
    unsigned* bar; unsigned x;
    volatile LAS unsigned* st;
};

__device__ __forceinline__ XcdBarrier xcd_barrier_post(unsigned* bar, volatile LAS unsigned* st) {
    XcdBarrier b; b.bar = bar; b.x = xb_xcc_id(); b.st = st;
    if (threadIdx.x == 0) (void)xb_add(&bar[XB_XCNT(b.x)], 1u);
    return b;
}
__device__ __forceinline__ void xcd_barrier_complete(unsigned* bar, unsigned x, unsigned& nloc, unsigned& nx) {
    const unsigned G = gridDim.x * gridDim.y * gridDim.z;
    unsigned sum, cnt, mine, sp = 0u;
    for (;;) {
        sum = 0u; cnt = 0u; mine = 0u;
#pragma unroll
        for (unsigned j = 0; j < 16; ++j) { const unsigned c = xb_ld(&bar[XB_XCNT(j)]); sum += c; cnt += (c > 0u) ? 1u : 0u; mine = (j == x) ? c : mine; }
        if (sum == G) break;
        __builtin_amdgcn_s_sleep(1);
        if ((++sp & 255u) == 0u) { if (xb_ld(&bar[XB_TMO])) break; if (sp > XB_SPIN_CAP) { atomicAdd(&bar[XB_TMO], 1u); break; } }
    }
    nloc = mine > 0u ? mine : 1u; nx = cnt > 0u ? cnt : 1u;
}

__device__ __forceinline__ void xcd_barrier(const XcdBarrier& b) {
    asm volatile("s_waitcnt vmcnt(0)" ::: "memory");
    __syncthreads();
    if (threadIdx.x == 0) {
        unsigned* bar = b.bar;
        __builtin_amdgcn_s_waitcnt(0);
        unsigned nloc = b.st[0], nx = b.st[1];
        if (nloc == 0u) { xcd_barrier_complete(bar, b.x, nloc, nx); b.st[0] = nloc; b.st[1] = nx; }
        const unsigned old = xb_add(&bar[XB_XSUB(b.x)], 1u);
        const unsigned gen = old / nloc;
        if (old + 1u == (gen + 1u) * nloc) {
            __builtin_amdgcn_fence(__ATOMIC_RELEASE, "agent");
            asm volatile("s_waitcnt vmcnt(0)" ::: "memory");
            const unsigned og = xb_add(&bar[XB_TOP], 1u);
            const unsigned tg = og / nx;
            if (og + 1u == (tg + 1u) * nx) xb_add(&bar[XB_TOPGEN], 1u);
            else XB_SPIN(xb_ld(&bar[XB_TOPGEN]) == tg, bar);
            __builtin_amdgcn_fence(__ATOMIC_ACQUIRE, "agent");
            xb_add(&bar[XB_XGEN(b.x)], 1u);
            asm volatile("s_waitcnt vmcnt(0)" ::: "memory");
        } else {
            XB_SPIN(xb_ld(&bar[XB_XGEN(b.x)]) == gen, bar);
            __builtin_amdgcn_fence(__ATOMIC_ACQUIRE, "agent");
            asm volatile("s_waitcnt vmcnt(0)" ::: "memory");
        }
    }
    __syncthreads();
}

constexpr int NWAVES = 8;
constexpr int BATCH = 8, SEQ = 4096, T = BATCH * SEQ, D = 2048, NIN = 5120, NEXP = 32, NA = 2 * T;
constexpr float EPS = 1e-6f, LOG2E = 1.4426950408889634f, C2 = 0.125f * 1.4426950408889634f;
constexpr size_t MiB = 1u << 20;
constexpr size_t WS_CTL = 0, CTL_ZERO_BYTES = 1 * MiB;
constexpr size_t WS_RSTD1 = 1 * MiB, WS_RSTD2 = WS_RSTD1 + 128 * 1024, WS_WTS = WS_RSTD2 + 128 * 1024;
constexpr size_t WS_LIST = 2 * MiB;
constexpr size_t WS_PART = 6 * MiB;
constexpr size_t WS_WIN = 10 * MiB, WS_WOUT = 30 * MiB;
constexpr size_t WS_WGU = 38 * MiB, WS_WD = 166 * MiB;
constexpr size_t WS_XB = 230 * MiB;
constexpr size_t WS_CG = 358 * MiB;
constexpr size_t WS_MIX = 422 * MiB;
constexpr size_t WS_HB = 550 * MiB;
constexpr size_t WS_HB8 = 678 * MiB;
constexpr size_t WS_WR = 742 * MiB;
constexpr size_t WS_X8 = 743 * MiB;
constexpr size_t WS_WIN8 = 807 * MiB;
constexpr size_t WS_O1S = 811 * MiB;
constexpr size_t WS_LISTW = 827 * MiB, WS_LISTR = 831 * MiB;
constexpr size_t WS_END = 835 * MiB;
constexpr float WSCALE = 32.f, H1SCALE = 4.f, YSCALE = 8.f;
constexpr int CW_TMO = 0, CW_CODE = 1, CW_BAR = 4096, CW_CNT = 8192;
constexpr int CW_GQ = 20480;
constexpr int CW_H8Q = 24576 + 1024;
constexpr int CW_CVQ = 24576, CW_DONE = 24576 + 64;
constexpr int CW_QA = 12288, CW_QC = 12288 + 512, CW_NMAX = 16384;
constexpr int RING_OFF = 0, RING_BYTES = 131072, LDSCTL_OFF = RING_BYTES, MISC_OFF = LDSCTL_OFF + 320, TAB_OFF = LDSCTL_OFF + 1024;
constexpr int LDS_BYTES = 147456;
constexpr int NPHASE = 8;
#ifndef MK_ONE_LAUNCH
#define MK_ONE_LAUNCH 1
#endif
#ifndef PROBE_DOUBLE
#define PROBE_DOUBLE 0
#endif
#ifndef PROBE_CLOCK
#define PROBE_CLOCK 0
#endif
#ifndef USE_NAIVE_ROUTER
#define USE_NAIVE_ROUTER 0
#endif
#ifndef USE_NAIVE_ATTN
#define USE_NAIVE_ATTN 0
#endif


typedef unsigned u32x4g __attribute__((ext_vector_type(4)));
__device__ __forceinline__ float wave_sum(float v) {
#pragma unroll
    for (int o = 1; o < 64; o <<= 1) v += __shfl_xor(v, o);
    return v;
}
__device__ __forceinline__ float bflo(unsigned w) { return __builtin_bit_cast(float, w << 16); }
__device__ __forceinline__ float bfhi(unsigned w) { return __builtin_bit_cast(float, w & 0xffff0000u); }
__device__ __forceinline__ float fexp2(float x) { return __builtin_amdgcn_exp2f(x); }

__device__ __forceinline__ void tr_item(const float* W, int N, const float* gk, int k0, int n0, bf16* dst, int dstK, LAS float* scr, int lane) {
    const int kr = lane >> 3, n4 = 4 * (lane & 7); f32x4 v[8];
#pragma unroll
    for (int i = 0; i < 8; ++i) v[i] = *(const GAS f32x4*)(W + (size_t)(k0 + 8 * i + kr) * N + n0 + n4);
#pragma unroll
    for (int i = 0; i < 8; ++i) { const int kk = 8 * i + kr; const float g = gk ? gk[k0 + kk] : 1.0f;
        scr[(n4 + 0) * 66 + kk] = v[i].x * g; scr[(n4 + 1) * 66 + kk] = v[i].y * g; scr[(n4 + 2) * 66 + kk] = v[i].z * g; scr[(n4 + 3) * 66 + kk] = v[i].w * g; }
    LDS_WAIT(); asm volatile("" ::: "memory");
    const int c = lane & 7;
#pragma unroll
    for (int j = 0; j < 4; ++j) { const int n = (lane >> 3) + 8 * j; const LAS float* s = scr + n * 66 + 8 * c;
        v4u o; o.x = pk2(s[0], s[1]); o.y = pk2(s[2], s[3]); o.z = pk2(s[4], s[5]); o.w = pk2(s[6], s[7]);
        *(GAS v4u*)(dst + (size_t)n * dstK + 8 * c) = o; }
    LDS_WAIT(); asm volatile("" ::: "memory");
}
__device__ __forceinline__ void tr8_load(const float* W, int N, int k0, int n0, int lane, f32x4 (&v)[8]) {
    const int kr = lane >> 3, n4 = 4 * (lane & 7);
#pragma unroll
    for (int i = 0; i < 8; ++i) v[i] = *(const GAS f32x4*)(W + (size_t)(k0 + 8 * i + kr) * N + n0 + n4);
}
__device__ __forceinline__ void tr8_finish(const f32x4 (&v)[8], const float* gk, float scale, int k0, unsigned char* dst, int dstK, LAS float* scr, int lane) {
    const int kr = lane >> 3, n4 = 4 * (lane & 7);
#pragma unroll
    for (int i = 0; i < 8; ++i) { const int kk = 8 * i + kr; const float g = (gk ? gk[k0 + kk] : 1.0f) * scale;
        scr[(n4 + 0) * 66 + kk] = v[i].x * g; scr[(n4 + 1) * 66 + kk] = v[i].y * g; scr[(n4 + 2) * 66 + kk] = v[i].z * g; scr[(n4 + 3) * 66 + kk] = v[i].w * g; }
    LDS_WAIT(); asm volatile("" ::: "memory");
    const int c = lane & 7;
#pragma unroll
    for (int j = 0; j < 4; ++j) { const int n = (lane >> 3) + 8 * j; const LAS float* s = scr + n * 66 + 8 * c;
        pg8::u32x2 o; o.x = pg8::pk4_fp8(s[0], s[1], s[2], s[3]); o.y = pg8::pk4_fp8(s[4], s[5], s[6], s[7]);
        *(GAS pg8::u32x2*)(dst + (size_t)n * dstK + 8 * c) = o; }
    LDS_WAIT(); asm volatile("" ::: "memory");
}
__device__ __forceinline__ void tr_item8(const float* W, int N, const float* gk, float scale, int k0, int n0, unsigned char* dst, int dstK, LAS float* scr, int lane) {
    f32x4 v[8]; tr8_load(W, N, k0, n0, lane, v); tr8_finish(v, gk, scale, k0, dst, dstK, scr, lane);
}
struct Ptrs {
    const float *x, *g1, *w_in, *lq1, *lk1, *lq2, *lk2, *subg, *cw, *cb, *lng, *lnb, *w_out, *g2, *wgr, *bgr, *wer, *ber, *w_gate, *w_up, *w_down, *gf;
    float* out; unsigned char* ws;
};
__device__ __forceinline__ void p0_prologue(const Ptrs& P, LAS unsigned char* lds, int lane, int wave, int gw, int NGW) {
    LAS float* scr = (LAS float*)(lds + RING_OFF + wave * 16384);
    bf16* WIN = (bf16*)(P.ws + WS_WIN); bf16* WOUT = (bf16*)(P.ws + WS_WOUT);
    constexpr int I_IN = 32 * 160, I_OUT = 32 * 64, NITEMS = I_IN + I_OUT;
    for (int it = gw; it < NITEMS; it += NGW) {
        if (it < I_IN) { const int kb = it / 160, nb = it % 160;
            if (nb < 96) tr_item(P.w_in, NIN, P.g1, 64 * kb, 32 * nb, WIN + (size_t)(32 * nb) * 2048 + 64 * kb, 2048, scr, lane);
            else { const int j0 = 32 * (nb - 96), jj = j0 & 1023, drow = 256 * (jj >> 7) + (jj & 127) + (j0 >= 1024 ? 128 : 0);
                tr_item8(P.w_in, NIN, P.g1, WSCALE, 64 * kb, 32 * nb, P.ws + WS_WIN8 + (size_t)drow * 2048 + 64 * kb, 2048, scr, lane); } }
        else { const int r = it - I_IN, kb = r >> 6, nb = r & 63; tr_item(P.w_out, 2048, nullptr, 64 * kb, 32 * nb, WOUT + (size_t)(32 * nb) * 2048 + 64 * kb, 2048, scr, lane); }
    }
    { bf16* WR = (bf16*)(P.ws + WS_WR);
      for (int it = gw; it < 32; it += NGW) tr_item(P.wer, 32, P.g2, 64 * it, 0, WR + 64 * it, 2048, scr, lane);
      for (int k = gw * 64 + lane; k < 2048; k += NGW * 64) { const float gk = P.g2[k]; const f32x4 w = *(const f32x4*)(P.wgr + (size_t)k * 4);
          WR[(size_t)128 * 2048 + k] = (bf16)f2bf(w.x * gk); WR[(size_t)129 * 2048 + k] = (bf16)f2bf(w.y * gk); WR[(size_t)130 * 2048 + k] = (bf16)f2bf(w.z * gk); WR[(size_t)131 * 2048 + k] = (bf16)f2bf(w.w * gk); } }
    bf16* XB = (bf16*)(P.ws + WS_XB); float* RS1 = (float*)(P.ws + WS_RSTD1);
    for (int m0 = gw; m0 < T; m0 += 2 * NGW) {
        f32x4 v[2][8]; float ss[2] = {0.f, 0.f};
#pragma unroll
        for (int q = 0; q < 2; ++q) { const int mr = (m0 + q * NGW < T) ? m0 + q * NGW : T - 1; const GAS f32x4* xr = (const GAS f32x4*)(P.x + (size_t)mr * D) + lane;
#pragma unroll
            for (int j = 0; j < 8; ++j) v[q][j] = xr[64 * j]; }
#pragma unroll
        for (int q = 0; q < 2; ++q) { const int m = m0 + q * NGW; if (m >= T) continue;
#pragma unroll
            for (int j = 0; j < 8; ++j) ss[q] += (v[q][j].x * v[q][j].x + v[q][j].y * v[q][j].y) + (v[q][j].z * v[q][j].z + v[q][j].w * v[q][j].w);
            ss[q] = wave_sum(ss[q]);
            if (lane == 0) RS1[m] = 1.0f / sqrtf(ss[q] * (1.0f / D) + EPS);
            GAS unsigned long long* o8 = (GAS unsigned long long*)(XB + (size_t)m * D) + lane; GAS unsigned* o4 = (GAS unsigned*)(P.ws + WS_X8 + (size_t)m * D) + lane;
#pragma unroll
            for (int j = 0; j < 8; ++j) { o8[64 * j] = (unsigned long long)pk2(v[q][j].x, v[q][j].y) | ((unsigned long long)pk2(v[q][j].z, v[q][j].w) << 32); o4[64 * j] = pg8::pk4_fp8(v[q][j].x, v[q][j].y, v[q][j].z, v[q][j].w); } }
    }
}

constexpr int CVT_ITEMS = 3 * 32768, CVT_CH = 4, CVT_CHUNK = CVT_CH * NWAVES, CVT_NCHUNK = CVT_ITEMS / CVT_CHUNK;
struct MoeItem { const float* src; const float* gk; unsigned char* dst; int N, k0, n0, dstK; };
__device__ __forceinline__ MoeItem moe_decode(const Ptrs& P, int r) {
    unsigned char* WGU = P.ws + WS_WGU; unsigned char* WD = P.ws + WS_WD; MoeItem m;
    const int mat = r >> 15, r2 = r & 32767, e = r2 >> 10, idx = r2 & 1023;
    if (mat < 2) { const int kb = idx >> 5, n0 = 32 * (idx & 31); const int drow = e * 2048 + 256 * (n0 >> 7) + (n0 & 127) + (mat == 1 ? 128 : 0);
        m.src = (mat == 0 ? P.w_gate : P.w_up) + (size_t)e * 2048 * 1024; m.N = 1024; m.gk = P.g2; m.k0 = 64 * kb; m.n0 = n0; m.dst = WGU + (size_t)drow * 2048 + 64 * kb; m.dstK = 2048; }
    else { const int kb = idx >> 6, nb = idx & 63; m.src = P.w_down + (size_t)e * 1024 * 2048; m.N = 2048; m.gk = nullptr; m.k0 = 64 * kb; m.n0 = 32 * nb; m.dst = WD + ((size_t)e * 2048 + 32 * nb) * 1024 + 64 * kb; m.dstK = 1024; }
    return m;
}
__device__ __forceinline__ void cvt_fill(const Ptrs& P, LAS unsigned char* lds, volatile LAS unsigned* slot, int max_chunks, const unsigned* donew, int G) {
    int tid_ = threadIdx.x; asm volatile("" : "+v"(tid_)); const int lane = tid_ & 63, wave = __builtin_amdgcn_readfirstlane(tid_ >> 6);
    LAS float* scr = (LAS float*)(lds + RING_OFF + wave * 16384); unsigned* ctr = (unsigned*)(P.ws + WS_CTL) + CW_CVQ;
    for (int n = 0; n < max_chunks; ++n) {
        if (threadIdx.x == 0) { unsigned v = 0xffffffffu;
            if (!(donew && (int)__hip_atomic_load(donew, __ATOMIC_RELAXED, __HIP_MEMORY_SCOPE_AGENT) >= G - 16)) v = __hip_atomic_fetch_add(ctr, 1u, __ATOMIC_RELAXED, __HIP_MEMORY_SCOPE_AGENT);
            *slot = v; }
        __syncthreads(); const unsigned c = *slot; __syncthreads();
        if (c >= (unsigned)CVT_NCHUNK) break;
#pragma unroll 1
        for (int j = 0; j < CVT_CH; j += 2) {
            const MoeItem m0 = moe_decode(P, (int)c * CVT_CHUNK + wave * CVT_CH + j), m1 = moe_decode(P, (int)c * CVT_CHUNK + wave * CVT_CH + j + 1);
            f32x4 v0[8], v1[8]; tr8_load(m0.src, m0.N, m0.k0, m0.n0, lane, v0); tr8_load(m1.src, m1.N, m1.k0, m1.n0, lane, v1);
            tr8_finish(v0, m0.gk, WSCALE, m0.k0, m0.dst, m0.dstK, scr, lane); tr8_finish(v1, m1.gk, WSCALE, m1.k0, m1.dst, m1.dstK, scr, lane); }
    }
}
__device__ __forceinline__ void h8_fill(const Ptrs& P, const bf16* HB, unsigned char* H8, volatile LAS unsigned* slot) {
    int tid_ = threadIdx.x; asm volatile("" : "+v"(tid_)); const int lane = tid_ & 63, wave = __builtin_amdgcn_readfirstlane(tid_ >> 6);
    unsigned* ctr = (unsigned*)(P.ws + WS_CTL) + CW_H8Q;
    for (;;) { const int c = attn_body::wg_pop(ctr, slot); if (c >= T / 64) break;
#pragma unroll 1
        for (int j = 0; j < 8; j += 4) { const int r0 = c * 64 + wave * 8 + j; u32x4g a[4][4];
#pragma unroll
            for (int q = 0; q < 4; ++q)
#pragma unroll
                for (int i = 0; i < 4; ++i) a[q][i] = *(const u32x4g*)(HB + (size_t)(r0 + q) * D + 16 * lane + 1024 * (i >> 1) + 8 * (i & 1));
#pragma unroll
            for (int q = 0; q < 4; ++q)
#pragma unroll
                for (int hj = 0; hj < 2; ++hj) { const u32x4g w0 = a[q][2 * hj], w1 = a[q][2 * hj + 1]; v4u o;
                    o.x = pg8::pk4_fp8(bflo(w0.x), bfhi(w0.x), bflo(w0.y), bfhi(w0.y)); o.y = pg8::pk4_fp8(bflo(w0.z), bfhi(w0.z), bflo(w0.w), bfhi(w0.w));
                    o.z = pg8::pk4_fp8(bflo(w1.x), bfhi(w1.x), bflo(w1.y), bfhi(w1.y)); o.w = pg8::pk4_fp8(bflo(w1.z), bfhi(w1.z), bflo(w1.w), bfhi(w1.w));
                    *(v4u*)(H8 + (size_t)(r0 + q) * D + 16 * lane + 1024 * hj) = o; } }
    }
}
__device__ __forceinline__ void router_skinny(const Ptrs& P, const bf16* HB, unsigned char* H8, LAS unsigned char* lds, int G) {
    int tid_ = threadIdx.x; asm volatile("" : "+v"(tid_)); const int tid = tid_, lane = tid & 63, wave = __builtin_amdgcn_readfirstlane(tid >> 6), fr = lane & 15, fq = lane >> 4;
    constexpr int BROW = 1040, BBUF = 48 * BROW;
    const bf16* WR = (const bf16*)(P.ws + WS_WR);
    LAS unsigned char* Bb = lds + RING_OFF; LAS float* LX = (LAS float*)(lds + RING_OFF + 2 * BBUF) + wave * (16 * 37);
    LAS unsigned* cntL = (LAS unsigned*)(lds + RING_OFF + 2 * BBUF + 8 * 16 * 37 * 4); LAS unsigned* baseL = cntL + 32;
    const float* part = (const float*)(P.ws + WS_PART); float* listr = (float*)(P.ws + WS_LISTR); float* listw = (float*)(P.ws + WS_LISTW); int* list = (int*)(P.ws + WS_LIST);
    unsigned* cnt = (unsigned*)(P.ws + WS_CTL) + CW_CNT;
    int brow[6], bcol[6];
#pragma unroll
    for (int i = 0; i < 6; ++i) { const int pc = tid + 512 * i; brow[i] = pc >> 6; bcol[i] = pc & 63; }
    for (int u = blockIdx.x; u < T / 128; u += G) {
        const int r0 = u * 128 + wave * 16;
        const bf16* arow = HB + (size_t)(r0 + fr) * D + 16 * fq;
        unsigned char* orow = H8 + (size_t)(r0 + fr) * D + 16 * fq;
        u32x4g bs[6], a[2][16]; pg8::f32x4 acc[3];
#pragma unroll
        for (int nb = 0; nb < 3; ++nb) acc[nb] = (pg8::f32x4){0.f, 0.f, 0.f, 0.f};
#define RS_LOADB(c) do { _Pragma("unroll") for (int i = 0; i < 6; ++i) { const int sr = brow[i] < 32 ? brow[i] : 128 + ((brow[i] - 32) & 3); \
            bs[i] = *(const u32x4g*)(WR + (size_t)sr * D + 512 * (c) + 8 * bcol[i]); } } while (0)
#define RS_STOREB(c) do { _Pragma("unroll") for (int i = 0; i < 6; ++i) *(LAS u32x4g*)(Bb + ((c) & 1) * BBUF + brow[i] * BROW + bcol[i] * 16) = bs[i]; } while (0)
#define RS_LOADA(c) do { _Pragma("unroll") for (int s = 0; s < 16; ++s) a[(c) & 1][s] = *(const u32x4g*)(arow + 512 * (c) + 64 * (s >> 1) + 8 * (s & 1)); } while (0)
        RS_LOADB(0); RS_LOADA(0); RS_STOREB(0);
#pragma unroll
        for (int c = 0; c < 4; ++c) {
            __syncthreads();
            if (c < 3) { RS_LOADB(c + 1); RS_LOADA(c + 1); }
#pragma unroll
            for (int s = 0; s < 16; ++s) {
                const pg8::bf16x8 af = __builtin_bit_cast(pg8::bf16x8, a[c & 1][s]);
#pragma unroll
                for (int nb = 0; nb < 3; ++nb) {
                    const pg8::bf16x8 bf = *(const LAS pg8::bf16x8*)(Bb + (c & 1) * BBUF + (16 * nb + fr) * BROW + (64 * (s >> 1) + 16 * fq + 8 * (s & 1)) * 2);
                    acc[nb] = __builtin_amdgcn_mfma_f32_16x16x32_bf16(af, bf, acc[nb], 0, 0, 0); }
            }
            if (c < 3) RS_STOREB(c + 1);
#pragma unroll
            for (int s = 0; s < 16; s += 2) { const u32x4g w0 = a[c & 1][s], w1 = a[c & 1][s + 1]; v4u o;
                o.x = pg8::pk4_fp8(bflo(w0.x), bfhi(w0.x), bflo(w0.y), bfhi(w0.y)); o.y = pg8::pk4_fp8(bflo(w0.z), bfhi(w0.z), bflo(w0.w), bfhi(w0.w));
                o.z = pg8::pk4_fp8(bflo(w1.x), bfhi(w1.x), bflo(w1.y), bfhi(w1.y)); o.w = pg8::pk4_fp8(bflo(w1.z), bfhi(w1.z), bflo(w1.w), bfhi(w1.w));
                *(v4u*)(orow + 512 * c + 64 * (s >> 1)) = o; }
        }
#undef RS_LOADB
#undef RS_STOREB
#undef RS_LOADA
#pragma unroll
        for (int nb = 0; nb < 3; ++nb)
#pragma unroll
            for (int r = 0; r < 4; ++r) if (nb < 2 || fr < 4) LX[(4 * fq + r) * 37 + 16 * nb + fr] = acc[nb][r];
        if (tid < 32) cntL[tid] = 0u;
        __syncthreads();
        int ea = 0, eb = 0, row = 0; unsigned ra = 0u, rb = 0u; float w1 = 0.f, w2 = 0.f, rstd = 0.f;
        if (lane < 16) { row = r0 + lane; const LAS float* lx = LX + lane * 37;
            float sq[4];
#pragma unroll
            for (int q = 0; q < 4; ++q) { const pg8::f32x4 p0 = *(const pg8::f32x4*)(part + (size_t)row * 32 + 8 * q), p1 = *(const pg8::f32x4*)(part + (size_t)row * 32 + 8 * q + 4);
                sq[q] = ((p0[0] + p0[1]) + (p0[2] + p0[3])) + ((p1[0] + p1[1]) + (p1[2] + p1[3])); }
            const float ss = (sq[0] + sq[1]) + (sq[2] + sq[3]);
            rstd = 1.0f / sqrtf(ss * (1.0f / 2048.0f) + 1e-6f);
            float g[4];
#pragma unroll
            for (int i = 0; i < 4; ++i) g[i] = lx[32 + i] * rstd + P.bgr[i];
            int gs = 0; float gm = g[0];
#pragma unroll
            for (int i = 1; i < 4; ++i) if (g[i] > gm) { gm = g[i]; gs = i; }
            float gsum = 0.f;
#pragma unroll
            for (int i = 0; i < 4; ++i) gsum += __expf(g[i] - gm);
            const float gw = 1.0f / gsum;
            float ev[8];
#pragma unroll
            for (int i = 0; i < 8; ++i) ev[i] = lx[8 * gs + i] * rstd + P.ber[8 * gs + i];
            int i1 = 0; float v1 = ev[0];
#pragma unroll
            for (int i = 1; i < 8; ++i) if (ev[i] > v1) { v1 = ev[i]; i1 = i; }
            int i2 = -1; float v2 = -3.0e38f;
#pragma unroll
            for (int i = 0; i < 8; ++i) if (i != i1 && ev[i] > v2) { v2 = ev[i]; i2 = i; }
            const float e2 = __expf(v2 - v1); w1 = gw / (1.f + e2); w2 = gw * e2 / (1.f + e2);
            ea = gs * 8 + i1; eb = gs * 8 + i2;
            ra = __hip_atomic_fetch_add(cntL + ea, 1u, __ATOMIC_RELAXED, __HIP_MEMORY_SCOPE_WORKGROUP);
            rb = __hip_atomic_fetch_add(cntL + eb, 1u, __ATOMIC_RELAXED, __HIP_MEMORY_SCOPE_WORKGROUP); }
        __syncthreads();
        if (tid < 32) { const unsigned n = cntL[tid]; baseL[tid] = n ? __hip_atomic_fetch_add(cnt + 64 * tid, n, __ATOMIC_RELAXED, __HIP_MEMORY_SCOPE_AGENT) : 0u; }
        __syncthreads();
        if (lane < 16) { const size_t ia = (size_t)ea * T + baseL[ea] + ra, ib = (size_t)eb * T + baseL[eb] + rb;
            list[ia] = 2 * row; list[ib] = 2 * row + 1; listw[ia] = w1; listw[ib] = w2; listr[ia] = rstd; listr[ib] = rstd; }
    }
    __syncthreads();
}
__device__ __forceinline__ void phase_tail(const Ptrs& P, LAS unsigned char* lds, volatile LAS unsigned* slot, int ph, int G) {
    unsigned* donew = (unsigned*)(P.ws + WS_CTL) + CW_DONE + 64 * ph;
    __syncthreads();
    if (threadIdx.x == 0) { const unsigned old = __hip_atomic_fetch_add(donew, 1u, __ATOMIC_RELAXED, __HIP_MEMORY_SCOPE_AGENT); *slot = (int)(old + 1u) >= G - 16 ? 1u : 0u; }
    __syncthreads(); const unsigned late = *slot; __syncthreads();
    if (late) return;
    cvt_fill(P, lds, slot, 1 << 30, donew, G);
}

__device__ __forceinline__ void naive_attn(const Ptrs& P, const bf16* Q, const bf16* Kb, const bf16* Vb, bf16* MIX, int lane, int gw, int NGW) {
    const float s1 = wave_sum(P.lq1[lane] * P.lk1[lane]), s2 = wave_sum(P.lq2[lane] * P.lk2[lane]);
    const float lam0 = 0.2f, lam = expf(s1) - expf(s2) + lam0;
    const int r16 = lane & 15, c = (lane >> 4) & 1, vh = lane >> 5;
    for (int u = gw; u < 16384; u += NGW) {
        const int bh = u & 63, qb = 255 - (u >> 6), b = bh >> 3, h = bh & 7, i = qb * 16 + r16, jmax = qb * 16 + 15;
        const float sl2 = exp2f(-(float)(h + 1)) * LOG2E; const size_t rowb = (size_t)b * SEQ;
        float q[64], O[64];
        { const u32x4g* qp = (const u32x4g*)(Q + (rowb + i) * 1024 + h * 128 + c * 64);
#pragma unroll
          for (int d8 = 0; d8 < 8; ++d8) { const u32x4g w = qp[d8]; q[8 * d8 + 0] = bflo(w.x); q[8 * d8 + 1] = bfhi(w.x); q[8 * d8 + 2] = bflo(w.y); q[8 * d8 + 3] = bfhi(w.y);
              q[8 * d8 + 4] = bflo(w.z); q[8 * d8 + 5] = bfhi(w.z); q[8 * d8 + 6] = bflo(w.w); q[8 * d8 + 7] = bfhi(w.w); } }
#pragma unroll
        for (int d = 0; d < 64; ++d) O[d] = 0.f;
        float m = -1e30f, l = 0.f;
        for (int j = 0; j <= jmax; ++j) {
            const u32x4g* kp = (const u32x4g*)(Kb + (rowb + j) * 1024 + h * 128 + c * 64); float s = 0.f;
#pragma unroll
            for (int d8 = 0; d8 < 8; ++d8) { const u32x4g w = kp[d8];
                s += q[8 * d8 + 0] * bflo(w.x) + q[8 * d8 + 1] * bfhi(w.x) + q[8 * d8 + 2] * bflo(w.y) + q[8 * d8 + 3] * bfhi(w.y)
                   + q[8 * d8 + 4] * bflo(w.z) + q[8 * d8 + 5] * bfhi(w.z) + q[8 * d8 + 6] * bflo(w.w) + q[8 * d8 + 7] * bfhi(w.w); }
            s += sl2 * (float)(j - i);
            if (j <= i) {
                if (s > m) { const float al = fexp2(m - s); l *= al;
#pragma unroll
                    for (int d = 0; d < 64; ++d) O[d] *= al;
                    m = s; }
                const float p = fexp2(s - m); l += p;
                const u32x4g* vp = (const u32x4g*)(Vb + (rowb + j) * 1024 + h * 128 + vh * 64);
#pragma unroll
                for (int d8 = 0; d8 < 8; ++d8) { const u32x4g w = vp[d8];
                    O[8 * d8 + 0] += p * bflo(w.x); O[8 * d8 + 1] += p * bfhi(w.x); O[8 * d8 + 2] += p * bflo(w.y); O[8 * d8 + 3] += p * bfhi(w.y);
                    O[8 * d8 + 4] += p * bflo(w.z); O[8 * d8 + 5] += p * bfhi(w.z); O[8 * d8 + 6] += p * bflo(w.w); O[8 * d8 + 7] += p * bfhi(w.w); }
            }
        }
        const float il = 1.0f / l; float ss = 0.f;
#pragma unroll
        for (int d = 0; d < 64; ++d) { float o = O[d] * il; const float o2 = __shfl_xor(o, 16); o = o - lam * o2; O[d] = o; ss += o * o; }
        ss += __shfl_xor(ss, 32);
        const float r = (1.0f / sqrtf(ss * (1.0f / 128.0f) + EPS)) * (1.0f - lam0);
        if (c == 0) { u32x4g* op = (u32x4g*)(MIX + (rowb + i) * 2048 + h * 128 + vh * 64); const float* sg = P.subg + vh * 64;
#pragma unroll
            for (int d8 = 0; d8 < 8; ++d8) { u32x4g w; w.x = pk2(O[8 * d8 + 0] * r * sg[8 * d8 + 0], O[8 * d8 + 1] * r * sg[8 * d8 + 1]); w.y = pk2(O[8 * d8 + 2] * r * sg[8 * d8 + 2], O[8 * d8 + 3] * r * sg[8 * d8 + 3]);
                w.z = pk2(O[8 * d8 + 4] * r * sg[8 * d8 + 4], O[8 * d8 + 5] * r * sg[8 * d8 + 5]); w.w = pk2(O[8 * d8 + 6] * r * sg[8 * d8 + 6], O[8 * d8 + 7] * r * sg[8 * d8 + 7]); op[d8] = w; } }
    }
}

typedef float f32x2c __attribute__((ext_vector_type(2)));
__device__ __forceinline__ void conv_phase(const Ptrs& P, const bf16* CA, bf16* MIX, LAS unsigned char* lds, int blk, unsigned* qctr, volatile LAS unsigned* slot) {
    int tid_ = threadIdx.x; asm volatile("" : "+v"(tid_)); const int tid = tid_, lane = tid & 63, wave = __builtin_amdgcn_readfirstlane(tid >> 6);
    LAS unsigned* C = (LAS unsigned*)(lds + RING_OFF);
    f32x2c w[31];
#pragma unroll
    for (int j = 0; j < 31; ++j) w[j] = *(const f32x2c*)(P.cw + j * 1024 + 2 * tid);
    const f32x2c bias = *(const f32x2c*)(P.cb + 2 * tid);
    for (int qi = 0; qi < 8; ++qi) { const int xq = (blk + qi) & 7;
    for (;;) { const int n_ = attn_body::wg_pop(qctr + 64 * xq, slot); if (n_ >= 64) break;
        const int tile = xq + 8 * n_, b = tile >> 6, t0 = (tile & 63) * 64; const size_t rowb = (size_t)b * SEQ;
        const unsigned* up = (const unsigned*)(CA + rowb * 1024 + 2 * tid);
        f32x2c win[38]; unsigned hist[30];
#pragma unroll
        for (int k = 0; k < 30; ++k) { const int t = t0 - 30 + k; hist[k] = (t >= 0) ? up[(size_t)t * 512] : 0u; }
        unsigned nw[8];
#pragma unroll
        for (int i = 0; i < 8; ++i) nw[i] = up[(size_t)(t0 + i) * 512];
#pragma unroll
        for (int k = 0; k < 30; ++k) win[k] = (f32x2c){bflo(hist[k]), bfhi(hist[k])};
#pragma unroll 1
        for (int blk8 = 0; blk8 < 8; ++blk8) {
#pragma unroll
            for (int i = 0; i < 8; ++i) win[30 + i] = (f32x2c){bflo(nw[i]), bfhi(nw[i])};
            if (blk8 < 7) {
#pragma unroll
                for (int i = 0; i < 8; ++i) nw[i] = up[(size_t)(t0 + 8 * (blk8 + 1) + i) * 512];
            }
#pragma unroll
            for (int i = 0; i < 8; ++i) { f32x2c acc = bias;
#pragma unroll
                for (int j = 0; j < 31; ++j) acc = w[j] * win[i + j] + acc;
                C[(8 * blk8 + i) * 512 + tid] = pk2(acc.x, acc.y); }
#pragma unroll
            for (int k = 0; k < 30; ++k) win[k] = win[k + 8];
        }
        __syncthreads();
#pragma unroll 1
        for (int k = 0; k < 8; ++k) { const int rr = wave + 8 * k, t = t0 + rr; const LAS unsigned* row = C + rr * 512;
            const v4u x0 = *(const LAS v4u*)(row + 4 * lane), x1 = *(const LAS v4u*)(row + 256 + 4 * lane);
            float v[16] = {bflo(x0.x), bfhi(x0.x), bflo(x0.y), bfhi(x0.y), bflo(x0.z), bfhi(x0.z), bflo(x0.w), bfhi(x0.w), bflo(x1.x), bfhi(x1.x), bflo(x1.y), bfhi(x1.y), bflo(x1.z), bfhi(x1.z), bflo(x1.w), bfhi(x1.w)};
            float s = 0.f;
#pragma unroll
            for (int i = 0; i < 16; ++i) s += v[i];
            const float mean = wave_sum(s) * (1.0f / 1024.0f); float qq = 0.f;
#pragma unroll
            for (int i = 0; i < 16; ++i) { v[i] -= mean; qq += v[i] * v[i]; }
            const float rstd = 1.0f / sqrtf(wave_sum(qq) * (1.0f / 1024.0f) + EPS);
            float y[16];
#pragma unroll
            for (int i = 0; i < 16; ++i) { const int ch = (i < 8 ? 8 * lane + i : 512 + 8 * lane + (i - 8)); const float z = v[i] * rstd * P.lng[ch] + P.lnb[ch]; y[i] = z / (1.f + __expf(-z)); }
            bf16* op = MIX + (rowb + t) * 2048 + 1024 + 8 * lane;
            v4u o0, o1; o0.x = pk2(y[0], y[1]); o0.y = pk2(y[2], y[3]); o0.z = pk2(y[4], y[5]); o0.w = pk2(y[6], y[7]); o1.x = pk2(y[8], y[9]); o1.y = pk2(y[10], y[11]); o1.z = pk2(y[12], y[13]); o1.w = pk2(y[14], y[15]);
            *(GAS v4u*)op = o0; *(GAS v4u*)(op + 512) = o1; }
        __syncthreads();
    } }
}

__device__ __forceinline__ void router_phase(const Ptrs& P, const bf16* HB, int lane, int gw, int NGW) {
    float* RS2 = (float*)(P.ws + WS_RSTD2); float* WTS = (float*)(P.ws + WS_WTS); int* LIST = (int*)(P.ws + WS_LIST); unsigned* CNT = (unsigned*)(P.ws + WS_CTL) + CW_CNT;
    for (int tok = gw; tok < T; tok += NGW) {
        float hv[32]; const bf16* hp = HB + (size_t)tok * D; float ss = 0.f;
#pragma unroll
        for (int j = 0; j < 4; ++j) { const u32x4g w = *(const u32x4g*)(hp + 8 * lane + 512 * j);
            hv[8 * j + 0] = bflo(w.x); hv[8 * j + 1] = bfhi(w.x); hv[8 * j + 2] = bflo(w.y); hv[8 * j + 3] = bfhi(w.y); hv[8 * j + 4] = bflo(w.z); hv[8 * j + 5] = bfhi(w.z); hv[8 * j + 6] = bflo(w.w); hv[8 * j + 7] = bfhi(w.w); }
#pragma unroll
        for (int k = 0; k < 32; ++k) ss += hv[k] * hv[k];
        ss = wave_sum(ss); const float rstd = 1.0f / sqrtf(ss * (1.0f / D) + EPS);
        float lg[36];
#pragma unroll
        for (int o = 0; o < 36; ++o) lg[o] = 0.f;
#pragma unroll
        for (int j = 0; j < 4; ++j)
#pragma unroll 2
            for (int i = 0; i < 8; ++i) { const int e = 8 * lane + 512 * j + i; const float xv = hv[8 * j + i] * P.g2[e];
                const f32x4* wr = (const f32x4*)(P.wer + (size_t)e * 32); const f32x4 wg = *(const f32x4*)(P.wgr + (size_t)e * 4);
#pragma unroll
                for (int o4 = 0; o4 < 8; ++o4) { const f32x4 w = wr[o4]; lg[4 * o4 + 0] += xv * w.x; lg[4 * o4 + 1] += xv * w.y; lg[4 * o4 + 2] += xv * w.z; lg[4 * o4 + 3] += xv * w.w; }
                lg[32] += xv * wg.x; lg[33] += xv * wg.y; lg[34] += xv * wg.z; lg[35] += xv * wg.w; }
#pragma unroll
        for (int o = 0; o < 36; ++o) lg[o] = wave_sum(lg[o]) * rstd + (o < 32 ? P.ber[o] : P.bgr[o - 32]);
        int gs = 0; float gm = lg[32];
#pragma unroll
        for (int g = 1; g < 4; ++g) if (lg[32 + g] > gm) { gm = lg[32 + g]; gs = g; }
        float gsum = 0.f;
#pragma unroll
        for (int g = 0; g < 4; ++g) gsum += __expf(lg[32 + g] - gm);
        const float gw_ = 1.0f / gsum;
        float ev[8];
#pragma unroll
        for (int i = 0; i < 8; ++i) ev[i] = gs == 0 ? lg[i] : gs == 1 ? lg[8 + i] : gs == 2 ? lg[16 + i] : lg[24 + i];
        int i1 = 0; float v1 = ev[0];
#pragma unroll
        for (int i = 1; i < 8; ++i) if (ev[i] > v1) { v1 = ev[i]; i1 = i; }
        int i2 = -1; float v2 = -3.0e38f;
#pragma unroll
        for (int i = 0; i < 8; ++i) if (i != i1 && ev[i] > v2) { v2 = ev[i]; i2 = i; }
        const float e2 = __expf(v2 - v1), w1 = gw_ / (1.f + e2), w2 = gw_ * e2 / (1.f + e2);
        if (lane == 0) {
            RS2[tok] = rstd;
            const int ea = gs * 8 + i1, eb = gs * 8 + i2;
            const unsigned ra = __hip_atomic_fetch_add(CNT + 64 * ea, 1u, __ATOMIC_RELAXED, __HIP_MEMORY_SCOPE_AGENT);
            const unsigned rb = __hip_atomic_fetch_add(CNT + 64 * eb, 1u, __ATOMIC_RELAXED, __HIP_MEMORY_SCOPE_AGENT);
            LIST[(size_t)ea * T + ra] = 2 * tok; LIST[(size_t)eb * T + rb] = 2 * tok + 1; WTS[2 * tok] = w1; WTS[2 * tok + 1] = w2;
        }
    }
}
__device__ __forceinline__ void moe_tables(const Ptrs& P, LAS unsigned char* lds) {
    int tid = threadIdx.x; asm volatile("" : "+v"(tid));
    LAS int* cntL = (LAS int*)(lds + TAB_OFF); LAS int* ts = cntL + 32; unsigned* CNT = (unsigned*)(P.ws + WS_CTL) + CW_CNT;
    if (tid < 32) cntL[tid] = (int)__hip_atomic_load(CNT + 64 * tid, __ATOMIC_RELAXED, __HIP_MEMORY_SCOPE_AGENT);
    __syncthreads();
    if (tid == 0) { int s = 0; for (int e = 0; e < 32; ++e) { ts[e] = s; s += (cntL[e] + 255) >> 8; } ts[32] = s; }
    __syncthreads();
}

__device__ __forceinline__ float fp8f(unsigned w, int i) { return i == 0 ? __builtin_amdgcn_cvt_f32_fp8(w, 0) : i == 1 ? __builtin_amdgcn_cvt_f32_fp8(w, 1) : i == 2 ? __builtin_amdgcn_cvt_f32_fp8(w, 2) : __builtin_amdgcn_cvt_f32_fp8(w, 3); }
__device__ __forceinline__ void final_phase(const Ptrs& P, const bf16* HB, const unsigned char* Y8, int NGW) {
    int tid_ = threadIdx.x; asm volatile("" : "+v"(tid_)); const int lane = tid_ & 63, gw = (int)blockIdx.x * NWAVES + __builtin_amdgcn_readfirstlane(tid_ >> 6);
    for (int tok = gw; tok < T; tok += NGW) {
        const bf16* hp = HB + (size_t)tok * D; const unsigned char* y1 = Y8 + (size_t)tok * 4096; const unsigned char* y2 = y1 + 2048; float v[32]; float ss = 0.f;
#pragma unroll
        for (int j = 0; j < 4; ++j) { const int o = 8 * lane + 512 * j; const u32x4g a = *(const u32x4g*)(hp + o); const pg8::u32x2 b = *(const pg8::u32x2*)(y1 + o), c = *(const pg8::u32x2*)(y2 + o);
            const float ys = 1.0f / YSCALE;
            v[8 * j + 0] = bflo(a.x) + (fp8f(b.x, 0) + fp8f(c.x, 0)) * ys; v[8 * j + 1] = bfhi(a.x) + (fp8f(b.x, 1) + fp8f(c.x, 1)) * ys; v[8 * j + 2] = bflo(a.y) + (fp8f(b.x, 2) + fp8f(c.x, 2)) * ys; v[8 * j + 3] = bfhi(a.y) + (fp8f(b.x, 3) + fp8f(c.x, 3)) * ys;
            v[8 * j + 4] = bflo(a.z) + (fp8f(b.y, 0) + fp8f(c.y, 0)) * ys; v[8 * j + 5] = bfhi(a.z) + (fp8f(b.y, 1) + fp8f(c.y, 1)) * ys; v[8 * j + 6] = bflo(a.w) + (fp8f(b.y, 2) + fp8f(c.y, 2)) * ys; v[8 * j + 7] = bfhi(a.w) + (fp8f(b.y, 3) + fp8f(c.y, 3)) * ys; }
#pragma unroll
        for (int k = 0; k < 32; ++k) ss += v[k] * v[k];
        ss = wave_sum(ss); const float rstd = 1.0f / sqrtf(ss * (1.0f / D) + EPS);
        float* op = P.out + (size_t)tok * D;
#pragma unroll
        for (int j = 0; j < 4; ++j) { const int o = 8 * lane + 512 * j; const f32x4 g0 = *(const f32x4*)(P.gf + o), g1 = *(const f32x4*)(P.gf + o + 4);
            f32x4 r0 = {v[8 * j + 0] * rstd * g0.x, v[8 * j + 1] * rstd * g0.y, v[8 * j + 2] * rstd * g0.z, v[8 * j + 3] * rstd * g0.w};
            f32x4 r1 = {v[8 * j + 4] * rstd * g1.x, v[8 * j + 5] * rstd * g1.y, v[8 * j + 6] * rstd * g1.z, v[8 * j + 7] * rstd * g1.w};
            *(f32x4*)(op + o) = r0; *(f32x4*)(op + o + 4) = r1; }
    }
}

struct Args { const float* in[22]; float* out; unsigned char* ws; int ph_lo, ph_hi; };
__global__ void __launch_bounds__(NWAVES * 64, 2) fwd(Args args) {
    extern __shared__ __attribute__((aligned(16))) unsigned char lds_raw[];
    LAS unsigned char* lds = (LAS unsigned char*)lds_raw;
    volatile LAS unsigned* MISC = (volatile LAS unsigned*)(lds + MISC_OFF);
    const int tid = threadIdx.x, lane = tid & 63, wave = __builtin_amdgcn_readfirstlane(tid >> 6), G = gridDim.x;
    const int gw = blockIdx.x * NWAVES + wave, NGW = G * NWAVES;
    Ptrs P;
    P.x = args.in[0]; P.g1 = args.in[1]; P.w_in = args.in[2]; P.lq1 = args.in[3]; P.lk1 = args.in[4]; P.lq2 = args.in[5]; P.lk2 = args.in[6]; P.subg = args.in[7];
    P.cw = args.in[8]; P.cb = args.in[9]; P.lng = args.in[10]; P.lnb = args.in[11]; P.w_out = args.in[12]; P.g2 = args.in[13]; P.wgr = args.in[14]; P.bgr = args.in[15];
    P.wer = args.in[16]; P.ber = args.in[17]; P.w_gate = args.in[18]; P.w_up = args.in[19]; P.w_down = args.in[20]; P.gf = args.in[21]; P.out = args.out; P.ws = args.ws;
    unsigned char* ws = args.ws;
#define WIN ((bf16*)(ws + WS_WIN))
#define WOUT ((bf16*)(ws + WS_WOUT))
#define WGU (ws + WS_WGU)
#define WD (ws + WS_WD)
#define XB ((bf16*)(ws + WS_XB))
#define H1 (ws + WS_XB)
#define HB8 (ws + WS_HB8)
#define CGB ((bf16*)(ws + WS_CG))
#define MIX ((bf16*)(ws + WS_MIX))
#define HB ((bf16*)(ws + WS_HB))
#define QB ((bf16*)P.out)
#define KB (QB + (size_t)T * 1024)
#define VB (QB + (size_t)T * 2048)
#define CAB (QB + (size_t)T * 3072)
#define YB ((bf16*)P.out)
#define RELOAD_ARGS() do { const __attribute__((address_space(4))) Args* ka_ = (const __attribute__((address_space(4))) Args*)__builtin_amdgcn_kernarg_segment_ptr(); asm volatile("" : "+s"(ka_)); \
    P.x = ka_->in[0]; P.g1 = ka_->in[1]; P.w_in = ka_->in[2]; P.lq1 = ka_->in[3]; P.lk1 = ka_->in[4]; P.lq2 = ka_->in[5]; P.lk2 = ka_->in[6]; P.subg = ka_->in[7]; \
    P.cw = ka_->in[8]; P.cb = ka_->in[9]; P.lng = ka_->in[10]; P.lnb = ka_->in[11]; P.w_out = ka_->in[12]; P.g2 = ka_->in[13]; P.wgr = ka_->in[14]; P.bgr = ka_->in[15]; \
    P.wer = ka_->in[16]; P.ber = ka_->in[17]; P.w_gate = ka_->in[18]; P.w_up = ka_->in[19]; P.w_down = ka_->in[20]; P.gf = ka_->in[21]; P.out = ka_->out; P.ws = ka_->ws; ws = ka_->ws; } while (0)
    for (int u = tid; u < (LDS_BYTES - LDSCTL_OFF) / 4; u += NWAVES * 64) ((LAS unsigned*)(lds + LDSCTL_OFF))[u] = 0u;
    __syncthreads();
    const int lo = args.ph_lo, hi = args.ph_hi;
    XcdBarrier bar; bar.bar = (unsigned*)(ws + WS_CTL) + CW_BAR; bar.x = 0; bar.st = nullptr;
    if (hi - lo > 1) bar = xcd_barrier_post((unsigned*)(ws + WS_CTL) + CW_BAR, MISC + 8);
#define IN(k) (lo <= (k) && (k) < hi)
#if PROBE_PHASE >= 0
    unsigned long long pst_[NPHASE + 1]; pst_[0] = __builtin_amdgcn_s_memrealtime();
#define SEAM(k) do { if (IN(k) && IN((k) + 1)) xcd_barrier(bar); pst_[(k) + 1] = __builtin_amdgcn_s_memrealtime(); } while (0)
#else
#define SEAM(k) do { if (IN(k) && IN((k) + 1)) xcd_barrier(bar); } while (0)
#endif
#define REP(k) for (int rep_ = 0; rep_ <= ((PROBE_DOUBLE >> (k)) & 1); ++rep_)

    if (IN(0)) REP(0) { p0_prologue(P, lds, lane, wave, gw, NGW); }
    SEAM(0);
#if PROBE_CLOCK
    const long long pc0 = clock64(), pr0 = wall_clock64();
#endif
    if (IN(1)) {
        cvt_fill(P, lds, MISC + 12, (int)((blockIdx.x >> 3) % 8), nullptr, G);
        for (int pass = 0; pass < 2; ++pass) {
            if ((pass ^ (int)(blockIdx.x & 1)) == 0) { pg8::Gemm g{XB, WIN, 1, 3072, D, (unsigned*)(ws + WS_CTL) + 3002}; pg8::DynDense S; S.init(T, 3072, (unsigned*)(ws + WS_CTL) + CW_GQ + 0 * 512, (volatile LAS int*)(MISC + 16), (int)blockIdx.x);
                pg8::EpiIn E{QB, (size_t)T * 1024, CGB, (const float*)(ws + WS_RSTD1), C2, (unsigned*)(ws + WS_CTL) + CW_NMAX, 0, 1.0f};
                pg8::gemm_phase<pg8::EpiIn, pg8::DynDense, true, false>(lds + RING_OFF, g, S, E); }
            else { pg8::Gemm g{(const bf16*)(ws + WS_X8), (const bf16*)(ws + WS_WIN8), 2, 2048, D / 2, (unsigned*)(ws + WS_CTL) + 3002}; pg8::DynDenseG S; S.init(T, 2048, (unsigned*)(ws + WS_CTL) + CW_GQ + 1 * 512, (volatile LAS int*)(MISC + 16), (int)blockIdx.x);
                pg8::EpiGLU E{CAB, (const float*)(ws + WS_RSTD1), 1.0f / WSCALE};
                pg8::gemm_phase<pg8::EpiGLU, pg8::DynDenseG, true, true, true>(lds + RING_OFF, g, S, E); }
        }
#if PROBE_ATT == 6
        if (threadIdx.x == 0) atomicMax((unsigned*)(ws + WS_CTL) + CW_NMAX + 900, (unsigned)(__builtin_amdgcn_s_memrealtime() - pst_[1]));
#endif
#if PROBE_ATT == 7
        if (threadIdx.x == 0) atomicAdd((unsigned*)(ws + WS_CTL) + CW_NMAX + 900, (unsigned)(__builtin_amdgcn_s_memrealtime() - pst_[1]) >> 8);
#endif
#if PROBE_ATT == 5
        if (blockIdx.x == PROBE_BLK && threadIdx.x == 0) atomicAdd((unsigned*)(ws + WS_CTL) + CW_NMAX + 900, (unsigned)(__builtin_amdgcn_s_memrealtime() - pst_[1]));
#endif
        phase_tail(P, lds, MISC + 12, 1, G);
    }
#if PROBE_CLOCK
    if (IN(1) && tid == 0) { const unsigned dt = (unsigned)(wall_clock64() - pr0); atomicAdd((unsigned*)(ws + WS_CTL) + 3000, dt); atomicMax((unsigned*)(ws + WS_CTL) + 3001, dt); }
#endif
    SEAM(1);
    if (IN(2)) {
#if USE_NAIVE_ATTN
        naive_attn(P, QB, KB, VB, MIX, lane, gw, NGW);
#else
        { float s1 = 0.f, s2 = 0.f;
          for (int i = 0; i < 64; ++i) { s1 += P.lq1[i] * P.lk1[i]; s2 += P.lq2[i] * P.lk2[i]; }
          const float lam0 = 0.2f, lam = expf(s1) - expf(s2) + lam0;
          static_assert(attn_body::ATTN_LDS_BYTES <= RING_BYTES, "attention LDS");
          attn_body::attn_phase<8>((char*)lds_raw + RING_OFF, (int)blockIdx.x, (unsigned*)(ws + WS_CTL) + CW_QA, MISC + 12, lam, 1.0f - lam0, P.subg, (const unsigned*)(ws + WS_CTL) + CW_NMAX, (unsigned*)(ws + WS_O1S) + (size_t)blockIdx.x * 16384,
                                   (const attn_body::bf16*)QB, (const attn_body::bf16*)KB, (const attn_body::bf16*)VB, (attn_body::bf16*)MIX); }
        RELOAD_ARGS();
#endif
        conv_phase(P, CAB, MIX, lds, (int)blockIdx.x, (unsigned*)(ws + WS_CTL) + CW_QC, MISC + 12);
#if PROBE_ATT == 2
        if (blockIdx.x == PROBE_BLK && threadIdx.x == 0) atomicAdd((unsigned*)(ws + WS_CTL) + CW_NMAX + 900, (unsigned)(__builtin_amdgcn_s_memrealtime() - pst_[2]));
#endif
        phase_tail(P, lds, MISC + 12, 2, G);
    }
    SEAM(2);
    if (IN(3)) {
        pg8::Gemm g{MIX, WOUT, 3, D, D, (unsigned*)(ws + WS_CTL) + 3002}; pg8::StaticOrder S; S.init(T, D, G, (int)blockIdx.x); S.rep = 1 + ((PROBE_DOUBLE >> 3) & 1);
        pg8::EpiOut E{HB, XB, (float*)(ws + WS_PART), nullptr};
        pg8::gemm_phase<pg8::EpiOut, pg8::StaticOrder, true, false>(lds + RING_OFF, g, S, E);
        phase_tail(P, lds, MISC + 12, 3, G);
    }
    SEAM(3);
#if PROBE_ATT == 9
    if (IN(4) && blockIdx.x == PROBE_BLK && threadIdx.x == 0) atomicAdd((unsigned*)(ws + WS_CTL) + CW_NMAX + 900, 10u * __hip_atomic_load((unsigned*)(ws + WS_CTL) + CW_CVQ, __ATOMIC_RELAXED, __HIP_MEMORY_SCOPE_AGENT));
#endif
#if USE_NAIVE_ROUTER
    if (IN(4)) { router_phase(P, HB, lane, gw, NGW); }
#else
    if (IN(4)) {
        router_skinny(P, HB, HB8, lds, G);
#if PROBE_ATT == 11
        if (threadIdx.x == 0) atomicMax((unsigned*)(ws + WS_CTL) + CW_NMAX + 900, (unsigned)(__builtin_amdgcn_s_memrealtime() - pst_[4]));
#endif
#if PROBE_ATT == 10
        if (blockIdx.x == PROBE_BLK && threadIdx.x == 0) atomicAdd((unsigned*)(ws + WS_CTL) + CW_NMAX + 900, (unsigned)(__builtin_amdgcn_s_memrealtime() - pst_[4]));
#endif
#if PROBE_ATT == 8
        if (blockIdx.x == PROBE_BLK && threadIdx.x == 0) atomicAdd((unsigned*)(ws + WS_CTL) + CW_NMAX + 900, 10u * __hip_atomic_load((unsigned*)(ws + WS_CTL) + CW_CVQ, __ATOMIC_RELAXED, __HIP_MEMORY_SCOPE_AGENT));
#endif
        cvt_fill(P, lds, MISC + 12, 1 << 30, nullptr, G);
    }
#endif
    SEAM(4);
    if (IN(5)) {
        moe_tables(P, lds);
        pg8::Gemm g{(const bf16*)HB8, (const bf16*)WGU, 5, 2048, D / 2, (unsigned*)(ws + WS_CTL) + 3002};
        pg8::MoeOrder S{(const LAS int*)(lds + TAB_OFF) + 32, (const LAS int*)(lds + TAB_OFF), (const int*)(ws + WS_LIST), G, (int)blockIdx.x, 1, T, (size_t)2048 * 2048, 0};
        pg8::EpiGU E{H1, (const int*)(ws + WS_LIST), (const float*)(ws + WS_LISTR), 1.0f / WSCALE, H1SCALE};
        pg8::gemm_phase<pg8::EpiGU, pg8::MoeOrder, true, true, true>(lds + RING_OFF, g, S, E);
    }
    SEAM(5);
    if (IN(6)) {
        moe_tables(P, lds);
        pg8::Gemm g{(const bf16*)H1, (const bf16*)WD, 6, 2048, 512, (unsigned*)(ws + WS_CTL) + 3002};
        pg8::MoeOrder S{(const LAS int*)(lds + TAB_OFF) + 32, (const LAS int*)(lds + TAB_OFF), (const int*)(ws + WS_LIST), G, (int)blockIdx.x, 0, T, (size_t)2048 * 1024, 1};
        pg8::EpiDown E{ws + WS_MIX, (const int*)(ws + WS_LIST), (const float*)(ws + WS_LISTW), YSCALE / (WSCALE * H1SCALE)};
        pg8::gemm_phase<pg8::EpiDown, pg8::MoeOrder, true, true, true>(lds + RING_OFF, g, S, E);
    }
    SEAM(6);
    if (IN(7)) { final_phase(P, HB, ws + WS_MIX, NGW); }
#if PROBE_ATT
    if (blockIdx.x == 0) { const unsigned long long span = __hip_atomic_load((unsigned*)(ws + WS_CTL) + CW_NMAX + 900, __ATOMIC_RELAXED, __HIP_MEMORY_SCOPE_AGENT); const unsigned long long r1 = __builtin_amdgcn_s_memrealtime(); while (__builtin_amdgcn_s_memrealtime() - r1 < span) __builtin_amdgcn_s_sleep(8); }
#endif
#if PROBE_PHASE >= 0
    pst_[NPHASE] = __builtin_amdgcn_s_memrealtime();
    if (blockIdx.x == 0 && PROBE_PHASE < 100) { const unsigned long long span = pst_[(PROBE_PHASE < 100 ? PROBE_PHASE : 0) + 1] - pst_[PROBE_PHASE < 100 ? PROBE_PHASE : 0]; const unsigned long long r1 = __builtin_amdgcn_s_memrealtime(); while (__builtin_amdgcn_s_memrealtime() - r1 < span) __builtin_amdgcn_s_sleep(8); }
#endif
#if PROBE_KLOOP
    if (blockIdx.x == 0) { const long long pticks = (long long)__hip_atomic_load((unsigned*)(ws + WS_CTL) + 3002, __ATOMIC_RELAXED, __HIP_MEMORY_SCOPE_AGENT); const long long r1 = wall_clock64(); while (wall_clock64() - r1 < pticks) __builtin_amdgcn_s_sleep(8); }
#endif
#if PROBE_CLOCK
    if (blockIdx.x == 0) { const unsigned sum = __hip_atomic_load((unsigned*)(ws + WS_CTL) + 3000, __ATOMIC_RELAXED, __HIP_MEMORY_SCOPE_AGENT), mx = __hip_atomic_load((unsigned*)(ws + WS_CTL) + 3001, __ATOMIC_RELAXED, __HIP_MEMORY_SCOPE_AGENT);
        const long long pticks = (long long)mx - (long long)(sum / (unsigned)G); const long long r1 = wall_clock64(); while (wall_clock64() - r1 < pticks) __builtin_amdgcn_s_sleep(8); }
#endif
#undef IN
#undef SEAM
#undef REP
}

extern "C" void kernel_launch(void* const* d_in, const int* in_sizes, int n_in, void* d_out, int out_size, void* d_ws, size_t ws_size, hipStream_t stream) {
    static int grid = 0;
    if (grid == 0) {
        if (n_in != 22 || in_sizes[0] != T * D || out_size != T * D || ws_size < WS_END) { fprintf(stderr, "kernel_launch: unexpected shapes (n_in %d, in0 %d, out %d, ws %zu); nothing launched\n", n_in, n_in > 0 ? in_sizes[0] : -1, out_size, ws_size); grid = -1; return; }
        int dev = 0, cus = 0, per_cu = 0;
        if (hipGetDevice(&dev) != hipSuccess || hipDeviceGetAttribute(&cus, hipDeviceAttributeMultiprocessorCount, dev) != hipSuccess) { grid = -1; return; }
        if (hipFuncSetAttribute((const void*)fwd, hipFuncAttributeMaxDynamicSharedMemorySize, LDS_BYTES) != hipSuccess) { fprintf(stderr, "kernel_launch: hipFuncSetAttribute failed\n"); grid = -1; return; }
        if (hipOccupancyMaxActiveBlocksPerMultiprocessor(&per_cu, (const void*)fwd, NWAVES * 64, LDS_BYTES) != hipSuccess || per_cu < 1) fprintf(stderr, "kernel_launch: occupancy query reports %d\n", per_cu);
        (void)hipGetLastError();
        grid = cus;
    }
    if (grid < 0) return;
    if (hipMemsetAsync((char*)d_ws + WS_CTL, 0, CTL_ZERO_BYTES, stream) != hipSuccess) return;
    Args a{};
    for (int i = 0; i < 22; ++i) a.in[i] = (const float*)d_in[i];
    a.out = (float*)d_out; a.ws = (unsigned char*)d_ws;
#if MK_ONE_LAUNCH
    a.ph_lo = 0; a.ph_hi = NPHASE;
    hipLaunchKernelGGL(fwd, dim3(grid), dim3(NWAVES * 64), LDS_BYTES, stream, a);
#else
    for (int p = 0; p < NPHASE; ++p) { a.ph_lo = p; a.ph_hi = p + 1; hipLaunchKernelGGL(fwd, dim3(grid), dim3(NWAVES * 64), LDS_BYTES, stream, a); }
#endif
}
```

```cpp
#include <hip/hip_runtime.h>
#include <cstdio>
#include <cstdint>
#ifndef PROBE_KLOOP
#define PROBE_KLOOP 0
#endif
#ifndef PROBE_WHAT
#define PROBE_WHAT 0
#endif
#ifndef PROBE_PHASE
#define PROBE_PHASE -1
#endif
#ifndef PROBE_ATT
#define PROBE_ATT 0
#endif
#ifndef PROBE_BLK
#define PROBE_BLK 0
#endif
namespace pg8 {
#define PG8_LAS __attribute__((address_space(3)))
typedef unsigned short bf16_t;
typedef short bf16x8 __attribute__((ext_vector_type(8)));
typedef float f32x4 __attribute__((ext_vector_type(4)));
typedef unsigned u32x4 __attribute__((ext_vector_type(4)));
constexpr int BM = 256, BK = 64, HALF = 128, HTB = HALF * BK * 2  , STAGE_BYTES = 8 * HTB, NXCD = 8, WGM = 8;

__host__ __device__ __forceinline__ int lds_byte(int r, int c) { const int st = (r >> 4) * 2 + (c >> 5), rr = r & 15, cc = c & 31, ob = rr * 64 + cc * 2; return st * 1024 + (ob ^ (((ob >> 9) & 1) << 5)); }
__host__ __device__ __forceinline__ void stage_rc(int b, int& R, int& C) { const int st = b / 1024, sb = b % 1024, swz = sb ^ (((sb >> 9) & 1) << 5); R = (st >> 1) * 16 + swz / 64; C = (st & 1) * 32 + (swz % 64) / 2; }
__host__ __device__ __forceinline__ int perm32(int rho) { const int n = rho >> 4, i = rho & 15; return 8 * (i >> 2) + 4 * n + (i & 3); }

struct Unit { int pm, pn, e, nvalid, lbase, srow; };
struct Gemm { const bf16_t* A; const bf16_t* Bt; int M, N, K; unsigned* probe = nullptr; };

struct StaticOrder {
    int nM, nN, nwg, G, c, rep = 1;
    __host__ __device__ void init(int M, int N, int G_, int c_) { nM = M / BM; nN = N / BM; nwg = nM * nN; G = G_; c = c_; }
    __host__ __device__ bool next(int i, Unit& u) const {
        long L = (long)i * G + c; if (L >= (long)nwg * rep) return false; L %= nwg;
        int wgid = (int)L; { const int q = nwg / NXCD, r = nwg % NXCD, xcd = wgid % NXCD, off = wgid / NXCD; wgid = (xcd < r ? xcd * (q + 1) : r * (q + 1) + (xcd - r) * q) + off; }
        const int nig = WGM * nN, gid = wgid / nig, fm = gid * WGM, gsz = (nM - fm) < WGM ? (nM - fm) : WGM;
        u.pm = fm + ((wgid % nig) % gsz); u.pn = (wgid % nig) / gsz; return true;
    }
    __device__ __forceinline__ const char* bbase(const Gemm& g, const Unit& u, size_t tstep) const { return (const char*)g.Bt + (size_t)u.pn * tstep; }
    __device__ __forceinline__ unsigned goff(const Unit&, int, int, int) const { return 0u; }
    __device__ __forceinline__ void a_ready(const Unit&) const {}
    __device__ __forceinline__ void done(const Unit&) const {}
};

struct StaticOrderG : StaticOrder {
    __device__ __forceinline__ unsigned goff(const Unit& u, int r, int C, int K) const { return ((unsigned)(u.pm * BM + r) * (unsigned)K + (unsigned)C) * 2u; }
};

struct MoeOrder {
    const PG8_LAS int* tstart; const PG8_LAS int* cnt; const int* list; int G, c, shift, lcap; size_t estride; int sorted;
    __device__ __forceinline__ bool next(int i, Unit& u) const {
        const int ntiles = tstart[32]; const int x = c & 7, k = i * (G >> 3) + (c >> 3); const int rt = 2 * (k >> 1) + (x & 1); if (rt >= ntiles) return false;
        int e = 0;
#pragma unroll
        for (int q = 1; q < 32; ++q) e += (tstart[q] <= rt) ? 1 : 0;
        e = __builtin_amdgcn_readfirstlane(e);
        const int pm = __builtin_amdgcn_readfirstlane(rt - tstart[e]); const int rem = __builtin_amdgcn_readfirstlane(cnt[e]) - 256 * pm;
        u.pm = pm; u.pn = 2 * (x >> 1) + (k & 1); u.e = e; u.nvalid = rem < 256 ? rem : 256; u.lbase = e * lcap + 256 * pm; u.srow = 256 * rt; return true;
    }
    __device__ __forceinline__ const char* bbase(const Gemm& g, const Unit& u, size_t tstep) const { return (const char*)g.Bt + (size_t)u.e * estride + (size_t)u.pn * tstep; }
    __device__ __forceinline__ unsigned goff(const Unit& u, int r, int C, int K) const {
        if (sorted) return ((unsigned)(u.srow + r) * (unsigned)K + (unsigned)C) * 2u;
        const int a = list[u.lbase + (r < u.nvalid ? r : 0)];
        return ((unsigned)(a >> shift) * (unsigned)K + (unsigned)C) * 2u;
    }
    __device__ __forceinline__ void a_ready(const Unit&) const {}
    __device__ __forceinline__ void done(const Unit&) const {}
};

struct DynQ {
    unsigned* ctr; volatile PG8_LAS int* slot; int x0, qi; unsigned pend;
    __device__ __forceinline__ void qinit(unsigned* ctr_, volatile PG8_LAS int* slot_, int bx) { ctr = ctr_; slot = slot_; x0 = bx & 7; qi = 0; pend = 0u;
        if (threadIdx.x == 0) pend = __hip_atomic_fetch_add(ctr + 64 * x0, 1u, __ATOMIC_RELAXED, __HIP_MEMORY_SCOPE_AGENT); }
    template <class SizeF> __device__ __forceinline__ int qnext(int i, const SizeF& size_of) {
        const int par = i & 1;
        if (threadIdx.x == 0) { int res = -1;
            while (qi < 8) { const int x = (x0 + qi) & 7; if (pend < (unsigned)size_of(x)) { res = (x << 24) | (int)pend; break; }
                ++qi; if (qi < 8) pend = __hip_atomic_fetch_add(ctr + 64 * ((x0 + qi) & 7), 1u, __ATOMIC_RELAXED, __HIP_MEMORY_SCOPE_AGENT); }
            slot[par] = res;
            if (res >= 0) pend = __hip_atomic_fetch_add(ctr + 64 * ((x0 + qi) & 7), 1u, __ATOMIC_RELAXED, __HIP_MEMORY_SCOPE_AGENT); }
        asm volatile("s_waitcnt lgkmcnt(0)" ::: "memory"); __builtin_amdgcn_s_barrier(); asm volatile("" ::: "memory");
        return __builtin_amdgcn_readfirstlane(slot[par]);
    }
};
struct DynDense : DynQ {
    int nM, nN, nwg;
    __device__ __forceinline__ void init(int M, int N, unsigned* ctr_, volatile PG8_LAS int* slot_, int bx) { nM = M / BM; nN = N / BM; nwg = nM * nN; qinit(ctr_, slot_, bx); }
    __device__ __forceinline__ bool next(int i, Unit& u) {
        const int q = nwg / NXCD, r = nwg % NXCD;
        const int code = qnext(i, [=](int x) { return q + (x < r ? 1 : 0); }); if (code < 0) return false;
        const int x = code >> 24, k = code & 0xffffff; const int wgid = (x < r ? x * (q + 1) : r * (q + 1) + (x - r) * q) + k;
        const int nig = WGM * nN, gid = wgid / nig, fm = gid * WGM, gsz = (nM - fm) < WGM ? (nM - fm) : WGM;
        u.pm = fm + ((wgid % nig) % gsz); u.pn = (wgid % nig) / gsz; return true;
    }
    __device__ __forceinline__ const char* bbase(const Gemm& g, const Unit& u, size_t tstep) const { return (const char*)g.Bt + (size_t)u.pn * tstep; }
    __device__ __forceinline__ unsigned goff(const Unit&, int, int, int) const { return 0u; }
    __device__ __forceinline__ void a_ready(const Unit&) const {}
    __device__ __forceinline__ void done(const Unit&) const {}
};
struct DynDenseG : DynDense {
    __device__ __forceinline__ unsigned goff(const Unit& u, int r, int C, int K) const { return ((unsigned)(u.pm * BM + r) * (unsigned)K + (unsigned)C) * 2u; }
};

__device__ __forceinline__ unsigned cvt_pk_bf16(float lo, float hi) { unsigned r; asm volatile("v_cvt_pk_bf16_f32 %0, %1, %2" : "=v"(r) : "v"(lo), "v"(hi)); return r; }
__device__ __forceinline__ float bf_lo(unsigned w) { return __builtin_bit_cast(float, w << 16); }
__device__ __forceinline__ float bf_hi(unsigned w) { return __builtin_bit_cast(float, w & 0xffff0000u); }
__device__ __forceinline__ unsigned pk4_fp8(float a, float b, float c, float d) {
    a = __builtin_amdgcn_fmed3f(a, -440.f, 440.f); b = __builtin_amdgcn_fmed3f(b, -440.f, 440.f); c = __builtin_amdgcn_fmed3f(c, -440.f, 440.f); d = __builtin_amdgcn_fmed3f(d, -440.f, 440.f);
    int r = __builtin_amdgcn_cvt_pk_fp8_f32(a, b, 0, false); r = __builtin_amdgcn_cvt_pk_fp8_f32(c, d, r, true); return (unsigned)r; }
typedef unsigned u32x2 __attribute__((ext_vector_type(2)));
__device__ __forceinline__ void swap16(u32x2& a, u32x2& b) { auto r0 = __builtin_amdgcn_permlane16_swap(a.x, b.x, false, false); auto r1 = __builtin_amdgcn_permlane16_swap(a.y, b.y, false, false); a = (u32x2){r0[0], r1[0]}; b = (u32x2){r0[1], r1[1]}; }
typedef int v4i_t __attribute__((ext_vector_type(4)));

struct EpiIn {
    static constexpr bool PERM = true, AFTER_DRAIN = false;
    bf16_t* P0; size_t stride; bf16_t* CG; const float* rstd; float scale0; unsigned* nmax; int tbase; float oscale;
    __device__ __forceinline__ void operator()(const f32x4 (&acc)[2][2][4][2], const Unit& u, int wr, int wc, int fr, int fq) const {
        const int row0 = u.pm * BM + wr * 64 + fr, t = (u.pn >> 2) + tbase; bf16_t* base = (t < 4) ? P0 + (size_t)t * stride : CG;
        const float sc = ((t == 0) ? scale0 : 1.f) * oscale; const int col0 = (u.pn & 3) * BM + wc * 32 + 8 * fq;
        float mx[2] = {0.f, 0.f}; float rsv[2][4];
#pragma unroll
        for (int ai = 0; ai < 2; ++ai)
#pragma unroll
            for (int m = 0; m < 4; ++m) rsv[ai][m] = rstd[row0 + ai * HALF + m * 16];
#pragma unroll
        for (int ai = 0; ai < 2; ++ai)
#pragma unroll
            for (int m = 0; m < 4; ++m) { const int row = row0 + ai * HALF + m * 16; const float rs = rsv[ai][m] * sc; bf16_t* rowp = base + (size_t)row * 1024 + col0;
#pragma unroll
                for (int bj = 0; bj < 2; ++bj) { const f32x4 v0 = acc[ai][bj][m][0] * rs, v1 = acc[ai][bj][m][1] * rs;
                    u32x4 w; w.x = cvt_pk_bf16(v0[0], v0[1]); w.y = cvt_pk_bf16(v0[2], v0[3]); w.z = cvt_pk_bf16(v1[0], v1[1]); w.w = cvt_pk_bf16(v1[2], v1[3]);
                    *(u32x4*)(rowp + bj * HALF) = w;
                    if (t < 2) { float ss = (v0[0] * v0[0] + v0[1] * v0[1]) + (v0[2] * v0[2] + v0[3] * v0[3]) + (v1[0] * v1[0] + v1[1] * v1[1]) + (v1[2] * v1[2] + v1[3] * v1[3]);
                        ss += __shfl_xor(ss, 16); ss += __shfl_xor(ss, 32); mx[bj] = __builtin_fmaxf(mx[bj], ss); } } }
        if (t < 2) {
#pragma unroll
            for (int bj = 0; bj < 2; ++bj) { float v = mx[bj];
                v = __builtin_fmaxf(v, __shfl_xor(v, 1)); v = __builtin_fmaxf(v, __shfl_xor(v, 2)); v = __builtin_fmaxf(v, __shfl_xor(v, 4)); v = __builtin_fmaxf(v, __shfl_xor(v, 8));
                const int colb = (u.pn & 3) * BM + bj * HALF + wc * 32, g64 = colb >> 6, bh = (u.pm >> 4) * 8 + (g64 >> 1);
                if (fr == 0 && fq == 0) atomicMax(nmax + ((t * 64 + bh) * 2 + (g64 & 1)) * 2 + (wc & 1), __builtin_bit_cast(unsigned, v)); }
        }
    }
};
struct EpiGLU {
    static constexpr bool PERM = true, AFTER_DRAIN = false;
    bf16_t* U; const float* rstd; float oscale;
    __device__ __forceinline__ void operator()(const f32x4 (&acc)[2][2][4][2], const Unit& u, int wr, int wc, int fr, int fq) const {
        const int row0 = u.pm * BM + wr * 64 + fr, col0 = u.pn * HALF + wc * 32 + 8 * fq; float rsv[2][4];
#pragma unroll
        for (int ai = 0; ai < 2; ++ai)
#pragma unroll
            for (int m = 0; m < 4; ++m) rsv[ai][m] = rstd[row0 + ai * HALF + m * 16];
#pragma unroll
        for (int ai = 0; ai < 2; ++ai)
#pragma unroll
            for (int m = 0; m < 4; ++m) { const int row = row0 + ai * HALF + m * 16; const float rs = rsv[ai][m] * oscale;
                const f32x4 a0 = acc[ai][0][m][0] * rs, a1 = acc[ai][0][m][1] * rs, g0 = acc[ai][1][m][0] * rs, g1 = acc[ai][1][m][1] * rs;
#define PG8_SG(x) __builtin_amdgcn_rcpf(1.f + __builtin_amdgcn_exp2f(-1.4426950408889634f * (x)))
                u32x4 w; w.x = cvt_pk_bf16(a0[0] * PG8_SG(g0[0]), a0[1] * PG8_SG(g0[1])); w.y = cvt_pk_bf16(a0[2] * PG8_SG(g0[2]), a0[3] * PG8_SG(g0[3]));
                w.z = cvt_pk_bf16(a1[0] * PG8_SG(g1[0]), a1[1] * PG8_SG(g1[1])); w.w = cvt_pk_bf16(a1[2] * PG8_SG(g1[2]), a1[3] * PG8_SG(g1[3]));
#undef PG8_SG
                *(u32x4*)(U + (size_t)row * 1024 + col0) = w; }
    }
};
struct EpiOut {
    static constexpr bool PERM = true, AFTER_DRAIN = false;
    bf16_t* H; const bf16_t* XB; float* part; unsigned char* H8;
    __device__ __forceinline__ void operator()(const f32x4 (&acc)[2][2][4][2], const Unit& u, int wr, int wc, int fr, int fq) const {
        const int row0 = u.pm * BM + wr * 64 + fr, col0 = u.pn * BM + wc * 32 + 8 * fq;
#pragma unroll
        for (int ai = 0; ai < 2; ++ai) { u32x4 xbv[4][2];
#pragma unroll
            for (int m = 0; m < 4; ++m)
#pragma unroll
                for (int bj = 0; bj < 2; ++bj) xbv[m][bj] = *(const u32x4*)(XB + (size_t)(row0 + ai * HALF + m * 16) * 2048 + col0 + bj * HALF);
#pragma unroll
            for (int m = 0; m < 4; ++m) { const int row = row0 + ai * HALF + m * 16; const size_t off = (size_t)row * 2048 + col0; float ss = 0.f;
#pragma unroll
                for (int bj = 0; bj < 2; ++bj) { const u32x4 xb = xbv[m][bj];
                    f32x4 v0 = acc[ai][bj][m][0], v1 = acc[ai][bj][m][1];
                    v0[0] += bf_lo(xb.x); v0[1] += bf_hi(xb.x); v0[2] += bf_lo(xb.y); v0[3] += bf_hi(xb.y); v1[0] += bf_lo(xb.z); v1[1] += bf_hi(xb.z); v1[2] += bf_lo(xb.w); v1[3] += bf_hi(xb.w);
                    ss += (v0[0] * v0[0] + v0[1] * v0[1]) + (v0[2] * v0[2] + v0[3] * v0[3]) + (v1[0] * v1[0] + v1[1] * v1[1]) + (v1[2] * v1[2] + v1[3] * v1[3]);
                    u32x4 w; w.x = cvt_pk_bf16(v0[0], v0[1]); w.y = cvt_pk_bf16(v0[2], v0[3]); w.z = cvt_pk_bf16(v1[0], v1[1]); w.w = cvt_pk_bf16(v1[2], v1[3]);
                    *(u32x4*)(H + off + bj * HALF) = w;
                    if (H8) { u32x2 w8; w8.x = pk4_fp8(v0[0], v0[1], v0[2], v0[3]); w8.y = pk4_fp8(v1[0], v1[1], v1[2], v1[3]); *(u32x2*)(H8 + off + bj * HALF) = w8; } }
                ss += __shfl_xor(ss, 16); ss += __shfl_xor(ss, 32);
                if (fq == 0) part[(size_t)row * 32 + u.pn * 4 + wc] = ss; } }
    }
};
__device__ __forceinline__ float silu_f(float x) { return x * __builtin_amdgcn_rcpf(1.f + __builtin_amdgcn_exp2f(-1.4426950408889634f * x)); }
struct EpiGU {
    static constexpr bool PERM = true, AFTER_DRAIN = false;
    unsigned char* H1; const int* list; const float* listr; float wscale, oscale;
    __device__ __forceinline__ void operator()(const f32x4 (&acc)[2][2][4][2], const Unit& u, int wr, int wc, int fr, int fq) const {
        const int col0 = u.pn * HALF + wc * 32 + 8 * fq;
        float rsv[2][4];
#pragma unroll
        for (int ai = 0; ai < 2; ++ai)
#pragma unroll
            for (int m = 0; m < 4; ++m) { const int r = ai * HALF + wr * 64 + m * 16 + fr; rsv[ai][m] = listr[u.lbase + (r < u.nvalid ? r : 0)]; }
#pragma unroll
        for (int ai = 0; ai < 2; ++ai)
#pragma unroll
            for (int mp = 0; mp < 4; mp += 2) { u32x2 wv[2];
#pragma unroll
                for (int q = 0; q < 2; ++q) { const int m = mp + q; const float rs = rsv[ai][m] * wscale;
                    const f32x4 g0 = acc[ai][0][m][0] * rs, g1 = acc[ai][0][m][1] * rs, u0 = acc[ai][1][m][0] * (rs * oscale), u1 = acc[ai][1][m][1] * (rs * oscale);
                    wv[q].x = pk4_fp8(silu_f(g0[0]) * u0[0], silu_f(g0[1]) * u0[1], silu_f(g0[2]) * u0[2], silu_f(g0[3]) * u0[3]);
                    wv[q].y = pk4_fp8(silu_f(g1[0]) * u1[0], silu_f(g1[1]) * u1[1], silu_f(g1[2]) * u1[2], silu_f(g1[3]) * u1[3]); }
                swap16(wv[0], wv[1]);
                const int odd = fq & 1, r = ai * HALF + wr * 64 + (mp + odd) * 16 + fr;
                if (r < u.nvalid) { const u32x4 w = {wv[0].x, wv[0].y, wv[1].x, wv[1].y};
                    *(u32x4*)(H1 + (size_t)(u.srow + r) * 1024 + col0 - 8 * odd) = w; } }
    }
};
struct EpiDown {
    static constexpr bool PERM = true, AFTER_DRAIN = false;
    unsigned char* Y; const int* list; const float* listw; float oscale;
    __device__ __forceinline__ void operator()(const f32x4 (&acc)[2][2][4][2], const Unit& u, int wr, int wc, int fr, int fq) const {
        const int col0 = u.pn * BM + wc * 32 + 8 * fq;
        int av[2][4]; float wv[2][4];
#pragma unroll
        for (int ai = 0; ai < 2; ++ai)
#pragma unroll
            for (int m = 0; m < 4; ++m) { const int r = ai * HALF + wr * 64 + m * 16 + fr, ix = u.lbase + (r < u.nvalid ? r : 0); av[ai][m] = list[ix]; wv[ai][m] = listw[ix]; }
#pragma unroll
        for (int ai = 0; ai < 2; ++ai)
#pragma unroll
            for (int m = 0; m < 4; ++m) { const int r = ai * HALF + wr * 64 + m * 16 + fr; const int a = av[ai][m]; const float ws = wv[ai][m] * oscale;
                u32x2 w0, w1;
                { const f32x4 v0 = acc[ai][0][m][0] * ws, v1 = acc[ai][0][m][1] * ws; w0.x = pk4_fp8(v0[0], v0[1], v0[2], v0[3]); w0.y = pk4_fp8(v1[0], v1[1], v1[2], v1[3]); }
                { const f32x4 v0 = acc[ai][1][m][0] * ws, v1 = acc[ai][1][m][1] * ws; w1.x = pk4_fp8(v0[0], v0[1], v0[2], v0[3]); w1.y = pk4_fp8(v1[0], v1[1], v1[2], v1[3]); }
                swap16(w0, w1);
                if (r < u.nvalid) { const int odd = fq & 1; const u32x4 w = {w0.x, w0.y, w1.x, w1.y};
                    *(u32x4*)(Y + (size_t)a * 2048 + col0 + (odd ? HALF - 8 : 0)) = w; } }
    }
};
struct EpiRouter {
    static constexpr bool PERM = true, AFTER_DRAIN = false;
    const float* part; const float* ber; const float* bgr; float* listr; float* listw; int* list; unsigned* cnt; int lcap;
    __device__ __forceinline__ void operator()(const f32x4 (&acc)[2][2][4][2], const Unit& u, int wr, int wc, int fr, int fq) const {
        if (wc != 0) return;
#pragma unroll
        for (int ai = 0; ai < 2; ++ai)
#pragma unroll
            for (int m = 0; m < 4; ++m) { const int row = u.pm * BM + ai * HALF + wr * 64 + m * 16 + fr;
                const f32x4 p0 = *(const f32x4*)(part + (size_t)row * 32 + 8 * fq), p1 = *(const f32x4*)(part + (size_t)row * 32 + 8 * fq + 4);
                float ss = ((p0[0] + p0[1]) + (p0[2] + p0[3])) + ((p1[0] + p1[1]) + (p1[2] + p1[3]));
                ss += __shfl_xor(ss, 16); ss += __shfl_xor(ss, 32);
                const float rstd = 1.0f / sqrtf(ss * (1.0f / 2048.0f) + 1e-6f);
                const f32x4 gl = acc[ai][1][m][0]; float g[4];
#pragma unroll
                for (int i = 0; i < 4; ++i) g[i] = __shfl(gl[i], fr) * rstd + bgr[i];
                int gs = 0; float gm = g[0];
#pragma unroll
                for (int i = 1; i < 4; ++i) if (g[i] > gm) { gm = g[i]; gs = i; }
                float gsum = 0.f;
#pragma unroll
                for (int i = 0; i < 4; ++i) gsum += __expf(g[i] - gm);
                const float gw = 1.0f / gsum;
                if (fq == gs) { float ev[8];
#pragma unroll
                    for (int i = 0; i < 4; ++i) { ev[i] = acc[ai][0][m][0][i] * rstd + ber[8 * fq + i]; ev[4 + i] = acc[ai][0][m][1][i] * rstd + ber[8 * fq + 4 + i]; }
                    int i1 = 0; float v1 = ev[0];
#pragma unroll
                    for (int i = 1; i < 8; ++i) if (ev[i] > v1) { v1 = ev[i]; i1 = i; }
                    int i2 = -1; float v2 = -3.0e38f;
#pragma unroll
                    for (int i = 0; i < 8; ++i) if (i != i1 && ev[i] > v2) { v2 = ev[i]; i2 = i; }
                    const float e2 = __expf(v2 - v1), w1 = gw / (1.f + e2), w2 = gw * e2 / (1.f + e2);
                    const int ea = gs * 8 + i1, eb = gs * 8 + i2;
                    const unsigned ra = __hip_atomic_fetch_add(cnt + 64 * ea, 1u, __ATOMIC_RELAXED, __HIP_MEMORY_SCOPE_AGENT);
                    const unsigned rb = __hip_atomic_fetch_add(cnt + 64 * eb, 1u, __ATOMIC_RELAXED, __HIP_MEMORY_SCOPE_AGENT);
                    const size_t ia = (size_t)ea * lcap + ra, ib = (size_t)eb * lcap + rb;
                    list[ia] = 2 * row; list[ib] = 2 * row + 1; listw[ia] = w1; listw[ib] = w2; listr[ia] = rstd; listr[ib] = rstd; } }
    }
};

template <class Epi, class Sched, bool ALIGN_EPI, bool GATHER, bool FP8 = false>
__device__ __forceinline__ void gemm_phase(PG8_LAS unsigned char* lds, const Gemm g, Sched& S, const Epi& E) {
    int tid_ = threadIdx.x; asm volatile("" : "+v"(tid_));
    const int tid = tid_, wid = __builtin_amdgcn_readfirstlane(tid >> 6), lane = tid & 63, wr = wid >> 2, wc = wid & 3, fr = lane & 15, fq = lane >> 4;
    const int K = g.K, nt = K / BK;
    unsigned voffA[2], voffB[2]; int RA[2], CA[2];
#pragma unroll
    for (int i = 0; i < 2; ++i) { int R, C; stage_rc(tid * 16 + i * 8192, R, C); const int Rb = Epi::PERM ? ((R & ~31) + perm32(R & 31)) : R;
        voffA[i] = (unsigned)(R * K + C) * 2u; voffB[i] = (unsigned)(Rb * K + C) * 2u; RA[i] = R; CA[i] = C; }
    const size_t kstep = (size_t)(BK * 2);
    const size_t hstep = (size_t)HALF * K * 2;
    const size_t tstep = 2 * hstep;
    const unsigned ldsw = (unsigned)wid * 1024u;
    const int aoff = lds_byte(wr * 64 + fr, fq * 8), boff = lds_byte(wc * 32 + fr, fq * 8);
#define PG8_SA(b, h) (((b) * 2 + (h)) * HTB)
#define PG8_SB(b, h) ((4 + (b) * 2 + (h)) * HTB)
#define PG8_STAGE(bufoff, gbase, voff) do { _Pragma("unroll") for (int _i = 0; _i < 2; ++_i) \
        __builtin_amdgcn_global_load_lds((const unsigned*)((const char*)(gbase) + (voff)[_i]), (PG8_LAS unsigned*)(lds + (bufoff) + ldsw + _i * 8192), 16, 0, 0); } while (0)
#define PG8_STAGE_A(bufoff, kp, h) do { if constexpr (GATHER) { PG8_STAGE(bufoff, kp, cgo[h]); } else { PG8_STAGE(bufoff, (kp) + (h) * hstep, voffA); } } while (0)
#define PG8_LDA(dst, b, h) do { _Pragma("unroll") for (int m = 0; m < 4; ++m) _Pragma("unroll") for (int k = 0; k < 2; ++k) dst[m][k] = *(const PG8_LAS bf16x8*)(lds + PG8_SA(b, h) + aoff + m * 2048 + k * 1024); } while (0)
#define PG8_LDB(dst, b, h) do { _Pragma("unroll") for (int n = 0; n < 2; ++n) _Pragma("unroll") for (int k = 0; k < 2; ++k) dst[n][k] = *(const PG8_LAS bf16x8*)(lds + PG8_SB(b, h) + boff + n * 2048 + k * 1024); } while (0)
#define PG8_CAT(x, y) __builtin_shufflevector(__builtin_bit_cast(v4i_t, x), __builtin_bit_cast(v4i_t, y), 0, 1, 2, 3, 4, 5, 6, 7)
#define PG8_MMA(ai, bj, At, Bt) do { __builtin_amdgcn_s_setprio(1); \
        if constexpr (FP8) { _Pragma("unroll") for (int m = 0; m < 4; ++m) _Pragma("unroll") for (int n = 0; n < 2; ++n) \
            acc[ai][bj][m][n] = __builtin_amdgcn_mfma_scale_f32_16x16x128_f8f6f4(PG8_CAT(Bt[n][0], Bt[n][1]), PG8_CAT(At[m][0], At[m][1]), acc[ai][bj][m][n], 0, 0, 0, 0, 0, 0); } \
        else { _Pragma("unroll") for (int m = 0; m < 4; ++m) _Pragma("unroll") for (int n = 0; n < 2; ++n) _Pragma("unroll") for (int k = 0; k < 2; ++k) \
            acc[ai][bj][m][n] = __builtin_amdgcn_mfma_f32_16x16x32_bf16(Bt[n][k], At[m][k], acc[ai][bj][m][n], 0, 0, 0); } \
        __builtin_amdgcn_s_setprio(0); } while (0)
#define PG8_WAIT_V(n) asm volatile("s_waitcnt vmcnt(" #n ")" ::: "memory")
#define PG8_WAIT_L(n) asm volatile("s_waitcnt lgkmcnt(" #n ")" ::: "memory")
#define PG8_BAR __builtin_amdgcn_s_barrier()
#define PG8_SCHED __builtin_amdgcn_sched_barrier(0)
    Unit cur, nxt; int ui = 0;
#if PROBE_KLOOP
    unsigned pk_acc_ = 0u;
#endif
    if (!S.next(0, cur)) return;
    f32x4 acc[2][2][4][2];
#pragma unroll
    for (int a = 0; a < 2; ++a)
#pragma unroll
        for (int b = 0; b < 2; ++b)
#pragma unroll
            for (int m = 0; m < 4; ++m)
#pragma unroll
                for (int n = 0; n < 2; ++n) acc[a][b][m][n] = (f32x4){0.f, 0.f, 0.f, 0.f};
    bf16x8 At[4][2], B0[2][2], B1[2][2];
    unsigned cgo[2][2] = {{0u, 0u}, {0u, 0u}}, ngo[2][2] = {{0u, 0u}, {0u, 0u}};
    if constexpr (GATHER) {
#pragma unroll
        for (int h = 0; h < 2; ++h)
#pragma unroll
            for (int i = 0; i < 2; ++i) cgo[h][i] = S.goff(cur, h * HALF + RA[i], CA[i], K);
    }
    const char* cA = GATHER ? (const char*)g.A : (const char*)g.A + (size_t)cur.pm * tstep; const char* cB = S.bbase(g, cur, tstep);
    S.a_ready(cur);
    PG8_STAGE(PG8_SB(0, 0), cB, voffB); PG8_STAGE(PG8_SB(0, 1), cB + hstep, voffB); PG8_STAGE_A(PG8_SA(0, 0), cA, 0); PG8_STAGE_A(PG8_SA(0, 1), cA, 1);
    if (wr == 1) PG8_BAR;
    PG8_WAIT_V(2); PG8_BAR;
    PG8_STAGE(PG8_SB(1, 0), cB + kstep, voffB); PG8_STAGE_A(PG8_SA(1, 0), cA + kstep, 0); PG8_STAGE(PG8_SB(1, 1), cB + hstep + kstep, voffB);
    PG8_WAIT_V(6); PG8_BAR;
    for (;;) {
        const bool has_next = S.next(ui + 1, nxt);
        if constexpr (GATHER) {
            if (has_next) {
#pragma unroll
                for (int h = 0; h < 2; ++h)
#pragma unroll
                    for (int i = 0; i < 2; ++i) ngo[h][i] = S.goff(nxt, h * HALF + RA[i], CA[i], K);
            } else {
#pragma unroll
                for (int h = 0; h < 2; ++h)
#pragma unroll
                    for (int i = 0; i < 2; ++i) ngo[h][i] = cgo[h][i];
            }
        }
        const char* nA = GATHER ? (const char*)g.A : (has_next ? (const char*)g.A + (size_t)nxt.pm * tstep : cA); const char* nB = has_next ? S.bbase(g, nxt, tstep) : cB;
#if PROBE_KLOOP
        const unsigned long long pk0_ = __builtin_amdgcn_s_memrealtime();
#endif
        for (int t = 0; t < nt; t += 2) {
            const bool last = (t == nt - 2);
            const char* a1 = cA + (size_t)(t + 1) * kstep;
            const char* a2 = last ? nA : cA + (size_t)(t + 2) * kstep; const char* b2 = last ? nB : cB + (size_t)(t + 2) * kstep;
            const char* a3 = a2 + kstep; const char* b3 = b2 + kstep;
            if (last && has_next) S.a_ready(nxt);
            PG8_LDB(B0, 0, 0); PG8_LDB(B1, 0, 1); PG8_SCHED; PG8_LDA(At, 0, 0); PG8_STAGE_A(PG8_SA(1, 1), a1, 1);
            if constexpr (GATHER) { if (last) {
#pragma unroll
                for (int h = 0; h < 2; ++h)
#pragma unroll
                    for (int i = 0; i < 2; ++i) cgo[h][i] = ngo[h][i]; } }
            PG8_WAIT_V(8); PG8_WAIT_L(0); PG8_BAR; PG8_MMA(0, 0, At, B0); PG8_MMA(0, 1, At, B1); PG8_BAR; PG8_SCHED;
            PG8_LDA(At, 0, 1); PG8_STAGE(PG8_SB(0, 0), b2, voffB); PG8_STAGE(PG8_SB(0, 1), b2 + hstep, voffB); PG8_STAGE_A(PG8_SA(0, 0), a2, 0);
            PG8_WAIT_V(8); PG8_WAIT_L(0); PG8_BAR; PG8_MMA(1, 0, At, B0); PG8_MMA(1, 1, At, B1); PG8_BAR; PG8_SCHED;
            PG8_LDB(B0, 1, 0); PG8_LDB(B1, 1, 1); PG8_SCHED; PG8_LDA(At, 1, 0); PG8_STAGE_A(PG8_SA(0, 1), a2, 1);
            PG8_WAIT_V(8); PG8_WAIT_L(0); PG8_BAR; PG8_MMA(0, 0, At, B0); PG8_MMA(0, 1, At, B1); PG8_BAR; PG8_SCHED;
            PG8_LDA(At, 1, 1); PG8_STAGE(PG8_SB(1, 0), b3, voffB); PG8_STAGE(PG8_SB(1, 1), b3 + hstep, voffB); PG8_STAGE_A(PG8_SA(1, 0), a3, 0);
            PG8_WAIT_V(8); PG8_WAIT_L(0); PG8_BAR; PG8_MMA(1, 0, At, B0); PG8_MMA(1, 1, At, B1); PG8_BAR; PG8_SCHED;
        }
#if PROBE_KLOOP
        const unsigned long long pk1_ = __builtin_amdgcn_s_memrealtime(); if (PROBE_WHAT == 0) pk_acc_ += (unsigned)(pk1_ - pk0_);
#endif
        if constexpr (ALIGN_EPI) { if (wr == 0) PG8_BAR; }
#if PROBE_KLOOP
        const unsigned long long pk2_ = __builtin_amdgcn_s_memrealtime(); if (PROBE_WHAT == 1) pk_acc_ += (unsigned)(pk2_ - pk1_);
#endif
        E(acc, cur, wr, wc, fr, fq); S.done(cur);
#if PROBE_KLOOP
        asm volatile("s_waitcnt vmcnt(0)" ::: "memory"); if (PROBE_WHAT == 2) pk_acc_ += (unsigned)(__builtin_amdgcn_s_memrealtime() - pk2_);
#endif
        if (!has_next) break;
#pragma unroll
        for (int a = 0; a < 2; ++a)
#pragma unroll
            for (int b = 0; b < 2; ++b)
#pragma unroll
                for (int m = 0; m < 4; ++m)
#pragma unroll
                    for (int n = 0; n < 2; ++n) acc[a][b][m][n] = (f32x4){0.f, 0.f, 0.f, 0.f};
        cur = nxt; cA = nA; cB = nB; ++ui;
        if constexpr (ALIGN_EPI) { if (wr == 1) PG8_BAR; }
    }
#if PROBE_KLOOP
    if (blockIdx.x == PROBE_BLK && tid == 0 && g.M == PROBE_KLOOP) atomicAdd(g.probe, pk_acc_);
#endif
    PG8_WAIT_V(0);
    if constexpr (!ALIGN_EPI) { if (wr == 0) PG8_BAR; }
    PG8_BAR;
#undef PG8_SA
#undef PG8_SB
#undef PG8_STAGE
#undef PG8_STAGE_A
#undef PG8_LDA
#undef PG8_LDB
#undef PG8_MMA
#undef PG8_CAT
#undef PG8_WAIT_V
#undef PG8_WAIT_L
#undef PG8_BAR
#undef PG8_SCHED
}
}
#include <hip/hip_bf16.h>
#include <cmath>
namespace attn_body {
using bf16=__hip_bfloat16;
using bf16x8=__attribute__((ext_vector_type(8)))short;
using s16x4=__attribute__((ext_vector_type(4)))short;
using f32x16=__attribute__((ext_vector_type(16)))float;
using u32x4=__attribute__((ext_vector_type(4)))unsigned;
constexpr int BATCH=8,SEQ=4096,D=64,DM=1024;
constexpr int NW=8,QBLK=32,QB=QBLK*NW,KVBLK=64,NQB=SEQ/QB;
__device__ __forceinline__ int crow(int r,int hi){return (r&3)+8*(r>>2)+4*hi;}
#define SBAR() __builtin_amdgcn_sched_barrier(0)
__device__ __forceinline__ void cmask(f32x16&p0,f32x16&p1,int jb,int qrel,int hi){
  const float NEG=-INFINITY; const int lim=qrel-64*jb-4*hi;
  #pragma unroll
  for(int r=0;r<16;++r){const int cr=(r&3)+8*(r>>2); if(cr>lim)p0[r]=NEG; if(cr+32>lim)p1[r]=NEG;}
}

constexpr int NSLOT=3, SLOTB=8192;
constexpr int LDS_K=0, LDS_V=NSLOT*SLOTB, LDS_WS=3*NSLOT*SLOTB, LDS_OST=LDS_WS+NW*64*4, LDS_BYTES=LDS_OST+NW*4096;
__device__ __forceinline__ void glds16(const void*sbase,unsigned voff,unsigned lds_dst){unsigned keep;
  asm volatile("s_mov_b32 %0, m0\n\ts_mov_b32 m0, %3\n\ts_nop 0\n\tglobal_load_lds_dwordx4 %1, %2\n\ts_mov_b32 m0, %0":"=&s"(keep):"v"(voff),"s"(sbase),"s"(lds_dst):"memory");}
__device__ __forceinline__ float max3f(float a,float b,float c){float r;asm("v_max3_f32 %0, %1, %2, %3":"=v"(r):"v"(a),"v"(b),"v"(c));return r;}
__device__ __forceinline__ float max2f(float a,float b){float r;asm("v_max_f32_e32 %0, %1, %2":"=v"(r):"v"(a),"v"(b));return r;}
__device__ __forceinline__ float fsub_s(float a,float b){float r;asm("v_sub_f32_e32 %0, %1, %2":"=v"(r):"v"(a),"v"(b));return r;}
typedef float f32x2_t __attribute__((ext_vector_type(2))); typedef __bf16 bf16x2_t __attribute__((ext_vector_type(2)));
__device__ __forceinline__ unsigned cvtpk_s(float lo,float hi){f32x2_t v={lo,hi};bf16x2_t b=__builtin_convertvector(v,bf16x2_t);return __builtin_bit_cast(unsigned,b);}
#define WAIT_BAR(N) asm volatile("s_waitcnt vmcnt(" #N ") lgkmcnt(0)\n\ts_barrier":::"memory")
#define MFMA32(a,b,c) __builtin_amdgcn_mfma_f32_32x32x16_bf16(a,b,c,0,0,0)

__device__ __forceinline__ void qkt(f32x16&p0,f32x16&p1,const char*Kslot,const bf16x8*qr,int r32,int hi){
  const char*kb=Kslot+hi*1024+r32*16;
  #pragma unroll
  for(int d0=0;d0<4;++d0){
    const bf16x8 b0=*reinterpret_cast<const bf16x8*>(kb+d0*2048);
    const bf16x8 b1=*reinterpret_cast<const bf16x8*>(kb+d0*2048+512);
    p0=MFMA32(b0,qr[d0],p0);p1=MFMA32(b1,qr[d0],p1);}
}
typedef __attribute__((address_space(3))) const char* lds_cptr;
typedef short v4i16_t __attribute__((ext_vector_type(4)));
__device__ __forceinline__ void kload8(bf16x8*kf,lds_cptr kp){
  kf[0]=*(const __attribute__((address_space(3))) bf16x8*)(kp);      kf[1]=*(const __attribute__((address_space(3))) bf16x8*)(kp+512);
  kf[2]=*(const __attribute__((address_space(3))) bf16x8*)(kp+2048); kf[3]=*(const __attribute__((address_space(3))) bf16x8*)(kp+2560);
  kf[4]=*(const __attribute__((address_space(3))) bf16x8*)(kp+4096); kf[5]=*(const __attribute__((address_space(3))) bf16x8*)(kp+4608);
  kf[6]=*(const __attribute__((address_space(3))) bf16x8*)(kp+6144); kf[7]=*(const __attribute__((address_space(3))) bf16x8*)(kp+6656);
}
__device__ __forceinline__ void kload2(bf16x8*kf,lds_cptr kp,int j){ kf[2*j]=*(const __attribute__((address_space(3))) bf16x8*)(kp+j*2048); kf[2*j+1]=*(const __attribute__((address_space(3))) bf16x8*)(kp+j*2048+512); }
__device__ __forceinline__ s16x4 vtr(lds_cptr p){ return __builtin_bit_cast(s16x4,__builtin_amdgcn_ds_read_tr16_b64_v4i16((__attribute__((address_space(3))) v4i16_t*)p)); }
__device__ __forceinline__ float rowmax(const f32x16&p0,const f32x16&p1){
  float a=max3f(p0[0],p0[1],p1[0]),b=max3f(p0[2],p0[3],p1[1]);a=max3f(a,p1[2],p1[3]);
  #pragma unroll
  for(int r=4;r<16;r+=4){a=max3f(a,p0[r],p0[r+1]);b=max3f(b,p0[r+2],p0[r+3]);a=max3f(a,p1[r],p1[r+1]);b=max3f(b,p1[r+2],p1[r+3]);}
  const float m=max2f(a,b);
  auto rr=__builtin_amdgcn_permlane32_swap(__float_as_uint(m),__float_as_uint(m),false,false);
  return max2f(__uint_as_float(rr[0]),__uint_as_float(rr[1]));
}
__device__ __forceinline__ void pv(f32x16*o,int vb,bf16x8 pa0,bf16x8 pa1,bf16x8 pa2,bf16x8 pa3){
  #pragma unroll
  for(int d0=0;d0<4;++d0){s16x4 lo[4],hi[4];
    #pragma unroll
    for(int ks=0;ks<4;++ks){
      asm volatile("ds_read_b64_tr_b16 %0,%1 offset:%c2":"=&v"(lo[ks]):"v"(vb),"i"(d0*4096+ks*1024):"memory");
      asm volatile("ds_read_b64_tr_b16 %0,%1 offset:%c2":"=&v"(hi[ks]):"v"(vb),"i"(d0*4096+ks*1024+512):"memory");}
    asm volatile("s_waitcnt lgkmcnt(0)":::"memory");SBAR();
    #define PK(k) (bf16x8){lo[k][0],lo[k][1],lo[k][2],lo[k][3],hi[k][0],hi[k][1],hi[k][2],hi[k][3]}
    o[d0]=MFMA32(pa0,PK(0),o[d0]);
    o[d0]=MFMA32(pa1,PK(1),o[d0]);
    o[d0]=MFMA32(pa2,PK(2),o[d0]);
    o[d0]=MFMA32(pa3,PK(3),o[d0]);
    #undef PK
  }
}

template<int THRL> __device__ __forceinline__ void attn_sub(int b,int qkcol,int vcol,int qb,int cmap,float sl2,float lam,int ntcap,float Ub,float oscale,const float*subg,unsigned*o1s,bf16*MIXh,const bf16*Q,const bf16*__restrict__ K,const bf16*__restrict__ V,char*shm,unsigned*pw_){
#if PROBE_ATT >= 3
  const unsigned long long ps0_=__builtin_amdgcn_s_memrealtime();
#endif
  const int tid=threadIdx.x,lane=tid&63,r32=lane&31,hi=lane>>5; const int wid=__builtin_amdgcn_readfirstlane(tid>>6);
  const long rowbase=(long)b*SEQ; const int q0=qb*QB;
  const bf16*Qw=Q+(rowbase+q0+wid*QBLK)*DM+qkcol;
  const bf16*Kh=K+rowbase*DM+qkcol,*Vh=V+rowbase*DM+vcol;
  const unsigned lds0=(unsigned)(uintptr_t)shm;
  float*wsf=(float*)(shm+LDS_WS)+wid*64;
  const unsigned koff=(unsigned)(lane*DM+wid*8)*2u, voffv=(unsigned)((16*(wid&3)+(lane>>2))*DM+(wid>>2)*32+(lane&3)*8)*2u;
  const unsigned kdst=lds0+LDS_K+wid*1024, vdst=lds0+LDS_V+wid*1024;
  const int NTR=(q0+QB)/KVBLK;
  int NT=NTR<ntcap?NTR:ntcap;
  #define DMA_K(t,slot) glds16(Kh+(long)(NTR-1-(t))*KVBLK*DM,koff,(unsigned)__builtin_amdgcn_readfirstlane(kdst+(slot)))
  #define DMA_V(t,slot) do{ glds16(Vh+(long)(NTR-1-(t))*KVBLK*DM,voffv,(unsigned)__builtin_amdgcn_readfirstlane(vdst+2*(slot))); glds16(Vh+(long)(NTR-1-(t))*KVBLK*DM+64,voffv,(unsigned)__builtin_amdgcn_readfirstlane(vdst+2*(slot)+8192)); }while(0)
  const char*Kbase=shm+LDS_K; bf16x8 kf[8];
  const lds_cptr shm3=(lds_cptr)shm; const lds_cptr kp0=shm3+LDS_K+hi*1024+r32*16; const lds_cptr vp0=shm3+LDS_V+((lane>>4)&1)*32+(lane&3)*8+(4*hi+((lane&15)>>2))*64;
  #define vb0 ((int)(unsigned)(uintptr_t)vp0)
  DMA_K(0,0);DMA_V(0,0);DMA_K(1,SLOTB);
  bf16x8 qr[4];
  #pragma unroll
  for(int d0=0;d0<4;++d0)qr[d0]=*reinterpret_cast<const bf16x8*>(&Qw[(long)r32*DM+d0*16+hi*8]);
  const int qrel=wid*QBLK+r32;
  const unsigned lm=hi?0u:0xffffffffu;
  const int qw0=wid*QBLK;
  unsigned bbx; { const unsigned sh=__float_as_uint(sl2)&0xffff0000u; const float sr=sl2-__uint_as_float(sh); bbx=((sh>>16)|(cvtpk_s(sr,0.f)<<16))&lm; }
  const float dlt=64.f*sl2;
  float cref=sl2*(float)(192-qrel);
  #define BIAS2(C0,C1,t) do{ const float c_=__builtin_fmaf(-dlt,(float)(t),cref); const unsigned h_=__float_as_uint(c_)&0xffff0000u; const float r1_=c_-__uint_as_float(h_); \
      const unsigned m_=__float_as_uint(r1_)&0xffff0000u; const float r2_=r1_-__uint_as_float(m_); \
      int q_=qrel; asm volatile("":"+v"(q_)); const float rf_=(float)(q_-qw0); \
      u32x4 b_=(u32x4){bbx,((h_>>16)|m_)&lm,(__float_as_uint(r2_)>>16)&lm,0u}; u32x4 a_=(u32x4){cvtpk_s(rf_,rf_),0x3F803F80u,0x00003F80u,0u}; asm volatile("":"+v"(a_),"+v"(b_)); \
      const f32x16 z_=f32x16{}; C0=MFMA32(__builtin_bit_cast(bf16x8,a_),__builtin_bit_cast(bf16x8,b_),z_); \
      a_.x=cvtpk_s(rf_+32.f,rf_+32.f); asm volatile("":"+v"(a_)); C1=MFMA32(__builtin_bit_cast(bf16x8,a_),__builtin_bit_cast(bf16x8,b_),z_); }while(0)
  float l_reg=0.f;f32x16 o[4];o[0]=f32x16{};o[1]=f32x16{};o[2]=f32x16{};o[3]=f32x16{};
  #define CMASK(P0,P1,t) do{int jb_=3-(t); if(jb_>=0)cmask(P0,P1,jb_,qrel,hi);}while(0)
  bool resc=false;
  #define START(P0,P1) do{ const float rm=rowmax(P0,P1); resc=false; \
    if(__any(rm>(float)THRL)){ const float dl=max2f(rm,0.f); cref=fsub_s(cref,dl); \
      _Pragma("unroll") for(int r=0;r<16;++r){P0[r]=fsub_s(P0[r],dl);P1[r]=fsub_s(P1[r],dl);} } \
    _Pragma("unroll") for(int r=0;r<16;++r)P0[r]=__builtin_amdgcn_exp2f(P0[r]); }while(0)
  #define RESC() do{ if(resc){ asm volatile("s_waitcnt lgkmcnt(0)":::"memory"); \
      _Pragma("unroll") for(int d_=0;d_<4;++d_) _Pragma("unroll") for(int r=0;r<16;++r)o[d_][r]*=wsf[crow(r,hi)]; } }while(0)
  f32x16 pA0,pA1,pB0,pB1;
  int sl_prev=0,sl_cur=0,sl_next=SLOTB;
  #define ROT() do{sl_prev=sl_cur;sl_cur=sl_next;sl_next=(sl_next==(NSLOT-1)*SLOTB)?0:sl_next+SLOTB;}while(0)
  DMA_K(2,2*SLOTB);
  WAIT_BAR(3);
  BIAS2(pA0,pA1,0);
  qkt(pA0,pA1,Kbase,qr,r32,hi);asm volatile("s_nop 15\n\ts_nop 7":"+v"(pA0),"+v"(pA1));CMASK(pA0,pA1,0);
  START(pA0,pA1);
  _Pragma("unroll") for(int r=0;r<16;++r)pA1[r]=__builtin_amdgcn_exp2f(pA1[r]);
  WAIT_BAR(0);
  DMA_K(3,0);DMA_V(1,SLOTB);
  ROT();
  kload8(kf,kp0+sl_cur);
  WAIT_BAR(3);
  s16x4 vlo[8],vhi[8]; u32x4 pw0,pw1,pw2,pw3;
  #define PKW(P,B) cvtpk_s(P[B],P[B+1])
  #define PAF(k) __builtin_bit_cast(bf16x8,pw##k)
  #define VFR(i) (bf16x8){vlo[i][0],vlo[i][1],vlo[i][2],vlo[i][3],vhi[i][0],vhi[i][1],vhi[i][2],vhi[i][3]}
  #define PIN(x) asm volatile("":"+v"(x))
  #define MX3(a,b,c) __builtin_fmaxf(__builtin_fmaxf((a),(b)),(c))
  #define GAPA(MF,A0,A1,A2,A3,W0,W1,PW) do{ MF; sacc+=A0; sacc+=A1; sacc+=A2; sacc+=A3; PIN(sacc); W0; W1; PIN(PW); SBAR(); }while(0)
  #define EX(v) __builtin_amdgcn_exp2f(v)
  #define GAPB(MF,X,B) do{ MF; X[B]=EX(X[B]); X[B+1]=EX(X[B+1]); PIN(X); SBAR(); }while(0)
  #define VRD2(i) do{ vlo[i]=vtr(vp_+(8192+((i)>>2)*4096+((i)&3)*1024)); vhi[i]=vtr(vp_+(8192+((i)>>2)*4096+((i)&3)*1024+512)); SBAR(); }while(0)
  #define VRD(i) do{ vlo[i]=vtr(vp_+(((i)>>2)*4096+((i)&3)*1024)); vhi[i]=vtr(vp_+(((i)>>2)*4096+((i)&3)*1024+512)); }while(0)
  #define KRD(G,j) do{ if(G){ kload2(kf,kp0+sl_next,j); SBAR(); } }while(0)
  #define STEP(C0,C1,P0,P1,t,GK,GV,GL) do{ SBAR(); \
    BIAS2(C0,C1,t); SBAR(); \
    const lds_cptr vp_=vp0+2*sl_prev; \
    VRD(0); SBAR(); float sacc=(P0[0]+P0[1]); \
    GAPA(C0=MFMA32(kf[0],qr[0],C0), P0[2],P0[3],P0[4],P0[5],     pw0[0]=PKW(P0,0), pw0[1]=PKW(P0,2), pw0); \
    VRD(4); SBAR(); GAPA(C1=MFMA32(kf[1],qr[0],C1), P0[6],P0[7],P0[8],P0[9],     pw0[2]=PKW(P0,4), pw0[3]=PKW(P0,6), pw0); \
    VRD(1); SBAR(); GAPA(C0=MFMA32(kf[2],qr[1],C0),   P0[10],P0[11],P0[12],P0[13], pw1[0]=PKW(P0,8), pw1[1]=PKW(P0,10), pw1); \
    VRD(5); SBAR(); GAPA(C1=MFMA32(kf[3],qr[1],C1),   P0[14],P0[15],P1[0],P1[1],   pw1[2]=PKW(P0,12),pw1[3]=PKW(P0,14), pw1); \
    VRD(2); SBAR(); GAPA(C0=MFMA32(kf[4],qr[2],C0),   P1[2],P1[3],P1[4],P1[5],     pw2[0]=PKW(P1,0), pw2[1]=PKW(P1,2), pw2); \
    VRD(6); SBAR(); GAPA(C1=MFMA32(kf[5],qr[2],C1),   P1[6],P1[7],P1[8],P1[9],     pw2[2]=PKW(P1,4), pw2[3]=PKW(P1,6), pw2); \
    VRD(3); SBAR(); GAPA(C0=MFMA32(kf[6],qr[3],C0),   P1[10],P1[11],P1[12],P1[13], pw3[0]=PKW(P1,8), pw3[1]=PKW(P1,10), pw3); \
    VRD(7); SBAR(); GAPA(C1=MFMA32(kf[7],qr[3],C1),   P1[14],P1[15],0.f,0.f,       pw3[2]=PKW(P1,12),pw3[3]=PKW(P1,14), pw3); \
    l_reg+=sacc; \
    if(GK){DMA_K((t)+3,sl_cur);} if(GV){DMA_V((t)+1,sl_next);} \
    CMASK(C0,C1,t); \
    { float a=MX3(C0[0],C0[1],C1[0]),b=MX3(C0[2],C0[3],C1[1]); a=MX3(a,C1[2],C1[3]); \
      _Pragma("unroll") for(int r=4;r<16;r+=4){a=MX3(a,C0[r],C0[r+1]);b=MX3(b,C0[r+2],C0[r+3]);a=MX3(a,C1[r],C1[r+1]);b=MX3(b,C1[r+2],C1[r+3]);} \
      float rm=__builtin_fmaxf(a,b); { auto rr=__builtin_amdgcn_permlane32_swap(__float_as_uint(rm),__float_as_uint(rm),false,false); rm=__builtin_fmaxf(__uint_as_float(rr[0]),__uint_as_float(rr[1])); } \
      resc=false; \
      if(__builtin_expect(__any(rm>(float)THRL),0)){ const float dl=__builtin_fmaxf(rm,0.f); cref-=dl; \
        _Pragma("unroll") for(int r=0;r<16;++r){C0[r]-=dl;C1[r]-=dl;} \
        const float f=__builtin_amdgcn_exp2f(-dl); l_reg*=f; if(hi==0)wsf[r32]=f; resc=true; } } \
    SBAR(); \
    GAPB(o[0]=MFMA32(PAF(0),VFR(0),o[0]), C0,0);  VRD2(0); \
    GAPB(o[1]=MFMA32(PAF(0),VFR(4),o[1]), C0,2);  VRD2(4); \
    KRD(GL,0); GAPB(o[0]=MFMA32(PAF(1),VFR(1),o[0]), C0,4);  VRD2(1); \
    KRD(GL,1); GAPB(o[1]=MFMA32(PAF(1),VFR(5),o[1]), C0,6);  VRD2(5); \
    KRD(GL,2); GAPB(o[0]=MFMA32(PAF(2),VFR(2),o[0]), C0,8);  VRD2(2); \
    KRD(GL,3); GAPB(o[1]=MFMA32(PAF(2),VFR(6),o[1]), C0,10); VRD2(6); \
    GAPB(o[0]=MFMA32(PAF(3),VFR(3),o[0]), C0,12); VRD2(3); \
    GAPB(o[1]=MFMA32(PAF(3),VFR(7),o[1]), C0,14); VRD2(7); \
    GAPB(o[2]=MFMA32(PAF(0),VFR(0),o[2]), C1,0); \
    GAPB(o[3]=MFMA32(PAF(0),VFR(4),o[3]), C1,2); \
    GAPB(o[2]=MFMA32(PAF(1),VFR(1),o[2]), C1,4); \
    GAPB(o[3]=MFMA32(PAF(1),VFR(5),o[3]), C1,6); \
    GAPB(o[2]=MFMA32(PAF(2),VFR(2),o[2]), C1,8); \
    GAPB(o[3]=MFMA32(PAF(2),VFR(6),o[3]), C1,10); \
    GAPB(o[2]=MFMA32(PAF(3),VFR(3),o[2]), C1,12); \
    GAPB(o[3]=MFMA32(PAF(3),VFR(7),o[3]), C1,14); \
    }while(0)
  #define ENDW(tt) do{ if((tt)+3<NT){WAIT_BAR(3);} else if((tt)+2<NT){WAIT_BAR(2);} else {WAIT_BAR(0);} }while(0)
#if PROBE_ATT == 3
  if(blockIdx.x==PROBE_BLK&&threadIdx.x==0)atomicAdd(pw_,(unsigned)(__builtin_amdgcn_s_memrealtime()-ps0_));
#endif
  int t=1;
  for(;t<5&&t+1<NT;t+=2){
    STEP(pB0,pB1,pA0,pA1,t,(t+3<NT),(t+1<NT),(t+1<NT));       ENDW(t);   RESC(); ROT();
    STEP(pA0,pA1,pB0,pB1,t+1,(t+4<NT),(t+2<NT),(t+2<NT));     ENDW(t+1); RESC(); ROT();
  }
  #undef CMASK
  #define CMASK(P0,P1,t) do{}while(0)
  for(;t+5<NT;t+=2){
    if((t&15)==5){
    float lt=l_reg; {auto rr=__builtin_amdgcn_permlane32_swap(__float_as_uint(lt),__float_as_uint(lt),false,false);lt=__uint_as_float(rr[0])+__uint_as_float(rr[1]);}
    float dl2=(sl2*(float)(192-qrel)-cref)+__builtin_amdgcn_logf(lt);
    #define DPPMIN(ctl) dl2=__builtin_fminf(dl2,__uint_as_float((unsigned)__builtin_amdgcn_update_dpp(0,(int)__float_as_uint(dl2),ctl,0xF,0xF,false)))
    DPPMIN(0xB1); DPPMIN(0x4E); DPPMIN(0x141); DPPMIN(0x140);
    #undef DPPMIN
    { auto rr=__builtin_amdgcn_permlane16_swap(__float_as_uint(dl2),__float_as_uint(dl2),false,false); dl2=__builtin_fminf(__uint_as_float(rr[0]),__uint_as_float(rr[1])); }
    float*xw=(float*)(shm+LDS_OST);
    if(lane==0)xw[wid]=dl2;
    asm volatile("s_waitcnt lgkmcnt(0)\n\ts_barrier":::"memory");
    float dmin=xw[0];
    #pragma unroll
    for(int w_=1;w_<8;++w_)dmin=__builtin_fminf(dmin,xw[w_]);
    dmin=__uint_as_float(__builtin_amdgcn_readfirstlane(__float_as_uint(dmin)));
    const float d0_=(Ub-dmin+24.f+log2f(1.f/(1.f-exp2f(-sl2))))/sl2; float st_=ceilf((d0_+255.f)*(1.f/64.f)); const float lo_=(float)(t+5); st_=st_<lo_?lo_:(st_>64.f?64.f:st_);
    const int nc_=__builtin_amdgcn_readfirstlane((((int)st_)+1)&~1); if(nc_<NT)NT=nc_;
    asm volatile("s_waitcnt lgkmcnt(0)":::"memory");
  }
    STEP(pB0,pB1,pA0,pA1,t,true,true,true);     WAIT_BAR(3); RESC(); ROT();
    STEP(pA0,pA1,pB0,pB1,t+1,true,true,true);   WAIT_BAR(3); RESC(); ROT();
  }
  for(;t+1<NT;t+=2){
    STEP(pB0,pB1,pA0,pA1,t,(t+3<NT),(t+1<NT),(t+1<NT));       ENDW(t);   RESC(); ROT();
    STEP(pA0,pA1,pB0,pB1,t+1,(t+4<NT),(t+2<NT),(t+2<NT));     ENDW(t+1); RESC(); ROT();
  }
  #undef CMASK
  #define CMASK(P0,P1,t) do{int jb_=3-(t); if(jb_>=0)cmask(P0,P1,jb_,qrel,hi);}while(0)
  STEP(pB0,pB1,pA0,pA1,NT-1,false,false,false); RESC();
#if PROBE_ATT == 4
  const unsigned long long ps1_=__builtin_amdgcn_s_memrealtime();
#endif
  { float sacc=pB0[0]+pB0[1]; _Pragma("unroll") for(int r=2;r<16;++r)sacc+=pB0[r]; _Pragma("unroll") for(int r=0;r<16;++r)sacc+=pB1[r]; l_reg+=sacc;
    pw0=(u32x4){PKW(pB0,0),PKW(pB0,2),PKW(pB0,4),PKW(pB0,6)};pw1=(u32x4){PKW(pB0,8),PKW(pB0,10),PKW(pB0,12),PKW(pB0,14)};pw2=(u32x4){PKW(pB1,0),PKW(pB1,2),PKW(pB1,4),PKW(pB1,6)};pw3=(u32x4){PKW(pB1,8),PKW(pB1,10),PKW(pB1,12),PKW(pB1,14)};
    SBAR(); pv(o,vb0+2*sl_cur,PAF(0),PAF(1),PAF(2),PAF(3)); }
  #undef PKW
  #undef PAF
  #undef VFR
  #undef PIN
  #undef MX3
  #undef GAPA
  #undef GAPB
  #undef EX
  #undef VRD
  #undef VRD2
  #undef KRD
  #undef STEP
  #undef ENDW
  { int tid_e=threadIdx.x; asm volatile("":"+v"(tid_e)); const int lane=tid_e&63,r32=lane&31,hi=lane>>5; const int wid=__builtin_amdgcn_readfirstlane(tid_e>>6);
    float*wsf=(float*)(shm+LDS_WS)+wid*64;
  {auto rr=__builtin_amdgcn_permlane32_swap(__float_as_uint(l_reg),__float_as_uint(l_reg),false,false);l_reg=__uint_as_float(rr[0])+__uint_as_float(rr[1]);}
  if(hi==0)wsf[32+r32]=l_reg;asm volatile("s_waitcnt lgkmcnt(0)":::"memory");
  float rli[16];
  #pragma unroll
  for(int r=0;r<16;++r)rli[r]=__builtin_amdgcn_rcpf(wsf[32+crow(r,hi)]);
  u32x4*ow=(u32x4*)(o1s+wid*2048)+lane;
  if(cmap==0){
    #pragma unroll
    for(int i=0;i<8;++i){ const int dq=i>>1,r0=8*(i&1); u32x4 w;
      w.x=cvtpk_s(o[dq][r0+0]*rli[r0+0],o[dq][r0+1]*rli[r0+1]); w.y=cvtpk_s(o[dq][r0+2]*rli[r0+2],o[dq][r0+3]*rli[r0+3]);
      w.z=cvtpk_s(o[dq][r0+4]*rli[r0+4],o[dq][r0+5]*rli[r0+5]); w.w=cvtpk_s(o[dq][r0+6]*rli[r0+6],o[dq][r0+7]*rli[r0+7]); ow[i*64]=w; }
  } else {
    bf16*stg=(bf16*)(shm+LDS_OST)+wid*2048;
    const int row=lane>>1,part=lane&1; float v[64]; float ss=0.f;
    unsigned o1w[32];
    #pragma unroll
    for(int i=0;i<8;++i){ const u32x4 w=ow[i*64]; o1w[4*i+0]=w.x; o1w[4*i+1]=w.y; o1w[4*i+2]=w.z; o1w[4*i+3]=w.w; }
    #pragma unroll
    for(int p_=0;p_<2;++p_){
      #pragma unroll
      for(int d0=0;d0<2;++d0){ const int dq=2*p_+d0;
        #pragma unroll
        for(int rp=0;rp<8;++rp){ const unsigned w=o1w[dq*8+rp];
          const float a0=__uint_as_float(w<<16)-lam*(o[dq][2*rp]*rli[2*rp]), a1=__uint_as_float(w&0xffff0000u)-lam*(o[dq][2*rp+1]*rli[2*rp+1]);
          stg[crow(2*rp,hi)*64+d0*32+r32]=__float2bfloat16(a0); stg[crow(2*rp+1,hi)*64+d0*32+r32]=__float2bfloat16(a1); } }
      asm volatile("s_waitcnt lgkmcnt(0)":::"memory");
      #pragma unroll
      for(int i=0;i<4;++i){ const u32x4 w=*(const u32x4*)(stg+row*64+part*32+8*i);
        v[32*p_+8*i+0]=__uint_as_float(w.x<<16); v[32*p_+8*i+1]=__uint_as_float(w.x&0xffff0000u); v[32*p_+8*i+2]=__uint_as_float(w.y<<16); v[32*p_+8*i+3]=__uint_as_float(w.y&0xffff0000u);
        v[32*p_+8*i+4]=__uint_as_float(w.z<<16); v[32*p_+8*i+5]=__uint_as_float(w.z&0xffff0000u); v[32*p_+8*i+6]=__uint_as_float(w.w<<16); v[32*p_+8*i+7]=__uint_as_float(w.w&0xffff0000u); }
      asm volatile("s_waitcnt lgkmcnt(0)":::"memory");
    }
    #pragma unroll
    for(int i=0;i<64;++i)ss+=v[i]*v[i];
    ss+=__uint_as_float((unsigned)__builtin_amdgcn_update_dpp(0,(int)__float_as_uint(ss),0xB1,0xF,0xF,false));
    const float rs=(1.0f/sqrtf(ss*(1.0f/128.0f)+1e-6f))*oscale;
    bf16*op=MIXh+((long)rowbase+q0+wid*QBLK+row)*2048+part*32;
    #pragma unroll
    for(int p_=0;p_<2;++p_){ const float*sg=subg+64*p_+32*part;
      #pragma unroll
      for(int i=0;i<4;++i){ u32x4 w; const float*vv=v+32*p_+8*i; const float*gg=sg+8*i;
        w.x=cvtpk_s(vv[0]*rs*gg[0],vv[1]*rs*gg[1]); w.y=cvtpk_s(vv[2]*rs*gg[2],vv[3]*rs*gg[3]); w.z=cvtpk_s(vv[4]*rs*gg[4],vv[5]*rs*gg[5]); w.w=cvtpk_s(vv[6]*rs*gg[6],vv[7]*rs*gg[7]);
        *(u32x4*)(op+64*p_+8*i)=w; } }
  }
  }
  asm volatile("s_waitcnt lgkmcnt(0)\n\ts_barrier":::"memory");
#if PROBE_ATT == 4
  if(blockIdx.x==PROBE_BLK&&threadIdx.x==0)atomicAdd(pw_,(unsigned)(__builtin_amdgcn_s_memrealtime()-ps1_));
#endif
  #undef DMA_K
  #undef DMA_V
  #undef vb0
  #undef CMASK
  #undef START
  #undef RESC
  #undef ROT
  #undef BIAS2
}
constexpr int ATTN_LDS_BYTES=LDS_BYTES;
template<int THRL> __device__ __forceinline__ void attn_unit4(int b,int h,int qb,float lam,float oscale,const float*subg,const unsigned*nmax,unsigned*o1s,const bf16*Q,const bf16*K,const bf16*V,bf16*MIX,char*shm){
  const float sl2=exp2f(-(float)(h+1))*1.4426950408889634f;
  int cap[2]; float Uv[2];
  #pragma unroll
  for(int c=0;c<2;++c){ const int bh=b*8+h; const unsigned*qn=nmax+((0*64+bh)*2+c)*2,*kn=nmax+((1*64+bh)*2+c)*2;
    const float U=1.02f*(sqrtf(__uint_as_float(qn[0])*__uint_as_float(kn[0]))+sqrtf(__uint_as_float(qn[1])*__uint_as_float(kn[1])));
    const float d0=(2.f*U+24.f+log2f(1.f/(1.f-exp2f(-sl2))))/sl2; float st=ceilf((d0+255.f)*(1.f/64.f)); st=st<4.f?4.f:(st>64.f?64.f:st);
    cap[c]=__builtin_amdgcn_readfirstlane((((int)st)+1)&~1); Uv[c]=__uint_as_float(__builtin_amdgcn_readfirstlane(__float_as_uint(U))); }
  for(int c=0;c<2;++c) attn_sub<THRL>(b,(2*h+c)*64,h*128,qb,c,sl2,lam,c?cap[1]:cap[0],c?Uv[1]:Uv[0],oscale,subg,o1s,MIX+h*128,Q,K,V,shm,(unsigned*)nmax+900);
}
__device__ __forceinline__ int wg_pop(unsigned*ctr,volatile __attribute__((address_space(3))) unsigned*slot){
  if(threadIdx.x==0)*slot=__hip_atomic_fetch_add(ctr,1u,__ATOMIC_RELAXED,__HIP_MEMORY_SCOPE_AGENT);
  __syncthreads(); const unsigned n=*slot; __syncthreads(); return (int)n;
}
template<int THRL=8> __device__ __forceinline__ void attn_phase(char*lds,int bx,unsigned*qctr,volatile __attribute__((address_space(3))) unsigned*slot,float lam,float oscale,const float*subg,const unsigned*nmax,unsigned*o1s,const bf16*Q,const bf16*K,const bf16*V,bf16*MIX){
  for(int qi=0;qi<8;++qi){ const int x=(bx+qi)&7;
    for(;;){ const int n=wg_pop(qctr+64*x,slot); if(n>=128)break;
      const int qb=15-(n>>3),h=7-(n&7),b=(x+h)&7;
#if PROBE_ATT == 1
      const unsigned long long pa0_=__builtin_amdgcn_s_memrealtime();
#endif
      attn_unit4<THRL>(b,h,qb,lam,oscale,subg,nmax,o1s,Q,K,V,MIX,lds);
#if PROBE_ATT == 1
      if(blockIdx.x==PROBE_BLK&&threadIdx.x==0)atomicAdd((unsigned*)nmax+900,(unsigned)(__builtin_amdgcn_s_memrealtime()-pa0_));
#endif
    } }
}
#undef SBAR
#undef WAIT_BAR
#undef MFMA32
}
#define GAS __attribute__((address_space(1)))
#define LAS __attribute__((address_space(3)))
typedef unsigned short bf16;
typedef unsigned v4u __attribute__((ext_vector_type(4)));
typedef float f32x4 __attribute__((ext_vector_type(4)));
typedef short bf16x8 __attribute__((ext_vector_type(8)));
typedef GAS unsigned gu32;
typedef GAS unsigned long long gu64;
#define RLX_AGENT __ATOMIC_RELAXED, __HIP_MEMORY_SCOPE_AGENT
#define LDS_WAIT() asm volatile("s_waitcnt lgkmcnt(0)" ::: "memory")
#define VM_WAIT() asm volatile("s_waitcnt vmcnt(0)" ::: "memory")
__device__ __forceinline__ unsigned long long rt() { return __builtin_amdgcn_s_memrealtime(); }
__device__ __forceinline__ unsigned f2bf(float f) { unsigned u = __builtin_bit_cast(unsigned, f); return (u + 0x7fffu + ((u >> 16) & 1u)) >> 16; }
__device__ __forceinline__ unsigned pk2(float lo, float hi) { return f2bf(lo) | (f2bf(hi) << 16); }

#define XB_TMO      128
#define XB_XCNT(j)  (256  + 64 * (j))
#define XB_XSUB(j)  (1280 + 64 * (j))
#define XB_XGEN(j)  (2304 + 64 * (j))
#define XB_TOP      3328
#define XB_TOPGEN   3392
#define XCD_BAR_WORDS 3456
#define XB_SPIN_CAP (1u << 18)

__device__ __forceinline__ unsigned xb_ld(unsigned* p)              { return __hip_atomic_load(p, __ATOMIC_RELAXED, __HIP_MEMORY_SCOPE_AGENT); }
__device__ __forceinline__ unsigned xb_add(unsigned* p, unsigned v) { return __hip_atomic_fetch_add(p, v, __ATOMIC_RELAXED, __HIP_MEMORY_SCOPE_AGENT); }
__device__ __forceinline__ unsigned xb_xcc_id() { return (unsigned)__builtin_amdgcn_s_getreg((3 << 11) | 20) & 0xFu; }
#define XB_SPIN(cond, bar) do { unsigned _sp = 0; while (cond) { __builtin_amdgcn_s_sleep(1); \
    if ((++_sp & 255u) == 0u) { if (xb_ld(&(bar)[XB_TMO])) break; if (_sp > XB_SPIN_CAP) { atomicAdd(&(bar)[XB_TMO], 1u); break; } } } } while (0)

struct XcdBarrier {
    unsigned* bar; unsigned x;
    volatile LAS unsigned* st;
};

__device__ __forceinline__ XcdBarrier xcd_barrier_post(unsigned* bar, volatile LAS unsigned* st) {
    XcdBarrier b; b.bar = bar; b.x = xb_xcc_id(); b.st = st;
    if (threadIdx.x == 0) (void)xb_add(&bar[XB_XCNT(b.x)], 1u);
    return b;
}
__device__ __forceinline__ void xcd_barrier_complete(unsigned* bar, unsigned x, unsigned& nloc, unsigned& nx) {
    const unsigned G = gridDim.x * gridDim.y * gridDim.z;
    unsigned sum, cnt, mine, sp = 0u;
    for (;;) {
        sum = 0u; cnt = 0u; mine = 0u;
#pragma unroll
        for (unsigned j = 0; j < 16; ++j) { const unsigned c = xb_ld(&bar[XB_XCNT(j)]); sum += c; cnt += (c > 0u) ? 1u : 0u; mine = (j == x) ? c : mine; }
        if (sum == G) break;
        __builtin_amdgcn_s_sleep(1);
        if ((++sp & 255u) == 0u) { if (xb_ld(&bar[XB_TMO])) break; if (sp > XB_SPIN_CAP) { atomicAdd(&bar[XB_TMO], 1u); break; } }
    }
    nloc = mine > 0u ? mine : 1u; nx = cnt > 0u ? cnt : 1u;
}

__device__ __forceinline__ void xcd_barrier(const XcdBarrier& b) {
    asm volatile("s_waitcnt vmcnt(0)" ::: "memory");
    __syncthreads();
    if (threadIdx.x == 0) {
        unsigned* bar = b.bar;
        __builtin_amdgcn_s_waitcnt(0);
        unsigned nloc = b.st[0], nx = b.st[1];
        if (nloc == 0u) { xcd_barrier_complete(bar, b.x, nloc, nx); b.st[0] = nloc; b.st[1] = nx; }
        const unsigned old = xb_add(&bar[XB_XSUB(b.x)], 1u);
        const unsigned gen = old / nloc;
        if (old + 1u == (gen + 1u) * nloc) {
            __builtin_amdgcn_fence(__ATOMIC_RELEASE, "agent");
            asm volatile("s_waitcnt vmcnt(0)" ::: "memory");
            const unsigned og = xb_add(&bar[XB_TOP], 1u);
            const unsigned tg = og / nx;
            if (og + 1u == (tg + 1u) * nx) xb_add(&bar[XB_TOPGEN], 1u);
            else XB_SPIN(xb_ld(&bar[XB_TOPGEN]) == tg, bar);
            __builtin_amdgcn_fence(__ATOMIC_ACQUIRE, "agent");
            xb_add(&bar[XB_XGEN(b.x)], 1u);
            asm volatile("s_waitcnt vmcnt(0)" ::: "memory");
        } else {
            XB_SPIN(xb_ld(&bar[XB_XGEN(b.x)]) == gen, bar);
            __builtin_amdgcn_fence(__ATOMIC_ACQUIRE, "agent");
            asm volatile("s_waitcnt vmcnt(0)" ::: "memory");
        }
    }
    __syncthreads();
}

constexpr int NWAVES = 8;
constexpr int BATCH = 8, SEQ = 4096, T = BATCH * SEQ, D = 2048, NIN = 5120, NEXP = 32, NA = 2 * T;
constexpr float EPS = 1e-6f, LOG2E = 1.4426950408889634f, C2 = 0.125f * 1.4426950408889634f;
constexpr size_t MiB = 1u << 20;
constexpr size_t WS_CTL = 0, CTL_ZERO_BYTES = 1 * MiB;
constexpr size_t WS_RSTD1 = 1 * MiB, WS_RSTD2 = WS_RSTD1 + 128 * 1024, WS_WTS = WS_RSTD2 + 128 * 1024;
constexpr size_t WS_LIST = 2 * MiB;
constexpr size_t WS_PART = 6 * MiB;
constexpr size_t WS_WIN = 10 * MiB, WS_WOUT = 30 * MiB;
constexpr size_t WS_WGU = 38 * MiB, WS_WD = 166 * MiB;
constexpr size_t WS_XB = 230 * MiB;
constexpr size_t WS_CG = 358 * MiB;
constexpr size_t WS_MIX = 422 * MiB;
constexpr size_t WS_HB = 550 * MiB;
constexpr size_t WS_HB8 = 678 * MiB;
constexpr size_t WS_WR = 742 * MiB;
constexpr size_t WS_X8 = 743 * MiB;
constexpr size_t WS_WIN8 = 807 * MiB;
constexpr size_t WS_O1S = 811 * MiB;
constexpr size_t WS_LISTW = 827 * MiB, WS_LISTR = 831 * MiB;
constexpr size_t WS_END = 835 * MiB;
constexpr float WSCALE = 32.f, H1SCALE = 4.f, YSCALE = 8.f;
constexpr int CW_TMO = 0, CW_CODE = 1, CW_BAR = 4096, CW_CNT = 8192;
constexpr int CW_GQ = 20480;
constexpr int CW_H8Q = 24576 + 1024;
constexpr int CW_CVQ = 24576, CW_DONE = 24576 + 64;
constexpr int CW_QA = 12288, CW_QC = 12288 + 512, CW_NMAX = 16384;
constexpr int RING_OFF = 0, RING_BYTES = 131072, LDSCTL_OFF = RING_BYTES, MISC_OFF = LDSCTL_OFF + 320, TAB_OFF = LDSCTL_OFF + 1024;
constexpr int LDS_BYTES = 147456;
constexpr int NPHASE = 8;
#ifndef MK_ONE_LAUNCH
#define MK_ONE_LAUNCH 1
#endif
#ifndef PROBE_DOUBLE
#define PROBE_DOUBLE 0
#endif
#ifndef PROBE_CLOCK
#define PROBE_CLOCK 0
#endif
#ifndef USE_NAIVE_ROUTER
#define USE_NAIVE_ROUTER 0
#endif
#ifndef USE_NAIVE_ATTN
#define USE_NAIVE_ATTN 0
#endif


typedef unsigned u32x4g __attribute__((ext_vector_type(4)));
__device__ __forceinline__ float wave_sum(float v) {
#pragma unroll
    for (int o = 1; o < 64; o <<= 1) v += __shfl_xor(v, o);
    return v;
}
__device__ __forceinline__ float bflo(unsigned w) { return __builtin_bit_cast(float, w << 16); }
__device__ __forceinline__ float bfhi(unsigned w) { return __builtin_bit_cast(float, w & 0xffff0000u); }
__device__ __forceinline__ float fexp2(float x) { return __builtin_amdgcn_exp2f(x); }

__device__ __forceinline__ void tr_item(const float* W, int N, const float* gk, int k0, int n0, bf16* dst, int dstK, LAS float* scr, int lane) {
    const int kr = lane >> 3, n4 = 4 * (lane & 7); f32x4 v[8];
#pragma unroll
    for (int i = 0; i < 8; ++i) v[i] = *(const GAS f32x4*)(W + (size_t)(k0 + 8 * i + kr) * N + n0 + n4);
#pragma unroll
    for (int i = 0; i < 8; ++i) { const int kk = 8 * i + kr; const float g = gk ? gk[k0 + kk] : 1.0f;
        scr[(n4 + 0) * 66 + kk] = v[i].x * g; scr[(n4 + 1) * 66 + kk] = v[i].y * g; scr[(n4 + 2) * 66 + kk] = v[i].z * g; scr[(n4 + 3) * 66 + kk] = v[i].w * g; }
    LDS_WAIT(); asm volatile("" ::: "memory");
    const int c = lane & 7;
#pragma unroll
    for (int j = 0; j < 4; ++j) { const int n = (lane >> 3) + 8 * j; const LAS float* s = scr + n * 66 + 8 * c;
        v4u o; o.x = pk2(s[0], s[1]); o.y = pk2(s[2], s[3]); o.z = pk2(s[4], s[5]); o.w = pk2(s[6], s[7]);
        *(GAS v4u*)(dst + (size_t)n * dstK + 8 * c) = o; }
    LDS_WAIT(); asm volatile("" ::: "memory");
}
__device__ __forceinline__ void tr8_load(const float* W, int N, int k0, int n0, int lane, f32x4 (&v)[8]) {
    const int kr = lane >> 3, n4 = 4 * (lane & 7);
#pragma unroll
    for (int i = 0; i < 8; ++i) v[i] = *(const GAS f32x4*)(W + (size_t)(k0 + 8 * i + kr) * N + n0 + n4);
}
__device__ __forceinline__ void tr8_finish(const f32x4 (&v)[8], const float* gk, float scale, int k0, unsigned char* dst, int dstK, LAS float* scr, int lane) {
    const int kr = lane >> 3, n4 = 4 * (lane & 7);
#pragma unroll
    for (int i = 0; i < 8; ++i) { const int kk = 8 * i + kr; const float g = (gk ? gk[k0 + kk] : 1.0f) * scale;
        scr[(n4 + 0) * 66 + kk] = v[i].x * g; scr[(n4 + 1) * 66 + kk] = v[i].y * g; scr[(n4 + 2) * 66 + kk] = v[i].z * g; scr[(n4 + 3) * 66 + kk] = v[i].w * g; }
    LDS_WAIT(); asm volatile("" ::: "memory");
    const int c = lane & 7;
#pragma unroll
    for (int j = 0; j < 4; ++j) { const int n = (lane >> 3) + 8 * j; const LAS float* s = scr + n * 66 + 8 * c;
        pg8::u32x2 o; o.x = pg8::pk4_fp8(s[0], s[1], s[2], s[3]); o.y = pg8::pk4_fp8(s[4], s[5], s[6], s[7]);
        *(GAS pg8::u32x2*)(dst + (size_t)n * dstK + 8 * c) = o; }
    LDS_WAIT(); asm volatile("" ::: "memory");
}
__device__ __forceinline__ void tr_item8(const float* W, int N, const float* gk, float scale, int k0, int n0, unsigned char* dst, int dstK, LAS float* scr, int lane) {
    f32x4 v[8]; tr8_load(W, N, k0, n0, lane, v); tr8_finish(v, gk, scale, k0, dst, dstK, scr, lane);
}
struct Ptrs {
    const float *x, *g1, *w_in, *lq1, *lk1, *lq2, *lk2, *subg, *cw, *cb, *lng, *lnb, *w_out, *g2, *wgr, *bgr, *wer, *ber, *w_gate, *w_up, *w_down, *gf;
    float* out; unsigned char* ws;
};
__device__ __forceinline__ void p0_prologue(const Ptrs& P, LAS unsigned char* lds, int lane, int wave, int gw, int NGW) {
    LAS float* scr = (LAS float*)(lds + RING_OFF + wave * 16384);
    bf16* WIN = (bf16*)(P.ws + WS_WIN); bf16* WOUT = (bf16*)(P.ws + WS_WOUT);
    constexpr int I_IN = 32 * 160, I_OUT = 32 * 64, NITEMS = I_IN + I_OUT;
    for (int it = gw; it < NITEMS; it += NGW) {
        if (it < I_IN) { const int kb = it / 160, nb = it % 160;
            if (nb < 96) tr_item(P.w_in, NIN, P.g1, 64 * kb, 32 * nb, WIN + (size_t)(32 * nb) * 2048 + 64 * kb, 2048, scr, lane);
            else { const int j0 = 32 * (nb - 96), jj = j0 & 1023, drow = 256 * (jj >> 7) + (jj & 127) + (j0 >= 1024 ? 128 : 0);
                tr_item8(P.w_in, NIN, P.g1, WSCALE, 64 * kb, 32 * nb, P.ws + WS_WIN8 + (size_t)drow * 2048 + 64 * kb, 2048, scr, lane); } }
        else { const int r = it - I_IN, kb = r >> 6, nb = r & 63; tr_item(P.w_out, 2048, nullptr, 64 * kb, 32 * nb, WOUT + (size_t)(32 * nb) * 2048 + 64 * kb, 2048, scr, lane); }
    }
    { bf16* WR = (bf16*)(P.ws + WS_WR);
      for (int it = gw; it < 32; it += NGW) tr_item(P.wer, 32, P.g2, 64 * it, 0, WR + 64 * it, 2048, scr, lane);
      for (int k = gw * 64 + lane; k < 2048; k += NGW * 64) { const float gk = P.g2[k]; const f32x4 w = *(const f32x4*)(P.wgr + (size_t)k * 4);
          WR[(size_t)128 * 2048 + k] = (bf16)f2bf(w.x * gk); WR[(size_t)129 * 2048 + k] = (bf16)f2bf(w.y * gk); WR[(size_t)130 * 2048 + k] = (bf16)f2bf(w.z * gk); WR[(size_t)131 * 2048 + k] = (bf16)f2bf(w.w * gk); } }
    bf16* XB = (bf16*)(P.ws + WS_XB); float* RS1 = (float*)(P.ws + WS_RSTD1);
    for (int m0 = gw; m0 < T; m0 += 2 * NGW) {
        f32x4 v[2][8]; float ss[2] = {0.f, 0.f};
#pragma unroll
        for (int q = 0; q < 2; ++q) { const int mr = (m0 + q * NGW < T) ? m0 + q * NGW : T - 1; const GAS f32x4* xr = (const GAS f32x4*)(P.x + (size_t)mr * D) + lane;
#pragma unroll
            for (int j = 0; j < 8; ++j) v[q][j] = xr[64 * j]; }
#pragma unroll
        for (int q = 0; q < 2; ++q) { const int m = m0 + q * NGW; if (m >= T) continue;
#pragma unroll
            for (int j = 0; j < 8; ++j) ss[q] += (v[q][j].x * v[q][j].x + v[q][j].y * v[q][j].y) + (v[q][j].z * v[q][j].z + v[q][j].w * v[q][j].w);
            ss[q] = wave_sum(ss[q]);
            if (lane == 0) RS1[m] = 1.0f / sqrtf(ss[q] * (1.0f / D) + EPS);
            GAS unsigned long long* o8 = (GAS unsigned long long*)(XB + (size_t)m * D) + lane; GAS unsigned* o4 = (GAS unsigned*)(P.ws + WS_X8 + (size_t)m * D) + lane;
#pragma unroll
            for (int j = 0; j < 8; ++j) { o8[64 * j] = (unsigned long long)pk2(v[q][j].x, v[q][j].y) | ((unsigned long long)pk2(v[q][j].z, v[q][j].w) << 32); o4[64 * j] = pg8::pk4_fp8(v[q][j].x, v[q][j].y, v[q][j].z, v[q][j].w); } }
    }
}

constexpr int CVT_ITEMS = 3 * 32768, CVT_CH = 4, CVT_CHUNK = CVT_CH * NWAVES, CVT_NCHUNK = CVT_ITEMS / CVT_CHUNK;
struct MoeItem { const float* src; const float* gk; unsigned char* dst; int N, k0, n0, dstK; };
__device__ __forceinline__ MoeItem moe_decode(const Ptrs& P, int r) {
    unsigned char* WGU = P.ws + WS_WGU; unsigned char* WD = P.ws + WS_WD; MoeItem m;
    const int mat = r >> 15, r2 = r & 32767, e = r2 >> 10, idx = r2 & 1023;
    if (mat < 2) { const int kb = idx >> 5, n0 = 32 * (idx & 31); const int drow = e * 2048 + 256 * (n0 >> 7) + (n0 & 127) + (mat == 1 ? 128 : 0);
        m.src = (mat == 0 ? P.w_gate : P.w_up) + (size_t)e * 2048 * 1024; m.N = 1024; m.gk = P.g2; m.k0 = 64 * kb; m.n0 = n0; m.dst = WGU + (size_t)drow * 2048 + 64 * kb; m.dstK = 2048; }
    else { const int kb = idx >> 6, nb = idx & 63; m.src = P.w_down + (size_t)e * 1024 * 2048; m.N = 2048; m.gk = nullptr; m.k0 = 64 * kb; m.n0 = 32 * nb; m.dst = WD + ((size_t)e * 2048 + 32 * nb) * 1024 + 64 * kb; m.dstK = 1024; }
    return m;
}
__device__ __forceinline__ void cvt_fill(const Ptrs& P, LAS unsigned char* lds, volatile LAS unsigned* slot, int max_chunks, const unsigned* donew, int G) {
    int tid_ = threadIdx.x; asm volatile("" : "+v"(tid_)); const int lane = tid_ & 63, wave = __builtin_amdgcn_readfirstlane(tid_ >> 6);
    LAS float* scr = (LAS float*)(lds + RING_OFF + wave * 16384); unsigned* ctr = (unsigned*)(P.ws + WS_CTL) + CW_CVQ;
    for (int n = 0; n < max_chunks; ++n) {
        if (threadIdx.x == 0) { unsigned v = 0xffffffffu;
            if (!(donew && (int)__hip_atomic_load(donew, __ATOMIC_RELAXED, __HIP_MEMORY_SCOPE_AGENT) >= G - 16)) v = __hip_atomic_fetch_add(ctr, 1u, __ATOMIC_RELAXED, __HIP_MEMORY_SCOPE_AGENT);
            *slot = v; }
        __syncthreads(); const unsigned c = *slot; __syncthreads();
        if (c >= (unsigned)CVT_NCHUNK) break;
#pragma unroll 1
        for (int j = 0; j < CVT_CH; j += 2) {
            const MoeItem m0 = moe_decode(P, (int)c * CVT_CHUNK + wave * CVT_CH + j), m1 = moe_decode(P, (int)c * CVT_CHUNK + wave * CVT_CH + j + 1);
            f32x4 v0[8], v1[8]; tr8_load(m0.src, m0.N, m0.k0, m0.n0, lane, v0); tr8_load(m1.src, m1.N, m1.k0, m1.n0, lane, v1);
            tr8_finish(v0, m0.gk, WSCALE, m0.k0, m0.dst, m0.dstK, scr, lane); tr8_finish(v1, m1.gk, WSCALE, m1.k0, m1.dst, m1.dstK, scr, lane); }
    }
}
__device__ __forceinline__ void h8_fill(const Ptrs& P, const bf16* HB, unsigned char* H8, volatile LAS unsigned* slot) {
    int tid_ = threadIdx.x; asm volatile("" : "+v"(tid_)); const int lane = tid_ & 63, wave = __builtin_amdgcn_readfirstlane(tid_ >> 6);
    unsigned* ctr = (unsigned*)(P.ws + WS_CTL) + CW_H8Q;
    for (;;) { const int c = attn_body::wg_pop(ctr, slot); if (c >= T / 64) break;
#pragma unroll 1
        for (int j = 0; j < 8; j += 4) { const int r0 = c * 64 + wave * 8 + j; u32x4g a[4][4];
#pragma unroll
            for (int q = 0; q < 4; ++q)
#pragma unroll
                for (int i = 0; i < 4; ++i) a[q][i] = *(const u32x4g*)(HB + (size_t)(r0 + q) * D + 16 * lane + 1024 * (i >> 1) + 8 * (i & 1));
#pragma unroll
            for (int q = 0; q < 4; ++q)
#pragma unroll
                for (int hj = 0; hj < 2; ++hj) { const u32x4g w0 = a[q][2 * hj], w1 = a[q][2 * hj + 1]; v4u o;
                    o.x = pg8::pk4_fp8(bflo(w0.x), bfhi(w0.x), bflo(w0.y), bfhi(w0.y)); o.y = pg8::pk4_fp8(bflo(w0.z), bfhi(w0.z), bflo(w0.w), bfhi(w0.w));
                    o.z = pg8::pk4_fp8(bflo(w1.x), bfhi(w1.x), bflo(w1.y), bfhi(w1.y)); o.w = pg8::pk4_fp8(bflo(w1.z), bfhi(w1.z), bflo(w1.w), bfhi(w1.w));
                    *(v4u*)(H8 + (size_t)(r0 + q) * D + 16 * lane + 1024 * hj) = o; } }
    }
}
__device__ __forceinline__ void router_skinny(const Ptrs& P, const bf16* HB, unsigned char* H8, LAS unsigned char* lds, int G) {
    int tid_ = threadIdx.x; asm volatile("" : "+v"(tid_)); const int tid = tid_, lane = tid & 63, wave = __builtin_amdgcn_readfirstlane(tid >> 6), fr = lane & 15, fq = lane >> 4;
    constexpr int BROW = 1040, BBUF = 48 * BROW;
    const bf16* WR = (const bf16*)(P.ws + WS_WR);
    LAS unsigned char* Bb = lds + RING_OFF; LAS float* LX = (LAS float*)(lds + RING_OFF + 2 * BBUF) + wave * (16 * 37);
    LAS unsigned* cntL = (LAS unsigned*)(lds + RING_OFF + 2 * BBUF + 8 * 16 * 37 * 4); LAS unsigned* baseL = cntL + 32;
    const float* part = (const float*)(P.ws + WS_PART); float* listr = (float*)(P.ws + WS_LISTR); float* listw = (float*)(P.ws + WS_LISTW); int* list = (int*)(P.ws + WS_LIST);
    unsigned* cnt = (unsigned*)(P.ws + WS_CTL) + CW_CNT;
    int brow[6], bcol[6];
#pragma unroll
    for (int i = 0; i < 6; ++i) { const int pc = tid + 512 * i; brow[i] = pc >> 6; bcol[i] = pc & 63; }
    for (int u = blockIdx.x; u < T / 128; u += G) {
        const int r0 = u * 128 + wave * 16;
        const bf16* arow = HB + (size_t)(r0 + fr) * D + 16 * fq;
        unsigned char* orow = H8 + (size_t)(r0 + fr) * D + 16 * fq;
        u32x4g bs[6], a[2][16]; pg8::f32x4 acc[3];
#pragma unroll
        for (int nb = 0; nb < 3; ++nb) acc[nb] = (pg8::f32x4){0.f, 0.f, 0.f, 0.f};
#define RS_LOADB(c) do { _Pragma("unroll") for (int i = 0; i < 6; ++i) { const int sr = brow[i] < 32 ? brow[i] : 128 + ((brow[i] - 32) & 3); \
            bs[i] = *(const u32x4g*)(WR + (size_t)sr * D + 512 * (c) + 8 * bcol[i]); } } while (0)
#define RS_STOREB(c) do { _Pragma("unroll") for (int i = 0; i < 6; ++i) *(LAS u32x4g*)(Bb + ((c) & 1) * BBUF + brow[i] * BROW + bcol[i] * 16) = bs[i]; } while (0)
#define RS_LOADA(c) do { _Pragma("unroll") for (int s = 0; s < 16; ++s) a[(c) & 1][s] = *(const u32x4g*)(arow + 512 * (c) + 64 * (s >> 1) + 8 * (s & 1)); } while (0)
        RS_LOADB(0); RS_LOADA(0); RS_STOREB(0);
#pragma unroll
        for (int c = 0; c < 4; ++c) {
            __syncthreads();
            if (c < 3) { RS_LOADB(c + 1); RS_LOADA(c + 1); }
#pragma unroll
            for (int s = 0; s < 16; ++s) {
                const pg8::bf16x8 af = __builtin_bit_cast(pg8::bf16x8, a[c & 1][s]);
#pragma unroll
                for (int nb = 0; nb < 3; ++nb) {
                    const pg8::bf16x8 bf = *(const LAS pg8::bf16x8*)(Bb + (c & 1) * BBUF + (16 * nb + fr) * BROW + (64 * (s >> 1) + 16 * fq + 8 * (s & 1)) * 2);
                    acc[nb] = __builtin_amdgcn_mfma_f32_16x16x32_bf16(af, bf, acc[nb], 0, 0, 0); }
            }
            if (c < 3) RS_STOREB(c + 1);
#pragma unroll
            for (int s = 0; s < 16; s += 2) { const u32x4g w0 = a[c & 1][s], w1 = a[c & 1][s + 1]; v4u o;
                o.x = pg8::pk4_fp8(bflo(w0.x), bfhi(w0.x), bflo(w0.y), bfhi(w0.y)); o.y = pg8::pk4_fp8(bflo(w0.z), bfhi(w0.z), bflo(w0.w), bfhi(w0.w));
                o.z = pg8::pk4_fp8(bflo(w1.x), bfhi(w1.x), bflo(w1.y), bfhi(w1.y)); o.w = pg8::pk4_fp8(bflo(w1.z), bfhi(w1.z), bflo(w1.w), bfhi(w1.w));
                *(v4u*)(orow + 512 * c + 64 * (s >> 1)) = o; }
        }
#undef RS_LOADB
#undef RS_STOREB
#undef RS_LOADA
#pragma unroll
        for (int nb = 0; nb < 3; ++nb)
#pragma unroll
            for (int r = 0; r < 4; ++r) if (nb < 2 || fr < 4) LX[(4 * fq + r) * 37 + 16 * nb + fr] = acc[nb][r];
        if (tid < 32) cntL[tid] = 0u;
        __syncthreads();
        int ea = 0, eb = 0, row = 0; unsigned ra = 0u, rb = 0u; float w1 = 0.f, w2 = 0.f, rstd = 0.f;
        if (lane < 16) { row = r0 + lane; const LAS float* lx = LX + lane * 37;
            float sq[4];
#pragma unroll
            for (int q = 0; q < 4; ++q) { const pg8::f32x4 p0 = *(const pg8::f32x4*)(part + (size_t)row * 32 + 8 * q), p1 = *(const pg8::f32x4*)(part + (size_t)row * 32 + 8 * q + 4);
                sq[q] = ((p0[0] + p0[1]) + (p0[2] + p0[3])) + ((p1[0] + p1[1]) + (p1[2] + p1[3])); }
            const float ss = (sq[0] + sq[1]) + (sq[2] + sq[3]);
            rstd = 1.0f / sqrtf(ss * (1.0f / 2048.0f) + 1e-6f);
            float g[4];
#pragma unroll
            for (int i = 0; i < 4; ++i) g[i] = lx[32 + i] * rstd + P.bgr[i];
            int gs = 0; float gm = g[0];
#pragma unroll
            for (int i = 1; i < 4; ++i) if (g[i] > gm) { gm = g[i]; gs = i; }
            float gsum = 0.f;
#pragma unroll
            for (int i = 0; i < 4; ++i) gsum += __expf(g[i] - gm);
            const float gw = 1.0f / gsum;
            float ev[8];
#pragma unroll
            for (int i = 0; i < 8; ++i) ev[i] = lx[8 * gs + i] * rstd + P.ber[8 * gs + i];
            int i1 = 0; float v1 = ev[0];
#pragma unroll
            for (int i = 1; i < 8; ++i) if (ev[i] > v1) { v1 = ev[i]; i1 = i; }
            int i2 = -1; float v2 = -3.0e38f;
#pragma unroll
            for (int i = 0; i < 8; ++i) if (i != i1 && ev[i] > v2) { v2 = ev[i]; i2 = i; }
            const float e2 = __expf(v2 - v1); w1 = gw / (1.f + e2); w2 = gw * e2 / (1.f + e2);
            ea = gs * 8 + i1; eb = gs * 8 + i2;
            ra = __hip_atomic_fetch_add(cntL + ea, 1u, __ATOMIC_RELAXED, __HIP_MEMORY_SCOPE_WORKGROUP);
            rb = __hip_atomic_fetch_add(cntL + eb, 1u, __ATOMIC_RELAXED, __HIP_MEMORY_SCOPE_WORKGROUP); }
        __syncthreads();
        if (tid < 32) { const unsigned n = cntL[tid]; baseL[tid] = n ? __hip_atomic_fetch_add(cnt + 64 * tid, n, __ATOMIC_RELAXED, __HIP_MEMORY_SCOPE_AGENT) : 0u; }
        __syncthreads();
        if (lane < 16) { const size_t ia = (size_t)ea * T + baseL[ea] + ra, ib = (size_t)eb * T + baseL[eb] + rb;
            list[ia] = 2 * row; list[ib] = 2 * row + 1; listw[ia] = w1; listw[ib] = w2; listr[ia] = rstd; listr[ib] = rstd; }
    }
    __syncthreads();
}
__device__ __forceinline__ void phase_tail(const Ptrs& P, LAS unsigned char* lds, volatile LAS unsigned* slot, int ph, int G) {
    unsigned* donew = (unsigned*)(P.ws + WS_CTL) + CW_DONE + 64 * ph;
    __syncthreads();
    if (threadIdx.x == 0) { const unsigned old = __hip_atomic_fetch_add(donew, 1u, __ATOMIC_RELAXED, __HIP_MEMORY_SCOPE_AGENT); *slot = (int)(old + 1u) >= G - 16 ? 1u : 0u; }
    __syncthreads(); const unsigned late = *slot; __syncthreads();
    if (late) return;
    cvt_fill(P, lds, slot, 1 << 30, donew, G);
}

__device__ __forceinline__ void naive_attn(const Ptrs& P, const bf16* Q, const bf16* Kb, const bf16* Vb, bf16* MIX, int lane, int gw, int NGW) {
    const float s1 = wave_sum(P.lq1[lane] * P.lk1[lane]), s2 = wave_sum(P.lq2[lane] * P.lk2[lane]);
    const float lam0 = 0.2f, lam = expf(s1) - expf(s2) + lam0;
    const int r16 = lane & 15, c = (lane >> 4) & 1, vh = lane >> 5;
    for (int u = gw; u < 16384; u += NGW) {
        const int bh = u & 63, qb = 255 - (u >> 6), b = bh >> 3, h = bh & 7, i = qb * 16 + r16, jmax = qb * 16 + 15;
        const float sl2 = exp2f(-(float)(h + 1)) * LOG2E; const size_t rowb = (size_t)b * SEQ;
        float q[64], O[64];
        { const u32x4g* qp = (const u32x4g*)(Q + (rowb + i) * 1024 + h * 128 + c * 64);
#pragma unroll
          for (int d8 = 0; d8 < 8; ++d8) { const u32x4g w = qp[d8]; q[8 * d8 + 0] = bflo(w.x); q[8 * d8 + 1] = bfhi(w.x); q[8 * d8 + 2] = bflo(w.y); q[8 * d8 + 3] = bfhi(w.y);
              q[8 * d8 + 4] = bflo(w.z); q[8 * d8 + 5] = bfhi(w.z); q[8 * d8 + 6] = bflo(w.w); q[8 * d8 + 7] = bfhi(w.w); } }
#pragma unroll
        for (int d = 0; d < 64; ++d) O[d] = 0.f;
        float m = -1e30f, l = 0.f;
        for (int j = 0; j <= jmax; ++j) {
            const u32x4g* kp = (const u32x4g*)(Kb + (rowb + j) * 1024 + h * 128 + c * 64); float s = 0.f;
#pragma unroll
            for (int d8 = 0; d8 < 8; ++d8) { const u32x4g w = kp[d8];
                s += q[8 * d8 + 0] * bflo(w.x) + q[8 * d8 + 1] * bfhi(w.x) + q[8 * d8 + 2] * bflo(w.y) + q[8 * d8 + 3] * bfhi(w.y)
                   + q[8 * d8 + 4] * bflo(w.z) + q[8 * d8 + 5] * bfhi(w.z) + q[8 * d8 + 6] * bflo(w.w) + q[8 * d8 + 7] * bfhi(w.w); }
            s += sl2 * (float)(j - i);
            if (j <= i) {
                if (s > m) { const float al = fexp2(m - s); l *= al;
#pragma unroll
                    for (int d = 0; d < 64; ++d) O[d] *= al;
                    m = s; }
                const float p = fexp2(s - m); l += p;
                const u32x4g* vp = (const u32x4g*)(Vb + (rowb + j) * 1024 + h * 128 + vh * 64);
#pragma unroll
                for (int d8 = 0; d8 < 8; ++d8) { const u32x4g w = vp[d8];
                    O[8 * d8 + 0] += p * bflo(w.x); O[8 * d8 + 1] += p * bfhi(w.x); O[8 * d8 + 2] += p * bflo(w.y); O[8 * d8 + 3] += p * bfhi(w.y);
                    O[8 * d8 + 4] += p * bflo(w.z); O[8 * d8 + 5] += p * bfhi(w.z); O[8 * d8 + 6] += p * bflo(w.w); O[8 * d8 + 7] += p * bfhi(w.w); }
            }
        }
        const float il = 1.0f / l; float ss = 0.f;
#pragma unroll
        for (int d = 0; d < 64; ++d) { float o = O[d] * il; const float o2 = __shfl_xor(o, 16); o = o - lam * o2; O[d] = o; ss += o * o; }
        ss += __shfl_xor(ss, 32);
        const float r = (1.0f / sqrtf(ss * (1.0f / 128.0f) + EPS)) * (1.0f - lam0);
        if (c == 0) { u32x4g* op = (u32x4g*)(MIX + (rowb + i) * 2048 + h * 128 + vh * 64); const float* sg = P.subg + vh * 64;
#pragma unroll
            for (int d8 = 0; d8 < 8; ++d8) { u32x4g w; w.x = pk2(O[8 * d8 + 0] * r * sg[8 * d8 + 0], O[8 * d8 + 1] * r * sg[8 * d8 + 1]); w.y = pk2(O[8 * d8 + 2] * r * sg[8 * d8 + 2], O[8 * d8 + 3] * r * sg[8 * d8 + 3]);
                w.z = pk2(O[8 * d8 + 4] * r * sg[8 * d8 + 4], O[8 * d8 + 5] * r * sg[8 * d8 + 5]); w.w = pk2(O[8 * d8 + 6] * r * sg[8 * d8 + 6], O[8 * d8 + 7] * r * sg[8 * d8 + 7]); op[d8] = w; } }
    }
}

typedef float f32x2c __attribute__((ext_vector_type(2)));
__device__ __forceinline__ void conv_phase(const Ptrs& P, const bf16* CA, bf16* MIX, LAS unsigned char* lds, int blk, unsigned* qctr, volatile LAS unsigned* slot) {
    int tid_ = threadIdx.x; asm volatile("" : "+v"(tid_)); const int tid = tid_, lane = tid & 63, wave = __builtin_amdgcn_readfirstlane(tid >> 6);
    LAS unsigned* C = (LAS unsigned*)(lds + RING_OFF);
    f32x2c w[31];
#pragma unroll
    for (int j = 0; j < 31; ++j) w[j] = *(const f32x2c*)(P.cw + j * 1024 + 2 * tid);
    const f32x2c bias = *(const f32x2c*)(P.cb + 2 * tid);
    for (int qi = 0; qi < 8; ++qi) { const int xq = (blk + qi) & 7;
    for (;;) { const int n_ = attn_body::wg_pop(qctr + 64 * xq, slot); if (n_ >= 64) break;
        const int tile = xq + 8 * n_, b = tile >> 6, t0 = (tile & 63) * 64; const size_t rowb = (size_t)b * SEQ;
        const unsigned* up = (const unsigned*)(CA + rowb * 1024 + 2 * tid);
        f32x2c win[38]; unsigned hist[30];
#pragma unroll
        for (int k = 0; k < 30; ++k) { const int t = t0 - 30 + k; hist[k] = (t >= 0) ? up[(size_t)t * 512] : 0u; }
        unsigned nw[8];
#pragma unroll
        for (int i = 0; i < 8; ++i) nw[i] = up[(size_t)(t0 + i) * 512];
#pragma unroll
        for (int k = 0; k < 30; ++k) win[k] = (f32x2c){bflo(hist[k]), bfhi(hist[k])};
#pragma unroll 1
        for (int blk8 = 0; blk8 < 8; ++blk8) {
#pragma unroll
            for (int i = 0; i < 8; ++i) win[30 + i] = (f32x2c){bflo(nw[i]), bfhi(nw[i])};
            if (blk8 < 7) {
#pragma unroll
                for (int i = 0; i < 8; ++i) nw[i] = up[(size_t)(t0 + 8 * (blk8 + 1) + i) * 512];
            }
#pragma unroll
            for (int i = 0; i < 8; ++i) { f32x2c acc = bias;
#pragma unroll
                for (int j = 0; j < 31; ++j) acc = w[j] * win[i + j] + acc;
                C[(8 * blk8 + i) * 512 + tid] = pk2(acc.x, acc.y); }
#pragma unroll
            for (int k = 0; k < 30; ++k) win[k] = win[k + 8];
        }
        __syncthreads();
#pragma unroll 1
        for (int k = 0; k < 8; ++k) { const int rr = wave + 8 * k, t = t0 + rr; const LAS unsigned* row = C + rr * 512;
            const v4u x0 = *(const LAS v4u*)(row + 4 * lane), x1 = *(const LAS v4u*)(row + 256 + 4 * lane);
            float v[16] = {bflo(x0.x), bfhi(x0.x), bflo(x0.y), bfhi(x0.y), bflo(x0.z), bfhi(x0.z), bflo(x0.w), bfhi(x0.w), bflo(x1.x), bfhi(x1.x), bflo(x1.y), bfhi(x1.y), bflo(x1.z), bfhi(x1.z), bflo(x1.w), bfhi(x1.w)};
            float s = 0.f;
#pragma unroll
            for (int i = 0; i < 16; ++i) s += v[i];
            const float mean = wave_sum(s) * (1.0f / 1024.0f); float qq = 0.f;
#pragma unroll
            for (int i = 0; i < 16; ++i) { v[i] -= mean; qq += v[i] * v[i]; }
            const float rstd = 1.0f / sqrtf(wave_sum(qq) * (1.0f / 1024.0f) + EPS);
            float y[16];
#pragma unroll
            for (int i = 0; i < 16; ++i) { const int ch = (i < 8 ? 8 * lane + i : 512 + 8 * lane + (i - 8)); const float z = v[i] * rstd * P.lng[ch] + P.lnb[ch]; y[i] = z / (1.f + __expf(-z)); }
            bf16* op = MIX + (rowb + t) * 2048 + 1024 + 8 * lane;
            v4u o0, o1; o0.x = pk2(y[0], y[1]); o0.y = pk2(y[2], y[3]); o0.z = pk2(y[4], y[5]); o0.w = pk2(y[6], y[7]); o1.x = pk2(y[8], y[9]); o1.y = pk2(y[10], y[11]); o1.z = pk2(y[12], y[13]); o1.w = pk2(y[14], y[15]);
            *(GAS v4u*)op = o0; *(GAS v4u*)(op + 512) = o1; }
        __syncthreads();
    } }
}

__device__ __forceinline__ void router_phase(const Ptrs& P, const bf16* HB, int lane, int gw, int NGW) {
    float* RS2 = (float*)(P.ws + WS_RSTD2); float* WTS = (float*)(P.ws + WS_WTS); int* LIST = (int*)(P.ws + WS_LIST); unsigned* CNT = (unsigned*)(P.ws + WS_CTL) + CW_CNT;
    for (int tok = gw; tok < T; tok += NGW) {
        float hv[32]; const bf16* hp = HB + (size_t)tok * D; float ss = 0.f;
#pragma unroll
        for (int j = 0; j < 4; ++j) { const u32x4g w = *(const u32x4g*)(hp + 8 * lane + 512 * j);
            hv[8 * j + 0] = bflo(w.x); hv[8 * j + 1] = bfhi(w.x); hv[8 * j + 2] = bflo(w.y); hv[8 * j + 3] = bfhi(w.y); hv[8 * j + 4] = bflo(w.z); hv[8 * j + 5] = bfhi(w.z); hv[8 * j + 6] = bflo(w.w); hv[8 * j + 7] = bfhi(w.w); }
#pragma unroll
        for (int k = 0; k < 32; ++k) ss += hv[k] * hv[k];
        ss = wave_sum(ss); const float rstd = 1.0f / sqrtf(ss * (1.0f / D) + EPS);
        float lg[36];
#pragma unroll
        for (int o = 0; o < 36; ++o) lg[o] = 0.f;
#pragma unroll
        for (int j = 0; j < 4; ++j)
#pragma unroll 2
            for (int i = 0; i < 8; ++i) { const int e = 8 * lane + 512 * j + i; const float xv = hv[8 * j + i] * P.g2[e];
                const f32x4* wr = (const f32x4*)(P.wer + (size_t)e * 32); const f32x4 wg = *(const f32x4*)(P.wgr + (size_t)e * 4);
#pragma unroll
                for (int o4 = 0; o4 < 8; ++o4) { const f32x4 w = wr[o4]; lg[4 * o4 + 0] += xv * w.x; lg[4 * o4 + 1] += xv * w.y; lg[4 * o4 + 2] += xv * w.z; lg[4 * o4 + 3] += xv * w.w; }
                lg[32] += xv * wg.x; lg[33] += xv * wg.y; lg[34] += xv * wg.z; lg[35] += xv * wg.w; }
#pragma unroll
        for (int o = 0; o < 36; ++o) lg[o] = wave_sum(lg[o]) * rstd + (o < 32 ? P.ber[o] : P.bgr[o - 32]);
        int gs = 0; float gm = lg[32];
#pragma unroll
        for (int g = 1; g < 4; ++g) if (lg[32 + g] > gm) { gm = lg[32 + g]; gs = g; }
        float gsum = 0.f;
#pragma unroll
        for (int g = 0; g < 4; ++g) gsum += __expf(lg[32 + g] - gm);
        const float gw_ = 1.0f / gsum;
        float ev[8];
#pragma unroll
        for (int i = 0; i < 8; ++i) ev[i] = gs == 0 ? lg[i] : gs == 1 ? lg[8 + i] : gs == 2 ? lg[16 + i] : lg[24 + i];
        int i1 = 0; float v1 = ev[0];
#pragma unroll
        for (int i = 1; i < 8; ++i) if (ev[i] > v1) { v1 = ev[i]; i1 = i; }
        int i2 = -1; float v2 = -3.0e38f;
#pragma unroll
        for (int i = 0; i < 8; ++i) if (i != i1 && ev[i] > v2) { v2 = ev[i]; i2 = i; }
        const float e2 = __expf(v2 - v1), w1 = gw_ / (1.f + e2), w2 = gw_ * e2 / (1.f + e2);
        if (lane == 0) {
            RS2[tok] = rstd;
            const int ea = gs * 8 + i1, eb = gs * 8 + i2;
            const unsigned ra = __hip_atomic_fetch_add(CNT + 64 * ea, 1u, __ATOMIC_RELAXED, __HIP_MEMORY_SCOPE_AGENT);
            const unsigned rb = __hip_atomic_fetch_add(CNT + 64 * eb, 1u, __ATOMIC_RELAXED, __HIP_MEMORY_SCOPE_AGENT);
            LIST[(size_t)ea * T + ra] = 2 * tok; LIST[(size_t)eb * T + rb] = 2 * tok + 1; WTS[2 * tok] = w1; WTS[2 * tok + 1] = w2;
        }
    }
}
__device__ __forceinline__ void moe_tables(const Ptrs& P, LAS unsigned char* lds) {
    int tid = threadIdx.x; asm volatile("" : "+v"(tid));
    LAS int* cntL = (LAS int*)(lds + TAB_OFF); LAS int* ts = cntL + 32; unsigned* CNT = (unsigned*)(P.ws + WS_CTL) + CW_CNT;
    if (tid < 32) cntL[tid] = (int)__hip_atomic_load(CNT + 64 * tid, __ATOMIC_RELAXED, __HIP_MEMORY_SCOPE_AGENT);
    __syncthreads();
    if (tid == 0) { int s = 0; for (int e = 0; e < 32; ++e) { ts[e] = s; s += (cntL[e] + 255) >> 8; } ts[32] = s; }
    __syncthreads();
}

__device__ __forceinline__ float fp8f(unsigned w, int i) { return i == 0 ? __builtin_amdgcn_cvt_f32_fp8(w, 0) : i == 1 ? __builtin_amdgcn_cvt_f32_fp8(w, 1) : i == 2 ? __builtin_amdgcn_cvt_f32_fp8(w, 2) : __builtin_amdgcn_cvt_f32_fp8(w, 3); }
__device__ __forceinline__ void final_phase(const Ptrs& P, const bf16* HB, const unsigned char* Y8, int NGW) {
    int tid_ = threadIdx.x; asm volatile("" : "+v"(tid_)); const int lane = tid_ & 63, gw = (int)blockIdx.x * NWAVES + __builtin_amdgcn_readfirstlane(tid_ >> 6);
    for (int tok = gw; tok < T; tok += NGW) {
        const bf16* hp = HB + (size_t)tok * D; const unsigned char* y1 = Y8 + (size_t)tok * 4096; const unsigned char* y2 = y1 + 2048; float v[32]; float ss = 0.f;
#pragma unroll
        for (int j = 0; j < 4; ++j) { const int o = 8 * lane + 512 * j; const u32x4g a = *(const u32x4g*)(hp + o); const pg8::u32x2 b = *(const pg8::u32x2*)(y1 + o), c = *(const pg8::u32x2*)(y2 + o);
            const float ys = 1.0f / YSCALE;
            v[8 * j + 0] = bflo(a.x) + (fp8f(b.x, 0) + fp8f(c.x, 0)) * ys; v[8 * j + 1] = bfhi(a.x) + (fp8f(b.x, 1) + fp8f(c.x, 1)) * ys; v[8 * j + 2] = bflo(a.y) + (fp8f(b.x, 2) + fp8f(c.x, 2)) * ys; v[8 * j + 3] = bfhi(a.y) + (fp8f(b.x, 3) + fp8f(c.x, 3)) * ys;
            v[8 * j + 4] = bflo(a.z) + (fp8f(b.y, 0) + fp8f(c.y, 0)) * ys; v[8 * j + 5] = bfhi(a.z) + (fp8f(b.y, 1) + fp8f(c.y, 1)) * ys; v[8 * j + 6] = bflo(a.w) + (fp8f(b.y, 2) + fp8f(c.y, 2)) * ys; v[8 * j + 7] = bfhi(a.w) + (fp8f(b.y, 3) + fp8f(c.y, 3)) * ys; }
#pragma unroll
        for (int k = 0; k < 32; ++k) ss += v[k] * v[k];
        ss = wave_sum(ss); const float rstd = 1.0f / sqrtf(ss * (1.0f / D) + EPS);
        float* op = P.out + (size_t)tok * D;
#pragma unroll
        for (int j = 0; j < 4; ++j) { const int o = 8 * lane + 512 * j; const f32x4 g0 = *(const f32x4*)(P.gf + o), g1 = *(const f32x4*)(P.gf + o + 4);
            f32x4 r0 = {v[8 * j + 0] * rstd * g0.x, v[8 * j + 1] * rstd * g0.y, v[8 * j + 2] * rstd * g0.z, v[8 * j + 3] * rstd * g0.w};
            f32x4 r1 = {v[8 * j + 4] * rstd * g1.x, v[8 * j + 5] * rstd * g1.y, v[8 * j + 6] * rstd * g1.z, v[8 * j + 7] * rstd * g1.w};
            *(f32x4*)(op + o) = r0; *(f32x4*)(op + o + 4) = r1; }
    }
}

struct Args { const float* in[22]; float* out; unsigned char* ws; int ph_lo, ph_hi; };
__global__ void __launch_bounds__(NWAVES * 64, 2) fwd(Args args) {
    extern __shared__ __attribute__((aligned(16))) unsigned char lds_raw[];
    LAS unsigned char* lds = (LAS unsigned char*)lds_raw;
    volatile LAS unsigned* MISC = (volatile LAS unsigned*)(lds + MISC_OFF);
    const int tid = threadIdx.x, lane = tid & 63, wave = __builtin_amdgcn_readfirstlane(tid >> 6), G = gridDim.x;
    const int gw = blockIdx.x * NWAVES + wave, NGW = G * NWAVES;
    Ptrs P;
    P.x = args.in[0]; P.g1 = args.in[1]; P.w_in = args.in[2]; P.lq1 = args.in[3]; P.lk1 = args.in[4]; P.lq2 = args.in[5]; P.lk2 = args.in[6]; P.subg = args.in[7];
    P.cw = args.in[8]; P.cb = args.in[9]; P.lng = args.in[10]; P.lnb = args.in[11]; P.w_out = args.in[12]; P.g2 = args.in[13]; P.wgr = args.in[14]; P.bgr = args.in[15];
    P.wer = args.in[16]; P.ber = args.in[17]; P.w_gate = args.in[18]; P.w_up = args.in[19]; P.w_down = args.in[20]; P.gf = args.in[21]; P.out = args.out; P.ws = args.ws;
    unsigned char* ws = args.ws;
#define WIN ((bf16*)(ws + WS_WIN))
#define WOUT ((bf16*)(ws + WS_WOUT))
#define WGU (ws + WS_WGU)
#define WD (ws + WS_WD)
#define XB ((bf16*)(ws + WS_XB))
#define H1 (ws + WS_XB)
#define HB8 (ws + WS_HB8)
#define CGB ((bf16*)(ws + WS_CG))
#define MIX ((bf16*)(ws + WS_MIX))
#define HB ((bf16*)(ws + WS_HB))
#define QB ((bf16*)P.out)
#define KB (QB + (size_t)T * 1024)
#define VB (QB + (size_t)T * 2048)
#define CAB (QB + (size_t)T * 3072)
#define YB ((bf16*)P.out)
#define RELOAD_ARGS() do { const __attribute__((address_space(4))) Args* ka_ = (const __attribute__((address_space(4))) Args*)__builtin_amdgcn_kernarg_segment_ptr(); asm volatile("" : "+s"(ka_)); \
    P.x = ka_->in[0]; P.g1 = ka_->in[1]; P.w_in = ka_->in[2]; P.lq1 = ka_->in[3]; P.lk1 = ka_->in[4]; P.lq2 = ka_->in[5]; P.lk2 = ka_->in[6]; P.subg = ka_->in[7]; \
    P.cw = ka_->in[8]; P.cb = ka_->in[9]; P.lng = ka_->in[10]; P.lnb = ka_->in[11]; P.w_out = ka_->in[12]; P.g2 = ka_->in[13]; P.wgr = ka_->in[14]; P.bgr = ka_->in[15]; \
    P.wer = ka_->in[16]; P.ber = ka_->in[17]; P.w_gate = ka_->in[18]; P.w_up = ka_->in[19]; P.w_down = ka_->in[20]; P.gf = ka_->in[21]; P.out = ka_->out; P.ws = ka_->ws; ws = ka_->ws; } while (0)
    for (int u = tid; u < (LDS_BYTES - LDSCTL_OFF) / 4; u += NWAVES * 64) ((LAS unsigned*)(lds + LDSCTL_OFF))[u] = 0u;
    __syncthreads();
    const int lo = args.ph_lo, hi = args.ph_hi;
    XcdBarrier bar; bar.bar = (unsigned*)(ws + WS_CTL) + CW_BAR; bar.x = 0; bar.st = nullptr;
    if (hi - lo > 1) bar = xcd_barrier_post((unsigned*)(ws + WS_CTL) + CW_BAR, MISC + 8);
#define IN(k) (lo <= (k) && (k) < hi)
#if PROBE_PHASE >= 0
    unsigned long long pst_[NPHASE + 1]; pst_[0] = __builtin_amdgcn_s_memrealtime();
#define SEAM(k) do { if (IN(k) && IN((k) + 1)) xcd_barrier(bar); pst_[(k) + 1] = __builtin_amdgcn_s_memrealtime(); } while (0)
#else
#define SEAM(k) do { if (IN(k) && IN((k) + 1)) xcd_barrier(bar); } while (0)
#endif
#define REP(k) for (int rep_ = 0; rep_ <= ((PROBE_DOUBLE >> (k)) & 1); ++rep_)

    if (IN(0)) REP(0) { p0_prologue(P, lds, lane, wave, gw, NGW); }
    SEAM(0);
#if PROBE_CLOCK
    const long long pc0 = clock64(), pr0 = wall_clock64();
#endif
    if (IN(1)) {
        cvt_fill(P, lds, MISC + 12, (int)((blockIdx.x >> 3) % 8), nullptr, G);
        for (int pass = 0; pass < 2; ++pass) {
            if ((pass ^ (int)(blockIdx.x & 1)) == 0) { pg8::Gemm g{XB, WIN, 1, 3072, D, (unsigned*)(ws + WS_CTL) + 3002}; pg8::DynDense S; S.init(T, 3072, (unsigned*)(ws + WS_CTL) + CW_GQ + 0 * 512, (volatile LAS int*)(MISC + 16), (int)blockIdx.x);
                pg8::EpiIn E{QB, (size_t)T * 1024, CGB, (const float*)(ws + WS_RSTD1), C2, (unsigned*)(ws + WS_CTL) + CW_NMAX, 0, 1.0f};
                pg8::gemm_phase<pg8::EpiIn, pg8::DynDense, true, false>(lds + RING_OFF, g, S, E); }
            else { pg8::Gemm g{(const bf16*)(ws + WS_X8), (const bf16*)(ws + WS_WIN8), 2, 2048, D / 2, (unsigned*)(ws + WS_CTL) + 3002}; pg8::DynDenseG S; S.init(T, 2048, (unsigned*)(ws + WS_CTL) + CW_GQ + 1 * 512, (volatile LAS int*)(MISC + 16), (int)blockIdx.x);
                pg8::EpiGLU E{CAB, (const float*)(ws + WS_RSTD1), 1.0f / WSCALE};
                pg8::gemm_phase<pg8::EpiGLU, pg8::DynDenseG, true, true, true>(lds + RING_OFF, g, S, E); }
        }
#if PROBE_ATT == 6
        if (threadIdx.x == 0) atomicMax((unsigned*)(ws + WS_CTL) + CW_NMAX + 900, (unsigned)(__builtin_amdgcn_s_memrealtime() - pst_[1]));
#endif
#if PROBE_ATT == 7
        if (threadIdx.x == 0) atomicAdd((unsigned*)(ws + WS_CTL) + CW_NMAX + 900, (unsigned)(__builtin_amdgcn_s_memrealtime() - pst_[1]) >> 8);
#endif
#if PROBE_ATT == 5
        if (blockIdx.x == PROBE_BLK && threadIdx.x == 0) atomicAdd((unsigned*)(ws + WS_CTL) + CW_NMAX + 900, (unsigned)(__builtin_amdgcn_s_memrealtime() - pst_[1]));
#endif
        phase_tail(P, lds, MISC + 12, 1, G);
    }
#if PROBE_CLOCK
    if (IN(1) && tid == 0) { const unsigned dt = (unsigned)(wall_clock64() - pr0); atomicAdd((unsigned*)(ws + WS_CTL) + 3000, dt); atomicMax((unsigned*)(ws + WS_CTL) + 3001, dt); }
#endif
    SEAM(1);
    if (IN(2)) {
#if USE_NAIVE_ATTN
        naive_attn(P, QB, KB, VB, MIX, lane, gw, NGW);
#else
        { float s1 = 0.f, s2 = 0.f;
          for (int i = 0; i < 64; ++i) { s1 += P.lq1[i] * P.lk1[i]; s2 += P.lq2[i] * P.lk2[i]; }
          const float lam0 = 0.2f, lam = expf(s1) - expf(s2) + lam0;
          static_assert(attn_body::ATTN_LDS_BYTES <= RING_BYTES, "attention LDS");
          attn_body::attn_phase<8>((char*)lds_raw + RING_OFF, (int)blockIdx.x, (unsigned*)(ws + WS_CTL) + CW_QA, MISC + 12, lam, 1.0f - lam0, P.subg, (const unsigned*)(ws + WS_CTL) + CW_NMAX, (unsigned*)(ws + WS_O1S) + (size_t)blockIdx.x * 16384,
                                   (const attn_body::bf16*)QB, (const attn_body::bf16*)KB, (const attn_body::bf16*)VB, (attn_body::bf16*)MIX); }
        RELOAD_ARGS();
#endif
        conv_phase(P, CAB, MIX, lds, (int)blockIdx.x, (unsigned*)(ws + WS_CTL) + CW_QC, MISC + 12);
#if PROBE_ATT == 2
        if (blockIdx.x == PROBE_BLK && threadIdx.x == 0) atomicAdd((unsigned*)(ws + WS_CTL) + CW_NMAX + 900, (unsigned)(__builtin_amdgcn_s_memrealtime() - pst_[2]));
#endif
        phase_tail(P, lds, MISC + 12, 2, G);
    }
    SEAM(2);
    if (IN(3)) {
        pg8::Gemm g{MIX, WOUT, 3, D, D, (unsigned*)(ws + WS_CTL) + 3002}; pg8::StaticOrder S; S.init(T, D, G, (int)blockIdx.x); S.rep = 1 + ((PROBE_DOUBLE >> 3) & 1);
        pg8::EpiOut E{HB, XB, (float*)(ws + WS_PART), nullptr};
        pg8::gemm_phase<pg8::EpiOut, pg8::StaticOrder, true, false>(lds + RING_OFF, g, S, E);
        phase_tail(P, lds, MISC + 12, 3, G);
    }
    SEAM(3);
#if PROBE_ATT == 9
    if (IN(4) && blockIdx.x == PROBE_BLK && threadIdx.x == 0) atomicAdd((unsigned*)(ws + WS_CTL) + CW_NMAX + 900, 10u * __hip_atomic_load((unsigned*)(ws + WS_CTL) + CW_CVQ, __ATOMIC_RELAXED, __HIP_MEMORY_SCOPE_AGENT));
#endif
#if USE_NAIVE_ROUTER
    if (IN(4)) { router_phase(P, HB, lane, gw, NGW); }
#else
    if (IN(4)) {
        router_skinny(P, HB, HB8, lds, G);
#if PROBE_ATT == 11
        if (threadIdx.x == 0) atomicMax((unsigned*)(ws + WS_CTL) + CW_NMAX + 900, (unsigned)(__builtin_amdgcn_s_memrealtime() - pst_[4]));
#endif
#if PROBE_ATT == 10
        if (blockIdx.x == PROBE_BLK && threadIdx.x == 0) atomicAdd((unsigned*)(ws + WS_CTL) + CW_NMAX + 900, (unsigned)(__builtin_amdgcn_s_memrealtime() - pst_[4]));
#endif
#if PROBE_ATT == 8
        if (blockIdx.x == PROBE_BLK && threadIdx.x == 0) atomicAdd((unsigned*)(ws + WS_CTL) + CW_NMAX + 900, 10u * __hip_atomic_load((unsigned*)(ws + WS_CTL) + CW_CVQ, __ATOMIC_RELAXED, __HIP_MEMORY_SCOPE_AGENT));
#endif
        cvt_fill(P, lds, MISC + 12, 1 << 30, nullptr, G);
    }
#endif
    SEAM(4);
    if (IN(5)) {
        moe_tables(P, lds);
        pg8::Gemm g{(const bf16*)HB8, (const bf16*)WGU, 5, 2048, D / 2, (unsigned*)(ws + WS_CTL) + 3002};
        pg8::MoeOrder S{(const LAS int*)(lds + TAB_OFF) + 32, (const LAS int*)(lds + TAB_OFF), (const int*)(ws + WS_LIST), G, (int)blockIdx.x, 1, T, (size_t)2048 * 2048, 0};
        pg8::EpiGU E{H1, (const int*)(ws + WS_LIST), (const float*)(ws + WS_LISTR), 1.0f / WSCALE, H1SCALE};
        pg8::gemm_phase<pg8::EpiGU, pg8::MoeOrder, true, true, true>(lds + RING_OFF, g, S, E);
    }
    SEAM(5);
    if (IN(6)) {
        if (!IN(5)) moe_tables(P, lds);
        pg8::Gemm g{(const bf16*)H1, (const bf16*)WD, 6, 2048, 512, (unsigned*)(ws + WS_CTL) + 3002};
        pg8::MoeOrder S{(const LAS int*)(lds + TAB_OFF) + 32, (const LAS int*)(lds + TAB_OFF), (const int*)(ws + WS_LIST), G, (int)blockIdx.x, 0, T, (size_t)2048 * 1024, 1};
        pg8::EpiDown E{ws + WS_MIX, (const int*)(ws + WS_LIST), (const float*)(ws + WS_LISTW), YSCALE / (WSCALE * H1SCALE)};
        pg8::gemm_phase<pg8::EpiDown, pg8::MoeOrder, true, true, true>(lds + RING_OFF, g, S, E);
    }
    SEAM(6);
    if (IN(7)) { final_phase(P, HB, ws + WS_MIX, NGW); }
#if PROBE_ATT
    if (blockIdx.x == 0) { const unsigned long long span = __hip_atomic_load((unsigned*)(ws + WS_CTL) + CW_NMAX + 900, __ATOMIC_RELAXED, __HIP_MEMORY_SCOPE_AGENT); const unsigned long long r1 = __builtin_amdgcn_s_memrealtime(); while (__builtin_amdgcn_s_memrealtime() - r1 < span) __builtin_amdgcn_s_sleep(8); }
#endif
#if PROBE_PHASE >= 0
    pst_[NPHASE] = __builtin_amdgcn_s_memrealtime();
    if (blockIdx.x == 0 && PROBE_PHASE < 100) { const unsigned long long span = pst_[(PROBE_PHASE < 100 ? PROBE_PHASE : 0) + 1] - pst_[PROBE_PHASE < 100 ? PROBE_PHASE : 0]; const unsigned long long r1 = __builtin_amdgcn_s_memrealtime(); while (__builtin_amdgcn_s_memrealtime() - r1 < span) __builtin_amdgcn_s_sleep(8); }
#endif
#if PROBE_KLOOP
    if (blockIdx.x == 0) { const long long pticks = (long long)__hip_atomic_load((unsigned*)(ws + WS_CTL) + 3002, __ATOMIC_RELAXED, __HIP_MEMORY_SCOPE_AGENT); const long long r1 = wall_clock64(); while (wall_clock64() - r1 < pticks) __builtin_amdgcn_s_sleep(8); }
#endif
#if PROBE_CLOCK
    if (blockIdx.x == 0) { const unsigned sum = __hip_atomic_load((unsigned*)(ws + WS_CTL) + 3000, __ATOMIC_RELAXED, __HIP_MEMORY_SCOPE_AGENT), mx = __hip_atomic_load((unsigned*)(ws + WS_CTL) + 3001, __ATOMIC_RELAXED, __HIP_MEMORY_SCOPE_AGENT);
        const long long pticks = (long long)mx - (long long)(sum / (unsigned)G); const long long r1 = wall_clock64(); while (wall_clock64() - r1 < pticks) __builtin_amdgcn_s_sleep(8); }
#endif
#undef IN
#undef SEAM
#undef REP
}

extern "C" void kernel_launch(void* const* d_in, const int* in_sizes, int n_in, void* d_out, int out_size, void* d_ws, size_t ws_size, hipStream_t stream) {
    static int grid = 0;
    if (grid == 0) {
        if (n_in != 22 || in_sizes[0] != T * D || out_size != T * D || ws_size < WS_END) { fprintf(stderr, "kernel_launch: unexpected shapes (n_in %d, in0 %d, out %d, ws %zu); nothing launched\n", n_in, n_in > 0 ? in_sizes[0] : -1, out_size, ws_size); grid = -1; return; }
        int dev = 0, cus = 0, per_cu = 0;
        if (hipGetDevice(&dev) != hipSuccess || hipDeviceGetAttribute(&cus, hipDeviceAttributeMultiprocessorCount, dev) != hipSuccess) { grid = -1; return; }
        if (hipFuncSetAttribute((const void*)fwd, hipFuncAttributeMaxDynamicSharedMemorySize, LDS_BYTES) != hipSuccess) { fprintf(stderr, "kernel_launch: hipFuncSetAttribute failed\n"); grid = -1; return; }
        if (hipOccupancyMaxActiveBlocksPerMultiprocessor(&per_cu, (const void*)fwd, NWAVES * 64, LDS_BYTES) != hipSuccess || per_cu < 1) fprintf(stderr, "kernel_launch: occupancy query reports %d\n", per_cu);
        (void)hipGetLastError();
        grid = cus;
    }
    if (grid < 0) return;
    if (hipMemsetAsync((char*)d_ws + WS_CTL, 0, CTL_ZERO_BYTES, stream) != hipSuccess) return;
    Args a{};
    for (int i = 0; i < 22; ++i) a.in[i] = (const float*)d_in[i];
    a.out = (float*)d_out; a.ws = (unsigned char*)d_ws;
#if MK_ONE_LAUNCH
    a.ph_lo = 0; a.ph_hi = NPHASE;
    hipLaunchKernelGGL(fwd, dim3(grid), dim3(NWAVES * 64), LDS_BYTES, stream, a);
#else
    for (int p = 0; p < NPHASE; ++p) { a.ph_lo = p; a.ph_hi = p + 1; hipLaunchKernelGGL(fwd, dim3(grid), dim3(NWAVES * 64), LDS_BYTES, stream, a); }
#endif
}
```

```cpp
#include <hip/hip_runtime.h>
#include <cstdio>
#include <cstdint>
#ifndef PROBE_KLOOP
#define PROBE_KLOOP 0
#endif
#ifndef PROBE_WHAT
#define PROBE_WHAT 0
#endif
#ifndef PROBE_PHASE
#define PROBE_PHASE -1
#endif
#ifndef PROBE_ATT
#define PROBE_ATT 0
#endif
#ifndef PROBE_BLK
#define PROBE_BLK 0
#endif
namespace pg8 {
#define PG8_LAS __attribute__((address_space(3)))
typedef unsigned short bf16_t;
typedef short bf16x8 __attribute__((ext_vector_type(8)));
typedef float f32x4 __attribute__((ext_vector_type(4)));
typedef unsigned u32x4 __attribute__((ext_vector_type(4)));
constexpr int BM = 256, BK = 64, HALF = 128, HTB = HALF * BK * 2  , STAGE_BYTES = 8 * HTB, NXCD = 8, WGM = 8;

__host__ __device__ __forceinline__ int lds_byte(int r, int c) { const int st = (r >> 4) * 2 + (c >> 5), rr = r & 15, cc = c & 31, ob = rr * 64 + cc * 2; return st * 1024 + (ob ^ (((ob >> 9) & 1) << 5)); }
__host__ __device__ __forceinline__ void stage_rc(int b, int& R, int& C) { const int st = b / 1024, sb = b % 1024, swz = sb ^ (((sb >> 9) & 1) << 5); R = (st >> 1) * 16 + swz / 64; C = (st & 1) * 32 + (swz % 64) / 2; }
__host__ __device__ __forceinline__ int perm32(int rho) { const int n = rho >> 4, i = rho & 15; return 8 * (i >> 2) + 4 * n + (i & 3); }

struct Unit { int pm, pn, e, nvalid, lbase, srow; };
struct Gemm { const bf16_t* A; const bf16_t* Bt; int M, N, K; unsigned* probe = nullptr; };

struct StaticOrder {
    int nM, nN, nwg, G, c, rep = 1;
    __host__ __device__ void init(int M, int N, int G_, int c_) { nM = M / BM; nN = N / BM; nwg = nM * nN; G = G_; c = c_; }
    __host__ __device__ bool next(int i, Unit& u) const {
        long L = (long)i * G + c; if (L >= (long)nwg * rep) return false; L %= nwg;
        int wgid = (int)L; { const int q = nwg / NXCD, r = nwg % NXCD, xcd = wgid % NXCD, off = wgid / NXCD; wgid = (xcd < r ? xcd * (q + 1) : r * (q + 1) + (xcd - r) * q) + off; }
        const int nig = WGM * nN, gid = wgid / nig, fm = gid * WGM, gsz = (nM - fm) < WGM ? (nM - fm) : WGM;
        u.pm = fm + ((wgid % nig) % gsz); u.pn = (wgid % nig) / gsz; return true;
    }
    __device__ __forceinline__ const char* bbase(const Gemm& g, const Unit& u, size_t tstep) const { return (const char*)g.Bt + (size_t)u.pn * tstep; }
    __device__ __forceinline__ unsigned goff(const Unit&, int, int, int) const { return 0u; }
    __device__ __forceinline__ void a_ready(const Unit&) const {}
    __device__ __forceinline__ void done(const Unit&) const {}
};

struct StaticOrderG : StaticOrder {
    __device__ __forceinline__ unsigned goff(const Unit& u, int r, int C, int K) const { return ((unsigned)(u.pm * BM + r) * (unsigned)K + (unsigned)C) * 2u; }
};

struct MoeOrder {
    const PG8_LAS int* tstart; const PG8_LAS int* cnt; const int* list; int G, c, shift, lcap; size_t estride; int sorted;
    __device__ __forceinline__ bool next(int i, Unit& u) const {
        const int ntiles = tstart[32]; const int x = c & 7, k = i * (G >> 3) + (c >> 3); const int rt = 2 * (k >> 1) + (x & 1); if (rt >= ntiles) return false;
        int e = 0;
#pragma unroll
        for (int q = 1; q < 32; ++q) e += (tstart[q] <= rt) ? 1 : 0;
        e = __builtin_amdgcn_readfirstlane(e);
        const int pm = __builtin_amdgcn_readfirstlane(rt - tstart[e]); const int rem = __builtin_amdgcn_readfirstlane(cnt[e]) - 256 * pm;
        u.pm = pm; u.pn = 2 * (x >> 1) + (k & 1); u.e = e; u.nvalid = rem < 256 ? rem : 256; u.lbase = e * lcap + 256 * pm; u.srow = 256 * rt; return true;
    }
    __device__ __forceinline__ const char* bbase(const Gemm& g, const Unit& u, size_t tstep) const { return (const char*)g.Bt + (size_t)u.e * estride + (size_t)u.pn * tstep; }
    __device__ __forceinline__ unsigned goff(const Unit& u, int r, int C, int K) const {
        if (sorted) return ((unsigned)(u.srow + r) * (unsigned)K + (unsigned)C) * 2u;
        const int a = list[u.lbase + (r < u.nvalid ? r : 0)];
        return ((unsigned)(a >> shift) * (unsigned)K + (unsigned)C) * 2u;
    }
    __device__ __forceinline__ void a_ready(const Unit&) const {}
    __device__ __forceinline__ void done(const Unit&) const {}
};

struct DynQ {
    unsigned* ctr; volatile PG8_LAS int* slot; int x0, qi; unsigned pend;
    __device__ __forceinline__ void qinit(unsigned* ctr_, volatile PG8_LAS int* slot_, int bx) { ctr = ctr_; slot = slot_; x0 = bx & 7; qi = 0; pend = 0u;
        if (threadIdx.x == 0) pend = __hip_atomic_fetch_add(ctr + 64 * x0, 1u, __ATOMIC_RELAXED, __HIP_MEMORY_SCOPE_AGENT); }
    template <class SizeF> __device__ __forceinline__ int qnext(int i, const SizeF& size_of) {
        const int par = i & 1;
        if (threadIdx.x == 0) { int res = -1;
            while (qi < 8) { const int x = (x0 + qi) & 7; if (pend < (unsigned)size_of(x)) { res = (x << 24) | (int)pend; break; }
                ++qi; if (qi < 8) pend = __hip_atomic_fetch_add(ctr + 64 * ((x0 + qi) & 7), 1u, __ATOMIC_RELAXED, __HIP_MEMORY_SCOPE_AGENT); }
            slot[par] = res;
            if (res >= 0) pend = __hip_atomic_fetch_add(ctr + 64 * ((x0 + qi) & 7), 1u, __ATOMIC_RELAXED, __HIP_MEMORY_SCOPE_AGENT); }
        asm volatile("s_waitcnt lgkmcnt(0)" ::: "memory"); __builtin_amdgcn_s_barrier(); asm volatile("" ::: "memory");
        return __builtin_amdgcn_readfirstlane(slot[par]);
    }
};
struct DynDense : DynQ {
    int nM, nN, nwg;
    __device__ __forceinline__ void init(int M, int N, unsigned* ctr_, volatile PG8_LAS int* slot_, int bx) { nM = M / BM; nN = N / BM; nwg = nM * nN; qinit(ctr_, slot_, bx); }
    __device__ __forceinline__ bool next(int i, Unit& u) {
        const int q = nwg / NXCD, r = nwg % NXCD;
        const int code = qnext(i, [=](int x) { return q + (x < r ? 1 : 0); }); if (code < 0) return false;
        const int x = code >> 24, k = code & 0xffffff; const int wgid = (x < r ? x * (q + 1) : r * (q + 1) + (x - r) * q) + k;
        const int nig = WGM * nN, gid = wgid / nig, fm = gid * WGM, gsz = (nM - fm) < WGM ? (nM - fm) : WGM;
        u.pm = fm + ((wgid % nig) % gsz); u.pn = (wgid % nig) / gsz; return true;
    }
    __device__ __forceinline__ const char* bbase(const Gemm& g, const Unit& u, size_t tstep) const { return (const char*)g.Bt + (size_t)u.pn * tstep; }
    __device__ __forceinline__ unsigned goff(const Unit&, int, int, int) const { return 0u; }
    __device__ __forceinline__ void a_ready(const Unit&) const {}
    __device__ __forceinline__ void done(const Unit&) const {}
};
struct DynDenseG : DynDense {
    __device__ __forceinline__ unsigned goff(const Unit& u, int r, int C, int K) const { return ((unsigned)(u.pm * BM + r) * (unsigned)K + (unsigned)C) * 2u; }
};

__device__ __forceinline__ unsigned cvt_pk_bf16(float lo, float hi) { unsigned r; asm volatile("v_cvt_pk_bf16_f32 %0, %1, %2" : "=v"(r) : "v"(lo), "v"(hi)); return r; }
__device__ __forceinline__ float bf_lo(unsigned w) { return __builtin_bit_cast(float, w << 16); }
__device__ __forceinline__ float bf_hi(unsigned w) { return __builtin_bit_cast(float, w & 0xffff0000u); }
__device__ __forceinline__ unsigned pk4_fp8(float a, float b, float c, float d) {
    a = __builtin_amdgcn_fmed3f(a, -440.f, 440.f); b = __builtin_amdgcn_fmed3f(b, -440.f, 440.f); c = __builtin_amdgcn_fmed3f(c, -440.f, 440.f); d = __builtin_amdgcn_fmed3f(d, -440.f, 440.f);
    int r = __builtin_amdgcn_cvt_pk_fp8_f32(a, b, 0, false); r = __builtin_amdgcn_cvt_pk_fp8_f32(c, d, r, true); return (unsigned)r; }
typedef unsigned u32x2 __attribute__((ext_vector_type(2)));
__device__ __forceinline__ void swap16(u32x2& a, u32x2& b) { auto r0 = __builtin_amdgcn_permlane16_swap(a.x, b.x, false, false); auto r1 = __builtin_amdgcn_permlane16_swap(a.y, b.y, false, false); a = (u32x2){r0[0], r1[0]}; b = (u32x2){r0[1], r1[1]}; }
typedef int v4i_t __attribute__((ext_vector_type(4)));

struct EpiIn {
    static constexpr bool PERM = true, AFTER_DRAIN = false;
    bf16_t* P0; size_t stride; bf16_t* CG; const float* rstd; float scale0; unsigned* nmax; int tbase; float oscale;
    __device__ __forceinline__ void operator()(const f32x4 (&acc)[2][2][4][2], const Unit& u, int wr, int wc, int fr, int fq) const {
        const int row0 = u.pm * BM + wr * 64 + fr, t = (u.pn >> 2) + tbase; bf16_t* base = (t < 4) ? P0 + (size_t)t * stride : CG;
        const float sc = ((t == 0) ? scale0 : 1.f) * oscale; const int col0 = (u.pn & 3) * BM + wc * 32 + 8 * fq;
        float mx[2] = {0.f, 0.f}; float rsv[2][4];
#pragma unroll
        for (int ai = 0; ai < 2; ++ai)
#pragma unroll
            for (int m = 0; m < 4; ++m) rsv[ai][m] = rstd[row0 + ai * HALF + m * 16];
#pragma unroll
        for (int ai = 0; ai < 2; ++ai)
#pragma unroll
            for (int m = 0; m < 4; ++m) { const int row = row0 + ai * HALF + m * 16; const float rs = rsv[ai][m] * sc; bf16_t* rowp = base + (size_t)row * 1024 + col0;
#pragma unroll
                for (int bj = 0; bj < 2; ++bj) { const f32x4 v0 = acc[ai][bj][m][0] * rs, v1 = acc[ai][bj][m][1] * rs;
                    u32x4 w; w.x = cvt_pk_bf16(v0[0], v0[1]); w.y = cvt_pk_bf16(v0[2], v0[3]); w.z = cvt_pk_bf16(v1[0], v1[1]); w.w = cvt_pk_bf16(v1[2], v1[3]);
                    *(u32x4*)(rowp + bj * HALF) = w;
                    if (t < 2) { float ss = (v0[0] * v0[0] + v0[1] * v0[1]) + (v0[2] * v0[2] + v0[3] * v0[3]) + (v1[0] * v1[0] + v1[1] * v1[1]) + (v1[2] * v1[2] + v1[3] * v1[3]);
                        ss += __shfl_xor(ss, 16); ss += __shfl_xor(ss, 32); mx[bj] = __builtin_fmaxf(mx[bj], ss); } } }
        if (t < 2) {
#pragma unroll
            for (int bj = 0; bj < 2; ++bj) { float v = mx[bj];
                v = __builtin_fmaxf(v, __shfl_xor(v, 1)); v = __builtin_fmaxf(v, __shfl_xor(v, 2)); v = __builtin_fmaxf(v, __shfl_xor(v, 4)); v = __builtin_fmaxf(v, __shfl_xor(v, 8));
                const int colb = (u.pn & 3) * BM + bj * HALF + wc * 32, g64 = colb >> 6, bh = (u.pm >> 4) * 8 + (g64 >> 1);
                if (fr == 0 && fq == 0) atomicMax(nmax + ((t * 64 + bh) * 2 + (g64 & 1)) * 2 + (wc & 1), __builtin_bit_cast(unsigned, v)); }
        }
    }
};
struct EpiGLU {
    static constexpr bool PERM = true, AFTER_DRAIN = false;
    bf16_t* U; const float* rstd; float oscale;
    __device__ __forceinline__ void operator()(const f32x4 (&acc)[2][2][4][2], const Unit& u, int wr, int wc, int fr, int fq) const {
        const int row0 = u.pm * BM + wr * 64 + fr, col0 = u.pn * HALF + wc * 32 + 8 * fq; float rsv[2][4];
#pragma unroll
        for (int ai = 0; ai < 2; ++ai)
#pragma unroll
            for (int m = 0; m < 4; ++m) rsv[ai][m] = rstd[row0 + ai * HALF + m * 16];
#pragma unroll
        for (int ai = 0; ai < 2; ++ai)
#pragma unroll
            for (int m = 0; m < 4; ++m) { const int row = row0 + ai * HALF + m * 16; const float rs = rsv[ai][m] * oscale;
                const f32x4 a0 = acc[ai][0][m][0] * rs, a1 = acc[ai][0][m][1] * rs, g0 = acc[ai][1][m][0] * rs, g1 = acc[ai][1][m][1] * rs;
#define PG8_SG(x) __builtin_amdgcn_rcpf(1.f + __builtin_amdgcn_exp2f(-1.4426950408889634f * (x)))
                u32x4 w; w.x = cvt_pk_bf16(a0[0] * PG8_SG(g0[0]), a0[1] * PG8_SG(g0[1])); w.y = cvt_pk_bf16(a0[2] * PG8_SG(g0[2]), a0[3] * PG8_SG(g0[3]));
                w.z = cvt_pk_bf16(a1[0] * PG8_SG(g1[0]), a1[1] * PG8_SG(g1[1])); w.w = cvt_pk_bf16(a1[2] * PG8_SG(g1[2]), a1[3] * PG8_SG(g1[3]));
#undef PG8_SG
                *(u32x4*)(U + (size_t)row * 1024 + col0) = w; }
    }
};
struct EpiOut {
    static constexpr bool PERM = true, AFTER_DRAIN = false;
    bf16_t* H; const bf16_t* XB; float* part; unsigned char* H8;
    __device__ __forceinline__ void operator()(const f32x4 (&acc)[2][2][4][2], const Unit& u, int wr, int wc, int fr, int fq) const {
        const int row0 = u.pm * BM + wr * 64 + fr, col0 = u.pn * BM + wc * 32 + 8 * fq;
#pragma unroll
        for (int ai = 0; ai < 2; ++ai) { u32x4 xbv[4][2];
#pragma unroll
            for (int m = 0; m < 4; ++m)
#pragma unroll
                for (int bj = 0; bj < 2; ++bj) xbv[m][bj] = *(const u32x4*)(XB + (size_t)(row0 + ai * HALF + m * 16) * 2048 + col0 + bj * HALF);
#pragma unroll
            for (int m = 0; m < 4; ++m) { const int row = row0 + ai * HALF + m * 16; const size_t off = (size_t)row * 2048 + col0; float ss = 0.f;
#pragma unroll
                for (int bj = 0; bj < 2; ++bj) { const u32x4 xb = xbv[m][bj];
                    f32x4 v0 = acc[ai][bj][m][0], v1 = acc[ai][bj][m][1];
                    v0[0] += bf_lo(xb.x); v0[1] += bf_hi(xb.x); v0[2] += bf_lo(xb.y); v0[3] += bf_hi(xb.y); v1[0] += bf_lo(xb.z); v1[1] += bf_hi(xb.z); v1[2] += bf_lo(xb.w); v1[3] += bf_hi(xb.w);
                    ss += (v0[0] * v0[0] + v0[1] * v0[1]) + (v0[2] * v0[2] + v0[3] * v0[3]) + (v1[0] * v1[0] + v1[1] * v1[1]) + (v1[2] * v1[2] + v1[3] * v1[3]);
                    u32x4 w; w.x = cvt_pk_bf16(v0[0], v0[1]); w.y = cvt_pk_bf16(v0[2], v0[3]); w.z = cvt_pk_bf16(v1[0], v1[1]); w.w = cvt_pk_bf16(v1[2], v1[3]);
                    *(u32x4*)(H + off + bj * HALF) = w;
                    if (H8) { u32x2 w8; w8.x = pk4_fp8(v0[0], v0[1], v0[2], v0[3]); w8.y = pk4_fp8(v1[0], v1[1], v1[2], v1[3]); *(u32x2*)(H8 + off + bj * HALF) = w8; } }
                ss += __shfl_xor(ss, 16); ss += __shfl_xor(ss, 32);
                if (fq == 0) part[(size_t)row * 32 + u.pn * 4 + wc] = ss; } }
    }
};
__device__ __forceinline__ float silu_f(float x) { return x * __builtin_amdgcn_rcpf(1.f + __builtin_amdgcn_exp2f(-1.4426950408889634f * x)); }
struct EpiGU {
    static constexpr bool PERM = true, AFTER_DRAIN = false;
    unsigned char* H1; const int* list; const float* listr; float wscale, oscale;
    __device__ __forceinline__ void operator()(const f32x4 (&acc)[2][2][4][2], const Unit& u, int wr, int wc, int fr, int fq) const {
        const int col0 = u.pn * HALF + wc * 32 + 8 * fq;
        float rsv[2][4];
#pragma unroll
        for (int ai = 0; ai < 2; ++ai)
#pragma unroll
            for (int m = 0; m < 4; ++m) { const int r = ai * HALF + wr * 64 + m * 16 + fr; rsv[ai][m] = listr[u.lbase + (r < u.nvalid ? r : 0)]; }
#pragma unroll
        for (int ai = 0; ai < 2; ++ai)
#pragma unroll
            for (int mp = 0; mp < 4; mp += 2) { u32x2 wv[2];
#pragma unroll
                for (int q = 0; q < 2; ++q) { const int m = mp + q; const float rs = rsv[ai][m] * wscale;
                    const f32x4 g0 = acc[ai][0][m][0] * rs, g1 = acc[ai][0][m][1] * rs, u0 = acc[ai][1][m][0] * (rs * oscale), u1 = acc[ai][1][m][1] * (rs * oscale);
                    wv[q].x = pk4_fp8(silu_f(g0[0]) * u0[0], silu_f(g0[1]) * u0[1], silu_f(g0[2]) * u0[2], silu_f(g0[3]) * u0[3]);
                    wv[q].y = pk4_fp8(silu_f(g1[0]) * u1[0], silu_f(g1[1]) * u1[1], silu_f(g1[2]) * u1[2], silu_f(g1[3]) * u1[3]); }
                swap16(wv[0], wv[1]);
                const int odd = fq & 1, r = ai * HALF + wr * 64 + (mp + odd) * 16 + fr;
                if (r < u.nvalid) { const u32x4 w = {wv[0].x, wv[0].y, wv[1].x, wv[1].y};
                    *(u32x4*)(H1 + (size_t)(u.srow + r) * 1024 + col0 - 8 * odd) = w; } }
    }
};
struct EpiDown {
    static constexpr bool PERM = true, AFTER_DRAIN = false;
    unsigned char* Y; const int* list; const float* listw; float oscale;
    __device__ __forceinline__ void operator()(const f32x4 (&acc)[2][2][4][2], const Unit& u, int wr, int wc, int fr, int fq) const {
        const int col0 = u.pn * BM + wc * 32 + 8 * fq;
        int av[2][4]; float wv[2][4];
#pragma unroll
        for (int ai = 0; ai < 2; ++ai)
#pragma unroll
            for (int m = 0; m < 4; ++m) { const int r = ai * HALF + wr * 64 + m * 16 + fr, ix = u.lbase + (r < u.nvalid ? r : 0); av[ai][m] = list[ix]; wv[ai][m] = listw[ix]; }
#pragma unroll
        for (int ai = 0; ai < 2; ++ai)
#pragma unroll
            for (int m = 0; m < 4; ++m) { const int r = ai * HALF + wr * 64 + m * 16 + fr; const int a = av[ai][m]; const float ws = wv[ai][m] * oscale;
                u32x2 w0, w1;
                { const f32x4 v0 = acc[ai][0][m][0] * ws, v1 = acc[ai][0][m][1] * ws; w0.x = pk4_fp8(v0[0], v0[1], v0[2], v0[3]); w0.y = pk4_fp8(v1[0], v1[1], v1[2], v1[3]); }
                { const f32x4 v0 = acc[ai][1][m][0] * ws, v1 = acc[ai][1][m][1] * ws; w1.x = pk4_fp8(v0[0], v0[1], v0[2], v0[3]); w1.y = pk4_fp8(v1[0], v1[1], v1[2], v1[3]); }
                swap16(w0, w1);
                if (r < u.nvalid) { const int odd = fq & 1; const u32x4 w = {w0.x, w0.y, w1.x, w1.y};
                    *(u32x4*)(Y + (size_t)a * 2048 + col0 + (odd ? HALF - 8 : 0)) = w; } }
    }
};
struct EpiRouter {
    static constexpr bool PERM = true, AFTER_DRAIN = false;
    const float* part; const float* ber; const float* bgr; float* listr; float* listw; int* list; unsigned* cnt; int lcap;
    __device__ __forceinline__ void operator()(const f32x4 (&acc)[2][2][4][2], const Unit& u, int wr, int wc, int fr, int fq) const {
        if (wc != 0) return;
#pragma unroll
        for (int ai = 0; ai < 2; ++ai)
#pragma unroll
            for (int m = 0; m < 4; ++m) { const int row = u.pm * BM + ai * HALF + wr * 64 + m * 16 + fr;
                const f32x4 p0 = *(const f32x4*)(part + (size_t)row * 32 + 8 * fq), p1 = *(const f32x4*)(part + (size_t)row * 32 + 8 * fq + 4);
                float ss = ((p0[0] + p0[1]) + (p0[2] + p0[3])) + ((p1[0] + p1[1]) + (p1[2] + p1[3]));
                ss += __shfl_xor(ss, 16); ss += __shfl_xor(ss, 32);
                const float rstd = 1.0f / sqrtf(ss * (1.0f / 2048.0f) + 1e-6f);
                const f32x4 gl = acc[ai][1][m][0]; float g[4];
#pragma unroll
                for (int i = 0; i < 4; ++i) g[i] = __shfl(gl[i], fr) * rstd + bgr[i];
                int gs = 0; float gm = g[0];
#pragma unroll
                for (int i = 1; i < 4; ++i) if (g[i] > gm) { gm = g[i]; gs = i; }
                float gsum = 0.f;
#pragma unroll
                for (int i = 0; i < 4; ++i) gsum += __expf(g[i] - gm);
                const float gw = 1.0f / gsum;
                if (fq == gs) { float ev[8];
#pragma unroll
                    for (int i = 0; i < 4; ++i) { ev[i] = acc[ai][0][m][0][i] * rstd + ber[8 * fq + i]; ev[4 + i] = acc[ai][0][m][1][i] * rstd + ber[8 * fq + 4 + i]; }
                    int i1 = 0; float v1 = ev[0];
#pragma unroll
                    for (int i = 1; i < 8; ++i) if (ev[i] > v1) { v1 = ev[i]; i1 = i; }
                    int i2 = -1; float v2 = -3.0e38f;
#pragma unroll
                    for (int i = 0; i < 8; ++i) if (i != i1 && ev[i] > v2) { v2 = ev[i]; i2 = i; }
                    const float e2 = __expf(v2 - v1), w1 = gw / (1.f + e2), w2 = gw * e2 / (1.f + e2);
                    const int ea = gs * 8 + i1, eb = gs * 8 + i2;
                    const unsigned ra = __hip_atomic_fetch_add(cnt + 64 * ea, 1u, __ATOMIC_RELAXED, __HIP_MEMORY_SCOPE_AGENT);
                    const unsigned rb = __hip_atomic_fetch_add(cnt + 64 * eb, 1u, __ATOMIC_RELAXED, __HIP_MEMORY_SCOPE_AGENT);
                    const size_t ia = (size_t)ea * lcap + ra, ib = (size_t)eb * lcap + rb;
                    list[ia] = 2 * row; list[ib] = 2 * row + 1; listw[ia] = w1; listw[ib] = w2; listr[ia] = rstd; listr[ib] = rstd; } }
    }
};

template <class Epi, class Sched, bool ALIGN_EPI, bool GATHER, bool FP8 = false>
__device__ __forceinline__ void gemm_phase(PG8_LAS unsigned char* lds, const Gemm g, Sched& S, const Epi& E) {
    int tid_ = threadIdx.x; asm volatile("" : "+v"(tid_));
    const int tid = tid_, wid = __builtin_amdgcn_readfirstlane(tid >> 6), lane = tid & 63, wr = wid >> 2, wc = wid & 3, fr = lane & 15, fq = lane >> 4;
    const int K = g.K, nt = K / BK;
    unsigned voffA[2], voffB[2]; int RA[2], CA[2];
#pragma unroll
    for (int i = 0; i < 2; ++i) { int R, C; stage_rc(tid * 16 + i * 8192, R, C); const int Rb = Epi::PERM ? ((R & ~31) + perm32(R & 31)) : R;
        voffA[i] = (unsigned)(R * K + C) * 2u; voffB[i] = (unsigned)(Rb * K + C) * 2u; RA[i] = R; CA[i] = C; }
    const size_t kstep = (size_t)(BK * 2);
    const size_t hstep = (size_t)HALF * K * 2;
    const size_t tstep = 2 * hstep;
    const unsigned ldsw = (unsigned)wid * 1024u;
    const int aoff = lds_byte(wr * 64 + fr, fq * 8), boff = lds_byte(wc * 32 + fr, fq * 8);
#define PG8_SA(b, h) (((b) * 2 + (h)) * HTB)
#define PG8_SB(b, h) ((4 + (b) * 2 + (h)) * HTB)
#define PG8_STAGE(bufoff, gbase, voff) do { _Pragma("unroll") for (int _i = 0; _i < 2; ++_i) \
        __builtin_amdgcn_global_load_lds((const unsigned*)((const char*)(gbase) + (voff)[_i]), (PG8_LAS unsigned*)(lds + (bufoff) + ldsw + _i * 8192), 16, 0, 0); } while (0)
#define PG8_STAGE_A(bufoff, kp, h) do { if constexpr (GATHER) { PG8_STAGE(bufoff, kp, cgo[h]); } else { PG8_STAGE(bufoff, (kp) + (h) * hstep, voffA); } } while (0)
#define PG8_LDA(dst, b, h) do { _Pragma("unroll") for (int m = 0; m < 4; ++m) _Pragma("unroll") for (int k = 0; k < 2; ++k) dst[m][k] = *(const PG8_LAS bf16x8*)(lds + PG8_SA(b, h) + aoff + m * 2048 + k * 1024); } while (0)
#define PG8_LDB(dst, b, h) do { _Pragma("unroll") for (int n = 0; n < 2; ++n) _Pragma("unroll") for (int k = 0; k < 2; ++k) dst[n][k] = *(const PG8_LAS bf16x8*)(lds + PG8_SB(b, h) + boff + n * 2048 + k * 1024); } while (0)
#define PG8_CAT(x, y) __builtin_shufflevector(__builtin_bit_cast(v4i_t, x), __builtin_bit_cast(v4i_t, y), 0, 1, 2, 3, 4, 5, 6, 7)
#define PG8_MMA(ai, bj, At, Bt) do { __builtin_amdgcn_s_setprio(1); \
        if constexpr (FP8) { _Pragma("unroll") for (int m = 0; m < 4; ++m) _Pragma("unroll") for (int n = 0; n < 2; ++n) \
            acc[ai][bj][m][n] = __builtin_amdgcn_mfma_scale_f32_16x16x128_f8f6f4(PG8_CAT(Bt[n][0], Bt[n][1]), PG8_CAT(At[m][0], At[m][1]), acc[ai][bj][m][n], 0, 0, 0, 0, 0, 0); } \
        else { _Pragma("unroll") for (int m = 0; m < 4; ++m) _Pragma("unroll") for (int n = 0; n < 2; ++n) _Pragma("unroll") for (int k = 0; k < 2; ++k) \
            acc[ai][bj][m][n] = __builtin_amdgcn_mfma_f32_16x16x32_bf16(Bt[n][k], At[m][k], acc[ai][bj][m][n], 0, 0, 0); } \
        __builtin_amdgcn_s_setprio(0); } while (0)
#define PG8_WAIT_V(n) asm volatile("s_waitcnt vmcnt(" #n ")" ::: "memory")
#define PG8_WAIT_L(n) asm volatile("s_waitcnt lgkmcnt(" #n ")" ::: "memory")
#define PG8_BAR __builtin_amdgcn_s_barrier()
#define PG8_SCHED __builtin_amdgcn_sched_barrier(0)
    Unit cur, nxt; int ui = 0;
#if PROBE_KLOOP
    unsigned pk_acc_ = 0u;
#endif
    if (!S.next(0, cur)) return;
    f32x4 acc[2][2][4][2];
#pragma unroll
    for (int a = 0; a < 2; ++a)
#pragma unroll
        for (int b = 0; b < 2; ++b)
#pragma unroll
            for (int m = 0; m < 4; ++m)
#pragma unroll
                for (int n = 0; n < 2; ++n) acc[a][b][m][n] = (f32x4){0.f, 0.f, 0.f, 0.f};
    bf16x8 At[4][2], B0[2][2], B1[2][2];
    unsigned cgo[2][2] = {{0u, 0u}, {0u, 0u}}, ngo[2][2] = {{0u, 0u}, {0u, 0u}};
    if constexpr (GATHER) {
#pragma unroll
        for (int h = 0; h < 2; ++h)
#pragma unroll
            for (int i = 0; i < 2; ++i) cgo[h][i] = S.goff(cur, h * HALF + RA[i], CA[i], K);
    }
    const char* cA = GATHER ? (const char*)g.A : (const char*)g.A + (size_t)cur.pm * tstep; const char* cB = S.bbase(g, cur, tstep);
    S.a_ready(cur);
    PG8_STAGE(PG8_SB(0, 0), cB, voffB); PG8_STAGE(PG8_SB(0, 1), cB + hstep, voffB); PG8_STAGE_A(PG8_SA(0, 0), cA, 0); PG8_STAGE_A(PG8_SA(0, 1), cA, 1);
    if (wr == 1) PG8_BAR;
    PG8_WAIT_V(2); PG8_BAR;
    PG8_STAGE(PG8_SB(1, 0), cB + kstep, voffB); PG8_STAGE_A(PG8_SA(1, 0), cA + kstep, 0); PG8_STAGE(PG8_SB(1, 1), cB + hstep + kstep, voffB);
    PG8_WAIT_V(6); PG8_BAR;
    for (;;) {
        const bool has_next = S.next(ui + 1, nxt);
        if constexpr (GATHER) {
            if (has_next) {
#pragma unroll
                for (int h = 0; h < 2; ++h)
#pragma unroll
                    for (int i = 0; i < 2; ++i) ngo[h][i] = S.goff(nxt, h * HALF + RA[i], CA[i], K);
            } else {
#pragma unroll
                for (int h = 0; h < 2; ++h)
#pragma unroll
                    for (int i = 0; i < 2; ++i) ngo[h][i] = cgo[h][i];
            }
        }
        const char* nA = GATHER ? (const char*)g.A : (has_next ? (const char*)g.A + (size_t)nxt.pm * tstep : cA); const char* nB = has_next ? S.bbase(g, nxt, tstep) : cB;
#if PROBE_KLOOP
        const unsigned long long pk0_ = __builtin_amdgcn_s_memrealtime();
#endif
        for (int t = 0; t < nt; t += 2) {
            const bool last = (t == nt - 2);
            const char* a1 = cA + (size_t)(t + 1) * kstep;
            const char* a2 = last ? nA : cA + (size_t)(t + 2) * kstep; const char* b2 = last ? nB : cB + (size_t)(t + 2) * kstep;
            const char* a3 = a2 + kstep; const char* b3 = b2 + kstep;
            if (last && has_next) S.a_ready(nxt);
            PG8_LDB(B0, 0, 0); PG8_LDB(B1, 0, 1); PG8_SCHED; PG8_LDA(At, 0, 0); PG8_STAGE_A(PG8_SA(1, 1), a1, 1);
            if constexpr (GATHER) { if (last) {
#pragma unroll
                for (int h = 0; h < 2; ++h)
#pragma unroll
                    for (int i = 0; i < 2; ++i) cgo[h][i] = ngo[h][i]; } }
            PG8_WAIT_V(8); PG8_WAIT_L(0); PG8_BAR; PG8_MMA(0, 0, At, B0); PG8_MMA(0, 1, At, B1); PG8_BAR; PG8_SCHED;
            PG8_LDA(At, 0, 1); PG8_STAGE(PG8_SB(0, 0), b2, voffB); PG8_STAGE(PG8_SB(0, 1), b2 + hstep, voffB); PG8_STAGE_A(PG8_SA(0, 0), a2, 0);
            PG8_WAIT_V(8); PG8_WAIT_L(0); PG8_BAR; PG8_MMA(1, 0, At, B0); PG8_MMA(1, 1, At, B1); PG8_BAR; PG8_SCHED;
            PG8_LDB(B0, 1, 0); PG8_LDB(B1, 1, 1); PG8_SCHED; PG8_LDA(At, 1, 0); PG8_STAGE_A(PG8_SA(0, 1), a2, 1);
            PG8_WAIT_V(8); PG8_WAIT_L(0); PG8_BAR; PG8_MMA(0, 0, At, B0); PG8_MMA(0, 1, At, B1); PG8_BAR; PG8_SCHED;
            PG8_LDA(At, 1, 1); PG8_STAGE(PG8_SB(1, 0), b3, voffB); PG8_STAGE(PG8_SB(1, 1), b3 + hstep, voffB); PG8_STAGE_A(PG8_SA(1, 0), a3, 0);
            PG8_WAIT_V(8); PG8_WAIT_L(0); PG8_BAR; PG8_MMA(1, 0, At, B0); PG8_MMA(1, 1, At, B1); PG8_BAR; PG8_SCHED;
        }
#if PROBE_KLOOP
        const unsigned long long pk1_ = __builtin_amdgcn_s_memrealtime(); if (PROBE_WHAT == 0) pk_acc_ += (unsigned)(pk1_ - pk0_);
#endif
        if constexpr (ALIGN_EPI) { if (wr == 0) PG8_BAR; }
#if PROBE_KLOOP
        const unsigned long long pk2_ = __builtin_amdgcn_s_memrealtime(); if (PROBE_WHAT == 1) pk_acc_ += (unsigned)(pk2_ - pk1_);
#endif
        E(acc, cur, wr, wc, fr, fq); S.done(cur);
#if PROBE_KLOOP
        asm volatile("s_waitcnt vmcnt(0)" ::: "memory"); if (PROBE_WHAT == 2) pk_acc_ += (unsigned)(__builtin_amdgcn_s_memrealtime() - pk2_);
#endif
        if (!has_next) break;
#pragma unroll
        for (int a = 0; a < 2; ++a)
#pragma unroll
            for (int b = 0; b < 2; ++b)
#pragma unroll
                for (int m = 0; m < 4; ++m)
#pragma unroll
                    for (int n = 0; n < 2; ++n) acc[a][b][m][n] = (f32x4){0.f, 0.f, 0.f, 0.f};
        cur = nxt; cA = nA; cB = nB; ++ui;
        if constexpr (ALIGN_EPI) { if (wr == 1) PG8_BAR; }
    }
#if PROBE_KLOOP
    if (blockIdx.x == PROBE_BLK && tid == 0 && g.M == PROBE_KLOOP) atomicAdd(g.probe, pk_acc_);
#endif
    PG8_WAIT_V(0);
    if constexpr (!ALIGN_EPI) { if (wr == 0) PG8_BAR; }
    PG8_BAR;
#undef PG8_SA
#undef PG8_SB
#undef PG8_STAGE
#undef PG8_STAGE_A
#undef PG8_LDA
#undef PG8_LDB
#undef PG8_MMA
#undef PG8_CAT
#undef PG8_WAIT_V
#undef PG8_WAIT_L
#undef PG8_BAR
#undef PG8_SCHED
}
}
#include <hip/hip_bf16.h>
#include <cmath>
namespace attn_body {
using bf16=__hip_bfloat16;
using bf16x8=__attribute__((ext_vector_type(8)))short;
using s16x4=__attribute__((ext_vector_type(4)))short;
using f32x16=__attribute__((ext_vector_type(16)))float;
using u32x4=__attribute__((ext_vector_type(4)))unsigned;
constexpr int BATCH=8,SEQ=4096,D=64,DM=1024;
constexpr int NW=8,QBLK=32,QB=QBLK*NW,KVBLK=64,NQB=SEQ/QB;
__device__ __forceinline__ int crow(int r,int hi){return (r&3)+8*(r>>2)+4*hi;}
#define SBAR() __builtin_amdgcn_sched_barrier(0)
__device__ __forceinline__ void cmask(f32x16&p0,f32x16&p1,int jb,int qrel,int hi){
  const float NEG=-INFINITY; const int lim=qrel-64*jb-4*hi;
  #pragma unroll
  for(int r=0;r<16;++r){const int cr=(r&3)+8*(r>>2); if(cr>lim)p0[r]=NEG; if(cr+32>lim)p1[r]=NEG;}
}

constexpr int NSLOT=3, SLOTB=8192;
constexpr int LDS_K=0, LDS_V=NSLOT*SLOTB, LDS_WS=3*NSLOT*SLOTB, LDS_OST=LDS_WS+NW*64*4, LDS_NMAX=LDS_OST+NW*4096, LDS_BYTES=LDS_NMAX+2048;
__device__ __forceinline__ void glds16(const void*sbase,unsigned voff,unsigned lds_dst){unsigned keep;
  asm volatile("s_mov_b32 %0, m0\n\ts_mov_b32 m0, %3\n\ts_nop 0\n\tglobal_load_lds_dwordx4 %1, %2\n\ts_mov_b32 m0, %0":"=&s"(keep):"v"(voff),"s"(sbase),"s"(lds_dst):"memory");}
__device__ __forceinline__ float max3f(float a,float b,float c){float r;asm("v_max3_f32 %0, %1, %2, %3":"=v"(r):"v"(a),"v"(b),"v"(c));return r;}
__device__ __forceinline__ float max2f(float a,float b){float r;asm("v_max_f32_e32 %0, %1, %2":"=v"(r):"v"(a),"v"(b));return r;}
__device__ __forceinline__ float fsub_s(float a,float b){float r;asm("v_sub_f32_e32 %0, %1, %2":"=v"(r):"v"(a),"v"(b));return r;}
typedef float f32x2_t __attribute__((ext_vector_type(2))); typedef __bf16 bf16x2_t __attribute__((ext_vector_type(2)));
__device__ __forceinline__ unsigned cvtpk_s(float lo,float hi){f32x2_t v={lo,hi};bf16x2_t b=__builtin_convertvector(v,bf16x2_t);return __builtin_bit_cast(unsigned,b);}
#define WAIT_BAR(N) asm volatile("s_waitcnt vmcnt(" #N ") lgkmcnt(0)\n\ts_barrier":::"memory")
#define MFMA32(a,b,c) __builtin_amdgcn_mfma_f32_32x32x16_bf16(a,b,c,0,0,0)

__device__ __forceinline__ void qkt(f32x16&p0,f32x16&p1,const char*Kslot,const bf16x8*qr,int r32,int hi){
  const char*kb=Kslot+hi*1024+r32*16;
  #pragma unroll
  for(int d0=0;d0<4;++d0){
    const bf16x8 b0=*reinterpret_cast<const bf16x8*>(kb+d0*2048);
    const bf16x8 b1=*reinterpret_cast<const bf16x8*>(kb+d0*2048+512);
    p0=MFMA32(b0,qr[d0],p0);p1=MFMA32(b1,qr[d0],p1);}
}
typedef __attribute__((address_space(3))) const char* lds_cptr;
typedef short v4i16_t __attribute__((ext_vector_type(4)));
__device__ __forceinline__ void kload8(bf16x8*kf,lds_cptr kp){
  kf[0]=*(const __attribute__((address_space(3))) bf16x8*)(kp);      kf[1]=*(const __attribute__((address_space(3))) bf16x8*)(kp+512);
  kf[2]=*(const __attribute__((address_space(3))) bf16x8*)(kp+2048); kf[3]=*(const __attribute__((address_space(3))) bf16x8*)(kp+2560);
  kf[4]=*(const __attribute__((address_space(3))) bf16x8*)(kp+4096); kf[5]=*(const __attribute__((address_space(3))) bf16x8*)(kp+4608);
  kf[6]=*(const __attribute__((address_space(3))) bf16x8*)(kp+6144); kf[7]=*(const __attribute__((address_space(3))) bf16x8*)(kp+6656);
}
__device__ __forceinline__ void kload2(bf16x8*kf,lds_cptr kp,int j){ kf[2*j]=*(const __attribute__((address_space(3))) bf16x8*)(kp+j*2048); kf[2*j+1]=*(const __attribute__((address_space(3))) bf16x8*)(kp+j*2048+512); }
__device__ __forceinline__ s16x4 vtr(lds_cptr p){ return __builtin_bit_cast(s16x4,__builtin_amdgcn_ds_read_tr16_b64_v4i16((__attribute__((address_space(3))) v4i16_t*)p)); }
__device__ __forceinline__ float rowmax(const f32x16&p0,const f32x16&p1){
  float a=max3f(p0[0],p0[1],p1[0]),b=max3f(p0[2],p0[3],p1[1]);a=max3f(a,p1[2],p1[3]);
  #pragma unroll
  for(int r=4;r<16;r+=4){a=max3f(a,p0[r],p0[r+1]);b=max3f(b,p0[r+2],p0[r+3]);a=max3f(a,p1[r],p1[r+1]);b=max3f(b,p1[r+2],p1[r+3]);}
  const float m=max2f(a,b);
  auto rr=__builtin_amdgcn_permlane32_swap(__float_as_uint(m),__float_as_uint(m),false,false);
  return max2f(__uint_as_float(rr[0]),__uint_as_float(rr[1]));
}
__device__ __forceinline__ void pv(f32x16*o,int vb,bf16x8 pa0,bf16x8 pa1,bf16x8 pa2,bf16x8 pa3){
  #pragma unroll
  for(int d0=0;d0<4;++d0){s16x4 lo[4],hi[4];
    #pragma unroll
    for(int ks=0;ks<4;++ks){
      asm volatile("ds_read_b64_tr_b16 %0,%1 offset:%c2":"=&v"(lo[ks]):"v"(vb),"i"(d0*4096+ks*1024):"memory");
      asm volatile("ds_read_b64_tr_b16 %0,%1 offset:%c2":"=&v"(hi[ks]):"v"(vb),"i"(d0*4096+ks*1024+512):"memory");}
    asm volatile("s_waitcnt lgkmcnt(0)":::"memory");SBAR();
    #define PK(k) (bf16x8){lo[k][0],lo[k][1],lo[k][2],lo[k][3],hi[k][0],hi[k][1],hi[k][2],hi[k][3]}
    o[d0]=MFMA32(pa0,PK(0),o[d0]);
    o[d0]=MFMA32(pa1,PK(1),o[d0]);
    o[d0]=MFMA32(pa2,PK(2),o[d0]);
    o[d0]=MFMA32(pa3,PK(3),o[d0]);
    #undef PK
  }
}

template<int THRL> __device__ __forceinline__ void attn_sub(int b,int qkcol,int vcol,int qb,int cmap,float sl2,float lam,int ntcap,float Ub,float oscale,const float*subg,unsigned*o1s,bf16*MIXh,const bf16*Q,const bf16*__restrict__ K,const bf16*__restrict__ V,char*shm,unsigned*pw_,unsigned*popctr,volatile __attribute__((address_space(3))) unsigned*popslot){
#if PROBE_ATT >= 3
  const unsigned long long ps0_=__builtin_amdgcn_s_memrealtime();
#endif
  const int tid=threadIdx.x,lane=tid&63,r32=lane&31,hi=lane>>5; const int wid=__builtin_amdgcn_readfirstlane(tid>>6);
  const long rowbase=(long)b*SEQ; const int q0=qb*QB;
  const bf16*Qw=Q+(rowbase+q0+wid*QBLK)*DM+qkcol;
  const bf16*Kh=K+rowbase*DM+qkcol,*Vh=V+rowbase*DM+vcol;
  const unsigned lds0=(unsigned)(uintptr_t)shm;
  float*wsf=(float*)(shm+LDS_WS)+wid*64;
  const unsigned koff=(unsigned)(lane*DM+wid*8)*2u, voffv=(unsigned)((16*(wid&3)+(lane>>2))*DM+(wid>>2)*32+(lane&3)*8)*2u;
  const unsigned kdst=lds0+LDS_K+wid*1024, vdst=lds0+LDS_V+wid*1024;
  const int NTR=(q0+QB)/KVBLK;
  int NT=NTR<ntcap?NTR:ntcap;
  #define DMA_K(t,slot) glds16(Kh+(long)(NTR-1-(t))*KVBLK*DM,koff,(unsigned)__builtin_amdgcn_readfirstlane(kdst+(slot)))
  #define DMA_V(t,slot) do{ glds16(Vh+(long)(NTR-1-(t))*KVBLK*DM,voffv,(unsigned)__builtin_amdgcn_readfirstlane(vdst+2*(slot))); glds16(Vh+(long)(NTR-1-(t))*KVBLK*DM+64,voffv,(unsigned)__builtin_amdgcn_readfirstlane(vdst+2*(slot)+8192)); }while(0)
  const char*Kbase=shm+LDS_K; bf16x8 kf[8];
  const lds_cptr shm3=(lds_cptr)shm; const lds_cptr kp0=shm3+LDS_K+hi*1024+r32*16; const lds_cptr vp0=shm3+LDS_V+((lane>>4)&1)*32+(lane&3)*8+(4*hi+((lane&15)>>2))*64;
  #define vb0 ((int)(unsigned)(uintptr_t)vp0)
  DMA_K(0,0);DMA_V(0,0);DMA_K(1,SLOTB);
  bf16x8 qr[4];
  #pragma unroll
  for(int d0=0;d0<4;++d0)qr[d0]=*reinterpret_cast<const bf16x8*>(&Qw[(long)r32*DM+d0*16+hi*8]);
  const int qrel=wid*QBLK+r32;
  const unsigned lm=hi?0u:0xffffffffu;
  const int qw0=wid*QBLK;
  unsigned bbx; { const unsigned sh=__float_as_uint(sl2)&0xffff0000u; const float sr=sl2-__uint_as_float(sh); bbx=((sh>>16)|(cvtpk_s(sr,0.f)<<16))&lm; }
  const float dlt=64.f*sl2;
  float cref=sl2*(float)(192-qrel);
  #define BIAS2(C0,C1,t) do{ const float c_=__builtin_fmaf(-dlt,(float)(t),cref); const unsigned h_=__float_as_uint(c_)&0xffff0000u; const float r1_=c_-__uint_as_float(h_); \
      const unsigned m_=__float_as_uint(r1_)&0xffff0000u; const float r2_=r1_-__uint_as_float(m_); \
      int q_=qrel; asm volatile("":"+v"(q_)); const float rf_=(float)(q_-qw0); \
      u32x4 b_=(u32x4){bbx,((h_>>16)|m_)&lm,(__float_as_uint(r2_)>>16)&lm,0u}; u32x4 a_=(u32x4){cvtpk_s(rf_,rf_),0x3F803F80u,0x00003F80u,0u}; asm volatile("":"+v"(a_),"+v"(b_)); \
      const f32x16 z_=f32x16{}; C0=MFMA32(__builtin_bit_cast(bf16x8,a_),__builtin_bit_cast(bf16x8,b_),z_); \
      a_.x=cvtpk_s(rf_+32.f,rf_+32.f); asm volatile("":"+v"(a_)); C1=MFMA32(__builtin_bit_cast(bf16x8,a_),__builtin_bit_cast(bf16x8,b_),z_); }while(0)
  float l_reg=0.f;f32x16 o[4];o[0]=f32x16{};o[1]=f32x16{};o[2]=f32x16{};o[3]=f32x16{};
  #define CMASK(P0,P1,t) do{int jb_=3-(t); if(jb_>=0)cmask(P0,P1,jb_,qrel,hi);}while(0)
  bool resc=false;
  #define START(P0,P1) do{ const float rm=rowmax(P0,P1); resc=false; \
    if(__any(rm>(float)THRL)){ const float dl=max2f(rm,0.f); cref=fsub_s(cref,dl); \
      _Pragma("unroll") for(int r=0;r<16;++r){P0[r]=fsub_s(P0[r],dl);P1[r]=fsub_s(P1[r],dl);} } \
    _Pragma("unroll") for(int r=0;r<16;++r)P0[r]=__builtin_amdgcn_exp2f(P0[r]); }while(0)
  #define RESC() do{ if(resc){ asm volatile("s_waitcnt lgkmcnt(0)":::"memory"); \
      _Pragma("unroll") for(int d_=0;d_<4;++d_) _Pragma("unroll") for(int r=0;r<16;++r)o[d_][r]*=wsf[crow(r,hi)]; } }while(0)
  f32x16 pA0,pA1,pB0,pB1;
  int sl_prev=0,sl_cur=0,sl_next=SLOTB;
  #define ROT() do{sl_prev=sl_cur;sl_cur=sl_next;sl_next=(sl_next==(NSLOT-1)*SLOTB)?0:sl_next+SLOTB;}while(0)
  DMA_K(2,2*SLOTB);
  WAIT_BAR(3);
  BIAS2(pA0,pA1,0);
  qkt(pA0,pA1,Kbase,qr,r32,hi);asm volatile("s_nop 15\n\ts_nop 7":"+v"(pA0),"+v"(pA1));CMASK(pA0,pA1,0);
  START(pA0,pA1);
  _Pragma("unroll") for(int r=0;r<16;++r)pA1[r]=__builtin_amdgcn_exp2f(pA1[r]);
  WAIT_BAR(0);
  DMA_K(3,0);DMA_V(1,SLOTB);
  ROT();
  kload8(kf,kp0+sl_cur);
  WAIT_BAR(3);
  s16x4 vlo[8],vhi[8]; u32x4 pw0,pw1,pw2,pw3;
  #define PKW(P,B) cvtpk_s(P[B],P[B+1])
  #define PAF(k) __builtin_bit_cast(bf16x8,pw##k)
  #define VFR(i) (bf16x8){vlo[i][0],vlo[i][1],vlo[i][2],vlo[i][3],vhi[i][0],vhi[i][1],vhi[i][2],vhi[i][3]}
  #define PIN(x) asm volatile("":"+v"(x))
  #define MX3(a,b,c) __builtin_fmaxf(__builtin_fmaxf((a),(b)),(c))
  #define GAPA(MF,A0,A1,A2,A3,W0,W1,PW) do{ MF; sacc+=A0; sacc+=A1; sacc+=A2; sacc+=A3; PIN(sacc); W0; W1; PIN(PW); SBAR(); }while(0)
  #define EX(v) __builtin_amdgcn_exp2f(v)
  #define GAPB(MF,X,B) do{ MF; X[B]=EX(X[B]); X[B+1]=EX(X[B+1]); PIN(X); SBAR(); }while(0)
  #define VRD2(i) do{ vlo[i]=vtr(vp_+(8192+((i)>>2)*4096+((i)&3)*1024)); vhi[i]=vtr(vp_+(8192+((i)>>2)*4096+((i)&3)*1024+512)); SBAR(); }while(0)
  #define VRD(i) do{ vlo[i]=vtr(vp_+(((i)>>2)*4096+((i)&3)*1024)); vhi[i]=vtr(vp_+(((i)>>2)*4096+((i)&3)*1024+512)); }while(0)
  #define KRD(G,j) do{ if(G){ kload2(kf,kp0+sl_next,j); SBAR(); } }while(0)
  #define STEP(C0,C1,P0,P1,t,GK,GV,GL) do{ SBAR(); \
    BIAS2(C0,C1,t); SBAR(); \
    const lds_cptr vp_=vp0+2*sl_prev; \
    VRD(0); SBAR(); float sacc=(P0[0]+P0[1]); \
    GAPA(C0=MFMA32(kf[0],qr[0],C0), P0[2],P0[3],P0[4],P0[5],     pw0[0]=PKW(P0,0), pw0[1]=PKW(P0,2), pw0); \
    VRD(4); SBAR(); GAPA(C1=MFMA32(kf[1],qr[0],C1), P0[6],P0[7],P0[8],P0[9],     pw0[2]=PKW(P0,4), pw0[3]=PKW(P0,6), pw0); \
    VRD(1); SBAR(); GAPA(C0=MFMA32(kf[2],qr[1],C0),   P0[10],P0[11],P0[12],P0[13], pw1[0]=PKW(P0,8), pw1[1]=PKW(P0,10), pw1); \
    VRD(5); SBAR(); GAPA(C1=MFMA32(kf[3],qr[1],C1),   P0[14],P0[15],P1[0],P1[1],   pw1[2]=PKW(P0,12),pw1[3]=PKW(P0,14), pw1); \
    VRD(2); SBAR(); GAPA(C0=MFMA32(kf[4],qr[2],C0),   P1[2],P1[3],P1[4],P1[5],     pw2[0]=PKW(P1,0), pw2[1]=PKW(P1,2), pw2); \
    VRD(6); SBAR(); GAPA(C1=MFMA32(kf[5],qr[2],C1),   P1[6],P1[7],P1[8],P1[9],     pw2[2]=PKW(P1,4), pw2[3]=PKW(P1,6), pw2); \
    VRD(3); SBAR(); GAPA(C0=MFMA32(kf[6],qr[3],C0),   P1[10],P1[11],P1[12],P1[13], pw3[0]=PKW(P1,8), pw3[1]=PKW(P1,10), pw3); \
    VRD(7); SBAR(); GAPA(C1=MFMA32(kf[7],qr[3],C1),   P1[14],P1[15],0.f,0.f,       pw3[2]=PKW(P1,12),pw3[3]=PKW(P1,14), pw3); \
    l_reg+=sacc; \
    if(GK){DMA_K((t)+3,sl_cur);} if(GV){DMA_V((t)+1,sl_next);} \
    CMASK(C0,C1,t); \
    { float a=MX3(C0[0],C0[1],C1[0]),b=MX3(C0[2],C0[3],C1[1]); a=MX3(a,C1[2],C1[3]); \
      _Pragma("unroll") for(int r=4;r<16;r+=4){a=MX3(a,C0[r],C0[r+1]);b=MX3(b,C0[r+2],C0[r+3]);a=MX3(a,C1[r],C1[r+1]);b=MX3(b,C1[r+2],C1[r+3]);} \
      float rm=__builtin_fmaxf(a,b); { auto rr=__builtin_amdgcn_permlane32_swap(__float_as_uint(rm),__float_as_uint(rm),false,false); rm=__builtin_fmaxf(__uint_as_float(rr[0]),__uint_as_float(rr[1])); } \
      resc=false; \
      if(__builtin_expect(__any(rm>(float)THRL),0)){ const float dl=__builtin_fmaxf(rm,0.f); cref-=dl; \
        _Pragma("unroll") for(int r=0;r<16;++r){C0[r]-=dl;C1[r]-=dl;} \
        const float f=__builtin_amdgcn_exp2f(-dl); l_reg*=f; if(hi==0)wsf[r32]=f; resc=true; } } \
    SBAR(); \
    GAPB(o[0]=MFMA32(PAF(0),VFR(0),o[0]), C0,0);  VRD2(0); \
    GAPB(o[1]=MFMA32(PAF(0),VFR(4),o[1]), C0,2);  VRD2(4); \
    KRD(GL,0); GAPB(o[0]=MFMA32(PAF(1),VFR(1),o[0]), C0,4);  VRD2(1); \
    KRD(GL,1); GAPB(o[1]=MFMA32(PAF(1),VFR(5),o[1]), C0,6);  VRD2(5); \
    KRD(GL,2); GAPB(o[0]=MFMA32(PAF(2),VFR(2),o[0]), C0,8);  VRD2(2); \
    KRD(GL,3); GAPB(o[1]=MFMA32(PAF(2),VFR(6),o[1]), C0,10); VRD2(6); \
    GAPB(o[0]=MFMA32(PAF(3),VFR(3),o[0]), C0,12); VRD2(3); \
    GAPB(o[1]=MFMA32(PAF(3),VFR(7),o[1]), C0,14); VRD2(7); \
    GAPB(o[2]=MFMA32(PAF(0),VFR(0),o[2]), C1,0); \
    GAPB(o[3]=MFMA32(PAF(0),VFR(4),o[3]), C1,2); \
    GAPB(o[2]=MFMA32(PAF(1),VFR(1),o[2]), C1,4); \
    GAPB(o[3]=MFMA32(PAF(1),VFR(5),o[3]), C1,6); \
    GAPB(o[2]=MFMA32(PAF(2),VFR(2),o[2]), C1,8); \
    GAPB(o[3]=MFMA32(PAF(2),VFR(6),o[3]), C1,10); \
    GAPB(o[2]=MFMA32(PAF(3),VFR(3),o[2]), C1,12); \
    GAPB(o[3]=MFMA32(PAF(3),VFR(7),o[3]), C1,14); \
    }while(0)
  #define ENDW(tt) do{ if((tt)+3<NT){WAIT_BAR(3);} else if((tt)+2<NT){WAIT_BAR(2);} else {WAIT_BAR(0);} }while(0)
#if PROBE_ATT == 3
  if(blockIdx.x==PROBE_BLK&&threadIdx.x==0)atomicAdd(pw_,(unsigned)(__builtin_amdgcn_s_memrealtime()-ps0_));
#endif
  int t=1;
  for(;t<5&&t+1<NT;t+=2){
    STEP(pB0,pB1,pA0,pA1,t,(t+3<NT),(t+1<NT),(t+1<NT));       ENDW(t);   RESC(); ROT();
    STEP(pA0,pA1,pB0,pB1,t+1,(t+4<NT),(t+2<NT),(t+2<NT));     ENDW(t+1); RESC(); ROT();
  }
  #undef CMASK
  #define CMASK(P0,P1,t) do{}while(0)
  for(;t+5<NT;t+=2){
    if((t&15)==5){
    float lt=l_reg; {auto rr=__builtin_amdgcn_permlane32_swap(__float_as_uint(lt),__float_as_uint(lt),false,false);lt=__uint_as_float(rr[0])+__uint_as_float(rr[1]);}
    float dl2=(sl2*(float)(192-qrel)-cref)+__builtin_amdgcn_logf(lt);
    #define DPPMIN(ctl) dl2=__builtin_fminf(dl2,__uint_as_float((unsigned)__builtin_amdgcn_update_dpp(0,(int)__float_as_uint(dl2),ctl,0xF,0xF,false)))
    DPPMIN(0xB1); DPPMIN(0x4E); DPPMIN(0x141); DPPMIN(0x140);
    #undef DPPMIN
    { auto rr=__builtin_amdgcn_permlane16_swap(__float_as_uint(dl2),__float_as_uint(dl2),false,false); dl2=__builtin_fminf(__uint_as_float(rr[0]),__uint_as_float(rr[1])); }
    float*xw=(float*)(shm+LDS_OST);
    if(lane==0)xw[wid]=dl2;
    asm volatile("s_waitcnt lgkmcnt(0)\n\ts_barrier":::"memory");
    float dmin=xw[0];
    #pragma unroll
    for(int w_=1;w_<8;++w_)dmin=__builtin_fminf(dmin,xw[w_]);
    dmin=__uint_as_float(__builtin_amdgcn_readfirstlane(__float_as_uint(dmin)));
    const float d0_=(Ub-dmin+24.f+log2f(1.f/(1.f-exp2f(-sl2))))/sl2; float st_=ceilf((d0_+255.f)*(1.f/64.f)); const float lo_=(float)(t+5); st_=st_<lo_?lo_:(st_>64.f?64.f:st_);
    const int nc_=__builtin_amdgcn_readfirstlane((((int)st_)+1)&~1); if(nc_<NT)NT=nc_;
    asm volatile("s_waitcnt lgkmcnt(0)":::"memory");
  }
    STEP(pB0,pB1,pA0,pA1,t,true,true,true);     WAIT_BAR(3); RESC(); ROT();
    STEP(pA0,pA1,pB0,pB1,t+1,true,true,true);   WAIT_BAR(3); RESC(); ROT();
  }
  for(;t+1<NT;t+=2){
    STEP(pB0,pB1,pA0,pA1,t,(t+3<NT),(t+1<NT),(t+1<NT));       ENDW(t);   RESC(); ROT();
    STEP(pA0,pA1,pB0,pB1,t+1,(t+4<NT),(t+2<NT),(t+2<NT));     ENDW(t+1); RESC(); ROT();
  }
  #undef CMASK
  #define CMASK(P0,P1,t) do{int jb_=3-(t); if(jb_>=0)cmask(P0,P1,jb_,qrel,hi);}while(0)
  STEP(pB0,pB1,pA0,pA1,NT-1,false,false,false); RESC();
#if PROBE_ATT == 4
  const unsigned long long ps1_=__builtin_amdgcn_s_memrealtime();
#endif
  { float sacc=pB0[0]+pB0[1]; _Pragma("unroll") for(int r=2;r<16;++r)sacc+=pB0[r]; _Pragma("unroll") for(int r=0;r<16;++r)sacc+=pB1[r]; l_reg+=sacc;
    pw0=(u32x4){PKW(pB0,0),PKW(pB0,2),PKW(pB0,4),PKW(pB0,6)};pw1=(u32x4){PKW(pB0,8),PKW(pB0,10),PKW(pB0,12),PKW(pB0,14)};pw2=(u32x4){PKW(pB1,0),PKW(pB1,2),PKW(pB1,4),PKW(pB1,6)};pw3=(u32x4){PKW(pB1,8),PKW(pB1,10),PKW(pB1,12),PKW(pB1,14)};
    SBAR(); pv(o,vb0+2*sl_cur,PAF(0),PAF(1),PAF(2),PAF(3)); }
  #undef PKW
  #undef PAF
  #undef VFR
  #undef PIN
  #undef MX3
  #undef GAPA
  #undef GAPB
  #undef EX
  #undef VRD
  #undef VRD2
  #undef KRD
  #undef STEP
  #undef ENDW
  { int tid_e=threadIdx.x; asm volatile("":"+v"(tid_e)); const int lane=tid_e&63,r32=lane&31,hi=lane>>5; const int wid=__builtin_amdgcn_readfirstlane(tid_e>>6);
    unsigned nx_=0u; if(popctr&&tid_e==0)nx_=__hip_atomic_fetch_add(popctr,1u,__ATOMIC_RELAXED,__HIP_MEMORY_SCOPE_AGENT);
    float*wsf=(float*)(shm+LDS_WS)+wid*64;
  {auto rr=__builtin_amdgcn_permlane32_swap(__float_as_uint(l_reg),__float_as_uint(l_reg),false,false);l_reg=__uint_as_float(rr[0])+__uint_as_float(rr[1]);}
  if(hi==0)wsf[32+r32]=l_reg;asm volatile("s_waitcnt lgkmcnt(0)":::"memory");
  float rli[16];
  #pragma unroll
  for(int r=0;r<16;++r)rli[r]=__builtin_amdgcn_rcpf(wsf[32+crow(r,hi)]);
  u32x4*ow=(u32x4*)(o1s+wid*2048)+lane;
  if(cmap==0){
    #pragma unroll
    for(int i=0;i<8;++i){ const int dq=i>>1,r0=8*(i&1); u32x4 w;
      w.x=cvtpk_s(o[dq][r0+0]*rli[r0+0],o[dq][r0+1]*rli[r0+1]); w.y=cvtpk_s(o[dq][r0+2]*rli[r0+2],o[dq][r0+3]*rli[r0+3]);
      w.z=cvtpk_s(o[dq][r0+4]*rli[r0+4],o[dq][r0+5]*rli[r0+5]); w.w=cvtpk_s(o[dq][r0+6]*rli[r0+6],o[dq][r0+7]*rli[r0+7]); ow[i*64]=w; }
  } else {
    bf16*stg=(bf16*)(shm+LDS_OST)+wid*2048;
    const int row=lane>>1,part=lane&1; float v[64]; float ss=0.f;
    unsigned o1w[32];
    #pragma unroll
    for(int i=0;i<8;++i){ const u32x4 w=ow[i*64]; o1w[4*i+0]=w.x; o1w[4*i+1]=w.y; o1w[4*i+2]=w.z; o1w[4*i+3]=w.w; }
    #pragma unroll
    for(int p_=0;p_<2;++p_){
      #pragma unroll
      for(int d0=0;d0<2;++d0){ const int dq=2*p_+d0;
        #pragma unroll
        for(int rp=0;rp<8;++rp){ const unsigned w=o1w[dq*8+rp];
          const float a0=__uint_as_float(w<<16)-lam*(o[dq][2*rp]*rli[2*rp]), a1=__uint_as_float(w&0xffff0000u)-lam*(o[dq][2*rp+1]*rli[2*rp+1]);
          stg[crow(2*rp,hi)*64+d0*32+r32]=__float2bfloat16(a0); stg[crow(2*rp+1,hi)*64+d0*32+r32]=__float2bfloat16(a1); } }
      asm volatile("s_waitcnt lgkmcnt(0)":::"memory");
      #pragma unroll
      for(int i=0;i<4;++i){ const u32x4 w=*(const u32x4*)(stg+row*64+part*32+8*i);
        v[32*p_+8*i+0]=__uint_as_float(w.x<<16); v[32*p_+8*i+1]=__uint_as_float(w.x&0xffff0000u); v[32*p_+8*i+2]=__uint_as_float(w.y<<16); v[32*p_+8*i+3]=__uint_as_float(w.y&0xffff0000u);
        v[32*p_+8*i+4]=__uint_as_float(w.z<<16); v[32*p_+8*i+5]=__uint_as_float(w.z&0xffff0000u); v[32*p_+8*i+6]=__uint_as_float(w.w<<16); v[32*p_+8*i+7]=__uint_as_float(w.w&0xffff0000u); }
      asm volatile("s_waitcnt lgkmcnt(0)":::"memory");
    }
    #pragma unroll
    for(int i=0;i<64;++i)ss+=v[i]*v[i];
    ss+=__uint_as_float((unsigned)__builtin_amdgcn_update_dpp(0,(int)__float_as_uint(ss),0xB1,0xF,0xF,false));
    const float rs=(1.0f/sqrtf(ss*(1.0f/128.0f)+1e-6f))*oscale;
    bf16*op=MIXh+((long)rowbase+q0+wid*QBLK+row)*2048+part*32;
    #pragma unroll
    for(int p_=0;p_<2;++p_){ const float*sg=subg+64*p_+32*part;
      #pragma unroll
      for(int i=0;i<4;++i){ u32x4 w; const float*vv=v+32*p_+8*i; const float*gg=sg+8*i;
        w.x=cvtpk_s(vv[0]*rs*gg[0],vv[1]*rs*gg[1]); w.y=cvtpk_s(vv[2]*rs*gg[2],vv[3]*rs*gg[3]); w.z=cvtpk_s(vv[4]*rs*gg[4],vv[5]*rs*gg[5]); w.w=cvtpk_s(vv[6]*rs*gg[6],vv[7]*rs*gg[7]);
        *(u32x4*)(op+64*p_+8*i)=w; } }
  }
    if(popctr&&tid_e==0)*popslot=nx_;
  }
  asm volatile("s_waitcnt lgkmcnt(0)\n\ts_barrier":::"memory");
#if PROBE_ATT == 4
  if(blockIdx.x==PROBE_BLK&&threadIdx.x==0)atomicAdd(pw_,(unsigned)(__builtin_amdgcn_s_memrealtime()-ps1_));
#endif
  #undef DMA_K
  #undef DMA_V
  #undef vb0
  #undef CMASK
  #undef START
  #undef RESC
  #undef ROT
  #undef BIAS2
}
constexpr int ATTN_LDS_BYTES=LDS_BYTES;
template<int THRL> __device__ __forceinline__ void attn_unit4(int b,int h,int qb,float lam,float oscale,const float*subg,const unsigned*nmax,unsigned*o1s,const bf16*Q,const bf16*K,const bf16*V,bf16*MIX,char*shm,unsigned*popctr,volatile __attribute__((address_space(3))) unsigned*popslot){
  const float sl2=exp2f(-(float)(h+1))*1.4426950408889634f;
  int cap[2]; float Uv[2];
  const __attribute__((address_space(3))) unsigned*nml=(const __attribute__((address_space(3))) unsigned*)(shm+LDS_NMAX);
  #pragma unroll
  for(int c=0;c<2;++c){ const int bh=b*8+h; const __attribute__((address_space(3))) unsigned*qn=nml+((0*64+bh)*2+c)*2,*kn=nml+((1*64+bh)*2+c)*2;
    const float U=1.02f*(sqrtf(__uint_as_float(qn[0])*__uint_as_float(kn[0]))+sqrtf(__uint_as_float(qn[1])*__uint_as_float(kn[1])));
    const float d0=(2.f*U+24.f+log2f(1.f/(1.f-exp2f(-sl2))))/sl2; float st=ceilf((d0+255.f)*(1.f/64.f)); st=st<4.f?4.f:(st>64.f?64.f:st);
    cap[c]=__builtin_amdgcn_readfirstlane((((int)st)+1)&~1); Uv[c]=__uint_as_float(__builtin_amdgcn_readfirstlane(__float_as_uint(U))); }
  for(int c=0;c<2;++c) attn_sub<THRL>(b,(2*h+c)*64,h*128,qb,c,sl2,lam,c?cap[1]:cap[0],c?Uv[1]:Uv[0],oscale,subg,o1s,MIX+h*128,Q,K,V,shm,(unsigned*)nmax+900,c?popctr:nullptr,popslot);
}
__device__ __forceinline__ int wg_pop(unsigned*ctr,volatile __attribute__((address_space(3))) unsigned*slot){
  if(threadIdx.x==0)*slot=__hip_atomic_fetch_add(ctr,1u,__ATOMIC_RELAXED,__HIP_MEMORY_SCOPE_AGENT);
  __syncthreads(); const unsigned n=*slot; __syncthreads(); return (int)n;
}
template<int THRL=8> __device__ __forceinline__ void attn_phase(char*lds,int bx,unsigned*qctr,volatile __attribute__((address_space(3))) unsigned*slot,float lam,float oscale,const float*subg,const unsigned*nmax,unsigned*o1s,const bf16*Q,const bf16*K,const bf16*V,bf16*MIX){
  { int tid_=threadIdx.x; asm volatile("":"+v"(tid_)); ((__attribute__((address_space(3))) unsigned*)(lds+LDS_NMAX))[tid_]=nmax[tid_]; }
  for(int qi=0;qi<8;++qi){ const int x=(bx+qi)&7;
    int n=wg_pop(qctr+64*x,slot);
    for(;n<128;){
      const int qb=15-(n>>3),h=7-(n&7),b=(x+h)&7;
#if PROBE_ATT == 1
      const unsigned long long pa0_=__builtin_amdgcn_s_memrealtime();
#endif
      attn_unit4<THRL>(b,h,qb,lam,oscale,subg,nmax,o1s,Q,K,V,MIX,lds,qctr+64*x,slot);
#if PROBE_ATT == 1
      if(blockIdx.x==PROBE_BLK&&threadIdx.x==0)atomicAdd((unsigned*)nmax+900,(unsigned)(__builtin_amdgcn_s_memrealtime()-pa0_));
#endif
      n=(int)*slot; __syncthreads();
    } }
}
#undef SBAR
#undef WAIT_BAR
#undef MFMA32
}
#define GAS __attribute__((address_space(1)))
#define LAS __attribute__((address_space(3)))
typedef unsigned short bf16;
typedef unsigned v4u __attribute__((ext_vector_type(4)));
typedef float f32x4 __attribute__((ext_vector_type(4)));
typedef short bf16x8 __attribute__((ext_vector_type(8)));
typedef GAS unsigned gu32;
typedef GAS unsigned long long gu64;
#define RLX_AGENT __ATOMIC_RELAXED, __HIP_MEMORY_SCOPE_AGENT
#define LDS_WAIT() asm volatile("s_waitcnt lgkmcnt(0)" ::: "memory")
#define VM_WAIT() asm volatile("s_waitcnt vmcnt(0)" ::: "memory")
__device__ __forceinline__ unsigned long long rt() { return __builtin_amdgcn_s_memrealtime(); }
__device__ __forceinline__ unsigned f2bf(float f) { unsigned u = __builtin_bit_cast(unsigned, f); return (u + 0x7fffu + ((u >> 16) & 1u)) >> 16; }
__device__ __forceinline__ unsigned pk2(float lo, float hi) { return f2bf(lo) | (f2bf(hi) << 16); }

#define XB_TMO      128
#define XB_XCNT(j)  (256  + 64 * (j))
#define XB_XSUB(j)  (1280 + 64 * (j))
#define XB_XGEN(j)  (2304 + 64 * (j))
#define XB_TOP      3328
#define XB_TOPGEN   3392
#define XCD_BAR_WORDS 3456
#define XB_SPIN_CAP (1u << 18)

__device__ __forceinline__ unsigned xb_ld(unsigned* p)              { return __hip_atomic_load(p, __ATOMIC_RELAXED, __HIP_MEMORY_SCOPE_AGENT); }
__device__ __forceinline__ unsigned xb_add(unsigned* p, unsigned v) { return __hip_atomic_fetch_add(p, v, __ATOMIC_RELAXED, __HIP_MEMORY_SCOPE_AGENT); }
__device__ __forceinline__ unsigned xb_xcc_id() { return (unsigned)__builtin_amdgcn_s_getreg((3 << 11) | 20) & 0xFu; }
#define XB_SPIN(cond, bar) do { unsigned _sp = 0; while (cond) { __builtin_amdgcn_s_sleep(1); \
    if ((++_sp & 255u) == 0u) { if (xb_ld(&(bar)[XB_TMO])) break; if (_sp > XB_SPIN_CAP) { atomicAdd(&(bar)[XB_TMO], 1u); break; } } } } while (0)

struct XcdBarrier {
    unsigned* bar; unsigned x;
    volatile LAS unsigned* st;
};

__device__ __forceinline__ XcdBarrier xcd_barrier_post(unsigned* bar, volatile LAS unsigned* st) {
    XcdBarrier b; b.bar = bar; b.x = xb_xcc_id(); b.st = st;
    if (threadIdx.x == 0) (void)xb_add(&bar[XB_XCNT(b.x)], 1u);
    return b;
}
__device__ __forceinline__ void xcd_barrier_complete(unsigned* bar, unsigned x, unsigned& nloc, unsigned& nx) {
    const unsigned G = gridDim.x * gridDim.y * gridDim.z;
    unsigned sum, cnt, mine, sp = 0u;
    for (;;) {
        sum = 0u; cnt = 0u; mine = 0u;
#pragma unroll
        for (unsigned j = 0; j < 16; ++j) { const unsigned c = xb_ld(&bar[XB_XCNT(j)]); sum += c; cnt += (c > 0u) ? 1u : 0u; mine = (j == x) ? c : mine; }
        if (sum == G) break;
        __builtin_amdgcn_s_sleep(1);
        if ((++sp & 255u) == 0u) { if (xb_ld(&bar[XB_TMO])) break; if (sp > XB_SPIN_CAP) { atomicAdd(&bar[XB_TMO], 1u); break; } }
    }
    nloc = mine > 0u ? mine : 1u; nx = cnt > 0u ? cnt : 1u;
}

__device__ __forceinline__ void xcd_barrier(const XcdBarrier& b) {
    asm volatile("s_waitcnt vmcnt(0)" ::: "memory");
    __syncthreads();
    if (threadIdx.x == 0) {
        unsigned* bar = b.bar;
        __builtin_amdgcn_s_waitcnt(0);
        unsigned nloc = b.st[0], nx = b.st[1];
        if (nloc == 0u) { xcd_barrier_complete(bar, b.x, nloc, nx); b.st[0] = nloc; b.st[1] = nx; }
        const unsigned old = xb_add(&bar[XB_XSUB(b.x)], 1u);
        const unsigned gen = old / nloc;
        if (old + 1u == (gen + 1u) * nloc) {
            __builtin_amdgcn_fence(__ATOMIC_RELEASE, "agent");
            asm volatile("s_waitcnt vmcnt(0)" ::: "memory");
            const unsigned og = xb_add(&bar[XB_TOP], 1u);
            const unsigned tg = og / nx;
            if (og + 1u == (tg + 1u) * nx) xb_add(&bar[XB_TOPGEN], 1u);
            else XB_SPIN(xb_ld(&bar[XB_TOPGEN]) == tg, bar);
            __builtin_amdgcn_fence(__ATOMIC_ACQUIRE, "agent");
            xb_add(&bar[XB_XGEN(b.x)], 1u);
            asm volatile("s_waitcnt vmcnt(0)" ::: "memory");
        } else {
            XB_SPIN(xb_ld(&bar[XB_XGEN(b.x)]) == gen, bar);
            __builtin_amdgcn_fence(__ATOMIC_ACQUIRE, "agent");
            asm volatile("s_waitcnt vmcnt(0)" ::: "memory");
        }
    }
    __syncthreads();
}

constexpr int NWAVES = 8;
constexpr int BATCH = 8, SEQ = 4096, T = BATCH * SEQ, D = 2048, NIN = 5120, NEXP = 32, NA = 2 * T;
constexpr float EPS = 1e-6f, LOG2E = 1.4426950408889634f, C2 = 0.125f * 1.4426950408889634f;
constexpr size_t MiB = 1u << 20;
constexpr size_t WS_CTL = 0, CTL_ZERO_BYTES = 1 * MiB;
constexpr size_t WS_RSTD1 = 1 * MiB, WS_RSTD2 = WS_RSTD1 + 128 * 1024, WS_WTS = WS_RSTD2 + 128 * 1024;
constexpr size_t WS_LIST = 2 * MiB;
constexpr size_t WS_PART = 6 * MiB;
constexpr size_t WS_WIN = 10 * MiB, WS_WOUT = 30 * MiB;
constexpr size_t WS_WGU = 38 * MiB, WS_WD = 166 * MiB;
constexpr size_t WS_XB = 230 * MiB;
constexpr size_t WS_CG = 358 * MiB;
constexpr size_t WS_MIX = 422 * MiB;
constexpr size_t WS_HB = 550 * MiB;
constexpr size_t WS_HB8 = 678 * MiB;
constexpr size_t WS_WR = 742 * MiB;
constexpr size_t WS_X8 = 743 * MiB;
constexpr size_t WS_WIN8 = 807 * MiB;
constexpr size_t WS_O1S = 811 * MiB;
constexpr size_t WS_LISTW = 827 * MiB, WS_LISTR = 831 * MiB;
constexpr size_t WS_END = 835 * MiB;
constexpr float WSCALE = 32.f, H1SCALE = 4.f, YSCALE = 8.f;
constexpr int CW_TMO = 0, CW_CODE = 1, CW_BAR = 4096, CW_CNT = 8192;
constexpr int CW_GQ = 20480;
constexpr int CW_H8Q = 24576 + 1024;
constexpr int CW_CVQ = 24576, CW_DONE = 24576 + 64;
constexpr int CW_QA = 12288, CW_QC = 12288 + 512, CW_NMAX = 16384;
constexpr int RING_OFF = 0, RING_BYTES = 131072, LDSCTL_OFF = RING_BYTES, MISC_OFF = LDSCTL_OFF + 320, TAB_OFF = LDSCTL_OFF + 1024;
constexpr int LDS_BYTES = 147456;
constexpr int NPHASE = 8;
#ifndef MK_ONE_LAUNCH
#define MK_ONE_LAUNCH 1
#endif
#ifndef PROBE_DOUBLE
#define PROBE_DOUBLE 0
#endif
#ifndef PROBE_CLOCK
#define PROBE_CLOCK 0
#endif
#ifndef USE_NAIVE_ROUTER
#define USE_NAIVE_ROUTER 0
#endif
#ifndef USE_NAIVE_ATTN
#define USE_NAIVE_ATTN 0
#endif


typedef unsigned u32x4g __attribute__((ext_vector_type(4)));
__device__ __forceinline__ float wave_sum(float v) {
#pragma unroll
    for (int o = 1; o < 64; o <<= 1) v += __shfl_xor(v, o);
    return v;
}
__device__ __forceinline__ float bflo(unsigned w) { return __builtin_bit_cast(float, w << 16); }
__device__ __forceinline__ float bfhi(unsigned w) { return __builtin_bit_cast(float, w & 0xffff0000u); }
__device__ __forceinline__ float fexp2(float x) { return __builtin_amdgcn_exp2f(x); }

__device__ __forceinline__ void tr_item(const float* W, int N, const float* gk, int k0, int n0, bf16* dst, int dstK, LAS float* scr, int lane) {
    const int kr = lane >> 3, n4 = 4 * (lane & 7); f32x4 v[8];
#pragma unroll
    for (int i = 0; i < 8; ++i) v[i] = *(const GAS f32x4*)(W + (size_t)(k0 + 8 * i + kr) * N + n0 + n4);
#pragma unroll
    for (int i = 0; i < 8; ++i) { const int kk = 8 * i + kr; const float g = gk ? gk[k0 + kk] : 1.0f;
        scr[(n4 + 0) * 66 + kk] = v[i].x * g; scr[(n4 + 1) * 66 + kk] = v[i].y * g; scr[(n4 + 2) * 66 + kk] = v[i].z * g; scr[(n4 + 3) * 66 + kk] = v[i].w * g; }
    LDS_WAIT(); asm volatile("" ::: "memory");
    const int c = lane & 7;
#pragma unroll
    for (int j = 0; j < 4; ++j) { const int n = (lane >> 3) + 8 * j; const LAS float* s = scr + n * 66 + 8 * c;
        v4u o; o.x = pk2(s[0], s[1]); o.y = pk2(s[2], s[3]); o.z = pk2(s[4], s[5]); o.w = pk2(s[6], s[7]);
        *(GAS v4u*)(dst + (size_t)n * dstK + 8 * c) = o; }
    LDS_WAIT(); asm volatile("" ::: "memory");
}
__device__ __forceinline__ void tr8_load(const float* W, int N, int k0, int n0, int lane, f32x4 (&v)[8]) {
    const int kr = lane >> 3, n4 = 4 * (lane & 7);
#pragma unroll
    for (int i = 0; i < 8; ++i) v[i] = *(const GAS f32x4*)(W + (size_t)(k0 + 8 * i + kr) * N + n0 + n4);
}
__device__ __forceinline__ void tr8_finish(const f32x4 (&v)[8], const float* gk, float scale, int k0, unsigned char* dst, int dstK, LAS float* scr, int lane) {
    const int kr = lane >> 3, n4 = 4 * (lane & 7);
#pragma unroll
    for (int i = 0; i < 8; ++i) { const int kk = 8 * i + kr; const float g = (gk ? gk[k0 + kk] : 1.0f) * scale;
        scr[(n4 + 0) * 66 + kk] = v[i].x * g; scr[(n4 + 1) * 66 + kk] = v[i].y * g; scr[(n4 + 2) * 66 + kk] = v[i].z * g; scr[(n4 + 3) * 66 + kk] = v[i].w * g; }
    LDS_WAIT(); asm volatile("" ::: "memory");
    const int c = lane & 7;
#pragma unroll
    for (int j = 0; j < 4; ++j) { const int n = (lane >> 3) + 8 * j; const LAS float* s = scr + n * 66 + 8 * c;
        pg8::u32x2 o; o.x = pg8::pk4_fp8(s[0], s[1], s[2], s[3]); o.y = pg8::pk4_fp8(s[4], s[5], s[6], s[7]);
        *(GAS pg8::u32x2*)(dst + (size_t)n * dstK + 8 * c) = o; }
    LDS_WAIT(); asm volatile("" ::: "memory");
}
__device__ __forceinline__ void tr_item8(const float* W, int N, const float* gk, float scale, int k0, int n0, unsigned char* dst, int dstK, LAS float* scr, int lane) {
    f32x4 v[8]; tr8_load(W, N, k0, n0, lane, v); tr8_finish(v, gk, scale, k0, dst, dstK, scr, lane);
}
struct Ptrs {
    const float *x, *g1, *w_in, *lq1, *lk1, *lq2, *lk2, *subg, *cw, *cb, *lng, *lnb, *w_out, *g2, *wgr, *bgr, *wer, *ber, *w_gate, *w_up, *w_down, *gf;
    float* out; unsigned char* ws;
};
__device__ __forceinline__ void p0_prologue(const Ptrs& P, LAS unsigned char* lds, int lane, int wave, int gw, int NGW) {
    LAS float* scr = (LAS float*)(lds + RING_OFF + wave * 16384);
    bf16* WIN = (bf16*)(P.ws + WS_WIN); bf16* WOUT = (bf16*)(P.ws + WS_WOUT);
    constexpr int I_IN = 32 * 160, I_OUT = 32 * 64, NITEMS = I_IN + I_OUT;
    for (int it = gw; it < NITEMS; it += NGW) {
        if (it < I_IN) { const int kb = it / 160, nb = it % 160;
            if (nb < 96) tr_item(P.w_in, NIN, P.g1, 64 * kb, 32 * nb, WIN + (size_t)(32 * nb) * 2048 + 64 * kb, 2048, scr, lane);
            else { const int j0 = 32 * (nb - 96), jj = j0 & 1023, drow = 256 * (jj >> 7) + (jj & 127) + (j0 >= 1024 ? 128 : 0);
                tr_item8(P.w_in, NIN, P.g1, WSCALE, 64 * kb, 32 * nb, P.ws + WS_WIN8 + (size_t)drow * 2048 + 64 * kb, 2048, scr, lane); } }
        else { const int r = it - I_IN, kb = r >> 6, nb = r & 63; tr_item(P.w_out, 2048, nullptr, 64 * kb, 32 * nb, WOUT + (size_t)(32 * nb) * 2048 + 64 * kb, 2048, scr, lane); }
    }
    { bf16* WR = (bf16*)(P.ws + WS_WR);
      for (int it = gw; it < 32; it += NGW) tr_item(P.wer, 32, P.g2, 64 * it, 0, WR + 64 * it, 2048, scr, lane);
      for (int k = gw * 64 + lane; k < 2048; k += NGW * 64) { const float gk = P.g2[k]; const f32x4 w = *(const f32x4*)(P.wgr + (size_t)k * 4);
          WR[(size_t)128 * 2048 + k] = (bf16)f2bf(w.x * gk); WR[(size_t)129 * 2048 + k] = (bf16)f2bf(w.y * gk); WR[(size_t)130 * 2048 + k] = (bf16)f2bf(w.z * gk); WR[(size_t)131 * 2048 + k] = (bf16)f2bf(w.w * gk); } }
    bf16* XB = (bf16*)(P.ws + WS_XB); float* RS1 = (float*)(P.ws + WS_RSTD1);
    for (int m0 = gw; m0 < T; m0 += 2 * NGW) {
        f32x4 v[2][8]; float ss[2] = {0.f, 0.f};
#pragma unroll
        for (int q = 0; q < 2; ++q) { const int mr = (m0 + q * NGW < T) ? m0 + q * NGW : T - 1; const GAS f32x4* xr = (const GAS f32x4*)(P.x + (size_t)mr * D) + lane;
#pragma unroll
            for (int j = 0; j < 8; ++j) v[q][j] = xr[64 * j]; }
#pragma unroll
        for (int q = 0; q < 2; ++q) { const int m = m0 + q * NGW; if (m >= T) continue;
#pragma unroll
            for (int j = 0; j < 8; ++j) ss[q] += (v[q][j].x * v[q][j].x + v[q][j].y * v[q][j].y) + (v[q][j].z * v[q][j].z + v[q][j].w * v[q][j].w);
            ss[q] = wave_sum(ss[q]);
            if (lane == 0) RS1[m] = 1.0f / sqrtf(ss[q] * (1.0f / D) + EPS);
            GAS unsigned long long* o8 = (GAS unsigned long long*)(XB + (size_t)m * D) + lane; GAS unsigned* o4 = (GAS unsigned*)(P.ws + WS_X8 + (size_t)m * D) + lane;
#pragma unroll
            for (int j = 0; j < 8; ++j) { o8[64 * j] = (unsigned long long)pk2(v[q][j].x, v[q][j].y) | ((unsigned long long)pk2(v[q][j].z, v[q][j].w) << 32); o4[64 * j] = pg8::pk4_fp8(v[q][j].x, v[q][j].y, v[q][j].z, v[q][j].w); } }
    }
}

constexpr int CVT_ITEMS = 3 * 32768, CVT_CH = 4, CVT_CHUNK = CVT_CH * NWAVES, CVT_NCHUNK = CVT_ITEMS / CVT_CHUNK;
struct MoeItem { const float* src; const float* gk; unsigned char* dst; int N, k0, n0, dstK; };
__device__ __forceinline__ MoeItem moe_decode(const Ptrs& P, int r) {
    unsigned char* WGU = P.ws + WS_WGU; unsigned char* WD = P.ws + WS_WD; MoeItem m;
    const int mat = r >> 15, r2 = r & 32767, e = r2 >> 10, idx = r2 & 1023;
    if (mat < 2) { const int kb = idx >> 5, n0 = 32 * (idx & 31); const int drow = e * 2048 + 256 * (n0 >> 7) + (n0 & 127) + (mat == 1 ? 128 : 0);
        m.src = (mat == 0 ? P.w_gate : P.w_up) + (size_t)e * 2048 * 1024; m.N = 1024; m.gk = P.g2; m.k0 = 64 * kb; m.n0 = n0; m.dst = WGU + (size_t)drow * 2048 + 64 * kb; m.dstK = 2048; }
    else { const int kb = idx >> 6, nb = idx & 63; m.src = P.w_down + (size_t)e * 1024 * 2048; m.N = 2048; m.gk = nullptr; m.k0 = 64 * kb; m.n0 = 32 * nb; m.dst = WD + ((size_t)e * 2048 + 32 * nb) * 1024 + 64 * kb; m.dstK = 1024; }
    return m;
}
__device__ __forceinline__ void cvt_fill(const Ptrs& P, LAS unsigned char* lds, volatile LAS unsigned* slot, int max_chunks, const unsigned* donew, int G) {
    int tid_ = threadIdx.x; asm volatile("" : "+v"(tid_)); const int lane = tid_ & 63, wave = __builtin_amdgcn_readfirstlane(tid_ >> 6);
    LAS float* scr = (LAS float*)(lds + RING_OFF + wave * 16384); unsigned* ctr = (unsigned*)(P.ws + WS_CTL) + CW_CVQ;
    for (int n = 0; n < max_chunks; ++n) {
        if (threadIdx.x == 0) { unsigned v = 0xffffffffu;
            if (!(donew && (int)__hip_atomic_load(donew, __ATOMIC_RELAXED, __HIP_MEMORY_SCOPE_AGENT) >= G - 16)) v = __hip_atomic_fetch_add(ctr, 1u, __ATOMIC_RELAXED, __HIP_MEMORY_SCOPE_AGENT);
            *slot = v; }
        __syncthreads(); const unsigned c = *slot; __syncthreads();
        if (c >= (unsigned)CVT_NCHUNK) break;
#pragma unroll 1
        for (int j = 0; j < CVT_CH; j += 2) {
            const MoeItem m0 = moe_decode(P, (int)c * CVT_CHUNK + wave * CVT_CH + j), m1 = moe_decode(P, (int)c * CVT_CHUNK + wave * CVT_CH + j + 1);
            f32x4 v0[8], v1[8]; tr8_load(m0.src, m0.N, m0.k0, m0.n0, lane, v0); tr8_load(m1.src, m1.N, m1.k0, m1.n0, lane, v1);
            tr8_finish(v0, m0.gk, WSCALE, m0.k0, m0.dst, m0.dstK, scr, lane); tr8_finish(v1, m1.gk, WSCALE, m1.k0, m1.dst, m1.dstK, scr, lane); }
    }
}
__device__ __forceinline__ void h8_fill(const Ptrs& P, const bf16* HB, unsigned char* H8, volatile LAS unsigned* slot) {
    int tid_ = threadIdx.x; asm volatile("" : "+v"(tid_)); const int lane = tid_ & 63, wave = __builtin_amdgcn_readfirstlane(tid_ >> 6);
    unsigned* ctr = (unsigned*)(P.ws + WS_CTL) + CW_H8Q;
    for (;;) { const int c = attn_body::wg_pop(ctr, slot); if (c >= T / 64) break;
#pragma unroll 1
        for (int j = 0; j < 8; j += 4) { const int r0 = c * 64 + wave * 8 + j; u32x4g a[4][4];
#pragma unroll
            for (int q = 0; q < 4; ++q)
#pragma unroll
                for (int i = 0; i < 4; ++i) a[q][i] = *(const u32x4g*)(HB + (size_t)(r0 + q) * D + 16 * lane + 1024 * (i >> 1) + 8 * (i & 1));
#pragma unroll
            for (int q = 0; q < 4; ++q)
#pragma unroll
                for (int hj = 0; hj < 2; ++hj) { const u32x4g w0 = a[q][2 * hj], w1 = a[q][2 * hj + 1]; v4u o;
                    o.x = pg8::pk4_fp8(bflo(w0.x), bfhi(w0.x), bflo(w0.y), bfhi(w0.y)); o.y = pg8::pk4_fp8(bflo(w0.z), bfhi(w0.z), bflo(w0.w), bfhi(w0.w));
                    o.z = pg8::pk4_fp8(bflo(w1.x), bfhi(w1.x), bflo(w1.y), bfhi(w1.y)); o.w = pg8::pk4_fp8(bflo(w1.z), bfhi(w1.z), bflo(w1.w), bfhi(w1.w));
                    *(v4u*)(H8 + (size_t)(r0 + q) * D + 16 * lane + 1024 * hj) = o; } }
    }
}
__device__ __forceinline__ void router_skinny(const Ptrs& P, const bf16* HB, unsigned char* H8, LAS unsigned char* lds, int G) {
    int tid_ = threadIdx.x; asm volatile("" : "+v"(tid_)); const int tid = tid_, lane = tid & 63, wave = __builtin_amdgcn_readfirstlane(tid >> 6), fr = lane & 15, fq = lane >> 4;
    constexpr int BROW = 1040, BBUF = 48 * BROW;
    const bf16* WR = (const bf16*)(P.ws + WS_WR);
    LAS unsigned char* Bb = lds + RING_OFF; LAS float* LX = (LAS float*)(lds + RING_OFF + 2 * BBUF) + wave * (16 * 37);
    LAS unsigned* cntL = (LAS unsigned*)(lds + RING_OFF + 2 * BBUF + 8 * 16 * 37 * 4); LAS unsigned* baseL = cntL + 32;
    const float* part = (const float*)(P.ws + WS_PART); float* listr = (float*)(P.ws + WS_LISTR); float* listw = (float*)(P.ws + WS_LISTW); int* list = (int*)(P.ws + WS_LIST);
    unsigned* cnt = (unsigned*)(P.ws + WS_CTL) + CW_CNT;
    int brow[6], bcol[6];
#pragma unroll
    for (int i = 0; i < 6; ++i) { const int pc = tid + 512 * i; brow[i] = pc >> 6; bcol[i] = pc & 63; }
    for (int u = blockIdx.x; u < T / 128; u += G) {
        const int r0 = u * 128 + wave * 16;
        const bf16* arow = HB + (size_t)(r0 + fr) * D + 16 * fq;
        unsigned char* orow = H8 + (size_t)(r0 + fr) * D + 16 * fq;
        u32x4g bs[6], a[2][16]; pg8::f32x4 acc[3];
#pragma unroll
        for (int nb = 0; nb < 3; ++nb) acc[nb] = (pg8::f32x4){0.f, 0.f, 0.f, 0.f};
#define RS_LOADB(c) do { _Pragma("unroll") for (int i = 0; i < 6; ++i) { const int sr = brow[i] < 32 ? brow[i] : 128 + ((brow[i] - 32) & 3); \
            bs[i] = *(const u32x4g*)(WR + (size_t)sr * D + 512 * (c) + 8 * bcol[i]); } } while (0)
#define RS_STOREB(c) do { _Pragma("unroll") for (int i = 0; i < 6; ++i) *(LAS u32x4g*)(Bb + ((c) & 1) * BBUF + brow[i] * BROW + bcol[i] * 16) = bs[i]; } while (0)
#define RS_LOADA(c) do { _Pragma("unroll") for (int s = 0; s < 16; ++s) a[(c) & 1][s] = *(const u32x4g*)(arow + 512 * (c) + 64 * (s >> 1) + 8 * (s & 1)); } while (0)
        RS_LOADB(0); RS_LOADA(0); RS_STOREB(0);
#pragma unroll
        for (int c = 0; c < 4; ++c) {
            __syncthreads();
            if (c < 3) { RS_LOADB(c + 1); RS_LOADA(c + 1); }
#pragma unroll
            for (int s = 0; s < 16; ++s) {
                const pg8::bf16x8 af = __builtin_bit_cast(pg8::bf16x8, a[c & 1][s]);
#pragma unroll
                for (int nb = 0; nb < 3; ++nb) {
                    const pg8::bf16x8 bf = *(const LAS pg8::bf16x8*)(Bb + (c & 1) * BBUF + (16 * nb + fr) * BROW + (64 * (s >> 1) + 16 * fq + 8 * (s & 1)) * 2);
                    acc[nb] = __builtin_amdgcn_mfma_f32_16x16x32_bf16(af, bf, acc[nb], 0, 0, 0); }
            }
            if (c < 3) RS_STOREB(c + 1);
#pragma unroll
            for (int s = 0; s < 16; s += 2) { const u32x4g w0 = a[c & 1][s], w1 = a[c & 1][s + 1]; v4u o;
                o.x = pg8::pk4_fp8(bflo(w0.x), bfhi(w0.x), bflo(w0.y), bfhi(w0.y)); o.y = pg8::pk4_fp8(bflo(w0.z), bfhi(w0.z), bflo(w0.w), bfhi(w0.w));
                o.z = pg8::pk4_fp8(bflo(w1.x), bfhi(w1.x), bflo(w1.y), bfhi(w1.y)); o.w = pg8::pk4_fp8(bflo(w1.z), bfhi(w1.z), bflo(w1.w), bfhi(w1.w));
                *(v4u*)(orow + 512 * c + 64 * (s >> 1)) = o; }
        }
#undef RS_LOADB
#undef RS_STOREB
#undef RS_LOADA
#pragma unroll
        for (int nb = 0; nb < 3; ++nb)
#pragma unroll
            for (int r = 0; r < 4; ++r) if (nb < 2 || fr < 4) LX[(4 * fq + r) * 37 + 16 * nb + fr] = acc[nb][r];
        if (tid < 32) cntL[tid] = 0u;
        __syncthreads();
        int ea = 0, eb = 0, row = 0; unsigned ra = 0u, rb = 0u; float w1 = 0.f, w2 = 0.f, rstd = 0.f;
        if (lane < 16) { row = r0 + lane; const LAS float* lx = LX + lane * 37;
            float sq[4];
#pragma unroll
            for (int q = 0; q < 4; ++q) { const pg8::f32x4 p0 = *(const pg8::f32x4*)(part + (size_t)row * 32 + 8 * q), p1 = *(const pg8::f32x4*)(part + (size_t)row * 32 + 8 * q + 4);
                sq[q] = ((p0[0] + p0[1]) + (p0[2] + p0[3])) + ((p1[0] + p1[1]) + (p1[2] + p1[3])); }
            const float ss = (sq[0] + sq[1]) + (sq[2] + sq[3]);
            rstd = 1.0f / sqrtf(ss * (1.0f / 2048.0f) + 1e-6f);
            float g[4];
#pragma unroll
            for (int i = 0; i < 4; ++i) g[i] = lx[32 + i] * rstd + P.bgr[i];
            int gs = 0; float gm = g[0];
#pragma unroll
            for (int i = 1; i < 4; ++i) if (g[i] > gm) { gm = g[i]; gs = i; }
            float gsum = 0.f;
#pragma unroll
            for (int i = 0; i < 4; ++i) gsum += __expf(g[i] - gm);
            const float gw = 1.0f / gsum;
            float ev[8];
#pragma unroll
            for (int i = 0; i < 8; ++i) ev[i] = lx[8 * gs + i] * rstd + P.ber[8 * gs + i];
            int i1 = 0; float v1 = ev[0];
#pragma unroll
            for (int i = 1; i < 8; ++i) if (ev[i] > v1) { v1 = ev[i]; i1 = i; }
            int i2 = -1; float v2 = -3.0e38f;
#pragma unroll
            for (int i = 0; i < 8; ++i) if (i != i1 && ev[i] > v2) { v2 = ev[i]; i2 = i; }
            const float e2 = __expf(v2 - v1); w1 = gw / (1.f + e2); w2 = gw * e2 / (1.f + e2);
            ea = gs * 8 + i1; eb = gs * 8 + i2;
            ra = __hip_atomic_fetch_add(cntL + ea, 1u, __ATOMIC_RELAXED, __HIP_MEMORY_SCOPE_WORKGROUP);
            rb = __hip_atomic_fetch_add(cntL + eb, 1u, __ATOMIC_RELAXED, __HIP_MEMORY_SCOPE_WORKGROUP); }
        __syncthreads();
        if (tid < 32) { const unsigned n = cntL[tid]; baseL[tid] = n ? __hip_atomic_fetch_add(cnt + 64 * tid, n, __ATOMIC_RELAXED, __HIP_MEMORY_SCOPE_AGENT) : 0u; }
        __syncthreads();
        if (lane < 16) { const size_t ia = (size_t)ea * T + baseL[ea] + ra, ib = (size_t)eb * T + baseL[eb] + rb;
            list[ia] = 2 * row; list[ib] = 2 * row + 1; listw[ia] = w1; listw[ib] = w2; listr[ia] = rstd; listr[ib] = rstd; }
    }
    __syncthreads();
}
__device__ __forceinline__ void phase_tail(const Ptrs& P, LAS unsigned char* lds, volatile LAS unsigned* slot, int ph, int G) {
    unsigned* donew = (unsigned*)(P.ws + WS_CTL) + CW_DONE + 64 * ph;
    __syncthreads();
    if (threadIdx.x == 0) { const unsigned old = __hip_atomic_fetch_add(donew, 1u, __ATOMIC_RELAXED, __HIP_MEMORY_SCOPE_AGENT); *slot = (int)(old + 1u) >= G - 16 ? 1u : 0u; }
    __syncthreads(); const unsigned late = *slot; __syncthreads();
    if (late) return;
    cvt_fill(P, lds, slot, 1 << 30, donew, G);
}

__device__ __forceinline__ void naive_attn(const Ptrs& P, const bf16* Q, const bf16* Kb, const bf16* Vb, bf16* MIX, int lane, int gw, int NGW) {
    const float s1 = wave_sum(P.lq1[lane] * P.lk1[lane]), s2 = wave_sum(P.lq2[lane] * P.lk2[lane]);
    const float lam0 = 0.2f, lam = expf(s1) - expf(s2) + lam0;
    const int r16 = lane & 15, c = (lane >> 4) & 1, vh = lane >> 5;
    for (int u = gw; u < 16384; u += NGW) {
        const int bh = u & 63, qb = 255 - (u >> 6), b = bh >> 3, h = bh & 7, i = qb * 16 + r16, jmax = qb * 16 + 15;
        const float sl2 = exp2f(-(float)(h + 1)) * LOG2E; const size_t rowb = (size_t)b * SEQ;
        float q[64], O[64];
        { const u32x4g* qp = (const u32x4g*)(Q + (rowb + i) * 1024 + h * 128 + c * 64);
#pragma unroll
          for (int d8 = 0; d8 < 8; ++d8) { const u32x4g w = qp[d8]; q[8 * d8 + 0] = bflo(w.x); q[8 * d8 + 1] = bfhi(w.x); q[8 * d8 + 2] = bflo(w.y); q[8 * d8 + 3] = bfhi(w.y);
              q[8 * d8 + 4] = bflo(w.z); q[8 * d8 + 5] = bfhi(w.z); q[8 * d8 + 6] = bflo(w.w); q[8 * d8 + 7] = bfhi(w.w); } }
#pragma unroll
        for (int d = 0; d < 64; ++d) O[d] = 0.f;
        float m = -1e30f, l = 0.f;
        for (int j = 0; j <= jmax; ++j) {
            const u32x4g* kp = (const u32x4g*)(Kb + (rowb + j) * 1024 + h * 128 + c * 64); float s = 0.f;
#pragma unroll
            for (int d8 = 0; d8 < 8; ++d8) { const u32x4g w = kp[d8];
                s += q[8 * d8 + 0] * bflo(w.x) + q[8 * d8 + 1] * bfhi(w.x) + q[8 * d8 + 2] * bflo(w.y) + q[8 * d8 + 3] * bfhi(w.y)
                   + q[8 * d8 + 4] * bflo(w.z) + q[8 * d8 + 5] * bfhi(w.z) + q[8 * d8 + 6] * bflo(w.w) + q[8 * d8 + 7] * bfhi(w.w); }
            s += sl2 * (float)(j - i);
            if (j <= i) {
                if (s > m) { const float al = fexp2(m - s); l *= al;
#pragma unroll
                    for (int d = 0; d < 64; ++d) O[d] *= al;
                    m = s; }
                const float p = fexp2(s - m); l += p;
                const u32x4g* vp = (const u32x4g*)(Vb + (rowb + j) * 1024 + h * 128 + vh * 64);
#pragma unroll
                for (int d8 = 0; d8 < 8; ++d8) { const u32x4g w = vp[d8];
                    O[8 * d8 + 0] += p * bflo(w.x); O[8 * d8 + 1] += p * bfhi(w.x); O[8 * d8 + 2] += p * bflo(w.y); O[8 * d8 + 3] += p * bfhi(w.y);
                    O[8 * d8 + 4] += p * bflo(w.z); O[8 * d8 + 5] += p * bfhi(w.z); O[8 * d8 + 6] += p * bflo(w.w); O[8 * d8 + 7] += p * bfhi(w.w); }
            }
        }
        const float il = 1.0f / l; float ss = 0.f;
#pragma unroll
        for (int d = 0; d < 64; ++d) { float o = O[d] * il; const float o2 = __shfl_xor(o, 16); o = o - lam * o2; O[d] = o; ss += o * o; }
        ss += __shfl_xor(ss, 32);
        const float r = (1.0f / sqrtf(ss * (1.0f / 128.0f) + EPS)) * (1.0f - lam0);
        if (c == 0) { u32x4g* op = (u32x4g*)(MIX + (rowb + i) * 2048 + h * 128 + vh * 64); const float* sg = P.subg + vh * 64;
#pragma unroll
            for (int d8 = 0; d8 < 8; ++d8) { u32x4g w; w.x = pk2(O[8 * d8 + 0] * r * sg[8 * d8 + 0], O[8 * d8 + 1] * r * sg[8 * d8 + 1]); w.y = pk2(O[8 * d8 + 2] * r * sg[8 * d8 + 2], O[8 * d8 + 3] * r * sg[8 * d8 + 3]);
                w.z = pk2(O[8 * d8 + 4] * r * sg[8 * d8 + 4], O[8 * d8 + 5] * r * sg[8 * d8 + 5]); w.w = pk2(O[8 * d8 + 6] * r * sg[8 * d8 + 6], O[8 * d8 + 7] * r * sg[8 * d8 + 7]); op[d8] = w; } }
    }
}

typedef float f32x2c __attribute__((ext_vector_type(2)));
__device__ __forceinline__ void conv_phase(const Ptrs& P, const bf16* CA, bf16* MIX, LAS unsigned char* lds, int blk, unsigned* qctr, volatile LAS unsigned* slot) {
    int tid_ = threadIdx.x; asm volatile("" : "+v"(tid_)); const int tid = tid_, lane = tid & 63, wave = __builtin_amdgcn_readfirstlane(tid >> 6);
    LAS unsigned* C = (LAS unsigned*)(lds + RING_OFF);
    f32x2c w[31];
#pragma unroll
    for (int j = 0; j < 31; ++j) w[j] = *(const f32x2c*)(P.cw + j * 1024 + 2 * tid);
    const f32x2c bias = *(const f32x2c*)(P.cb + 2 * tid);
    for (int qi = 0; qi < 8; ++qi) { const int xq = (blk + qi) & 7;
    for (;;) { const int n_ = attn_body::wg_pop(qctr + 64 * xq, slot); if (n_ >= 64) break;
        const int tile = xq + 8 * n_, b = tile >> 6, t0 = (tile & 63) * 64; const size_t rowb = (size_t)b * SEQ;
        const unsigned* up = (const unsigned*)(CA + rowb * 1024 + 2 * tid);
        f32x2c win[38]; unsigned hist[30];
#pragma unroll
        for (int k = 0; k < 30; ++k) { const int t = t0 - 30 + k; hist[k] = (t >= 0) ? up[(size_t)t * 512] : 0u; }
        unsigned nw[8];
#pragma unroll
        for (int i = 0; i < 8; ++i) nw[i] = up[(size_t)(t0 + i) * 512];
#pragma unroll
        for (int k = 0; k < 30; ++k) win[k] = (f32x2c){bflo(hist[k]), bfhi(hist[k])};
#pragma unroll 1
        for (int blk8 = 0; blk8 < 8; ++blk8) {
#pragma unroll
            for (int i = 0; i < 8; ++i) win[30 + i] = (f32x2c){bflo(nw[i]), bfhi(nw[i])};
            if (blk8 < 7) {
#pragma unroll
                for (int i = 0; i < 8; ++i) nw[i] = up[(size_t)(t0 + 8 * (blk8 + 1) + i) * 512];
            }
#pragma unroll
            for (int i = 0; i < 8; ++i) { f32x2c acc = bias;
#pragma unroll
                for (int j = 0; j < 31; ++j) acc = w[j] * win[i + j] + acc;
                C[(8 * blk8 + i) * 512 + tid] = pk2(acc.x, acc.y); }
#pragma unroll
            for (int k = 0; k < 30; ++k) win[k] = win[k + 8];
        }
        __syncthreads();
#pragma unroll 1
        for (int k = 0; k < 8; ++k) { const int rr = wave + 8 * k, t = t0 + rr; const LAS unsigned* row = C + rr * 512;
            const v4u x0 = *(const LAS v4u*)(row + 4 * lane), x1 = *(const LAS v4u*)(row + 256 + 4 * lane);
            float v[16] = {bflo(x0.x), bfhi(x0.x), bflo(x0.y), bfhi(x0.y), bflo(x0.z), bfhi(x0.z), bflo(x0.w), bfhi(x0.w), bflo(x1.x), bfhi(x1.x), bflo(x1.y), bfhi(x1.y), bflo(x1.z), bfhi(x1.z), bflo(x1.w), bfhi(x1.w)};
            float s = 0.f;
#pragma unroll
            for (int i = 0; i < 16; ++i) s += v[i];
            const float mean = wave_sum(s) * (1.0f / 1024.0f); float qq = 0.f;
#pragma unroll
            for (int i = 0; i < 16; ++i) { v[i] -= mean; qq += v[i] * v[i]; }
            const float rstd = 1.0f / sqrtf(wave_sum(qq) * (1.0f / 1024.0f) + EPS);
            float y[16];
#pragma unroll
            for (int i = 0; i < 16; ++i) { const int ch = (i < 8 ? 8 * lane + i : 512 + 8 * lane + (i - 8)); const float z = v[i] * rstd * P.lng[ch] + P.lnb[ch]; y[i] = z / (1.f + __expf(-z)); }
            bf16* op = MIX + (rowb + t) * 2048 + 1024 + 8 * lane;
            v4u o0, o1; o0.x = pk2(y[0], y[1]); o0.y = pk2(y[2], y[3]); o0.z = pk2(y[4], y[5]); o0.w = pk2(y[6], y[7]); o1.x = pk2(y[8], y[9]); o1.y = pk2(y[10], y[11]); o1.z = pk2(y[12], y[13]); o1.w = pk2(y[14], y[15]);
            *(GAS v4u*)op = o0; *(GAS v4u*)(op + 512) = o1; }
        __syncthreads();
    } }
}

__device__ __forceinline__ void router_phase(const Ptrs& P, const bf16* HB, int lane, int gw, int NGW) {
    float* RS2 = (float*)(P.ws + WS_RSTD2); float* WTS = (float*)(P.ws + WS_WTS); int* LIST = (int*)(P.ws + WS_LIST); unsigned* CNT = (unsigned*)(P.ws + WS_CTL) + CW_CNT;
    for (int tok = gw; tok < T; tok += NGW) {
        float hv[32]; const bf16* hp = HB + (size_t)tok * D; float ss = 0.f;
#pragma unroll
        for (int j = 0; j < 4; ++j) { const u32x4g w = *(const u32x4g*)(hp + 8 * lane + 512 * j);
            hv[8 * j + 0] = bflo(w.x); hv[8 * j + 1] = bfhi(w.x); hv[8 * j + 2] = bflo(w.y); hv[8 * j + 3] = bfhi(w.y); hv[8 * j + 4] = bflo(w.z); hv[8 * j + 5] = bfhi(w.z); hv[8 * j + 6] = bflo(w.w); hv[8 * j + 7] = bfhi(w.w); }
#pragma unroll
        for (int k = 0; k < 32; ++k) ss += hv[k] * hv[k];
        ss = wave_sum(ss); const float rstd = 1.0f / sqrtf(ss * (1.0f / D) + EPS);
        float lg[36];
#pragma unroll
        for (int o = 0; o < 36; ++o) lg[o] = 0.f;
#pragma unroll
        for (int j = 0; j < 4; ++j)
#pragma unroll 2
            for (int i = 0; i < 8; ++i) { const int e = 8 * lane + 512 * j + i; const float xv = hv[8 * j + i] * P.g2[e];
                const f32x4* wr = (const f32x4*)(P.wer + (size_t)e * 32); const f32x4 wg = *(const f32x4*)(P.wgr + (size_t)e * 4);
#pragma unroll
                for (int o4 = 0; o4 < 8; ++o4) { const f32x4 w = wr[o4]; lg[4 * o4 + 0] += xv * w.x; lg[4 * o4 + 1] += xv * w.y; lg[4 * o4 + 2] += xv * w.z; lg[4 * o4 + 3] += xv * w.w; }
                lg[32] += xv * wg.x; lg[33] += xv * wg.y; lg[34] += xv * wg.z; lg[35] += xv * wg.w; }
#pragma unroll
        for (int o = 0; o < 36; ++o) lg[o] = wave_sum(lg[o]) * rstd + (o < 32 ? P.ber[o] : P.bgr[o - 32]);
        int gs = 0; float gm = lg[32];
#pragma unroll
        for (int g = 1; g < 4; ++g) if (lg[32 + g] > gm) { gm = lg[32 + g]; gs = g; }
        float gsum = 0.f;
#pragma unroll
        for (int g = 0; g < 4; ++g) gsum += __expf(lg[32 + g] - gm);
        const float gw_ = 1.0f / gsum;
        float ev[8];
#pragma unroll
        for (int i = 0; i < 8; ++i) ev[i] = gs == 0 ? lg[i] : gs == 1 ? lg[8 + i] : gs == 2 ? lg[16 + i] : lg[24 + i];
        int i1 = 0; float v1 = ev[0];
#pragma unroll
        for (int i = 1; i < 8; ++i) if (ev[i] > v1) { v1 = ev[i]; i1 = i; }
        int i2 = -1; float v2 = -3.0e38f;
#pragma unroll
        for (int i = 0; i < 8; ++i) if (i != i1 && ev[i] > v2) { v2 = ev[i]; i2 = i; }
        const float e2 = __expf(v2 - v1), w1 = gw_ / (1.f + e2), w2 = gw_ * e2 / (1.f + e2);
        if (lane == 0) {
            RS2[tok] = rstd;
            const int ea = gs * 8 + i1, eb = gs * 8 + i2;
            const unsigned ra = __hip_atomic_fetch_add(CNT + 64 * ea, 1u, __ATOMIC_RELAXED, __HIP_MEMORY_SCOPE_AGENT);
            const unsigned rb = __hip_atomic_fetch_add(CNT + 64 * eb, 1u, __ATOMIC_RELAXED, __HIP_MEMORY_SCOPE_AGENT);
            LIST[(size_t)ea * T + ra] = 2 * tok; LIST[(size_t)eb * T + rb] = 2 * tok + 1; WTS[2 * tok] = w1; WTS[2 * tok + 1] = w2;
        }
    }
}
__device__ __forceinline__ void moe_tables(const Ptrs& P, LAS unsigned char* lds) {
    int tid = threadIdx.x; asm volatile("" : "+v"(tid));
    LAS int* cntL = (LAS int*)(lds + TAB_OFF); LAS int* ts = cntL + 32; unsigned* CNT = (unsigned*)(P.ws + WS_CTL) + CW_CNT;
    if (tid < 32) cntL[tid] = (int)__hip_atomic_load(CNT + 64 * tid, __ATOMIC_RELAXED, __HIP_MEMORY_SCOPE_AGENT);
    __syncthreads();
    if (tid == 0) { int s = 0; for (int e = 0; e < 32; ++e) { ts[e] = s; s += (cntL[e] + 255) >> 8; } ts[32] = s; }
    __syncthreads();
}

__device__ __forceinline__ float fp8f(unsigned w, int i) { return i == 0 ? __builtin_amdgcn_cvt_f32_fp8(w, 0) : i == 1 ? __builtin_amdgcn_cvt_f32_fp8(w, 1) : i == 2 ? __builtin_amdgcn_cvt_f32_fp8(w, 2) : __builtin_amdgcn_cvt_f32_fp8(w, 3); }
__device__ __forceinline__ void final_phase(const Ptrs& P, const bf16* HB, const unsigned char* Y8, int NGW) {
    int tid_ = threadIdx.x; asm volatile("" : "+v"(tid_)); const int lane = tid_ & 63, gw = (int)blockIdx.x * NWAVES + __builtin_amdgcn_readfirstlane(tid_ >> 6);
    for (int tok = gw; tok < T; tok += NGW) {
        const bf16* hp = HB + (size_t)tok * D; const unsigned char* y1 = Y8 + (size_t)tok * 4096; const unsigned char* y2 = y1 + 2048; float v[32]; float ss = 0.f;
#pragma unroll
        for (int j = 0; j < 4; ++j) { const int o = 8 * lane + 512 * j; const u32x4g a = *(const u32x4g*)(hp + o); const pg8::u32x2 b = *(const pg8::u32x2*)(y1 + o), c = *(const pg8::u32x2*)(y2 + o);
            const float ys = 1.0f / YSCALE;
            v[8 * j + 0] = bflo(a.x) + (fp8f(b.x, 0) + fp8f(c.x, 0)) * ys; v[8 * j + 1] = bfhi(a.x) + (fp8f(b.x, 1) + fp8f(c.x, 1)) * ys; v[8 * j + 2] = bflo(a.y) + (fp8f(b.x, 2) + fp8f(c.x, 2)) * ys; v[8 * j + 3] = bfhi(a.y) + (fp8f(b.x, 3) + fp8f(c.x, 3)) * ys;
            v[8 * j + 4] = bflo(a.z) + (fp8f(b.y, 0) + fp8f(c.y, 0)) * ys; v[8 * j + 5] = bfhi(a.z) + (fp8f(b.y, 1) + fp8f(c.y, 1)) * ys; v[8 * j + 6] = bflo(a.w) + (fp8f(b.y, 2) + fp8f(c.y, 2)) * ys; v[8 * j + 7] = bfhi(a.w) + (fp8f(b.y, 3) + fp8f(c.y, 3)) * ys; }
#pragma unroll
        for (int k = 0; k < 32; ++k) ss += v[k] * v[k];
        ss = wave_sum(ss); const float rstd = 1.0f / sqrtf(ss * (1.0f / D) + EPS);
        float* op = P.out + (size_t)tok * D;
#pragma unroll
        for (int j = 0; j < 4; ++j) { const int o = 8 * lane + 512 * j; const f32x4 g0 = *(const f32x4*)(P.gf + o), g1 = *(const f32x4*)(P.gf + o + 4);
            f32x4 r0 = {v[8 * j + 0] * rstd * g0.x, v[8 * j + 1] * rstd * g0.y, v[8 * j + 2] * rstd * g0.z, v[8 * j + 3] * rstd * g0.w};
            f32x4 r1 = {v[8 * j + 4] * rstd * g1.x, v[8 * j + 5] * rstd * g1.y, v[8 * j + 6] * rstd * g1.z, v[8 * j + 7] * rstd * g1.w};
            *(f32x4*)(op + o) = r0; *(f32x4*)(op + o + 4) = r1; }
    }
}

struct Args { const float* in[22]; float* out; unsigned char* ws; int ph_lo, ph_hi; };
__global__ void __launch_bounds__(NWAVES * 64, 2) fwd(Args args) {
    extern __shared__ __attribute__((aligned(16))) unsigned char lds_raw[];
    LAS unsigned char* lds = (LAS unsigned char*)lds_raw;
    volatile LAS unsigned* MISC = (volatile LAS unsigned*)(lds + MISC_OFF);
    const int tid = threadIdx.x, lane = tid & 63, wave = __builtin_amdgcn_readfirstlane(tid >> 6), G = gridDim.x;
    const int gw = blockIdx.x * NWAVES + wave, NGW = G * NWAVES;
    Ptrs P;
    P.x = args.in[0]; P.g1 = args.in[1]; P.w_in = args.in[2]; P.lq1 = args.in[3]; P.lk1 = args.in[4]; P.lq2 = args.in[5]; P.lk2 = args.in[6]; P.subg = args.in[7];
    P.cw = args.in[8]; P.cb = args.in[9]; P.lng = args.in[10]; P.lnb = args.in[11]; P.w_out = args.in[12]; P.g2 = args.in[13]; P.wgr = args.in[14]; P.bgr = args.in[15];
    P.wer = args.in[16]; P.ber = args.in[17]; P.w_gate = args.in[18]; P.w_up = args.in[19]; P.w_down = args.in[20]; P.gf = args.in[21]; P.out = args.out; P.ws = args.ws;
    unsigned char* ws = args.ws;
#define WIN ((bf16*)(ws + WS_WIN))
#define WOUT ((bf16*)(ws + WS_WOUT))
#define WGU (ws + WS_WGU)
#define WD (ws + WS_WD)
#define XB ((bf16*)(ws + WS_XB))
#define H1 (ws + WS_XB)
#define HB8 (ws + WS_HB8)
#define CGB ((bf16*)(ws + WS_CG))
#define MIX ((bf16*)(ws + WS_MIX))
#define HB ((bf16*)(ws + WS_HB))
#define QB ((bf16*)P.out)
#define KB (QB + (size_t)T * 1024)
#define VB (QB + (size_t)T * 2048)
#define CAB (QB + (size_t)T * 3072)
#define YB ((bf16*)P.out)
#define RELOAD_ARGS() do { const __attribute__((address_space(4))) Args* ka_ = (const __attribute__((address_space(4))) Args*)__builtin_amdgcn_kernarg_segment_ptr(); asm volatile("" : "+s"(ka_)); \
    P.x = ka_->in[0]; P.g1 = ka_->in[1]; P.w_in = ka_->in[2]; P.lq1 = ka_->in[3]; P.lk1 = ka_->in[4]; P.lq2 = ka_->in[5]; P.lk2 = ka_->in[6]; P.subg = ka_->in[7]; \
    P.cw = ka_->in[8]; P.cb = ka_->in[9]; P.lng = ka_->in[10]; P.lnb = ka_->in[11]; P.w_out = ka_->in[12]; P.g2 = ka_->in[13]; P.wgr = ka_->in[14]; P.bgr = ka_->in[15]; \
    P.wer = ka_->in[16]; P.ber = ka_->in[17]; P.w_gate = ka_->in[18]; P.w_up = ka_->in[19]; P.w_down = ka_->in[20]; P.gf = ka_->in[21]; P.out = ka_->out; P.ws = ka_->ws; ws = ka_->ws; } while (0)
    for (int u = tid; u < (LDS_BYTES - LDSCTL_OFF) / 4; u += NWAVES * 64) ((LAS unsigned*)(lds + LDSCTL_OFF))[u] = 0u;
    __syncthreads();
    const int lo = args.ph_lo, hi = args.ph_hi;
    XcdBarrier bar; bar.bar = (unsigned*)(ws + WS_CTL) + CW_BAR; bar.x = 0; bar.st = nullptr;
    if (hi - lo > 1) bar = xcd_barrier_post((unsigned*)(ws + WS_CTL) + CW_BAR, MISC + 8);
#define IN(k) (lo <= (k) && (k) < hi)
#if PROBE_PHASE >= 0
    unsigned long long pst_[NPHASE + 1]; pst_[0] = __builtin_amdgcn_s_memrealtime();
#define SEAM(k) do { if (IN(k) && IN((k) + 1)) xcd_barrier(bar); pst_[(k) + 1] = __builtin_amdgcn_s_memrealtime(); } while (0)
#else
#define SEAM(k) do { if (IN(k) && IN((k) + 1)) xcd_barrier(bar); } while (0)
#endif
#define REP(k) for (int rep_ = 0; rep_ <= ((PROBE_DOUBLE >> (k)) & 1); ++rep_)

    if (IN(0)) REP(0) { p0_prologue(P, lds, lane, wave, gw, NGW); }
    SEAM(0);
#if PROBE_CLOCK
    const long long pc0 = clock64(), pr0 = wall_clock64();
#endif
    if (IN(1)) {
        cvt_fill(P, lds, MISC + 12, (int)((blockIdx.x >> 3) % 8), nullptr, G);
        for (int pass = 0; pass < 2; ++pass) {
            if ((pass ^ (int)(blockIdx.x & 1)) == 0) { pg8::Gemm g{XB, WIN, 1, 3072, D, (unsigned*)(ws + WS_CTL) + 3002}; pg8::DynDense S; S.init(T, 3072, (unsigned*)(ws + WS_CTL) + CW_GQ + 0 * 512, (volatile LAS int*)(MISC + 16), (int)blockIdx.x);
                pg8::EpiIn E{QB, (size_t)T * 1024, CGB, (const float*)(ws + WS_RSTD1), C2, (unsigned*)(ws + WS_CTL) + CW_NMAX, 0, 1.0f};
                pg8::gemm_phase<pg8::EpiIn, pg8::DynDense, true, false>(lds + RING_OFF, g, S, E); }
            else { pg8::Gemm g{(const bf16*)(ws + WS_X8), (const bf16*)(ws + WS_WIN8), 2, 2048, D / 2, (unsigned*)(ws + WS_CTL) + 3002}; pg8::DynDenseG S; S.init(T, 2048, (unsigned*)(ws + WS_CTL) + CW_GQ + 1 * 512, (volatile LAS int*)(MISC + 16), (int)blockIdx.x);
                pg8::EpiGLU E{CAB, (const float*)(ws + WS_RSTD1), 1.0f / WSCALE};
                pg8::gemm_phase<pg8::EpiGLU, pg8::DynDenseG, true, true, true>(lds + RING_OFF, g, S, E); }
        }
#if PROBE_ATT == 6
        if (threadIdx.x == 0) atomicMax((unsigned*)(ws + WS_CTL) + CW_NMAX + 900, (unsigned)(__builtin_amdgcn_s_memrealtime() - pst_[1]));
#endif
#if PROBE_ATT == 7
        if (threadIdx.x == 0) atomicAdd((unsigned*)(ws + WS_CTL) + CW_NMAX + 900, (unsigned)(__builtin_amdgcn_s_memrealtime() - pst_[1]) >> 8);
#endif
#if PROBE_ATT == 5
        if (blockIdx.x == PROBE_BLK && threadIdx.x == 0) atomicAdd((unsigned*)(ws + WS_CTL) + CW_NMAX + 900, (unsigned)(__builtin_amdgcn_s_memrealtime() - pst_[1]));
#endif
        phase_tail(P, lds, MISC + 12, 1, G);
    }
#if PROBE_CLOCK
    if (IN(1) && tid == 0) { const unsigned dt = (unsigned)(wall_clock64() - pr0); atomicAdd((unsigned*)(ws + WS_CTL) + 3000, dt); atomicMax((unsigned*)(ws + WS_CTL) + 3001, dt); }
#endif
    SEAM(1);
    if (IN(2)) {
#if USE_NAIVE_ATTN
        naive_attn(P, QB, KB, VB, MIX, lane, gw, NGW);
#else
        { float s1 = 0.f, s2 = 0.f;
          for (int i = 0; i < 64; ++i) { s1 += P.lq1[i] * P.lk1[i]; s2 += P.lq2[i] * P.lk2[i]; }
          const float lam0 = 0.2f, lam = expf(s1) - expf(s2) + lam0;
          static_assert(attn_body::ATTN_LDS_BYTES <= RING_BYTES, "attention LDS");
          attn_body::attn_phase<8>((char*)lds_raw + RING_OFF, (int)blockIdx.x, (unsigned*)(ws + WS_CTL) + CW_QA, MISC + 12, lam, 1.0f - lam0, P.subg, (const unsigned*)(ws + WS_CTL) + CW_NMAX, (unsigned*)(ws + WS_O1S) + (size_t)blockIdx.x * 16384,
                                   (const attn_body::bf16*)QB, (const attn_body::bf16*)KB, (const attn_body::bf16*)VB, (attn_body::bf16*)MIX); }
        RELOAD_ARGS();
#endif
        conv_phase(P, CAB, MIX, lds, (int)blockIdx.x, (unsigned*)(ws + WS_CTL) + CW_QC, MISC + 12);
#if PROBE_ATT == 2
        if (blockIdx.x == PROBE_BLK && threadIdx.x == 0) atomicAdd((unsigned*)(ws + WS_CTL) + CW_NMAX + 900, (unsigned)(__builtin_amdgcn_s_memrealtime() - pst_[2]));
#endif
        phase_tail(P, lds, MISC + 12, 2, G);
    }
    SEAM(2);
    if (IN(3)) {
        pg8::Gemm g{MIX, WOUT, 3, D, D, (unsigned*)(ws + WS_CTL) + 3002}; pg8::StaticOrder S; S.init(T, D, G, (int)blockIdx.x); S.rep = 1 + ((PROBE_DOUBLE >> 3) & 1);
        pg8::EpiOut E{HB, XB, (float*)(ws + WS_PART), nullptr};
        pg8::gemm_phase<pg8::EpiOut, pg8::StaticOrder, true, false>(lds + RING_OFF, g, S, E);
        phase_tail(P, lds, MISC + 12, 3, G);
    }
    SEAM(3);
#if PROBE_ATT == 9
    if (IN(4) && blockIdx.x == PROBE_BLK && threadIdx.x == 0) atomicAdd((unsigned*)(ws + WS_CTL) + CW_NMAX + 900, 10u * __hip_atomic_load((unsigned*)(ws + WS_CTL) + CW_CVQ, __ATOMIC_RELAXED, __HIP_MEMORY_SCOPE_AGENT));
#endif
#if USE_NAIVE_ROUTER
    if (IN(4)) { router_phase(P, HB, lane, gw, NGW); }
#else
    if (IN(4)) {
        router_skinny(P, HB, HB8, lds, G);
#if PROBE_ATT == 11
        if (threadIdx.x == 0) atomicMax((unsigned*)(ws + WS_CTL) + CW_NMAX + 900, (unsigned)(__builtin_amdgcn_s_memrealtime() - pst_[4]));
#endif
#if PROBE_ATT == 10
        if (blockIdx.x == PROBE_BLK && threadIdx.x == 0) atomicAdd((unsigned*)(ws + WS_CTL) + CW_NMAX + 900, (unsigned)(__builtin_amdgcn_s_memrealtime() - pst_[4]));
#endif
#if PROBE_ATT == 8
        if (blockIdx.x == PROBE_BLK && threadIdx.x == 0) atomicAdd((unsigned*)(ws + WS_CTL) + CW_NMAX + 900, 10u * __hip_atomic_load((unsigned*)(ws + WS_CTL) + CW_CVQ, __ATOMIC_RELAXED, __HIP_MEMORY_SCOPE_AGENT));
#endif
        cvt_fill(P, lds, MISC + 12, 1 << 30, nullptr, G);
    }
#endif
    SEAM(4);
    if (IN(5)) {
        moe_tables(P, lds);
        pg8::Gemm g{(const bf16*)HB8, (const bf16*)WGU, 5, 2048, D / 2, (unsigned*)(ws + WS_CTL) + 3002};
        pg8::MoeOrder S{(const LAS int*)(lds + TAB_OFF) + 32, (const LAS int*)(lds + TAB_OFF), (const int*)(ws + WS_LIST), G, (int)blockIdx.x, 1, T, (size_t)2048 * 2048, 0};
        pg8::EpiGU E{H1, (const int*)(ws + WS_LIST), (const float*)(ws + WS_LISTR), 1.0f / WSCALE, H1SCALE};
        pg8::gemm_phase<pg8::EpiGU, pg8::MoeOrder, true, true, true>(lds + RING_OFF, g, S, E);
    }
    SEAM(5);
    if (IN(6)) {
        if (!IN(5)) moe_tables(P, lds);
        pg8::Gemm g{(const bf16*)H1, (const bf16*)WD, 6, 2048, 512, (unsigned*)(ws + WS_CTL) + 3002};
        pg8::MoeOrder S{(const LAS int*)(lds + TAB_OFF) + 32, (const LAS int*)(lds + TAB_OFF), (const int*)(ws + WS_LIST), G, (int)blockIdx.x, 0, T, (size_t)2048 * 1024, 1};
        pg8::EpiDown E{ws + WS_MIX, (const int*)(ws + WS_LIST), (const float*)(ws + WS_LISTW), YSCALE / (WSCALE * H1SCALE)};
        pg8::gemm_phase<pg8::EpiDown, pg8::MoeOrder, true, true, true>(lds + RING_OFF, g, S, E);
    }
    SEAM(6);
    if (IN(7)) { final_phase(P, HB, ws + WS_MIX, NGW); }
#if PROBE_ATT
    if (blockIdx.x == 0) { const unsigned long long span = __hip_atomic_load((unsigned*)(ws + WS_CTL) + CW_NMAX + 900, __ATOMIC_RELAXED, __HIP_MEMORY_SCOPE_AGENT); const unsigned long long r1 = __builtin_amdgcn_s_memrealtime(); while (__builtin_amdgcn_s_memrealtime() - r1 < span) __builtin_amdgcn_s_sleep(8); }
#endif
#if PROBE_PHASE >= 0
    pst_[NPHASE] = __builtin_amdgcn_s_memrealtime();
    if (blockIdx.x == 0 && PROBE_PHASE < 100) { const unsigned long long span = pst_[(PROBE_PHASE < 100 ? PROBE_PHASE : 0) + 1] - pst_[PROBE_PHASE < 100 ? PROBE_PHASE : 0]; const unsigned long long r1 = __builtin_amdgcn_s_memrealtime(); while (__builtin_amdgcn_s_memrealtime() - r1 < span) __builtin_amdgcn_s_sleep(8); }
#endif
#if PROBE_KLOOP
    if (blockIdx.x == 0) { const long long pticks = (long long)__hip_atomic_load((unsigned*)(ws + WS_CTL) + 3002, __ATOMIC_RELAXED, __HIP_MEMORY_SCOPE_AGENT); const long long r1 = wall_clock64(); while (wall_clock64() - r1 < pticks) __builtin_amdgcn_s_sleep(8); }
#endif
#if PROBE_CLOCK
    if (blockIdx.x == 0) { const unsigned sum = __hip_atomic_load((unsigned*)(ws + WS_CTL) + 3000, __ATOMIC_RELAXED, __HIP_MEMORY_SCOPE_AGENT), mx = __hip_atomic_load((unsigned*)(ws + WS_CTL) + 3001, __ATOMIC_RELAXED, __HIP_MEMORY_SCOPE_AGENT);
        const long long pticks = (long long)mx - (long long)(sum / (unsigned)G); const long long r1 = wall_clock64(); while (wall_clock64() - r1 < pticks) __builtin_amdgcn_s_sleep(8); }
#endif
#undef IN
#undef SEAM
#undef REP
}

extern "C" void kernel_launch(void* const* d_in, const int* in_sizes, int n_in, void* d_out, int out_size, void* d_ws, size_t ws_size, hipStream_t stream) {
    static int grid = 0;
    if (grid == 0) {
        if (n_in != 22 || in_sizes[0] != T * D || out_size != T * D || ws_size < WS_END) { fprintf(stderr, "kernel_launch: unexpected shapes (n_in %d, in0 %d, out %d, ws %zu); nothing launched\n", n_in, n_in > 0 ? in_sizes[0] : -1, out_size, ws_size); grid = -1; return; }
        int dev = 0, cus = 0, per_cu = 0;
        if (hipGetDevice(&dev) != hipSuccess || hipDeviceGetAttribute(&cus, hipDeviceAttributeMultiprocessorCount, dev) != hipSuccess) { grid = -1; return; }
        if (hipFuncSetAttribute((const void*)fwd, hipFuncAttributeMaxDynamicSharedMemorySize, LDS_BYTES) != hipSuccess) { fprintf(stderr, "kernel_launch: hipFuncSetAttribute failed\n"); grid = -1; return; }
        if (hipOccupancyMaxActiveBlocksPerMultiprocessor(&per_cu, (const void*)fwd, NWAVES * 64, LDS_BYTES) != hipSuccess || per_cu < 1) fprintf(stderr, "kernel_launch: occupancy query reports %d\n", per_cu);
        (void)hipGetLastError();
        grid = cus;
    }
    if (grid < 0) return;
    if (hipMemsetAsync((char*)d_ws + WS_CTL, 0, CTL_ZERO_BYTES, stream) != hipSuccess) return;
    Args a{};
    for (int i = 0; i < 22; ++i) a.in[i] = (const float*)d_in[i];
    a.out = (float*)d_out; a.ws = (unsigned char*)d_ws;
#if MK_ONE_LAUNCH
    a.ph_lo = 0; a.ph_hi = NPHASE;
    hipLaunchKernelGGL(fwd, dim3(grid), dim3(NWAVES * 64), LDS_BYTES, stream, a);
#else
    for (int p = 0; p < NPHASE; ++p) { a.ph_lo = p; a.ph_hi = p + 1; hipLaunchKernelGGL(fwd, dim3(grid), dim3(NWAVES * 64), LDS_BYTES, stream, a); }
#endif
}
```

```cpp
#include <hip/hip_runtime.h>
#include <cstdio>
#include <cstdint>
#ifndef PROBE_KLOOP
#define PROBE_KLOOP 0
#endif
#ifndef PROBE_WHAT
#define PROBE_WHAT 0
#endif
#ifndef PROBE_PHASE
#define PROBE_PHASE -1
#endif
#ifndef PROBE_ATT
#define PROBE_ATT 0
#endif
#ifndef PROBE_BLK
#define PROBE_BLK 0
#endif
namespace pg8 {
#define PG8_LAS __attribute__((address_space(3)))
typedef unsigned short bf16_t;
typedef short bf16x8 __attribute__((ext_vector_type(8)));
typedef float f32x4 __attribute__((ext_vector_type(4)));
typedef unsigned u32x4 __attribute__((ext_vector_type(4)));
constexpr int BM = 256, BK = 64, HALF = 128, HTB = HALF * BK * 2  , STAGE_BYTES = 8 * HTB, NXCD = 8, WGM = 8;

__host__ __device__ __forceinline__ int lds_byte(int r, int c) { const int st = (r >> 4) * 2 + (c >> 5), rr = r & 15, cc = c & 31, ob = rr * 64 + cc * 2; return st * 1024 + (ob ^ (((ob >> 9) & 1) << 5)); }
__host__ __device__ __forceinline__ void stage_rc(int b, int& R, int& C) { const int st = b / 1024, sb = b % 1024, swz = sb ^ (((sb >> 9) & 1) << 5); R = (st >> 1) * 16 + swz / 64; C = (st & 1) * 32 + (swz % 64) / 2; }
__host__ __device__ __forceinline__ int perm32(int rho) { const int n = rho >> 4, i = rho & 15; return 8 * (i >> 2) + 4 * n + (i & 3); }

struct Unit { int pm, pn, e, nvalid, lbase, srow; };
struct Gemm { const bf16_t* A; const bf16_t* Bt; int M, N, K; unsigned* probe = nullptr; };

struct StaticOrder {
    int nM, nN, nwg, G, c, rep = 1;
    __host__ __device__ void init(int M, int N, int G_, int c_) { nM = M / BM; nN = N / BM; nwg = nM * nN; G = G_; c = c_; }
    __host__ __device__ bool next(int i, Unit& u) const {
        long L = (long)i * G + c; if (L >= (long)nwg * rep) return false; L %= nwg;
        int wgid = (int)L; { const int q = nwg / NXCD, r = nwg % NXCD, xcd = wgid % NXCD, off = wgid / NXCD; wgid = (xcd < r ? xcd * (q + 1) : r * (q + 1) + (xcd - r) * q) + off; }
        const int nig = WGM * nN, gid = wgid / nig, fm = gid * WGM, gsz = (nM - fm) < WGM ? (nM - fm) : WGM;
        u.pm = fm + ((wgid % nig) % gsz); u.pn = (wgid % nig) / gsz; return true;
    }
    __device__ __forceinline__ const char* bbase(const Gemm& g, const Unit& u, size_t tstep) const { return (const char*)g.Bt + (size_t)u.pn * tstep; }
    __device__ __forceinline__ unsigned goff(const Unit&, int, int, int) const { return 0u; }
    __device__ __forceinline__ void a_ready(const Unit&) const {}
    __device__ __forceinline__ void done(const Unit&) const {}
};

struct StaticOrderG : StaticOrder {
    __device__ __forceinline__ unsigned goff(const Unit& u, int r, int C, int K) const { return ((unsigned)(u.pm * BM + r) * (unsigned)K + (unsigned)C) * 2u; }
};

struct MoeOrder {
    const PG8_LAS int* tstart; const PG8_LAS int* cnt; const int* list; int G, c, shift, lcap; size_t estride; int sorted;
    __device__ __forceinline__ bool next(int i, Unit& u) const {
        const int ntiles = tstart[32]; const int x = c & 7, k = i * (G >> 3) + (c >> 3); const int rt = 2 * (k >> 1) + (x & 1); if (rt >= ntiles) return false;
        int e = 0;
#pragma unroll
        for (int q = 1; q < 32; ++q) e += (tstart[q] <= rt) ? 1 : 0;
        e = __builtin_amdgcn_readfirstlane(e);
        const int pm = __builtin_amdgcn_readfirstlane(rt - tstart[e]); const int rem = __builtin_amdgcn_readfirstlane(cnt[e]) - 256 * pm;
        u.pm = pm; u.pn = 2 * (x >> 1) + (k & 1); u.e = e; u.nvalid = rem < 256 ? rem : 256; u.lbase = e * lcap + 256 * pm; u.srow = 256 * rt; return true;
    }
    __device__ __forceinline__ const char* bbase(const Gemm& g, const Unit& u, size_t tstep) const { return (const char*)g.Bt + (size_t)u.e * estride + (size_t)u.pn * tstep; }
    __device__ __forceinline__ unsigned goff(const Unit& u, int r, int C, int K) const {
        if (sorted) return ((unsigned)(u.srow + r) * (unsigned)K + (unsigned)C) * 2u;
        const int a = list[u.lbase + (r < u.nvalid ? r : 0)];
        return ((unsigned)(a >> shift) * (unsigned)K + (unsigned)C) * 2u;
    }
    __device__ __forceinline__ void a_ready(const Unit&) const {}
    __device__ __forceinline__ void done(const Unit&) const {}
};

struct DynQ {
    unsigned* ctr; volatile PG8_LAS int* slot; int x0, qi; unsigned pend;
    __device__ __forceinline__ void qinit(unsigned* ctr_, volatile PG8_LAS int* slot_, int bx) { ctr = ctr_; slot = slot_; x0 = bx & 7; qi = 0; pend = 0u;
        if (threadIdx.x == 0) pend = __hip_atomic_fetch_add(ctr + 64 * x0, 1u, __ATOMIC_RELAXED, __HIP_MEMORY_SCOPE_AGENT); }
    template <class SizeF> __device__ __forceinline__ int qnext(int i, const SizeF& size_of) {
        const int par = i & 1;
        if (threadIdx.x == 0) { int res = -1;
            while (qi < 8) { const int x = (x0 + qi) & 7; if (pend < (unsigned)size_of(x)) { res = (x << 24) | (int)pend; break; }
                ++qi; if (qi < 8) pend = __hip_atomic_fetch_add(ctr + 64 * ((x0 + qi) & 7), 1u, __ATOMIC_RELAXED, __HIP_MEMORY_SCOPE_AGENT); }
            slot[par] = res;
            if (res >= 0) pend = __hip_atomic_fetch_add(ctr + 64 * ((x0 + qi) & 7), 1u, __ATOMIC_RELAXED, __HIP_MEMORY_SCOPE_AGENT); }
        asm volatile("s_waitcnt lgkmcnt(0)" ::: "memory"); __builtin_amdgcn_s_barrier(); asm volatile("" ::: "memory");
        return __builtin_amdgcn_readfirstlane(slot[par]);
    }
};
struct DynDense : DynQ {
    int nM, nN, nwg;
    __device__ __forceinline__ void init(int M, int N, unsigned* ctr_, volatile PG8_LAS int* slot_, int bx) { nM = M / BM; nN = N / BM; nwg = nM * nN; qinit(ctr_, slot_, bx); }
    __device__ __forceinline__ bool next(int i, Unit& u) {
        const int q = nwg / NXCD, r = nwg % NXCD;
        const int code = qnext(i, [=](int x) { return q + (x < r ? 1 : 0); }); if (code < 0) return false;
        const int x = code >> 24, k = code & 0xffffff; const int wgid = (x < r ? x * (q + 1) : r * (q + 1) + (x - r) * q) + k;
        const int nig = WGM * nN, gid = wgid / nig, fm = gid * WGM, gsz = (nM - fm) < WGM ? (nM - fm) : WGM;
        u.pm = fm + ((wgid % nig) % gsz); u.pn = (wgid % nig) / gsz; return true;
    }
    __device__ __forceinline__ const char* bbase(const Gemm& g, const Unit& u, size_t tstep) const { return (const char*)g.Bt + (size_t)u.pn * tstep; }
    __device__ __forceinline__ unsigned goff(const Unit&, int, int, int) const { return 0u; }
    __device__ __forceinline__ void a_ready(const Unit&) const {}
    __device__ __forceinline__ void done(const Unit&) const {}
};
struct DynDenseG : DynDense {
    __device__ __forceinline__ unsigned goff(const Unit& u, int r, int C, int K) const { return ((unsigned)(u.pm * BM + r) * (unsigned)K + (unsigned)C) * 2u; }
};

__device__ __forceinline__ unsigned cvt_pk_bf16(float lo, float hi) { unsigned r; asm volatile("v_cvt_pk_bf16_f32 %0, %1, %2" : "=v"(r) : "v"(lo), "v"(hi)); return r; }
__device__ __forceinline__ float bf_lo(unsigned w) { return __builtin_bit_cast(float, w << 16); }
__device__ __forceinline__ float bf_hi(unsigned w) { return __builtin_bit_cast(float, w & 0xffff0000u); }
__device__ __forceinline__ unsigned pk4_fp8(float a, float b, float c, float d) {
    a = __builtin_amdgcn_fmed3f(a, -440.f, 440.f); b = __builtin_amdgcn_fmed3f(b, -440.f, 440.f); c = __builtin_amdgcn_fmed3f(c, -440.f, 440.f); d = __builtin_amdgcn_fmed3f(d, -440.f, 440.f);
    int r = __builtin_amdgcn_cvt_pk_fp8_f32(a, b, 0, false); r = __builtin_amdgcn_cvt_pk_fp8_f32(c, d, r, true); return (unsigned)r; }
typedef unsigned u32x2 __attribute__((ext_vector_type(2)));
__device__ __forceinline__ void swap16(u32x2& a, u32x2& b) { auto r0 = __builtin_amdgcn_permlane16_swap(a.x, b.x, false, false); auto r1 = __builtin_amdgcn_permlane16_swap(a.y, b.y, false, false); a = (u32x2){r0[0], r1[0]}; b = (u32x2){r0[1], r1[1]}; }
typedef int v4i_t __attribute__((ext_vector_type(4)));

__device__ __forceinline__ float rows4_sum(float v) {
    { unsigned a = __builtin_bit_cast(unsigned, v), b = a; asm volatile("" : "+v"(b)); auto r = __builtin_amdgcn_permlane16_swap(a, b, false, false); unsigned r0 = r[0], r1 = r[1]; asm volatile("" : "+v"(r0), "+v"(r1)); v = __builtin_bit_cast(float, r0) + __builtin_bit_cast(float, r1); }
    { unsigned a = __builtin_bit_cast(unsigned, v), b = a; asm volatile("" : "+v"(b)); auto r = __builtin_amdgcn_permlane32_swap(a, b, false, false); unsigned r0 = r[0], r1 = r[1]; asm volatile("" : "+v"(r0), "+v"(r1)); v = __builtin_bit_cast(float, r0) + __builtin_bit_cast(float, r1); }
    return v; }
struct EpiIn {
    static constexpr bool PERM = true, AFTER_DRAIN = false;
    bf16_t* P0; size_t stride; bf16_t* CG; const float* rstd; float scale0; unsigned* nmax; int tbase; float oscale;
    __device__ __forceinline__ void operator()(const f32x4 (&acc)[2][2][4][2], const Unit& u, int wr, int wc, int fr, int fq) const {
        const int row0 = u.pm * BM + wr * 64 + fr, t = (u.pn >> 2) + tbase; bf16_t* base = (t < 4) ? P0 + (size_t)t * stride : CG;
        const float sc = ((t == 0) ? scale0 : 1.f) * oscale; const int col0 = (u.pn & 3) * BM + wc * 32 + 8 * fq;
        float mx[2] = {0.f, 0.f}; float rsv[2][4];
#pragma unroll
        for (int ai = 0; ai < 2; ++ai)
#pragma unroll
            for (int m = 0; m < 4; ++m) rsv[ai][m] = rstd[row0 + ai * HALF + m * 16];
#pragma unroll
        for (int ai = 0; ai < 2; ++ai)
#pragma unroll
            for (int m = 0; m < 4; ++m) { const int row = row0 + ai * HALF + m * 16; const float rs = rsv[ai][m] * sc; bf16_t* rowp = base + (size_t)row * 1024 + col0;
#pragma unroll
                for (int bj = 0; bj < 2; ++bj) { const f32x4 v0 = acc[ai][bj][m][0] * rs, v1 = acc[ai][bj][m][1] * rs;
                    u32x4 w; w.x = cvt_pk_bf16(v0[0], v0[1]); w.y = cvt_pk_bf16(v0[2], v0[3]); w.z = cvt_pk_bf16(v1[0], v1[1]); w.w = cvt_pk_bf16(v1[2], v1[3]);
                    *(u32x4*)(rowp + bj * HALF) = w;
                    if (t < 2) { float ss = (v0[0] * v0[0] + v0[1] * v0[1]) + (v0[2] * v0[2] + v0[3] * v0[3]) + (v1[0] * v1[0] + v1[1] * v1[1]) + (v1[2] * v1[2] + v1[3] * v1[3]);
                        ss = rows4_sum(ss); mx[bj] = __builtin_fmaxf(mx[bj], ss); } } }
        if (t < 2) {
#pragma unroll
            for (int bj = 0; bj < 2; ++bj) { float v = mx[bj];
                v = __builtin_fmaxf(v, __shfl_xor(v, 1)); v = __builtin_fmaxf(v, __shfl_xor(v, 2)); v = __builtin_fmaxf(v, __shfl_xor(v, 4)); v = __builtin_fmaxf(v, __shfl_xor(v, 8));
                const int colb = (u.pn & 3) * BM + bj * HALF + wc * 32, g64 = colb >> 6, bh = (u.pm >> 4) * 8 + (g64 >> 1);
                if (fr == 0 && fq == 0) atomicMax(nmax + ((t * 64 + bh) * 2 + (g64 & 1)) * 2 + (wc & 1), __builtin_bit_cast(unsigned, v)); }
        }
    }
};
struct EpiGLU {
    static constexpr bool PERM = true, AFTER_DRAIN = false;
    bf16_t* U; const float* rstd; float oscale;
    __device__ __forceinline__ void operator()(const f32x4 (&acc)[2][2][4][2], const Unit& u, int wr, int wc, int fr, int fq) const {
        const int row0 = u.pm * BM + wr * 64 + fr, col0 = u.pn * HALF + wc * 32 + 8 * fq; float rsv[2][4];
#pragma unroll
        for (int ai = 0; ai < 2; ++ai)
#pragma unroll
            for (int m = 0; m < 4; ++m) rsv[ai][m] = rstd[row0 + ai * HALF + m * 16];
#pragma unroll
        for (int ai = 0; ai < 2; ++ai)
#pragma unroll
            for (int m = 0; m < 4; ++m) { const int row = row0 + ai * HALF + m * 16; const float rs = rsv[ai][m] * oscale;
                const f32x4 a0 = acc[ai][0][m][0] * rs, a1 = acc[ai][0][m][1] * rs, g0 = acc[ai][1][m][0] * rs, g1 = acc[ai][1][m][1] * rs;
#define PG8_SG(x) __builtin_amdgcn_rcpf(1.f + __builtin_amdgcn_exp2f(-1.4426950408889634f * (x)))
                u32x4 w; w.x = cvt_pk_bf16(a0[0] * PG8_SG(g0[0]), a0[1] * PG8_SG(g0[1])); w.y = cvt_pk_bf16(a0[2] * PG8_SG(g0[2]), a0[3] * PG8_SG(g0[3]));
                w.z = cvt_pk_bf16(a1[0] * PG8_SG(g1[0]), a1[1] * PG8_SG(g1[1])); w.w = cvt_pk_bf16(a1[2] * PG8_SG(g1[2]), a1[3] * PG8_SG(g1[3]));
#undef PG8_SG
                *(u32x4*)(U + (size_t)row * 1024 + col0) = w; }
    }
};
struct EpiOut {
    static constexpr bool PERM = true, AFTER_DRAIN = false;
    bf16_t* H; const bf16_t* XB; float* part; unsigned char* H8;
    __device__ __forceinline__ void operator()(const f32x4 (&acc)[2][2][4][2], const Unit& u, int wr, int wc, int fr, int fq) const {
        const int row0 = u.pm * BM + wr * 64 + fr, col0 = u.pn * BM + wc * 32 + 8 * fq;
#pragma unroll
        for (int ai = 0; ai < 2; ++ai) { u32x4 xbv[4][2];
#pragma unroll
            for (int m = 0; m < 4; ++m)
#pragma unroll
                for (int bj = 0; bj < 2; ++bj) xbv[m][bj] = __builtin_nontemporal_load((const u32x4*)(XB + (size_t)(row0 + ai * HALF + m * 16) * 2048 + col0 + bj * HALF));
#pragma unroll
            for (int m = 0; m < 4; ++m) { const int row = row0 + ai * HALF + m * 16; const size_t off = (size_t)row * 2048 + col0; float ss = 0.f;
#pragma unroll
                for (int bj = 0; bj < 2; ++bj) { const u32x4 xb = xbv[m][bj];
                    f32x4 v0 = acc[ai][bj][m][0], v1 = acc[ai][bj][m][1];
                    v0[0] += bf_lo(xb.x); v0[1] += bf_hi(xb.x); v0[2] += bf_lo(xb.y); v0[3] += bf_hi(xb.y); v1[0] += bf_lo(xb.z); v1[1] += bf_hi(xb.z); v1[2] += bf_lo(xb.w); v1[3] += bf_hi(xb.w);
                    ss += (v0[0] * v0[0] + v0[1] * v0[1]) + (v0[2] * v0[2] + v0[3] * v0[3]) + (v1[0] * v1[0] + v1[1] * v1[1]) + (v1[2] * v1[2] + v1[3] * v1[3]);
                    u32x4 w; w.x = cvt_pk_bf16(v0[0], v0[1]); w.y = cvt_pk_bf16(v0[2], v0[3]); w.z = cvt_pk_bf16(v1[0], v1[1]); w.w = cvt_pk_bf16(v1[2], v1[3]);
                    *(u32x4*)(H + off + bj * HALF) = w;
                    if (H8) { u32x2 w8; w8.x = pk4_fp8(v0[0], v0[1], v0[2], v0[3]); w8.y = pk4_fp8(v1[0], v1[1], v1[2], v1[3]); *(u32x2*)(H8 + off + bj * HALF) = w8; } }
                ss = rows4_sum(ss);
                if (fq == 0) part[(size_t)row * 32 + u.pn * 4 + wc] = ss; } }
    }
};
__device__ __forceinline__ float silu_f(float x) { return x * __builtin_amdgcn_rcpf(1.f + __builtin_amdgcn_exp2f(-1.4426950408889634f * x)); }
struct EpiGU {
    static constexpr bool PERM = true, AFTER_DRAIN = false;
    unsigned char* H1; const int* list; const float* listr; float wscale, oscale;
    __device__ __forceinline__ void operator()(const f32x4 (&acc)[2][2][4][2], const Unit& u, int wr, int wc, int fr, int fq) const {
        const int col0 = u.pn * HALF + wc * 32 + 8 * fq;
        float rsv[2][4];
#pragma unroll
        for (int ai = 0; ai < 2; ++ai)
#pragma unroll
            for (int m = 0; m < 4; ++m) { const int r = ai * HALF + wr * 64 + m * 16 + fr; rsv[ai][m] = listr[u.lbase + (r < u.nvalid ? r : 0)]; }
#pragma unroll
        for (int ai = 0; ai < 2; ++ai)
#pragma unroll
            for (int mp = 0; mp < 4; mp += 2) { u32x2 wv[2];
#pragma unroll
                for (int q = 0; q < 2; ++q) { const int m = mp + q; const float rs = rsv[ai][m] * wscale;
                    const f32x4 g0 = acc[ai][0][m][0] * rs, g1 = acc[ai][0][m][1] * rs, u0 = acc[ai][1][m][0] * (rs * oscale), u1 = acc[ai][1][m][1] * (rs * oscale);
                    wv[q].x = pk4_fp8(silu_f(g0[0]) * u0[0], silu_f(g0[1]) * u0[1], silu_f(g0[2]) * u0[2], silu_f(g0[3]) * u0[3]);
                    wv[q].y = pk4_fp8(silu_f(g1[0]) * u1[0], silu_f(g1[1]) * u1[1], silu_f(g1[2]) * u1[2], silu_f(g1[3]) * u1[3]); }
                swap16(wv[0], wv[1]);
                const int odd = fq & 1, r = ai * HALF + wr * 64 + (mp + odd) * 16 + fr;
                if (r < u.nvalid) { const u32x4 w = {wv[0].x, wv[0].y, wv[1].x, wv[1].y};
                    *(u32x4*)(H1 + (size_t)(u.srow + r) * 1024 + col0 - 8 * odd) = w; } }
    }
};
struct EpiDown {
    static constexpr bool PERM = true, AFTER_DRAIN = false;
    unsigned char* Y; const int* list; const float* listw; float oscale;
    __device__ __forceinline__ void operator()(const f32x4 (&acc)[2][2][4][2], const Unit& u, int wr, int wc, int fr, int fq) const {
        const int col0 = u.pn * BM + wc * 32 + 8 * fq;
        int av[2][4]; float wv[2][4];
#pragma unroll
        for (int ai = 0; ai < 2; ++ai)
#pragma unroll
            for (int m = 0; m < 4; ++m) { const int r = ai * HALF + wr * 64 + m * 16 + fr, ix = u.lbase + (r < u.nvalid ? r : 0); av[ai][m] = list[ix]; wv[ai][m] = listw[ix]; }
#pragma unroll
        for (int ai = 0; ai < 2; ++ai)
#pragma unroll
            for (int m = 0; m < 4; ++m) { const int r = ai * HALF + wr * 64 + m * 16 + fr; const int a = av[ai][m]; const float ws = wv[ai][m] * oscale;
                u32x2 w0, w1;
                { const f32x4 v0 = acc[ai][0][m][0] * ws, v1 = acc[ai][0][m][1] * ws; w0.x = pk4_fp8(v0[0], v0[1], v0[2], v0[3]); w0.y = pk4_fp8(v1[0], v1[1], v1[2], v1[3]); }
                { const f32x4 v0 = acc[ai][1][m][0] * ws, v1 = acc[ai][1][m][1] * ws; w1.x = pk4_fp8(v0[0], v0[1], v0[2], v0[3]); w1.y = pk4_fp8(v1[0], v1[1], v1[2], v1[3]); }
                swap16(w0, w1);
                if (r < u.nvalid) { const int odd = fq & 1; const u32x4 w = {w0.x, w0.y, w1.x, w1.y};
                    *(u32x4*)(Y + (size_t)a * 2048 + col0 + (odd ? HALF - 8 : 0)) = w; } }
    }
};
struct EpiRouter {
    static constexpr bool PERM = true, AFTER_DRAIN = false;
    const float* part; const float* ber; const float* bgr; float* listr; float* listw; int* list; unsigned* cnt; int lcap;
    __device__ __forceinline__ void operator()(const f32x4 (&acc)[2][2][4][2], const Unit& u, int wr, int wc, int fr, int fq) const {
        if (wc != 0) return;
#pragma unroll
        for (int ai = 0; ai < 2; ++ai)
#pragma unroll
            for (int m = 0; m < 4; ++m) { const int row = u.pm * BM + ai * HALF + wr * 64 + m * 16 + fr;
                const f32x4 p0 = *(const f32x4*)(part + (size_t)row * 32 + 8 * fq), p1 = *(const f32x4*)(part + (size_t)row * 32 + 8 * fq + 4);
                float ss = ((p0[0] + p0[1]) + (p0[2] + p0[3])) + ((p1[0] + p1[1]) + (p1[2] + p1[3]));
                ss += __shfl_xor(ss, 16); ss += __shfl_xor(ss, 32);
                const float rstd = 1.0f / sqrtf(ss * (1.0f / 2048.0f) + 1e-6f);
                const f32x4 gl = acc[ai][1][m][0]; float g[4];
#pragma unroll
                for (int i = 0; i < 4; ++i) g[i] = __shfl(gl[i], fr) * rstd + bgr[i];
                int gs = 0; float gm = g[0];
#pragma unroll
                for (int i = 1; i < 4; ++i) if (g[i] > gm) { gm = g[i]; gs = i; }
                float gsum = 0.f;
#pragma unroll
                for (int i = 0; i < 4; ++i) gsum += __expf(g[i] - gm);
                const float gw = 1.0f / gsum;
                if (fq == gs) { float ev[8];
#pragma unroll
                    for (int i = 0; i < 4; ++i) { ev[i] = acc[ai][0][m][0][i] * rstd + ber[8 * fq + i]; ev[4 + i] = acc[ai][0][m][1][i] * rstd + ber[8 * fq + 4 + i]; }
                    int i1 = 0; float v1 = ev[0];
#pragma unroll
                    for (int i = 1; i < 8; ++i) if (ev[i] > v1) { v1 = ev[i]; i1 = i; }
                    int i2 = -1; float v2 = -3.0e38f;
#pragma unroll
                    for (int i = 0; i < 8; ++i) if (i != i1 && ev[i] > v2) { v2 = ev[i]; i2 = i; }
                    const float e2 = __expf(v2 - v1), w1 = gw / (1.f + e2), w2 = gw * e2 / (1.f + e2);
                    const int ea = gs * 8 + i1, eb = gs * 8 + i2;
                    const unsigned ra = __hip_atomic_fetch_add(cnt + 64 * ea, 1u, __ATOMIC_RELAXED, __HIP_MEMORY_SCOPE_AGENT);
                    const unsigned rb = __hip_atomic_fetch_add(cnt + 64 * eb, 1u, __ATOMIC_RELAXED, __HIP_MEMORY_SCOPE_AGENT);
                    const size_t ia = (size_t)ea * lcap + ra, ib = (size_t)eb * lcap + rb;
                    list[ia] = 2 * row; list[ib] = 2 * row + 1; listw[ia] = w1; listw[ib] = w2; listr[ia] = rstd; listr[ib] = rstd; } }
    }
};

template <class Epi, class Sched, bool ALIGN_EPI, bool GATHER, bool FP8 = false>
__device__ __forceinline__ void gemm_phase(PG8_LAS unsigned char* lds, const Gemm g, Sched& S, const Epi& E) {
    int tid_ = threadIdx.x; asm volatile("" : "+v"(tid_));
    const int tid = tid_, wid = __builtin_amdgcn_readfirstlane(tid >> 6), lane = tid & 63, wr = wid >> 2, wc = wid & 3, fr = lane & 15, fq = lane >> 4;
    const int K = g.K, nt = K / BK;
    unsigned voffA[2], voffB[2]; int RA[2], CA[2];
#pragma unroll
    for (int i = 0; i < 2; ++i) { int R, C; stage_rc(tid * 16 + i * 8192, R, C); const int Rb = Epi::PERM ? ((R & ~31) + perm32(R & 31)) : R;
        voffA[i] = (unsigned)(R * K + C) * 2u; voffB[i] = (unsigned)(Rb * K + C) * 2u; RA[i] = R; CA[i] = C; }
    const size_t kstep = (size_t)(BK * 2);
    const size_t hstep = (size_t)HALF * K * 2;
    const size_t tstep = 2 * hstep;
    const unsigned ldsw = (unsigned)wid * 1024u;
    const int aoff = lds_byte(wr * 64 + fr, fq * 8), boff = lds_byte(wc * 32 + fr, fq * 8);
#define PG8_SA(b, h) (((b) * 2 + (h)) * HTB)
#define PG8_SB(b, h) ((4 + (b) * 2 + (h)) * HTB)
#define PG8_STAGE(bufoff, gbase, voff) do { _Pragma("unroll") for (int _i = 0; _i < 2; ++_i) \
        __builtin_amdgcn_global_load_lds((const unsigned*)((const char*)(gbase) + (voff)[_i]), (PG8_LAS unsigned*)(lds + (bufoff) + ldsw + _i * 8192), 16, 0, 0); } while (0)
#define PG8_STAGE_A(bufoff, kp, h) do { if constexpr (GATHER) { PG8_STAGE(bufoff, kp, cgo[h]); } else { PG8_STAGE(bufoff, (kp) + (h) * hstep, voffA); } } while (0)
#define PG8_LDA(dst, b, h) do { _Pragma("unroll") for (int m = 0; m < 4; ++m) _Pragma("unroll") for (int k = 0; k < 2; ++k) dst[m][k] = *(const PG8_LAS bf16x8*)(lds + PG8_SA(b, h) + aoff + m * 2048 + k * 1024); } while (0)
#define PG8_LDB(dst, b, h) do { _Pragma("unroll") for (int n = 0; n < 2; ++n) _Pragma("unroll") for (int k = 0; k < 2; ++k) dst[n][k] = *(const PG8_LAS bf16x8*)(lds + PG8_SB(b, h) + boff + n * 2048 + k * 1024); } while (0)
#define PG8_CAT(x, y) __builtin_shufflevector(__builtin_bit_cast(v4i_t, x), __builtin_bit_cast(v4i_t, y), 0, 1, 2, 3, 4, 5, 6, 7)
#define PG8_MMA(ai, bj, At, Bt) do { __builtin_amdgcn_s_setprio(1); \
        if constexpr (FP8) { _Pragma("unroll") for (int m = 0; m < 4; ++m) _Pragma("unroll") for (int n = 0; n < 2; ++n) \
            acc[ai][bj][m][n] = __builtin_amdgcn_mfma_scale_f32_16x16x128_f8f6f4(PG8_CAT(Bt[n][0], Bt[n][1]), PG8_CAT(At[m][0], At[m][1]), acc[ai][bj][m][n], 0, 0, 0, 0, 0, 0); } \
        else { _Pragma("unroll") for (int m = 0; m < 4; ++m) _Pragma("unroll") for (int n = 0; n < 2; ++n) _Pragma("unroll") for (int k = 0; k < 2; ++k) \
            acc[ai][bj][m][n] = __builtin_amdgcn_mfma_f32_16x16x32_bf16(Bt[n][k], At[m][k], acc[ai][bj][m][n], 0, 0, 0); } \
        __builtin_amdgcn_s_setprio(0); } while (0)
#define PG8_WAIT_V(n) asm volatile("s_waitcnt vmcnt(" #n ")" ::: "memory")
#define PG8_WAIT_L(n) asm volatile("s_waitcnt lgkmcnt(" #n ")" ::: "memory")
#define PG8_BAR __builtin_amdgcn_s_barrier()
#define PG8_SCHED __builtin_amdgcn_sched_barrier(0)
    Unit cur, nxt; int ui = 0;
#if PROBE_KLOOP
    unsigned pk_acc_ = 0u;
#endif
    if (!S.next(0, cur)) return;
    f32x4 acc[2][2][4][2];
#pragma unroll
    for (int a = 0; a < 2; ++a)
#pragma unroll
        for (int b = 0; b < 2; ++b)
#pragma unroll
            for (int m = 0; m < 4; ++m)
#pragma unroll
                for (int n = 0; n < 2; ++n) acc[a][b][m][n] = (f32x4){0.f, 0.f, 0.f, 0.f};
    bf16x8 At[4][2], B0[2][2], B1[2][2];
    unsigned cgo[2][2] = {{0u, 0u}, {0u, 0u}}, ngo[2][2] = {{0u, 0u}, {0u, 0u}};
    if constexpr (GATHER) {
#pragma unroll
        for (int h = 0; h < 2; ++h)
#pragma unroll
            for (int i = 0; i < 2; ++i) cgo[h][i] = S.goff(cur, h * HALF + RA[i], CA[i], K);
    }
    const char* cA = GATHER ? (const char*)g.A : (const char*)g.A + (size_t)cur.pm * tstep; const char* cB = S.bbase(g, cur, tstep);
    S.a_ready(cur);
    PG8_STAGE(PG8_SB(0, 0), cB, voffB); PG8_STAGE(PG8_SB(0, 1), cB + hstep, voffB); PG8_STAGE_A(PG8_SA(0, 0), cA, 0); PG8_STAGE_A(PG8_SA(0, 1), cA, 1);
    if (wr == 1) PG8_BAR;
    PG8_WAIT_V(2); PG8_BAR;
    PG8_STAGE(PG8_SB(1, 0), cB + kstep, voffB); PG8_STAGE_A(PG8_SA(1, 0), cA + kstep, 0); PG8_STAGE(PG8_SB(1, 1), cB + hstep + kstep, voffB);
    PG8_WAIT_V(6); PG8_BAR;
    for (;;) {
        const bool has_next = S.next(ui + 1, nxt);
        if constexpr (GATHER) {
            if (has_next) {
#pragma unroll
                for (int h = 0; h < 2; ++h)
#pragma unroll
                    for (int i = 0; i < 2; ++i) ngo[h][i] = S.goff(nxt, h * HALF + RA[i], CA[i], K);
            } else {
#pragma unroll
                for (int h = 0; h < 2; ++h)
#pragma unroll
                    for (int i = 0; i < 2; ++i) ngo[h][i] = cgo[h][i];
            }
        }
        const char* nA = GATHER ? (const char*)g.A : (has_next ? (const char*)g.A + (size_t)nxt.pm * tstep : cA); const char* nB = has_next ? S.bbase(g, nxt, tstep) : cB;
#if PROBE_KLOOP
        const unsigned long long pk0_ = __builtin_amdgcn_s_memrealtime();
#endif
        for (int t = 0; t < nt; t += 2) {
            const bool last = (t == nt - 2);
            const char* a1 = cA + (size_t)(t + 1) * kstep;
            const char* a2 = last ? nA : cA + (size_t)(t + 2) * kstep; const char* b2 = last ? nB : cB + (size_t)(t + 2) * kstep;
            const char* a3 = a2 + kstep; const char* b3 = b2 + kstep;
            if (last && has_next) S.a_ready(nxt);
            PG8_LDB(B0, 0, 0); PG8_LDB(B1, 0, 1); PG8_SCHED; PG8_LDA(At, 0, 0); PG8_STAGE_A(PG8_SA(1, 1), a1, 1);
            if constexpr (GATHER) { if (last) {
#pragma unroll
                for (int h = 0; h < 2; ++h)
#pragma unroll
                    for (int i = 0; i < 2; ++i) cgo[h][i] = ngo[h][i]; } }
            PG8_WAIT_V(8); PG8_WAIT_L(0); PG8_BAR; PG8_MMA(0, 0, At, B0); PG8_MMA(0, 1, At, B1); PG8_BAR; PG8_SCHED;
            PG8_LDA(At, 0, 1); PG8_STAGE(PG8_SB(0, 0), b2, voffB); PG8_STAGE(PG8_SB(0, 1), b2 + hstep, voffB); PG8_STAGE_A(PG8_SA(0, 0), a2, 0);
            PG8_WAIT_V(8); PG8_WAIT_L(0); PG8_BAR; PG8_MMA(1, 0, At, B0); PG8_MMA(1, 1, At, B1); PG8_BAR; PG8_SCHED;
            PG8_LDB(B0, 1, 0); PG8_LDB(B1, 1, 1); PG8_SCHED; PG8_LDA(At, 1, 0); PG8_STAGE_A(PG8_SA(0, 1), a2, 1);
            PG8_WAIT_V(8); PG8_WAIT_L(0); PG8_BAR; PG8_MMA(0, 0, At, B0); PG8_MMA(0, 1, At, B1); PG8_BAR; PG8_SCHED;
            PG8_LDA(At, 1, 1); PG8_STAGE(PG8_SB(1, 0), b3, voffB); PG8_STAGE(PG8_SB(1, 1), b3 + hstep, voffB); PG8_STAGE_A(PG8_SA(1, 0), a3, 0);
            PG8_WAIT_V(8); PG8_WAIT_L(0); PG8_BAR; PG8_MMA(1, 0, At, B0); PG8_MMA(1, 1, At, B1); PG8_BAR; PG8_SCHED;
        }
#if PROBE_KLOOP
        const unsigned long long pk1_ = __builtin_amdgcn_s_memrealtime(); if (PROBE_WHAT == 0) pk_acc_ += (unsigned)(pk1_ - pk0_);
#endif
        if constexpr (ALIGN_EPI) { if (wr == 0) PG8_BAR; }
#if PROBE_KLOOP
        const unsigned long long pk2_ = __builtin_amdgcn_s_memrealtime(); if (PROBE_WHAT == 1) pk_acc_ += (unsigned)(pk2_ - pk1_);
#endif
        E(acc, cur, wr, wc, fr, fq); S.done(cur);
#if PROBE_KLOOP
        asm volatile("s_waitcnt vmcnt(0)" ::: "memory"); if (PROBE_WHAT == 2) pk_acc_ += (unsigned)(__builtin_amdgcn_s_memrealtime() - pk2_);
#endif
        if (!has_next) break;
#pragma unroll
        for (int a = 0; a < 2; ++a)
#pragma unroll
            for (int b = 0; b < 2; ++b)
#pragma unroll
                for (int m = 0; m < 4; ++m)
#pragma unroll
                    for (int n = 0; n < 2; ++n) acc[a][b][m][n] = (f32x4){0.f, 0.f, 0.f, 0.f};
        cur = nxt; cA = nA; cB = nB; ++ui;
        if constexpr (ALIGN_EPI) { if (wr == 1) PG8_BAR; }
    }
#if PROBE_KLOOP
    if (blockIdx.x == PROBE_BLK && tid == 0 && g.M == PROBE_KLOOP) atomicAdd(g.probe, pk_acc_);
#endif
    PG8_WAIT_V(0);
    if constexpr (!ALIGN_EPI) { if (wr == 0) PG8_BAR; }
    PG8_BAR;
#undef PG8_SA
#undef PG8_SB
#undef PG8_STAGE
#undef PG8_STAGE_A
#undef PG8_LDA
#undef PG8_LDB
#undef PG8_MMA
#undef PG8_CAT
#undef PG8_WAIT_V
#undef PG8_WAIT_L
#undef PG8_BAR
#undef PG8_SCHED
}
}
#include <hip/hip_bf16.h>
#include <cmath>
namespace attn_body {
using bf16=__hip_bfloat16;
using bf16x8=__attribute__((ext_vector_type(8)))short;
using s16x4=__attribute__((ext_vector_type(4)))short;
using f32x16=__attribute__((ext_vector_type(16)))float;
using u32x4=__attribute__((ext_vector_type(4)))unsigned;
constexpr int BATCH=8,SEQ=4096,D=64,DM=1024;
constexpr int NW=8,QBLK=32,QB=QBLK*NW,KVBLK=64,NQB=SEQ/QB;
__device__ __forceinline__ int crow(int r,int hi){return (r&3)+8*(r>>2)+4*hi;}
#define SBAR() __builtin_amdgcn_sched_barrier(0)
__device__ __forceinline__ void cmask(f32x16&p0,f32x16&p1,int jb,int qrel,int hi){
  const float NEG=-INFINITY; const int lim=qrel-64*jb-4*hi;
  #pragma unroll
  for(int r=0;r<16;++r){const int cr=(r&3)+8*(r>>2); if(cr>lim)p0[r]=NEG; if(cr+32>lim)p1[r]=NEG;}
}

constexpr int NSLOT=3, SLOTB=8192;
constexpr int LDS_K=0, LDS_V=NSLOT*SLOTB, LDS_WS=3*NSLOT*SLOTB, LDS_OST=LDS_WS+NW*64*4, LDS_NMAX=LDS_OST+NW*4096, LDS_BYTES=LDS_NMAX+2048;
__device__ __forceinline__ void glds16(const void*sbase,unsigned voff,unsigned lds_dst){unsigned keep;
  asm volatile("s_mov_b32 %0, m0\n\ts_mov_b32 m0, %3\n\ts_nop 0\n\tglobal_load_lds_dwordx4 %1, %2\n\ts_mov_b32 m0, %0":"=&s"(keep):"v"(voff),"s"(sbase),"s"(lds_dst):"memory");}
__device__ __forceinline__ float max3f(float a,float b,float c){float r;asm("v_max3_f32 %0, %1, %2, %3":"=v"(r):"v"(a),"v"(b),"v"(c));return r;}
__device__ __forceinline__ float max2f(float a,float b){float r;asm("v_max_f32_e32 %0, %1, %2":"=v"(r):"v"(a),"v"(b));return r;}
__device__ __forceinline__ float fsub_s(float a,float b){float r;asm("v_sub_f32_e32 %0, %1, %2":"=v"(r):"v"(a),"v"(b));return r;}
typedef float f32x2_t __attribute__((ext_vector_type(2))); typedef __bf16 bf16x2_t __attribute__((ext_vector_type(2)));
__device__ __forceinline__ unsigned cvtpk_s(float lo,float hi){f32x2_t v={lo,hi};bf16x2_t b=__builtin_convertvector(v,bf16x2_t);return __builtin_bit_cast(unsigned,b);}
#define WAIT_BAR(N) asm volatile("s_waitcnt vmcnt(" #N ") lgkmcnt(0)\n\ts_barrier":::"memory")
#define MFMA32(a,b,c) __builtin_amdgcn_mfma_f32_32x32x16_bf16(a,b,c,0,0,0)

__device__ __forceinline__ void qkt(f32x16&p0,f32x16&p1,const char*Kslot,const bf16x8*qr,int r32,int hi){
  const char*kb=Kslot+hi*1024+r32*16;
  #pragma unroll
  for(int d0=0;d0<4;++d0){
    const bf16x8 b0=*reinterpret_cast<const bf16x8*>(kb+d0*2048);
    const bf16x8 b1=*reinterpret_cast<const bf16x8*>(kb+d0*2048+512);
    p0=MFMA32(b0,qr[d0],p0);p1=MFMA32(b1,qr[d0],p1);}
}
typedef __attribute__((address_space(3))) const char* lds_cptr;
typedef short v4i16_t __attribute__((ext_vector_type(4)));
__device__ __forceinline__ void kload8(bf16x8*kf,lds_cptr kp){
  kf[0]=*(const __attribute__((address_space(3))) bf16x8*)(kp);      kf[1]=*(const __attribute__((address_space(3))) bf16x8*)(kp+512);
  kf[2]=*(const __attribute__((address_space(3))) bf16x8*)(kp+2048); kf[3]=*(const __attribute__((address_space(3))) bf16x8*)(kp+2560);
  kf[4]=*(const __attribute__((address_space(3))) bf16x8*)(kp+4096); kf[5]=*(const __attribute__((address_space(3))) bf16x8*)(kp+4608);
  kf[6]=*(const __attribute__((address_space(3))) bf16x8*)(kp+6144); kf[7]=*(const __attribute__((address_space(3))) bf16x8*)(kp+6656);
}
__device__ __forceinline__ void kload2(bf16x8*kf,lds_cptr kp,int j){ kf[2*j]=*(const __attribute__((address_space(3))) bf16x8*)(kp+j*2048); kf[2*j+1]=*(const __attribute__((address_space(3))) bf16x8*)(kp+j*2048+512); }
__device__ __forceinline__ s16x4 vtr(lds_cptr p){ return __builtin_bit_cast(s16x4,__builtin_amdgcn_ds_read_tr16_b64_v4i16((__attribute__((address_space(3))) v4i16_t*)p)); }
__device__ __forceinline__ float rowmax(const f32x16&p0,const f32x16&p1){
  float a=max3f(p0[0],p0[1],p1[0]),b=max3f(p0[2],p0[3],p1[1]);a=max3f(a,p1[2],p1[3]);
  #pragma unroll
  for(int r=4;r<16;r+=4){a=max3f(a,p0[r],p0[r+1]);b=max3f(b,p0[r+2],p0[r+3]);a=max3f(a,p1[r],p1[r+1]);b=max3f(b,p1[r+2],p1[r+3]);}
  const float m=max2f(a,b);
  auto rr=__builtin_amdgcn_permlane32_swap(__float_as_uint(m),__float_as_uint(m),false,false);
  return max2f(__uint_as_float(rr[0]),__uint_as_float(rr[1]));
}
__device__ __forceinline__ void pv(f32x16*o,int vb,bf16x8 pa0,bf16x8 pa1,bf16x8 pa2,bf16x8 pa3){
  #pragma unroll
  for(int d0=0;d0<4;++d0){s16x4 lo[4],hi[4];
    #pragma unroll
    for(int ks=0;ks<4;++ks){
      asm volatile("ds_read_b64_tr_b16 %0,%1 offset:%c2":"=&v"(lo[ks]):"v"(vb),"i"(d0*4096+ks*1024):"memory");
      asm volatile("ds_read_b64_tr_b16 %0,%1 offset:%c2":"=&v"(hi[ks]):"v"(vb),"i"(d0*4096+ks*1024+512):"memory");}
    asm volatile("s_waitcnt lgkmcnt(0)":::"memory");SBAR();
    #define PK(k) (bf16x8){lo[k][0],lo[k][1],lo[k][2],lo[k][3],hi[k][0],hi[k][1],hi[k][2],hi[k][3]}
    o[d0]=MFMA32(pa0,PK(0),o[d0]);
    o[d0]=MFMA32(pa1,PK(1),o[d0]);
    o[d0]=MFMA32(pa2,PK(2),o[d0]);
    o[d0]=MFMA32(pa3,PK(3),o[d0]);
    #undef PK
  }
}

template<int THRL> __device__ __forceinline__ void attn_sub(int b,int qkcol,int vcol,int qb,int cmap,float sl2,float lam,int ntcap,float Ub,float oscale,const float*subg,unsigned*o1s,bf16*MIXh,const bf16*Q,const bf16*__restrict__ K,const bf16*__restrict__ V,char*shm,unsigned*pw_,unsigned*popctr,volatile __attribute__((address_space(3))) unsigned*popslot){
#if PROBE_ATT >= 3
  const unsigned long long ps0_=__builtin_amdgcn_s_memrealtime();
#endif
  const int tid=threadIdx.x,lane=tid&63,r32=lane&31,hi=lane>>5; const int wid=__builtin_amdgcn_readfirstlane(tid>>6);
  const long rowbase=(long)b*SEQ; const int q0=qb*QB;
  const bf16*Qw=Q+(rowbase+q0+wid*QBLK)*DM+qkcol;
  const bf16*Kh=K+rowbase*DM+qkcol,*Vh=V+rowbase*DM+vcol;
  const unsigned lds0=(unsigned)(uintptr_t)shm;
  float*wsf=(float*)(shm+LDS_WS)+wid*64;
  const unsigned koff=(unsigned)(lane*DM+wid*8)*2u, voffv=(unsigned)((16*(wid&3)+(lane>>2))*DM+(wid>>2)*32+(lane&3)*8)*2u;
  const unsigned kdst=lds0+LDS_K+wid*1024, vdst=lds0+LDS_V+wid*1024;
  const int NTR=(q0+QB)/KVBLK;
  int NT=NTR<ntcap?NTR:ntcap;
  #define DMA_K(t,slot) glds16(Kh+(long)(NTR-1-(t))*KVBLK*DM,koff,(unsigned)__builtin_amdgcn_readfirstlane(kdst+(slot)))
  #define DMA_V(t,slot) do{ glds16(Vh+(long)(NTR-1-(t))*KVBLK*DM,voffv,(unsigned)__builtin_amdgcn_readfirstlane(vdst+2*(slot))); glds16(Vh+(long)(NTR-1-(t))*KVBLK*DM+64,voffv,(unsigned)__builtin_amdgcn_readfirstlane(vdst+2*(slot)+8192)); }while(0)
  const char*Kbase=shm+LDS_K; bf16x8 kf[8];
  const lds_cptr shm3=(lds_cptr)shm; const lds_cptr kp0=shm3+LDS_K+hi*1024+r32*16; const lds_cptr vp0=shm3+LDS_V+((lane>>4)&1)*32+(lane&3)*8+(4*hi+((lane&15)>>2))*64;
  #define vb0 ((int)(unsigned)(uintptr_t)vp0)
  DMA_K(0,0);DMA_V(0,0);DMA_K(1,SLOTB);
  bf16x8 qr[4];
  #pragma unroll
  for(int d0=0;d0<4;++d0)qr[d0]=*reinterpret_cast<const bf16x8*>(&Qw[(long)r32*DM+d0*16+hi*8]);
  const int qrel=wid*QBLK+r32;
  const unsigned lm=hi?0u:0xffffffffu;
  const int qw0=wid*QBLK;
  unsigned bbx; { const unsigned sh=__float_as_uint(sl2)&0xffff0000u; const float sr=sl2-__uint_as_float(sh); bbx=((sh>>16)|(cvtpk_s(sr,0.f)<<16))&lm; }
  const float dlt=64.f*sl2;
  float cref=sl2*(float)(192-qrel);
  #define BIAS2(C0,C1,t) do{ const float c_=__builtin_fmaf(-dlt,(float)(t),cref); const unsigned h_=__float_as_uint(c_)&0xffff0000u; const float r1_=c_-__uint_as_float(h_); \
      const unsigned m_=__float_as_uint(r1_)&0xffff0000u; const float r2_=r1_-__uint_as_float(m_); \
      int q_=qrel; asm volatile("":"+v"(q_)); const float rf_=(float)(q_-qw0); \
      u32x4 b_=(u32x4){bbx,((h_>>16)|m_)&lm,(__float_as_uint(r2_)>>16)&lm,0u}; u32x4 a_=(u32x4){cvtpk_s(rf_,rf_),0x3F803F80u,0x00003F80u,0u}; asm volatile("":"+v"(a_),"+v"(b_)); \
      const f32x16 z_=f32x16{}; C0=MFMA32(__builtin_bit_cast(bf16x8,a_),__builtin_bit_cast(bf16x8,b_),z_); \
      a_.x=cvtpk_s(rf_+32.f,rf_+32.f); asm volatile("":"+v"(a_)); C1=MFMA32(__builtin_bit_cast(bf16x8,a_),__builtin_bit_cast(bf16x8,b_),z_); }while(0)
  float l_reg=0.f;f32x16 o[4];o[0]=f32x16{};o[1]=f32x16{};o[2]=f32x16{};o[3]=f32x16{};
  #define CMASK(P0,P1,t) do{int jb_=3-(t); if(jb_>=0)cmask(P0,P1,jb_,qrel,hi);}while(0)
  bool resc=false;
  #define START(P0,P1) do{ const float rm=rowmax(P0,P1); resc=false; \
    if(__any(rm>(float)THRL)){ const float dl=max2f(rm,0.f); cref=fsub_s(cref,dl); \
      _Pragma("unroll") for(int r=0;r<16;++r){P0[r]=fsub_s(P0[r],dl);P1[r]=fsub_s(P1[r],dl);} } \
    _Pragma("unroll") for(int r=0;r<16;++r)P0[r]=__builtin_amdgcn_exp2f(P0[r]); }while(0)
  #define RESC() do{ if(resc){ asm volatile("s_waitcnt lgkmcnt(0)":::"memory"); \
      _Pragma("unroll") for(int d_=0;d_<4;++d_) _Pragma("unroll") for(int r=0;r<16;++r)o[d_][r]*=wsf[crow(r,hi)]; } }while(0)
  f32x16 pA0,pA1,pB0,pB1;
  int sl_prev=0,sl_cur=0,sl_next=SLOTB;
  #define ROT() do{sl_prev=sl_cur;sl_cur=sl_next;sl_next=(sl_next==(NSLOT-1)*SLOTB)?0:sl_next+SLOTB;}while(0)
  DMA_K(2,2*SLOTB);
  WAIT_BAR(3);
  BIAS2(pA0,pA1,0);
  qkt(pA0,pA1,Kbase,qr,r32,hi);asm volatile("s_nop 15\n\ts_nop 7":"+v"(pA0),"+v"(pA1));CMASK(pA0,pA1,0);
  START(pA0,pA1);
  _Pragma("unroll") for(int r=0;r<16;++r)pA1[r]=__builtin_amdgcn_exp2f(pA1[r]);
  WAIT_BAR(0);
  DMA_K(3,0);DMA_V(1,SLOTB);
  ROT();
  kload8(kf,kp0+sl_cur);
  WAIT_BAR(3);
  s16x4 vlo[8],vhi[8]; u32x4 pw0,pw1,pw2,pw3;
  #define PKW(P,B) cvtpk_s(P[B],P[B+1])
  #define PAF(k) __builtin_bit_cast(bf16x8,pw##k)
  #define VFR(i) (bf16x8){vlo[i][0],vlo[i][1],vlo[i][2],vlo[i][3],vhi[i][0],vhi[i][1],vhi[i][2],vhi[i][3]}
  #define PIN(x) asm volatile("":"+v"(x))
  #define MX3(a,b,c) __builtin_fmaxf(__builtin_fmaxf((a),(b)),(c))
  #define GAPA(MF,A0,A1,A2,A3,W0,W1,PW) do{ MF; sacc+=A0; sacc+=A1; sacc+=A2; sacc+=A3; PIN(sacc); W0; W1; PIN(PW); SBAR(); }while(0)
  #define EX(v) __builtin_amdgcn_exp2f(v)
  #define GAPB(MF,X,B) do{ MF; X[B]=EX(X[B]); X[B+1]=EX(X[B+1]); PIN(X); SBAR(); }while(0)
  #define VRD2(i) do{ vlo[i]=vtr(vp_+(8192+((i)>>2)*4096+((i)&3)*1024)); vhi[i]=vtr(vp_+(8192+((i)>>2)*4096+((i)&3)*1024+512)); SBAR(); }while(0)
  #define VRD(i) do{ vlo[i]=vtr(vp_+(((i)>>2)*4096+((i)&3)*1024)); vhi[i]=vtr(vp_+(((i)>>2)*4096+((i)&3)*1024+512)); }while(0)
  #define KRD(G,j) do{ if(G){ kload2(kf,kp0+sl_next,j); SBAR(); } }while(0)
  #define STEP(C0,C1,P0,P1,t,GK,GV,GL) do{ SBAR(); \
    BIAS2(C0,C1,t); SBAR(); \
    const lds_cptr vp_=vp0+2*sl_prev; \
    VRD(0); SBAR(); float sacc=(P0[0]+P0[1]); \
    GAPA(C0=MFMA32(kf[0],qr[0],C0), P0[2],P0[3],P0[4],P0[5],     pw0[0]=PKW(P0,0), pw0[1]=PKW(P0,2), pw0); \
    VRD(4); SBAR(); GAPA(C1=MFMA32(kf[1],qr[0],C1), P0[6],P0[7],P0[8],P0[9],     pw0[2]=PKW(P0,4), pw0[3]=PKW(P0,6), pw0); \
    VRD(1); SBAR(); GAPA(C0=MFMA32(kf[2],qr[1],C0),   P0[10],P0[11],P0[12],P0[13], pw1[0]=PKW(P0,8), pw1[1]=PKW(P0,10), pw1); \
    VRD(5); SBAR(); GAPA(C1=MFMA32(kf[3],qr[1],C1),   P0[14],P0[15],P1[0],P1[1],   pw1[2]=PKW(P0,12),pw1[3]=PKW(P0,14), pw1); \
    VRD(2); SBAR(); GAPA(C0=MFMA32(kf[4],qr[2],C0),   P1[2],P1[3],P1[4],P1[5],     pw2[0]=PKW(P1,0), pw2[1]=PKW(P1,2), pw2); \
    VRD(6); SBAR(); GAPA(C1=MFMA32(kf[5],qr[2],C1),   P1[6],P1[7],P1[8],P1[9],     pw2[2]=PKW(P1,4), pw2[3]=PKW(P1,6), pw2); \
    VRD(3); SBAR(); GAPA(C0=MFMA32(kf[6],qr[3],C0),   P1[10],P1[11],P1[12],P1[13], pw3[0]=PKW(P1,8), pw3[1]=PKW(P1,10), pw3); \
    VRD(7); SBAR(); GAPA(C1=MFMA32(kf[7],qr[3],C1),   P1[14],P1[15],0.f,0.f,       pw3[2]=PKW(P1,12),pw3[3]=PKW(P1,14), pw3); \
    l_reg+=sacc; \
    if(GK){DMA_K((t)+3,sl_cur);} if(GV){DMA_V((t)+1,sl_next);} \
    CMASK(C0,C1,t); \
    { float a=MX3(C0[0],C0[1],C1[0]),b=MX3(C0[2],C0[3],C1[1]); a=MX3(a,C1[2],C1[3]); \
      _Pragma("unroll") for(int r=4;r<16;r+=4){a=MX3(a,C0[r],C0[r+1]);b=MX3(b,C0[r+2],C0[r+3]);a=MX3(a,C1[r],C1[r+1]);b=MX3(b,C1[r+2],C1[r+3]);} \
      float rm=__builtin_fmaxf(a,b); { auto rr=__builtin_amdgcn_permlane32_swap(__float_as_uint(rm),__float_as_uint(rm),false,false); rm=__builtin_fmaxf(__uint_as_float(rr[0]),__uint_as_float(rr[1])); } \
      resc=false; \
      if(__builtin_expect(__any(rm>(float)THRL),0)){ const float dl=__builtin_fmaxf(rm,0.f); cref-=dl; \
        _Pragma("unroll") for(int r=0;r<16;++r){C0[r]-=dl;C1[r]-=dl;} \
        const float f=__builtin_amdgcn_exp2f(-dl); l_reg*=f; if(hi==0)wsf[r32]=f; resc=true; } } \
    SBAR(); \
    GAPB(o[0]=MFMA32(PAF(0),VFR(0),o[0]), C0,0);  VRD2(0); \
    GAPB(o[1]=MFMA32(PAF(0),VFR(4),o[1]), C0,2);  VRD2(4); \
    KRD(GL,0); GAPB(o[0]=MFMA32(PAF(1),VFR(1),o[0]), C0,4);  VRD2(1); \
    KRD(GL,1); GAPB(o[1]=MFMA32(PAF(1),VFR(5),o[1]), C0,6);  VRD2(5); \
    KRD(GL,2); GAPB(o[0]=MFMA32(PAF(2),VFR(2),o[0]), C0,8);  VRD2(2); \
    KRD(GL,3); GAPB(o[1]=MFMA32(PAF(2),VFR(6),o[1]), C0,10); VRD2(6); \
    GAPB(o[0]=MFMA32(PAF(3),VFR(3),o[0]), C0,12); VRD2(3); \
    GAPB(o[1]=MFMA32(PAF(3),VFR(7),o[1]), C0,14); VRD2(7); \
    GAPB(o[2]=MFMA32(PAF(0),VFR(0),o[2]), C1,0); \
    GAPB(o[3]=MFMA32(PAF(0),VFR(4),o[3]), C1,2); \
    GAPB(o[2]=MFMA32(PAF(1),VFR(1),o[2]), C1,4); \
    GAPB(o[3]=MFMA32(PAF(1),VFR(5),o[3]), C1,6); \
    GAPB(o[2]=MFMA32(PAF(2),VFR(2),o[2]), C1,8); \
    GAPB(o[3]=MFMA32(PAF(2),VFR(6),o[3]), C1,10); \
    GAPB(o[2]=MFMA32(PAF(3),VFR(3),o[2]), C1,12); \
    GAPB(o[3]=MFMA32(PAF(3),VFR(7),o[3]), C1,14); \
    }while(0)
  #define ENDW(tt) do{ if((tt)+3<NT){WAIT_BAR(3);} else if((tt)+2<NT){WAIT_BAR(2);} else {WAIT_BAR(0);} }while(0)
#if PROBE_ATT == 3
  if(blockIdx.x==PROBE_BLK&&threadIdx.x==0)atomicAdd(pw_,(unsigned)(__builtin_amdgcn_s_memrealtime()-ps0_));
#endif
  int t=1;
  for(;t<5&&t+1<NT;t+=2){
    STEP(pB0,pB1,pA0,pA1,t,(t+3<NT),(t+1<NT),(t+1<NT));       ENDW(t);   RESC(); ROT();
    STEP(pA0,pA1,pB0,pB1,t+1,(t+4<NT),(t+2<NT),(t+2<NT));     ENDW(t+1); RESC(); ROT();
  }
  #undef CMASK
  #define CMASK(P0,P1,t) do{}while(0)
  for(;t+5<NT;t+=2){
    if((t&7)==5){
    float lt=l_reg; {auto rr=__builtin_amdgcn_permlane32_swap(__float_as_uint(lt),__float_as_uint(lt),false,false);lt=__uint_as_float(rr[0])+__uint_as_float(rr[1]);}
    float dl2=(sl2*(float)(192-qrel)-cref)+__builtin_amdgcn_logf(lt);
    #define DPPMIN(ctl) dl2=__builtin_fminf(dl2,__uint_as_float((unsigned)__builtin_amdgcn_update_dpp(0,(int)__float_as_uint(dl2),ctl,0xF,0xF,false)))
    DPPMIN(0xB1); DPPMIN(0x4E); DPPMIN(0x141); DPPMIN(0x140);
    #undef DPPMIN
    { auto rr=__builtin_amdgcn_permlane16_swap(__float_as_uint(dl2),__float_as_uint(dl2),false,false); dl2=__builtin_fminf(__uint_as_float(rr[0]),__uint_as_float(rr[1])); }
    float*xw=(float*)(shm+LDS_OST);
    if(lane==0)xw[wid]=dl2;
    asm volatile("s_waitcnt lgkmcnt(0)\n\ts_barrier":::"memory");
    float dmin=xw[0];
    #pragma unroll
    for(int w_=1;w_<8;++w_)dmin=__builtin_fminf(dmin,xw[w_]);
    dmin=__uint_as_float(__builtin_amdgcn_readfirstlane(__float_as_uint(dmin)));
    const float d0_=(Ub-dmin+24.f+log2f(1.f/(1.f-exp2f(-sl2))))/sl2; float st_=ceilf((d0_+255.f)*(1.f/64.f)); const float lo_=(float)(t+5); st_=st_<lo_?lo_:(st_>64.f?64.f:st_);
    const int nc_=__builtin_amdgcn_readfirstlane((((int)st_)+1)&~1); if(nc_<NT)NT=nc_;
    asm volatile("s_waitcnt lgkmcnt(0)":::"memory");
  }
    STEP(pB0,pB1,pA0,pA1,t,true,true,true);     WAIT_BAR(3); RESC(); ROT();
    STEP(pA0,pA1,pB0,pB1,t+1,true,true,true);   WAIT_BAR(3); RESC(); ROT();
  }
  for(;t+1<NT;t+=2){
    STEP(pB0,pB1,pA0,pA1,t,(t+3<NT),(t+1<NT),(t+1<NT));       ENDW(t);   RESC(); ROT();
    STEP(pA0,pA1,pB0,pB1,t+1,(t+4<NT),(t+2<NT),(t+2<NT));     ENDW(t+1); RESC(); ROT();
  }
  #undef CMASK
  #define CMASK(P0,P1,t) do{int jb_=3-(t); if(jb_>=0)cmask(P0,P1,jb_,qrel,hi);}while(0)
  STEP(pB0,pB1,pA0,pA1,NT-1,false,false,false); RESC();
#if PROBE_ATT == 4
  const unsigned long long ps1_=__builtin_amdgcn_s_memrealtime();
#endif
  { float sacc=pB0[0]+pB0[1]; _Pragma("unroll") for(int r=2;r<16;++r)sacc+=pB0[r]; _Pragma("unroll") for(int r=0;r<16;++r)sacc+=pB1[r]; l_reg+=sacc;
    pw0=(u32x4){PKW(pB0,0),PKW(pB0,2),PKW(pB0,4),PKW(pB0,6)};pw1=(u32x4){PKW(pB0,8),PKW(pB0,10),PKW(pB0,12),PKW(pB0,14)};pw2=(u32x4){PKW(pB1,0),PKW(pB1,2),PKW(pB1,4),PKW(pB1,6)};pw3=(u32x4){PKW(pB1,8),PKW(pB1,10),PKW(pB1,12),PKW(pB1,14)};
    SBAR(); pv(o,vb0+2*sl_cur,PAF(0),PAF(1),PAF(2),PAF(3)); }
  #undef PKW
  #undef PAF
  #undef VFR
  #undef PIN
  #undef MX3
  #undef GAPA
  #undef GAPB
  #undef EX
  #undef VRD
  #undef VRD2
  #undef KRD
  #undef STEP
  #undef ENDW
  { int tid_e=threadIdx.x; asm volatile("":"+v"(tid_e)); const int lane=tid_e&63,r32=lane&31,hi=lane>>5; const int wid=__builtin_amdgcn_readfirstlane(tid_e>>6);
    unsigned nx_=0u; if(popctr&&tid_e==0)nx_=__hip_atomic_fetch_add(popctr,1u,__ATOMIC_RELAXED,__HIP_MEMORY_SCOPE_AGENT);
    float*wsf=(float*)(shm+LDS_WS)+wid*64;
  {auto rr=__builtin_amdgcn_permlane32_swap(__float_as_uint(l_reg),__float_as_uint(l_reg),false,false);l_reg=__uint_as_float(rr[0])+__uint_as_float(rr[1]);}
  if(hi==0)wsf[32+r32]=l_reg;asm volatile("s_waitcnt lgkmcnt(0)":::"memory");
  float rli[16];
  #pragma unroll
  for(int r=0;r<16;++r)rli[r]=__builtin_amdgcn_rcpf(wsf[32+crow(r,hi)]);
  u32x4*ow=(u32x4*)(o1s+wid*2048)+lane;
  if(cmap==0){
    #pragma unroll
    for(int i=0;i<8;++i){ const int dq=i>>1,r0=8*(i&1); u32x4 w;
      w.x=cvtpk_s(o[dq][r0+0]*rli[r0+0],o[dq][r0+1]*rli[r0+1]); w.y=cvtpk_s(o[dq][r0+2]*rli[r0+2],o[dq][r0+3]*rli[r0+3]);
      w.z=cvtpk_s(o[dq][r0+4]*rli[r0+4],o[dq][r0+5]*rli[r0+5]); w.w=cvtpk_s(o[dq][r0+6]*rli[r0+6],o[dq][r0+7]*rli[r0+7]); ow[i*64]=w; }
  } else {
    bf16*stg=(bf16*)(shm+LDS_OST)+wid*2048;
    const int row=lane>>1,part=lane&1; float v[64]; float ss=0.f;
    unsigned o1w[32];
    #pragma unroll
    for(int i=0;i<8;++i){ const u32x4 w=ow[i*64]; o1w[4*i+0]=w.x; o1w[4*i+1]=w.y; o1w[4*i+2]=w.z; o1w[4*i+3]=w.w; }
    #pragma unroll
    for(int p_=0;p_<2;++p_){
      #pragma unroll
      for(int d0=0;d0<2;++d0){ const int dq=2*p_+d0;
        #pragma unroll
        for(int rp=0;rp<8;++rp){ const unsigned w=o1w[dq*8+rp];
          const float a0=__uint_as_float(w<<16)-lam*(o[dq][2*rp]*rli[2*rp]), a1=__uint_as_float(w&0xffff0000u)-lam*(o[dq][2*rp+1]*rli[2*rp+1]);
          stg[crow(2*rp,hi)*64+d0*32+r32]=__float2bfloat16(a0); stg[crow(2*rp+1,hi)*64+d0*32+r32]=__float2bfloat16(a1); } }
      asm volatile("s_waitcnt lgkmcnt(0)":::"memory");
      #pragma unroll
      for(int i=0;i<4;++i){ const u32x4 w=*(const u32x4*)(stg+row*64+part*32+8*i);
        v[32*p_+8*i+0]=__uint_as_float(w.x<<16); v[32*p_+8*i+1]=__uint_as_float(w.x&0xffff0000u); v[32*p_+8*i+2]=__uint_as_float(w.y<<16); v[32*p_+8*i+3]=__uint_as_float(w.y&0xffff0000u);
        v[32*p_+8*i+4]=__uint_as_float(w.z<<16); v[32*p_+8*i+5]=__uint_as_float(w.z&0xffff0000u); v[32*p_+8*i+6]=__uint_as_float(w.w<<16); v[32*p_+8*i+7]=__uint_as_float(w.w&0xffff0000u); }
      asm volatile("s_waitcnt lgkmcnt(0)":::"memory");
    }
    #pragma unroll
    for(int i=0;i<64;++i)ss+=v[i]*v[i];
    ss+=__uint_as_float((unsigned)__builtin_amdgcn_update_dpp(0,(int)__float_as_uint(ss),0xB1,0xF,0xF,false));
    const float rs=(1.0f/sqrtf(ss*(1.0f/128.0f)+1e-6f))*oscale;
    bf16*op=MIXh+((long)rowbase+q0+wid*QBLK+row)*2048+part*32;
    #pragma unroll
    for(int p_=0;p_<2;++p_){ const float*sg=subg+64*p_+32*part;
      #pragma unroll
      for(int i=0;i<4;++i){ u32x4 w; const float*vv=v+32*p_+8*i; const float*gg=sg+8*i;
        w.x=cvtpk_s(vv[0]*rs*gg[0],vv[1]*rs*gg[1]); w.y=cvtpk_s(vv[2]*rs*gg[2],vv[3]*rs*gg[3]); w.z=cvtpk_s(vv[4]*rs*gg[4],vv[5]*rs*gg[5]); w.w=cvtpk_s(vv[6]*rs*gg[6],vv[7]*rs*gg[7]);
        *(u32x4*)(op+64*p_+8*i)=w; } }
  }
    if(popctr&&tid_e==0)*popslot=nx_;
  }
  asm volatile("s_waitcnt lgkmcnt(0)\n\ts_barrier":::"memory");
#if PROBE_ATT == 4
  if(blockIdx.x==PROBE_BLK&&threadIdx.x==0)atomicAdd(pw_,(unsigned)(__builtin_amdgcn_s_memrealtime()-ps1_));
#endif
  #undef DMA_K
  #undef DMA_V
  #undef vb0
  #undef CMASK
  #undef START
  #undef RESC
  #undef ROT
  #undef BIAS2
}
constexpr int ATTN_LDS_BYTES=LDS_BYTES;
template<int THRL> __device__ __forceinline__ void attn_unit4(int b,int h,int qb,float lam,float oscale,const float*subg,const unsigned*nmax,unsigned*o1s,const bf16*Q,const bf16*K,const bf16*V,bf16*MIX,char*shm,unsigned*popctr,volatile __attribute__((address_space(3))) unsigned*popslot){
  const float sl2=exp2f(-(float)(h+1))*1.4426950408889634f;
  int cap[2]; float Uv[2];
  const __attribute__((address_space(3))) unsigned*nml=(const __attribute__((address_space(3))) unsigned*)(shm+LDS_NMAX);
  #pragma unroll
  for(int c=0;c<2;++c){ const int bh=b*8+h; const __attribute__((address_space(3))) unsigned*qn=nml+((0*64+bh)*2+c)*2,*kn=nml+((1*64+bh)*2+c)*2;
    const float U=1.02f*(sqrtf(__uint_as_float(qn[0])*__uint_as_float(kn[0]))+sqrtf(__uint_as_float(qn[1])*__uint_as_float(kn[1])));
    const float d0=(2.f*U+24.f+log2f(1.f/(1.f-exp2f(-sl2))))/sl2; float st=ceilf((d0+255.f)*(1.f/64.f)); st=st<4.f?4.f:(st>64.f?64.f:st);
    cap[c]=__builtin_amdgcn_readfirstlane((((int)st)+1)&~1); Uv[c]=__uint_as_float(__builtin_amdgcn_readfirstlane(__float_as_uint(U))); }
  for(int c=0;c<2;++c) attn_sub<THRL>(b,(2*h+c)*64,h*128,qb,c,sl2,lam,c?cap[1]:cap[0],c?Uv[1]:Uv[0],oscale,subg,o1s,MIX+h*128,Q,K,V,shm,(unsigned*)nmax+900,c?popctr:nullptr,popslot);
}
__device__ __forceinline__ int wg_pop(unsigned*ctr,volatile __attribute__((address_space(3))) unsigned*slot){
  if(threadIdx.x==0)*slot=__hip_atomic_fetch_add(ctr,1u,__ATOMIC_RELAXED,__HIP_MEMORY_SCOPE_AGENT);
  __syncthreads(); const unsigned n=*slot; __syncthreads(); return (int)n;
}
template<int THRL=8> __device__ __forceinline__ void attn_phase(char*lds,int bx,unsigned*qctr,volatile __attribute__((address_space(3))) unsigned*slot,float lam,float oscale,const float*subg,const unsigned*nmax,unsigned*o1s,const bf16*Q,const bf16*K,const bf16*V,bf16*MIX){
  { int tid_=threadIdx.x; asm volatile("":"+v"(tid_)); ((__attribute__((address_space(3))) unsigned*)(lds+LDS_NMAX))[tid_]=nmax[tid_]; }
  for(int qi=0;qi<8;++qi){ const int x=(bx+qi)&7;
    int n=wg_pop(qctr+64*x,slot);
    for(;n<128;){
      const int qb=15-(n>>3),h=7-(n&7),b=(x+h)&7;
#if PROBE_ATT == 1
      const unsigned long long pa0_=__builtin_amdgcn_s_memrealtime();
#endif
      attn_unit4<THRL>(b,h,qb,lam,oscale,subg,nmax,o1s,Q,K,V,MIX,lds,qctr+64*x,slot);
#if PROBE_ATT == 1
      if(blockIdx.x==PROBE_BLK&&threadIdx.x==0)atomicAdd((unsigned*)nmax+900,(unsigned)(__builtin_amdgcn_s_memrealtime()-pa0_));
#endif
      n=(int)*slot; __syncthreads();
    } }
}
#undef SBAR
#undef WAIT_BAR
#undef MFMA32
}
#define GAS __attribute__((address_space(1)))
#define LAS __attribute__((address_space(3)))
typedef unsigned short bf16;
typedef unsigned v4u __attribute__((ext_vector_type(4)));
typedef float f32x4 __attribute__((ext_vector_type(4)));
typedef short bf16x8 __attribute__((ext_vector_type(8)));
typedef GAS unsigned gu32;
typedef GAS unsigned long long gu64;
#define RLX_AGENT __ATOMIC_RELAXED, __HIP_MEMORY_SCOPE_AGENT
#define LDS_WAIT() asm volatile("s_waitcnt lgkmcnt(0)" ::: "memory")
#define VM_WAIT() asm volatile("s_waitcnt vmcnt(0)" ::: "memory")
__device__ __forceinline__ unsigned long long rt() { return __builtin_amdgcn_s_memrealtime(); }
__device__ __forceinline__ unsigned f2bf(float f) { unsigned u = __builtin_bit_cast(unsigned, f); return (u + 0x7fffu + ((u >> 16) & 1u)) >> 16; }
__device__ __forceinline__ unsigned pk2(float lo, float hi) { return f2bf(lo) | (f2bf(hi) << 16); }

#define XB_TMO      128
#define XB_XCNT(j)  (256  + 64 * (j))
#define XB_XSUB(j)  (1280 + 64 * (j))
#define XB_XGEN(j)  (2304 + 64 * (j))
#define XB_TOP      3328
#define XB_TOPGEN   3392
#define XCD_BAR_WORDS 3456
#define XB_SPIN_CAP (1u << 18)

__device__ __forceinline__ unsigned xb_ld(unsigned* p)              { return __hip_atomic_load(p, __ATOMIC_RELAXED, __HIP_MEMORY_SCOPE_AGENT); }
__device__ __forceinline__ unsigned xb_add(unsigned* p, unsigned v) { return __hip_atomic_fetch_add(p, v, __ATOMIC_RELAXED, __HIP_MEMORY_SCOPE_AGENT); }
__device__ __forceinline__ unsigned xb_xcc_id() { return (unsigned)__builtin_amdgcn_s_getreg((3 << 11) | 20) & 0xFu; }
#define XB_SPIN(cond, bar) do { unsigned _sp = 0; while (cond) { __builtin_amdgcn_s_sleep(1); \
    if ((++_sp & 255u) == 0u) { if (xb_ld(&(bar)[XB_TMO])) break; if (_sp > XB_SPIN_CAP) { atomicAdd(&(bar)[XB_TMO], 1u); break; } } } } while (0)

struct XcdBarrier {
    unsigned* bar; unsigned x;
    volatile LAS unsigned* st;
};

__device__ __forceinline__ XcdBarrier xcd_barrier_post(unsigned* bar, volatile LAS unsigned* st) {
    XcdBarrier b; b.bar = bar; b.x = xb_xcc_id(); b.st = st;
    if (threadIdx.x == 0) (void)xb_add(&bar[XB_XCNT(b.x)], 1u);
    return b;
}
__device__ __forceinline__ void xcd_barrier_complete(unsigned* bar, unsigned x, unsigned& nloc, unsigned& nx) {
    const unsigned G = gridDim.x * gridDim.y * gridDim.z;
    unsigned sum, cnt, mine, sp = 0u;
    for (;;) {
        sum = 0u; cnt = 0u; mine = 0u;
#pragma unroll
        for (unsigned j = 0; j < 16; ++j) { const unsigned c = xb_ld(&bar[XB_XCNT(j)]); sum += c; cnt += (c > 0u) ? 1u : 0u; mine = (j == x) ? c : mine; }
        if (sum == G) break;
        __builtin_amdgcn_s_sleep(1);
        if ((++sp & 255u) == 0u) { if (xb_ld(&bar[XB_TMO])) break; if (sp > XB_SPIN_CAP) { atomicAdd(&bar[XB_TMO], 1u); break; } }
    }
    nloc = mine > 0u ? mine : 1u; nx = cnt > 0u ? cnt : 1u;
}

__device__ __forceinline__ void xcd_barrier(const XcdBarrier& b) {
    asm volatile("s_waitcnt vmcnt(0)" ::: "memory");
    __syncthreads();
    if (threadIdx.x == 0) {
        unsigned* bar = b.bar;
        __builtin_amdgcn_s_waitcnt(0);
        unsigned nloc = b.st[0], nx = b.st[1];
        if (nloc == 0u) { xcd_barrier_complete(bar, b.x, nloc, nx); b.st[0] = nloc; b.st[1] = nx; }
        const unsigned old = xb_add(&bar[XB_XSUB(b.x)], 1u);
        const unsigned gen = old / nloc;
        if (old + 1u == (gen + 1u) * nloc) {
            __builtin_amdgcn_fence(__ATOMIC_RELEASE, "agent");
            asm volatile("s_waitcnt vmcnt(0)" ::: "memory");
            const unsigned og = xb_add(&bar[XB_TOP], 1u);
            const unsigned tg = og / nx;
            if (og + 1u == (tg + 1u) * nx) xb_add(&bar[XB_TOPGEN], 1u);
            else XB_SPIN(xb_ld(&bar[XB_TOPGEN]) == tg, bar);
            __builtin_amdgcn_fence(__ATOMIC_ACQUIRE, "agent");
            xb_add(&bar[XB_XGEN(b.x)], 1u);
            asm volatile("s_waitcnt vmcnt(0)" ::: "memory");
        } else {
            XB_SPIN(xb_ld(&bar[XB_XGEN(b.x)]) == gen, bar);
            __builtin_amdgcn_fence(__ATOMIC_ACQUIRE, "agent");
            asm volatile("s_waitcnt vmcnt(0)" ::: "memory");
        }
    }
    __syncthreads();
}

constexpr int NWAVES = 8;
constexpr int BATCH = 8, SEQ = 4096, T = BATCH * SEQ, D = 2048, NIN = 5120, NEXP = 32, NA = 2 * T;
constexpr float EPS = 1e-6f, LOG2E = 1.4426950408889634f, C2 = 0.125f * 1.4426950408889634f;
constexpr size_t MiB = 1u << 20;
constexpr size_t WS_CTL = 0, CTL_ZERO_BYTES = 128 * 1024;
constexpr size_t WS_RSTD1 = 1 * MiB, WS_RSTD2 = WS_RSTD1 + 128 * 1024, WS_WTS = WS_RSTD2 + 128 * 1024;
constexpr size_t WS_LIST = 2 * MiB;
constexpr size_t WS_PART = 6 * MiB;
constexpr size_t WS_WIN = 10 * MiB, WS_WOUT = 30 * MiB;
constexpr size_t WS_WGU = 38 * MiB, WS_WD = 166 * MiB;
constexpr size_t WS_XB = 230 * MiB;
constexpr size_t WS_CG = 358 * MiB;
constexpr size_t WS_MIX = 422 * MiB;
constexpr size_t WS_HB = 550 * MiB;
constexpr size_t WS_HB8 = 678 * MiB;
constexpr size_t WS_WR = 742 * MiB;
constexpr size_t WS_X8 = 743 * MiB;
constexpr size_t WS_WIN8 = 807 * MiB;
constexpr size_t WS_O1S = 811 * MiB;
constexpr size_t WS_LISTW = 827 * MiB, WS_LISTR = 831 * MiB;
constexpr size_t WS_END = 835 * MiB;
constexpr float WSCALE = 32.f, H1SCALE = 4.f, YSCALE = 8.f;
constexpr int CW_TMO = 0, CW_CODE = 1, CW_BAR = 4096, CW_CNT = 8192;
constexpr int CW_GQ = 20480;
constexpr int CW_H8Q = 24576 + 1024;
constexpr int CW_CVQ = 24576, CW_DONE = 24576 + 64;
constexpr int CW_QA = 12288, CW_QC = 12288 + 512, CW_NMAX = 16384;
constexpr int RING_OFF = 0, RING_BYTES = 131072, LDSCTL_OFF = RING_BYTES, MISC_OFF = LDSCTL_OFF + 320, TAB_OFF = LDSCTL_OFF + 1024;
constexpr int LDS_BYTES = 147456;
constexpr int NPHASE = 8;
#ifndef MK_ONE_LAUNCH
#define MK_ONE_LAUNCH 1
#endif
#ifndef PROBE_DOUBLE
#define PROBE_DOUBLE 0
#endif
#ifndef PROBE_CLOCK
#define PROBE_CLOCK 0
#endif
#ifndef USE_NAIVE_ROUTER
#define USE_NAIVE_ROUTER 0
#endif
#ifndef USE_NAIVE_ATTN
#define USE_NAIVE_ATTN 0
#endif


typedef unsigned u32x4g __attribute__((ext_vector_type(4)));
__device__ __forceinline__ float wave_sum(float v) {
#define WS_DPP(ctl) v += __builtin_bit_cast(float, __builtin_amdgcn_update_dpp(0, __builtin_bit_cast(int, v), ctl, 0xF, 0xF, false))
    WS_DPP(0xB1); WS_DPP(0x4E); WS_DPP(0x141); WS_DPP(0x140);
#undef WS_DPP
    return pg8::rows4_sum(v);
}
__device__ __forceinline__ float bflo(unsigned w) { return __builtin_bit_cast(float, w << 16); }
__device__ __forceinline__ float bfhi(unsigned w) { return __builtin_bit_cast(float, w & 0xffff0000u); }
__device__ __forceinline__ float fexp2(float x) { return __builtin_amdgcn_exp2f(x); }

__device__ __forceinline__ void tr_item(const float* W, int N, const float* gk, int k0, int n0, bf16* dst, int dstK, LAS float* scr, int lane) {
    const int kr = lane >> 3, n4 = 4 * (lane & 7); f32x4 v[8];
#pragma unroll
    for (int i = 0; i < 8; ++i) v[i] = __builtin_nontemporal_load((const GAS f32x4*)(W + (size_t)(k0 + 8 * i + kr) * N + n0 + n4));
#pragma unroll
    for (int i = 0; i < 8; ++i) { const int kk = 8 * i + kr; const float g = gk ? gk[k0 + kk] : 1.0f;
        scr[(n4 + 0) * 66 + kk] = v[i].x * g; scr[(n4 + 1) * 66 + kk] = v[i].y * g; scr[(n4 + 2) * 66 + kk] = v[i].z * g; scr[(n4 + 3) * 66 + kk] = v[i].w * g; }
    LDS_WAIT(); asm volatile("" ::: "memory");
    const int c = lane & 7;
#pragma unroll
    for (int j = 0; j < 4; ++j) { const int n = (lane >> 3) + 8 * j; const LAS float* s = scr + n * 66 + 8 * c;
        v4u o; o.x = pk2(s[0], s[1]); o.y = pk2(s[2], s[3]); o.z = pk2(s[4], s[5]); o.w = pk2(s[6], s[7]);
        *(GAS v4u*)(dst + (size_t)n * dstK + 8 * c) = o; }
    LDS_WAIT(); asm volatile("" ::: "memory");
}
__device__ __forceinline__ void tr8_load(const float* W, int N, int k0, int n0, int lane, f32x4 (&v)[8]) {
    const int kr = lane >> 3, n4 = 4 * (lane & 7);
#pragma unroll
    for (int i = 0; i < 8; ++i) v[i] = __builtin_nontemporal_load((const GAS f32x4*)(W + (size_t)(k0 + 8 * i + kr) * N + n0 + n4));
}
__device__ __forceinline__ void tr8_finish(const f32x4 (&v)[8], const float* gk, float scale, int k0, unsigned char* dst, int dstK, LAS float* scr, int lane) {
    const int kr = lane >> 3, n4 = 4 * (lane & 7);
#pragma unroll
    for (int i = 0; i < 8; ++i) { const int kk = 8 * i + kr; const float g = (gk ? gk[k0 + kk] : 1.0f) * scale;
        scr[(n4 + 0) * 66 + kk] = v[i].x * g; scr[(n4 + 1) * 66 + kk] = v[i].y * g; scr[(n4 + 2) * 66 + kk] = v[i].z * g; scr[(n4 + 3) * 66 + kk] = v[i].w * g; }
    LDS_WAIT(); asm volatile("" ::: "memory");
    const int c = lane & 7;
#pragma unroll
    for (int j = 0; j < 4; ++j) { const int n = (lane >> 3) + 8 * j; const LAS float* s = scr + n * 66 + 8 * c;
        pg8::u32x2 o; o.x = pg8::pk4_fp8(s[0], s[1], s[2], s[3]); o.y = pg8::pk4_fp8(s[4], s[5], s[6], s[7]);
        __builtin_nontemporal_store(o, (GAS pg8::u32x2*)(dst + (size_t)n * dstK + 8 * c)); }
    LDS_WAIT(); asm volatile("" ::: "memory");
}
__device__ __forceinline__ void tr_item8(const float* W, int N, const float* gk, float scale, int k0, int n0, unsigned char* dst, int dstK, LAS float* scr, int lane) {
    f32x4 v[8]; tr8_load(W, N, k0, n0, lane, v); tr8_finish(v, gk, scale, k0, dst, dstK, scr, lane);
}
struct Ptrs {
    const float *x, *g1, *w_in, *lq1, *lk1, *lq2, *lk2, *subg, *cw, *cb, *lng, *lnb, *w_out, *g2, *wgr, *bgr, *wer, *ber, *w_gate, *w_up, *w_down, *gf;
    float* out; unsigned char* ws;
};
__device__ __forceinline__ void p0_prologue(const Ptrs& P, LAS unsigned char* lds, int lane, int wave, int gw, int NGW) {
    LAS float* scr = (LAS float*)(lds + RING_OFF + wave * 16384);
    bf16* WIN = (bf16*)(P.ws + WS_WIN); bf16* WOUT = (bf16*)(P.ws + WS_WOUT);
    constexpr int I_IN = 32 * 160, I_OUT = 32 * 64, NITEMS = I_IN + I_OUT;
    for (int it = gw; it < NITEMS; it += NGW) {
        if (it < I_IN) { const int kb = it / 160, nb = it % 160;
            if (nb < 96) tr_item(P.w_in, NIN, P.g1, 64 * kb, 32 * nb, WIN + (size_t)(32 * nb) * 2048 + 64 * kb, 2048, scr, lane);
            else { const int j0 = 32 * (nb - 96), jj = j0 & 1023, drow = 256 * (jj >> 7) + (jj & 127) + (j0 >= 1024 ? 128 : 0);
                tr_item8(P.w_in, NIN, P.g1, WSCALE, 64 * kb, 32 * nb, P.ws + WS_WIN8 + (size_t)drow * 2048 + 64 * kb, 2048, scr, lane); } }
        else { const int r = it - I_IN, kb = r >> 6, nb = r & 63; tr_item(P.w_out, 2048, nullptr, 64 * kb, 32 * nb, WOUT + (size_t)(32 * nb) * 2048 + 64 * kb, 2048, scr, lane); }
    }
    { bf16* WR = (bf16*)(P.ws + WS_WR);
      for (int it = gw; it < 32; it += NGW) tr_item(P.wer, 32, P.g2, 64 * it, 0, WR + 64 * it, 2048, scr, lane);
      for (int k = gw * 64 + lane; k < 2048; k += NGW * 64) { const float gk = P.g2[k]; const f32x4 w = *(const f32x4*)(P.wgr + (size_t)k * 4);
          WR[(size_t)128 * 2048 + k] = (bf16)f2bf(w.x * gk); WR[(size_t)129 * 2048 + k] = (bf16)f2bf(w.y * gk); WR[(size_t)130 * 2048 + k] = (bf16)f2bf(w.z * gk); WR[(size_t)131 * 2048 + k] = (bf16)f2bf(w.w * gk); } }
    bf16* XB = (bf16*)(P.ws + WS_XB); float* RS1 = (float*)(P.ws + WS_RSTD1);
    for (int m0 = gw; m0 < T; m0 += 2 * NGW) {
        f32x4 v[2][8]; float ss[2] = {0.f, 0.f};
#pragma unroll
        for (int q = 0; q < 2; ++q) { const int mr = (m0 + q * NGW < T) ? m0 + q * NGW : T - 1; const GAS f32x4* xr = (const GAS f32x4*)(P.x + (size_t)mr * D) + lane;
#pragma unroll
            for (int j = 0; j < 8; ++j) v[q][j] = __builtin_nontemporal_load(&xr[64 * j]); }
#pragma unroll
        for (int q = 0; q < 2; ++q) { const int m = m0 + q * NGW; if (m >= T) continue;
#pragma unroll
            for (int j = 0; j < 8; ++j) ss[q] += (v[q][j].x * v[q][j].x + v[q][j].y * v[q][j].y) + (v[q][j].z * v[q][j].z + v[q][j].w * v[q][j].w);
            ss[q] = wave_sum(ss[q]);
            if (lane == 0) RS1[m] = 1.0f / sqrtf(ss[q] * (1.0f / D) + EPS);
            GAS unsigned long long* o8 = (GAS unsigned long long*)(XB + (size_t)m * D) + lane; GAS unsigned* o4 = (GAS unsigned*)(P.ws + WS_X8 + (size_t)m * D) + lane;
#pragma unroll
            for (int j = 0; j < 8; ++j) { o8[64 * j] = (unsigned long long)pk2(v[q][j].x, v[q][j].y) | ((unsigned long long)pk2(v[q][j].z, v[q][j].w) << 32); o4[64 * j] = pg8::pk4_fp8(v[q][j].x, v[q][j].y, v[q][j].z, v[q][j].w); } }
    }
}

constexpr int CVT_ITEMS = 3 * 32768, CVT_CH = 4, CVT_CHUNK = CVT_CH * NWAVES, CVT_NCHUNK = CVT_ITEMS / CVT_CHUNK;
struct MoeItem { const float* src; const float* gk; unsigned char* dst; int N, k0, n0, dstK; };
__device__ __forceinline__ MoeItem moe_decode(const Ptrs& P, int r) {
    unsigned char* WGU = P.ws + WS_WGU; unsigned char* WD = P.ws + WS_WD; MoeItem m;
    const int mat = r >> 15, r2 = r & 32767, e = r2 >> 10, idx = r2 & 1023;
    if (mat < 2) { const int kb = idx >> 5, n0 = 32 * (idx & 31); const int drow = e * 2048 + 256 * (n0 >> 7) + (n0 & 127) + (mat == 1 ? 128 : 0);
        m.src = (mat == 0 ? P.w_gate : P.w_up) + (size_t)e * 2048 * 1024; m.N = 1024; m.gk = P.g2; m.k0 = 64 * kb; m.n0 = n0; m.dst = WGU + (size_t)drow * 2048 + 64 * kb; m.dstK = 2048; }
    else { const int kb = idx >> 6, nb = idx & 63; m.src = P.w_down + (size_t)e * 1024 * 2048; m.N = 2048; m.gk = nullptr; m.k0 = 64 * kb; m.n0 = 32 * nb; m.dst = WD + ((size_t)e * 2048 + 32 * nb) * 1024 + 64 * kb; m.dstK = 1024; }
    return m;
}
__device__ __forceinline__ void cvt_fill(const Ptrs& P, LAS unsigned char* lds, volatile LAS unsigned* slot, int max_chunks, const unsigned* donew, int G) {
    int tid_ = threadIdx.x; asm volatile("" : "+v"(tid_)); const int lane = tid_ & 63, wave = __builtin_amdgcn_readfirstlane(tid_ >> 6);
    LAS float* scr = (LAS float*)(lds + RING_OFF + wave * 16384); unsigned* ctr = (unsigned*)(P.ws + WS_CTL) + CW_CVQ;
    for (int n = 0; n < max_chunks; ++n) {
        if (threadIdx.x == 0) { unsigned v = 0xffffffffu;
            if (!(donew && (int)__hip_atomic_load(donew, __ATOMIC_RELAXED, __HIP_MEMORY_SCOPE_AGENT) >= G - 16)) v = __hip_atomic_fetch_add(ctr, 1u, __ATOMIC_RELAXED, __HIP_MEMORY_SCOPE_AGENT);
            *slot = v; }
        __syncthreads(); const unsigned c = *slot; __syncthreads();
        if (c >= (unsigned)CVT_NCHUNK) break;
#pragma unroll 1
        for (int j = 0; j < CVT_CH; j += 2) {
            const MoeItem m0 = moe_decode(P, (int)c * CVT_CHUNK + wave * CVT_CH + j), m1 = moe_decode(P, (int)c * CVT_CHUNK + wave * CVT_CH + j + 1);
            f32x4 v0[8], v1[8]; tr8_load(m0.src, m0.N, m0.k0, m0.n0, lane, v0); tr8_load(m1.src, m1.N, m1.k0, m1.n0, lane, v1);
            tr8_finish(v0, m0.gk, WSCALE, m0.k0, m0.dst, m0.dstK, scr, lane); tr8_finish(v1, m1.gk, WSCALE, m1.k0, m1.dst, m1.dstK, scr, lane); }
    }
}
__device__ __forceinline__ void h8_fill(const Ptrs& P, const bf16* HB, unsigned char* H8, volatile LAS unsigned* slot) {
    int tid_ = threadIdx.x; asm volatile("" : "+v"(tid_)); const int lane = tid_ & 63, wave = __builtin_amdgcn_readfirstlane(tid_ >> 6);
    unsigned* ctr = (unsigned*)(P.ws + WS_CTL) + CW_H8Q;
    for (;;) { const int c = attn_body::wg_pop(ctr, slot); if (c >= T / 64) break;
#pragma unroll 1
        for (int j = 0; j < 8; j += 4) { const int r0 = c * 64 + wave * 8 + j; u32x4g a[4][4];
#pragma unroll
            for (int q = 0; q < 4; ++q)
#pragma unroll
                for (int i = 0; i < 4; ++i) a[q][i] = *(const u32x4g*)(HB + (size_t)(r0 + q) * D + 16 * lane + 1024 * (i >> 1) + 8 * (i & 1));
#pragma unroll
            for (int q = 0; q < 4; ++q)
#pragma unroll
                for (int hj = 0; hj < 2; ++hj) { const u32x4g w0 = a[q][2 * hj], w1 = a[q][2 * hj + 1]; v4u o;
                    o.x = pg8::pk4_fp8(bflo(w0.x), bfhi(w0.x), bflo(w0.y), bfhi(w0.y)); o.y = pg8::pk4_fp8(bflo(w0.z), bfhi(w0.z), bflo(w0.w), bfhi(w0.w));
                    o.z = pg8::pk4_fp8(bflo(w1.x), bfhi(w1.x), bflo(w1.y), bfhi(w1.y)); o.w = pg8::pk4_fp8(bflo(w1.z), bfhi(w1.z), bflo(w1.w), bfhi(w1.w));
                    *(v4u*)(H8 + (size_t)(r0 + q) * D + 16 * lane + 1024 * hj) = o; } }
    }
}
__device__ __forceinline__ void router_skinny(const Ptrs& P, const bf16* HB, unsigned char* H8, LAS unsigned char* lds, int G) {
    int tid_ = threadIdx.x; asm volatile("" : "+v"(tid_)); const int tid = tid_, lane = tid & 63, wave = __builtin_amdgcn_readfirstlane(tid >> 6), fr = lane & 15, fq = lane >> 4;
    constexpr int BROW = 1040, BBUF = 48 * BROW;
    const bf16* WR = (const bf16*)(P.ws + WS_WR);
    LAS unsigned char* Bb = lds + RING_OFF; LAS float* LX = (LAS float*)(lds + RING_OFF + 2 * BBUF) + wave * (16 * 37);
    LAS unsigned* cntL = (LAS unsigned*)(lds + RING_OFF + 2 * BBUF + 8 * 16 * 37 * 4); LAS unsigned* baseL = cntL + 32;
    const float* part = (const float*)(P.ws + WS_PART); float* listr = (float*)(P.ws + WS_LISTR); float* listw = (float*)(P.ws + WS_LISTW); int* list = (int*)(P.ws + WS_LIST);
    unsigned* cnt = (unsigned*)(P.ws + WS_CTL) + CW_CNT;
    int brow[6], bcol[6];
#pragma unroll
    for (int i = 0; i < 6; ++i) { const int pc = tid + 512 * i; brow[i] = pc >> 6; bcol[i] = pc & 63; }
    for (int u = blockIdx.x; u < T / 128; u += G) {
        const int r0 = u * 128 + wave * 16;
        const bf16* arow = HB + (size_t)(r0 + fr) * D + 16 * fq;
        unsigned char* orow = H8 + (size_t)(r0 + fr) * D + 16 * fq;
        u32x4g bs[6], a[2][16]; pg8::f32x4 acc[3];
#pragma unroll
        for (int nb = 0; nb < 3; ++nb) acc[nb] = (pg8::f32x4){0.f, 0.f, 0.f, 0.f};
#define RS_LOADB(c) do { _Pragma("unroll") for (int i = 0; i < 6; ++i) { const int sr = brow[i] < 32 ? brow[i] : 128 + ((brow[i] - 32) & 3); \
            bs[i] = *(const u32x4g*)(WR + (size_t)sr * D + 512 * (c) + 8 * bcol[i]); } } while (0)
#define RS_STOREB(c) do { _Pragma("unroll") for (int i = 0; i < 6; ++i) *(LAS u32x4g*)(Bb + ((c) & 1) * BBUF + brow[i] * BROW + bcol[i] * 16) = bs[i]; } while (0)
#define RS_LOADA(c) do { _Pragma("unroll") for (int s = 0; s < 16; ++s) a[(c) & 1][s] = *(const u32x4g*)(arow + 512 * (c) + 64 * (s >> 1) + 8 * (s & 1)); } while (0)
        RS_LOADB(0); RS_LOADA(0); RS_STOREB(0);
#pragma unroll
        for (int c = 0; c < 4; ++c) {
            __syncthreads();
            if (c < 3) { RS_LOADB(c + 1); RS_LOADA(c + 1); }
#pragma unroll
            for (int s = 0; s < 16; ++s) {
                const pg8::bf16x8 af = __builtin_bit_cast(pg8::bf16x8, a[c & 1][s]);
#pragma unroll
                for (int nb = 0; nb < 3; ++nb) {
                    const pg8::bf16x8 bf = *(const LAS pg8::bf16x8*)(Bb + (c & 1) * BBUF + (16 * nb + fr) * BROW + (64 * (s >> 1) + 16 * fq + 8 * (s & 1)) * 2);
                    acc[nb] = __builtin_amdgcn_mfma_f32_16x16x32_bf16(af, bf, acc[nb], 0, 0, 0); }
            }
            if (c < 3) RS_STOREB(c + 1);
#pragma unroll
            for (int s = 0; s < 16; s += 2) { const u32x4g w0 = a[c & 1][s], w1 = a[c & 1][s + 1]; v4u o;
                o.x = pg8::pk4_fp8(bflo(w0.x), bfhi(w0.x), bflo(w0.y), bfhi(w0.y)); o.y = pg8::pk4_fp8(bflo(w0.z), bfhi(w0.z), bflo(w0.w), bfhi(w0.w));
                o.z = pg8::pk4_fp8(bflo(w1.x), bfhi(w1.x), bflo(w1.y), bfhi(w1.y)); o.w = pg8::pk4_fp8(bflo(w1.z), bfhi(w1.z), bflo(w1.w), bfhi(w1.w));
                *(v4u*)(orow + 512 * c + 64 * (s >> 1)) = o; }
        }
#undef RS_LOADB
#undef RS_STOREB
#undef RS_LOADA
#pragma unroll
        for (int nb = 0; nb < 3; ++nb)
#pragma unroll
            for (int r = 0; r < 4; ++r) if (nb < 2 || fr < 4) LX[(4 * fq + r) * 37 + 16 * nb + fr] = acc[nb][r];
        if (tid < 32) cntL[tid] = 0u;
        __syncthreads();
        int ea = 0, eb = 0, row = 0; unsigned ra = 0u, rb = 0u; float w1 = 0.f, w2 = 0.f, rstd = 0.f;
        if (lane < 16) { row = r0 + lane; const LAS float* lx = LX + lane * 37;
            float sq[4];
#pragma unroll
            for (int q = 0; q < 4; ++q) { const pg8::f32x4 p0 = *(const pg8::f32x4*)(part + (size_t)row * 32 + 8 * q), p1 = *(const pg8::f32x4*)(part + (size_t)row * 32 + 8 * q + 4);
                sq[q] = ((p0[0] + p0[1]) + (p0[2] + p0[3])) + ((p1[0] + p1[1]) + (p1[2] + p1[3])); }
            const float ss = (sq[0] + sq[1]) + (sq[2] + sq[3]);
            rstd = 1.0f / sqrtf(ss * (1.0f / 2048.0f) + 1e-6f);
            float g[4];
#pragma unroll
            for (int i = 0; i < 4; ++i) g[i] = lx[32 + i] * rstd + P.bgr[i];
            int gs = 0; float gm = g[0];
#pragma unroll
            for (int i = 1; i < 4; ++i) if (g[i] > gm) { gm = g[i]; gs = i; }
            float gsum = 0.f;
#pragma unroll
            for (int i = 0; i < 4; ++i) gsum += __expf(g[i] - gm);
            const float gw = 1.0f / gsum;
            float ev[8];
#pragma unroll
            for (int i = 0; i < 8; ++i) ev[i] = lx[8 * gs + i] * rstd + P.ber[8 * gs + i];
            int i1 = 0; float v1 = ev[0];
#pragma unroll
            for (int i = 1; i < 8; ++i) if (ev[i] > v1) { v1 = ev[i]; i1 = i; }
            int i2 = -1; float v2 = -3.0e38f;
#pragma unroll
            for (int i = 0; i < 8; ++i) if (i != i1 && ev[i] > v2) { v2 = ev[i]; i2 = i; }
            const float e2 = __expf(v2 - v1); w1 = gw / (1.f + e2); w2 = gw * e2 / (1.f + e2);
            ea = gs * 8 + i1; eb = gs * 8 + i2;
            ra = __hip_atomic_fetch_add(cntL + ea, 1u, __ATOMIC_RELAXED, __HIP_MEMORY_SCOPE_WORKGROUP);
            rb = __hip_atomic_fetch_add(cntL + eb, 1u, __ATOMIC_RELAXED, __HIP_MEMORY_SCOPE_WORKGROUP); }
        __syncthreads();
        if (tid < 32) { const unsigned n = cntL[tid]; baseL[tid] = n ? __hip_atomic_fetch_add(cnt + 64 * tid, n, __ATOMIC_RELAXED, __HIP_MEMORY_SCOPE_AGENT) : 0u; }
        __syncthreads();
        if (lane < 16) { const size_t ia = (size_t)ea * T + baseL[ea] + ra, ib = (size_t)eb * T + baseL[eb] + rb;
            list[ia] = 2 * row; list[ib] = 2 * row + 1; listw[ia] = w1; listw[ib] = w2; listr[ia] = rstd; listr[ib] = rstd; }
    }
    __syncthreads();
}
__device__ __forceinline__ void phase_tail(const Ptrs& P, LAS unsigned char* lds, volatile LAS unsigned* slot, int ph, int G) {
    unsigned* donew = (unsigned*)(P.ws + WS_CTL) + CW_DONE + 64 * ph;
    __syncthreads();
    if (threadIdx.x == 0) { const unsigned old = __hip_atomic_fetch_add(donew, 1u, __ATOMIC_RELAXED, __HIP_MEMORY_SCOPE_AGENT); *slot = (int)(old + 1u) >= G - 16 ? 1u : 0u; }
    __syncthreads(); const unsigned late = *slot; __syncthreads();
    if (late) return;
    cvt_fill(P, lds, slot, 1 << 30, donew, G);
}

__device__ __forceinline__ void naive_attn(const Ptrs& P, const bf16* Q, const bf16* Kb, const bf16* Vb, bf16* MIX, int lane, int gw, int NGW) {
    const float s1 = wave_sum(P.lq1[lane] * P.lk1[lane]), s2 = wave_sum(P.lq2[lane] * P.lk2[lane]);
    const float lam0 = 0.2f, lam = expf(s1) - expf(s2) + lam0;
    const int r16 = lane & 15, c = (lane >> 4) & 1, vh = lane >> 5;
    for (int u = gw; u < 16384; u += NGW) {
        const int bh = u & 63, qb = 255 - (u >> 6), b = bh >> 3, h = bh & 7, i = qb * 16 + r16, jmax = qb * 16 + 15;
        const float sl2 = exp2f(-(float)(h + 1)) * LOG2E; const size_t rowb = (size_t)b * SEQ;
        float q[64], O[64];
        { const u32x4g* qp = (const u32x4g*)(Q + (rowb + i) * 1024 + h * 128 + c * 64);
#pragma unroll
          for (int d8 = 0; d8 < 8; ++d8) { const u32x4g w = qp[d8]; q[8 * d8 + 0] = bflo(w.x); q[8 * d8 + 1] = bfhi(w.x); q[8 * d8 + 2] = bflo(w.y); q[8 * d8 + 3] = bfhi(w.y);
              q[8 * d8 + 4] = bflo(w.z); q[8 * d8 + 5] = bfhi(w.z); q[8 * d8 + 6] = bflo(w.w); q[8 * d8 + 7] = bfhi(w.w); } }
#pragma unroll
        for (int d = 0; d < 64; ++d) O[d] = 0.f;
        float m = -1e30f, l = 0.f;
        for (int j = 0; j <= jmax; ++j) {
            const u32x4g* kp = (const u32x4g*)(Kb + (rowb + j) * 1024 + h * 128 + c * 64); float s = 0.f;
#pragma unroll
            for (int d8 = 0; d8 < 8; ++d8) { const u32x4g w = kp[d8];
                s += q[8 * d8 + 0] * bflo(w.x) + q[8 * d8 + 1] * bfhi(w.x) + q[8 * d8 + 2] * bflo(w.y) + q[8 * d8 + 3] * bfhi(w.y)
                   + q[8 * d8 + 4] * bflo(w.z) + q[8 * d8 + 5] * bfhi(w.z) + q[8 * d8 + 6] * bflo(w.w) + q[8 * d8 + 7] * bfhi(w.w); }
            s += sl2 * (float)(j - i);
            if (j <= i) {
                if (s > m) { const float al = fexp2(m - s); l *= al;
#pragma unroll
                    for (int d = 0; d < 64; ++d) O[d] *= al;
                    m = s; }
                const float p = fexp2(s - m); l += p;
                const u32x4g* vp = (const u32x4g*)(Vb + (rowb + j) * 1024 + h * 128 + vh * 64);
#pragma unroll
                for (int d8 = 0; d8 < 8; ++d8) { const u32x4g w = vp[d8];
                    O[8 * d8 + 0] += p * bflo(w.x); O[8 * d8 + 1] += p * bfhi(w.x); O[8 * d8 + 2] += p * bflo(w.y); O[8 * d8 + 3] += p * bfhi(w.y);
                    O[8 * d8 + 4] += p * bflo(w.z); O[8 * d8 + 5] += p * bfhi(w.z); O[8 * d8 + 6] += p * bflo(w.w); O[8 * d8 + 7] += p * bfhi(w.w); }
            }
        }
        const float il = 1.0f / l; float ss = 0.f;
#pragma unroll
        for (int d = 0; d < 64; ++d) { float o = O[d] * il; const float o2 = __shfl_xor(o, 16); o = o - lam * o2; O[d] = o; ss += o * o; }
        ss += __shfl_xor(ss, 32);
        const float r = (1.0f / sqrtf(ss * (1.0f / 128.0f) + EPS)) * (1.0f - lam0);
        if (c == 0) { u32x4g* op = (u32x4g*)(MIX + (rowb + i) * 2048 + h * 128 + vh * 64); const float* sg = P.subg + vh * 64;
#pragma unroll
            for (int d8 = 0; d8 < 8; ++d8) { u32x4g w; w.x = pk2(O[8 * d8 + 0] * r * sg[8 * d8 + 0], O[8 * d8 + 1] * r * sg[8 * d8 + 1]); w.y = pk2(O[8 * d8 + 2] * r * sg[8 * d8 + 2], O[8 * d8 + 3] * r * sg[8 * d8 + 3]);
                w.z = pk2(O[8 * d8 + 4] * r * sg[8 * d8 + 4], O[8 * d8 + 5] * r * sg[8 * d8 + 5]); w.w = pk2(O[8 * d8 + 6] * r * sg[8 * d8 + 6], O[8 * d8 + 7] * r * sg[8 * d8 + 7]); op[d8] = w; } }
    }
}

typedef float f32x2c __attribute__((ext_vector_type(2)));
__device__ __forceinline__ void conv_phase(const Ptrs& P, const bf16* CA, bf16* MIX, LAS unsigned char* lds, int blk, unsigned* qctr, volatile LAS unsigned* slot) {
    int tid_ = threadIdx.x; asm volatile("" : "+v"(tid_)); const int tid = tid_, lane = tid & 63, wave = __builtin_amdgcn_readfirstlane(tid >> 6);
    LAS unsigned* C = (LAS unsigned*)(lds + RING_OFF);
    f32x2c w[31];
#pragma unroll
    for (int j = 0; j < 31; ++j) w[j] = *(const f32x2c*)(P.cw + j * 1024 + 2 * tid);
    const f32x2c bias = *(const f32x2c*)(P.cb + 2 * tid);
    for (int qi = 0; qi < 8; ++qi) { const int xq = (blk + qi) & 7;
    for (;;) { const int n_ = attn_body::wg_pop(qctr + 64 * xq, slot); if (n_ >= 64) break;
        const int tile = xq + 8 * n_, b = tile >> 6, t0 = (tile & 63) * 64; const size_t rowb = (size_t)b * SEQ;
        const unsigned* up = (const unsigned*)(CA + rowb * 1024 + 2 * tid);
        f32x2c win[38]; unsigned hist[30];
#pragma unroll
        for (int k = 0; k < 30; ++k) { const int t = t0 - 30 + k; hist[k] = (t >= 0) ? up[(size_t)t * 512] : 0u; }
        unsigned nw[8];
#pragma unroll
        for (int i = 0; i < 8; ++i) nw[i] = up[(size_t)(t0 + i) * 512];
#pragma unroll
        for (int k = 0; k < 30; ++k) win[k] = (f32x2c){bflo(hist[k]), bfhi(hist[k])};
#pragma unroll 1
        for (int blk8 = 0; blk8 < 8; ++blk8) {
#pragma unroll
            for (int i = 0; i < 8; ++i) win[30 + i] = (f32x2c){bflo(nw[i]), bfhi(nw[i])};
            if (blk8 < 7) {
#pragma unroll
                for (int i = 0; i < 8; ++i) nw[i] = up[(size_t)(t0 + 8 * (blk8 + 1) + i) * 512];
            }
#pragma unroll
            for (int i = 0; i < 8; ++i) { f32x2c acc = bias;
#pragma unroll
                for (int j = 0; j < 31; ++j) acc = w[j] * win[i + j] + acc;
                C[(8 * blk8 + i) * 512 + tid] = pk2(acc.x, acc.y); }
#pragma unroll
            for (int k = 0; k < 30; ++k) win[k] = win[k + 8];
        }
        __syncthreads();
#pragma unroll 1
        for (int k = 0; k < 8; ++k) { const int rr = wave + 8 * k, t = t0 + rr; const LAS unsigned* row = C + rr * 512;
            const v4u x0 = *(const LAS v4u*)(row + 4 * lane), x1 = *(const LAS v4u*)(row + 256 + 4 * lane);
            float v[16] = {bflo(x0.x), bfhi(x0.x), bflo(x0.y), bfhi(x0.y), bflo(x0.z), bfhi(x0.z), bflo(x0.w), bfhi(x0.w), bflo(x1.x), bfhi(x1.x), bflo(x1.y), bfhi(x1.y), bflo(x1.z), bfhi(x1.z), bflo(x1.w), bfhi(x1.w)};
            float s = 0.f;
#pragma unroll
            for (int i = 0; i < 16; ++i) s += v[i];
            const float mean = wave_sum(s) * (1.0f / 1024.0f); float qq = 0.f;
#pragma unroll
            for (int i = 0; i < 16; ++i) { v[i] -= mean; qq += v[i] * v[i]; }
            const float rstd = 1.0f / sqrtf(wave_sum(qq) * (1.0f / 1024.0f) + EPS);
            float y[16];
#pragma unroll
            for (int i = 0; i < 16; ++i) { const int ch = (i < 8 ? 8 * lane + i : 512 + 8 * lane + (i - 8)); const float z = v[i] * rstd * P.lng[ch] + P.lnb[ch]; y[i] = z / (1.f + __expf(-z)); }
            bf16* op = MIX + (rowb + t) * 2048 + 1024 + 8 * lane;
            v4u o0, o1; o0.x = pk2(y[0], y[1]); o0.y = pk2(y[2], y[3]); o0.z = pk2(y[4], y[5]); o0.w = pk2(y[6], y[7]); o1.x = pk2(y[8], y[9]); o1.y = pk2(y[10], y[11]); o1.z = pk2(y[12], y[13]); o1.w = pk2(y[14], y[15]);
            *(GAS v4u*)op = o0; *(GAS v4u*)(op + 512) = o1; }
        __syncthreads();
    } }
}

__device__ __forceinline__ void router_phase(const Ptrs& P, const bf16* HB, int lane, int gw, int NGW) {
    float* RS2 = (float*)(P.ws + WS_RSTD2); float* WTS = (float*)(P.ws + WS_WTS); int* LIST = (int*)(P.ws + WS_LIST); unsigned* CNT = (unsigned*)(P.ws + WS_CTL) + CW_CNT;
    for (int tok = gw; tok < T; tok += NGW) {
        float hv[32]; const bf16* hp = HB + (size_t)tok * D; float ss = 0.f;
#pragma unroll
        for (int j = 0; j < 4; ++j) { const u32x4g w = *(const u32x4g*)(hp + 8 * lane + 512 * j);
            hv[8 * j + 0] = bflo(w.x); hv[8 * j + 1] = bfhi(w.x); hv[8 * j + 2] = bflo(w.y); hv[8 * j + 3] = bfhi(w.y); hv[8 * j + 4] = bflo(w.z); hv[8 * j + 5] = bfhi(w.z); hv[8 * j + 6] = bflo(w.w); hv[8 * j + 7] = bfhi(w.w); }
#pragma unroll
        for (int k = 0; k < 32; ++k) ss += hv[k] * hv[k];
        ss = wave_sum(ss); const float rstd = 1.0f / sqrtf(ss * (1.0f / D) + EPS);
        float lg[36];
#pragma unroll
        for (int o = 0; o < 36; ++o) lg[o] = 0.f;
#pragma unroll
        for (int j = 0; j < 4; ++j)
#pragma unroll 2
            for (int i = 0; i < 8; ++i) { const int e = 8 * lane + 512 * j + i; const float xv = hv[8 * j + i] * P.g2[e];
                const f32x4* wr = (const f32x4*)(P.wer + (size_t)e * 32); const f32x4 wg = *(const f32x4*)(P.wgr + (size_t)e * 4);
#pragma unroll
                for (int o4 = 0; o4 < 8; ++o4) { const f32x4 w = wr[o4]; lg[4 * o4 + 0] += xv * w.x; lg[4 * o4 + 1] += xv * w.y; lg[4 * o4 + 2] += xv * w.z; lg[4 * o4 + 3] += xv * w.w; }
                lg[32] += xv * wg.x; lg[33] += xv * wg.y; lg[34] += xv * wg.z; lg[35] += xv * wg.w; }
#pragma unroll
        for (int o = 0; o < 36; ++o) lg[o] = wave_sum(lg[o]) * rstd + (o < 32 ? P.ber[o] : P.bgr[o - 32]);
        int gs = 0; float gm = lg[32];
#pragma unroll
        for (int g = 1; g < 4; ++g) if (lg[32 + g] > gm) { gm = lg[32 + g]; gs = g; }
        float gsum = 0.f;
#pragma unroll
        for (int g = 0; g < 4; ++g) gsum += __expf(lg[32 + g] - gm);
        const float gw_ = 1.0f / gsum;
        float ev[8];
#pragma unroll
        for (int i = 0; i < 8; ++i) ev[i] = gs == 0 ? lg[i] : gs == 1 ? lg[8 + i] : gs == 2 ? lg[16 + i] : lg[24 + i];
        int i1 = 0; float v1 = ev[0];
#pragma unroll
        for (int i = 1; i < 8; ++i) if (ev[i] > v1) { v1 = ev[i]; i1 = i; }
        int i2 = -1; float v2 = -3.0e38f;
#pragma unroll
        for (int i = 0; i < 8; ++i) if (i != i1 && ev[i] > v2) { v2 = ev[i]; i2 = i; }
        const float e2 = __expf(v2 - v1), w1 = gw_ / (1.f + e2), w2 = gw_ * e2 / (1.f + e2);
        if (lane == 0) {
            RS2[tok] = rstd;
            const int ea = gs * 8 + i1, eb = gs * 8 + i2;
            const unsigned ra = __hip_atomic_fetch_add(CNT + 64 * ea, 1u, __ATOMIC_RELAXED, __HIP_MEMORY_SCOPE_AGENT);
            const unsigned rb = __hip_atomic_fetch_add(CNT + 64 * eb, 1u, __ATOMIC_RELAXED, __HIP_MEMORY_SCOPE_AGENT);
            LIST[(size_t)ea * T + ra] = 2 * tok; LIST[(size_t)eb * T + rb] = 2 * tok + 1; WTS[2 * tok] = w1; WTS[2 * tok + 1] = w2;
        }
    }
}
__device__ __forceinline__ void moe_tables(const Ptrs& P, LAS unsigned char* lds) {
    int tid = threadIdx.x; asm volatile("" : "+v"(tid));
    LAS int* cntL = (LAS int*)(lds + TAB_OFF); LAS int* ts = cntL + 32; unsigned* CNT = (unsigned*)(P.ws + WS_CTL) + CW_CNT;
    if (tid < 32) cntL[tid] = (int)__hip_atomic_load(CNT + 64 * tid, __ATOMIC_RELAXED, __HIP_MEMORY_SCOPE_AGENT);
    __syncthreads();
    if (tid == 0) { int s = 0; for (int e = 0; e < 32; ++e) { ts[e] = s; s += (cntL[e] + 255) >> 8; } ts[32] = s; }
    __syncthreads();
}

__device__ __forceinline__ float fp8f(unsigned w, int i) { return i == 0 ? __builtin_amdgcn_cvt_f32_fp8(w, 0) : i == 1 ? __builtin_amdgcn_cvt_f32_fp8(w, 1) : i == 2 ? __builtin_amdgcn_cvt_f32_fp8(w, 2) : __builtin_amdgcn_cvt_f32_fp8(w, 3); }
__device__ __forceinline__ void final_phase(const Ptrs& P, const bf16* HB, const unsigned char* Y8, int NGW) {
    int tid_ = threadIdx.x; asm volatile("" : "+v"(tid_)); const int lane = tid_ & 63, gw = (int)blockIdx.x * NWAVES + __builtin_amdgcn_readfirstlane(tid_ >> 6);
    for (int tok0 = gw; tok0 < T; tok0 += 2 * NGW) {
        u32x4g a[2][4]; pg8::u32x2 b[2][4], c[2][4];
#pragma unroll
        for (int q = 0; q < 2; ++q) { const int tk = (tok0 + q * NGW < T) ? tok0 + q * NGW : T - 1;
            const bf16* hp = HB + (size_t)tk * D; const unsigned char* y1 = Y8 + (size_t)tk * 4096; const unsigned char* y2 = y1 + 2048;
#pragma unroll
            for (int j = 0; j < 4; ++j) { const int o = 8 * lane + 512 * j; a[q][j] = __builtin_nontemporal_load((const u32x4g*)(hp + o));
                b[q][j] = __builtin_nontemporal_load((const pg8::u32x2*)(y1 + o)); c[q][j] = __builtin_nontemporal_load((const pg8::u32x2*)(y2 + o)); } }
#pragma unroll
        for (int q = 0; q < 2; ++q) { const int tok = tok0 + q * NGW; if (tok >= T) continue;
            float v[32]; float ss = 0.f; const float ys = 1.0f / YSCALE;
#pragma unroll
            for (int j = 0; j < 4; ++j) { const u32x4g aa = a[q][j]; const pg8::u32x2 bb = b[q][j], cc = c[q][j];
                v[8 * j + 0] = bflo(aa.x) + (fp8f(bb.x, 0) + fp8f(cc.x, 0)) * ys; v[8 * j + 1] = bfhi(aa.x) + (fp8f(bb.x, 1) + fp8f(cc.x, 1)) * ys;
                v[8 * j + 2] = bflo(aa.y) + (fp8f(bb.x, 2) + fp8f(cc.x, 2)) * ys; v[8 * j + 3] = bfhi(aa.y) + (fp8f(bb.x, 3) + fp8f(cc.x, 3)) * ys;
                v[8 * j + 4] = bflo(aa.z) + (fp8f(bb.y, 0) + fp8f(cc.y, 0)) * ys; v[8 * j + 5] = bfhi(aa.z) + (fp8f(bb.y, 1) + fp8f(cc.y, 1)) * ys;
                v[8 * j + 6] = bflo(aa.w) + (fp8f(bb.y, 2) + fp8f(cc.y, 2)) * ys; v[8 * j + 7] = bfhi(aa.w) + (fp8f(bb.y, 3) + fp8f(cc.y, 3)) * ys; }
#pragma unroll
            for (int k = 0; k < 32; ++k) ss += v[k] * v[k];
            ss = wave_sum(ss); const float rstd = 1.0f / sqrtf(ss * (1.0f / D) + EPS);
            float* op = P.out + (size_t)tok * D;
#pragma unroll
            for (int j = 0; j < 4; ++j) { const int o = 8 * lane + 512 * j; const f32x4 g0 = *(const f32x4*)(P.gf + o), g1 = *(const f32x4*)(P.gf + o + 4);
                f32x4 r0 = {v[8 * j + 0] * rstd * g0.x, v[8 * j + 1] * rstd * g0.y, v[8 * j + 2] * rstd * g0.z, v[8 * j + 3] * rstd * g0.w};
                f32x4 r1 = {v[8 * j + 4] * rstd * g1.x, v[8 * j + 5] * rstd * g1.y, v[8 * j + 6] * rstd * g1.z, v[8 * j + 7] * rstd * g1.w};
                *(f32x4*)(op + o) = r0; *(f32x4*)(op + o + 4) = r1; } }
    }
}

struct Args { const float* in[22]; float* out; unsigned char* ws; int ph_lo, ph_hi; };
__global__ void __launch_bounds__(NWAVES * 64, 2) fwd(Args args) {
    extern __shared__ __attribute__((aligned(16))) unsigned char lds_raw[];
    LAS unsigned char* lds = (LAS unsigned char*)lds_raw;
    volatile LAS unsigned* MISC = (volatile LAS unsigned*)(lds + MISC_OFF);
    const int tid = threadIdx.x, lane = tid & 63, wave = __builtin_amdgcn_readfirstlane(tid >> 6), G = gridDim.x;
    const int gw = blockIdx.x * NWAVES + wave, NGW = G * NWAVES;
    Ptrs P;
    P.x = args.in[0]; P.g1 = args.in[1]; P.w_in = args.in[2]; P.lq1 = args.in[3]; P.lk1 = args.in[4]; P.lq2 = args.in[5]; P.lk2 = args.in[6]; P.subg = args.in[7];
    P.cw = args.in[8]; P.cb = args.in[9]; P.lng = args.in[10]; P.lnb = args.in[11]; P.w_out = args.in[12]; P.g2 = args.in[13]; P.wgr = args.in[14]; P.bgr = args.in[15];
    P.wer = args.in[16]; P.ber = args.in[17]; P.w_gate = args.in[18]; P.w_up = args.in[19]; P.w_down = args.in[20]; P.gf = args.in[21]; P.out = args.out; P.ws = args.ws;
    unsigned char* ws = args.ws;
#define WIN ((bf16*)(ws + WS_WIN))
#define WOUT ((bf16*)(ws + WS_WOUT))
#define WGU (ws + WS_WGU)
#define WD (ws + WS_WD)
#define XB ((bf16*)(ws + WS_XB))
#define H1 (ws + WS_XB)
#define HB8 (ws + WS_HB8)
#define CGB ((bf16*)(ws + WS_CG))
#define MIX ((bf16*)(ws + WS_MIX))
#define HB ((bf16*)(ws + WS_HB))
#define QB ((bf16*)P.out)
#define KB (QB + (size_t)T * 1024)
#define VB (QB + (size_t)T * 2048)
#define CAB (QB + (size_t)T * 3072)
#define YB ((bf16*)P.out)
#define RELOAD_ARGS() do { const __attribute__((address_space(4))) Args* ka_ = (const __attribute__((address_space(4))) Args*)__builtin_amdgcn_kernarg_segment_ptr(); asm volatile("" : "+s"(ka_)); \
    P.x = ka_->in[0]; P.g1 = ka_->in[1]; P.w_in = ka_->in[2]; P.lq1 = ka_->in[3]; P.lk1 = ka_->in[4]; P.lq2 = ka_->in[5]; P.lk2 = ka_->in[6]; P.subg = ka_->in[7]; \
    P.cw = ka_->in[8]; P.cb = ka_->in[9]; P.lng = ka_->in[10]; P.lnb = ka_->in[11]; P.w_out = ka_->in[12]; P.g2 = ka_->in[13]; P.wgr = ka_->in[14]; P.bgr = ka_->in[15]; \
    P.wer = ka_->in[16]; P.ber = ka_->in[17]; P.w_gate = ka_->in[18]; P.w_up = ka_->in[19]; P.w_down = ka_->in[20]; P.gf = ka_->in[21]; P.out = ka_->out; P.ws = ka_->ws; ws = ka_->ws; } while (0)
    for (int u = tid; u < (LDS_BYTES - LDSCTL_OFF) / 4; u += NWAVES * 64) ((LAS unsigned*)(lds + LDSCTL_OFF))[u] = 0u;
    __syncthreads();
    const int lo = args.ph_lo, hi = args.ph_hi;
    XcdBarrier bar; bar.bar = (unsigned*)(ws + WS_CTL) + CW_BAR; bar.x = 0; bar.st = nullptr;
    if (hi - lo > 1) bar = xcd_barrier_post((unsigned*)(ws + WS_CTL) + CW_BAR, MISC + 8);
#define IN(k) (lo <= (k) && (k) < hi)
#if PROBE_PHASE >= 0
    unsigned long long pst_[NPHASE + 1]; pst_[0] = __builtin_amdgcn_s_memrealtime();
#define SEAM(k) do { if (IN(k) && IN((k) + 1)) xcd_barrier(bar); pst_[(k) + 1] = __builtin_amdgcn_s_memrealtime(); } while (0)
#else
#define SEAM(k) do { if (IN(k) && IN((k) + 1)) xcd_barrier(bar); } while (0)
#endif
#define REP(k) for (int rep_ = 0; rep_ <= ((PROBE_DOUBLE >> (k)) & 1); ++rep_)

    if (IN(0)) REP(0) { p0_prologue(P, lds, lane, wave, gw, NGW); }
    SEAM(0);
#if PROBE_CLOCK
    const long long pc0 = clock64(), pr0 = wall_clock64();
#endif
    if (IN(1)) {
        cvt_fill(P, lds, MISC + 12, (int)((blockIdx.x >> 3) % 8) * 3 / 4, nullptr, G);
        for (int pass = 0; pass < 2; ++pass) {
            if ((pass ^ (int)(blockIdx.x & 1)) == 0) { pg8::Gemm g{XB, WIN, 1, 3072, D, (unsigned*)(ws + WS_CTL) + 3002}; pg8::DynDense S; S.init(T, 3072, (unsigned*)(ws + WS_CTL) + CW_GQ + 0 * 512, (volatile LAS int*)(MISC + 16), (int)blockIdx.x);
                pg8::EpiIn E{QB, (size_t)T * 1024, CGB, (const float*)(ws + WS_RSTD1), C2, (unsigned*)(ws + WS_CTL) + CW_NMAX, 0, 1.0f};
                pg8::gemm_phase<pg8::EpiIn, pg8::DynDense, true, false>(lds + RING_OFF, g, S, E); }
            else { pg8::Gemm g{(const bf16*)(ws + WS_X8), (const bf16*)(ws + WS_WIN8), 2, 2048, D / 2, (unsigned*)(ws + WS_CTL) + 3002}; pg8::DynDenseG S; S.init(T, 2048, (unsigned*)(ws + WS_CTL) + CW_GQ + 1 * 512, (volatile LAS int*)(MISC + 16), (int)blockIdx.x);
                pg8::EpiGLU E{CAB, (const float*)(ws + WS_RSTD1), 1.0f / WSCALE};
                pg8::gemm_phase<pg8::EpiGLU, pg8::DynDenseG, true, true, true>(lds + RING_OFF, g, S, E); }
        }
#if PROBE_ATT == 6
        if (threadIdx.x == 0) atomicMax((unsigned*)(ws + WS_CTL) + CW_NMAX + 900, (unsigned)(__builtin_amdgcn_s_memrealtime() - pst_[1]));
#endif
#if PROBE_ATT == 7
        if (threadIdx.x == 0) atomicAdd((unsigned*)(ws + WS_CTL) + CW_NMAX + 900, (unsigned)(__builtin_amdgcn_s_memrealtime() - pst_[1]) >> 8);
#endif
#if PROBE_ATT == 5
        if (blockIdx.x == PROBE_BLK && threadIdx.x == 0) atomicAdd((unsigned*)(ws + WS_CTL) + CW_NMAX + 900, (unsigned)(__builtin_amdgcn_s_memrealtime() - pst_[1]));
#endif
        phase_tail(P, lds, MISC + 12, 1, G);
    }
#if PROBE_CLOCK
    if (IN(1) && tid == 0) { const unsigned dt = (unsigned)(wall_clock64() - pr0); atomicAdd((unsigned*)(ws + WS_CTL) + 3000, dt); atomicMax((unsigned*)(ws + WS_CTL) + 3001, dt); }
#endif
    SEAM(1);
    if (IN(2)) {
#if USE_NAIVE_ATTN
        naive_attn(P, QB, KB, VB, MIX, lane, gw, NGW);
#else
        { float s1 = 0.f, s2 = 0.f;
          for (int i = 0; i < 64; ++i) { s1 += P.lq1[i] * P.lk1[i]; s2 += P.lq2[i] * P.lk2[i]; }
          const float lam0 = 0.2f, lam = expf(s1) - expf(s2) + lam0;
          static_assert(attn_body::ATTN_LDS_BYTES <= RING_BYTES, "attention LDS");
          attn_body::attn_phase<8>((char*)lds_raw + RING_OFF, (int)blockIdx.x, (unsigned*)(ws + WS_CTL) + CW_QA, MISC + 12, lam, 1.0f - lam0, P.subg, (const unsigned*)(ws + WS_CTL) + CW_NMAX, (unsigned*)(ws + WS_O1S) + (size_t)blockIdx.x * 16384,
                                   (const attn_body::bf16*)QB, (const attn_body::bf16*)KB, (const attn_body::bf16*)VB, (attn_body::bf16*)MIX); }
        RELOAD_ARGS();
#endif
        conv_phase(P, CAB, MIX, lds, (int)blockIdx.x, (unsigned*)(ws + WS_CTL) + CW_QC, MISC + 12);
#if PROBE_ATT == 2
        if (blockIdx.x == PROBE_BLK && threadIdx.x == 0) atomicAdd((unsigned*)(ws + WS_CTL) + CW_NMAX + 900, (unsigned)(__builtin_amdgcn_s_memrealtime() - pst_[2]));
#endif
        phase_tail(P, lds, MISC + 12, 2, G);
    }
    SEAM(2);
    if (IN(3)) {
        pg8::Gemm g{MIX, WOUT, 3, D, D, (unsigned*)(ws + WS_CTL) + 3002}; pg8::StaticOrder S; S.init(T, D, G, (int)blockIdx.x); S.rep = 1 + ((PROBE_DOUBLE >> 3) & 1);
        pg8::EpiOut E{HB, XB, (float*)(ws + WS_PART), nullptr};
        pg8::gemm_phase<pg8::EpiOut, pg8::StaticOrder, true, false>(lds + RING_OFF, g, S, E);
        phase_tail(P, lds, MISC + 12, 3, G);
    }
    SEAM(3);
#if PROBE_ATT == 9
    if (IN(4) && blockIdx.x == PROBE_BLK && threadIdx.x == 0) atomicAdd((unsigned*)(ws + WS_CTL) + CW_NMAX + 900, 10u * __hip_atomic_load((unsigned*)(ws + WS_CTL) + CW_CVQ, __ATOMIC_RELAXED, __HIP_MEMORY_SCOPE_AGENT));
#endif
#if USE_NAIVE_ROUTER
    if (IN(4)) { router_phase(P, HB, lane, gw, NGW); }
#else
    if (IN(4)) {
        router_skinny(P, HB, HB8, lds, G);
#if PROBE_ATT == 11
        if (threadIdx.x == 0) atomicMax((unsigned*)(ws + WS_CTL) + CW_NMAX + 900, (unsigned)(__builtin_amdgcn_s_memrealtime() - pst_[4]));
#endif
#if PROBE_ATT == 10
        if (blockIdx.x == PROBE_BLK && threadIdx.x == 0) atomicAdd((unsigned*)(ws + WS_CTL) + CW_NMAX + 900, (unsigned)(__builtin_amdgcn_s_memrealtime() - pst_[4]));
#endif
#if PROBE_ATT == 8
        if (blockIdx.x == PROBE_BLK && threadIdx.x == 0) atomicAdd((unsigned*)(ws + WS_CTL) + CW_NMAX + 900, 10u * __hip_atomic_load((unsigned*)(ws + WS_CTL) + CW_CVQ, __ATOMIC_RELAXED, __HIP_MEMORY_SCOPE_AGENT));
#endif
        cvt_fill(P, lds, MISC + 12, 1 << 30, nullptr, G);
    }
#endif
    SEAM(4);
    if (IN(5)) {
        moe_tables(P, lds);
        pg8::Gemm g{(const bf16*)HB8, (const bf16*)WGU, 5, 2048, D / 2, (unsigned*)(ws + WS_CTL) + 3002};
        pg8::MoeOrder S{(const LAS int*)(lds + TAB_OFF) + 32, (const LAS int*)(lds + TAB_OFF), (const int*)(ws + WS_LIST), G, (int)blockIdx.x, 1, T, (size_t)2048 * 2048, 0};
        pg8::EpiGU E{H1, (const int*)(ws + WS_LIST), (const float*)(ws + WS_LISTR), 1.0f / WSCALE, H1SCALE};
        pg8::gemm_phase<pg8::EpiGU, pg8::MoeOrder, true, true, true>(lds + RING_OFF, g, S, E);
    }
    SEAM(5);
    if (IN(6)) {
        if (!IN(5)) moe_tables(P, lds);
        pg8::Gemm g{(const bf16*)H1, (const bf16*)WD, 6, 2048, 512, (unsigned*)(ws + WS_CTL) + 3002};
        pg8::MoeOrder S{(const LAS int*)(lds + TAB_OFF) + 32, (const LAS int*)(lds + TAB_OFF), (const int*)(ws + WS_LIST), G, (int)blockIdx.x, 0, T, (size_t)2048 * 1024, 1};
        pg8::EpiDown E{ws + WS_MIX, (const int*)(ws + WS_LIST), (const float*)(ws + WS_LISTW), YSCALE / (WSCALE * H1SCALE)};
        pg8::gemm_phase<pg8::EpiDown, pg8::MoeOrder, true, true, true>(lds + RING_OFF, g, S, E);
    }
    SEAM(6);
    if (IN(7)) { final_phase(P, HB, ws + WS_MIX, NGW); }
#if PROBE_ATT
    if (blockIdx.x == 0) { const unsigned long long span = __hip_atomic_load((unsigned*)(ws + WS_CTL) + CW_NMAX + 900, __ATOMIC_RELAXED, __HIP_MEMORY_SCOPE_AGENT); const unsigned long long r1 = __builtin_amdgcn_s_memrealtime(); while (__builtin_amdgcn_s_memrealtime() - r1 < span) __builtin_amdgcn_s_sleep(8); }
#endif
#if PROBE_PHASE >= 0
    pst_[NPHASE] = __builtin_amdgcn_s_memrealtime();
    if (blockIdx.x == 0 && PROBE_PHASE < 100) { const unsigned long long span = pst_[(PROBE_PHASE < 100 ? PROBE_PHASE : 0) + 1] - pst_[PROBE_PHASE < 100 ? PROBE_PHASE : 0]; const unsigned long long r1 = __builtin_amdgcn_s_memrealtime(); while (__builtin_amdgcn_s_memrealtime() - r1 < span) __builtin_amdgcn_s_sleep(8); }
#endif
#if PROBE_KLOOP
    if (blockIdx.x == 0) { const long long pticks = (long long)__hip_atomic_load((unsigned*)(ws + WS_CTL) + 3002, __ATOMIC_RELAXED, __HIP_MEMORY_SCOPE_AGENT); const long long r1 = wall_clock64(); while (wall_clock64() - r1 < pticks) __builtin_amdgcn_s_sleep(8); }
#endif
#if PROBE_CLOCK
    if (blockIdx.x == 0) { const unsigned sum = __hip_atomic_load((unsigned*)(ws + WS_CTL) + 3000, __ATOMIC_RELAXED, __HIP_MEMORY_SCOPE_AGENT), mx = __hip_atomic_load((unsigned*)(ws + WS_CTL) + 3001, __ATOMIC_RELAXED, __HIP_MEMORY_SCOPE_AGENT);
        const long long pticks = (long long)mx - (long long)(sum / (unsigned)G); const long long r1 = wall_clock64(); while (wall_clock64() - r1 < pticks) __builtin_amdgcn_s_sleep(8); }
#endif
#undef IN
#undef SEAM
#undef REP
}

extern "C" void kernel_launch(void* const* d_in, const int* in_sizes, int n_in, void* d_out, int out_size, void* d_ws, size_t ws_size, hipStream_t stream) {
    static int grid = 0;
    if (grid == 0) {
        if (n_in != 22 || in_sizes[0] != T * D || out_size != T * D || ws_size < WS_END) { fprintf(stderr, "kernel_launch: unexpected shapes (n_in %d, in0 %d, out %d, ws %zu); nothing launched\n", n_in, n_in > 0 ? in_sizes[0] : -1, out_size, ws_size); grid = -1; return; }
        int dev = 0, cus = 0, per_cu = 0;
        if (hipGetDevice(&dev) != hipSuccess || hipDeviceGetAttribute(&cus, hipDeviceAttributeMultiprocessorCount, dev) != hipSuccess) { grid = -1; return; }
        if (hipFuncSetAttribute((const void*)fwd, hipFuncAttributeMaxDynamicSharedMemorySize, LDS_BYTES) != hipSuccess) { fprintf(stderr, "kernel_launch: hipFuncSetAttribute failed\n"); grid = -1; return; }
        if (hipOccupancyMaxActiveBlocksPerMultiprocessor(&per_cu, (const void*)fwd, NWAVES * 64, LDS_BYTES) != hipSuccess || per_cu < 1) fprintf(stderr, "kernel_launch: occupancy query reports %d\n", per_cu);
        (void)hipGetLastError();
        grid = cus;
    }
    if (grid < 0) return;
    if (hipMemsetAsync((char*)d_ws + WS_CTL, 0, CTL_ZERO_BYTES, stream) != hipSuccess) return;
    Args a{};
    for (int i = 0; i < 22; ++i) a.in[i] = (const float*)d_in[i];
    a.out = (float*)d_out; a.ws = (unsigned char*)d_ws;
#if MK_ONE_LAUNCH
    a.ph_lo = 0; a.ph_hi = NPHASE;
    hipLaunchKernelGGL(fwd, dim3(grid), dim3(NWAVES * 64), LDS_BYTES, stream, a);
#else
    for (int p = 0; p < NPHASE; ++p) { a.ph_lo = p; a.ph_hi = p + 1; hipLaunchKernelGGL(fwd, dim3(grid), dim3(NWAVES * 64), LDS_BYTES, stream, a); }
#endif
}
```
